# Optimizing an MI355X kernel written in HIP

```python
import jax, jax.numpy as jnp
from jax import lax
import numpy as np

D_MODEL = 1024
BATCH = 2
SEQ = 16384
DEPTH = 2

CONV_DIM = 512
CONV_WIDTH = 3
NSA_HEADS = 8
NSA_GROUPS = 2
HEADS_PER_GROUP = NSA_HEADS // NSA_GROUPS
HEAD_DIM = 64
ROT_DIM = HEAD_DIM // 4
ROPE_THETA = 500000.0
CMP_BLOCK = 32
CMP_STRIDE = 16
CMP_HIDDEN = 256
SLC_BLOCK = 64
N_SELECT = 16
WINDOW = 512
MEM_LEN = 256
MEM_HEADS = 4
MEM_HEAD_DIM = 128
D_FF = 2816
Q_BLOCK = 128
EPS = 1e-6
NEG = -1e30
BIG = 1e30
SPLIT_SIZES = (CONV_DIM, CONV_DIM, CONV_DIM, NSA_HEADS * HEAD_DIM, 6 * NSA_GROUPS * HEAD_DIM, 3 * NSA_HEADS, MEM_HEADS * MEM_HEAD_DIM, 3 * D_MODEL)
MIX_IN = 3 * CONV_DIM + NSA_HEADS * HEAD_DIM + 6 * NSA_GROUPS * HEAD_DIM + 3 * NSA_HEADS + MEM_HEADS * MEM_HEAD_DIM + 3 * D_MODEL

kernel_name = 'hybrid_conv_nsa_memory_macaron_block'


def rms_norm(x, g):
    xf = x.astype(jnp.float32)
    y = xf * lax.rsqrt(jnp.mean(xf * xf, axis=-1, keepdims=True) + EPS)
    return (y * g.astype(jnp.float32)).astype(x.dtype)


def swiglu(h, w_in, w_out):
    a, b = jnp.split(h @ w_in, 2, axis=-1)
    return (jax.nn.silu(a) * b) @ w_out


def rope_tables(positions):
    inv_freq = ROPE_THETA ** (-jnp.arange(0, ROT_DIM, 2, dtype=jnp.float32) / ROT_DIM)
    ang = positions.astype(jnp.float32)[..., None] * inv_freq
    return jnp.cos(ang)[:, :, None, :], jnp.sin(ang)[:, :, None, :]


def partial_rope(t, cos, sin):
    half = ROT_DIM // 2
    t1, t2, rest = t[..., :half], t[..., half:ROT_DIM], t[..., ROT_DIM:]
    return jnp.concatenate([t1 * cos - t2 * sin, t2 * cos + t1 * sin, rest], axis=-1)


def masked_softmax(s, mask):
    s = jnp.where(mask, s.astype(jnp.float32), NEG)
    m = jnp.max(s, axis=-1, keepdims=True)
    p = jnp.where(mask, jnp.exp(s - m), 0.0)
    return p / jnp.maximum(jnp.sum(p, axis=-1, keepdims=True), 1e-30)


def short_conv(v, w):
    return lax.conv_general_dilated(v, w[:, None, :].astype(v.dtype), window_strides=(1,),
                                    padding=[(CONV_WIDTH - 1, 0)],
                                    dimension_numbers=('NWC', 'WIO', 'NWC'),
                                    feature_group_count=v.shape[-1])


def compress(t, pos_emb, w1, b1, w2):
    b, s, g, d = t.shape
    chunks = t.reshape(b, s // CMP_STRIDE, CMP_STRIDE, g, d)
    blocks = jnp.concatenate([chunks[:, :-1], chunks[:, 1:]], axis=2)
    blocks = blocks + pos_emb[None, None, :, None, :]
    flat = jnp.moveaxis(blocks, 3, 2).reshape(b, -1, g, CMP_BLOCK * d)
    return jax.nn.gelu(flat @ w1 + b1) @ w2


def cmp_to_slc_matrix(n_cmp, n_slc):
    i = jnp.arange(n_cmp)[:, None] * CMP_STRIDE
    j = jnp.arange(n_slc)[None, :] * SLC_BLOCK
    ov = jnp.minimum(i + CMP_BLOCK, j + SLC_BLOCK) - jnp.maximum(i, j)
    return jnp.maximum(ov, 0).astype(jnp.float32) / CMP_BLOCK


def nsa_attention(q, q_rot, k_cmp, v_cmp, k_slc, v_slc, k_win, v_win, gates):
    b, s, h, d = q.shape
    n_cmp = k_cmp.shape[1]
    n_slc = s // SLC_BLOCK
    top = min(N_SELECT, n_slc)
    scale = HEAD_DIM ** -0.5
    q_plain_g = q.reshape(b, s, NSA_GROUPS, HEADS_PER_GROUP, d)
    q_rot_g = q_rot.reshape(b, s, NSA_GROUPS, HEADS_PER_GROUP, d)
    kc = jnp.transpose(k_cmp, (0, 2, 1, 3))
    vc = jnp.transpose(v_cmp, (0, 2, 1, 3))
    cmp_end = jnp.arange(n_cmp) * CMP_STRIDE + CMP_BLOCK - 1
    overlap = cmp_to_slc_matrix(n_cmp, n_slc)
    ks_blocks = k_slc.reshape(b, n_slc, SLC_BLOCK, NSA_GROUPS, d).transpose(0, 3, 1, 2, 4)
    vs_blocks = v_slc.reshape(b, n_slc, SLC_BLOCK, NSA_GROUPS, d).transpose(0, 3, 1, 2, 4)
    pad = ((0, 0), (WINDOW, 0), (0, 0), (0, 0))
    kw_pad = jnp.pad(k_win, pad)
    vw_pad = jnp.pad(v_win, pad)
    bi = jnp.arange(b)[:, None, None, None]
    gi = jnp.arange(NSA_GROUPS)[None, :, None, None]
    blk = jnp.arange(n_slc)

    def block(start):
        t = start + jnp.arange(Q_BLOCK)
        qp = lax.dynamic_slice_in_dim(q_plain_g, start, Q_BLOCK, axis=1)
        qr = lax.dynamic_slice_in_dim(q_rot_g, start, Q_BLOCK, axis=1)
        s_c = jnp.einsum('bqghd,bgnd->bghqn', qp, kc) * scale
        p_c = masked_softmax(s_c, cmp_end[None, :] <= t[:, None])
        o_c = jnp.einsum('bghqn,bgnd->bqghd', p_c.astype(vc.dtype), vc)
        imp = jnp.einsum('bghqn,nj->bgqj', p_c, overlap)
        cur = (t // SLC_BLOCK)[:, None]
        forced = (blk == 0) | (blk == cur) | (blk == cur - 1)
        imp = jnp.where(blk > cur, NEG, jnp.where(forced, BIG, imp))
        _, idx = lax.top_k(imp, top)
        ks = ks_blocks[bi, gi, idx].reshape(b, NSA_GROUPS, Q_BLOCK, top * SLC_BLOCK, d)
        vs = vs_blocks[bi, gi, idx].reshape(b, NSA_GROUPS, Q_BLOCK, top * SLC_BLOCK, d)
        kpos = (idx[..., None] * SLC_BLOCK + jnp.arange(SLC_BLOCK)).reshape(b, NSA_GROUPS, Q_BLOCK, top * SLC_BLOCK)
        m_s = kpos <= t[None, None, :, None]
        s_s = jnp.einsum('bqghd,bgqld->bghql', qr, ks) * scale
        p_s = masked_softmax(s_s, m_s[:, :, None])
        o_s = jnp.einsum('bghql,bgqld->bqghd', p_s.astype(vs.dtype), vs)
        kw = lax.dynamic_slice_in_dim(kw_pad, start, WINDOW + Q_BLOCK, axis=1)
        vw = lax.dynamic_slice_in_dim(vw_pad, start, WINDOW + Q_BLOCK, axis=1)
        wpos = start - WINDOW + jnp.arange(WINDOW + Q_BLOCK)
        m_w = (wpos[None, :] >= 0) & (wpos[None, :] <= t[:, None]) & (wpos[None, :] > t[:, None] - WINDOW)
        s_w = jnp.einsum('bqghd,bkgd->bghqk', qr, kw) * scale
        p_w = masked_softmax(s_w, m_w)
        o_w = jnp.einsum('bghqk,bkgd->bqghd', p_w.astype(vw.dtype), vw)
        g = lax.dynamic_slice_in_dim(gates, start, Q_BLOCK, axis=1)
        return g[..., 0:1] * o_c + g[..., 1:2] * o_s + g[..., 2:3] * o_w

    out = lax.map(block, jnp.arange(s // Q_BLOCK) * Q_BLOCK)
    return jnp.moveaxis(out, 0, 1).reshape(b, s, h * d)


def token_mixer(h, mem, cos, sin, mem_g, w_in, conv_w, cmp_pos_k, cmp_pos_v,
                ck_w1, ck_b1, ck_w2, cv_w1, cv_b1, cv_w2,
                w_mem_kv, w_br_conv, w_br_nsa, w_br_mem, w_out):
    b, s, _ = h.shape
    points, acc = [], 0
    for n in SPLIT_SIZES[:-1]:
        acc += n
        points.append(acc)
    u, bg, cg, q, kv, nsa_g, q_mem, merge_g = jnp.split(h @ w_in, points, axis=-1)
    cos = cos.astype(h.dtype)
    sin = sin.astype(h.dtype)
    y_conv = bg * short_conv(cg * u, conv_w)
    q = q.reshape(b, s, NSA_HEADS, HEAD_DIM)
    kv = kv.reshape(b, s, 6, NSA_GROUPS, HEAD_DIM)
    k_cmp = compress(kv[:, :, 0], cmp_pos_k, ck_w1, ck_b1, ck_w2)
    v_cmp = compress(kv[:, :, 1], cmp_pos_v, cv_w1, cv_b1, cv_w2)
    k_slc = partial_rope(kv[:, :, 2], cos, sin)
    k_win = partial_rope(kv[:, :, 4], cos, sin)
    q_rot = partial_rope(q, cos, sin)
    gates = jax.nn.sigmoid(nsa_g).reshape(b, s, NSA_GROUPS, HEADS_PER_GROUP, 3)
    y_nsa = nsa_attention(q, q_rot, k_cmp, v_cmp, k_slc, kv[:, :, 3], k_win, kv[:, :, 5], gates)
    m_len = mem.shape[1]
    mkv = (rms_norm(mem, mem_g) @ w_mem_kv).reshape(b, m_len, 2, MEM_HEADS, MEM_HEAD_DIM)
    q_m = q_mem.reshape(b, s, MEM_HEADS, MEM_HEAD_DIM)
    s_m = jnp.einsum('bshd,bmhd->bhsm', q_m, mkv[:, :, 0]).astype(jnp.float32) * (MEM_HEAD_DIM ** -0.5)
    p_m = jax.nn.softmax(s_m, axis=-1)
    y_mem = jnp.einsum('bhsm,bmhd->bshd', p_m.astype(mkv.dtype), mkv[:, :, 1]).reshape(b, s, MEM_HEADS * MEM_HEAD_DIM)
    g_conv, g_nsa, g_mem = jnp.split(jax.nn.sigmoid(merge_g), 3, axis=-1)
    merged = g_conv * (y_conv @ w_br_conv) + g_nsa * (y_nsa @ w_br_nsa) + g_mem * (y_mem @ w_br_mem)
    return merged @ w_out


def setup_inputs(seed: int = 0) -> dict:
    key = jax.random.key(seed)
    keys = iter(jax.random.split(key, 40))
    L = DEPTH

    def dense(shape, fan_in):
        return jax.random.normal(next(keys), shape, jnp.float32) * fan_in ** -0.5

    def gain(shape):
        return 1.0 + 0.05 * jax.random.normal(next(keys), shape, jnp.float32)

    def small(shape, scale):
        return scale * jax.random.normal(next(keys), shape, jnp.float32)

    x = jax.random.normal(next(keys), (BATCH, SEQ, D_MODEL), jnp.float32)
    mem = jax.random.normal(next(keys), (BATCH, MEM_LEN, D_MODEL), jnp.float32)
    offset = jax.random.randint(next(keys), (BATCH, 1), 0, 4096, dtype=jnp.int32)
    positions = (jnp.arange(SEQ, dtype=jnp.int32)[None, :] + offset).astype(jnp.int32)
    return {
        'x': x,
        'mem': mem,
        'positions': positions,
        'ffn1_norm_pre': gain((L, D_MODEL)),
        'ffn1_norm_post': gain((L, D_MODEL)),
        'ffn1_w_in': dense((L, D_MODEL, 2 * D_FF), D_MODEL),
        'ffn1_w_out': dense((L, D_FF, D_MODEL), D_FF),
        'mix_norm_pre': gain((L, D_MODEL)),
        'mix_norm_post': gain((L, D_MODEL)),
        'mem_norm': gain((L, D_MODEL)),
        'w_mix_in': dense((L, D_MODEL, MIX_IN), D_MODEL),
        'conv_w': dense((L, CONV_WIDTH, CONV_DIM), CONV_WIDTH),
        'cmp_pos_k': small((L, CMP_BLOCK, HEAD_DIM), 0.1),
        'cmp_pos_v': small((L, CMP_BLOCK, HEAD_DIM), 0.1),
        'cmp_k_w1': dense((L, CMP_BLOCK * HEAD_DIM, CMP_HIDDEN), CMP_BLOCK * HEAD_DIM),
        'cmp_k_b1': small((L, CMP_HIDDEN), 0.01),
        'cmp_k_w2': dense((L, CMP_HIDDEN, HEAD_DIM), CMP_HIDDEN),
        'cmp_v_w1': dense((L, CMP_BLOCK * HEAD_DIM, CMP_HIDDEN), CMP_BLOCK * HEAD_DIM),
        'cmp_v_b1': small((L, CMP_HIDDEN), 0.01),
        'cmp_v_w2': dense((L, CMP_HIDDEN, HEAD_DIM), CMP_HIDDEN),
        'w_mem_kv': dense((L, D_MODEL, 2 * MEM_HEADS * MEM_HEAD_DIM), D_MODEL),
        'w_branch_conv': dense((L, CONV_DIM, D_MODEL), CONV_DIM),
        'w_branch_nsa': dense((L, NSA_HEADS * HEAD_DIM, D_MODEL), NSA_HEADS * HEAD_DIM),
        'w_branch_mem': dense((L, MEM_HEADS * MEM_HEAD_DIM, D_MODEL), MEM_HEADS * MEM_HEAD_DIM),
        'w_mix_out': dense((L, D_MODEL, D_MODEL), D_MODEL),
        'ffn2_norm_pre': gain((L, D_MODEL)),
        'ffn2_norm_post': gain((L, D_MODEL)),
        'ffn2_w_in': dense((L, D_MODEL, 2 * D_FF), D_MODEL),
        'ffn2_w_out': dense((L, D_FF, D_MODEL), D_FF),
    }


def reference(x, mem, positions, ffn1_norm_pre, ffn1_norm_post, ffn1_w_in, ffn1_w_out,
              mix_norm_pre, mix_norm_post, mem_norm, w_mix_in, conv_w,
              cmp_pos_k, cmp_pos_v, cmp_k_w1, cmp_k_b1, cmp_k_w2, cmp_v_w1, cmp_v_b1, cmp_v_w2,
              w_mem_kv, w_branch_conv, w_branch_nsa, w_branch_mem, w_mix_out,
              ffn2_norm_pre, ffn2_norm_post, ffn2_w_in, ffn2_w_out):
    cos, sin = rope_tables(positions)
    for l in range(DEPTH):
        h = rms_norm(x, ffn1_norm_pre[l])
        x = x + 0.5 * rms_norm(swiglu(h, ffn1_w_in[l], ffn1_w_out[l]), ffn1_norm_post[l])
        h = rms_norm(x, mix_norm_pre[l])
        y = token_mixer(h, mem, cos, sin, mem_norm[l], w_mix_in[l], conv_w[l],
                        cmp_pos_k[l], cmp_pos_v[l], cmp_k_w1[l], cmp_k_b1[l], cmp_k_w2[l],
                        cmp_v_w1[l], cmp_v_b1[l], cmp_v_w2[l], w_mem_kv[l],
                        w_branch_conv[l], w_branch_nsa[l], w_branch_mem[l], w_mix_out[l])
        x = x + rms_norm(y, mix_norm_post[l])
        h = rms_norm(x, ffn2_norm_pre[l])
        x = x + 0.5 * rms_norm(swiglu(h, ffn2_w_in[l], ffn2_w_out[l]), ffn2_norm_post[l])
    return x
```

```cpp
#include <hip/hip_runtime.h>
#include <hip/hip_cooperative_groups.h>
#include <cstdio>
#include <cstdint>
namespace cg = cooperative_groups;

#define LAS __attribute__((address_space(3)))
typedef unsigned short bf16_t;
typedef short bf16x8 __attribute__((ext_vector_type(8)));
typedef float f32x4 __attribute__((ext_vector_type(4)));
typedef float f32x16 __attribute__((ext_vector_type(16)));
typedef unsigned u32x4 __attribute__((ext_vector_type(4)));
typedef unsigned u32x2 __attribute__((ext_vector_type(2)));

constexpr int NBATCH = 2, S_ = 16384, T_ = NBATCH * S_, DM = 1024, FF = 2816, PP = 3584, GP = 3072, YP = 1536;
constexpr int NWAVES = 8;
constexpr float EPS = 1e-6f;
constexpr int PC_Q = 1536, PC_KV = 2048, PC_QM = 2816, PC_NG = 3328;

constexpr size_t MiB = 1u << 20;
constexpr size_t WS_W1IN = 0, WS_W1OUT = 11 * MiB, WS_WMIX = WS_W1OUT + 11 * MiB / 2, WS_WG = WS_WMIX + 7 * MiB, WS_WBR = WS_WG + 6 * MiB, WS_WOUT = WS_WBR + 3 * MiB,
                 WS_W2IN = WS_WOUT + 2 * MiB, WS_W2OUT = WS_W2IN + 11 * MiB, WS_WC1 = WS_W2OUT + 11 * MiB / 2  , WS_WMKV = WS_WC1 + 2 * MiB,
                 WS_MEMN = WS_WMKV + 2 * MiB, WS_MKV = WS_MEMN + 1 * MiB, WS_CB = WS_MKV + 1 * MiB  , WS_CBP = WS_CB + 8192  , WS_BAR = WS_CB + 8192 + 131072  ;
static_assert(WS_CB == 57 * MiB, "ws map");
constexpr size_t WS_ROPE = 58 * MiB, WS_MEMK = 60 * MiB, WS_MEMV = WS_MEMK + MiB / 2, WS_KCMP = 61 * MiB, WS_VCMP = WS_KCMP + MiB / 2, WS_CMPH = 62 * MiB,
                 WS_KSLC = 66 * MiB, WS_VSLC = 74 * MiB, WS_KWIN = 82 * MiB, WS_VWIN = 90 * MiB, WS_H = 98 * MiB, WS_Y = 162 * MiB, WS_R1 = 258 * MiB, WS_END = 483 * MiB;

typedef float f32x2_t __attribute__((ext_vector_type(2)));
typedef __bf16 bf16x2_t __attribute__((ext_vector_type(2)));
__device__ __forceinline__ unsigned cvt_pk_bf16(float lo, float hi) { f32x2_t v = {lo, hi}; bf16x2_t b = __builtin_convertvector(v, bf16x2_t); return __builtin_bit_cast(unsigned, b); }
__device__ __forceinline__ float bf_lo(unsigned u) { return __uint_as_float(u << 16); }
__device__ __forceinline__ float bf_hi(unsigned u) { return __uint_as_float(u & 0xffff0000u); }
__device__ __forceinline__ float bf1(bf16_t u) { return __uint_as_float(((unsigned)u) << 16); }
__device__ __forceinline__ float ex2(float x) { return __builtin_amdgcn_exp2f(x); }
__device__ __forceinline__ float rcpf_(float x) { return __builtin_amdgcn_rcpf(x); }
__device__ __forceinline__ float sigm(float x) { return rcpf_(1.f + ex2(-1.44269504f * x)); }
__device__ __forceinline__ float gelu_tanh(float x) { const float u = 0.7978845608f * (x + 0.044715f * x * x * x); return x * rcpf_(1.f + ex2(-2.88539008f * u)); }
__device__ __forceinline__ float wave_sum(float v) {
#pragma unroll
    for (int o = 1; o < 64; o <<= 1) v += __shfl_xor(v, o);
    return v;
}
__device__ __forceinline__ int pi32(int r) { return (r & 0x13) | ((r & 4) << 1) | ((r & 8) >> 1); }
#define LDS_WAIT() asm volatile("s_waitcnt lgkmcnt(0)" ::: "memory")

namespace pg8 {
constexpr int BM = 256, BK = 64, HALF = 128, HTB = HALF * BK * 2, STAGE_BYTES = 8 * HTB, NXCD = 8, WGM = 8;
__device__ __forceinline__ int lds_byte(int r, int c) { const int st = (r >> 4) * 2 + (c >> 5), rr = r & 15, cc = c & 31, ob = rr * 64 + cc * 2; return st * 1024 + (ob ^ (((ob >> 9) & 1) << 5)); }
__device__ __forceinline__ void stage_rc(int b, int& R, int& C) { const int st = b / 1024, sb = b % 1024, swz = sb ^ (((sb >> 9) & 1) << 5); R = (st >> 1) * 16 + swz / 64; C = (st & 1) * 32 + (swz % 64) / 2; }
__device__ __forceinline__ int perm32(int rho) { const int n = rho >> 4, i = rho & 15; return 8 * (i >> 2) + 4 * n + (i & 3); }

struct Unit { int pm, pn, tag; long long aoff, boff; };
struct GemmDesc { const char* A; const char* Bt; int lda, ldb, kstepA, kstepB, nt; };

__device__ __forceinline__ void swz_tile(int L, int nM, int nN, int& pm, int& pn) {
    const int nwg = nM * nN; int wgid = L;
    { const int q = nwg / NXCD, r = nwg % NXCD, xcd = wgid % NXCD, off = wgid / NXCD; wgid = (xcd < r ? xcd * (q + 1) : r * (q + 1) + (xcd - r) * q) + off; }
    const int nig = WGM * nN, gid = wgid / nig, fm = gid * WGM, gsz = (nM - fm) < WGM ? (nM - fm) : WGM;
    pm = fm + ((wgid % nig) % gsz); pn = (wgid % nig) / gsz;
}
struct StdOrder {
    int nM, nN, G, c; long long tA, tB;
    __device__ void init(int M, int N, int G_, int c_, int lda, int ldb) { nM = M / BM; nN = N / BM; G = G_; c = c_; tA = 512LL * lda; tB = 512LL * ldb; }
    __device__ bool next(int i, Unit& u) const {
        const long long L = (long long)i * G + c; if (L >= (long long)nM * nN) return false;
        swz_tile((int)L, nM, nN, u.pm, u.pn); u.tag = 0; u.aoff = u.pm * tA; u.boff = u.pn * tB; return true;
    }
};
struct MergeOrder {
    int nM, nN, G, c; long long tA, tB;
    __device__ void init(int M, int N, int G_, int c_, int lda, int ldb) { nM = M / BM; nN = N / BM; G = G_; c = c_; tA = 512LL * lda; tB = 512LL * ldb; }
    __device__ bool next(int i, Unit& u) const {
        const int ti = i / 3, br = i - 3 * ti; const long long L = (long long)ti * G + c; if (L >= (long long)nM * nN) return false;
        swz_tile((int)L, nM, nN, u.pm, u.pn); u.tag = br; u.aoff = u.pm * tA + br * 1024; u.boff = u.pn * tB + br * 1024; return true;
    }
};
struct CmpOrder {
    int c;
    __device__ bool next(int i, Unit& u) const {
        if (i != 0 || c >= 32) return false;
        const int kv = c >> 4, bg = (c >> 2) & 3, tile = c & 3, b = bg >> 1, g = bg & 1;
        u.pm = c; u.pn = 0; u.tag = kv;
        u.aoff = 2LL * (((long long)b * S_ + 4096LL * tile) * PP + PC_KV + kv * 128 + g * 64);
        u.boff = (long long)kv * (256 * 2048 * 2); return true;
    }
};

__device__ __forceinline__ u32x4 pack8(f32x4 a, f32x4 b) { u32x4 w; w.x = cvt_pk_bf16(a[0], a[1]); w.y = cvt_pk_bf16(a[2], a[3]); w.z = cvt_pk_bf16(b[0], b[1]); w.w = cvt_pk_bf16(b[2], b[3]); return w; }
template <int MODE> struct Epi {
    bf16_t* O; int ldc; const bf16_t* G; const float* bias;
    __device__ __forceinline__ void operator()(const f32x4 (&acc)[2][2][4][2], const Unit& u, int wr, int wc, int fr, int fq) const {
        const int row0 = u.pm * BM + wr * 64 + fr;
        if constexpr (MODE == 1) {
            const int col0 = u.pn * 128 + wc * 32 + 8 * fq;
#pragma unroll
            for (int ai = 0; ai < 2; ++ai)
#pragma unroll
                for (int m = 0; m < 4; ++m) {
                    bf16_t* rowp = O + (size_t)(row0 + ai * HALF + m * 16) * ldc + col0;
                    f32x4 v0, v1;
#pragma unroll
                    for (int e = 0; e < 4; ++e) { const float a0 = acc[ai][0][m][0][e], a1 = acc[ai][0][m][1][e]; v0[e] = a0 * sigm(a0) * acc[ai][1][m][0][e]; v1[e] = a1 * sigm(a1) * acc[ai][1][m][1][e]; }
                    *(u32x4*)rowp = pack8(v0, v1);
                    __builtin_amdgcn_sched_barrier(0);
                }
        } else {
            const int col0 = u.pn * BM + wc * 32 + 8 * fq;
#pragma unroll
            for (int ai = 0; ai < 2; ++ai)
#pragma unroll
                for (int m = 0; m < 4; ++m) {
                    const size_t row = (size_t)(row0 + ai * HALF + m * 16);
#pragma unroll
                    for (int bj = 0; bj < 2; ++bj) {
                        const int col = col0 + bj * HALF;
                        f32x4 v0 = acc[ai][bj][m][0], v1 = acc[ai][bj][m][1];
                        bf16_t* dst = O + row * ldc + col;
                        if constexpr (MODE == 2) {
#pragma unroll
                            for (int e = 0; e < 4; ++e) { v0[e] = sigm(v0[e]); v1[e] = sigm(v1[e]); }
                        }
                        if constexpr (MODE == 4) {
                            const f32x4 b0 = *(const f32x4*)(bias + u.tag * 256 + col), b1 = *(const f32x4*)(bias + u.tag * 256 + col + 4);
#pragma unroll
                            for (int e = 0; e < 4; ++e) { v0[e] = gelu_tanh(v0[e] + b0[e]); v1[e] = gelu_tanh(v1[e] + b1[e]); }
                        }
                        if constexpr (MODE == 3) {
                            const u32x4 gv = *(const u32x4*)(G + row * GP + u.tag * 1024 + col);
                            v0[0] *= bf_lo(gv.x); v0[1] *= bf_hi(gv.x); v0[2] *= bf_lo(gv.y); v0[3] *= bf_hi(gv.y);
                            v1[0] *= bf_lo(gv.z); v1[1] *= bf_hi(gv.z); v1[2] *= bf_lo(gv.w); v1[3] *= bf_hi(gv.w);
                            if (u.tag > 0) {
                                const u32x4 ov = *(const u32x4*)dst;
                                v0[0] += bf_lo(ov.x); v0[1] += bf_hi(ov.x); v0[2] += bf_lo(ov.y); v0[3] += bf_hi(ov.y);
                                v1[0] += bf_lo(ov.z); v1[1] += bf_hi(ov.z); v1[2] += bf_lo(ov.w); v1[3] += bf_hi(ov.w);
                            }
                        }
                        *(u32x4*)dst = pack8(v0, v1);
                    }
                }
        }
    }
};

template <class EpiT, class Sched>
__device__ __forceinline__ void gemm_phase(LAS unsigned char* lds, int tid_in, const GemmDesc g, const Sched& S, const EpiT& E) {
    int tid_ = tid_in; asm volatile("" : "+v"(tid_));
    const int tid = tid_, wid = __builtin_amdgcn_readfirstlane(tid >> 6), lane = tid & 63, wr = wid >> 2, wc = wid & 3, fr = lane & 15, fq = lane >> 4;
    const int nt = g.nt;
    unsigned voffA[2], voffB[2];
#pragma unroll
    for (int i = 0; i < 2; ++i) { int R, C; stage_rc(tid * 16 + i * 8192, R, C); const int Rb = (R & ~31) + perm32(R & 31);
        voffA[i] = (unsigned)(R * g.lda + C) * 2u; voffB[i] = (unsigned)(Rb * g.ldb + C) * 2u; }
    const size_t kA = (size_t)g.kstepA, kB = (size_t)g.kstepB;
    const size_t hA = (size_t)HALF * g.lda * 2, hB = (size_t)HALF * g.ldb * 2;
    const unsigned ldsw = (unsigned)wid * 1024u;
    const int aoff = lds_byte(wr * 64 + fr, fq * 8), boff = lds_byte(wc * 32 + fr, fq * 8);
#define PG8_SA(b, h) (((b) * 2 + (h)) * HTB)
#define PG8_SB(b, h) ((4 + (b) * 2 + (h)) * HTB)
#define PG8_STAGE(bufoff, gbase, voff) do { _Pragma("unroll") for (int _i = 0; _i < 2; ++_i) \
        __builtin_amdgcn_global_load_lds((const unsigned*)((const char*)(gbase) + (voff)[_i]), (LAS unsigned*)(lds + (bufoff) + ldsw + _i * 8192), 16, 0, 0); } while (0)
#define PG8_LDA(dst, b, h) do { _Pragma("unroll") for (int m = 0; m < 4; ++m) _Pragma("unroll") for (int k = 0; k < 2; ++k) dst[m][k] = *(const LAS bf16x8*)(lds + PG8_SA(b, h) + aoff + m * 2048 + k * 1024); } while (0)
#define PG8_LDB(dst, b, h) do { _Pragma("unroll") for (int n = 0; n < 2; ++n) _Pragma("unroll") for (int k = 0; k < 2; ++k) dst[n][k] = *(const LAS bf16x8*)(lds + PG8_SB(b, h) + boff + n * 2048 + k * 1024); } while (0)
#define PG8_MMA(ai, bj, At, Bt) do { __builtin_amdgcn_s_setprio(1); _Pragma("unroll") for (int m = 0; m < 4; ++m) _Pragma("unroll") for (int n = 0; n < 2; ++n) _Pragma("unroll") for (int k = 0; k < 2; ++k) \
        acc[ai][bj][m][n] = __builtin_amdgcn_mfma_f32_16x16x32_bf16(Bt[n][k], At[m][k], acc[ai][bj][m][n], 0, 0, 0); __builtin_amdgcn_s_setprio(0); } while (0)
#define PG8_WAIT_V(n) asm volatile("s_waitcnt vmcnt(" #n ")" ::: "memory")
#define PG8_WAIT_L(n) asm volatile("s_waitcnt lgkmcnt(" #n ")" ::: "memory")
#define PG8_BAR __builtin_amdgcn_s_barrier()
#define PG8_SCHED __builtin_amdgcn_sched_barrier(0)
    Unit cur, nxt; int ui = 0;
    if (!S.next(0, cur)) return;
    f32x4 acc[2][2][4][2];
#pragma unroll
    for (int a = 0; a < 2; ++a)
#pragma unroll
        for (int b = 0; b < 2; ++b)
#pragma unroll
            for (int m = 0; m < 4; ++m)
#pragma unroll
                for (int n = 0; n < 2; ++n) acc[a][b][m][n] = (f32x4){0.f, 0.f, 0.f, 0.f};
    bf16x8 At[4][2], B0[2][2], B1[2][2];
    const char* cA = g.A + cur.aoff; const char* cB = g.Bt + cur.boff;
    PG8_STAGE(PG8_SB(0, 0), cB, voffB); PG8_STAGE(PG8_SB(0, 1), cB + hB, voffB); PG8_STAGE(PG8_SA(0, 0), cA, voffA); PG8_STAGE(PG8_SA(0, 1), cA + hA, voffA);
    if (wr == 1) PG8_BAR;
    PG8_WAIT_V(2); PG8_BAR;
    PG8_STAGE(PG8_SB(1, 0), cB + kB, voffB); PG8_STAGE(PG8_SA(1, 0), cA + kA, voffA); PG8_STAGE(PG8_SB(1, 1), cB + hB + kB, voffB);
    PG8_WAIT_V(6); PG8_BAR;
    for (;;) {
        const bool has_next = S.next(ui + 1, nxt);
        const char* nA = has_next ? g.A + nxt.aoff : cA; const char* nB = has_next ? g.Bt + nxt.boff : cB;
        for (int t = 0; t < nt; t += 2) {
            const bool last = (t == nt - 2);
            const char* a1 = cA + (size_t)(t + 1) * kA;
            const char* a2 = last ? nA : cA + (size_t)(t + 2) * kA; const char* b2 = last ? nB : cB + (size_t)(t + 2) * kB;
            const char* a3 = a2 + kA; const char* b3 = b2 + kB;
            PG8_LDB(B0, 0, 0); PG8_LDB(B1, 0, 1); PG8_SCHED; PG8_LDA(At, 0, 0); PG8_STAGE(PG8_SA(1, 1), a1 + hA, voffA);
            PG8_WAIT_V(8); PG8_WAIT_L(0); PG8_BAR; PG8_MMA(0, 0, At, B0); PG8_MMA(0, 1, At, B1); PG8_BAR; PG8_SCHED;
            PG8_LDA(At, 0, 1); PG8_STAGE(PG8_SB(0, 0), b2, voffB); PG8_STAGE(PG8_SB(0, 1), b2 + hB, voffB); PG8_STAGE(PG8_SA(0, 0), a2, voffA);
            PG8_WAIT_V(8); PG8_WAIT_L(0); PG8_BAR; PG8_MMA(1, 0, At, B0); PG8_MMA(1, 1, At, B1); PG8_BAR; PG8_SCHED;
            PG8_LDB(B0, 1, 0); PG8_LDB(B1, 1, 1); PG8_SCHED; PG8_LDA(At, 1, 0); PG8_STAGE(PG8_SA(0, 1), a2 + hA, voffA);
            PG8_WAIT_V(8); PG8_WAIT_L(0); PG8_BAR; PG8_MMA(0, 0, At, B0); PG8_MMA(0, 1, At, B1); PG8_BAR; PG8_SCHED;
            PG8_LDA(At, 1, 1); PG8_STAGE(PG8_SB(1, 0), b3, voffB); PG8_STAGE(PG8_SB(1, 1), b3 + hB, voffB); PG8_STAGE(PG8_SA(1, 0), a3, voffA);
            PG8_WAIT_V(8); PG8_WAIT_L(0); PG8_BAR; PG8_MMA(1, 0, At, B0); PG8_MMA(1, 1, At, B1); PG8_BAR; PG8_SCHED;
        }
        if (wr == 0) PG8_BAR;
        E(acc, cur, wr, wc, fr, fq);
        if (!has_next) break;
#pragma unroll
        for (int a = 0; a < 2; ++a)
#pragma unroll
            for (int b = 0; b < 2; ++b)
#pragma unroll
                for (int m = 0; m < 4; ++m)
#pragma unroll
                    for (int n = 0; n < 2; ++n) acc[a][b][m][n] = (f32x4){0.f, 0.f, 0.f, 0.f};
        cur = nxt; cA = nA; cB = nB; ++ui;
        if (wr == 1) PG8_BAR;
    }
    PG8_WAIT_V(0);
    PG8_BAR;
#undef PG8_SA
#undef PG8_SB
#undef PG8_STAGE
#undef PG8_LDA
#undef PG8_LDB
#undef PG8_MMA
#undef PG8_WAIT_V
#undef PG8_WAIT_L
#undef PG8_BAR
#undef PG8_SCHED
}
}

struct Args { const void* in[29]; float* out; unsigned char* ws; int ph_lo, ph_hi; };
static_assert(sizeof(Args) == 29 * 8 + 8 + 8 + 8, "Args has no padding");

typedef __attribute__((address_space(1))) unsigned char gu8;
struct Ctx {
    const Args* a; gu8* ws; LAS unsigned char* lds; int tid, lane, wave, G, gw, NGW;
};
#define INF(k, l, n) ((const float*)C.a->in[k] + (size_t)(l) * (n))

__device__ __forceinline__ void tr_item(const float* W, int ldw, int src_col, int nvalid, int k0, bf16_t* WT, int ldt, int dst_row, int dst_k, LAS float* scr, int lane) {
#pragma unroll 8
    for (int i = 0; i < 32; ++i) { const int kk = 2 * i + (lane >> 5), c = lane & 31; scr[kk * 33 + c] = (c < nvalid) ? W[(size_t)(k0 + kk) * ldw + src_col + c] : 0.f; }
    LDS_WAIT();
    const int c = lane & 7;
#pragma unroll
    for (int j = 0; j < 4; ++j) { const int n = (lane >> 3) + 8 * j; const LAS float* s = scr + (8 * c) * 33 + n;
        u32x4 o; o.x = cvt_pk_bf16(s[0 * 33], s[1 * 33]); o.y = cvt_pk_bf16(s[2 * 33], s[3 * 33]); o.z = cvt_pk_bf16(s[4 * 33], s[5 * 33]); o.w = cvt_pk_bf16(s[6 * 33], s[7 * 33]);
        *(u32x4*)(WT + (size_t)(dst_row + n) * ldt + dst_k + k0 + 8 * c) = o; }
    LDS_WAIT();
}

__device__ __forceinline__ void convert_layer(const Ctx& C, int l) {
    LAS float* scr = (LAS float*)(C.lds + C.wave * 8448);
    gu8* ws = C.ws; const int lane = C.lane;
    constexpr int NITEMS = 2816 + 1408 + 1792 + 1536 + 768 + 512 + 2816 + 1408 + 256 + 256 + 512;
    for (int it = C.gw; it < NITEMS; it += C.NGW) {
        int r = it;
        if (r < 2816) { const int kb = r / 176, nb = r % 176, tile = nb >> 3, w = nb & 7, src = (w >> 2) * FF + tile * 128 + (w & 3) * 32;
            tr_item(INF(5, l, DM * 2 * FF), 2 * FF, src, 32, kb * 64, (bf16_t*)(ws + WS_W1IN), DM, nb * 32, 0, scr, lane); continue; } r -= 2816;
        if (r < 1408) { const int kb = r / 32, nb = r % 32;
            tr_item(INF(6, l, FF * DM), DM, nb * 32, 32, kb * 64, (bf16_t*)(ws + WS_W1OUT), FF, nb * 32, 0, scr, lane); continue; } r -= 1408;
        if (r < 1792) { const int kb = r / 112, nb = r % 112; int src = 0, nv = 0;
            if (nb < 88) { src = nb * 32; nv = 32; } else if (nb < 104) { src = 2840 + (nb - 88) * 32; nv = 32; } else if (nb == 104) { src = 2816; nv = 24; }
            tr_item(INF(10, l, DM * 6424), 6424, src, nv, kb * 64, (bf16_t*)(ws + WS_WMIX), DM, nb * 32, 0, scr, lane); continue; } r -= 1792;
        if (r < 1536) { const int kb = r / 96, nb = r % 96;
            tr_item(INF(10, l, DM * 6424), 6424, 3352 + nb * 32, 32, kb * 64, (bf16_t*)(ws + WS_WG), DM, nb * 32, 0, scr, lane); continue; } r -= 1536;
        if (r < 768) { const int br = r / 256, q = r % 256, kb = q / 32, nb = q % 32;
            const float* W = br == 0 ? INF(21, l, 512 * DM) : (br == 1 ? INF(22, l, 512 * DM) : INF(23, l, 512 * DM));
            tr_item(W, DM, nb * 32, 32, kb * 64, (bf16_t*)(ws + WS_WBR), YP, nb * 32, br * 512, scr, lane); continue; } r -= 768;
        if (r < 512) { const int kb = r / 32, nb = r % 32;
            tr_item(INF(24, l, DM * DM), DM, nb * 32, 32, kb * 64, (bf16_t*)(ws + WS_WOUT), DM, nb * 32, 0, scr, lane); continue; } r -= 512;
        if (r < 2816) { const int kb = r / 176, nb = r % 176, tile = nb >> 3, w = nb & 7, src = (w >> 2) * FF + tile * 128 + (w & 3) * 32;
            tr_item(INF(27, l, DM * 2 * FF), 2 * FF, src, 32, kb * 64, (bf16_t*)(ws + WS_W2IN), DM, nb * 32, 0, scr, lane); continue; } r -= 2816;
        if (r < 1408) { const int kb = r / 32, nb = r % 32;
            tr_item(INF(28, l, FF * DM), DM, nb * 32, 32, kb * 64, (bf16_t*)(ws + WS_W2OUT), FF, nb * 32, 0, scr, lane); continue; } r -= 1408;
        if (r < 256) { const int kb = r / 8, nb = r % 8;
            tr_item(INF(14, l, 2048 * 256), 256, nb * 32, 32, kb * 64, (bf16_t*)(ws + WS_WC1), 2048, nb * 32, 0, scr, lane); continue; } r -= 256;
        if (r < 256) { const int kb = r / 8, nb = r % 8;
            tr_item(INF(17, l, 2048 * 256), 256, nb * 32, 32, kb * 64, (bf16_t*)(ws + WS_WC1 + MiB), 2048, nb * 32, 0, scr, lane); continue; } r -= 256;
        { const int kb = r / 32, nb = r % 32;
            tr_item(INF(20, l, DM * DM), DM, nb * 32, 32, kb * 64, (bf16_t*)(ws + WS_WMKV), DM, nb * 32, 0, scr, lane); }
    }
    {
        const float* gm = INF(9, l, DM);
        for (int m = C.gw; m < 512; m += C.NGW) {
            const f32x4* xr = (const f32x4*)((const float*)C.a->in[1] + (size_t)m * DM) + lane;
            f32x4 v[4]; float s = 0.f;
#pragma unroll
            for (int j = 0; j < 4; ++j) { v[j] = xr[64 * j]; s += (v[j].x * v[j].x + v[j].y * v[j].y) + (v[j].z * v[j].z + v[j].w * v[j].w); }
            const float rstd = rsqrtf(wave_sum(s) * (1.f / DM) + EPS);
            u32x2* o = (u32x2*)((bf16_t*)(ws + WS_MEMN) + (size_t)m * DM) + lane;
#pragma unroll
            for (int j = 0; j < 4; ++j) { const f32x4 gg = ((const f32x4*)gm)[lane + 64 * j]; u32x2 w; w.x = cvt_pk_bf16(v[j].x * rstd * gg.x, v[j].y * rstd * gg.y); w.y = cvt_pk_bf16(v[j].z * rstd * gg.z, v[j].w * rstd * gg.w); o[64 * j] = w; }
        }
    }
    {
        float* cb = (float*)(ws + WS_CBP) + (size_t)l * 64 * 256;
        for (int it = C.gw; it < 64; it += C.NGW) {
            const int kv = it >> 5, ch = it & 31;
            const float* pos = kv ? INF(13, l, 2048) : INF(12, l, 2048);
            const float* w1 = kv ? INF(17, l, 2048 * 256) : INF(14, l, 2048 * 256);
            float p[4] = {0.f, 0.f, 0.f, 0.f};
            for (int k = ch * 64; k < ch * 64 + 64; ++k) { const float pv = pos[k];
#pragma unroll
                for (int q = 0; q < 4; ++q) p[q] += pv * w1[(size_t)k * 256 + lane + 64 * q]; }
#pragma unroll
            for (int q = 0; q < 4; ++q) cb[(size_t)it * 256 + lane + 64 * q] = p[q];
        }
    }
}

__device__ __forceinline__ void rope_table(const Ctx& C) {
    const int* pos = (const int*)C.a->in[2];
    float* tab = (float*)(C.ws + WS_ROPE);
    const float invf[8] = {1.0f, 0.1939227432012558f, 0.03760603070259094f, 0.007292664609849453f, 0.0014142135623842478f, 0.00027424818836152554f, 5.318296098266728e-05f, 1.0313386155758053e-05f};
    for (int e = C.gw * 64 + C.lane; e < T_ * 8; e += C.NGW * 64) {
        const int tok = e >> 3, i = e & 7;
        float f = invf[0];
#pragma unroll
        for (int q = 1; q < 8; ++q) f = (i == q) ? invf[q] : f;
        const float ang = (float)pos[tok] * f;
        const double rev = (double)ang * 0.15915494309189535; const float fr = (float)(rev - floor(rev));
        tab[(size_t)tok * 16 + i] = __builtin_amdgcn_cosf(fr); tab[(size_t)tok * 16 + 8 + i] = __builtin_amdgcn_sinf(fr);
    }
}
__device__ __forceinline__ void prenorm_rows(const Ctx& C, const float* x, const float* g, bf16_t* h) {
    constexpr int NR = 4;
    for (int m0 = C.gw; m0 < T_; m0 += NR * C.NGW) {
        f32x4 v[NR][4];
#pragma unroll
        for (int r = 0; r < NR; ++r) { const int m = (m0 + r * C.NGW < T_) ? m0 + r * C.NGW : m0; const f32x4* xr = (const f32x4*)(x + (size_t)m * DM) + C.lane;
#pragma unroll
            for (int j = 0; j < 4; ++j) v[r][j] = xr[64 * j]; }
#pragma unroll
        for (int r = 0; r < NR; ++r) {
            const int m = m0 + r * C.NGW; if (m >= T_) break;
            float s = 0.f;
#pragma unroll
            for (int j = 0; j < 4; ++j) s += (v[r][j].x * v[r][j].x + v[r][j].y * v[r][j].y) + (v[r][j].z * v[r][j].z + v[r][j].w * v[r][j].w);
            const float rstd = rsqrtf(wave_sum(s) * (1.f / DM) + EPS);
            u32x2* o = (u32x2*)(h + (size_t)m * DM) + C.lane;
#pragma unroll
            for (int j = 0; j < 4; ++j) { const f32x4 gg = ((const f32x4*)g)[C.lane + 64 * j]; u32x2 w; w.x = cvt_pk_bf16(v[r][j].x * rstd * gg.x, v[r][j].y * rstd * gg.y); w.y = cvt_pk_bf16(v[r][j].z * rstd * gg.z, v[r][j].w * rstd * gg.w); o[64 * j] = w; }
        }
    }
}
__device__ __forceinline__ void norm_phase(const Ctx& C, int w0, int nw, const float* xin, float* xout, const bf16_t* y, bf16_t* h, const float* gpost, const float* gpre, float coef) {
    for (int m0 = w0; m0 < T_; m0 += 2 * nw) {
        f32x4 xv[2][4]; u32x2 yw[2][4];
#pragma unroll
        for (int r = 0; r < 2; ++r) { const int m = (m0 + r * nw < T_) ? m0 + r * nw : m0; const f32x4* xr = (const f32x4*)(xin + (size_t)m * DM) + C.lane; const u32x2* yr = (const u32x2*)(y + (size_t)m * DM) + C.lane;
#pragma unroll
            for (int j = 0; j < 4; ++j) { xv[r][j] = xr[64 * j]; yw[r][j] = yr[64 * j]; } }
#pragma unroll
        for (int r = 0; r < 2; ++r) {
            const int m = m0 + r * nw; if (m >= T_) break;
            f32x4 yv[4]; float s = 0.f;
#pragma unroll
            for (int j = 0; j < 4; ++j) { const u32x2 w = yw[r][j]; yv[j] = (f32x4){bf_lo(w.x), bf_hi(w.x), bf_lo(w.y), bf_hi(w.y)};
                s += (yv[j].x * yv[j].x + yv[j].y * yv[j].y) + (yv[j].z * yv[j].z + yv[j].w * yv[j].w); }
            const float rs = rsqrtf(wave_sum(s) * (1.f / DM) + EPS) * coef; float s2 = 0.f;
            f32x4* xo = (f32x4*)(xout + (size_t)m * DM) + C.lane;
#pragma unroll
            for (int j = 0; j < 4; ++j) { const f32x4 gg = ((const f32x4*)gpost)[C.lane + 64 * j]; xv[r][j] = xv[r][j] + yv[j] * gg * rs; xo[64 * j] = xv[r][j];
                s2 += (xv[r][j].x * xv[r][j].x + xv[r][j].y * xv[r][j].y) + (xv[r][j].z * xv[r][j].z + xv[r][j].w * xv[r][j].w); }
            if (gpre) {
                const float r2 = rsqrtf(wave_sum(s2) * (1.f / DM) + EPS);
                u32x2* o = (u32x2*)(h + (size_t)m * DM) + C.lane;
#pragma unroll
                for (int j = 0; j < 4; ++j) { const f32x4 gg = ((const f32x4*)gpre)[C.lane + 64 * j]; u32x2 w; w.x = cvt_pk_bf16(xv[r][j].x * r2 * gg.x, xv[r][j].y * r2 * gg.y); w.y = cvt_pk_bf16(xv[r][j].z * r2 * gg.z, xv[r][j].w * r2 * gg.w); o[64 * j] = w; }
            }
        }
    }
}
__device__ __forceinline__ void cb_reduce(const Ctx& C, int l) {
    const int e = C.gw * 64 + C.lane;
    if (e < 512) { const int kv = e >> 8, n = e & 255; const float* pp = (const float*)(C.ws + WS_CBP) + (size_t)l * 64 * 256 + (size_t)kv * 32 * 256 + n;
        float s = (kv ? INF(18, l, 256) : INF(15, l, 256))[n];
        for (int ch = 0; ch < 32; ++ch) s += pp[ch * 256];
        ((float*)(C.ws + WS_CB))[l * 512 + e] = s; }
}
__device__ __forceinline__ void memkv_ops(const Ctx& C, int w0, int nw) {
    const bf16_t* src = (const bf16_t*)(C.ws + WS_MKV); bf16_t* ko = (bf16_t*)(C.ws + WS_MEMK); bf16_t* vo = (bf16_t*)(C.ws + WS_MEMV);
    for (int e = w0 * 64 + C.lane; e < 512 * 1024; e += nw * 64) {
        const int mr = e >> 10, col = e & 1023, kv = col >> 9, hm = (col >> 7) & 3, d = col & 127, b = mr >> 8, m = mr & 255;
        const bf16_t v = src[e];
        if (kv == 0) ko[((size_t)((((b * 4 + hm) * 8 + (m >> 5)) * 8 + (d >> 4)) * 64 + pi32(m & 31) + 32 * ((d >> 3) & 1))) * 8 + (d & 7)] = v;
        else vo[((size_t)((((b * 4 + hm) * 16 + (m >> 4)) * 4 + (d >> 5)) * 64 + (d & 31) + 32 * ((m >> 3) & 1))) * 8 + (m & 7)] = v;
    }
}

__device__ __forceinline__ void prep_items(const Ctx& C, int l, int w0, int nw) {
    const bf16_t* P = (const bf16_t*)(C.ws + WS_R1); bf16_t* Y = (bf16_t*)(C.ws + WS_Y);
    const int lane = C.lane;
    {
        const float* cw = INF(11, l, 3 * 512);
        float w[3][8];
#pragma unroll
        for (int k = 0; k < 3; ++k)
#pragma unroll
            for (int e = 0; e < 8; ++e) w[k][e] = cw[k * 512 + lane * 8 + e];
        for (int it = w0; it < T_ / 8; it += nw) {
            const int tok0 = it * 8, s0 = tok0 & (S_ - 1);
            float c1[8], c2[8];
#pragma unroll
            for (int e = 0; e < 8; ++e) { c1[e] = 0.f; c2[e] = 0.f; }
            if (s0 > 0) {
#pragma unroll
                for (int back = 2; back >= 1; --back) {
                    const bf16_t* row = P + (size_t)(tok0 - back) * PP + lane * 8;
                    const u32x4 u = *(const u32x4*)row, cc = *(const u32x4*)(row + 1024);
                    float t[8] = {bf_lo(u.x) * bf_lo(cc.x), bf_hi(u.x) * bf_hi(cc.x), bf_lo(u.y) * bf_lo(cc.y), bf_hi(u.y) * bf_hi(cc.y), bf_lo(u.z) * bf_lo(cc.z), bf_hi(u.z) * bf_hi(cc.z), bf_lo(u.w) * bf_lo(cc.w), bf_hi(u.w) * bf_hi(cc.w)};
#pragma unroll
                    for (int e = 0; e < 8; ++e) { if (back == 2) c2[e] = t[e]; else c1[e] = t[e]; }
                }
            }
#pragma unroll
            for (int tt = 0; tt < 8; ++tt) {
                const bf16_t* row = P + (size_t)(tok0 + tt) * PP + lane * 8;
                const u32x4 u = *(const u32x4*)row, bb = *(const u32x4*)(row + 512), cc = *(const u32x4*)(row + 1024);
                const float c0[8] = {bf_lo(u.x) * bf_lo(cc.x), bf_hi(u.x) * bf_hi(cc.x), bf_lo(u.y) * bf_lo(cc.y), bf_hi(u.y) * bf_hi(cc.y), bf_lo(u.z) * bf_lo(cc.z), bf_hi(u.z) * bf_hi(cc.z), bf_lo(u.w) * bf_lo(cc.w), bf_hi(u.w) * bf_hi(cc.w)};
                const float bv[8] = {bf_lo(bb.x), bf_hi(bb.x), bf_lo(bb.y), bf_hi(bb.y), bf_lo(bb.z), bf_hi(bb.z), bf_lo(bb.w), bf_hi(bb.w)};
                float o[8];
#pragma unroll
                for (int e = 0; e < 8; ++e) { o[e] = bv[e] * (w[0][e] * c2[e] + w[1][e] * c1[e] + w[2][e] * c0[e]); c2[e] = c1[e]; c1[e] = c0[e]; }
                u32x4 ov; ov.x = cvt_pk_bf16(o[0], o[1]); ov.y = cvt_pk_bf16(o[2], o[3]); ov.z = cvt_pk_bf16(o[4], o[5]); ov.w = cvt_pk_bf16(o[6], o[7]);
                *(u32x4*)(Y + (size_t)(tok0 + tt) * YP + lane * 8) = ov;
            }
        }
    }
    {
        const float* rope = (const float*)(C.ws + WS_ROPE);
        LAS bf16_t* vt = (LAS bf16_t*)(C.lds + C.wave * 4608);
        const int hi = lane >> 5, dl = lane & 31;
        for (int it = w0; it < 4 * 512; it += nw) {
            const int bg = it >> 9, tile = it & 511, b = bg >> 1, g = bg & 1;
            const size_t tokb = (size_t)b * S_ + 32 * tile;
#pragma unroll
            for (int which = 0; which < 2; ++which) {
                const int kc = PC_KV + (2 + 2 * which) * 128 + g * 64, vc = kc + 128;
                bf16_t* kop = (bf16_t*)(C.ws + (which ? WS_KWIN : WS_KSLC)); bf16_t* vop = (bf16_t*)(C.ws + (which ? WS_VWIN : WS_VSLC));
#pragma unroll
                for (int q = 0; q < 4; ++q) {
                    const int r = (lane >> 3) + 8 * q, c = lane & 7;
                    const bf16_t* row = P + (tokb + r) * PP;
                    u32x4 kv = *(const u32x4*)(row + kc + 8 * c);
                    if (c < 2) {
                        const u32x4 pv = *(const u32x4*)(row + kc + 8 * (c ^ 1));
                        const float* rt = rope + (tokb + r) * 16;
                        const f32x4 ca = *(const f32x4*)rt, cb2 = *(const f32x4*)(rt + 4), sa = *(const f32x4*)(rt + 8), sb = *(const f32x4*)(rt + 12);
                        const float cs[8] = {ca.x, ca.y, ca.z, ca.w, cb2.x, cb2.y, cb2.z, cb2.w}, sn[8] = {sa.x, sa.y, sa.z, sa.w, sb.x, sb.y, sb.z, sb.w};
                        const float mv[8] = {bf_lo(kv.x), bf_hi(kv.x), bf_lo(kv.y), bf_hi(kv.y), bf_lo(kv.z), bf_hi(kv.z), bf_lo(kv.w), bf_hi(kv.w)};
                        const float pp[8] = {bf_lo(pv.x), bf_hi(pv.x), bf_lo(pv.y), bf_hi(pv.y), bf_lo(pv.z), bf_hi(pv.z), bf_lo(pv.w), bf_hi(pv.w)};
                        const float sg = (c == 0) ? -1.f : 1.f; float o[8];
#pragma unroll
                        for (int e = 0; e < 8; ++e) o[e] = mv[e] * cs[e] + sg * pp[e] * sn[e];
                        kv.x = cvt_pk_bf16(o[0], o[1]); kv.y = cvt_pk_bf16(o[2], o[3]); kv.z = cvt_pk_bf16(o[4], o[5]); kv.w = cvt_pk_bf16(o[6], o[7]);
                    }
                    *(u32x4*)(kop + ((size_t)((bg * 512 + tile) * 4 + (c >> 1)) * 64 + pi32(r) + 32 * (c & 1)) * 8) = kv;
                    const u32x4 vv = *(const u32x4*)(row + vc + 8 * c);
                    *(LAS u32x4*)(vt + r * 72 + 8 * c) = vv;
                }
                LDS_WAIT();
#pragma unroll
                for (int o4 = 0; o4 < 4; ++o4) {
                    const int ks = o4 >> 1, dt = o4 & 1;
                    const LAS bf16_t* sp = vt + (16 * ks + 8 * hi) * 72 + 32 * dt + dl;
                    u32x4 o; o.x = (unsigned)sp[0] | ((unsigned)sp[72] << 16); o.y = (unsigned)sp[144] | ((unsigned)sp[216] << 16); o.z = (unsigned)sp[288] | ((unsigned)sp[360] << 16); o.w = (unsigned)sp[432] | ((unsigned)sp[504] << 16);
                    *(u32x4*)(vop + ((size_t)((bg * 1024 + 2 * tile + ks) * 2 + dt) * 64 + lane) * 8) = o;
                }
                LDS_WAIT();
            }
        }
    }
}

__device__ __forceinline__ void cmp_stage2(const Ctx& C, int l) {
    const int bxx = C.gw / NWAVES, kv = bxx & 1, wi = bxx >> 1, nwg2 = (C.G + 1 - kv) >> 1;
    const float* w2 = kv ? INF(19, l, 256 * 64) : INF(16, l, 256 * 64);
    LAS float* ws2 = (LAS float*)C.lds;
    for (int e = C.tid; e < 256 * 64 / 4; e += NWAVES * 64) ((LAS f32x4*)ws2)[e] = ((const f32x4*)w2)[e];
    __syncthreads();
    const bf16_t* hid = (const bf16_t*)(C.ws + WS_CMPH) + (size_t)kv * 4096 * 256;
    bf16_t* ko = (bf16_t*)(C.ws + WS_KCMP); bf16_t* vo = (bf16_t*)(C.ws + WS_VCMP);
    const int d = C.lane;
    for (int row = wi * NWAVES + C.wave; row < 4096; row += nwg2 * NWAVES) {
        asm volatile("" ::: "memory");
        const u32x2 hv = *((const u32x2*)(hid + (size_t)row * 256) + C.lane);
        const float h0 = bf_lo(hv.x), h1 = bf_hi(hv.x), h2 = bf_lo(hv.y), h3 = bf_hi(hv.y);
        float acc = 0.f;
#pragma unroll 4
        for (int k = 0; k < 64; ++k) {
            const float a0 = __int_as_float(__builtin_amdgcn_readlane(__float_as_int(h0), k)), a1 = __int_as_float(__builtin_amdgcn_readlane(__float_as_int(h1), k));
            const float a2 = __int_as_float(__builtin_amdgcn_readlane(__float_as_int(h2), k)), a3 = __int_as_float(__builtin_amdgcn_readlane(__float_as_int(h3), k));
            acc += a0 * ws2[(4 * k + 0) * 64 + d]; acc += a1 * ws2[(4 * k + 1) * 64 + d]; acc += a2 * ws2[(4 * k + 2) * 64 + d]; acc += a3 * ws2[(4 * k + 3) * 64 + d];
        }
        const int bg = row >> 10, n = row & 1023;
        if (n == 1023) acc = 0.f;
        const bf16_t o = (bf16_t)(cvt_pk_bf16(acc, 0.f) & 0xffffu);
        if (kv == 0) ko[((size_t)((bg * 32 + (n >> 5)) * 4 + (d >> 4)) * 64 + pi32(n & 31) + 32 * ((d >> 3) & 1)) * 8 + (d & 7)] = o;
        else vo[((size_t)((bg * 64 + (n >> 4)) * 2 + (d >> 5)) * 64 + (d & 31) + 32 * ((n >> 3) & 1)) * 8 + (n & 7)] = o;
    }
    __syncthreads();
}

__device__ __forceinline__ f32x16 mfma32(bf16x8 a, bf16x8 b, f32x16 c) { return __builtin_amdgcn_mfma_f32_32x32x16_bf16(a, b, c, 0, 0, 0); }
__device__ __forceinline__ float dpp_xor1(float v) { return __int_as_float(__builtin_amdgcn_update_dpp(0, __float_as_int(v), 0xB1, 0xF, 0xF, true)); }
__device__ __forceinline__ float dpp_xor2(float v) { return __int_as_float(__builtin_amdgcn_update_dpp(0, __float_as_int(v), 0x4E, 0xF, 0xF, true)); }
__device__ __forceinline__ bf16x8 pack_p(const float* p) { u32x4 w; w.x = cvt_pk_bf16(p[0], p[1]); w.y = cvt_pk_bf16(p[2], p[3]); w.z = cvt_pk_bf16(p[4], p[5]); w.w = cvt_pk_bf16(p[6], p[7]); return __builtin_bit_cast(bf16x8, w); }
__device__ __forceinline__ bf16x8 scale_q(u32x4 v, float s) { u32x4 w; w.x = cvt_pk_bf16(bf_lo(v.x) * s, bf_hi(v.x) * s); w.y = cvt_pk_bf16(bf_lo(v.y) * s, bf_hi(v.y) * s); w.z = cvt_pk_bf16(bf_lo(v.z) * s, bf_hi(v.z) * s); w.w = cvt_pk_bf16(bf_lo(v.w) * s, bf_hi(v.w) * s); return __builtin_bit_cast(bf16x8, w); }
#define KREL(i, hi) (8 * (hi) + (i) + (((i) >= 8) ? 8 : 0))

__device__ __forceinline__ void flash_load(const bf16x8* kp, const bf16x8* vp, bf16x8 (&kf)[4], bf16x8 (&vf)[4]) {
#pragma unroll
    for (int s = 0; s < 4; ++s) kf[s] = kp[s * 64];
#pragma unroll
    for (int s = 0; s < 4; ++s) vf[s] = vp[s * 64];
    __builtin_amdgcn_sched_barrier(0);
}
__device__ __forceinline__ void flash_compute(bool domask, const bf16x8 (&kf)[4], const bf16x8 (&vf)[4], const bf16x8 (&q)[4], int x0, unsigned span, float& m, float& l, f32x16 (&O)[2]) {
    f32x16 sc;
#pragma unroll
    for (int i = 0; i < 16; ++i) sc[i] = 0.f;
#pragma unroll
    for (int s = 0; s < 4; ++s) sc = mfma32(kf[s], q[s], sc);
    if (domask) {
#pragma unroll
        for (int i = 0; i < 16; ++i) sc[i] = ((unsigned)(x0 + i + (i >= 8 ? 8 : 0)) <= span) ? sc[i] : -1e30f;
    }
    const float a0 = fmaxf(fmaxf(sc[0], sc[1]), sc[2]), a1 = fmaxf(fmaxf(sc[3], sc[4]), sc[5]), a2 = fmaxf(fmaxf(sc[6], sc[7]), sc[8]), a3 = fmaxf(fmaxf(sc[9], sc[10]), sc[11]), a4 = fmaxf(fmaxf(sc[12], sc[13]), sc[14]);
    float mx = fmaxf(fmaxf(fmaxf(a0, a1), fmaxf(a2, a3)), fmaxf(a4, sc[15]));
    mx = fmaxf(mx, __shfl_xor(mx, 32));
    const float mn = fmaxf(m, mx);
    if (__ballot(mn > m) != 0ull) {
        const float alpha = ex2(m - mn); l *= alpha; O[0] = O[0] * alpha; O[1] = O[1] * alpha;
    }
    m = mn;
    const float msub = (mn < -1e29f) ? 0.f : mn;
    const f32x16 d = sc - msub;
    float p[16], ps = 0.f;
#pragma unroll
    for (int i = 0; i < 16; ++i) { p[i] = ex2(d[i]); ps += p[i]; }
    l += ps;
    const bf16x8 pb0 = pack_p(p), pb1 = pack_p(p + 8);
    O[0] = mfma32(vf[0], pb0, O[0]); O[1] = mfma32(vf[1], pb0, O[1]);
    O[0] = mfma32(vf[2], pb1, O[0]); O[1] = mfma32(vf[3], pb1, O[1]);
}
template <int MODE> __device__ __forceinline__ void flash_desc(int s, const LAS unsigned* list, int base, int t, int t0, int qi, int hi, int& tile, int& x0, unsigned& span, int& vm) {
    if constexpr (MODE == 0) {
        const unsigned e = (unsigned)__builtin_amdgcn_readfirstlane((int)list[s >> 1]);
        tile = 2 * (int)(e & 0xffffu) + (s & 1);
        const bool my = ((e >> 16) >> qi) & 1u; const int up = my ? (t - 32 * tile) : -1;
        x0 = up < 0 ? 64 : 8 * hi; span = up < 0 ? 0u : (unsigned)up;
        vm = (32 * tile + 31 <= t0) ? (((e >> 16) == 0xFFu) ? 0 : 1) : 2;
    } else {
        tile = base + s; x0 = 8 * hi - (t - 511 - 32 * tile); span = 511u;
        vm = (32 * tile + 31 <= t0 && 32 * tile >= t0 + 7 - 511) ? 0 : 2;
    }
}
template <int MODE> __device__ __forceinline__ void flash_run(const bf16x8* kb, const bf16x8* vb, const bf16x8 (&q)[4], int nsteps, const LAS unsigned* list, int base, int t, int t0, int qi, int hi, float& m, float& l, f32x16 (&O)[2]) {
    if (nsteps <= 0) return;
    bf16x8 kA[4], vA[4], kB[4], vB[4], kC[4], vC[4]; int x0A, x0B, x0C, vmA, vmB, vmC; unsigned spA, spB, spC;
#define FR_LOAD(S, KF, VF, X0, SP, VM) do { int tile_; const int sn_ = ((S) < nsteps) ? (S) : nsteps - 1; flash_desc<MODE>(sn_, list, base, t, t0, qi, hi, tile_, X0, SP, VM); \
        flash_load(kb + (size_t)tile_ * 256, vb + (size_t)tile_ * 256, KF, VF); } while (0)
    FR_LOAD(0, kA, vA, x0A, spA, vmA); FR_LOAD(1, kB, vB, x0B, spB, vmB);
#pragma unroll 1
    for (int s = 0; s < nsteps; s += 3) {
        FR_LOAD(s + 2, kC, vC, x0C, spC, vmC); flash_compute(vmA != 0, kA, vA, q, x0A, spA, m, l, O); if (s + 1 >= nsteps) break;
        FR_LOAD(s + 3, kA, vA, x0A, spA, vmA); flash_compute(vmB != 0, kB, vB, q, x0B, spB, m, l, O); if (s + 2 >= nsteps) break;
        FR_LOAD(s + 4, kB, vB, x0B, spB, vmB); flash_compute(vmC != 0, kC, vC, q, x0C, spC, m, l, O);
    }
#undef FR_LOAD
}

__device__ __forceinline__ unsigned wave_max_u32(unsigned v) {
#pragma unroll
    for (int o = 1; o < 64; o <<= 1) { const unsigned t = (unsigned)__shfl_xor((int)v, o); v = v > t ? v : t; }
    return v;
}

__device__ __forceinline__ void nsa_tile(const Ctx& C, int b, int g, int t0) {
    const bf16_t* P = (const bf16_t*)(C.ws + WS_R1); bf16_t* Y = (bf16_t*)(C.ws + WS_Y);
    const int lane = C.lane, r = lane & 31, hi = lane >> 5, qi = r >> 2, h = r & 3, head = g * 4 + h, bg = b * 2 + g;
    const int t = t0 + qi; const size_t tok = (size_t)b * S_ + t;
    LAS float* imp = (LAS float*)(C.lds + C.wave * 16640);
    LAS float* ost = (LAS float*)(C.lds + C.wave * 16640 + 8448) + lane;
    const float QS = 0.18033688011112042f;
    bf16x8 qf[4], qr[4];
    {
        const bf16_t* qp = P + tok * PP + PC_Q + head * 64;
#pragma unroll
        for (int s = 0; s < 4; ++s) qf[s] = scale_q(*(const u32x4*)(qp + 16 * s + 8 * hi), QS);
        const u32x4 mv4 = *(const u32x4*)(qp + 8 * hi), pv4 = *(const u32x4*)(qp + 8 * (hi ^ 1));
        const float* rt = (const float*)(C.ws + WS_ROPE) + tok * 16;
        const f32x4 ca = *(const f32x4*)rt, cb2 = *(const f32x4*)(rt + 4), sa = *(const f32x4*)(rt + 8), sb = *(const f32x4*)(rt + 12);
        const float cs[8] = {ca.x, ca.y, ca.z, ca.w, cb2.x, cb2.y, cb2.z, cb2.w}, sn[8] = {sa.x, sa.y, sa.z, sa.w, sb.x, sb.y, sb.z, sb.w};
        const float mv[8] = {bf_lo(mv4.x), bf_hi(mv4.x), bf_lo(mv4.y), bf_hi(mv4.y), bf_lo(mv4.z), bf_hi(mv4.z), bf_lo(mv4.w), bf_hi(mv4.w)};
        const float pp[8] = {bf_lo(pv4.x), bf_hi(pv4.x), bf_lo(pv4.y), bf_hi(pv4.y), bf_lo(pv4.z), bf_hi(pv4.z), bf_lo(pv4.w), bf_hi(pv4.w)};
        const float sg = hi ? 1.f : -1.f; float o[8];
#pragma unroll
        for (int e = 0; e < 8; ++e) o[e] = (mv[e] * cs[e] + sg * pp[e] * sn[e]) * QS;
        qr[0] = pack_p(o); qr[1] = qf[1]; qr[2] = qf[2]; qr[3] = qf[3];
    }
    const bf16_t* gp = P + tok * PP + PC_NG + head * 3;
    const float gc = sigm(bf1(gp[0])), gs = sigm(bf1(gp[1])), gw = sigm(bf1(gp[2]));

    const int cur = t0 >> 6;
    {
        const int nvq = (t >= 31) ? ((t - 31) >> 4) + 1 : 0;
        const int tl = t0 + 7, nvmax = (tl >= 31) ? ((tl - 31) >> 4) + 1 : 0, ntile = (nvmax + 31) >> 5;
        const bf16x8* kb = (const bf16x8*)(C.ws + WS_KCMP) + (size_t)bg * 32 * 4 * 64 + lane;
        const bf16x8* vb = (const bf16x8*)(C.ws + WS_VCMP) + (size_t)bg * 64 * 2 * 64 + lane;
        float m1 = -1e30f, l1 = 0.f;
#define CMP_P1(KF, KT) do { \
            f32x16 sc; _Pragma("unroll") for (int i = 0; i < 16; ++i) sc[i] = 0.f; \
            _Pragma("unroll") for (int s = 0; s < 4; ++s) sc = mfma32(KF[s], qf[s], sc); \
            const int up = nvq - 1 - 32 * (KT); const int x0 = up < 0 ? 64 : 8 * hi; const unsigned span = up < 0 ? 0u : (unsigned)up; \
            float mx = -1e30f; bool ok[16]; \
            _Pragma("unroll") for (int i = 0; i < 16; ++i) { ok[i] = (unsigned)(x0 + i + (i >= 8 ? 8 : 0)) <= span; sc[i] = ok[i] ? sc[i] : -1e30f; mx = fmaxf(mx, sc[i]); } \
            mx = fmaxf(mx, __shfl_xor(mx, 32)); \
            const float mn = fmaxf(m1, mx); float ps = 0.f; \
            _Pragma("unroll") for (int i = 0; i < 16; ++i) ps += ok[i] ? ex2(sc[i] - mn) : 0.f; \
            l1 = l1 * ex2(m1 - mn) + ps; m1 = mn; } while (0)
        if (ntile > 0) {
            bf16x8 kA[4], kB[4];
#pragma unroll
            for (int s = 0; s < 4; ++s) kA[s] = kb[s * 64];
#pragma unroll 1
            for (int kt = 0; kt < ntile; kt += 2) {
                { const int kn = (kt + 1 < ntile) ? kt + 1 : ntile - 1;
#pragma unroll
                  for (int s = 0; s < 4; ++s) kB[s] = kb[kn * 256 + s * 64]; }
                __builtin_amdgcn_sched_barrier(0);
                CMP_P1(kA, kt);
                if (kt + 1 >= ntile) break;
                { const int kn = (kt + 2 < ntile) ? kt + 2 : ntile - 1;
#pragma unroll
                  for (int s = 0; s < 4; ++s) kA[s] = kb[kn * 256 + s * 64]; }
                __builtin_amdgcn_sched_barrier(0);
                CMP_P1(kB, kt + 1);
            }
        }
#undef CMP_P1
        l1 += __shfl_xor(l1, 32);
        const float inv = 1.f / fmaxf(l1, 1e-30f);
        for (int e = lane; e < 8 * 264; e += 64) imp[e] = 0.f;
        LDS_WAIT();
        f32x16 O[2];
#pragma unroll
        for (int i = 0; i < 16; ++i) { O[0][i] = 0.f; O[1][i] = 0.f; }
#define CMP_P2(KF, VF, KT) do { \
            f32x16 sc; _Pragma("unroll") for (int i = 0; i < 16; ++i) sc[i] = 0.f; \
            _Pragma("unroll") for (int s = 0; s < 4; ++s) sc = mfma32(KF[s], qf[s], sc); \
            const int up = nvq - 1 - 32 * (KT); const int x0 = up < 0 ? 64 : 8 * hi; const unsigned span = up < 0 ? 0u : (unsigned)up; \
            float p[16]; \
            _Pragma("unroll") for (int i = 0; i < 16; ++i) { const bool ok = (unsigned)(x0 + i + (i >= 8 ? 8 : 0)) <= span; p[i] = ok ? ex2(sc[i] - m1) * inv : 0.f; } \
            _Pragma("unroll") for (int rr = 0; rr < 2; ++rr) { \
                const float* q8 = p + 8 * rr; \
                float a = q8[0] + q8[1] + q8[2] + 0.5f * q8[3], bq = 0.5f * q8[3] + q8[4] + q8[5] + q8[6] + 0.5f * q8[7], cq = 0.5f * q8[7]; \
                a += dpp_xor1(a); a += dpp_xor2(a); bq += dpp_xor1(bq); bq += dpp_xor2(bq); cq += dpp_xor1(cq); cq += dpp_xor2(cq); \
                _Pragma("unroll") for (int hh = 0; hh < 2; ++hh)     \
                if (h == 0 && hi == hh) { LAS float* ip = imp + qi * 264 + 8 * (KT) + 2 * hi + 4 * rr; \
                    __hip_atomic_fetch_add(ip, a, __ATOMIC_RELAXED, __HIP_MEMORY_SCOPE_WORKGROUP); __hip_atomic_fetch_add(ip + 1, bq, __ATOMIC_RELAXED, __HIP_MEMORY_SCOPE_WORKGROUP); \
                    __hip_atomic_fetch_add(ip + 2, cq, __ATOMIC_RELAXED, __HIP_MEMORY_SCOPE_WORKGROUP); } \
            } \
            const bf16x8 pb0 = pack_p(p), pb1 = pack_p(p + 8); \
            O[0] = mfma32(VF[0], pb0, O[0]); O[1] = mfma32(VF[1], pb0, O[1]); \
            O[0] = mfma32(VF[2], pb1, O[0]); O[1] = mfma32(VF[3], pb1, O[1]); } while (0)
        if (ntile > 0) {
            bf16x8 kA[4], kB[4], vA[4];
#pragma unroll
            for (int s = 0; s < 4; ++s) kA[s] = kb[s * 64];
#pragma unroll 1
            for (int kt = 0; kt < ntile; kt += 2) {
                { const int kn = (kt + 1 < ntile) ? kt + 1 : ntile - 1;
#pragma unroll
                  for (int s = 0; s < 4; ++s) kB[s] = kb[kn * 256 + s * 64];
#pragma unroll
                  for (int s = 0; s < 4; ++s) vA[s] = vb[kt * 256 + s * 64]; }
                __builtin_amdgcn_sched_barrier(0);
                CMP_P2(kA, vA, kt);
                if (kt + 1 >= ntile) break;
                { const int kn = (kt + 2 < ntile) ? kt + 2 : ntile - 1;
#pragma unroll
                  for (int s = 0; s < 4; ++s) kA[s] = kb[kn * 256 + s * 64];
#pragma unroll
                  for (int s = 0; s < 4; ++s) vA[s] = vb[(kt + 1) * 256 + s * 64]; }
                __builtin_amdgcn_sched_barrier(0);
                CMP_P2(kB, vA, kt + 1);
            }
        }
#undef CMP_P2
#pragma unroll
        for (int i = 0; i < 16; ++i) { ost[i * 64] = gc * O[0][i]; ost[(16 + i) * 64] = gc * O[1][i]; }
        LDS_WAIT();
    }

    unsigned bmv[4];
    if (cur <= 15) {
#pragma unroll
        for (int c = 0; c < 4; ++c) bmv[c] = (lane + 64 * c <= cur) ? 0xFFu : 0u;
    } else {
        unsigned key[8][4];
#pragma unroll
        for (int q2 = 0; q2 < 8; ++q2)
#pragma unroll
            for (int c = 0; c < 4; ++c) { const int j = lane + 64 * c; const bool cand = (j >= 1) && (j < cur - 1); const float v = imp[q2 * 264 + j];
                key[q2][c] = cand ? ((__float_as_uint(v) & 0xFFFFFF00u) | (unsigned)(255 - j)) : 0u; }
#pragma unroll
        for (int c = 0; c < 4; ++c) bmv[c] = 0u;
#pragma unroll 1
        for (int round = 0; round < 13; ++round) {
#pragma unroll
            for (int q2 = 0; q2 < 8; ++q2) {
                unsigned mx = key[q2][0]; mx = mx > key[q2][1] ? mx : key[q2][1]; mx = mx > key[q2][2] ? mx : key[q2][2]; mx = mx > key[q2][3] ? mx : key[q2][3];
                const unsigned w = wave_max_u32(mx);
#pragma unroll
                for (int c = 0; c < 4; ++c) { const bool win = (key[q2][c] == w) && (w != 0u); key[q2][c] = win ? 0u : key[q2][c]; bmv[c] |= win ? (1u << q2) : 0u; }
            }
        }
#pragma unroll
        for (int c = 0; c < 4; ++c) { const int j = lane + 64 * c; if (j == 0 || j == cur || j == cur - 1) bmv[c] = 0xFFu; }
    }

    {
        LAS unsigned* list = (LAS unsigned*)imp;
        int nblk = 0;
#pragma unroll
        for (int c = 0; c < 4; ++c) {
            const unsigned long long mk = __ballot(bmv[c] != 0u);
            const int pos = nblk + (int)__builtin_amdgcn_mbcnt_hi((unsigned)(mk >> 32), __builtin_amdgcn_mbcnt_lo((unsigned)mk, 0u));
            if (bmv[c] != 0u) list[pos] = (unsigned)(lane + 64 * c) | (bmv[c] << 16);
            nblk += __builtin_popcountll(mk);
        }
        LDS_WAIT();
        const bf16x8* kb = (const bf16x8*)(C.ws + WS_KSLC) + (size_t)bg * 512 * 4 * 64 + lane;
        const bf16x8* vb = (const bf16x8*)(C.ws + WS_VSLC) + (size_t)bg * 1024 * 2 * 64 + lane;
        float m = -1e30f, l = 0.f; f32x16 O[2];
#pragma unroll
        for (int i = 0; i < 16; ++i) { O[0][i] = 0.f; O[1][i] = 0.f; }
        flash_run<0>(kb, vb, qr, 2 * nblk, list, 0, t, t0, qi, hi, m, l, O);
        l += __shfl_xor(l, 32);
        const float sc = gs / fmaxf(l, 1e-30f);
#pragma unroll
        for (int i = 0; i < 16; ++i) { ost[i * 64] += sc * O[0][i]; ost[(16 + i) * 64] += sc * O[1][i]; }
        LDS_WAIT();
    }
    {
        const bf16x8* kb = (const bf16x8*)(C.ws + WS_KWIN) + (size_t)bg * 512 * 4 * 64 + lane;
        const bf16x8* vb = (const bf16x8*)(C.ws + WS_VWIN) + (size_t)bg * 1024 * 2 * 64 + lane;
        float m = -1e30f, l = 0.f; f32x16 O[2];
#pragma unroll
        for (int i = 0; i < 16; ++i) { O[0][i] = 0.f; O[1][i] = 0.f; }
        const int tlo = (t0 - 511 > 0 ? t0 - 511 : 0) >> 5, thi = (t0 + 7) >> 5;
        flash_run<1>(kb, vb, qr, thi - tlo + 1, (const LAS unsigned*)imp, tlo, t, t0, qi, hi, m, l, O);
        l += __shfl_xor(l, 32);
        const float sc = gw / fmaxf(l, 1e-30f);
        bf16_t* yp = Y + tok * YP + 512 + head * 64 + 4 * hi;
#pragma unroll
        for (int dt = 0; dt < 2; ++dt)
#pragma unroll
            for (int ig = 0; ig < 4; ++ig) { float o4[4];
#pragma unroll
                for (int e = 0; e < 4; ++e) o4[e] = ost[(dt * 16 + 4 * ig + e) * 64] + sc * O[dt][4 * ig + e];
                u32x2 w; w.x = cvt_pk_bf16(o4[0], o4[1]); w.y = cvt_pk_bf16(o4[2], o4[3]); *(u32x2*)(yp + 32 * dt + 8 * ig) = w; }
        LDS_WAIT();
    }
}

__device__ __forceinline__ void mem_tile(const Ctx& C, int b, int hm, int t0) {
    const bf16_t* P = (const bf16_t*)(C.ws + WS_R1); bf16_t* Y = (bf16_t*)(C.ws + WS_Y);
    const int lane = C.lane, r = lane & 31, hi = lane >> 5;
    const size_t tok = (size_t)b * S_ + t0 + r;
    const float QS = 0.12751743082459868f;
    bf16x8 q[8];
    const bf16_t* qp = P + tok * PP + PC_QM + hm * 128;
#pragma unroll
    for (int s = 0; s < 8; ++s) q[s] = scale_q(*(const u32x4*)(qp + 16 * s + 8 * hi), QS);
    const bf16x8* kb = (const bf16x8*)(C.ws + WS_MEMK) + (size_t)(b * 4 + hm) * 8 * 8 * 64 + lane;
    const bf16x8* vb = (const bf16x8*)(C.ws + WS_MEMV) + (size_t)(b * 4 + hm) * 16 * 4 * 64 + lane;
    float m = -1e30f, l = 0.f; f32x16 O[4];
#pragma unroll
    for (int i = 0; i < 16; ++i) { O[0][i] = 0.f; O[1][i] = 0.f; O[2][i] = 0.f; O[3][i] = 0.f; }
#define MEM_STEP(KF, VF) do { \
        f32x16 sc; _Pragma("unroll") for (int i = 0; i < 16; ++i) sc[i] = 0.f; \
        _Pragma("unroll") for (int s = 0; s < 8; ++s) sc = mfma32(KF[s], q[s], sc); \
        float mx = -1e30f; _Pragma("unroll") for (int i = 0; i < 16; ++i) mx = fmaxf(mx, sc[i]); \
        mx = fmaxf(mx, __shfl_xor(mx, 32)); \
        const float mn = fmaxf(m, mx), alpha = ex2(m - mn); m = mn; \
        float p[16], ps = 0.f; _Pragma("unroll") for (int i = 0; i < 16; ++i) { p[i] = ex2(sc[i] - mn); ps += p[i]; } \
        l = l * alpha + ps; \
        _Pragma("unroll") for (int i = 0; i < 16; ++i) { O[0][i] *= alpha; O[1][i] *= alpha; O[2][i] *= alpha; O[3][i] *= alpha; } \
        const bf16x8 pb0 = pack_p(p), pb1 = pack_p(p + 8); \
        _Pragma("unroll") for (int dt = 0; dt < 4; ++dt) { O[dt] = mfma32(VF[dt], pb0, O[dt]); O[dt] = mfma32(VF[4 + dt], pb1, O[dt]); } } while (0)
    {
        bf16x8 kA[8], vv[8];
#pragma unroll 1
        for (int kt = 0; kt < 8; ++kt) {
#pragma unroll
            for (int s = 0; s < 8; ++s) kA[s] = kb[kt * 512 + s * 64];
#pragma unroll
            for (int s = 0; s < 8; ++s) vv[s] = vb[kt * 512 + s * 64];
            __builtin_amdgcn_sched_barrier(0);
            MEM_STEP(kA, vv);
        }
    }
#undef MEM_STEP
    l += __shfl_xor(l, 32);
    const float inv = 1.f / l;
    bf16_t* yp = Y + tok * YP + 1024 + hm * 128 + 4 * hi;
#pragma unroll
    for (int dt = 0; dt < 4; ++dt)
#pragma unroll
        for (int ig = 0; ig < 4; ++ig) { u32x2 w; w.x = cvt_pk_bf16(O[dt][4 * ig] * inv, O[dt][4 * ig + 1] * inv); w.y = cvt_pk_bf16(O[dt][4 * ig + 2] * inv, O[dt][4 * ig + 3] * inv); *(u32x2*)(yp + 32 * dt + 8 * ig) = w; }
}

__device__ __forceinline__ void attention_phase(const Ctx& C) {
    const int bxx = C.gw / NWAVES; const bool xmode = (C.G & 7) == 0;
    const int x = bxx & 7, rank = xmode ? (bxx >> 3) * NWAVES + C.wave : C.gw, nrank = xmode ? (C.G >> 3) * NWAVES : C.NGW, nitem = xmode ? 1536 : 12288;
    for (int i = rank; i < nitem; i += nrank) {
        int nsa_n, mem_e;
        if (xmode) { nsa_n = (i < 1024) ? (x >> 1) * 2048 + 2 * i + (x & 1) : -1; mem_e = x * 512 + (i - 1024); }
        else { if (i < 8192) { const int k = i >> 11, w = i & 2047; nsa_n = k * 2048 + ((k & 1) ? 2047 - w : w); } else nsa_n = -1; mem_e = i - 8192; }
        if (nsa_n >= 0) { const int k = nsa_n >> 11; nsa_tile(C, k >> 1, k & 1, (nsa_n & 2047) * 8); }
        else { const int bh = mem_e >> 9; mem_tile(C, bh >> 2, bh & 3, (mem_e & 511) * 32); }
    }
}

#define XB_TMO      128
#define XB_XCNT(j)  (256  + 64 * (j))
#define XB_XSUB(j)  (1280 + 64 * (j))
#define XB_XGEN(j)  (2304 + 64 * (j))
#define XB_TOP      3328
#define XB_TOPGEN   3392
#define XCD_BAR_WORDS 3456
#define XB_SPIN_CAP (1u << 18)
__device__ __forceinline__ unsigned xb_ld(unsigned* p)              { return __hip_atomic_load(p, __ATOMIC_RELAXED, __HIP_MEMORY_SCOPE_AGENT); }
__device__ __forceinline__ unsigned xb_add(unsigned* p, unsigned v) { return __hip_atomic_fetch_add(p, v, __ATOMIC_RELAXED, __HIP_MEMORY_SCOPE_AGENT); }
__device__ __forceinline__ unsigned xb_xcc_id() { return (unsigned)__builtin_amdgcn_s_getreg((3 << 11) | 20) & 0xFu; }
#define XB_SPIN(cond, bar) do { unsigned _sp = 0; while (cond) { __builtin_amdgcn_s_sleep(1); \
    if ((++_sp & 255u) == 0u) { if (xb_ld(&(bar)[XB_TMO])) break; if (_sp > XB_SPIN_CAP) { atomicAdd(&(bar)[XB_TMO], 1u); break; } } } } while (0)
__device__ __forceinline__ void xcd_barrier_complete(unsigned* bar, unsigned x, unsigned& nloc, unsigned& nx) {
    const unsigned G = gridDim.x * gridDim.y * gridDim.z;
    unsigned sum, cnt, mine, sp = 0u;
    for (;;) {
        sum = 0u; cnt = 0u; mine = 0u;
#pragma unroll
        for (unsigned j = 0; j < 16; ++j) { const unsigned c = xb_ld(&bar[XB_XCNT(j)]); sum += c; cnt += (c > 0u) ? 1u : 0u; mine = (j == x) ? c : mine; }
        if (sum == G) break;
        __builtin_amdgcn_s_sleep(1);
        if ((++sp & 255u) == 0u) { if (xb_ld(&bar[XB_TMO])) break; if (sp > XB_SPIN_CAP) { atomicAdd(&bar[XB_TMO], 1u); break; } }
    }
    nloc = mine > 0u ? mine : 1u; nx = cnt > 0u ? cnt : 1u;
}
__device__ __forceinline__ void xcd_barrier(unsigned* bar, volatile LAS unsigned* st, bool tid0) {
    asm volatile("s_waitcnt vmcnt(0)" ::: "memory");
    __syncthreads();
    if (tid0) {
        __builtin_amdgcn_s_waitcnt(0);
        const unsigned x = xb_xcc_id();
        unsigned nloc = st[0], nx = st[1];
        if (nloc == 0u) { xcd_barrier_complete(bar, x, nloc, nx); st[0] = nloc; st[1] = nx; }
        const unsigned old = xb_add(&bar[XB_XSUB(x)], 1u);
        const unsigned gen = old / nloc;
        if (old + 1u == (gen + 1u) * nloc) {
            __builtin_amdgcn_fence(__ATOMIC_RELEASE, "agent");
            asm volatile("s_waitcnt vmcnt(0)" ::: "memory");
            const unsigned og = xb_add(&bar[XB_TOP], 1u);
            const unsigned tg = og / nx;
            if (og + 1u == (tg + 1u) * nx) xb_add(&bar[XB_TOPGEN], 1u);
            else XB_SPIN(xb_ld(&bar[XB_TOPGEN]) == tg, bar);
            __builtin_amdgcn_fence(__ATOMIC_ACQUIRE, "agent");
            xb_add(&bar[XB_XGEN(x)], 1u);
            asm volatile("s_waitcnt vmcnt(0)" ::: "memory");
        } else {
            XB_SPIN(xb_ld(&bar[XB_XGEN(x)]) == gen, bar);
            __builtin_amdgcn_fence(__ATOMIC_ACQUIRE, "agent");
            asm volatile("s_waitcnt vmcnt(0)" ::: "memory");
        }
    }
    __syncthreads();
}

constexpr int LDS_BYTES = 147456, XB_LDS_OFF = 147456 - 64;
constexpr int NPHASE = 1 + 2 * 14;

__global__ void __launch_bounds__(NWAVES * 64, 2) fwd_kernel(Args args) {
    extern __shared__ __attribute__((aligned(16))) unsigned char lds_raw[];
    cg::grid_group grid = cg::this_grid();
    if (args.ph_lo == 0x7fffffff) grid.sync();
    const int wave0 = __builtin_amdgcn_readfirstlane((int)threadIdx.x >> 6);
    {
        volatile LAS unsigned* st = (volatile LAS unsigned*)(lds_raw + XB_LDS_OFF);
        if (threadIdx.x == 0) { st[0] = 0u; st[1] = 0u; (void)xb_add((unsigned*)(args.ws + WS_BAR) + XB_XCNT(xb_xcc_id()), 1u); }
        __syncthreads();
    }
#define PHASE_BEGIN { \
        unsigned char* ws0_ = args.ws; asm volatile("" : "+s"(ws0_)); gu8* ws = (gu8*)ws0_;     \
        int tid_; asm volatile("v_mbcnt_lo_u32_b32 %0, -1, 0\n\tv_mbcnt_hi_u32_b32 %0, -1, %0" : "=v"(tid_)); tid_ += wave0 * 64; \
        Ctx C; C.a = &args; C.ws = ws; C.lds = (LAS unsigned char*)lds_raw; C.tid = tid_; C.lane = tid_ & 63; C.wave = __builtin_amdgcn_readfirstlane(tid_ >> 6); \
        int bx = blockIdx.x; asm volatile("" : "+s"(bx)); C.G = gridDim.x; C.gw = bx * NWAVES + C.wave; C.NGW = C.G * NWAVES; \
        bf16_t* const H = (bf16_t*)(ws + WS_H); bf16_t* const R1 = (bf16_t*)(ws + WS_R1); bf16_t* const Y = (bf16_t*)(ws + WS_Y); (void)H; (void)R1; (void)Y; (void)bx;
#define PHASE_END   xcd_barrier((unsigned*)(ws + WS_BAR), (volatile LAS unsigned*)(lds_raw + XB_LDS_OFF), tid_ == 0); }
#define PHASE_END_CG grid.sync(); }

    PHASE_BEGIN
        convert_layer(C, 0);
        rope_table(C);
        prenorm_rows(C, (const float*)args.in[0], (const float*)args.in[3], H);
    PHASE_END

#pragma unroll 1
    for (int l = 0; l < 2; ++l) {
        PHASE_BEGIN
            { pg8::GemmDesc g{(const char*)H, (const char*)(ws + WS_W1IN), DM, DM, 128, 128, 16}; pg8::StdOrder S; S.init(T_, 2 * FF, C.G, bx, DM, DM);
              pg8::Epi<1> E{R1, FF, nullptr, nullptr}; pg8::gemm_phase(C.lds, C.tid, g, S, E); }
        PHASE_END
        PHASE_BEGIN
            { pg8::GemmDesc g{(const char*)R1, (const char*)(ws + WS_W1OUT), FF, FF, 128, 128, 44}; pg8::StdOrder S; S.init(T_, DM, C.G, bx, FF, FF);
              pg8::Epi<0> E{H, DM, nullptr, nullptr}; pg8::gemm_phase(C.lds, C.tid, g, S, E); }
        PHASE_END
        PHASE_BEGIN
            if (bx < 8) {
                { pg8::GemmDesc g{(const char*)(ws + WS_MEMN), (const char*)(ws + WS_WMKV), DM, DM, 128, 128, 16}; pg8::StdOrder S; S.init(512, DM, C.G, bx, DM, DM);
              pg8::Epi<0> E{(bf16_t*)(ws + WS_MKV), DM, nullptr, nullptr}; pg8::gemm_phase(C.lds, C.tid, g, S, E); }
            } else {
                norm_phase(C, C.gw - 8 * NWAVES, C.NGW - 8 * NWAVES, l == 0 ? (const float*)args.in[0] : args.out, args.out, H, H, INF(4, l, DM), INF(7, l, DM), 0.5f);
            }
            cb_reduce(C, l);
        PHASE_END
        PHASE_BEGIN
            { pg8::GemmDesc g{(const char*)H, (const char*)(ws + WS_WMIX), DM, DM, 128, 128, 16}; pg8::StdOrder S; S.init(T_, PP, C.G, bx, DM, DM);
              pg8::Epi<0> E{R1, PP, nullptr, nullptr}; pg8::gemm_phase(C.lds, C.tid, g, S, E); }
        PHASE_END
        PHASE_BEGIN
            if (bx < 32) {
                pg8::GemmDesc g{(const char*)R1, (const char*)(ws + WS_WC1), 16 * PP, 2048, PP * 2, 128, 32}; pg8::CmpOrder S{bx};
                pg8::Epi<4> E{(bf16_t*)(ws + WS_CMPH), 256, nullptr, (const float*)(ws + WS_CB) + l * 512}; pg8::gemm_phase(C.lds, C.tid, g, S, E);
            } else {
                prep_items(C, l, C.gw - 32 * NWAVES, C.NGW - 32 * NWAVES);
                memkv_ops(C, C.gw - 32 * NWAVES, C.NGW - 32 * NWAVES);
            }
        PHASE_END
        PHASE_BEGIN
            cmp_stage2(C, l);
        PHASE_END
        PHASE_BEGIN
            attention_phase(C);
        PHASE_END
        PHASE_BEGIN
            { pg8::GemmDesc g{(const char*)H, (const char*)(ws + WS_WG), DM, DM, 128, 128, 16}; pg8::StdOrder S; S.init(T_, GP, C.G, bx, DM, DM);
              pg8::Epi<2> E{R1, GP, nullptr, nullptr}; pg8::gemm_phase(C.lds, C.tid, g, S, E); }
        PHASE_END
        PHASE_BEGIN
            { pg8::GemmDesc g{(const char*)Y, (const char*)(ws + WS_WBR), YP, YP, 128, 128, 8}; pg8::MergeOrder S; S.init(T_, DM, C.G, bx, YP, YP);
              pg8::Epi<3> E{H, DM, R1, nullptr}; pg8::gemm_phase(C.lds, C.tid, g, S, E); }
        PHASE_END
        PHASE_BEGIN
            { pg8::GemmDesc g{(const char*)H, (const char*)(ws + WS_WOUT), DM, DM, 128, 128, 16}; pg8::StdOrder S; S.init(T_, DM, C.G, bx, DM, DM);
              pg8::Epi<0> E{R1, DM, nullptr, nullptr}; pg8::gemm_phase(C.lds, C.tid, g, S, E); }
        PHASE_END
        PHASE_BEGIN
            norm_phase(C, C.gw, C.NGW, args.out, args.out, R1, H, INF(8, l, DM), INF(25, l, DM), 1.0f);
        PHASE_END
        PHASE_BEGIN
            { pg8::GemmDesc g{(const char*)H, (const char*)(ws + WS_W2IN), DM, DM, 128, 128, 16}; pg8::StdOrder S; S.init(T_, 2 * FF, C.G, bx, DM, DM);
              pg8::Epi<1> E{R1, FF, nullptr, nullptr}; pg8::gemm_phase(C.lds, C.tid, g, S, E); }
        PHASE_END
        PHASE_BEGIN
            { pg8::GemmDesc g{(const char*)R1, (const char*)(ws + WS_W2OUT), FF, FF, 128, 128, 44}; pg8::StdOrder S; S.init(T_, DM, C.G, bx, FF, FF);
              pg8::Epi<0> E{H, DM, nullptr, nullptr}; pg8::gemm_phase(C.lds, C.tid, g, S, E); }
        PHASE_END
        PHASE_BEGIN
            norm_phase(C, C.gw, C.NGW, args.out, args.out, H, H, INF(26, l, DM), l == 0 ? INF(3, 1, DM) : nullptr, 0.5f);
            if (l == 0) convert_layer(C, 1);
        PHASE_END
    }
}

extern "C" void kernel_launch(void* const* d_in, const int* in_sizes, int n_in, void* d_out, int out_size, void* d_ws, size_t ws_size, hipStream_t stream) {
    static int grid = 0;
    if (grid == 0) {
        if (n_in != 29 || ws_size < WS_END) { fprintf(stderr, "kernel_launch: unexpected n_in %d / ws %zu\n", n_in, ws_size); grid = -1; return; }
        int dev = 0, cus = 0, per_cu = 0;
        hipGetDevice(&dev); hipDeviceGetAttribute(&cus, hipDeviceAttributeMultiprocessorCount, dev);
        hipFuncSetAttribute((const void*)fwd_kernel, hipFuncAttributeMaxDynamicSharedMemorySize, LDS_BYTES);
        hipOccupancyMaxActiveBlocksPerMultiprocessor(&per_cu, (const void*)fwd_kernel, NWAVES * 64, LDS_BYTES);
        if (per_cu < 1) per_cu = 1;
        grid = cus * per_cu;
        (void)hipGetLastError();
    }
    if (grid < 0) return;
    hipMemsetAsync((char*)d_ws + WS_BAR, 0, 16384, stream);
    Args a{};
    for (int i = 0; i < 29; ++i) a.in[i] = d_in[i];
    a.out = (float*)d_out; a.ws = (unsigned char*)d_ws; a.ph_lo = 0; a.ph_hi = NPHASE;
    void* kargs[] = {&a};
    hipError_t e = hipLaunchCooperativeKernel((const void*)fwd_kernel, dim3(grid), dim3(NWAVES * 64), kargs, LDS_BYTES, stream);
    if (e != hipSuccess) fprintf(stderr, "cooperative launch failed: %s (grid %d)\n", hipGetErrorString(e), grid);
}
```

```cpp
#include <hip/hip_runtime.h>
#include <hip/hip_cooperative_groups.h>
#include <cstdio>
#include <cstdint>
namespace cg = cooperative_groups;

#define LAS __attribute__((address_space(3)))
typedef unsigned short bf16_t;
typedef short bf16x8 __attribute__((ext_vector_type(8)));
typedef float f32x4 __attribute__((ext_vector_type(4)));
typedef float f32x16 __attribute__((ext_vector_type(16)));
typedef unsigned u32x4 __attribute__((ext_vector_type(4)));
typedef unsigned u32x2 __attribute__((ext_vector_type(2)));

constexpr int NBATCH = 2, S_ = 16384, T_ = NBATCH * S_, DM = 1024, FF = 2816, PP = 3584, GP = 3072, YP = 1536;
constexpr int NWAVES = 8;
constexpr float EPS = 1e-6f;
constexpr int PC_Q = 1536, PC_KV = 2048, PC_QM = 2816, PC_NG = 3328;

constexpr size_t MiB = 1u << 20;
constexpr size_t WS_W1IN = 0, WS_W1OUT = 11 * MiB, WS_WMIX = WS_W1OUT + 11 * MiB / 2, WS_WG = WS_WMIX + 7 * MiB, WS_WBR = WS_WG + 6 * MiB, WS_WOUT = WS_WBR + 3 * MiB,
                 WS_W2IN = WS_WOUT + 2 * MiB, WS_W2OUT = WS_W2IN + 11 * MiB, WS_WC1 = WS_W2OUT + 11 * MiB / 2  , WS_WMKV = WS_WC1 + 2 * MiB,
                 WS_MEMN = WS_WMKV + 2 * MiB, WS_MKV = WS_MEMN + 1 * MiB, WS_CB = WS_MKV + 1 * MiB  , WS_CBP = WS_CB + 8192  , WS_BAR = WS_CB + 8192 + 131072  ;
static_assert(WS_CB == 57 * MiB, "ws map");
constexpr size_t WS_ROPE = 58 * MiB, WS_MEMK = 60 * MiB, WS_MEMV = WS_MEMK + MiB / 2, WS_KCMP = 61 * MiB, WS_VCMP = WS_KCMP + MiB / 2, WS_CMPH = 62 * MiB,
                 WS_KSLC = 66 * MiB, WS_VSLC = 74 * MiB, WS_KWIN = 82 * MiB, WS_VWIN = 90 * MiB, WS_H = 98 * MiB, WS_Y = 162 * MiB, WS_R1 = 258 * MiB, WS_END = 483 * MiB;

typedef float f32x2_t __attribute__((ext_vector_type(2)));
typedef __bf16 bf16x2_t __attribute__((ext_vector_type(2)));
__device__ __forceinline__ unsigned cvt_pk_bf16(float lo, float hi) { f32x2_t v = {lo, hi}; bf16x2_t b = __builtin_convertvector(v, bf16x2_t); return __builtin_bit_cast(unsigned, b); }
__device__ __forceinline__ float bf_lo(unsigned u) { return __uint_as_float(u << 16); }
__device__ __forceinline__ float bf_hi(unsigned u) { return __uint_as_float(u & 0xffff0000u); }
__device__ __forceinline__ float bf1(bf16_t u) { return __uint_as_float(((unsigned)u) << 16); }
__device__ __forceinline__ float ex2(float x) { return __builtin_amdgcn_exp2f(x); }
__device__ __forceinline__ float rcpf_(float x) { return __builtin_amdgcn_rcpf(x); }
__device__ __forceinline__ float sigm(float x) { return rcpf_(1.f + ex2(-1.44269504f * x)); }
__device__ __forceinline__ float gelu_tanh(float x) { const float u = 0.7978845608f * (x + 0.044715f * x * x * x); return x * rcpf_(1.f + ex2(-2.88539008f * u)); }
__device__ __forceinline__ float wave_sum(float v) {
#pragma unroll
    for (int o = 1; o < 64; o <<= 1) v += __shfl_xor(v, o);
    return v;
}
__device__ __forceinline__ int pi32(int r) { return (r & 0x13) | ((r & 4) << 1) | ((r & 8) >> 1); }
#define LDS_WAIT() asm volatile("s_waitcnt lgkmcnt(0)" ::: "memory")

namespace pg8 {
constexpr int BM = 256, BK = 64, HALF = 128, HTB = HALF * BK * 2, STAGE_BYTES = 8 * HTB, NXCD = 8, WGM = 8;
__device__ __forceinline__ int lds_byte(int r, int c) { const int st = (r >> 4) * 2 + (c >> 5), rr = r & 15, cc = c & 31, ob = rr * 64 + cc * 2; return st * 1024 + (ob ^ (((ob >> 9) & 1) << 5)); }
__device__ __forceinline__ void stage_rc(int b, int& R, int& C) { const int st = b / 1024, sb = b % 1024, swz = sb ^ (((sb >> 9) & 1) << 5); R = (st >> 1) * 16 + swz / 64; C = (st & 1) * 32 + (swz % 64) / 2; }
__device__ __forceinline__ int perm32(int rho) { const int n = rho >> 4, i = rho & 15; return 8 * (i >> 2) + 4 * n + (i & 3); }

struct Unit { int pm, pn, tag; long long aoff, boff; };
struct GemmDesc { const char* A; const char* Bt; int lda, ldb, kstepA, kstepB, nt; };

__device__ __forceinline__ void swz_tile(int L, int nM, int nN, int& pm, int& pn) {
    const int nwg = nM * nN; int wgid = L;
    { const int q = nwg / NXCD, r = nwg % NXCD, xcd = wgid % NXCD, off = wgid / NXCD; wgid = (xcd < r ? xcd * (q + 1) : r * (q + 1) + (xcd - r) * q) + off; }
    const int nig = WGM * nN, gid = wgid / nig, fm = gid * WGM, gsz = (nM - fm) < WGM ? (nM - fm) : WGM;
    pm = fm + ((wgid % nig) % gsz); pn = (wgid % nig) / gsz;
}
struct StdOrder {
    int nM, nN, G, c; long long tA, tB;
    __device__ void init(int M, int N, int G_, int c_, int lda, int ldb) { nM = M / BM; nN = N / BM; G = G_; c = c_; tA = 512LL * lda; tB = 512LL * ldb; }
    __device__ bool next(int i, Unit& u) const {
        const long long L = (long long)i * G + c; if (L >= (long long)nM * nN) return false;
        swz_tile((int)L, nM, nN, u.pm, u.pn); u.tag = 0; u.aoff = u.pm * tA; u.boff = u.pn * tB; return true;
    }
};
struct MergeOrder {
    int nM, nN, G, c; long long tA, tB;
    __device__ void init(int M, int N, int G_, int c_, int lda, int ldb) { nM = M / BM; nN = N / BM; G = G_; c = c_; tA = 512LL * lda; tB = 512LL * ldb; }
    __device__ bool next(int i, Unit& u) const {
        const int ti = i / 3, br = i - 3 * ti; const long long L = (long long)ti * G + c; if (L >= (long long)nM * nN) return false;
        swz_tile((int)L, nM, nN, u.pm, u.pn); u.tag = br; u.aoff = u.pm * tA + br * 1024; u.boff = u.pn * tB + br * 1024; return true;
    }
};
struct CmpOrder {
    int c;
    __device__ bool next(int i, Unit& u) const {
        if (i != 0 || c >= 32) return false;
        const int kv = c >> 4, bg = (c >> 2) & 3, tile = c & 3, b = bg >> 1, g = bg & 1;
        u.pm = c; u.pn = 0; u.tag = kv;
        u.aoff = 2LL * (((long long)b * S_ + 4096LL * tile) * PP + PC_KV + kv * 128 + g * 64);
        u.boff = (long long)kv * (256 * 2048 * 2); return true;
    }
};

__device__ __forceinline__ u32x4 pack8(f32x4 a, f32x4 b) { u32x4 w; w.x = cvt_pk_bf16(a[0], a[1]); w.y = cvt_pk_bf16(a[2], a[3]); w.z = cvt_pk_bf16(b[0], b[1]); w.w = cvt_pk_bf16(b[2], b[3]); return w; }
template <int MODE> struct Epi {
    bf16_t* O; int ldc; const bf16_t* G; const float* bias;
    __device__ __forceinline__ void operator()(const f32x4 (&acc)[2][2][4][2], const Unit& u, int wr, int wc, int fr, int fq) const {
        const int row0 = u.pm * BM + wr * 64 + fr;
        if constexpr (MODE == 1) {
            const int col0 = u.pn * 128 + wc * 32 + 8 * fq;
#pragma unroll
            for (int ai = 0; ai < 2; ++ai)
#pragma unroll
                for (int m = 0; m < 4; ++m) {
                    bf16_t* rowp = O + (size_t)(row0 + ai * HALF + m * 16) * ldc + col0;
                    f32x4 v0, v1;
#pragma unroll
                    for (int e = 0; e < 4; ++e) { const float a0 = acc[ai][0][m][0][e], a1 = acc[ai][0][m][1][e]; v0[e] = a0 * sigm(a0) * acc[ai][1][m][0][e]; v1[e] = a1 * sigm(a1) * acc[ai][1][m][1][e]; }
                    *(u32x4*)rowp = pack8(v0, v1);
                    __builtin_amdgcn_sched_barrier(0);
                }
        } else {
            const int col0 = u.pn * BM + wc * 32 + 8 * fq;
#pragma unroll
            for (int ai = 0; ai < 2; ++ai)
#pragma unroll
                for (int m = 0; m < 4; ++m) {
                    const size_t row = (size_t)(row0 + ai * HALF + m * 16);
#pragma unroll
                    for (int bj = 0; bj < 2; ++bj) {
                        const int col = col0 + bj * HALF;
                        f32x4 v0 = acc[ai][bj][m][0], v1 = acc[ai][bj][m][1];
                        bf16_t* dst = O + row * ldc + col;
                        if constexpr (MODE == 2) {
#pragma unroll
                            for (int e = 0; e < 4; ++e) { v0[e] = sigm(v0[e]); v1[e] = sigm(v1[e]); }
                        }
                        if constexpr (MODE == 4) {
                            const f32x4 b0 = *(const f32x4*)(bias + u.tag * 256 + col), b1 = *(const f32x4*)(bias + u.tag * 256 + col + 4);
#pragma unroll
                            for (int e = 0; e < 4; ++e) { v0[e] = gelu_tanh(v0[e] + b0[e]); v1[e] = gelu_tanh(v1[e] + b1[e]); }
                        }
                        if constexpr (MODE == 3) {
                            const u32x4 gv = *(const u32x4*)(G + row * GP + u.tag * 1024 + col);
                            v0[0] *= bf_lo(gv.x); v0[1] *= bf_hi(gv.x); v0[2] *= bf_lo(gv.y); v0[3] *= bf_hi(gv.y);
                            v1[0] *= bf_lo(gv.z); v1[1] *= bf_hi(gv.z); v1[2] *= bf_lo(gv.w); v1[3] *= bf_hi(gv.w);
                            if (u.tag > 0) {
                                const u32x4 ov = *(const u32x4*)dst;
                                v0[0] += bf_lo(ov.x); v0[1] += bf_hi(ov.x); v0[2] += bf_lo(ov.y); v0[3] += bf_hi(ov.y);
                                v1[0] += bf_lo(ov.z); v1[1] += bf_hi(ov.z); v1[2] += bf_lo(ov.w); v1[3] += bf_hi(ov.w);
                            }
                        }
                        *(u32x4*)dst = pack8(v0, v1);
                    }
                }
        }
    }
};

template <class EpiT, class Sched>
__device__ __forceinline__ void gemm_phase(LAS unsigned char* lds, int tid_in, const GemmDesc g, const Sched& S, const EpiT& E) {
    int tid_ = tid_in; asm volatile("" : "+v"(tid_));
    const int tid = tid_, wid = __builtin_amdgcn_readfirstlane(tid >> 6), lane = tid & 63, wr = wid >> 2, wc = wid & 3, fr = lane & 15, fq = lane >> 4;
    const int nt = g.nt;
    unsigned voffA[2], voffB[2];
#pragma unroll
    for (int i = 0; i < 2; ++i) { int R, C; stage_rc(tid * 16 + i * 8192, R, C); const int Rb = (R & ~31) + perm32(R & 31);
        voffA[i] = (unsigned)(R * g.lda + C) * 2u; voffB[i] = (unsigned)(Rb * g.ldb + C) * 2u; }
    const size_t kA = (size_t)g.kstepA, kB = (size_t)g.kstepB;
    const size_t hA = (size_t)HALF * g.lda * 2, hB = (size_t)HALF * g.ldb * 2;
    const unsigned ldsw = (unsigned)wid * 1024u;
    const int aoff = lds_byte(wr * 64 + fr, fq * 8), boff = lds_byte(wc * 32 + fr, fq * 8);
#define PG8_SA(b, h) (((b) * 2 + (h)) * HTB)
#define PG8_SB(b, h) ((4 + (b) * 2 + (h)) * HTB)
#define PG8_STAGE(bufoff, gbase, voff) do { _Pragma("unroll") for (int _i = 0; _i < 2; ++_i) \
        __builtin_amdgcn_global_load_lds((const unsigned*)((const char*)(gbase) + (voff)[_i]), (LAS unsigned*)(lds + (bufoff) + ldsw + _i * 8192), 16, 0, 0); } while (0)
#define PG8_LDA(dst, b, h) do { _Pragma("unroll") for (int m = 0; m < 4; ++m) _Pragma("unroll") for (int k = 0; k < 2; ++k) dst[m][k] = *(const LAS bf16x8*)(lds + PG8_SA(b, h) + aoff + m * 2048 + k * 1024); } while (0)
#define PG8_LDB(dst, b, h) do { _Pragma("unroll") for (int n = 0; n < 2; ++n) _Pragma("unroll") for (int k = 0; k < 2; ++k) dst[n][k] = *(const LAS bf16x8*)(lds + PG8_SB(b, h) + boff + n * 2048 + k * 1024); } while (0)
#define PG8_MMA(ai, bj, At, Bt) do { __builtin_amdgcn_s_setprio(1); _Pragma("unroll") for (int m = 0; m < 4; ++m) _Pragma("unroll") for (int n = 0; n < 2; ++n) _Pragma("unroll") for (int k = 0; k < 2; ++k) \
        acc[ai][bj][m][n] = __builtin_amdgcn_mfma_f32_16x16x32_bf16(Bt[n][k], At[m][k], acc[ai][bj][m][n], 0, 0, 0); __builtin_amdgcn_s_setprio(0); } while (0)
#define PG8_WAIT_V(n) asm volatile("s_waitcnt vmcnt(" #n ")" ::: "memory")
#define PG8_WAIT_L(n) asm volatile("s_waitcnt lgkmcnt(" #n ")" ::: "memory")
#define PG8_BAR __builtin_amdgcn_s_barrier()
#define PG8_SCHED __builtin_amdgcn_sched_barrier(0)
    Unit cur, nxt; int ui = 0;
    if (!S.next(0, cur)) return;
    f32x4 acc[2][2][4][2];
#pragma unroll
    for (int a = 0; a < 2; ++a)
#pragma unroll
        for (int b = 0; b < 2; ++b)
#pragma unroll
            for (int m = 0; m < 4; ++m)
#pragma unroll
                for (int n = 0; n < 2; ++n) acc[a][b][m][n] = (f32x4){0.f, 0.f, 0.f, 0.f};
    bf16x8 At[4][2], B0[2][2], B1[2][2];
    const char* cA = g.A + cur.aoff; const char* cB = g.Bt + cur.boff;
    PG8_STAGE(PG8_SB(0, 0), cB, voffB); PG8_STAGE(PG8_SB(0, 1), cB + hB, voffB); PG8_STAGE(PG8_SA(0, 0), cA, voffA); PG8_STAGE(PG8_SA(0, 1), cA + hA, voffA);
    if (wr == 1) PG8_BAR;
    PG8_WAIT_V(2); PG8_BAR;
    PG8_STAGE(PG8_SB(1, 0), cB + kB, voffB); PG8_STAGE(PG8_SA(1, 0), cA + kA, voffA); PG8_STAGE(PG8_SB(1, 1), cB + hB + kB, voffB);
    PG8_WAIT_V(6); PG8_BAR;
    for (;;) {
        const bool has_next = S.next(ui + 1, nxt);
        const char* nA = has_next ? g.A + nxt.aoff : cA; const char* nB = has_next ? g.Bt + nxt.boff : cB;
        for (int t = 0; t < nt; t += 2) {
            const bool last = (t == nt - 2);
            const char* a1 = cA + (size_t)(t + 1) * kA;
            const char* a2 = last ? nA : cA + (size_t)(t + 2) * kA; const char* b2 = last ? nB : cB + (size_t)(t + 2) * kB;
            const char* a3 = a2 + kA; const char* b3 = b2 + kB;
            PG8_LDB(B0, 0, 0); PG8_LDB(B1, 0, 1); PG8_SCHED; PG8_LDA(At, 0, 0); PG8_STAGE(PG8_SA(1, 1), a1 + hA, voffA);
            PG8_WAIT_V(8); PG8_WAIT_L(0); PG8_BAR; PG8_MMA(0, 0, At, B0); PG8_MMA(0, 1, At, B1); PG8_BAR; PG8_SCHED;
            PG8_LDA(At, 0, 1); PG8_STAGE(PG8_SB(0, 0), b2, voffB); PG8_STAGE(PG8_SB(0, 1), b2 + hB, voffB); PG8_STAGE(PG8_SA(0, 0), a2, voffA);
            PG8_WAIT_V(8); PG8_WAIT_L(0); PG8_BAR; PG8_MMA(1, 0, At, B0); PG8_MMA(1, 1, At, B1); PG8_BAR; PG8_SCHED;
            PG8_LDB(B0, 1, 0); PG8_LDB(B1, 1, 1); PG8_SCHED; PG8_LDA(At, 1, 0); PG8_STAGE(PG8_SA(0, 1), a2 + hA, voffA);
            PG8_WAIT_V(8); PG8_WAIT_L(0); PG8_BAR; PG8_MMA(0, 0, At, B0); PG8_MMA(0, 1, At, B1); PG8_BAR; PG8_SCHED;
            PG8_LDA(At, 1, 1); PG8_STAGE(PG8_SB(1, 0), b3, voffB); PG8_STAGE(PG8_SB(1, 1), b3 + hB, voffB); PG8_STAGE(PG8_SA(1, 0), a3, voffA);
            PG8_WAIT_V(8); PG8_WAIT_L(0); PG8_BAR; PG8_MMA(1, 0, At, B0); PG8_MMA(1, 1, At, B1); PG8_BAR; PG8_SCHED;
        }
        if (wr == 0) PG8_BAR;
        E(acc, cur, wr, wc, fr, fq);
        if (!has_next) break;
#pragma unroll
        for (int a = 0; a < 2; ++a)
#pragma unroll
            for (int b = 0; b < 2; ++b)
#pragma unroll
                for (int m = 0; m < 4; ++m)
#pragma unroll
                    for (int n = 0; n < 2; ++n) acc[a][b][m][n] = (f32x4){0.f, 0.f, 0.f, 0.f};
        cur = nxt; cA = nA; cB = nB; ++ui;
        if (wr == 1) PG8_BAR;
    }
    PG8_WAIT_V(0);
    PG8_BAR;
#undef PG8_SA
#undef PG8_SB
#undef PG8_STAGE
#undef PG8_LDA
#undef PG8_LDB
#undef PG8_MMA
#undef PG8_WAIT_V
#undef PG8_WAIT_L
#undef PG8_BAR
#undef PG8_SCHED
}
}

struct Args { const void* in[29]; float* out; unsigned char* ws; int ph_lo, ph_hi; };
static_assert(sizeof(Args) == 29 * 8 + 8 + 8 + 8, "Args has no padding");

typedef __attribute__((address_space(1))) unsigned char gu8;
struct Ctx {
    const Args* a; gu8* ws; LAS unsigned char* lds; int tid, lane, wave, G, gw, NGW;
};
#define INF(k, l, n) ((const float*)C.a->in[k] + (size_t)(l) * (n))

__device__ __forceinline__ void tr_item(const float* W, int ldw, int src_col, int nvalid, int k0, bf16_t* WT, int ldt, int dst_row, int dst_k, LAS float* scr, int lane) {
#pragma unroll 8
    for (int i = 0; i < 32; ++i) { const int kk = 2 * i + (lane >> 5), c = lane & 31; scr[kk * 33 + c] = (c < nvalid) ? W[(size_t)(k0 + kk) * ldw + src_col + c] : 0.f; }
    LDS_WAIT();
    const int c = lane & 7;
#pragma unroll
    for (int j = 0; j < 4; ++j) { const int n = (lane >> 3) + 8 * j; const LAS float* s = scr + (8 * c) * 33 + n;
        u32x4 o; o.x = cvt_pk_bf16(s[0 * 33], s[1 * 33]); o.y = cvt_pk_bf16(s[2 * 33], s[3 * 33]); o.z = cvt_pk_bf16(s[4 * 33], s[5 * 33]); o.w = cvt_pk_bf16(s[6 * 33], s[7 * 33]);
        *(u32x4*)(WT + (size_t)(dst_row + n) * ldt + dst_k + k0 + 8 * c) = o; }
    LDS_WAIT();
}

__device__ __forceinline__ void convert_layer(const Ctx& C, int l) {
    LAS float* scr = (LAS float*)(C.lds + C.wave * 8448);
    gu8* ws = C.ws; const int lane = C.lane;
    constexpr int NITEMS = 2816 + 1408 + 1792 + 1536 + 768 + 512 + 2816 + 1408 + 256 + 256 + 512;
    for (int it = C.gw; it < NITEMS; it += C.NGW) {
        int r = it;
        if (r < 2816) { const int kb = r / 176, nb = r % 176, tile = nb >> 3, w = nb & 7, src = (w >> 2) * FF + tile * 128 + (w & 3) * 32;
            tr_item(INF(5, l, DM * 2 * FF), 2 * FF, src, 32, kb * 64, (bf16_t*)(ws + WS_W1IN), DM, nb * 32, 0, scr, lane); continue; } r -= 2816;
        if (r < 1408) { const int kb = r / 32, nb = r % 32;
            tr_item(INF(6, l, FF * DM), DM, nb * 32, 32, kb * 64, (bf16_t*)(ws + WS_W1OUT), FF, nb * 32, 0, scr, lane); continue; } r -= 1408;
        if (r < 1792) { const int kb = r / 112, nb = r % 112; int src = 0, nv = 0;
            if (nb < 88) { src = nb * 32; nv = 32; } else if (nb < 104) { src = 2840 + (nb - 88) * 32; nv = 32; } else if (nb == 104) { src = 2816; nv = 24; }
            tr_item(INF(10, l, DM * 6424), 6424, src, nv, kb * 64, (bf16_t*)(ws + WS_WMIX), DM, nb * 32, 0, scr, lane); continue; } r -= 1792;
        if (r < 1536) { const int kb = r / 96, nb = r % 96;
            tr_item(INF(10, l, DM * 6424), 6424, 3352 + nb * 32, 32, kb * 64, (bf16_t*)(ws + WS_WG), DM, nb * 32, 0, scr, lane); continue; } r -= 1536;
        if (r < 768) { const int br = r / 256, q = r % 256, kb = q / 32, nb = q % 32;
            const float* W = br == 0 ? INF(21, l, 512 * DM) : (br == 1 ? INF(22, l, 512 * DM) : INF(23, l, 512 * DM));
            tr_item(W, DM, nb * 32, 32, kb * 64, (bf16_t*)(ws + WS_WBR), YP, nb * 32, br * 512, scr, lane); continue; } r -= 768;
        if (r < 512) { const int kb = r / 32, nb = r % 32;
            tr_item(INF(24, l, DM * DM), DM, nb * 32, 32, kb * 64, (bf16_t*)(ws + WS_WOUT), DM, nb * 32, 0, scr, lane); continue; } r -= 512;
        if (r < 2816) { const int kb = r / 176, nb = r % 176, tile = nb >> 3, w = nb & 7, src = (w >> 2) * FF + tile * 128 + (w & 3) * 32;
            tr_item(INF(27, l, DM * 2 * FF), 2 * FF, src, 32, kb * 64, (bf16_t*)(ws + WS_W2IN), DM, nb * 32, 0, scr, lane); continue; } r -= 2816;
        if (r < 1408) { const int kb = r / 32, nb = r % 32;
            tr_item(INF(28, l, FF * DM), DM, nb * 32, 32, kb * 64, (bf16_t*)(ws + WS_W2OUT), FF, nb * 32, 0, scr, lane); continue; } r -= 1408;
        if (r < 256) { const int kb = r / 8, nb = r % 8;
            tr_item(INF(14, l, 2048 * 256), 256, nb * 32, 32, kb * 64, (bf16_t*)(ws + WS_WC1), 2048, nb * 32, 0, scr, lane); continue; } r -= 256;
        if (r < 256) { const int kb = r / 8, nb = r % 8;
            tr_item(INF(17, l, 2048 * 256), 256, nb * 32, 32, kb * 64, (bf16_t*)(ws + WS_WC1 + MiB), 2048, nb * 32, 0, scr, lane); continue; } r -= 256;
        { const int kb = r / 32, nb = r % 32;
            tr_item(INF(20, l, DM * DM), DM, nb * 32, 32, kb * 64, (bf16_t*)(ws + WS_WMKV), DM, nb * 32, 0, scr, lane); }
    }
    {
        const float* gm = INF(9, l, DM);
        for (int m = C.gw; m < 512; m += C.NGW) {
            const f32x4* xr = (const f32x4*)((const float*)C.a->in[1] + (size_t)m * DM) + lane;
            f32x4 v[4]; float s = 0.f;
#pragma unroll
            for (int j = 0; j < 4; ++j) { v[j] = xr[64 * j]; s += (v[j].x * v[j].x + v[j].y * v[j].y) + (v[j].z * v[j].z + v[j].w * v[j].w); }
            const float rstd = rsqrtf(wave_sum(s) * (1.f / DM) + EPS);
            u32x2* o = (u32x2*)((bf16_t*)(ws + WS_MEMN) + (size_t)m * DM) + lane;
#pragma unroll
            for (int j = 0; j < 4; ++j) { const f32x4 gg = ((const f32x4*)gm)[lane + 64 * j]; u32x2 w; w.x = cvt_pk_bf16(v[j].x * rstd * gg.x, v[j].y * rstd * gg.y); w.y = cvt_pk_bf16(v[j].z * rstd * gg.z, v[j].w * rstd * gg.w); o[64 * j] = w; }
        }
    }
    {
        float* cb = (float*)(ws + WS_CBP) + (size_t)l * 64 * 256;
        for (int it = C.gw; it < 64; it += C.NGW) {
            const int kv = it >> 5, ch = it & 31;
            const float* pos = kv ? INF(13, l, 2048) : INF(12, l, 2048);
            const float* w1 = kv ? INF(17, l, 2048 * 256) : INF(14, l, 2048 * 256);
            float p[4] = {0.f, 0.f, 0.f, 0.f};
            for (int k = ch * 64; k < ch * 64 + 64; ++k) { const float pv = pos[k];
#pragma unroll
                for (int q = 0; q < 4; ++q) p[q] += pv * w1[(size_t)k * 256 + lane + 64 * q]; }
#pragma unroll
            for (int q = 0; q < 4; ++q) cb[(size_t)it * 256 + lane + 64 * q] = p[q];
        }
    }
}

__device__ __forceinline__ void rope_table(const Ctx& C) {
    const int* pos = (const int*)C.a->in[2];
    float* tab = (float*)(C.ws + WS_ROPE);
    const float invf[8] = {1.0f, 0.1939227432012558f, 0.03760603070259094f, 0.007292664609849453f, 0.0014142135623842478f, 0.00027424818836152554f, 5.318296098266728e-05f, 1.0313386155758053e-05f};
    for (int e = C.gw * 64 + C.lane; e < T_ * 8; e += C.NGW * 64) {
        const int tok = e >> 3, i = e & 7;
        float f = invf[0];
#pragma unroll
        for (int q = 1; q < 8; ++q) f = (i == q) ? invf[q] : f;
        const float ang = (float)pos[tok] * f;
        const double rev = (double)ang * 0.15915494309189535; const float fr = (float)(rev - floor(rev));
        tab[(size_t)tok * 16 + i] = __builtin_amdgcn_cosf(fr); tab[(size_t)tok * 16 + 8 + i] = __builtin_amdgcn_sinf(fr);
    }
}
__device__ __forceinline__ void prenorm_rows(const Ctx& C, const float* x, const float* g, bf16_t* h) {
    for (int m = C.gw; m < T_; m += C.NGW) {
        const f32x4* xr = (const f32x4*)(x + (size_t)m * DM) + C.lane;
        f32x4 v[4]; float s = 0.f;
#pragma unroll
        for (int j = 0; j < 4; ++j) { v[j] = xr[64 * j]; s += (v[j].x * v[j].x + v[j].y * v[j].y) + (v[j].z * v[j].z + v[j].w * v[j].w); }
        const float rstd = rsqrtf(wave_sum(s) * (1.f / DM) + EPS);
        u32x2* o = (u32x2*)(h + (size_t)m * DM) + C.lane;
#pragma unroll
        for (int j = 0; j < 4; ++j) { const f32x4 gg = ((const f32x4*)g)[C.lane + 64 * j]; u32x2 w; w.x = cvt_pk_bf16(v[j].x * rstd * gg.x, v[j].y * rstd * gg.y); w.y = cvt_pk_bf16(v[j].z * rstd * gg.z, v[j].w * rstd * gg.w); o[64 * j] = w; }
    }
}
__device__ __forceinline__ void norm_phase(const Ctx& C, int w0, int nw, const float* xin, float* xout, const bf16_t* y, bf16_t* h, const float* gpost, const float* gpre, float coef) {
    for (int m0 = w0; m0 < T_; m0 += 2 * nw) {
        f32x4 xv[2][4]; u32x2 yw[2][4];
#pragma unroll
        for (int r = 0; r < 2; ++r) { const int m = (m0 + r * nw < T_) ? m0 + r * nw : m0; const f32x4* xr = (const f32x4*)(xin + (size_t)m * DM) + C.lane; const u32x2* yr = (const u32x2*)(y + (size_t)m * DM) + C.lane;
#pragma unroll
            for (int j = 0; j < 4; ++j) { xv[r][j] = xr[64 * j]; yw[r][j] = yr[64 * j]; } }
#pragma unroll
        for (int r = 0; r < 2; ++r) {
            const int m = m0 + r * nw; if (m >= T_) break;
            f32x4 yv[4]; float s = 0.f;
#pragma unroll
            for (int j = 0; j < 4; ++j) { const u32x2 w = yw[r][j]; yv[j] = (f32x4){bf_lo(w.x), bf_hi(w.x), bf_lo(w.y), bf_hi(w.y)};
                s += (yv[j].x * yv[j].x + yv[j].y * yv[j].y) + (yv[j].z * yv[j].z + yv[j].w * yv[j].w); }
            const float rs = rsqrtf(wave_sum(s) * (1.f / DM) + EPS) * coef; float s2 = 0.f;
            f32x4* xo = (f32x4*)(xout + (size_t)m * DM) + C.lane;
#pragma unroll
            for (int j = 0; j < 4; ++j) { const f32x4 gg = ((const f32x4*)gpost)[C.lane + 64 * j]; xv[r][j] = xv[r][j] + yv[j] * gg * rs; xo[64 * j] = xv[r][j];
                s2 += (xv[r][j].x * xv[r][j].x + xv[r][j].y * xv[r][j].y) + (xv[r][j].z * xv[r][j].z + xv[r][j].w * xv[r][j].w); }
            if (gpre) {
                const float r2 = rsqrtf(wave_sum(s2) * (1.f / DM) + EPS);
                u32x2* o = (u32x2*)(h + (size_t)m * DM) + C.lane;
#pragma unroll
                for (int j = 0; j < 4; ++j) { const f32x4 gg = ((const f32x4*)gpre)[C.lane + 64 * j]; u32x2 w; w.x = cvt_pk_bf16(xv[r][j].x * r2 * gg.x, xv[r][j].y * r2 * gg.y); w.y = cvt_pk_bf16(xv[r][j].z * r2 * gg.z, xv[r][j].w * r2 * gg.w); o[64 * j] = w; }
            }
        }
    }
}
__device__ __forceinline__ void cb_reduce(const Ctx& C, int l) {
    const int e = C.gw * 64 + C.lane;
    if (e < 512) { const int kv = e >> 8, n = e & 255; const float* pp = (const float*)(C.ws + WS_CBP) + (size_t)l * 64 * 256 + (size_t)kv * 32 * 256 + n;
        float s = (kv ? INF(18, l, 256) : INF(15, l, 256))[n];
        for (int ch = 0; ch < 32; ++ch) s += pp[ch * 256];
        ((float*)(C.ws + WS_CB))[l * 512 + e] = s; }
}
__device__ __forceinline__ void memkv_ops(const Ctx& C, int w0, int nw) {
    const bf16_t* src = (const bf16_t*)(C.ws + WS_MKV); bf16_t* ko = (bf16_t*)(C.ws + WS_MEMK); bf16_t* vo = (bf16_t*)(C.ws + WS_MEMV);
    for (int e = w0 * 64 + C.lane; e < 512 * 1024; e += nw * 64) {
        const int mr = e >> 10, col = e & 1023, kv = col >> 9, hm = (col >> 7) & 3, d = col & 127, b = mr >> 8, m = mr & 255;
        const bf16_t v = src[e];
        if (kv == 0) ko[((size_t)((((b * 4 + hm) * 8 + (m >> 5)) * 8 + (d >> 4)) * 64 + pi32(m & 31) + 32 * ((d >> 3) & 1))) * 8 + (d & 7)] = v;
        else vo[((size_t)((((b * 4 + hm) * 16 + (m >> 4)) * 4 + (d >> 5)) * 64 + (d & 31) + 32 * ((m >> 3) & 1))) * 8 + (m & 7)] = v;
    }
}

__device__ __forceinline__ void prep_items(const Ctx& C, int l, int w0, int nw) {
    const bf16_t* P = (const bf16_t*)(C.ws + WS_R1); bf16_t* Y = (bf16_t*)(C.ws + WS_Y);
    const int lane = C.lane;
    {
        const float* cw = INF(11, l, 3 * 512);
        float w[3][8];
#pragma unroll
        for (int k = 0; k < 3; ++k)
#pragma unroll
            for (int e = 0; e < 8; ++e) w[k][e] = cw[k * 512 + lane * 8 + e];
        for (int it = w0; it < T_ / 8; it += nw) {
            const int tok0 = it * 8, s0 = tok0 & (S_ - 1);
            float c1[8], c2[8];
#pragma unroll
            for (int e = 0; e < 8; ++e) { c1[e] = 0.f; c2[e] = 0.f; }
            if (s0 > 0) {
#pragma unroll
                for (int back = 2; back >= 1; --back) {
                    const bf16_t* row = P + (size_t)(tok0 - back) * PP + lane * 8;
                    const u32x4 u = *(const u32x4*)row, cc = *(const u32x4*)(row + 1024);
                    float t[8] = {bf_lo(u.x) * bf_lo(cc.x), bf_hi(u.x) * bf_hi(cc.x), bf_lo(u.y) * bf_lo(cc.y), bf_hi(u.y) * bf_hi(cc.y), bf_lo(u.z) * bf_lo(cc.z), bf_hi(u.z) * bf_hi(cc.z), bf_lo(u.w) * bf_lo(cc.w), bf_hi(u.w) * bf_hi(cc.w)};
#pragma unroll
                    for (int e = 0; e < 8; ++e) { if (back == 2) c2[e] = t[e]; else c1[e] = t[e]; }
                }
            }
#pragma unroll
            for (int tt = 0; tt < 8; ++tt) {
                const bf16_t* row = P + (size_t)(tok0 + tt) * PP + lane * 8;
                const u32x4 u = *(const u32x4*)row, bb = *(const u32x4*)(row + 512), cc = *(const u32x4*)(row + 1024);
                const float c0[8] = {bf_lo(u.x) * bf_lo(cc.x), bf_hi(u.x) * bf_hi(cc.x), bf_lo(u.y) * bf_lo(cc.y), bf_hi(u.y) * bf_hi(cc.y), bf_lo(u.z) * bf_lo(cc.z), bf_hi(u.z) * bf_hi(cc.z), bf_lo(u.w) * bf_lo(cc.w), bf_hi(u.w) * bf_hi(cc.w)};
                const float bv[8] = {bf_lo(bb.x), bf_hi(bb.x), bf_lo(bb.y), bf_hi(bb.y), bf_lo(bb.z), bf_hi(bb.z), bf_lo(bb.w), bf_hi(bb.w)};
                float o[8];
#pragma unroll
                for (int e = 0; e < 8; ++e) { o[e] = bv[e] * (w[0][e] * c2[e] + w[1][e] * c1[e] + w[2][e] * c0[e]); c2[e] = c1[e]; c1[e] = c0[e]; }
                u32x4 ov; ov.x = cvt_pk_bf16(o[0], o[1]); ov.y = cvt_pk_bf16(o[2], o[3]); ov.z = cvt_pk_bf16(o[4], o[5]); ov.w = cvt_pk_bf16(o[6], o[7]);
                *(u32x4*)(Y + (size_t)(tok0 + tt) * YP + lane * 8) = ov;
            }
        }
    }
    {
        const float* rope = (const float*)(C.ws + WS_ROPE);
        LAS bf16_t* vt = (LAS bf16_t*)(C.lds + C.wave * 4608);
        const int hi = lane >> 5, dl = lane & 31;
        for (int it = w0; it < 4 * 512; it += nw) {
            const int bg = it >> 9, tile = it & 511, b = bg >> 1, g = bg & 1;
            const size_t tokb = (size_t)b * S_ + 32 * tile;
#pragma unroll
            for (int which = 0; which < 2; ++which) {
                const int kc = PC_KV + (2 + 2 * which) * 128 + g * 64, vc = kc + 128;
                bf16_t* kop = (bf16_t*)(C.ws + (which ? WS_KWIN : WS_KSLC)); bf16_t* vop = (bf16_t*)(C.ws + (which ? WS_VWIN : WS_VSLC));
#pragma unroll
                for (int q = 0; q < 4; ++q) {
                    const int r = (lane >> 3) + 8 * q, c = lane & 7;
                    const bf16_t* row = P + (tokb + r) * PP;
                    u32x4 kv = *(const u32x4*)(row + kc + 8 * c);
                    if (c < 2) {
                        const u32x4 pv = *(const u32x4*)(row + kc + 8 * (c ^ 1));
                        const float* rt = rope + (tokb + r) * 16;
                        const f32x4 ca = *(const f32x4*)rt, cb2 = *(const f32x4*)(rt + 4), sa = *(const f32x4*)(rt + 8), sb = *(const f32x4*)(rt + 12);
                        const float cs[8] = {ca.x, ca.y, ca.z, ca.w, cb2.x, cb2.y, cb2.z, cb2.w}, sn[8] = {sa.x, sa.y, sa.z, sa.w, sb.x, sb.y, sb.z, sb.w};
                        const float mv[8] = {bf_lo(kv.x), bf_hi(kv.x), bf_lo(kv.y), bf_hi(kv.y), bf_lo(kv.z), bf_hi(kv.z), bf_lo(kv.w), bf_hi(kv.w)};
                        const float pp[8] = {bf_lo(pv.x), bf_hi(pv.x), bf_lo(pv.y), bf_hi(pv.y), bf_lo(pv.z), bf_hi(pv.z), bf_lo(pv.w), bf_hi(pv.w)};
                        const float sg = (c == 0) ? -1.f : 1.f; float o[8];
#pragma unroll
                        for (int e = 0; e < 8; ++e) o[e] = mv[e] * cs[e] + sg * pp[e] * sn[e];
                        kv.x = cvt_pk_bf16(o[0], o[1]); kv.y = cvt_pk_bf16(o[2], o[3]); kv.z = cvt_pk_bf16(o[4], o[5]); kv.w = cvt_pk_bf16(o[6], o[7]);
                    }
                    *(u32x4*)(kop + ((size_t)((bg * 512 + tile) * 4 + (c >> 1)) * 64 + pi32(r) + 32 * (c & 1)) * 8) = kv;
                    const u32x4 vv = *(const u32x4*)(row + vc + 8 * c);
                    *(LAS u32x4*)(vt + r * 72 + 8 * c) = vv;
                }
                LDS_WAIT();
#pragma unroll
                for (int o4 = 0; o4 < 4; ++o4) {
                    const int ks = o4 >> 1, dt = o4 & 1;
                    const LAS bf16_t* sp = vt + (16 * ks + 8 * hi) * 72 + 32 * dt + dl;
                    u32x4 o; o.x = (unsigned)sp[0] | ((unsigned)sp[72] << 16); o.y = (unsigned)sp[144] | ((unsigned)sp[216] << 16); o.z = (unsigned)sp[288] | ((unsigned)sp[360] << 16); o.w = (unsigned)sp[432] | ((unsigned)sp[504] << 16);
                    *(u32x4*)(vop + ((size_t)((bg * 1024 + 2 * tile + ks) * 2 + dt) * 64 + lane) * 8) = o;
                }
                LDS_WAIT();
            }
        }
    }
}

__device__ __forceinline__ void cmp_stage2(const Ctx& C, int l) {
    const int bxx = C.gw / NWAVES, kv = bxx & 1, wi = bxx >> 1, nwg2 = (C.G + 1 - kv) >> 1;
    const float* w2 = kv ? INF(19, l, 256 * 64) : INF(16, l, 256 * 64);
    LAS float* ws2 = (LAS float*)C.lds;
    for (int e = C.tid; e < 256 * 64 / 4; e += NWAVES * 64) ((LAS f32x4*)ws2)[e] = ((const f32x4*)w2)[e];
    __syncthreads();
    const bf16_t* hid = (const bf16_t*)(C.ws + WS_CMPH) + (size_t)kv * 4096 * 256;
    bf16_t* ko = (bf16_t*)(C.ws + WS_KCMP); bf16_t* vo = (bf16_t*)(C.ws + WS_VCMP);
    const int d = C.lane;
    for (int row = wi * NWAVES + C.wave; row < 4096; row += nwg2 * NWAVES) {
        asm volatile("" ::: "memory");
        const u32x2 hv = *((const u32x2*)(hid + (size_t)row * 256) + C.lane);
        const float h0 = bf_lo(hv.x), h1 = bf_hi(hv.x), h2 = bf_lo(hv.y), h3 = bf_hi(hv.y);
        float acc = 0.f;
#pragma unroll 4
        for (int k = 0; k < 64; ++k) {
            const float a0 = __int_as_float(__builtin_amdgcn_readlane(__float_as_int(h0), k)), a1 = __int_as_float(__builtin_amdgcn_readlane(__float_as_int(h1), k));
            const float a2 = __int_as_float(__builtin_amdgcn_readlane(__float_as_int(h2), k)), a3 = __int_as_float(__builtin_amdgcn_readlane(__float_as_int(h3), k));
            acc += a0 * ws2[(4 * k + 0) * 64 + d]; acc += a1 * ws2[(4 * k + 1) * 64 + d]; acc += a2 * ws2[(4 * k + 2) * 64 + d]; acc += a3 * ws2[(4 * k + 3) * 64 + d];
        }
        const int bg = row >> 10, n = row & 1023;
        if (n == 1023) acc = 0.f;
        const bf16_t o = (bf16_t)(cvt_pk_bf16(acc, 0.f) & 0xffffu);
        if (kv == 0) ko[((size_t)((bg * 32 + (n >> 5)) * 4 + (d >> 4)) * 64 + pi32(n & 31) + 32 * ((d >> 3) & 1)) * 8 + (d & 7)] = o;
        else vo[((size_t)((bg * 64 + (n >> 4)) * 2 + (d >> 5)) * 64 + (d & 31) + 32 * ((n >> 3) & 1)) * 8 + (n & 7)] = o;
    }
    __syncthreads();
}

__device__ __forceinline__ float xhalf_max(float v) { const auto r = __builtin_amdgcn_permlane32_swap(__float_as_uint(v), __float_as_uint(v), false, false); return fmaxf(__uint_as_float(r[0]), __uint_as_float(r[1])); }
__device__ __forceinline__ float xhalf_sum(float v) { const auto r = __builtin_amdgcn_permlane32_swap(__float_as_uint(v), __float_as_uint(v), false, false); return __uint_as_float(r[0]) + __uint_as_float(r[1]); }
__device__ __forceinline__ f32x16 mfma32(bf16x8 a, bf16x8 b, f32x16 c) { return __builtin_amdgcn_mfma_f32_32x32x16_bf16(a, b, c, 0, 0, 0); }
__device__ __forceinline__ float dpp_xor1(float v) { return __int_as_float(__builtin_amdgcn_update_dpp(0, __float_as_int(v), 0xB1, 0xF, 0xF, true)); }
__device__ __forceinline__ float dpp_xor2(float v) { return __int_as_float(__builtin_amdgcn_update_dpp(0, __float_as_int(v), 0x4E, 0xF, 0xF, true)); }
__device__ __forceinline__ bf16x8 pack_p(const float* p) { u32x4 w; w.x = cvt_pk_bf16(p[0], p[1]); w.y = cvt_pk_bf16(p[2], p[3]); w.z = cvt_pk_bf16(p[4], p[5]); w.w = cvt_pk_bf16(p[6], p[7]); return __builtin_bit_cast(bf16x8, w); }
__device__ __forceinline__ bf16x8 scale_q(u32x4 v, float s) { u32x4 w; w.x = cvt_pk_bf16(bf_lo(v.x) * s, bf_hi(v.x) * s); w.y = cvt_pk_bf16(bf_lo(v.y) * s, bf_hi(v.y) * s); w.z = cvt_pk_bf16(bf_lo(v.z) * s, bf_hi(v.z) * s); w.w = cvt_pk_bf16(bf_lo(v.w) * s, bf_hi(v.w) * s); return __builtin_bit_cast(bf16x8, w); }
#define KREL(i, hi) (8 * (hi) + (i) + (((i) >= 8) ? 8 : 0))

__device__ __forceinline__ void flash_load(const bf16x8* kp, const bf16x8* vp, bf16x8 (&kf)[4], bf16x8 (&vf)[4]) {
#pragma unroll
    for (int s = 0; s < 4; ++s) kf[s] = kp[s * 64];
#pragma unroll
    for (int s = 0; s < 4; ++s) vf[s] = vp[s * 64];
    __builtin_amdgcn_sched_barrier(0);
}
__device__ __forceinline__ void flash_compute(bool domask, const bf16x8 (&kf)[4], const bf16x8 (&vf)[4], const bf16x8 (&q)[4], int x0, unsigned span, float& m, float& l, f32x16 (&O)[2]) {
    f32x16 sc;
#pragma unroll
    for (int i = 0; i < 16; ++i) sc[i] = 0.f;
#pragma unroll
    for (int s = 0; s < 4; ++s) sc = mfma32(kf[s], q[s], sc);
    if (domask) {
#pragma unroll
        for (int i = 0; i < 16; ++i) sc[i] = ((unsigned)(x0 + i + (i >= 8 ? 8 : 0)) <= span) ? sc[i] : -1e30f;
    }
    const float a0 = fmaxf(fmaxf(sc[0], sc[1]), sc[2]), a1 = fmaxf(fmaxf(sc[3], sc[4]), sc[5]), a2 = fmaxf(fmaxf(sc[6], sc[7]), sc[8]), a3 = fmaxf(fmaxf(sc[9], sc[10]), sc[11]), a4 = fmaxf(fmaxf(sc[12], sc[13]), sc[14]);
    float mx = fmaxf(fmaxf(fmaxf(a0, a1), fmaxf(a2, a3)), fmaxf(a4, sc[15]));
    mx = xhalf_max(mx);
    const float mn = fmaxf(m, mx);
    if (__ballot(mn > m) != 0ull) {
        const float alpha = ex2(m - mn); l *= alpha; O[0] = O[0] * alpha; O[1] = O[1] * alpha;
    }
    m = mn;
    const float msub = (mn < -1e29f) ? 0.f : mn;
    const f32x16 d = sc - msub;
    float p[16], ps = 0.f;
#pragma unroll
    for (int i = 0; i < 16; ++i) { p[i] = ex2(d[i]); ps += p[i]; }
    l += ps;
    const bf16x8 pb0 = pack_p(p), pb1 = pack_p(p + 8);
    O[0] = mfma32(vf[0], pb0, O[0]); O[1] = mfma32(vf[1], pb0, O[1]);
    O[0] = mfma32(vf[2], pb1, O[0]); O[1] = mfma32(vf[3], pb1, O[1]);
}
template <int MODE> __device__ __forceinline__ void flash_desc(int s, const LAS unsigned* list, int base, int t, int t0, int qi, int hi, int& tile, int& x0, unsigned& span, int& vm) {
    if constexpr (MODE == 0) {
        const unsigned e = (unsigned)__builtin_amdgcn_readfirstlane((int)list[s >> 1]);
        tile = 2 * (int)(e & 0xffffu) + (s & 1);
        const bool my = ((e >> 16) >> qi) & 1u; const int up = my ? (t - 32 * tile) : -1;
        x0 = up < 0 ? 64 : 8 * hi; span = up < 0 ? 0u : (unsigned)up;
        vm = (32 * tile + 31 <= t0) ? (((e >> 16) == 0xFFu) ? 0 : 1) : 2;
    } else {
        tile = base + s; x0 = 8 * hi - (t - 511 - 32 * tile); span = 511u;
        vm = (32 * tile + 31 <= t0 && 32 * tile >= t0 + 7 - 511) ? 0 : 2;
    }
}
template <int MODE> __device__ __forceinline__ void flash_run(const bf16x8* kb, const bf16x8* vb, const bf16x8 (&q)[4], int nsteps, const LAS unsigned* list, int base, int t, int t0, int qi, int hi, float& m, float& l, f32x16 (&O)[2]) {
    if (nsteps <= 0) return;
    bf16x8 kA[4], vA[4], kB[4], vB[4], kC[4], vC[4]; int x0A, x0B, x0C, vmA, vmB, vmC; unsigned spA, spB, spC;
#define FR_LOAD(S, KF, VF, X0, SP, VM) do { int tile_; const int sn_ = ((S) < nsteps) ? (S) : nsteps - 1; flash_desc<MODE>(sn_, list, base, t, t0, qi, hi, tile_, X0, SP, VM); \
        flash_load(kb + (size_t)tile_ * 256, vb + (size_t)tile_ * 256, KF, VF); } while (0)
    FR_LOAD(0, kA, vA, x0A, spA, vmA); FR_LOAD(1, kB, vB, x0B, spB, vmB);
#pragma unroll 1
    for (int s = 0; s < nsteps; s += 3) {
        FR_LOAD(s + 2, kC, vC, x0C, spC, vmC); flash_compute(vmA != 0, kA, vA, q, x0A, spA, m, l, O); if (s + 1 >= nsteps) break;
        FR_LOAD(s + 3, kA, vA, x0A, spA, vmA); flash_compute(vmB != 0, kB, vB, q, x0B, spB, m, l, O); if (s + 2 >= nsteps) break;
        FR_LOAD(s + 4, kB, vB, x0B, spB, vmB); flash_compute(vmC != 0, kC, vC, q, x0C, spC, m, l, O);
    }
#undef FR_LOAD
}

__device__ __forceinline__ unsigned wave_max_u32(unsigned v) {
#pragma unroll
    for (int o = 1; o < 16; o <<= 1) { const unsigned t = (unsigned)__shfl_xor((int)v, o); v = v > t ? v : t; }
    { const auto r = __builtin_amdgcn_permlane16_swap(v, v, false, false); v = r[0] > r[1] ? r[0] : r[1]; }
    { const auto r = __builtin_amdgcn_permlane32_swap(v, v, false, false); v = r[0] > r[1] ? r[0] : r[1]; }
    return v;
}

__device__ __forceinline__ void nsa_tile(const Ctx& C, int b, int g, int t0) {
    const bf16_t* P = (const bf16_t*)(C.ws + WS_R1); bf16_t* Y = (bf16_t*)(C.ws + WS_Y);
    const int lane = C.lane, r = lane & 31, hi = lane >> 5, qi = r >> 2, h = r & 3, head = g * 4 + h, bg = b * 2 + g;
    const int t = t0 + qi; const size_t tok = (size_t)b * S_ + t;
    LAS float* imp = (LAS float*)(C.lds + C.wave * 16640);
    LAS float* ost = (LAS float*)(C.lds + C.wave * 16640 + 8448) + lane;
    const float QS = 0.18033688011112042f;
    bf16x8 qf[4], qr[4];
    {
        const bf16_t* qp = P + tok * PP + PC_Q + head * 64;
#pragma unroll
        for (int s = 0; s < 4; ++s) qf[s] = scale_q(*(const u32x4*)(qp + 16 * s + 8 * hi), QS);
        const u32x4 mv4 = *(const u32x4*)(qp + 8 * hi), pv4 = *(const u32x4*)(qp + 8 * (hi ^ 1));
        const float* rt = (const float*)(C.ws + WS_ROPE) + tok * 16;
        const f32x4 ca = *(const f32x4*)rt, cb2 = *(const f32x4*)(rt + 4), sa = *(const f32x4*)(rt + 8), sb = *(const f32x4*)(rt + 12);
        const float cs[8] = {ca.x, ca.y, ca.z, ca.w, cb2.x, cb2.y, cb2.z, cb2.w}, sn[8] = {sa.x, sa.y, sa.z, sa.w, sb.x, sb.y, sb.z, sb.w};
        const float mv[8] = {bf_lo(mv4.x), bf_hi(mv4.x), bf_lo(mv4.y), bf_hi(mv4.y), bf_lo(mv4.z), bf_hi(mv4.z), bf_lo(mv4.w), bf_hi(mv4.w)};
        const float pp[8] = {bf_lo(pv4.x), bf_hi(pv4.x), bf_lo(pv4.y), bf_hi(pv4.y), bf_lo(pv4.z), bf_hi(pv4.z), bf_lo(pv4.w), bf_hi(pv4.w)};
        const float sg = hi ? 1.f : -1.f; float o[8];
#pragma unroll
        for (int e = 0; e < 8; ++e) o[e] = (mv[e] * cs[e] + sg * pp[e] * sn[e]) * QS;
        qr[0] = pack_p(o); qr[1] = qf[1]; qr[2] = qf[2]; qr[3] = qf[3];
    }
    const bf16_t* gp = P + tok * PP + PC_NG + head * 3;
    const float gc = sigm(bf1(gp[0])), gs = sigm(bf1(gp[1])), gw = sigm(bf1(gp[2]));

    const int cur = t0 >> 6;
    {
        const int nvq = (t >= 31) ? ((t - 31) >> 4) + 1 : 0;
        const int tl = t0 + 7, nvmax = (tl >= 31) ? ((tl - 31) >> 4) + 1 : 0, ntile = (nvmax + 31) >> 5;
        const bf16x8* kb = (const bf16x8*)(C.ws + WS_KCMP) + (size_t)bg * 32 * 4 * 64 + lane;
        const bf16x8* vb = (const bf16x8*)(C.ws + WS_VCMP) + (size_t)bg * 64 * 2 * 64 + lane;
        float m1 = -1e30f, l1 = 0.f;
#define CMP_P1(KF, KT) do { \
            f32x16 sc; _Pragma("unroll") for (int i = 0; i < 16; ++i) sc[i] = 0.f; \
            _Pragma("unroll") for (int s = 0; s < 4; ++s) sc = mfma32(KF[s], qf[s], sc); \
            const int up = nvq - 1 - 32 * (KT); const int x0 = up < 0 ? 64 : 8 * hi; const unsigned span = up < 0 ? 0u : (unsigned)up; \
            float mx = -1e30f; bool ok[16]; \
            _Pragma("unroll") for (int i = 0; i < 16; ++i) { ok[i] = (unsigned)(x0 + i + (i >= 8 ? 8 : 0)) <= span; sc[i] = ok[i] ? sc[i] : -1e30f; mx = fmaxf(mx, sc[i]); } \
            mx = xhalf_max(mx); \
            const float mn = fmaxf(m1, mx); float ps = 0.f; \
            _Pragma("unroll") for (int i = 0; i < 16; ++i) ps += ok[i] ? ex2(sc[i] - mn) : 0.f; \
            l1 = l1 * ex2(m1 - mn) + ps; m1 = mn; } while (0)
        if (ntile > 0) {
            bf16x8 kA[4], kB[4];
#pragma unroll
            for (int s = 0; s < 4; ++s) kA[s] = kb[s * 64];
#pragma unroll 1
            for (int kt = 0; kt < ntile; kt += 2) {
                { const int kn = (kt + 1 < ntile) ? kt + 1 : ntile - 1;
#pragma unroll
                  for (int s = 0; s < 4; ++s) kB[s] = kb[kn * 256 + s * 64]; }
                __builtin_amdgcn_sched_barrier(0);
                CMP_P1(kA, kt);
                if (kt + 1 >= ntile) break;
                { const int kn = (kt + 2 < ntile) ? kt + 2 : ntile - 1;
#pragma unroll
                  for (int s = 0; s < 4; ++s) kA[s] = kb[kn * 256 + s * 64]; }
                __builtin_amdgcn_sched_barrier(0);
                CMP_P1(kB, kt + 1);
            }
        }
#undef CMP_P1
        l1 = xhalf_sum(l1);
        const float inv = 1.f / fmaxf(l1, 1e-30f);
        for (int e = lane; e < 8 * 264; e += 64) imp[e] = 0.f;
        LDS_WAIT();
        f32x16 O[2];
#pragma unroll
        for (int i = 0; i < 16; ++i) { O[0][i] = 0.f; O[1][i] = 0.f; }
#define CMP_P2(KF, VF, KT) do { \
            f32x16 sc; _Pragma("unroll") for (int i = 0; i < 16; ++i) sc[i] = 0.f; \
            _Pragma("unroll") for (int s = 0; s < 4; ++s) sc = mfma32(KF[s], qf[s], sc); \
            const int up = nvq - 1 - 32 * (KT); const int x0 = up < 0 ? 64 : 8 * hi; const unsigned span = up < 0 ? 0u : (unsigned)up; \
            float p[16]; \
            _Pragma("unroll") for (int i = 0; i < 16; ++i) { const bool ok = (unsigned)(x0 + i + (i >= 8 ? 8 : 0)) <= span; p[i] = ok ? ex2(sc[i] - m1) * inv : 0.f; } \
            _Pragma("unroll") for (int rr = 0; rr < 2; ++rr) { \
                const float* q8 = p + 8 * rr; \
                float a = q8[0] + q8[1] + q8[2] + 0.5f * q8[3], bq = 0.5f * q8[3] + q8[4] + q8[5] + q8[6] + 0.5f * q8[7], cq = 0.5f * q8[7]; \
                a += dpp_xor1(a); a += dpp_xor2(a); bq += dpp_xor1(bq); bq += dpp_xor2(bq); cq += dpp_xor1(cq); cq += dpp_xor2(cq); \
                _Pragma("unroll") for (int hh = 0; hh < 2; ++hh)     \
                if (h == 0 && hi == hh) { LAS float* ip = imp + qi * 264 + 8 * (KT) + 2 * hi + 4 * rr; \
                    __hip_atomic_fetch_add(ip, a, __ATOMIC_RELAXED, __HIP_MEMORY_SCOPE_WORKGROUP); __hip_atomic_fetch_add(ip + 1, bq, __ATOMIC_RELAXED, __HIP_MEMORY_SCOPE_WORKGROUP); \
                    __hip_atomic_fetch_add(ip + 2, cq, __ATOMIC_RELAXED, __HIP_MEMORY_SCOPE_WORKGROUP); } \
            } \
            const bf16x8 pb0 = pack_p(p), pb1 = pack_p(p + 8); \
            O[0] = mfma32(VF[0], pb0, O[0]); O[1] = mfma32(VF[1], pb0, O[1]); \
            O[0] = mfma32(VF[2], pb1, O[0]); O[1] = mfma32(VF[3], pb1, O[1]); } while (0)
        if (ntile > 0) {
            bf16x8 kA[4], kB[4], vA[4];
#pragma unroll
            for (int s = 0; s < 4; ++s) kA[s] = kb[s * 64];
#pragma unroll 1
            for (int kt = 0; kt < ntile; kt += 2) {
                { const int kn = (kt + 1 < ntile) ? kt + 1 : ntile - 1;
#pragma unroll
                  for (int s = 0; s < 4; ++s) kB[s] = kb[kn * 256 + s * 64];
#pragma unroll
                  for (int s = 0; s < 4; ++s) vA[s] = vb[kt * 256 + s * 64]; }
                __builtin_amdgcn_sched_barrier(0);
                CMP_P2(kA, vA, kt);
                if (kt + 1 >= ntile) break;
                { const int kn = (kt + 2 < ntile) ? kt + 2 : ntile - 1;
#pragma unroll
                  for (int s = 0; s < 4; ++s) kA[s] = kb[kn * 256 + s * 64];
#pragma unroll
                  for (int s = 0; s < 4; ++s) vA[s] = vb[(kt + 1) * 256 + s * 64]; }
                __builtin_amdgcn_sched_barrier(0);
                CMP_P2(kB, vA, kt + 1);
            }
        }
#undef CMP_P2
#pragma unroll
        for (int i = 0; i < 16; ++i) { ost[i * 64] = gc * O[0][i]; ost[(16 + i) * 64] = gc * O[1][i]; }
        LDS_WAIT();
    }

    unsigned bmv[4];
    if (cur <= 15) {
#pragma unroll
        for (int c = 0; c < 4; ++c) bmv[c] = (lane + 64 * c <= cur) ? 0xFFu : 0u;
    } else {
        unsigned key[8][4];
#pragma unroll
        for (int q2 = 0; q2 < 8; ++q2)
#pragma unroll
            for (int c = 0; c < 4; ++c) { const int j = lane + 64 * c; const bool cand = (j >= 1) && (j < cur - 1); const float v = imp[q2 * 264 + j];
                key[q2][c] = cand ? ((__float_as_uint(v) & 0xFFFFFF00u) | (unsigned)(255 - j)) : 0u; }
#pragma unroll
        for (int c = 0; c < 4; ++c) bmv[c] = 0u;
#pragma unroll 1
        for (int round = 0; round < 13; ++round) {
#pragma unroll
            for (int q2 = 0; q2 < 8; ++q2) {
                unsigned mx = key[q2][0]; mx = mx > key[q2][1] ? mx : key[q2][1]; mx = mx > key[q2][2] ? mx : key[q2][2]; mx = mx > key[q2][3] ? mx : key[q2][3];
                const unsigned w = wave_max_u32(mx);
#pragma unroll
                for (int c = 0; c < 4; ++c) { const bool win = (key[q2][c] == w) && (w != 0u); key[q2][c] = win ? 0u : key[q2][c]; bmv[c] |= win ? (1u << q2) : 0u; }
            }
        }
#pragma unroll
        for (int c = 0; c < 4; ++c) { const int j = lane + 64 * c; if (j == 0 || j == cur || j == cur - 1) bmv[c] = 0xFFu; }
    }

    {
        LAS unsigned* list = (LAS unsigned*)imp;
        int nblk = 0;
#pragma unroll
        for (int c = 0; c < 4; ++c) {
            const unsigned long long mk = __ballot(bmv[c] != 0u);
            const int pos = nblk + (int)__builtin_amdgcn_mbcnt_hi((unsigned)(mk >> 32), __builtin_amdgcn_mbcnt_lo((unsigned)mk, 0u));
            if (bmv[c] != 0u) list[pos] = (unsigned)(lane + 64 * c) | (bmv[c] << 16);
            nblk += __builtin_popcountll(mk);
        }
        LDS_WAIT();
        const bf16x8* kb = (const bf16x8*)(C.ws + WS_KSLC) + (size_t)bg * 512 * 4 * 64 + lane;
        const bf16x8* vb = (const bf16x8*)(C.ws + WS_VSLC) + (size_t)bg * 1024 * 2 * 64 + lane;
        float m = -1e30f, l = 0.f; f32x16 O[2];
#pragma unroll
        for (int i = 0; i < 16; ++i) { O[0][i] = 0.f; O[1][i] = 0.f; }
        flash_run<0>(kb, vb, qr, 2 * nblk, list, 0, t, t0, qi, hi, m, l, O);
        l = xhalf_sum(l);
        const float sc = gs / fmaxf(l, 1e-30f);
#pragma unroll
        for (int i = 0; i < 16; ++i) { ost[i * 64] += sc * O[0][i]; ost[(16 + i) * 64] += sc * O[1][i]; }
        LDS_WAIT();
    }
    {
        const bf16x8* kb = (const bf16x8*)(C.ws + WS_KWIN) + (size_t)bg * 512 * 4 * 64 + lane;
        const bf16x8* vb = (const bf16x8*)(C.ws + WS_VWIN) + (size_t)bg * 1024 * 2 * 64 + lane;
        float m = -1e30f, l = 0.f; f32x16 O[2];
#pragma unroll
        for (int i = 0; i < 16; ++i) { O[0][i] = 0.f; O[1][i] = 0.f; }
        const int tlo = (t0 - 511 > 0 ? t0 - 511 : 0) >> 5, thi = (t0 + 7) >> 5;
        flash_run<1>(kb, vb, qr, thi - tlo + 1, (const LAS unsigned*)imp, tlo, t, t0, qi, hi, m, l, O);
        l = xhalf_sum(l);
        const float sc = gw / fmaxf(l, 1e-30f);
        bf16_t* yp = Y + tok * YP + 512 + head * 64 + 4 * hi;
#pragma unroll
        for (int dt = 0; dt < 2; ++dt)
#pragma unroll
            for (int ig = 0; ig < 4; ++ig) { float o4[4];
#pragma unroll
                for (int e = 0; e < 4; ++e) o4[e] = ost[(dt * 16 + 4 * ig + e) * 64] + sc * O[dt][4 * ig + e];
                u32x2 w; w.x = cvt_pk_bf16(o4[0], o4[1]); w.y = cvt_pk_bf16(o4[2], o4[3]); *(u32x2*)(yp + 32 * dt + 8 * ig) = w; }
        LDS_WAIT();
    }
}

__device__ __forceinline__ void mem_tile(const Ctx& C, int b, int hm, int t0) {
    const bf16_t* P = (const bf16_t*)(C.ws + WS_R1); bf16_t* Y = (bf16_t*)(C.ws + WS_Y);
    const int lane = C.lane, r = lane & 31, hi = lane >> 5;
    const size_t tok = (size_t)b * S_ + t0 + r;
    const float QS = 0.12751743082459868f;
    bf16x8 q[8];
    const bf16_t* qp = P + tok * PP + PC_QM + hm * 128;
#pragma unroll
    for (int s = 0; s < 8; ++s) q[s] = scale_q(*(const u32x4*)(qp + 16 * s + 8 * hi), QS);
    const bf16x8* kb = (const bf16x8*)(C.ws + WS_MEMK) + (size_t)(b * 4 + hm) * 8 * 8 * 64 + lane;
    const bf16x8* vb = (const bf16x8*)(C.ws + WS_MEMV) + (size_t)(b * 4 + hm) * 16 * 4 * 64 + lane;
    float m = -1e30f, l = 0.f; f32x16 O[4];
#pragma unroll
    for (int i = 0; i < 16; ++i) { O[0][i] = 0.f; O[1][i] = 0.f; O[2][i] = 0.f; O[3][i] = 0.f; }
#define MEM_STEP(KF, VF) do { \
        f32x16 sc; _Pragma("unroll") for (int i = 0; i < 16; ++i) sc[i] = 0.f; \
        _Pragma("unroll") for (int s = 0; s < 8; ++s) sc = mfma32(KF[s], q[s], sc); \
        float mx = -1e30f; _Pragma("unroll") for (int i = 0; i < 16; ++i) mx = fmaxf(mx, sc[i]); \
        mx = xhalf_max(mx); \
        const float mn = fmaxf(m, mx), alpha = ex2(m - mn); m = mn; \
        float p[16], ps = 0.f; _Pragma("unroll") for (int i = 0; i < 16; ++i) { p[i] = ex2(sc[i] - mn); ps += p[i]; } \
        l = l * alpha + ps; \
        _Pragma("unroll") for (int i = 0; i < 16; ++i) { O[0][i] *= alpha; O[1][i] *= alpha; O[2][i] *= alpha; O[3][i] *= alpha; } \
        const bf16x8 pb0 = pack_p(p), pb1 = pack_p(p + 8); \
        _Pragma("unroll") for (int dt = 0; dt < 4; ++dt) { O[dt] = mfma32(VF[dt], pb0, O[dt]); O[dt] = mfma32(VF[4 + dt], pb1, O[dt]); } } while (0)
    {
        bf16x8 kA[8], vv[8];
#pragma unroll 1
        for (int kt = 0; kt < 8; ++kt) {
#pragma unroll
            for (int s = 0; s < 8; ++s) kA[s] = kb[kt * 512 + s * 64];
#pragma unroll
            for (int s = 0; s < 8; ++s) vv[s] = vb[kt * 512 + s * 64];
            __builtin_amdgcn_sched_barrier(0);
            MEM_STEP(kA, vv);
        }
    }
#undef MEM_STEP
    l = xhalf_sum(l);
    const float inv = 1.f / l;
    bf16_t* yp = Y + tok * YP + 1024 + hm * 128 + 4 * hi;
#pragma unroll
    for (int dt = 0; dt < 4; ++dt)
#pragma unroll
        for (int ig = 0; ig < 4; ++ig) { u32x2 w; w.x = cvt_pk_bf16(O[dt][4 * ig] * inv, O[dt][4 * ig + 1] * inv); w.y = cvt_pk_bf16(O[dt][4 * ig + 2] * inv, O[dt][4 * ig + 3] * inv); *(u32x2*)(yp + 32 * dt + 8 * ig) = w; }
}

__device__ __forceinline__ void attention_phase(const Ctx& C) {
    const int bxx = C.gw / NWAVES; const bool xmode = (C.G & 7) == 0;
    const int x = bxx & 7, rank = xmode ? (bxx >> 3) * NWAVES + C.wave : C.gw, nrank = xmode ? (C.G >> 3) * NWAVES : C.NGW, nitem = xmode ? 1536 : 12288;
    for (int i = rank; i < nitem; i += nrank) {
        int nsa_n, mem_e;
        if (xmode) { nsa_n = (i < 1024) ? (x >> 1) * 2048 + 2 * i + (x & 1) : -1; mem_e = x * 512 + (i - 1024); }
        else { if (i < 8192) { const int k = i >> 11, w = i & 2047; nsa_n = k * 2048 + ((k & 1) ? 2047 - w : w); } else nsa_n = -1; mem_e = i - 8192; }
        if (nsa_n >= 0) { const int k = nsa_n >> 11; nsa_tile(C, k >> 1, k & 1, (nsa_n & 2047) * 8); }
        else { const int bh = mem_e >> 9; mem_tile(C, bh >> 2, bh & 3, (mem_e & 511) * 32); }
    }
}

#define XB_TMO      128
#define XB_XCNT(j)  (256  + 64 * (j))
#define XB_XSUB(j)  (1280 + 64 * (j))
#define XB_XGEN(j)  (2304 + 64 * (j))
#define XB_TOP      3328
#define XB_TOPGEN   3392
#define XCD_BAR_WORDS 3456
#define XB_SPIN_CAP (1u << 18)
__device__ __forceinline__ unsigned xb_ld(unsigned* p)              { return __hip_atomic_load(p, __ATOMIC_RELAXED, __HIP_MEMORY_SCOPE_AGENT); }
__device__ __forceinline__ unsigned xb_add(unsigned* p, unsigned v) { return __hip_atomic_fetch_add(p, v, __ATOMIC_RELAXED, __HIP_MEMORY_SCOPE_AGENT); }
__device__ __forceinline__ unsigned xb_xcc_id() { return (unsigned)__builtin_amdgcn_s_getreg((3 << 11) | 20) & 0xFu; }
#define XB_SPIN(cond, bar) do { unsigned _sp = 0; while (cond) { __builtin_amdgcn_s_sleep(1); \
    if ((++_sp & 255u) == 0u) { if (xb_ld(&(bar)[XB_TMO])) break; if (_sp > XB_SPIN_CAP) { atomicAdd(&(bar)[XB_TMO], 1u); break; } } } } while (0)
__device__ __forceinline__ void xcd_barrier_complete(unsigned* bar, unsigned x, unsigned& nloc, unsigned& nx) {
    const unsigned G = gridDim.x * gridDim.y * gridDim.z;
    unsigned sum, cnt, mine, sp = 0u;
    for (;;) {
        sum = 0u; cnt = 0u; mine = 0u;
#pragma unroll
        for (unsigned j = 0; j < 16; ++j) { const unsigned c = xb_ld(&bar[XB_XCNT(j)]); sum += c; cnt += (c > 0u) ? 1u : 0u; mine = (j == x) ? c : mine; }
        if (sum == G) break;
        __builtin_amdgcn_s_sleep(1);
        if ((++sp & 255u) == 0u) { if (xb_ld(&bar[XB_TMO])) break; if (sp > XB_SPIN_CAP) { atomicAdd(&bar[XB_TMO], 1u); break; } }
    }
    nloc = mine > 0u ? mine : 1u; nx = cnt > 0u ? cnt : 1u;
}
__device__ __forceinline__ void xcd_barrier(unsigned* bar, volatile LAS unsigned* st, bool tid0) {
    asm volatile("s_waitcnt vmcnt(0)" ::: "memory");
    __syncthreads();
    if (tid0) {
        __builtin_amdgcn_s_waitcnt(0);
        const unsigned x = xb_xcc_id();
        unsigned nloc = st[0], nx = st[1];
        if (nloc == 0u) { xcd_barrier_complete(bar, x, nloc, nx); st[0] = nloc; st[1] = nx; }
        const unsigned old = xb_add(&bar[XB_XSUB(x)], 1u);
        const unsigned gen = old / nloc;
        if (old + 1u == (gen + 1u) * nloc) {
            __builtin_amdgcn_fence(__ATOMIC_RELEASE, "agent");
            asm volatile("s_waitcnt vmcnt(0)" ::: "memory");
            const unsigned og = xb_add(&bar[XB_TOP], 1u);
            const unsigned tg = og / nx;
            if (og + 1u == (tg + 1u) * nx) xb_add(&bar[XB_TOPGEN], 1u);
            else XB_SPIN(xb_ld(&bar[XB_TOPGEN]) == tg, bar);
            __builtin_amdgcn_fence(__ATOMIC_ACQUIRE, "agent");
            xb_add(&bar[XB_XGEN(x)], 1u);
            asm volatile("s_waitcnt vmcnt(0)" ::: "memory");
        } else {
            XB_SPIN(xb_ld(&bar[XB_XGEN(x)]) == gen, bar);
            __builtin_amdgcn_fence(__ATOMIC_ACQUIRE, "agent");
            asm volatile("s_waitcnt vmcnt(0)" ::: "memory");
        }
    }
    __syncthreads();
}

constexpr int LDS_BYTES = 147456, XB_LDS_OFF = 147456 - 64;
constexpr int NPHASE = 1 + 2 * 14;

__global__ void __launch_bounds__(NWAVES * 64, 2) fwd_kernel(Args args) {
    extern __shared__ __attribute__((aligned(16))) unsigned char lds_raw[];
    cg::grid_group grid = cg::this_grid();
    if (args.ph_lo == 0x7fffffff) grid.sync();
    const int wave0 = __builtin_amdgcn_readfirstlane((int)threadIdx.x >> 6);
    {
        volatile LAS unsigned* st = (volatile LAS unsigned*)(lds_raw + XB_LDS_OFF);
        if (threadIdx.x == 0) { st[0] = 0u; st[1] = 0u; (void)xb_add((unsigned*)(args.ws + WS_BAR) + XB_XCNT(xb_xcc_id()), 1u); }
        __syncthreads();
    }
#define PHASE_BEGIN { \
        unsigned char* ws0_ = args.ws; asm volatile("" : "+s"(ws0_)); gu8* ws = (gu8*)ws0_;     \
        int tid_; asm volatile("v_mbcnt_lo_u32_b32 %0, -1, 0\n\tv_mbcnt_hi_u32_b32 %0, -1, %0" : "=v"(tid_)); tid_ += wave0 * 64; \
        Ctx C; C.a = &args; C.ws = ws; C.lds = (LAS unsigned char*)lds_raw; C.tid = tid_; C.lane = tid_ & 63; C.wave = __builtin_amdgcn_readfirstlane(tid_ >> 6); \
        int bx = blockIdx.x; asm volatile("" : "+s"(bx)); C.G = gridDim.x; C.gw = bx * NWAVES + C.wave; C.NGW = C.G * NWAVES; \
        bf16_t* const H = (bf16_t*)(ws + WS_H); bf16_t* const R1 = (bf16_t*)(ws + WS_R1); bf16_t* const Y = (bf16_t*)(ws + WS_Y); (void)H; (void)R1; (void)Y; (void)bx;
#define PHASE_END   xcd_barrier((unsigned*)(ws + WS_BAR), (volatile LAS unsigned*)(lds_raw + XB_LDS_OFF), tid_ == 0); }
#define PHASE_END_CG grid.sync(); }

    PHASE_BEGIN
        convert_layer(C, 0);
        rope_table(C);
        prenorm_rows(C, (const float*)args.in[0], (const float*)args.in[3], H);
    PHASE_END

#pragma unroll 1
    for (int l = 0; l < 2; ++l) {
        PHASE_BEGIN
            { pg8::GemmDesc g{(const char*)H, (const char*)(ws + WS_W1IN), DM, DM, 128, 128, 16}; pg8::StdOrder S; S.init(T_, 2 * FF, C.G, bx, DM, DM);
              pg8::Epi<1> E{R1, FF, nullptr, nullptr}; pg8::gemm_phase(C.lds, C.tid, g, S, E); }
        PHASE_END
        PHASE_BEGIN
            { pg8::GemmDesc g{(const char*)R1, (const char*)(ws + WS_W1OUT), FF, FF, 128, 128, 44}; pg8::StdOrder S; S.init(T_, DM, C.G, bx, FF, FF);
              pg8::Epi<0> E{H, DM, nullptr, nullptr}; pg8::gemm_phase(C.lds, C.tid, g, S, E); }
        PHASE_END
        PHASE_BEGIN
            if (bx < 8) {
                { pg8::GemmDesc g{(const char*)(ws + WS_MEMN), (const char*)(ws + WS_WMKV), DM, DM, 128, 128, 16}; pg8::StdOrder S; S.init(512, DM, C.G, bx, DM, DM);
              pg8::Epi<0> E{(bf16_t*)(ws + WS_MKV), DM, nullptr, nullptr}; pg8::gemm_phase(C.lds, C.tid, g, S, E); }
            } else {
                norm_phase(C, C.gw - 8 * NWAVES, C.NGW - 8 * NWAVES, l == 0 ? (const float*)args.in[0] : args.out, args.out, H, H, INF(4, l, DM), INF(7, l, DM), 0.5f);
            }
            cb_reduce(C, l);
        PHASE_END
        PHASE_BEGIN
            { pg8::GemmDesc g{(const char*)H, (const char*)(ws + WS_WMIX), DM, DM, 128, 128, 16}; pg8::StdOrder S; S.init(T_, PP, C.G, bx, DM, DM);
              pg8::Epi<0> E{R1, PP, nullptr, nullptr}; pg8::gemm_phase(C.lds, C.tid, g, S, E); }
        PHASE_END
        PHASE_BEGIN
            if (bx < 32) {
                pg8::GemmDesc g{(const char*)R1, (const char*)(ws + WS_WC1), 16 * PP, 2048, PP * 2, 128, 32}; pg8::CmpOrder S{bx};
                pg8::Epi<4> E{(bf16_t*)(ws + WS_CMPH), 256, nullptr, (const float*)(ws + WS_CB) + l * 512}; pg8::gemm_phase(C.lds, C.tid, g, S, E);
            } else {
                prep_items(C, l, C.gw - 32 * NWAVES, C.NGW - 32 * NWAVES);
                memkv_ops(C, C.gw - 32 * NWAVES, C.NGW - 32 * NWAVES);
            }
        PHASE_END
        PHASE_BEGIN
            cmp_stage2(C, l);
        PHASE_END
        PHASE_BEGIN
            attention_phase(C);
        PHASE_END
        PHASE_BEGIN
            { pg8::GemmDesc g{(const char*)H, (const char*)(ws + WS_WG), DM, DM, 128, 128, 16}; pg8::StdOrder S; S.init(T_, GP, C.G, bx, DM, DM);
              pg8::Epi<2> E{R1, GP, nullptr, nullptr}; pg8::gemm_phase(C.lds, C.tid, g, S, E); }
        PHASE_END
        PHASE_BEGIN
            { pg8::GemmDesc g{(const char*)Y, (const char*)(ws + WS_WBR), YP, YP, 128, 128, 8}; pg8::MergeOrder S; S.init(T_, DM, C.G, bx, YP, YP);
              pg8::Epi<3> E{H, DM, R1, nullptr}; pg8::gemm_phase(C.lds, C.tid, g, S, E); }
        PHASE_END
        PHASE_BEGIN
            { pg8::GemmDesc g{(const char*)H, (const char*)(ws + WS_WOUT), DM, DM, 128, 128, 16}; pg8::StdOrder S; S.init(T_, DM, C.G, bx, DM, DM);
              pg8::Epi<0> E{R1, DM, nullptr, nullptr}; pg8::gemm_phase(C.lds, C.tid, g, S, E); }
        PHASE_END
        PHASE_BEGIN
            norm_phase(C, C.gw, C.NGW, args.out, args.out, R1, H, INF(8, l, DM), INF(25, l, DM), 1.0f);
        PHASE_END
        PHASE_BEGIN
            { pg8::GemmDesc g{(const char*)H, (const char*)(ws + WS_W2IN), DM, DM, 128, 128, 16}; pg8::StdOrder S; S.init(T_, 2 * FF, C.G, bx, DM, DM);
              pg8::Epi<1> E{R1, FF, nullptr, nullptr}; pg8::gemm_phase(C.lds, C.tid, g, S, E); }
        PHASE_END
        PHASE_BEGIN
            { pg8::GemmDesc g{(const char*)R1, (const char*)(ws + WS_W2OUT), FF, FF, 128, 128, 44}; pg8::StdOrder S; S.init(T_, DM, C.G, bx, FF, FF);
              pg8::Epi<0> E{H, DM, nullptr, nullptr}; pg8::gemm_phase(C.lds, C.tid, g, S, E); }
        PHASE_END
        PHASE_BEGIN
            norm_phase(C, C.gw, C.NGW, args.out, args.out, H, H, INF(26, l, DM), l == 0 ? INF(3, 1, DM) : nullptr, 0.5f);
            if (l == 0) convert_layer(C, 1);
        PHASE_END
    }
}

extern "C" void kernel_launch(void* const* d_in, const int* in_sizes, int n_in, void* d_out, int out_size, void* d_ws, size_t ws_size, hipStream_t stream) {
    static int grid = 0;
    if (grid == 0) {
        if (n_in != 29 || ws_size < WS_END) { fprintf(stderr, "kernel_launch: unexpected n_in %d / ws %zu\n", n_in, ws_size); grid = -1; return; }
        int dev = 0, cus = 0, per_cu = 0;
        hipGetDevice(&dev); hipDeviceGetAttribute(&cus, hipDeviceAttributeMultiprocessorCount, dev);
        hipFuncSetAttribute((const void*)fwd_kernel, hipFuncAttributeMaxDynamicSharedMemorySize, LDS_BYTES);
        hipOccupancyMaxActiveBlocksPerMultiprocessor(&per_cu, (const void*)fwd_kernel, NWAVES * 64, LDS_BYTES);
        if (per_cu < 1) per_cu = 1;
        grid = cus * per_cu;
        (void)hipGetLastError();
    }
    if (grid < 0) return;
    hipMemsetAsync((char*)d_ws + WS_BAR, 0, 16384, stream);
    Args a{};
    for (int i = 0; i < 29; ++i) a.in[i] = d_in[i];
    a.out = (float*)d_out; a.ws = (unsigned char*)d_ws; a.ph_lo = 0; a.ph_hi = NPHASE;
    void* kargs[] = {&a};
    hipError_t e = hipLaunchCooperativeKernel((const void*)fwd_kernel, dim3(grid), dim3(NWAVES * 64), kargs, LDS_BYTES, stream);
    if (e != hipSuccess) fprintf(stderr, "cooperative launch failed: %s (grid %d)\n", hipGetErrorString(e), grid);
}
```

```cpp
#include <hip/hip_runtime.h>
#include <hip/hip_cooperative_groups.h>
#include <cstdio>
#include <cstdint>
namespace cg = cooperative_groups;

#define LAS __attribute__((address_space(3)))
typedef unsigned short bf16_t;
typedef short bf16x8 __attribute__((ext_vector_type(8)));
typedef float f32x4 __attribute__((ext_vector_type(4)));
typedef float f32x16 __attribute__((ext_vector_type(16)));
typedef unsigned u32x4 __attribute__((ext_vector_type(4)));
typedef unsigned u32x2 __attribute__((ext_vector_type(2)));

constexpr int NBATCH = 2, S_ = 16384, T_ = NBATCH * S_, DM = 1024, FF = 2816, PP = 3584, GP = 3072, YP = 1536;
constexpr int NWAVES = 8;
constexpr float EPS = 1e-6f;
constexpr int PC_Q = 1536, PC_KV = 2048, PC_QM = 2816, PC_NG = 3328;

constexpr size_t MiB = 1u << 20;
constexpr size_t WS_W1IN = 0, WS_W1OUT = 11 * MiB, WS_WMIX = WS_W1OUT + 11 * MiB / 2, WS_WG = WS_WMIX + 7 * MiB, WS_WBR = WS_WG + 6 * MiB, WS_WOUT = WS_WBR + 3 * MiB,
                 WS_W2IN = WS_WOUT + 2 * MiB, WS_W2OUT = WS_W2IN + 11 * MiB, WS_WC1 = WS_W2OUT + 11 * MiB / 2  , WS_WMKV = WS_WC1 + 2 * MiB,
                 WS_MEMN = WS_WMKV + 2 * MiB, WS_MKV = WS_MEMN + 1 * MiB, WS_CB = WS_MKV + 1 * MiB  , WS_CBP = WS_CB + 8192  , WS_BAR = WS_CB + 8192 + 131072  ;
static_assert(WS_CB == 57 * MiB, "ws map");
constexpr size_t WS_ROPE = 58 * MiB, WS_MEMK = 60 * MiB, WS_MEMV = WS_MEMK + MiB / 2, WS_KCMP = 61 * MiB, WS_VCMP = WS_KCMP + MiB / 2, WS_CMPH = 62 * MiB,
                 WS_KSLC = 66 * MiB, WS_VSLC = 74 * MiB, WS_KWIN = 82 * MiB, WS_VWIN = 90 * MiB, WS_H = 98 * MiB, WS_Y = 162 * MiB, WS_R1 = 258 * MiB, WS_END = 483 * MiB;

typedef float f32x2_t __attribute__((ext_vector_type(2)));
typedef __bf16 bf16x2_t __attribute__((ext_vector_type(2)));
__device__ __forceinline__ unsigned cvt_pk_bf16(float lo, float hi) { f32x2_t v = {lo, hi}; bf16x2_t b = __builtin_convertvector(v, bf16x2_t); return __builtin_bit_cast(unsigned, b); }
__device__ __forceinline__ float bf_lo(unsigned u) { return __uint_as_float(u << 16); }
__device__ __forceinline__ float bf_hi(unsigned u) { return __uint_as_float(u & 0xffff0000u); }
__device__ __forceinline__ float bf1(bf16_t u) { return __uint_as_float(((unsigned)u) << 16); }
__device__ __forceinline__ float ex2(float x) { return __builtin_amdgcn_exp2f(x); }
__device__ __forceinline__ float rcpf_(float x) { return __builtin_amdgcn_rcpf(x); }
__device__ __forceinline__ float sigm(float x) { return rcpf_(1.f + ex2(-1.44269504f * x)); }
__device__ __forceinline__ float gelu_tanh(float x) { const float u = 0.7978845608f * (x + 0.044715f * x * x * x); return x * rcpf_(1.f + ex2(-2.88539008f * u)); }
__device__ __forceinline__ float wave_sum(float v) {
#pragma unroll
    for (int o = 1; o < 64; o <<= 1) v += __shfl_xor(v, o);
    return v;
}
__device__ __forceinline__ int pi32(int r) { return (r & 0x13) | ((r & 4) << 1) | ((r & 8) >> 1); }
#define LDS_WAIT() asm volatile("s_waitcnt lgkmcnt(0)" ::: "memory")

namespace pg8 {
constexpr int BM = 256, BK = 64, HALF = 128, HTB = HALF * BK * 2, STAGE_BYTES = 8 * HTB, NXCD = 8, WGM = 8;
__device__ __forceinline__ int lds_byte(int r, int c) { const int st = (r >> 4) * 2 + (c >> 5), rr = r & 15, cc = c & 31, ob = rr * 64 + cc * 2; return st * 1024 + (ob ^ (((ob >> 9) & 1) << 5)); }
__device__ __forceinline__ void stage_rc(int b, int& R, int& C) { const int st = b / 1024, sb = b % 1024, swz = sb ^ (((sb >> 9) & 1) << 5); R = (st >> 1) * 16 + swz / 64; C = (st & 1) * 32 + (swz % 64) / 2; }
__device__ __forceinline__ int perm32(int rho) { const int n = rho >> 4, i = rho & 15; return 8 * (i >> 2) + 4 * n + (i & 3); }

struct Unit { int pm, pn, tag; long long aoff, boff; };
struct GemmDesc { const char* A; const char* Bt; int lda, ldb, kstepA, kstepB, nt; };

__device__ __forceinline__ void swz_tile(int L, int nM, int nN, int& pm, int& pn) {
    const int nwg = nM * nN; int wgid = L;
    { const int q = nwg / NXCD, r = nwg % NXCD, xcd = wgid % NXCD, off = wgid / NXCD; wgid = (xcd < r ? xcd * (q + 1) : r * (q + 1) + (xcd - r) * q) + off; }
    const int nig = WGM * nN, gid = wgid / nig, fm = gid * WGM, gsz = (nM - fm) < WGM ? (nM - fm) : WGM;
    pm = fm + ((wgid % nig) % gsz); pn = (wgid % nig) / gsz;
}
struct StdOrder {
    int nM, nN, G, c; long long tA, tB;
    __device__ void init(int M, int N, int G_, int c_, int lda, int ldb) { nM = M / BM; nN = N / BM; G = G_; c = c_; tA = 512LL * lda; tB = 512LL * ldb; }
    __device__ bool next(int i, Unit& u) const {
        const long long L = (long long)i * G + c; if (L >= (long long)nM * nN) return false;
        swz_tile((int)L, nM, nN, u.pm, u.pn); u.tag = 0; u.aoff = u.pm * tA; u.boff = u.pn * tB; return true;
    }
};
struct MergeOrder {
    int nM, nN, G, c; long long tA, tB;
    __device__ void init(int M, int N, int G_, int c_, int lda, int ldb) { nM = M / BM; nN = N / BM; G = G_; c = c_; tA = 512LL * lda; tB = 512LL * ldb; }
    __device__ bool next(int i, Unit& u) const {
        const int ti = i / 3, br = i - 3 * ti; const long long L = (long long)ti * G + c; if (L >= (long long)nM * nN) return false;
        swz_tile((int)L, nM, nN, u.pm, u.pn); u.tag = br; u.aoff = u.pm * tA + br * 1024; u.boff = u.pn * tB + br * 1024; return true;
    }
};
struct CmpOrder {
    int c;
    __device__ bool next(int i, Unit& u) const {
        if (i != 0 || c >= 32) return false;
        const int kv = c >> 4, bg = (c >> 2) & 3, tile = c & 3, b = bg >> 1, g = bg & 1;
        u.pm = c; u.pn = 0; u.tag = kv;
        u.aoff = 2LL * (((long long)b * S_ + 4096LL * tile) * PP + PC_KV + kv * 128 + g * 64);
        u.boff = (long long)kv * (256 * 2048 * 2); return true;
    }
};

__device__ __forceinline__ u32x4 pack8(f32x4 a, f32x4 b) { u32x4 w; w.x = cvt_pk_bf16(a[0], a[1]); w.y = cvt_pk_bf16(a[2], a[3]); w.z = cvt_pk_bf16(b[0], b[1]); w.w = cvt_pk_bf16(b[2], b[3]); return w; }
template <int MODE> struct Epi {
    bf16_t* O; int ldc; const bf16_t* G; const float* bias;
    __device__ __forceinline__ void operator()(const f32x4 (&acc)[2][2][4][2], const Unit& u, int wr, int wc, int fr, int fq) const {
        const int row0 = u.pm * BM + wr * 64 + fr;
        if constexpr (MODE == 1) {
            const int col0 = u.pn * 128 + wc * 32 + 8 * fq;
#pragma unroll
            for (int ai = 0; ai < 2; ++ai)
#pragma unroll
                for (int m = 0; m < 4; ++m) {
                    bf16_t* rowp = O + (size_t)(row0 + ai * HALF + m * 16) * ldc + col0;
                    f32x4 v0, v1;
#pragma unroll
                    for (int e = 0; e < 4; ++e) { const float a0 = acc[ai][0][m][0][e], a1 = acc[ai][0][m][1][e]; v0[e] = a0 * sigm(a0) * acc[ai][1][m][0][e]; v1[e] = a1 * sigm(a1) * acc[ai][1][m][1][e]; }
                    *(u32x4*)rowp = pack8(v0, v1);
                    __builtin_amdgcn_sched_barrier(0);
                }
        } else {
            const int col0 = u.pn * BM + wc * 32 + 8 * fq;
#pragma unroll
            for (int ai = 0; ai < 2; ++ai)
#pragma unroll
                for (int m = 0; m < 4; ++m) {
                    const size_t row = (size_t)(row0 + ai * HALF + m * 16);
#pragma unroll
                    for (int bj = 0; bj < 2; ++bj) {
                        const int col = col0 + bj * HALF;
                        f32x4 v0 = acc[ai][bj][m][0], v1 = acc[ai][bj][m][1];
                        bf16_t* dst = O + row * ldc + col;
                        if constexpr (MODE == 2) {
#pragma unroll
                            for (int e = 0; e < 4; ++e) { v0[e] = sigm(v0[e]); v1[e] = sigm(v1[e]); }
                        }
                        if constexpr (MODE == 4) {
                            const f32x4 b0 = *(const f32x4*)(bias + u.tag * 256 + col), b1 = *(const f32x4*)(bias + u.tag * 256 + col + 4);
#pragma unroll
                            for (int e = 0; e < 4; ++e) { v0[e] = gelu_tanh(v0[e] + b0[e]); v1[e] = gelu_tanh(v1[e] + b1[e]); }
                        }
                        if constexpr (MODE == 3) {
                            const u32x4 gv = *(const u32x4*)(G + row * GP + u.tag * 1024 + col);
                            v0[0] *= bf_lo(gv.x); v0[1] *= bf_hi(gv.x); v0[2] *= bf_lo(gv.y); v0[3] *= bf_hi(gv.y);
                            v1[0] *= bf_lo(gv.z); v1[1] *= bf_hi(gv.z); v1[2] *= bf_lo(gv.w); v1[3] *= bf_hi(gv.w);
                            if (u.tag > 0) {
                                const u32x4 ov = *(const u32x4*)dst;
                                v0[0] += bf_lo(ov.x); v0[1] += bf_hi(ov.x); v0[2] += bf_lo(ov.y); v0[3] += bf_hi(ov.y);
                                v1[0] += bf_lo(ov.z); v1[1] += bf_hi(ov.z); v1[2] += bf_lo(ov.w); v1[3] += bf_hi(ov.w);
                            }
                        }
                        *(u32x4*)dst = pack8(v0, v1);
                    }
                }
        }
    }
};

template <class EpiT, class Sched>
__device__ __forceinline__ void gemm_phase(LAS unsigned char* lds, int tid_in, const GemmDesc g, const Sched& S, const EpiT& E) {
    int tid_ = tid_in; asm volatile("" : "+v"(tid_));
    const int tid = tid_, wid = __builtin_amdgcn_readfirstlane(tid >> 6), lane = tid & 63, wr = wid >> 2, wc = wid & 3, fr = lane & 15, fq = lane >> 4;
    const int nt = g.nt;
    unsigned voffA[2], voffB[2];
#pragma unroll
    for (int i = 0; i < 2; ++i) { int R, C; stage_rc(tid * 16 + i * 8192, R, C); const int Rb = (R & ~31) + perm32(R & 31);
        voffA[i] = (unsigned)(R * g.lda + C) * 2u; voffB[i] = (unsigned)(Rb * g.ldb + C) * 2u; }
    const size_t kA = (size_t)g.kstepA, kB = (size_t)g.kstepB;
    const size_t hA = (size_t)HALF * g.lda * 2, hB = (size_t)HALF * g.ldb * 2;
    const unsigned ldsw = (unsigned)wid * 1024u;
    const int aoff = lds_byte(wr * 64 + fr, fq * 8), boff = lds_byte(wc * 32 + fr, fq * 8);
#define PG8_SA(b, h) (((b) * 2 + (h)) * HTB)
#define PG8_SB(b, h) ((4 + (b) * 2 + (h)) * HTB)
#define PG8_STAGE(bufoff, gbase, voff) do { _Pragma("unroll") for (int _i = 0; _i < 2; ++_i) \
        __builtin_amdgcn_global_load_lds((const unsigned*)((const char*)(gbase) + (voff)[_i]), (LAS unsigned*)(lds + (bufoff) + ldsw + _i * 8192), 16, 0, 0); } while (0)
#define PG8_LDA(dst, b, h) do { _Pragma("unroll") for (int m = 0; m < 4; ++m) _Pragma("unroll") for (int k = 0; k < 2; ++k) dst[m][k] = *(const LAS bf16x8*)(lds + PG8_SA(b, h) + aoff + m * 2048 + k * 1024); } while (0)
#define PG8_LDB(dst, b, h) do { _Pragma("unroll") for (int n = 0; n < 2; ++n) _Pragma("unroll") for (int k = 0; k < 2; ++k) dst[n][k] = *(const LAS bf16x8*)(lds + PG8_SB(b, h) + boff + n * 2048 + k * 1024); } while (0)
#define PG8_MMA(ai, bj, At, Bt) do { __builtin_amdgcn_s_setprio(1); _Pragma("unroll") for (int m = 0; m < 4; ++m) _Pragma("unroll") for (int n = 0; n < 2; ++n) _Pragma("unroll") for (int k = 0; k < 2; ++k) \
        acc[ai][bj][m][n] = __builtin_amdgcn_mfma_f32_16x16x32_bf16(Bt[n][k], At[m][k], acc[ai][bj][m][n], 0, 0, 0); __builtin_amdgcn_s_setprio(0); } while (0)
#define PG8_WAIT_V(n) asm volatile("s_waitcnt vmcnt(" #n ")" ::: "memory")
#define PG8_WAIT_L(n) asm volatile("s_waitcnt lgkmcnt(" #n ")" ::: "memory")
#define PG8_BAR __builtin_amdgcn_s_barrier()
#define PG8_SCHED __builtin_amdgcn_sched_barrier(0)
    Unit cur, nxt; int ui = 0;
    if (!S.next(0, cur)) return;
    f32x4 acc[2][2][4][2];
#pragma unroll
    for (int a = 0; a < 2; ++a)
#pragma unroll
        for (int b = 0; b < 2; ++b)
#pragma unroll
            for (int m = 0; m < 4; ++m)
#pragma unroll
                for (int n = 0; n < 2; ++n) acc[a][b][m][n] = (f32x4){0.f, 0.f, 0.f, 0.f};
    bf16x8 At[4][2], B0[2][2], B1[2][2];
    const char* cA = g.A + cur.aoff; const char* cB = g.Bt + cur.boff;
    PG8_STAGE(PG8_SB(0, 0), cB, voffB); PG8_STAGE(PG8_SB(0, 1), cB + hB, voffB); PG8_STAGE(PG8_SA(0, 0), cA, voffA); PG8_STAGE(PG8_SA(0, 1), cA + hA, voffA);
    if (wr == 1) PG8_BAR;
    PG8_WAIT_V(2); PG8_BAR;
    PG8_STAGE(PG8_SB(1, 0), cB + kB, voffB); PG8_STAGE(PG8_SA(1, 0), cA + kA, voffA); PG8_STAGE(PG8_SB(1, 1), cB + hB + kB, voffB);
    PG8_WAIT_V(6); PG8_BAR;
    for (;;) {
        const bool has_next = S.next(ui + 1, nxt);
        const char* nA = has_next ? g.A + nxt.aoff : cA; const char* nB = has_next ? g.Bt + nxt.boff : cB;
        for (int t = 0; t < nt; t += 2) {
            const bool last = (t == nt - 2);
            const char* a1 = cA + (size_t)(t + 1) * kA;
            const char* a2 = last ? nA : cA + (size_t)(t + 2) * kA; const char* b2 = last ? nB : cB + (size_t)(t + 2) * kB;
            const char* a3 = a2 + kA; const char* b3 = b2 + kB;
            PG8_LDB(B0, 0, 0); PG8_LDB(B1, 0, 1); PG8_SCHED; PG8_LDA(At, 0, 0); PG8_STAGE(PG8_SA(1, 1), a1 + hA, voffA);
            PG8_WAIT_V(8); PG8_WAIT_L(0); PG8_BAR; PG8_MMA(0, 0, At, B0); PG8_MMA(0, 1, At, B1); PG8_BAR; PG8_SCHED;
            PG8_LDA(At, 0, 1); PG8_STAGE(PG8_SB(0, 0), b2, voffB); PG8_STAGE(PG8_SB(0, 1), b2 + hB, voffB); PG8_STAGE(PG8_SA(0, 0), a2, voffA);
            PG8_WAIT_V(8); PG8_WAIT_L(0); PG8_BAR; PG8_MMA(1, 0, At, B0); PG8_MMA(1, 1, At, B1); PG8_BAR; PG8_SCHED;
            PG8_LDB(B0, 1, 0); PG8_LDB(B1, 1, 1); PG8_SCHED; PG8_LDA(At, 1, 0); PG8_STAGE(PG8_SA(0, 1), a2 + hA, voffA);
            PG8_WAIT_V(8); PG8_WAIT_L(0); PG8_BAR; PG8_MMA(0, 0, At, B0); PG8_MMA(0, 1, At, B1); PG8_BAR; PG8_SCHED;
            PG8_LDA(At, 1, 1); PG8_STAGE(PG8_SB(1, 0), b3, voffB); PG8_STAGE(PG8_SB(1, 1), b3 + hB, voffB); PG8_STAGE(PG8_SA(1, 0), a3, voffA);
            PG8_WAIT_V(8); PG8_WAIT_L(0); PG8_BAR; PG8_MMA(1, 0, At, B0); PG8_MMA(1, 1, At, B1); PG8_BAR; PG8_SCHED;
        }
        if (wr == 0) PG8_BAR;
        E(acc, cur, wr, wc, fr, fq);
        if (!has_next) break;
#pragma unroll
        for (int a = 0; a < 2; ++a)
#pragma unroll
            for (int b = 0; b < 2; ++b)
#pragma unroll
                for (int m = 0; m < 4; ++m)
#pragma unroll
                    for (int n = 0; n < 2; ++n) acc[a][b][m][n] = (f32x4){0.f, 0.f, 0.f, 0.f};
        cur = nxt; cA = nA; cB = nB; ++ui;
        if (wr == 1) PG8_BAR;
    }
    PG8_WAIT_V(0);
    PG8_BAR;
#undef PG8_SA
#undef PG8_SB
#undef PG8_STAGE
#undef PG8_LDA
#undef PG8_LDB
#undef PG8_MMA
#undef PG8_WAIT_V
#undef PG8_WAIT_L
#undef PG8_BAR
#undef PG8_SCHED
}
}

struct Args { const void* in[29]; float* out; unsigned char* ws; int ph_lo, ph_hi; };
static_assert(sizeof(Args) == 29 * 8 + 8 + 8 + 8, "Args has no padding");

typedef __attribute__((address_space(1))) unsigned char gu8;
struct Ctx {
    const Args* a; gu8* ws; LAS unsigned char* lds; int tid, lane, wave, G, gw, NGW;
};
#define INF(k, l, n) ((const float*)C.a->in[k] + (size_t)(l) * (n))

__device__ __forceinline__ void tr_item(const float* W, int ldw, int src_col, int nvalid, int k0, bf16_t* WT, int ldt, int dst_row, int dst_k, LAS float* scr, int lane) {
#pragma unroll 8
    for (int i = 0; i < 32; ++i) { const int kk = 2 * i + (lane >> 5), c = lane & 31; scr[kk * 33 + c] = (c < nvalid) ? W[(size_t)(k0 + kk) * ldw + src_col + c] : 0.f; }
    LDS_WAIT();
    const int c = lane & 7;
#pragma unroll
    for (int j = 0; j < 4; ++j) { const int n = (lane >> 3) + 8 * j; const LAS float* s = scr + (8 * c) * 33 + n;
        u32x4 o; o.x = cvt_pk_bf16(s[0 * 33], s[1 * 33]); o.y = cvt_pk_bf16(s[2 * 33], s[3 * 33]); o.z = cvt_pk_bf16(s[4 * 33], s[5 * 33]); o.w = cvt_pk_bf16(s[6 * 33], s[7 * 33]);
        *(u32x4*)(WT + (size_t)(dst_row + n) * ldt + dst_k + k0 + 8 * c) = o; }
    LDS_WAIT();
}

__device__ __forceinline__ void convert_layer(const Ctx& C, int l) {
    LAS float* scr = (LAS float*)(C.lds + C.wave * 8448);
    gu8* ws = C.ws; const int lane = C.lane;
    constexpr int NITEMS = 2816 + 1408 + 1792 + 1536 + 768 + 512 + 2816 + 1408 + 256 + 256 + 512;
    for (int it = C.gw; it < NITEMS; it += C.NGW) {
        int r = it;
        if (r < 2816) { const int kb = r / 176, nb = r % 176, tile = nb >> 3, w = nb & 7, src = (w >> 2) * FF + tile * 128 + (w & 3) * 32;
            tr_item(INF(5, l, DM * 2 * FF), 2 * FF, src, 32, kb * 64, (bf16_t*)(ws + WS_W1IN), DM, nb * 32, 0, scr, lane); continue; } r -= 2816;
        if (r < 1408) { const int kb = r / 32, nb = r % 32;
            tr_item(INF(6, l, FF * DM), DM, nb * 32, 32, kb * 64, (bf16_t*)(ws + WS_W1OUT), FF, nb * 32, 0, scr, lane); continue; } r -= 1408;
        if (r < 1792) { const int kb = r / 112, nb = r % 112; int src = 0, nv = 0;
            if (nb < 88) { src = nb * 32; nv = 32; } else if (nb < 104) { src = 2840 + (nb - 88) * 32; nv = 32; } else if (nb == 104) { src = 2816; nv = 24; }
            tr_item(INF(10, l, DM * 6424), 6424, src, nv, kb * 64, (bf16_t*)(ws + WS_WMIX), DM, nb * 32, 0, scr, lane); continue; } r -= 1792;
        if (r < 1536) { const int kb = r / 96, nb = r % 96;
            tr_item(INF(10, l, DM * 6424), 6424, 3352 + nb * 32, 32, kb * 64, (bf16_t*)(ws + WS_WG), DM, nb * 32, 0, scr, lane); continue; } r -= 1536;
        if (r < 768) { const int br = r / 256, q = r % 256, kb = q / 32, nb = q % 32;
            const float* W = br == 0 ? INF(21, l, 512 * DM) : (br == 1 ? INF(22, l, 512 * DM) : INF(23, l, 512 * DM));
            tr_item(W, DM, nb * 32, 32, kb * 64, (bf16_t*)(ws + WS_WBR), YP, nb * 32, br * 512, scr, lane); continue; } r -= 768;
        if (r < 512) { const int kb = r / 32, nb = r % 32;
            tr_item(INF(24, l, DM * DM), DM, nb * 32, 32, kb * 64, (bf16_t*)(ws + WS_WOUT), DM, nb * 32, 0, scr, lane); continue; } r -= 512;
        if (r < 2816) { const int kb = r / 176, nb = r % 176, tile = nb >> 3, w = nb & 7, src = (w >> 2) * FF + tile * 128 + (w & 3) * 32;
            tr_item(INF(27, l, DM * 2 * FF), 2 * FF, src, 32, kb * 64, (bf16_t*)(ws + WS_W2IN), DM, nb * 32, 0, scr, lane); continue; } r -= 2816;
        if (r < 1408) { const int kb = r / 32, nb = r % 32;
            tr_item(INF(28, l, FF * DM), DM, nb * 32, 32, kb * 64, (bf16_t*)(ws + WS_W2OUT), FF, nb * 32, 0, scr, lane); continue; } r -= 1408;
        if (r < 256) { const int kb = r / 8, nb = r % 8;
            tr_item(INF(14, l, 2048 * 256), 256, nb * 32, 32, kb * 64, (bf16_t*)(ws + WS_WC1), 2048, nb * 32, 0, scr, lane); continue; } r -= 256;
        if (r < 256) { const int kb = r / 8, nb = r % 8;
            tr_item(INF(17, l, 2048 * 256), 256, nb * 32, 32, kb * 64, (bf16_t*)(ws + WS_WC1 + MiB), 2048, nb * 32, 0, scr, lane); continue; } r -= 256;
        { const int kb = r / 32, nb = r % 32;
            tr_item(INF(20, l, DM * DM), DM, nb * 32, 32, kb * 64, (bf16_t*)(ws + WS_WMKV), DM, nb * 32, 0, scr, lane); }
    }
    {
        const float* gm = INF(9, l, DM);
        for (int m = C.gw; m < 512; m += C.NGW) {
            const f32x4* xr = (const f32x4*)((const float*)C.a->in[1] + (size_t)m * DM) + lane;
            f32x4 v[4]; float s = 0.f;
#pragma unroll
            for (int j = 0; j < 4; ++j) { v[j] = xr[64 * j]; s += (v[j].x * v[j].x + v[j].y * v[j].y) + (v[j].z * v[j].z + v[j].w * v[j].w); }
            const float rstd = rsqrtf(wave_sum(s) * (1.f / DM) + EPS);
            u32x2* o = (u32x2*)((bf16_t*)(ws + WS_MEMN) + (size_t)m * DM) + lane;
#pragma unroll
            for (int j = 0; j < 4; ++j) { const f32x4 gg = ((const f32x4*)gm)[lane + 64 * j]; u32x2 w; w.x = cvt_pk_bf16(v[j].x * rstd * gg.x, v[j].y * rstd * gg.y); w.y = cvt_pk_bf16(v[j].z * rstd * gg.z, v[j].w * rstd * gg.w); o[64 * j] = w; }
        }
    }
    {
        float* cb = (float*)(ws + WS_CBP) + (size_t)l * 64 * 256;
        for (int it = C.gw; it < 64; it += C.NGW) {
            const int kv = it >> 5, ch = it & 31;
            const float* pos = kv ? INF(13, l, 2048) : INF(12, l, 2048);
            const float* w1 = kv ? INF(17, l, 2048 * 256) : INF(14, l, 2048 * 256);
            float p[4] = {0.f, 0.f, 0.f, 0.f};
            for (int k = ch * 64; k < ch * 64 + 64; ++k) { const float pv = pos[k];
#pragma unroll
                for (int q = 0; q < 4; ++q) p[q] += pv * w1[(size_t)k * 256 + lane + 64 * q]; }
#pragma unroll
            for (int q = 0; q < 4; ++q) cb[(size_t)it * 256 + lane + 64 * q] = p[q];
        }
    }
}

__device__ __forceinline__ void rope_table(const Ctx& C) {
    const int* pos = (const int*)C.a->in[2];
    float* tab = (float*)(C.ws + WS_ROPE);
    const float invf[8] = {1.0f, 0.1939227432012558f, 0.03760603070259094f, 0.007292664609849453f, 0.0014142135623842478f, 0.00027424818836152554f, 5.318296098266728e-05f, 1.0313386155758053e-05f};
    for (int e = C.gw * 64 + C.lane; e < T_ * 8; e += C.NGW * 64) {
        const int tok = e >> 3, i = e & 7;
        float f = invf[0];
#pragma unroll
        for (int q = 1; q < 8; ++q) f = (i == q) ? invf[q] : f;
        const float ang = (float)pos[tok] * f;
        const double rev = (double)ang * 0.15915494309189535; const float fr = (float)(rev - floor(rev));
        tab[(size_t)tok * 16 + i] = __builtin_amdgcn_cosf(fr); tab[(size_t)tok * 16 + 8 + i] = __builtin_amdgcn_sinf(fr);
    }
}
__device__ __forceinline__ void prenorm_rows(const Ctx& C, const float* x, const float* g, bf16_t* h) {
    for (int m = C.gw; m < T_; m += C.NGW) {
        const f32x4* xr = (const f32x4*)(x + (size_t)m * DM) + C.lane;
        f32x4 v[4]; float s = 0.f;
#pragma unroll
        for (int j = 0; j < 4; ++j) { v[j] = xr[64 * j]; s += (v[j].x * v[j].x + v[j].y * v[j].y) + (v[j].z * v[j].z + v[j].w * v[j].w); }
        const float rstd = rsqrtf(wave_sum(s) * (1.f / DM) + EPS);
        u32x2* o = (u32x2*)(h + (size_t)m * DM) + C.lane;
#pragma unroll
        for (int j = 0; j < 4; ++j) { const f32x4 gg = ((const f32x4*)g)[C.lane + 64 * j]; u32x2 w; w.x = cvt_pk_bf16(v[j].x * rstd * gg.x, v[j].y * rstd * gg.y); w.y = cvt_pk_bf16(v[j].z * rstd * gg.z, v[j].w * rstd * gg.w); o[64 * j] = w; }
    }
}
__device__ __forceinline__ void norm_phase(const Ctx& C, int w0, int nw, const float* xin, float* xout, const bf16_t* y, bf16_t* h, const float* gpost, const float* gpre, float coef) {
    for (int m0 = w0; m0 < T_; m0 += 2 * nw) {
        f32x4 xv[2][4]; u32x2 yw[2][4];
#pragma unroll
        for (int r = 0; r < 2; ++r) { const int m = (m0 + r * nw < T_) ? m0 + r * nw : m0; const f32x4* xr = (const f32x4*)(xin + (size_t)m * DM) + C.lane; const u32x2* yr = (const u32x2*)(y + (size_t)m * DM) + C.lane;
#pragma unroll
            for (int j = 0; j < 4; ++j) { xv[r][j] = xr[64 * j]; yw[r][j] = yr[64 * j]; } }
#pragma unroll
        for (int r = 0; r < 2; ++r) {
            const int m = m0 + r * nw; if (m >= T_) break;
            f32x4 yv[4]; float s = 0.f;
#pragma unroll
            for (int j = 0; j < 4; ++j) { const u32x2 w = yw[r][j]; yv[j] = (f32x4){bf_lo(w.x), bf_hi(w.x), bf_lo(w.y), bf_hi(w.y)};
                s += (yv[j].x * yv[j].x + yv[j].y * yv[j].y) + (yv[j].z * yv[j].z + yv[j].w * yv[j].w); }
            const float rs = rsqrtf(wave_sum(s) * (1.f / DM) + EPS) * coef; float s2 = 0.f;
            f32x4* xo = (f32x4*)(xout + (size_t)m * DM) + C.lane;
#pragma unroll
            for (int j = 0; j < 4; ++j) { const f32x4 gg = ((const f32x4*)gpost)[C.lane + 64 * j]; xv[r][j] = xv[r][j] + yv[j] * gg * rs; xo[64 * j] = xv[r][j];
                s2 += (xv[r][j].x * xv[r][j].x + xv[r][j].y * xv[r][j].y) + (xv[r][j].z * xv[r][j].z + xv[r][j].w * xv[r][j].w); }
            if (gpre) {
                const float r2 = rsqrtf(wave_sum(s2) * (1.f / DM) + EPS);
                u32x2* o = (u32x2*)(h + (size_t)m * DM) + C.lane;
#pragma unroll
                for (int j = 0; j < 4; ++j) { const f32x4 gg = ((const f32x4*)gpre)[C.lane + 64 * j]; u32x2 w; w.x = cvt_pk_bf16(xv[r][j].x * r2 * gg.x, xv[r][j].y * r2 * gg.y); w.y = cvt_pk_bf16(xv[r][j].z * r2 * gg.z, xv[r][j].w * r2 * gg.w); o[64 * j] = w; }
            }
        }
    }
}
__device__ __forceinline__ void cb_reduce(const Ctx& C, int l) {
    const int e = C.gw * 64 + C.lane;
    if (e < 512) { const int kv = e >> 8, n = e & 255; const float* pp = (const float*)(C.ws + WS_CBP) + (size_t)l * 64 * 256 + (size_t)kv * 32 * 256 + n;
        float s = (kv ? INF(18, l, 256) : INF(15, l, 256))[n];
        for (int ch = 0; ch < 32; ++ch) s += pp[ch * 256];
        ((float*)(C.ws + WS_CB))[l * 512 + e] = s; }
}
__device__ __forceinline__ void memkv_ops(const Ctx& C, int w0, int nw) {
    const bf16_t* src = (const bf16_t*)(C.ws + WS_MKV); bf16_t* ko = (bf16_t*)(C.ws + WS_MEMK); bf16_t* vo = (bf16_t*)(C.ws + WS_MEMV);
    for (int e = w0 * 64 + C.lane; e < 512 * 1024; e += nw * 64) {
        const int mr = e >> 10, col = e & 1023, kv = col >> 9, hm = (col >> 7) & 3, d = col & 127, b = mr >> 8, m = mr & 255;
        const bf16_t v = src[e];
        if (kv == 0) ko[((size_t)((((b * 4 + hm) * 8 + (m >> 5)) * 8 + (d >> 4)) * 64 + pi32(m & 31) + 32 * ((d >> 3) & 1))) * 8 + (d & 7)] = v;
        else vo[((size_t)((((b * 4 + hm) * 16 + (m >> 4)) * 4 + (d >> 5)) * 64 + (d & 31) + 32 * ((m >> 3) & 1))) * 8 + (m & 7)] = v;
    }
}

__device__ __forceinline__ void prep_items(const Ctx& C, int l, int w0, int nw) {
    const bf16_t* P = (const bf16_t*)(C.ws + WS_R1); bf16_t* Y = (bf16_t*)(C.ws + WS_Y);
    const int lane = C.lane;
    {
        const float* cw = INF(11, l, 3 * 512);
        float w[3][8];
#pragma unroll
        for (int k = 0; k < 3; ++k)
#pragma unroll
            for (int e = 0; e < 8; ++e) w[k][e] = cw[k * 512 + lane * 8 + e];
        for (int it = w0; it < T_ / 8; it += nw) {
            const int tok0 = it * 8, s0 = tok0 & (S_ - 1);
            float c1[8], c2[8];
#pragma unroll
            for (int e = 0; e < 8; ++e) { c1[e] = 0.f; c2[e] = 0.f; }
            if (s0 > 0) {
#pragma unroll
                for (int back = 2; back >= 1; --back) {
                    const bf16_t* row = P + (size_t)(tok0 - back) * PP + lane * 8;
                    const u32x4 u = *(const u32x4*)row, cc = *(const u32x4*)(row + 1024);
                    float t[8] = {bf_lo(u.x) * bf_lo(cc.x), bf_hi(u.x) * bf_hi(cc.x), bf_lo(u.y) * bf_lo(cc.y), bf_hi(u.y) * bf_hi(cc.y), bf_lo(u.z) * bf_lo(cc.z), bf_hi(u.z) * bf_hi(cc.z), bf_lo(u.w) * bf_lo(cc.w), bf_hi(u.w) * bf_hi(cc.w)};
#pragma unroll
                    for (int e = 0; e < 8; ++e) { if (back == 2) c2[e] = t[e]; else c1[e] = t[e]; }
                }
            }
#pragma unroll
            for (int tt = 0; tt < 8; ++tt) {
                const bf16_t* row = P + (size_t)(tok0 + tt) * PP + lane * 8;
                const u32x4 u = *(const u32x4*)row, bb = *(const u32x4*)(row + 512), cc = *(const u32x4*)(row + 1024);
                const float c0[8] = {bf_lo(u.x) * bf_lo(cc.x), bf_hi(u.x) * bf_hi(cc.x), bf_lo(u.y) * bf_lo(cc.y), bf_hi(u.y) * bf_hi(cc.y), bf_lo(u.z) * bf_lo(cc.z), bf_hi(u.z) * bf_hi(cc.z), bf_lo(u.w) * bf_lo(cc.w), bf_hi(u.w) * bf_hi(cc.w)};
                const float bv[8] = {bf_lo(bb.x), bf_hi(bb.x), bf_lo(bb.y), bf_hi(bb.y), bf_lo(bb.z), bf_hi(bb.z), bf_lo(bb.w), bf_hi(bb.w)};
                float o[8];
#pragma unroll
                for (int e = 0; e < 8; ++e) { o[e] = bv[e] * (w[0][e] * c2[e] + w[1][e] * c1[e] + w[2][e] * c0[e]); c2[e] = c1[e]; c1[e] = c0[e]; }
                u32x4 ov; ov.x = cvt_pk_bf16(o[0], o[1]); ov.y = cvt_pk_bf16(o[2], o[3]); ov.z = cvt_pk_bf16(o[4], o[5]); ov.w = cvt_pk_bf16(o[6], o[7]);
                *(u32x4*)(Y + (size_t)(tok0 + tt) * YP + lane * 8) = ov;
            }
        }
    }
    {
        const float* rope = (const float*)(C.ws + WS_ROPE);
        LAS bf16_t* vt = (LAS bf16_t*)(C.lds + C.wave * 4608);
        const int hi = lane >> 5, dl = lane & 31;
        for (int it = w0; it < 4 * 512; it += nw) {
            const int bg = it >> 9, tile = it & 511, b = bg >> 1, g = bg & 1;
            const size_t tokb = (size_t)b * S_ + 32 * tile;
#pragma unroll
            for (int which = 0; which < 2; ++which) {
                const int kc = PC_KV + (2 + 2 * which) * 128 + g * 64, vc = kc + 128;
                bf16_t* kop = (bf16_t*)(C.ws + (which ? WS_KWIN : WS_KSLC)); bf16_t* vop = (bf16_t*)(C.ws + (which ? WS_VWIN : WS_VSLC));
#pragma unroll
                for (int q = 0; q < 4; ++q) {
                    const int r = (lane >> 3) + 8 * q, c = lane & 7;
                    const bf16_t* row = P + (tokb + r) * PP;
                    u32x4 kv = *(const u32x4*)(row + kc + 8 * c);
                    if (c < 2) {
                        const u32x4 pv = *(const u32x4*)(row + kc + 8 * (c ^ 1));
                        const float* rt = rope + (tokb + r) * 16;
                        const f32x4 ca = *(const f32x4*)rt, cb2 = *(const f32x4*)(rt + 4), sa = *(const f32x4*)(rt + 8), sb = *(const f32x4*)(rt + 12);
                        const float cs[8] = {ca.x, ca.y, ca.z, ca.w, cb2.x, cb2.y, cb2.z, cb2.w}, sn[8] = {sa.x, sa.y, sa.z, sa.w, sb.x, sb.y, sb.z, sb.w};
                        const float mv[8] = {bf_lo(kv.x), bf_hi(kv.x), bf_lo(kv.y), bf_hi(kv.y), bf_lo(kv.z), bf_hi(kv.z), bf_lo(kv.w), bf_hi(kv.w)};
                        const float pp[8] = {bf_lo(pv.x), bf_hi(pv.x), bf_lo(pv.y), bf_hi(pv.y), bf_lo(pv.z), bf_hi(pv.z), bf_lo(pv.w), bf_hi(pv.w)};
                        const float sg = (c == 0) ? -1.f : 1.f; float o[8];
#pragma unroll
                        for (int e = 0; e < 8; ++e) o[e] = mv[e] * cs[e] + sg * pp[e] * sn[e];
                        kv.x = cvt_pk_bf16(o[0], o[1]); kv.y = cvt_pk_bf16(o[2], o[3]); kv.z = cvt_pk_bf16(o[4], o[5]); kv.w = cvt_pk_bf16(o[6], o[7]);
                    }
                    if (which == 0)
                        *(u32x4*)(kop + ((size_t)(((bg * 512 + tile) * 2 + ((r >> 2) & 1)) * 2 + (c >> 2)) * 64 + ((r >> 3) * 4 + (r & 3)) + 16 * (c & 3)) * 8) = kv;
                    else
                        *(u32x4*)(kop + ((size_t)((bg * 512 + tile) * 4 + (c >> 1)) * 64 + pi32(r) + 32 * (c & 1)) * 8) = kv;
                    const u32x4 vv = *(const u32x4*)(row + vc + 8 * c);
                    *(LAS u32x4*)(vt + r * 72 + 8 * c) = vv;
                }
                LDS_WAIT();
#pragma unroll
                for (int o4 = 0; o4 < 4; ++o4) {
                    if (which == 0) {
                        const LAS bf16_t* sp = vt + (8 * (lane >> 4)) * 72 + 16 * o4 + (lane & 15);
                        u32x4 o; o.x = (unsigned)sp[0] | ((unsigned)sp[72] << 16); o.y = (unsigned)sp[144] | ((unsigned)sp[216] << 16); o.z = (unsigned)sp[288] | ((unsigned)sp[360] << 16); o.w = (unsigned)sp[432] | ((unsigned)sp[504] << 16);
                        *(u32x4*)(vop + ((size_t)((bg * 512 + tile) * 4 + o4) * 64 + lane) * 8) = o;
                        continue;
                    }
                    const int ks = o4 >> 1, dt = o4 & 1;
                    const LAS bf16_t* sp = vt + (16 * ks + 8 * hi) * 72 + 32 * dt + dl;
                    u32x4 o; o.x = (unsigned)sp[0] | ((unsigned)sp[72] << 16); o.y = (unsigned)sp[144] | ((unsigned)sp[216] << 16); o.z = (unsigned)sp[288] | ((unsigned)sp[360] << 16); o.w = (unsigned)sp[432] | ((unsigned)sp[504] << 16);
                    *(u32x4*)(vop + ((size_t)((bg * 1024 + 2 * tile + ks) * 2 + dt) * 64 + lane) * 8) = o;
                }
                LDS_WAIT();
            }
        }
    }
}

__device__ __forceinline__ void cmp_stage2(const Ctx& C, int l) {
    const int bxx = C.gw / NWAVES, kv = bxx & 1, wi = bxx >> 1, nwg2 = (C.G + 1 - kv) >> 1;
    const float* w2 = kv ? INF(19, l, 256 * 64) : INF(16, l, 256 * 64);
    LAS float* ws2 = (LAS float*)C.lds;
    for (int e = C.tid; e < 256 * 64 / 4; e += NWAVES * 64) ((LAS f32x4*)ws2)[e] = ((const f32x4*)w2)[e];
    __syncthreads();
    const bf16_t* hid = (const bf16_t*)(C.ws + WS_CMPH) + (size_t)kv * 4096 * 256;
    bf16_t* ko = (bf16_t*)(C.ws + WS_KCMP); bf16_t* vo = (bf16_t*)(C.ws + WS_VCMP);
    const int d = C.lane;
    for (int row = wi * NWAVES + C.wave; row < 4096; row += nwg2 * NWAVES) {
        asm volatile("" ::: "memory");
        const u32x2 hv = *((const u32x2*)(hid + (size_t)row * 256) + C.lane);
        const float h0 = bf_lo(hv.x), h1 = bf_hi(hv.x), h2 = bf_lo(hv.y), h3 = bf_hi(hv.y);
        float acc = 0.f;
#pragma unroll 4
        for (int k = 0; k < 64; ++k) {
            const float a0 = __int_as_float(__builtin_amdgcn_readlane(__float_as_int(h0), k)), a1 = __int_as_float(__builtin_amdgcn_readlane(__float_as_int(h1), k));
            const float a2 = __int_as_float(__builtin_amdgcn_readlane(__float_as_int(h2), k)), a3 = __int_as_float(__builtin_amdgcn_readlane(__float_as_int(h3), k));
            acc += a0 * ws2[(4 * k + 0) * 64 + d]; acc += a1 * ws2[(4 * k + 1) * 64 + d]; acc += a2 * ws2[(4 * k + 2) * 64 + d]; acc += a3 * ws2[(4 * k + 3) * 64 + d];
        }
        const int bg = row >> 10, n = row & 1023;
        if (n == 1023) acc = 0.f;
        const bf16_t o = (bf16_t)(cvt_pk_bf16(acc, 0.f) & 0xffffu);
        if (kv == 0) ko[((size_t)((bg * 32 + (n >> 5)) * 4 + (d >> 4)) * 64 + pi32(n & 31) + 32 * ((d >> 3) & 1)) * 8 + (d & 7)] = o;
        else vo[((size_t)((bg * 64 + (n >> 4)) * 2 + (d >> 5)) * 64 + (d & 31) + 32 * ((n >> 3) & 1)) * 8 + (n & 7)] = o;
    }
    __syncthreads();
}

__device__ __forceinline__ float xhalf_max(float v) { const auto r = __builtin_amdgcn_permlane32_swap(__float_as_uint(v), __float_as_uint(v), false, false); return fmaxf(__uint_as_float(r[0]), __uint_as_float(r[1])); }
__device__ __forceinline__ float xhalf_sum(float v) { const auto r = __builtin_amdgcn_permlane32_swap(__float_as_uint(v), __float_as_uint(v), false, false); return __uint_as_float(r[0]) + __uint_as_float(r[1]); }
__device__ __forceinline__ f32x16 mfma32(bf16x8 a, bf16x8 b, f32x16 c) { return __builtin_amdgcn_mfma_f32_32x32x16_bf16(a, b, c, 0, 0, 0); }
__device__ __forceinline__ float dpp_xor1(float v) { return __int_as_float(__builtin_amdgcn_update_dpp(0, __float_as_int(v), 0xB1, 0xF, 0xF, true)); }
__device__ __forceinline__ float dpp_xor2(float v) { return __int_as_float(__builtin_amdgcn_update_dpp(0, __float_as_int(v), 0x4E, 0xF, 0xF, true)); }
__device__ __forceinline__ bf16x8 pack_p(const float* p) { u32x4 w; w.x = cvt_pk_bf16(p[0], p[1]); w.y = cvt_pk_bf16(p[2], p[3]); w.z = cvt_pk_bf16(p[4], p[5]); w.w = cvt_pk_bf16(p[6], p[7]); return __builtin_bit_cast(bf16x8, w); }
__device__ __forceinline__ bf16x8 scale_q(u32x4 v, float s) { u32x4 w; w.x = cvt_pk_bf16(bf_lo(v.x) * s, bf_hi(v.x) * s); w.y = cvt_pk_bf16(bf_lo(v.y) * s, bf_hi(v.y) * s); w.z = cvt_pk_bf16(bf_lo(v.z) * s, bf_hi(v.z) * s); w.w = cvt_pk_bf16(bf_lo(v.w) * s, bf_hi(v.w) * s); return __builtin_bit_cast(bf16x8, w); }
#define KREL(i, hi) (8 * (hi) + (i) + (((i) >= 8) ? 8 : 0))

__device__ __forceinline__ void flash_load(const bf16x8* kp, const bf16x8* vp, bf16x8 (&kf)[4], bf16x8 (&vf)[4]) {
#pragma unroll
    for (int s = 0; s < 4; ++s) kf[s] = kp[s * 64];
#pragma unroll
    for (int s = 0; s < 4; ++s) vf[s] = vp[s * 64];
    __builtin_amdgcn_sched_barrier(0);
}
__device__ __forceinline__ void flash_compute(bool domask, const bf16x8 (&kf)[4], const bf16x8 (&vf)[4], const bf16x8 (&q)[4], int x0, unsigned span, float& m, float& l, f32x16 (&O)[2]) {
    f32x16 sc;
#pragma unroll
    for (int i = 0; i < 16; ++i) sc[i] = 0.f;
#pragma unroll
    for (int s = 0; s < 4; ++s) sc = mfma32(kf[s], q[s], sc);
    if (domask) {
#pragma unroll
        for (int i = 0; i < 16; ++i) sc[i] = ((unsigned)(x0 + i + (i >= 8 ? 8 : 0)) <= span) ? sc[i] : -1e30f;
    }
    const float a0 = fmaxf(fmaxf(sc[0], sc[1]), sc[2]), a1 = fmaxf(fmaxf(sc[3], sc[4]), sc[5]), a2 = fmaxf(fmaxf(sc[6], sc[7]), sc[8]), a3 = fmaxf(fmaxf(sc[9], sc[10]), sc[11]), a4 = fmaxf(fmaxf(sc[12], sc[13]), sc[14]);
    float mx = fmaxf(fmaxf(fmaxf(a0, a1), fmaxf(a2, a3)), fmaxf(a4, sc[15]));
    mx = xhalf_max(mx);
    const float mn = fmaxf(m, mx);
    if (__ballot(mn > m) != 0ull) {
        const float alpha = ex2(m - mn); l *= alpha; O[0] = O[0] * alpha; O[1] = O[1] * alpha;
    }
    m = mn;
    const float msub = (mn < -1e29f) ? 0.f : mn;
    const f32x16 d = sc - msub;
    float p[16], ps = 0.f;
#pragma unroll
    for (int i = 0; i < 16; ++i) { p[i] = ex2(d[i]); ps += p[i]; }
    l += ps;
    const bf16x8 pb0 = pack_p(p), pb1 = pack_p(p + 8);
    O[0] = mfma32(vf[0], pb0, O[0]); O[1] = mfma32(vf[1], pb0, O[1]);
    O[0] = mfma32(vf[2], pb1, O[0]); O[1] = mfma32(vf[3], pb1, O[1]);
}
template <int MODE> __device__ __forceinline__ void flash_desc(int s, const LAS unsigned* list, int base, int t, int t0, int qi, int hi, int& tile, int& x0, unsigned& span, int& vm) {
    if constexpr (MODE == 0) {
        const unsigned e = (unsigned)__builtin_amdgcn_readfirstlane((int)list[s >> 1]);
        tile = 2 * (int)(e & 0xffffu) + (s & 1);
        const bool my = ((e >> 16) >> qi) & 1u; const int up = my ? (t - 32 * tile) : -1;
        x0 = up < 0 ? 64 : 8 * hi; span = up < 0 ? 0u : (unsigned)up;
        vm = (32 * tile + 31 <= t0) ? (((e >> 16) == 0xFFu) ? 0 : 1) : 2;
    } else {
        tile = base + s; x0 = 8 * hi - (t - 511 - 32 * tile); span = 511u;
        vm = (32 * tile + 31 <= t0 && 32 * tile >= t0 + 7 - 511) ? 0 : 2;
    }
}
template <int MODE> __device__ __forceinline__ void flash_run(const bf16x8* kb, const bf16x8* vb, const bf16x8 (&q)[4], int nsteps, const LAS unsigned* list, int base, int t, int t0, int qi, int hi, float& m, float& l, f32x16 (&O)[2]) {
    if (nsteps <= 0) return;
    bf16x8 kA[4], vA[4], kB[4], vB[4], kC[4], vC[4]; int x0A, x0B, x0C, vmA, vmB, vmC; unsigned spA, spB, spC;
#define FR_LOAD(S, KF, VF, X0, SP, VM) do { int tile_; const int sn_ = ((S) < nsteps) ? (S) : nsteps - 1; flash_desc<MODE>(sn_, list, base, t, t0, qi, hi, tile_, X0, SP, VM); \
        flash_load(kb + (size_t)tile_ * 256, vb + (size_t)tile_ * 256, KF, VF); } while (0)
    FR_LOAD(0, kA, vA, x0A, spA, vmA); FR_LOAD(1, kB, vB, x0B, spB, vmB);
#pragma unroll 1
    for (int s = 0; s < nsteps; s += 3) {
        FR_LOAD(s + 2, kC, vC, x0C, spC, vmC); flash_compute(vmA != 0, kA, vA, q, x0A, spA, m, l, O); if (s + 1 >= nsteps) break;
        FR_LOAD(s + 3, kA, vA, x0A, spA, vmA); flash_compute(vmB != 0, kB, vB, q, x0B, spB, m, l, O); if (s + 2 >= nsteps) break;
        FR_LOAD(s + 4, kB, vB, x0B, spB, vmB); flash_compute(vmC != 0, kC, vC, q, x0C, spC, m, l, O);
    }
#undef FR_LOAD
}

typedef float f32x4v __attribute__((ext_vector_type(4)));
__device__ __forceinline__ f32x4v mfma16(bf16x8 a, bf16x8 b, f32x4v c) { return __builtin_amdgcn_mfma_f32_16x16x32_bf16(a, b, c, 0, 0, 0); }
__device__ __forceinline__ float xq_max(float v) { const auto r = __builtin_amdgcn_permlane16_swap(__float_as_uint(v), __float_as_uint(v), false, false); return xhalf_max(fmaxf(__uint_as_float(r[0]), __uint_as_float(r[1]))); }
__device__ __forceinline__ float xq_sum(float v) { const auto r = __builtin_amdgcn_permlane16_swap(__float_as_uint(v), __float_as_uint(v), false, false); return xhalf_sum(__uint_as_float(r[0]) + __uint_as_float(r[1])); }
__device__ __forceinline__ void flash16_load(const bf16x8* kp, const bf16x8* vp, bf16x8 (&kf)[4], bf16x8 (&vf)[4]) {
#pragma unroll
    for (int s = 0; s < 4; ++s) kf[s] = kp[s * 64];
#pragma unroll
    for (int s = 0; s < 4; ++s) vf[s] = vp[s * 64];
    __builtin_amdgcn_sched_barrier(0);
}
__device__ __forceinline__ void flash16_compute(bool domask, const bf16x8 (&kf)[4], const bf16x8 (&vf)[4], const bf16x8 (&q)[2], int x0, unsigned span, float& m, float& l, f32x4v (&O)[4]) {
    f32x4v s0 = {0.f, 0.f, 0.f, 0.f}, s1 = {0.f, 0.f, 0.f, 0.f};
    s0 = mfma16(kf[0], q[0], s0); s1 = mfma16(kf[2], q[0], s1);
    s0 = mfma16(kf[1], q[1], s0); s1 = mfma16(kf[3], q[1], s1);
    float sc[8] = {s0[0], s0[1], s0[2], s0[3], s1[0], s1[1], s1[2], s1[3]};
    if (domask) {
#pragma unroll
        for (int j = 0; j < 8; ++j) sc[j] = ((unsigned)(x0 + j) <= span) ? sc[j] : -1e30f;
    }
    float mx = fmaxf(fmaxf(fmaxf(sc[0], sc[1]), fmaxf(sc[2], sc[3])), fmaxf(fmaxf(sc[4], sc[5]), fmaxf(sc[6], sc[7])));
    mx = xq_max(mx);
    const float mn = fmaxf(m, mx);
    if (__ballot(mn > m) != 0ull) {
        const float alpha = ex2(m - mn); l *= alpha;
#pragma unroll
        for (int dt = 0; dt < 4; ++dt) O[dt] = O[dt] * alpha;
    }
    m = mn;
    const float msub = (mn < -1e29f) ? 0.f : mn;
    float p[8], ps = 0.f;
#pragma unroll
    for (int j = 0; j < 8; ++j) { p[j] = ex2(sc[j] - msub); ps += p[j]; }
    l += ps;
    const bf16x8 pb = pack_p(p);
#pragma unroll
    for (int dt = 0; dt < 4; ++dt) O[dt] = mfma16(vf[dt], pb, O[dt]);
}
__device__ __forceinline__ void flash16_desc(int s, const LAS unsigned* list, int t, int tmin, int qi4, int fq, int& grp, int& x0, unsigned& span, int& vm) {
    const unsigned e = (unsigned)__builtin_amdgcn_readfirstlane((int)list[s >> 1]);
    grp = 2 * (int)(e & 0xffffu) + (s & 1);
    const bool my = ((e >> 16) >> qi4) & 1u; const int up = my ? (t - 32 * grp) : -1;
    x0 = up < 0 ? 64 : 8 * fq; span = up < 0 ? 0u : (unsigned)up;
    vm = (32 * grp + 31 <= tmin && (e >> 16) == 0xFu) ? 0 : 1;
}
__device__ __forceinline__ void flash16_run(const bf16x8* kb, const bf16x8* vb, const bf16x8 (&q)[2], int nsteps, const LAS unsigned* list, int t, int tmin, int qi4, int fq, float& m, float& l, f32x4v (&O)[4]) {
    if (nsteps <= 0) return;
    bf16x8 kA[4], vA[4], kB[4], vB[4], kC[4], vC[4]; int x0A, x0B, x0C, vmA, vmB, vmC; unsigned spA, spB, spC;
#define F16_LOAD(S, KF, VF, X0, SP, VM) do { int grp_; const int sn_ = ((S) < nsteps) ? (S) : nsteps - 1; flash16_desc(sn_, list, t, tmin, qi4, fq, grp_, X0, SP, VM); \
        flash16_load(kb + (size_t)grp_ * 256, vb + (size_t)grp_ * 256, KF, VF); } while (0)
    F16_LOAD(0, kA, vA, x0A, spA, vmA); F16_LOAD(1, kB, vB, x0B, spB, vmB);
#pragma unroll 1
    for (int s = 0; s < nsteps; s += 3) {
        F16_LOAD(s + 2, kC, vC, x0C, spC, vmC); flash16_compute(vmA != 0, kA, vA, q, x0A, spA, m, l, O); if (s + 1 >= nsteps) break;
        F16_LOAD(s + 3, kA, vA, x0A, spA, vmA); flash16_compute(vmB != 0, kB, vB, q, x0B, spB, m, l, O); if (s + 2 >= nsteps) break;
        F16_LOAD(s + 4, kB, vB, x0B, spB, vmB); flash16_compute(vmC != 0, kC, vC, q, x0C, spC, m, l, O);
    }
#undef F16_LOAD
}

__device__ __forceinline__ unsigned wave_max_u32(unsigned v) {
#pragma unroll
    for (int o = 1; o < 16; o <<= 1) { const unsigned t = (unsigned)__shfl_xor((int)v, o); v = v > t ? v : t; }
    { const auto r = __builtin_amdgcn_permlane16_swap(v, v, false, false); v = r[0] > r[1] ? r[0] : r[1]; }
    { const auto r = __builtin_amdgcn_permlane32_swap(v, v, false, false); v = r[0] > r[1] ? r[0] : r[1]; }
    return v;
}

__device__ __forceinline__ void nsa_tile(const Ctx& C, int b, int g, int t0) {
    const bf16_t* P = (const bf16_t*)(C.ws + WS_R1); bf16_t* Y = (bf16_t*)(C.ws + WS_Y);
    int lane_ = C.lane; asm volatile("" : "+v"(lane_));
    const int lane = lane_, r = lane & 31, hi = lane >> 5, qi = r >> 2, h = r & 3, head = g * 4 + h, bg = b * 2 + g;
    const int t = t0 + qi; const size_t tok = (size_t)b * S_ + t;
    LAS float* imp = (LAS float*)(C.lds + C.wave * 16640);
    LAS float* ost = (LAS float*)(C.lds + C.wave * 16640 + 8448) + lane;
    const float QS = 0.18033688011112042f;
    bf16x8 qf[4], qr[4];
    {
        const bf16_t* qp = P + tok * PP + PC_Q + head * 64;
#pragma unroll
        for (int s = 0; s < 4; ++s) qf[s] = scale_q(*(const u32x4*)(qp + 16 * s + 8 * hi), QS);
        const u32x4 mv4 = *(const u32x4*)(qp + 8 * hi), pv4 = *(const u32x4*)(qp + 8 * (hi ^ 1));
        const float* rt = (const float*)(C.ws + WS_ROPE) + tok * 16;
        const f32x4 ca = *(const f32x4*)rt, cb2 = *(const f32x4*)(rt + 4), sa = *(const f32x4*)(rt + 8), sb = *(const f32x4*)(rt + 12);
        const float cs[8] = {ca.x, ca.y, ca.z, ca.w, cb2.x, cb2.y, cb2.z, cb2.w}, sn[8] = {sa.x, sa.y, sa.z, sa.w, sb.x, sb.y, sb.z, sb.w};
        const float mv[8] = {bf_lo(mv4.x), bf_hi(mv4.x), bf_lo(mv4.y), bf_hi(mv4.y), bf_lo(mv4.z), bf_hi(mv4.z), bf_lo(mv4.w), bf_hi(mv4.w)};
        const float pp[8] = {bf_lo(pv4.x), bf_hi(pv4.x), bf_lo(pv4.y), bf_hi(pv4.y), bf_lo(pv4.z), bf_hi(pv4.z), bf_lo(pv4.w), bf_hi(pv4.w)};
        const float sg = hi ? 1.f : -1.f; float o[8];
#pragma unroll
        for (int e = 0; e < 8; ++e) o[e] = (mv[e] * cs[e] + sg * pp[e] * sn[e]) * QS;
        qr[0] = pack_p(o); qr[1] = qf[1]; qr[2] = qf[2]; qr[3] = qf[3];
    }
    const bf16_t* gp = P + tok * PP + PC_NG + head * 3;
    const float gc = sigm(bf1(gp[0])), gs = sigm(bf1(gp[1])), gw = sigm(bf1(gp[2]));

    const int cur = t0 >> 6;
    {
        const int nvq = (t >= 31) ? ((t - 31) >> 4) + 1 : 0;
        const int tl = t0 + 7, nvmax = (tl >= 31) ? ((tl - 31) >> 4) + 1 : 0, ntile = (nvmax + 31) >> 5;
        const bf16x8* kb = (const bf16x8*)(C.ws + WS_KCMP) + (size_t)bg * 32 * 4 * 64 + lane;
        const bf16x8* vb = (const bf16x8*)(C.ws + WS_VCMP) + (size_t)bg * 64 * 2 * 64 + lane;
        float m1 = -1e30f, l1 = 0.f;
#define CMP_P1(KF, KT) do { \
            f32x16 sc; _Pragma("unroll") for (int i = 0; i < 16; ++i) sc[i] = 0.f; \
            _Pragma("unroll") for (int s = 0; s < 4; ++s) sc = mfma32(KF[s], qf[s], sc); \
            const int up = nvq - 1 - 32 * (KT); const int x0 = up < 0 ? 64 : 8 * hi; const unsigned span = up < 0 ? 0u : (unsigned)up; \
            float mx = -1e30f; bool ok[16]; \
            _Pragma("unroll") for (int i = 0; i < 16; ++i) { ok[i] = (unsigned)(x0 + i + (i >= 8 ? 8 : 0)) <= span; sc[i] = ok[i] ? sc[i] : -1e30f; mx = fmaxf(mx, sc[i]); } \
            mx = xhalf_max(mx); \
            const float mn = fmaxf(m1, mx); float ps = 0.f; \
            _Pragma("unroll") for (int i = 0; i < 16; ++i) ps += ok[i] ? ex2(sc[i] - mn) : 0.f; \
            l1 = l1 * ex2(m1 - mn) + ps; m1 = mn; } while (0)
        if (ntile > 0) {
            bf16x8 kA[4], kB[4];
#pragma unroll
            for (int s = 0; s < 4; ++s) kA[s] = kb[s * 64];
#pragma unroll 1
            for (int kt = 0; kt < ntile; kt += 2) {
                { const int kn = (kt + 1 < ntile) ? kt + 1 : ntile - 1;
#pragma unroll
                  for (int s = 0; s < 4; ++s) kB[s] = kb[kn * 256 + s * 64]; }
                __builtin_amdgcn_sched_barrier(0);
                CMP_P1(kA, kt);
                if (kt + 1 >= ntile) break;
                { const int kn = (kt + 2 < ntile) ? kt + 2 : ntile - 1;
#pragma unroll
                  for (int s = 0; s < 4; ++s) kA[s] = kb[kn * 256 + s * 64]; }
                __builtin_amdgcn_sched_barrier(0);
                CMP_P1(kB, kt + 1);
            }
        }
#undef CMP_P1
        l1 = xhalf_sum(l1);
        const float inv = 1.f / fmaxf(l1, 1e-30f);
        for (int e = lane; e < 8 * 264; e += 64) imp[e] = 0.f;
        LDS_WAIT();
        f32x16 O[2];
#pragma unroll
        for (int i = 0; i < 16; ++i) { O[0][i] = 0.f; O[1][i] = 0.f; }
#define CMP_P2(KF, VF, KT) do { \
            f32x16 sc; _Pragma("unroll") for (int i = 0; i < 16; ++i) sc[i] = 0.f; \
            _Pragma("unroll") for (int s = 0; s < 4; ++s) sc = mfma32(KF[s], qf[s], sc); \
            const int up = nvq - 1 - 32 * (KT); const int x0 = up < 0 ? 64 : 8 * hi; const unsigned span = up < 0 ? 0u : (unsigned)up; \
            float p[16]; \
            _Pragma("unroll") for (int i = 0; i < 16; ++i) { const bool ok = (unsigned)(x0 + i + (i >= 8 ? 8 : 0)) <= span; p[i] = ok ? ex2(sc[i] - m1) * inv : 0.f; } \
            _Pragma("unroll") for (int rr = 0; rr < 2; ++rr) { \
                const float* q8 = p + 8 * rr; \
                float a = q8[0] + q8[1] + q8[2] + 0.5f * q8[3], bq = 0.5f * q8[3] + q8[4] + q8[5] + q8[6] + 0.5f * q8[7], cq = 0.5f * q8[7]; \
                a += dpp_xor1(a); a += dpp_xor2(a); bq += dpp_xor1(bq); bq += dpp_xor2(bq); cq += dpp_xor1(cq); cq += dpp_xor2(cq); \
                _Pragma("unroll") for (int hh = 0; hh < 2; ++hh)     \
                if (h == 0 && hi == hh) { LAS float* ip = imp + qi * 264 + 8 * (KT) + 2 * hi + 4 * rr; \
                    __hip_atomic_fetch_add(ip, a, __ATOMIC_RELAXED, __HIP_MEMORY_SCOPE_WORKGROUP); __hip_atomic_fetch_add(ip + 1, bq, __ATOMIC_RELAXED, __HIP_MEMORY_SCOPE_WORKGROUP); \
                    __hip_atomic_fetch_add(ip + 2, cq, __ATOMIC_RELAXED, __HIP_MEMORY_SCOPE_WORKGROUP); } \
            } \
            const bf16x8 pb0 = pack_p(p), pb1 = pack_p(p + 8); \
            O[0] = mfma32(VF[0], pb0, O[0]); O[1] = mfma32(VF[1], pb0, O[1]); \
            O[0] = mfma32(VF[2], pb1, O[0]); O[1] = mfma32(VF[3], pb1, O[1]); } while (0)
        if (ntile > 0) {
            bf16x8 kA[4], kB[4], vA[4];
#pragma unroll
            for (int s = 0; s < 4; ++s) kA[s] = kb[s * 64];
#pragma unroll 1
            for (int kt = 0; kt < ntile; kt += 2) {
                { const int kn = (kt + 1 < ntile) ? kt + 1 : ntile - 1;
#pragma unroll
                  for (int s = 0; s < 4; ++s) kB[s] = kb[kn * 256 + s * 64];
#pragma unroll
                  for (int s = 0; s < 4; ++s) vA[s] = vb[kt * 256 + s * 64]; }
                __builtin_amdgcn_sched_barrier(0);
                CMP_P2(kA, vA, kt);
                if (kt + 1 >= ntile) break;
                { const int kn = (kt + 2 < ntile) ? kt + 2 : ntile - 1;
#pragma unroll
                  for (int s = 0; s < 4; ++s) kA[s] = kb[kn * 256 + s * 64];
#pragma unroll
                  for (int s = 0; s < 4; ++s) vA[s] = vb[(kt + 1) * 256 + s * 64]; }
                __builtin_amdgcn_sched_barrier(0);
                CMP_P2(kB, vA, kt + 1);
            }
        }
#undef CMP_P2
#pragma unroll
        for (int i = 0; i < 16; ++i) { ost[i * 64] = gc * O[0][i]; ost[(16 + i) * 64] = gc * O[1][i]; }
        LDS_WAIT();
    }

    unsigned bmv[4];
    if (cur <= 15) {
#pragma unroll
        for (int c = 0; c < 4; ++c) bmv[c] = (lane + 64 * c <= cur) ? 0xFFu : 0u;
    } else {
        unsigned key[8][4];
#pragma unroll
        for (int q2 = 0; q2 < 8; ++q2)
#pragma unroll
            for (int c = 0; c < 4; ++c) { const int j = lane + 64 * c; const bool cand = (j >= 1) && (j < cur - 1); const float v = imp[q2 * 264 + j];
                key[q2][c] = cand ? ((__float_as_uint(v) & 0xFFFFFF00u) | (unsigned)(255 - j)) : 0u; }
#pragma unroll
        for (int c = 0; c < 4; ++c) bmv[c] = 0u;
#pragma unroll 1
        for (int round = 0; round < 13; ++round) {
#pragma unroll
            for (int q2 = 0; q2 < 8; ++q2) {
                unsigned mx = key[q2][0]; mx = mx > key[q2][1] ? mx : key[q2][1]; mx = mx > key[q2][2] ? mx : key[q2][2]; mx = mx > key[q2][3] ? mx : key[q2][3];
                const unsigned w = wave_max_u32(mx);
#pragma unroll
                for (int c = 0; c < 4; ++c) { const bool win = (key[q2][c] == w) && (w != 0u); key[q2][c] = win ? 0u : key[q2][c]; bmv[c] |= win ? (1u << q2) : 0u; }
            }
        }
#pragma unroll
        for (int c = 0; c < 4; ++c) { const int j = lane + 64 * c; if (j == 0 || j == cur || j == cur - 1) bmv[c] = 0xFFu; }
    }

    {
        LAS unsigned* list = (LAS unsigned*)imp;
        LAS float* ostb = (LAS float*)(C.lds + C.wave * 16640 + 8448);
        const int q16 = lane & 15, fq = lane >> 4, qi4 = q16 >> 2, head4 = g * 4 + (q16 & 3);
        const bf16x8* kb = (const bf16x8*)(C.ws + WS_KSLC) + (size_t)bg * 512 * 256 + lane;
        const bf16x8* vb = (const bf16x8*)(C.ws + WS_VSLC) + (size_t)bg * 512 * 256 + lane;
#pragma unroll 1
        for (int sub = 0; sub < 2; ++sub) {
            int nblk = 0;
#pragma unroll
            for (int c = 0; c < 4; ++c) {
                const unsigned nib = (bmv[c] >> (4 * sub)) & 0xFu;
                const unsigned long long mk = __ballot(nib != 0u);
                const int pos = nblk + (int)__builtin_amdgcn_mbcnt_hi((unsigned)(mk >> 32), __builtin_amdgcn_mbcnt_lo((unsigned)mk, 0u));
                if (nib != 0u) list[pos] = (unsigned)(lane + 64 * c) | (nib << 16);
                nblk += __builtin_popcountll(mk);
            }
            LDS_WAIT();
            const int tmin = t0 + 4 * sub, t4 = tmin + qi4; const size_t tok4 = (size_t)b * S_ + t4;
            bf16x8 q16f[2];
            {
                const bf16_t* qp = P + tok4 * PP + PC_Q + head4 * 64;
                q16f[1] = scale_q(*(const u32x4*)(qp + 32 + 8 * fq), QS);
                const u32x4 mv4 = *(const u32x4*)(qp + 8 * fq), pv4 = *(const u32x4*)(qp + 8 * ((fq ^ 1) & 1));
                const float* rt = (const float*)(C.ws + WS_ROPE) + tok4 * 16;
                const f32x4 ca = *(const f32x4*)rt, cb2 = *(const f32x4*)(rt + 4), sa = *(const f32x4*)(rt + 8), sb = *(const f32x4*)(rt + 12);
                const float cs[8] = {ca.x, ca.y, ca.z, ca.w, cb2.x, cb2.y, cb2.z, cb2.w}, sn[8] = {sa.x, sa.y, sa.z, sa.w, sb.x, sb.y, sb.z, sb.w};
                const float mv[8] = {bf_lo(mv4.x), bf_hi(mv4.x), bf_lo(mv4.y), bf_hi(mv4.y), bf_lo(mv4.z), bf_hi(mv4.z), bf_lo(mv4.w), bf_hi(mv4.w)};
                const float pp[8] = {bf_lo(pv4.x), bf_hi(pv4.x), bf_lo(pv4.y), bf_hi(pv4.y), bf_lo(pv4.z), bf_hi(pv4.z), bf_lo(pv4.w), bf_hi(pv4.w)};
                const bool roped = fq < 2; const float sg = (fq == 0) ? -1.f : 1.f; float o[8];
#pragma unroll
                for (int e = 0; e < 8; ++e) o[e] = (roped ? (mv[e] * cs[e] + sg * pp[e] * sn[e]) : mv[e]) * QS;
                q16f[0] = pack_p(o);
            }
            const float gs4 = sigm(bf1(P[tok4 * PP + PC_NG + head4 * 3 + 1]));
            float m = -1e30f, l = 0.f; f32x4v O[4];
#pragma unroll
            for (int dt = 0; dt < 4; ++dt) O[dt] = (f32x4v){0.f, 0.f, 0.f, 0.f};
            flash16_run(kb, vb, q16f, 2 * nblk, list, t4, tmin, qi4, fq, m, l, O);
            l = xq_sum(l);
            const float sc = gs4 / fmaxf(l, 1e-30f);
#pragma unroll
            for (int dt = 0; dt < 4; ++dt)
#pragma unroll
                for (int i = 0; i < 4; ++i) { LAS float* op = ostb + ((dt >> 1) * 16 + 4 * (2 * (dt & 1) + (fq >> 1)) + i) * 64 + 16 * sub + q16 + 32 * (fq & 1); *op += sc * O[dt][i]; }
            LDS_WAIT();
        }
    }
    {
        const bf16x8* kb = (const bf16x8*)(C.ws + WS_KWIN) + (size_t)bg * 512 * 4 * 64 + lane;
        const bf16x8* vb = (const bf16x8*)(C.ws + WS_VWIN) + (size_t)bg * 1024 * 2 * 64 + lane;
        float m = -1e30f, l = 0.f; f32x16 O[2];
#pragma unroll
        for (int i = 0; i < 16; ++i) { O[0][i] = 0.f; O[1][i] = 0.f; }
        const int tlo = (t0 - 511 > 0 ? t0 - 511 : 0) >> 5, thi = (t0 + 7) >> 5;
        flash_run<1>(kb, vb, qr, thi - tlo + 1, (const LAS unsigned*)imp, tlo, t, t0, qi, hi, m, l, O);
        l = xhalf_sum(l);
        const float sc = gw / fmaxf(l, 1e-30f);
        bf16_t* yp = Y + tok * YP + 512 + head * 64 + 4 * hi;
#pragma unroll
        for (int dt = 0; dt < 2; ++dt)
#pragma unroll
            for (int ig = 0; ig < 4; ++ig) { float o4[4];
#pragma unroll
                for (int e = 0; e < 4; ++e) o4[e] = ost[(dt * 16 + 4 * ig + e) * 64] + sc * O[dt][4 * ig + e];
                u32x2 w; w.x = cvt_pk_bf16(o4[0], o4[1]); w.y = cvt_pk_bf16(o4[2], o4[3]); *(u32x2*)(yp + 32 * dt + 8 * ig) = w; }
        LDS_WAIT();
    }
}

__device__ __forceinline__ void mem_tile(const Ctx& C, int b, int hm, int t0) {
    const bf16_t* P = (const bf16_t*)(C.ws + WS_R1); bf16_t* Y = (bf16_t*)(C.ws + WS_Y);
    const int lane = C.lane, r = lane & 31, hi = lane >> 5;
    const size_t tok = (size_t)b * S_ + t0 + r;
    const float QS = 0.12751743082459868f;
    bf16x8 q[8];
    const bf16_t* qp = P + tok * PP + PC_QM + hm * 128;
#pragma unroll
    for (int s = 0; s < 8; ++s) q[s] = scale_q(*(const u32x4*)(qp + 16 * s + 8 * hi), QS);
    const bf16x8* kb = (const bf16x8*)(C.ws + WS_MEMK) + (size_t)(b * 4 + hm) * 8 * 8 * 64 + lane;
    const bf16x8* vb = (const bf16x8*)(C.ws + WS_MEMV) + (size_t)(b * 4 + hm) * 16 * 4 * 64 + lane;
    float m = -1e30f, l = 0.f; f32x16 O[4];
#pragma unroll
    for (int i = 0; i < 16; ++i) { O[0][i] = 0.f; O[1][i] = 0.f; O[2][i] = 0.f; O[3][i] = 0.f; }
#define MEM_STEP(KF, VF) do { \
        f32x16 sc; _Pragma("unroll") for (int i = 0; i < 16; ++i) sc[i] = 0.f; \
        _Pragma("unroll") for (int s = 0; s < 8; ++s) sc = mfma32(KF[s], q[s], sc); \
        float mx = -1e30f; _Pragma("unroll") for (int i = 0; i < 16; ++i) mx = fmaxf(mx, sc[i]); \
        mx = xhalf_max(mx); \
        const float mn = fmaxf(m, mx), alpha = ex2(m - mn); m = mn; \
        float p[16], ps = 0.f; _Pragma("unroll") for (int i = 0; i < 16; ++i) { p[i] = ex2(sc[i] - mn); ps += p[i]; } \
        l = l * alpha + ps; \
        _Pragma("unroll") for (int i = 0; i < 16; ++i) { O[0][i] *= alpha; O[1][i] *= alpha; O[2][i] *= alpha; O[3][i] *= alpha; } \
        const bf16x8 pb0 = pack_p(p), pb1 = pack_p(p + 8); \
        _Pragma("unroll") for (int dt = 0; dt < 4; ++dt) { O[dt] = mfma32(VF[dt], pb0, O[dt]); O[dt] = mfma32(VF[4 + dt], pb1, O[dt]); } } while (0)
    {
        bf16x8 kA[8], vv[8];
#pragma unroll 1
        for (int kt = 0; kt < 8; ++kt) {
#pragma unroll
            for (int s = 0; s < 8; ++s) kA[s] = kb[kt * 512 + s * 64];
#pragma unroll
            for (int s = 0; s < 8; ++s) vv[s] = vb[kt * 512 + s * 64];
            __builtin_amdgcn_sched_barrier(0);
            MEM_STEP(kA, vv);
        }
    }
#undef MEM_STEP
    l = xhalf_sum(l);
    const float inv = 1.f / l;
    bf16_t* yp = Y + tok * YP + 1024 + hm * 128 + 4 * hi;
#pragma unroll
    for (int dt = 0; dt < 4; ++dt)
#pragma unroll
        for (int ig = 0; ig < 4; ++ig) { u32x2 w; w.x = cvt_pk_bf16(O[dt][4 * ig] * inv, O[dt][4 * ig + 1] * inv); w.y = cvt_pk_bf16(O[dt][4 * ig + 2] * inv, O[dt][4 * ig + 3] * inv); *(u32x2*)(yp + 32 * dt + 8 * ig) = w; }
}

__device__ __forceinline__ void attention_phase(const Ctx& C) {
    const int bxx = C.gw / NWAVES; const bool xmode = (C.G & 7) == 0;
    const int x = bxx & 7, rank = xmode ? (bxx >> 3) * NWAVES + C.wave : C.gw, nrank = xmode ? (C.G >> 3) * NWAVES : C.NGW, nitem = xmode ? 1536 : 12288;
    for (int i = rank; i < nitem; i += nrank) {
        int nsa_n, mem_e;
        if (xmode) { nsa_n = (i < 1024) ? (x >> 1) * 2048 + 2 * i + (x & 1) : -1; mem_e = x * 512 + (i - 1024); }
        else { if (i < 8192) { const int k = i >> 11, w = i & 2047; nsa_n = k * 2048 + ((k & 1) ? 2047 - w : w); } else nsa_n = -1; mem_e = i - 8192; }
        if (nsa_n >= 0) { const int k = nsa_n >> 11; nsa_tile(C, k >> 1, k & 1, (nsa_n & 2047) * 8); }
        else { const int bh = mem_e >> 9; mem_tile(C, bh >> 2, bh & 3, (mem_e & 511) * 32); }
    }
}

#define XB_TMO      128
#define XB_XCNT(j)  (256  + 64 * (j))
#define XB_XSUB(j)  (1280 + 64 * (j))
#define XB_XGEN(j)  (2304 + 64 * (j))
#define XB_TOP      3328
#define XB_TOPGEN   3392
#define XCD_BAR_WORDS 3456
#define XB_SPIN_CAP (1u << 18)
__device__ __forceinline__ unsigned xb_ld(unsigned* p)              { return __hip_atomic_load(p, __ATOMIC_RELAXED, __HIP_MEMORY_SCOPE_AGENT); }
__device__ __forceinline__ unsigned xb_add(unsigned* p, unsigned v) { return __hip_atomic_fetch_add(p, v, __ATOMIC_RELAXED, __HIP_MEMORY_SCOPE_AGENT); }
__device__ __forceinline__ unsigned xb_xcc_id() { return (unsigned)__builtin_amdgcn_s_getreg((3 << 11) | 20) & 0xFu; }
#define XB_SPIN(cond, bar) do { unsigned _sp = 0; while (cond) { __builtin_amdgcn_s_sleep(1); \
    if ((++_sp & 255u) == 0u) { if (xb_ld(&(bar)[XB_TMO])) break; if (_sp > XB_SPIN_CAP) { atomicAdd(&(bar)[XB_TMO], 1u); break; } } } } while (0)
__device__ __forceinline__ void xcd_barrier_complete(unsigned* bar, unsigned x, unsigned& nloc, unsigned& nx) {
    const unsigned G = gridDim.x * gridDim.y * gridDim.z;
    unsigned sum, cnt, mine, sp = 0u;
    for (;;) {
        sum = 0u; cnt = 0u; mine = 0u;
#pragma unroll
        for (unsigned j = 0; j < 16; ++j) { const unsigned c = xb_ld(&bar[XB_XCNT(j)]); sum += c; cnt += (c > 0u) ? 1u : 0u; mine = (j == x) ? c : mine; }
        if (sum == G) break;
        __builtin_amdgcn_s_sleep(1);
        if ((++sp & 255u) == 0u) { if (xb_ld(&bar[XB_TMO])) break; if (sp > XB_SPIN_CAP) { atomicAdd(&bar[XB_TMO], 1u); break; } }
    }
    nloc = mine > 0u ? mine : 1u; nx = cnt > 0u ? cnt : 1u;
}
__device__ __forceinline__ void xcd_barrier(unsigned* bar, volatile LAS unsigned* st, bool tid0) {
    asm volatile("s_waitcnt vmcnt(0)" ::: "memory");
    __syncthreads();
    if (tid0) {
        __builtin_amdgcn_s_waitcnt(0);
        const unsigned x = xb_xcc_id();
        unsigned nloc = st[0], nx = st[1];
        if (nloc == 0u) { xcd_barrier_complete(bar, x, nloc, nx); st[0] = nloc; st[1] = nx; }
        const unsigned old = xb_add(&bar[XB_XSUB(x)], 1u);
        const unsigned gen = old / nloc;
        if (old + 1u == (gen + 1u) * nloc) {
            __builtin_amdgcn_fence(__ATOMIC_RELEASE, "agent");
            asm volatile("s_waitcnt vmcnt(0)" ::: "memory");
            const unsigned og = xb_add(&bar[XB_TOP], 1u);
            const unsigned tg = og / nx;
            if (og + 1u == (tg + 1u) * nx) xb_add(&bar[XB_TOPGEN], 1u);
            else XB_SPIN(xb_ld(&bar[XB_TOPGEN]) == tg, bar);
            __builtin_amdgcn_fence(__ATOMIC_ACQUIRE, "agent");
            xb_add(&bar[XB_XGEN(x)], 1u);
            asm volatile("s_waitcnt vmcnt(0)" ::: "memory");
        } else {
            XB_SPIN(xb_ld(&bar[XB_XGEN(x)]) == gen, bar);
            __builtin_amdgcn_fence(__ATOMIC_ACQUIRE, "agent");
            asm volatile("s_waitcnt vmcnt(0)" ::: "memory");
        }
    }
    __syncthreads();
}

constexpr int LDS_BYTES = 147456, XB_LDS_OFF = 147456 - 64;
constexpr int NPHASE = 1 + 2 * 14;

__global__ void __launch_bounds__(NWAVES * 64, 2) fwd_kernel(Args args) {
    extern __shared__ __attribute__((aligned(16))) unsigned char lds_raw[];
    cg::grid_group grid = cg::this_grid();
    if (args.ph_lo == 0x7fffffff) grid.sync();
    const int wave0 = __builtin_amdgcn_readfirstlane((int)threadIdx.x >> 6);
    {
        volatile LAS unsigned* st = (volatile LAS unsigned*)(lds_raw + XB_LDS_OFF);
        if (threadIdx.x == 0) { st[0] = 0u; st[1] = 0u; (void)xb_add((unsigned*)(args.ws + WS_BAR) + XB_XCNT(xb_xcc_id()), 1u); }
        __syncthreads();
    }
#define PHASE_BEGIN { \
        unsigned char* ws0_ = args.ws; asm volatile("" : "+s"(ws0_)); gu8* ws = (gu8*)ws0_;     \
        int tid_; asm volatile("v_mbcnt_lo_u32_b32 %0, -1, 0\n\tv_mbcnt_hi_u32_b32 %0, -1, %0" : "=v"(tid_)); tid_ += wave0 * 64; \
        Ctx C; C.a = &args; C.ws = ws; C.lds = (LAS unsigned char*)lds_raw; C.tid = tid_; C.lane = tid_ & 63; C.wave = __builtin_amdgcn_readfirstlane(tid_ >> 6); \
        int bx = blockIdx.x; asm volatile("" : "+s"(bx)); C.G = gridDim.x; C.gw = bx * NWAVES + C.wave; C.NGW = C.G * NWAVES; \
        bf16_t* const H = (bf16_t*)(ws + WS_H); bf16_t* const R1 = (bf16_t*)(ws + WS_R1); bf16_t* const Y = (bf16_t*)(ws + WS_Y); (void)H; (void)R1; (void)Y; (void)bx;
#define PHASE_END   xcd_barrier((unsigned*)(ws + WS_BAR), (volatile LAS unsigned*)(lds_raw + XB_LDS_OFF), tid_ == 0); }
#define PHASE_END_CG grid.sync(); }

    PHASE_BEGIN
        convert_layer(C, 0);
        rope_table(C);
        prenorm_rows(C, (const float*)args.in[0], (const float*)args.in[3], H);
    PHASE_END

#pragma unroll 1
    for (int l = 0; l < 2; ++l) {
        PHASE_BEGIN
            { pg8::GemmDesc g{(const char*)H, (const char*)(ws + WS_W1IN), DM, DM, 128, 128, 16}; pg8::StdOrder S; S.init(T_, 2 * FF, C.G, bx, DM, DM);
              pg8::Epi<1> E{R1, FF, nullptr, nullptr}; pg8::gemm_phase(C.lds, C.tid, g, S, E); }
        PHASE_END
        PHASE_BEGIN
            { pg8::GemmDesc g{(const char*)R1, (const char*)(ws + WS_W1OUT), FF, FF, 128, 128, 44}; pg8::StdOrder S; S.init(T_, DM, C.G, bx, FF, FF);
              pg8::Epi<0> E{H, DM, nullptr, nullptr}; pg8::gemm_phase(C.lds, C.tid, g, S, E); }
        PHASE_END
        PHASE_BEGIN
            if (bx < 8) {
                { pg8::GemmDesc g{(const char*)(ws + WS_MEMN), (const char*)(ws + WS_WMKV), DM, DM, 128, 128, 16}; pg8::StdOrder S; S.init(512, DM, C.G, bx, DM, DM);
              pg8::Epi<0> E{(bf16_t*)(ws + WS_MKV), DM, nullptr, nullptr}; pg8::gemm_phase(C.lds, C.tid, g, S, E); }
            } else {
                norm_phase(C, C.gw - 8 * NWAVES, C.NGW - 8 * NWAVES, l == 0 ? (const float*)args.in[0] : args.out, args.out, H, H, INF(4, l, DM), INF(7, l, DM), 0.5f);
            }
            cb_reduce(C, l);
        PHASE_END
        PHASE_BEGIN
            { pg8::GemmDesc g{(const char*)H, (const char*)(ws + WS_WMIX), DM, DM, 128, 128, 16}; pg8::StdOrder S; S.init(T_, PP, C.G, bx, DM, DM);
              pg8::Epi<0> E{R1, PP, nullptr, nullptr}; pg8::gemm_phase(C.lds, C.tid, g, S, E); }
        PHASE_END
        PHASE_BEGIN
            if (bx < 32) {
                pg8::GemmDesc g{(const char*)R1, (const char*)(ws + WS_WC1), 16 * PP, 2048, PP * 2, 128, 32}; pg8::CmpOrder S{bx};
                pg8::Epi<4> E{(bf16_t*)(ws + WS_CMPH), 256, nullptr, (const float*)(ws + WS_CB) + l * 512}; pg8::gemm_phase(C.lds, C.tid, g, S, E);
            } else {
                prep_items(C, l, C.gw - 32 * NWAVES, C.NGW - 32 * NWAVES);
                memkv_ops(C, C.gw - 32 * NWAVES, C.NGW - 32 * NWAVES);
            }
        PHASE_END
        PHASE_BEGIN
            cmp_stage2(C, l);
        PHASE_END
        PHASE_BEGIN
            attention_phase(C);
        PHASE_END
        PHASE_BEGIN
            { pg8::GemmDesc g{(const char*)H, (const char*)(ws + WS_WG), DM, DM, 128, 128, 16}; pg8::StdOrder S; S.init(T_, GP, C.G, bx, DM, DM);
              pg8::Epi<2> E{R1, GP, nullptr, nullptr}; pg8::gemm_phase(C.lds, C.tid, g, S, E); }
        PHASE_END
        PHASE_BEGIN
            { pg8::GemmDesc g{(const char*)Y, (const char*)(ws + WS_WBR), YP, YP, 128, 128, 8}; pg8::MergeOrder S; S.init(T_, DM, C.G, bx, YP, YP);
              pg8::Epi<3> E{H, DM, R1, nullptr}; pg8::gemm_phase(C.lds, C.tid, g, S, E); }
        PHASE_END
        PHASE_BEGIN
            { pg8::GemmDesc g{(const char*)H, (const char*)(ws + WS_WOUT), DM, DM, 128, 128, 16}; pg8::StdOrder S; S.init(T_, DM, C.G, bx, DM, DM);
              pg8::Epi<0> E{R1, DM, nullptr, nullptr}; pg8::gemm_phase(C.lds, C.tid, g, S, E); }
        PHASE_END
        PHASE_BEGIN
            norm_phase(C, C.gw, C.NGW, args.out, args.out, R1, H, INF(8, l, DM), INF(25, l, DM), 1.0f);
        PHASE_END
        PHASE_BEGIN
            { pg8::GemmDesc g{(const char*)H, (const char*)(ws + WS_W2IN), DM, DM, 128, 128, 16}; pg8::StdOrder S; S.init(T_, 2 * FF, C.G, bx, DM, DM);
              pg8::Epi<1> E{R1, FF, nullptr, nullptr}; pg8::gemm_phase(C.lds, C.tid, g, S, E); }
        PHASE_END
        PHASE_BEGIN
            { pg8::GemmDesc g{(const char*)R1, (const char*)(ws + WS_W2OUT), FF, FF, 128, 128, 44}; pg8::StdOrder S; S.init(T_, DM, C.G, bx, FF, FF);
              pg8::Epi<0> E{H, DM, nullptr, nullptr}; pg8::gemm_phase(C.lds, C.tid, g, S, E); }
        PHASE_END
        PHASE_BEGIN
            norm_phase(C, C.gw, C.NGW, args.out, args.out, H, H, INF(26, l, DM), l == 0 ? INF(3, 1, DM) : nullptr, 0.5f);
            if (l == 0) convert_layer(C, 1);
        PHASE_END
    }
}

extern "C" void kernel_launch(void* const* d_in, const int* in_sizes, int n_in, void* d_out, int out_size, void* d_ws, size_t ws_size, hipStream_t stream) {
    static int grid = 0;
    if (grid == 0) {
        if (n_in != 29 || ws_size < WS_END) { fprintf(stderr, "kernel_launch: unexpected n_in %d / ws %zu\n", n_in, ws_size); grid = -1; return; }
        int dev = 0, cus = 0, per_cu = 0;
        hipGetDevice(&dev); hipDeviceGetAttribute(&cus, hipDeviceAttributeMultiprocessorCount, dev);
        hipFuncSetAttribute((const void*)fwd_kernel, hipFuncAttributeMaxDynamicSharedMemorySize, LDS_BYTES);
        hipOccupancyMaxActiveBlocksPerMultiprocessor(&per_cu, (const void*)fwd_kernel, NWAVES * 64, LDS_BYTES);
        if (per_cu < 1) per_cu = 1;
        grid = cus * per_cu;
        (void)hipGetLastError();
    }
    if (grid < 0) return;
    hipMemsetAsync((char*)d_ws + WS_BAR, 0, 16384, stream);
    Args a{};
    for (int i = 0; i < 29; ++i) a.in[i] = d_in[i];
    a.out = (float*)d_out; a.ws = (unsigned char*)d_ws; a.ph_lo = 0; a.ph_hi = NPHASE;
    void* kargs[] = {&a};
    hipError_t e = hipLaunchCooperativeKernel((const void*)fwd_kernel, dim3(grid), dim3(NWAVES * 64), kargs, LDS_BYTES, stream);
    if (e != hipSuccess) fprintf(stderr, "cooperative launch failed: %s (grid %d)\n", hipGetErrorString(e), grid);
}
```

```cpp
#include <hip/hip_runtime.h>
#include <hip/hip_cooperative_groups.h>
#include <cstdio>
#include <cstdint>
namespace cg = cooperative_groups;

#define LAS __attribute__((address_space(3)))
typedef unsigned short bf16_t;
typedef short bf16x8 __attribute__((ext_vector_type(8)));
typedef float f32x4 __attribute__((ext_vector_type(4)));
typedef float f32x16 __attribute__((ext_vector_type(16)));
typedef unsigned u32x4 __attribute__((ext_vector_type(4)));
typedef unsigned u32x2 __attribute__((ext_vector_type(2)));

constexpr int NBATCH = 2, S_ = 16384, T_ = NBATCH * S_, DM = 1024, FF = 2816, PP = 3584, GP = 3072, YP = 1536;
constexpr int NWAVES = 8;
constexpr float EPS = 1e-6f;
constexpr int PC_Q = 1536, PC_KV = 2048, PC_QM = 2816, PC_NG = 3328;

constexpr size_t MiB = 1u << 20;
constexpr size_t WS_W1IN = 0, WS_W1OUT = 11 * MiB, WS_WMIX = WS_W1OUT + 11 * MiB / 2, WS_WG = WS_WMIX + 7 * MiB, WS_WBR = WS_WG + 6 * MiB, WS_WOUT = WS_WBR + 3 * MiB,
                 WS_W2IN = WS_WOUT + 2 * MiB, WS_W2OUT = WS_W2IN + 11 * MiB, WS_WC1 = WS_W2OUT + 11 * MiB / 2  , WS_WMKV = WS_WC1 + 2 * MiB,
                 WS_MEMN = WS_WMKV + 2 * MiB, WS_MKV = WS_MEMN + 1 * MiB, WS_CB = WS_MKV + 1 * MiB  , WS_CBP = WS_CB + 8192  , WS_BAR = WS_CB + 8192 + 131072  ;
static_assert(WS_CB == 57 * MiB, "ws map");
constexpr size_t WS_ROPE = 58 * MiB, WS_MEMK = 60 * MiB, WS_MEMV = WS_MEMK + MiB / 2, WS_KCMP = 61 * MiB, WS_VCMP = WS_KCMP + MiB / 2, WS_CMPH = 62 * MiB,
                 WS_KSLC = 66 * MiB, WS_VSLC = 74 * MiB, WS_KWIN = 82 * MiB, WS_VWIN = 90 * MiB, WS_H = 98 * MiB, WS_Y = 162 * MiB, WS_R1 = 258 * MiB, WS_END = 483 * MiB;

typedef float f32x2_t __attribute__((ext_vector_type(2)));
typedef __bf16 bf16x2_t __attribute__((ext_vector_type(2)));
__device__ __forceinline__ unsigned cvt_pk_bf16(float lo, float hi) { f32x2_t v = {lo, hi}; bf16x2_t b = __builtin_convertvector(v, bf16x2_t); return __builtin_bit_cast(unsigned, b); }
__device__ __forceinline__ float bf_lo(unsigned u) { return __uint_as_float(u << 16); }
__device__ __forceinline__ float bf_hi(unsigned u) { return __uint_as_float(u & 0xffff0000u); }
__device__ __forceinline__ float bf1(bf16_t u) { return __uint_as_float(((unsigned)u) << 16); }
__device__ __forceinline__ float ex2(float x) { return __builtin_amdgcn_exp2f(x); }
__device__ __forceinline__ float rcpf_(float x) { return __builtin_amdgcn_rcpf(x); }
__device__ __forceinline__ float sigm(float x) { return rcpf_(1.f + ex2(-1.44269504f * x)); }
__device__ __forceinline__ float gelu_tanh(float x) { const float u = 0.7978845608f * (x + 0.044715f * x * x * x); return x * rcpf_(1.f + ex2(-2.88539008f * u)); }
__device__ __forceinline__ float wave_sum(float v) {
#pragma unroll
    for (int o = 1; o < 64; o <<= 1) v += __shfl_xor(v, o);
    return v;
}
__device__ __forceinline__ int pi32(int r) { return (r & 0x13) | ((r & 4) << 1) | ((r & 8) >> 1); }
#define LDS_WAIT() asm volatile("s_waitcnt lgkmcnt(0)" ::: "memory")

namespace pg8 {
constexpr int BM = 256, BK = 64, HALF = 128, HTB = HALF * BK * 2, STAGE_BYTES = 8 * HTB, NXCD = 8, WGM = 8;
__device__ __forceinline__ int lds_byte(int r, int c) { const int st = (r >> 4) * 2 + (c >> 5), rr = r & 15, cc = c & 31, ob = rr * 64 + cc * 2; return st * 1024 + (ob ^ (((ob >> 9) & 1) << 5)); }
__device__ __forceinline__ void stage_rc(int b, int& R, int& C) { const int st = b / 1024, sb = b % 1024, swz = sb ^ (((sb >> 9) & 1) << 5); R = (st >> 1) * 16 + swz / 64; C = (st & 1) * 32 + (swz % 64) / 2; }
__device__ __forceinline__ int perm32(int rho) { const int n = rho >> 4, i = rho & 15; return 8 * (i >> 2) + 4 * n + (i & 3); }

struct Unit { int pm, pn, tag; long long aoff, boff; };
struct GemmDesc { const char* A; const char* Bt; int lda, ldb, kstepA, kstepB, nt; };

__device__ __forceinline__ void swz_tile(int L, int nM, int nN, int& pm, int& pn) {
    const int nwg = nM * nN; int wgid = L;
    { const int q = nwg / NXCD, r = nwg % NXCD, xcd = wgid % NXCD, off = wgid / NXCD; wgid = (xcd < r ? xcd * (q + 1) : r * (q + 1) + (xcd - r) * q) + off; }
    const int nig = WGM * nN, gid = wgid / nig, fm = gid * WGM, gsz = (nM - fm) < WGM ? (nM - fm) : WGM;
    pm = fm + ((wgid % nig) % gsz); pn = (wgid % nig) / gsz;
}
struct StdOrder {
    int nM, nN, G, c; long long tA, tB;
    __device__ void init(int M, int N, int G_, int c_, int lda, int ldb) { nM = M / BM; nN = N / BM; G = G_; c = c_; tA = 512LL * lda; tB = 512LL * ldb; }
    __device__ bool next(int i, Unit& u) const {
        const long long L = (long long)i * G + c; if (L >= (long long)nM * nN) return false;
        swz_tile((int)L, nM, nN, u.pm, u.pn); u.tag = 0; u.aoff = u.pm * tA; u.boff = u.pn * tB; return true;
    }
};
struct MergeOrder {
    int nM, nN, G, c; long long tA, tB;
    __device__ void init(int M, int N, int G_, int c_, int lda, int ldb) { nM = M / BM; nN = N / BM; G = G_; c = c_; tA = 512LL * lda; tB = 512LL * ldb; }
    __device__ bool next(int i, Unit& u) const {
        const int ti = i / 3, br = i - 3 * ti; const long long L = (long long)ti * G + c; if (L >= (long long)nM * nN) return false;
        swz_tile((int)L, nM, nN, u.pm, u.pn); u.tag = br; u.aoff = u.pm * tA + br * 1024; u.boff = u.pn * tB + br * 1024; return true;
    }
};
struct CmpOrder {
    int c;
    __device__ bool next(int i, Unit& u) const {
        if (i != 0 || c >= 32) return false;
        const int kv = c >> 4, bg = (c >> 2) & 3, tile = c & 3, b = bg >> 1, g = bg & 1;
        u.pm = c; u.pn = 0; u.tag = kv;
        u.aoff = 2LL * (((long long)b * S_ + 4096LL * tile) * PP + PC_KV + kv * 128 + g * 64);
        u.boff = (long long)kv * (256 * 2048 * 2); return true;
    }
};

__device__ __forceinline__ u32x4 pack8(f32x4 a, f32x4 b) { u32x4 w; w.x = cvt_pk_bf16(a[0], a[1]); w.y = cvt_pk_bf16(a[2], a[3]); w.z = cvt_pk_bf16(b[0], b[1]); w.w = cvt_pk_bf16(b[2], b[3]); return w; }
template <int MODE> struct Epi {
    bf16_t* O; int ldc; const bf16_t* G; const float* bias;
    __device__ __forceinline__ void operator()(const f32x4 (&acc)[2][2][4][2], const Unit& u, int wr, int wc, int fr, int fq) const {
        const int row0 = u.pm * BM + wr * 64 + fr;
        if constexpr (MODE == 1) {
            const int col0 = u.pn * 128 + wc * 32 + 8 * fq;
#pragma unroll
            for (int ai = 0; ai < 2; ++ai)
#pragma unroll
                for (int m = 0; m < 4; ++m) {
                    bf16_t* rowp = O + (size_t)(row0 + ai * HALF + m * 16) * ldc + col0;
                    f32x4 v0, v1;
#pragma unroll
                    for (int e = 0; e < 4; ++e) { const float a0 = acc[ai][0][m][0][e], a1 = acc[ai][0][m][1][e]; v0[e] = a0 * sigm(a0) * acc[ai][1][m][0][e]; v1[e] = a1 * sigm(a1) * acc[ai][1][m][1][e]; }
                    *(u32x4*)rowp = pack8(v0, v1);
                    __builtin_amdgcn_sched_barrier(0);
                }
        } else {
            const int col0 = u.pn * BM + wc * 32 + 8 * fq;
#pragma unroll
            for (int ai = 0; ai < 2; ++ai)
#pragma unroll
                for (int m = 0; m < 4; ++m) {
                    const size_t row = (size_t)(row0 + ai * HALF + m * 16);
#pragma unroll
                    for (int bj = 0; bj < 2; ++bj) {
                        const int col = col0 + bj * HALF;
                        f32x4 v0 = acc[ai][bj][m][0], v1 = acc[ai][bj][m][1];
                        bf16_t* dst = O + row * ldc + col;
                        if constexpr (MODE == 2) {
#pragma unroll
                            for (int e = 0; e < 4; ++e) { v0[e] = sigm(v0[e]); v1[e] = sigm(v1[e]); }
                        }
                        if constexpr (MODE == 4) {
                            const f32x4 b0 = *(const f32x4*)(bias + u.tag * 256 + col), b1 = *(const f32x4*)(bias + u.tag * 256 + col + 4);
#pragma unroll
                            for (int e = 0; e < 4; ++e) { v0[e] = gelu_tanh(v0[e] + b0[e]); v1[e] = gelu_tanh(v1[e] + b1[e]); }
                        }
                        if constexpr (MODE == 3) {
                            const u32x4 gv = *(const u32x4*)(G + row * GP + u.tag * 1024 + col);
                            v0[0] *= bf_lo(gv.x); v0[1] *= bf_hi(gv.x); v0[2] *= bf_lo(gv.y); v0[3] *= bf_hi(gv.y);
                            v1[0] *= bf_lo(gv.z); v1[1] *= bf_hi(gv.z); v1[2] *= bf_lo(gv.w); v1[3] *= bf_hi(gv.w);
                            if (u.tag > 0) {
                                const u32x4 ov = *(const u32x4*)dst;
                                v0[0] += bf_lo(ov.x); v0[1] += bf_hi(ov.x); v0[2] += bf_lo(ov.y); v0[3] += bf_hi(ov.y);
                                v1[0] += bf_lo(ov.z); v1[1] += bf_hi(ov.z); v1[2] += bf_lo(ov.w); v1[3] += bf_hi(ov.w);
                            }
                        }
                        *(u32x4*)dst = pack8(v0, v1);
                    }
                }
        }
    }
};

template <class EpiT, class Sched>
__device__ __forceinline__ void gemm_phase(LAS unsigned char* lds, int tid_in, const GemmDesc g, const Sched& S, const EpiT& E) {
    int tid_ = tid_in; asm volatile("" : "+v"(tid_));
    const int tid = tid_, wid = __builtin_amdgcn_readfirstlane(tid >> 6), lane = tid & 63, wr = wid >> 2, wc = wid & 3, fr = lane & 15, fq = lane >> 4;
    const int nt = g.nt;
    unsigned voffA[2], voffB[2];
#pragma unroll
    for (int i = 0; i < 2; ++i) { int R, C; stage_rc(tid * 16 + i * 8192, R, C); const int Rb = (R & ~31) + perm32(R & 31);
        voffA[i] = (unsigned)(R * g.lda + C) * 2u; voffB[i] = (unsigned)(Rb * g.ldb + C) * 2u; }
    const size_t kA = (size_t)g.kstepA, kB = (size_t)g.kstepB;
    const size_t hA = (size_t)HALF * g.lda * 2, hB = (size_t)HALF * g.ldb * 2;
    const unsigned ldsw = (unsigned)wid * 1024u;
    const int aoff = lds_byte(wr * 64 + fr, fq * 8), boff = lds_byte(wc * 32 + fr, fq * 8);
#define PG8_SA(b, h) (((b) * 2 + (h)) * HTB)
#define PG8_SB(b, h) ((4 + (b) * 2 + (h)) * HTB)
#define PG8_STAGE(bufoff, gbase, voff) do { _Pragma("unroll") for (int _i = 0; _i < 2; ++_i) \
        __builtin_amdgcn_global_load_lds((const unsigned*)((const char*)(gbase) + (voff)[_i]), (LAS unsigned*)(lds + (bufoff) + ldsw + _i * 8192), 16, 0, 0); } while (0)
#define PG8_LDA(dst, b, h) do { _Pragma("unroll") for (int m = 0; m < 4; ++m) _Pragma("unroll") for (int k = 0; k < 2; ++k) dst[m][k] = *(const LAS bf16x8*)(lds + PG8_SA(b, h) + aoff + m * 2048 + k * 1024); } while (0)
#define PG8_LDB(dst, b, h) do { _Pragma("unroll") for (int n = 0; n < 2; ++n) _Pragma("unroll") for (int k = 0; k < 2; ++k) dst[n][k] = *(const LAS bf16x8*)(lds + PG8_SB(b, h) + boff + n * 2048 + k * 1024); } while (0)
#define PG8_MMA(ai, bj, At, Bt) do { __builtin_amdgcn_s_setprio(1); _Pragma("unroll") for (int m = 0; m < 4; ++m) _Pragma("unroll") for (int n = 0; n < 2; ++n) _Pragma("unroll") for (int k = 0; k < 2; ++k) \
        acc[ai][bj][m][n] = __builtin_amdgcn_mfma_f32_16x16x32_bf16(Bt[n][k], At[m][k], acc[ai][bj][m][n], 0, 0, 0); __builtin_amdgcn_s_setprio(0); } while (0)
#define PG8_WAIT_V(n) asm volatile("s_waitcnt vmcnt(" #n ")" ::: "memory")
#define PG8_WAIT_L(n) asm volatile("s_waitcnt lgkmcnt(" #n ")" ::: "memory")
#define PG8_BAR __builtin_amdgcn_s_barrier()
#define PG8_SCHED __builtin_amdgcn_sched_barrier(0)
    Unit cur, nxt; int ui = 0;
    if (!S.next(0, cur)) return;
    f32x4 acc[2][2][4][2];
#pragma unroll
    for (int a = 0; a < 2; ++a)
#pragma unroll
        for (int b = 0; b < 2; ++b)
#pragma unroll
            for (int m = 0; m < 4; ++m)
#pragma unroll
                for (int n = 0; n < 2; ++n) acc[a][b][m][n] = (f32x4){0.f, 0.f, 0.f, 0.f};
    bf16x8 At[4][2], B0[2][2], B1[2][2];
    const char* cA = g.A + cur.aoff; const char* cB = g.Bt + cur.boff;
    PG8_STAGE(PG8_SB(0, 0), cB, voffB); PG8_STAGE(PG8_SB(0, 1), cB + hB, voffB); PG8_STAGE(PG8_SA(0, 0), cA, voffA); PG8_STAGE(PG8_SA(0, 1), cA + hA, voffA);
    if (wr == 1) PG8_BAR;
    PG8_WAIT_V(2); PG8_BAR;
    PG8_STAGE(PG8_SB(1, 0), cB + kB, voffB); PG8_STAGE(PG8_SA(1, 0), cA + kA, voffA); PG8_STAGE(PG8_SB(1, 1), cB + hB + kB, voffB);
    PG8_WAIT_V(6); PG8_BAR;
    for (;;) {
        const bool has_next = S.next(ui + 1, nxt);
        const char* nA = has_next ? g.A + nxt.aoff : cA; const char* nB = has_next ? g.Bt + nxt.boff : cB;
        for (int t = 0; t < nt; t += 2) {
            const bool last = (t == nt - 2);
            const char* a1 = cA + (size_t)(t + 1) * kA;
            const char* a2 = last ? nA : cA + (size_t)(t + 2) * kA; const char* b2 = last ? nB : cB + (size_t)(t + 2) * kB;
            const char* a3 = a2 + kA; const char* b3 = b2 + kB;
            PG8_LDB(B0, 0, 0); PG8_LDB(B1, 0, 1); PG8_SCHED; PG8_LDA(At, 0, 0); PG8_STAGE(PG8_SA(1, 1), a1 + hA, voffA);
            PG8_WAIT_V(8); PG8_WAIT_L(0); PG8_BAR; PG8_MMA(0, 0, At, B0); PG8_MMA(0, 1, At, B1); PG8_BAR; PG8_SCHED;
            PG8_LDA(At, 0, 1); PG8_STAGE(PG8_SB(0, 0), b2, voffB); PG8_STAGE(PG8_SB(0, 1), b2 + hB, voffB); PG8_STAGE(PG8_SA(0, 0), a2, voffA);
            PG8_WAIT_V(8); PG8_WAIT_L(0); PG8_BAR; PG8_MMA(1, 0, At, B0); PG8_MMA(1, 1, At, B1); PG8_BAR; PG8_SCHED;
            PG8_LDB(B0, 1, 0); PG8_LDB(B1, 1, 1); PG8_SCHED; PG8_LDA(At, 1, 0); PG8_STAGE(PG8_SA(0, 1), a2 + hA, voffA);
            PG8_WAIT_V(8); PG8_WAIT_L(0); PG8_BAR; PG8_MMA(0, 0, At, B0); PG8_MMA(0, 1, At, B1); PG8_BAR; PG8_SCHED;
            PG8_LDA(At, 1, 1); PG8_STAGE(PG8_SB(1, 0), b3, voffB); PG8_STAGE(PG8_SB(1, 1), b3 + hB, voffB); PG8_STAGE(PG8_SA(1, 0), a3, voffA);
            PG8_WAIT_V(8); PG8_WAIT_L(0); PG8_BAR; PG8_MMA(1, 0, At, B0); PG8_MMA(1, 1, At, B1); PG8_BAR; PG8_SCHED;
        }
        if (wr == 0) PG8_BAR;
        E(acc, cur, wr, wc, fr, fq);
        if (!has_next) break;
#pragma unroll
        for (int a = 0; a < 2; ++a)
#pragma unroll
            for (int b = 0; b < 2; ++b)
#pragma unroll
                for (int m = 0; m < 4; ++m)
#pragma unroll
                    for (int n = 0; n < 2; ++n) acc[a][b][m][n] = (f32x4){0.f, 0.f, 0.f, 0.f};
        cur = nxt; cA = nA; cB = nB; ++ui;
        if (wr == 1) PG8_BAR;
    }
    PG8_WAIT_V(0);
    PG8_BAR;
#undef PG8_SA
#undef PG8_SB
#undef PG8_STAGE
#undef PG8_LDA
#undef PG8_LDB
#undef PG8_MMA
#undef PG8_WAIT_V
#undef PG8_WAIT_L
#undef PG8_BAR
#undef PG8_SCHED
}
}

struct Args { const void* in[29]; float* out; unsigned char* ws; int ph_lo, ph_hi; };
static_assert(sizeof(Args) == 29 * 8 + 8 + 8 + 8, "Args has no padding");

typedef __attribute__((address_space(1))) unsigned char gu8;
struct Ctx {
    const Args* a; gu8* ws; LAS unsigned char* lds; int tid, lane, wave, G, gw, NGW;
};
#define INF(k, l, n) ((const float*)C.a->in[k] + (size_t)(l) * (n))

__device__ __forceinline__ void tr_item(const float* W, int ldw, int src_col, int nvalid, int k0, bf16_t* WT, int ldt, int dst_row, int dst_k, LAS float* scr, int lane) {
#pragma unroll 8
    for (int i = 0; i < 32; ++i) { const int kk = 2 * i + (lane >> 5), c = lane & 31; scr[kk * 33 + c] = (c < nvalid) ? W[(size_t)(k0 + kk) * ldw + src_col + c] : 0.f; }
    LDS_WAIT();
    const int c = lane & 7;
#pragma unroll
    for (int j = 0; j < 4; ++j) { const int n = (lane >> 3) + 8 * j; const LAS float* s = scr + (8 * c) * 33 + n;
        u32x4 o; o.x = cvt_pk_bf16(s[0 * 33], s[1 * 33]); o.y = cvt_pk_bf16(s[2 * 33], s[3 * 33]); o.z = cvt_pk_bf16(s[4 * 33], s[5 * 33]); o.w = cvt_pk_bf16(s[6 * 33], s[7 * 33]);
        *(u32x4*)(WT + (size_t)(dst_row + n) * ldt + dst_k + k0 + 8 * c) = o; }
    LDS_WAIT();
}

__device__ __forceinline__ void convert_layer(const Ctx& C, int l) {
    LAS float* scr = (LAS float*)(C.lds + C.wave * 8448);
    gu8* ws = C.ws; const int lane = C.lane;
    constexpr int NITEMS = 2816 + 1408 + 1792 + 1536 + 768 + 512 + 2816 + 1408 + 256 + 256 + 512;
    for (int it = C.gw; it < NITEMS; it += C.NGW) {
        int r = it;
        if (r < 2816) { const int kb = r / 176, nb = r % 176, tile = nb >> 3, w = nb & 7, src = (w >> 2) * FF + tile * 128 + (w & 3) * 32;
            tr_item(INF(5, l, DM * 2 * FF), 2 * FF, src, 32, kb * 64, (bf16_t*)(ws + WS_W1IN), DM, nb * 32, 0, scr, lane); continue; } r -= 2816;
        if (r < 1408) { const int kb = r / 32, nb = r % 32;
            tr_item(INF(6, l, FF * DM), DM, nb * 32, 32, kb * 64, (bf16_t*)(ws + WS_W1OUT), FF, nb * 32, 0, scr, lane); continue; } r -= 1408;
        if (r < 1792) { const int kb = r / 112, nb = r % 112; int src = 0, nv = 0;
            if (nb < 88) { src = nb * 32; nv = 32; } else if (nb < 104) { src = 2840 + (nb - 88) * 32; nv = 32; } else if (nb == 104) { src = 2816; nv = 24; }
            tr_item(INF(10, l, DM * 6424), 6424, src, nv, kb * 64, (bf16_t*)(ws + WS_WMIX), DM, nb * 32, 0, scr, lane); continue; } r -= 1792;
        if (r < 1536) { const int kb = r / 96, nb = r % 96;
            tr_item(INF(10, l, DM * 6424), 6424, 3352 + nb * 32, 32, kb * 64, (bf16_t*)(ws + WS_WG), DM, nb * 32, 0, scr, lane); continue; } r -= 1536;
        if (r < 768) { const int br = r / 256, q = r % 256, kb = q / 32, nb = q % 32;
            const float* W = br == 0 ? INF(21, l, 512 * DM) : (br == 1 ? INF(22, l, 512 * DM) : INF(23, l, 512 * DM));
            tr_item(W, DM, nb * 32, 32, kb * 64, (bf16_t*)(ws + WS_WBR), YP, nb * 32, br * 512, scr, lane); continue; } r -= 768;
        if (r < 512) { const int kb = r / 32, nb = r % 32;
            tr_item(INF(24, l, DM * DM), DM, nb * 32, 32, kb * 64, (bf16_t*)(ws + WS_WOUT), DM, nb * 32, 0, scr, lane); continue; } r -= 512;
        if (r < 2816) { const int kb = r / 176, nb = r % 176, tile = nb >> 3, w = nb & 7, src = (w >> 2) * FF + tile * 128 + (w & 3) * 32;
            tr_item(INF(27, l, DM * 2 * FF), 2 * FF, src, 32, kb * 64, (bf16_t*)(ws + WS_W2IN), DM, nb * 32, 0, scr, lane); continue; } r -= 2816;
        if (r < 1408) { const int kb = r / 32, nb = r % 32;
            tr_item(INF(28, l, FF * DM), DM, nb * 32, 32, kb * 64, (bf16_t*)(ws + WS_W2OUT), FF, nb * 32, 0, scr, lane); continue; } r -= 1408;
        if (r < 256) { const int kb = r / 8, nb = r % 8;
            tr_item(INF(14, l, 2048 * 256), 256, nb * 32, 32, kb * 64, (bf16_t*)(ws + WS_WC1), 2048, nb * 32, 0, scr, lane); continue; } r -= 256;
        if (r < 256) { const int kb = r / 8, nb = r % 8;
            tr_item(INF(17, l, 2048 * 256), 256, nb * 32, 32, kb * 64, (bf16_t*)(ws + WS_WC1 + MiB), 2048, nb * 32, 0, scr, lane); continue; } r -= 256;
        { const int kb = r / 32, nb = r % 32;
            tr_item(INF(20, l, DM * DM), DM, nb * 32, 32, kb * 64, (bf16_t*)(ws + WS_WMKV), DM, nb * 32, 0, scr, lane); }
    }
    {
        const float* gm = INF(9, l, DM);
        for (int m = C.gw; m < 512; m += C.NGW) {
            const f32x4* xr = (const f32x4*)((const float*)C.a->in[1] + (size_t)m * DM) + lane;
            f32x4 v[4]; float s = 0.f;
#pragma unroll
            for (int j = 0; j < 4; ++j) { v[j] = xr[64 * j]; s += (v[j].x * v[j].x + v[j].y * v[j].y) + (v[j].z * v[j].z + v[j].w * v[j].w); }
            const float rstd = rsqrtf(wave_sum(s) * (1.f / DM) + EPS);
            u32x2* o = (u32x2*)((bf16_t*)(ws + WS_MEMN) + (size_t)m * DM) + lane;
#pragma unroll
            for (int j = 0; j < 4; ++j) { const f32x4 gg = ((const f32x4*)gm)[lane + 64 * j]; u32x2 w; w.x = cvt_pk_bf16(v[j].x * rstd * gg.x, v[j].y * rstd * gg.y); w.y = cvt_pk_bf16(v[j].z * rstd * gg.z, v[j].w * rstd * gg.w); o[64 * j] = w; }
        }
    }
    {
        float* cb = (float*)(ws + WS_CBP) + (size_t)l * 64 * 256;
        for (int it = C.gw; it < 64; it += C.NGW) {
            const int kv = it >> 5, ch = it & 31;
            const float* pos = kv ? INF(13, l, 2048) : INF(12, l, 2048);
            const float* w1 = kv ? INF(17, l, 2048 * 256) : INF(14, l, 2048 * 256);
            float p[4] = {0.f, 0.f, 0.f, 0.f};
            for (int k = ch * 64; k < ch * 64 + 64; ++k) { const float pv = pos[k];
#pragma unroll
                for (int q = 0; q < 4; ++q) p[q] += pv * w1[(size_t)k * 256 + lane + 64 * q]; }
#pragma unroll
            for (int q = 0; q < 4; ++q) cb[(size_t)it * 256 + lane + 64 * q] = p[q];
        }
    }
}

__device__ __forceinline__ void rope_table(const Ctx& C) {
    const int* pos = (const int*)C.a->in[2];
    float* tab = (float*)(C.ws + WS_ROPE);
    const float invf[8] = {1.0f, 0.1939227432012558f, 0.03760603070259094f, 0.007292664609849453f, 0.0014142135623842478f, 0.00027424818836152554f, 5.318296098266728e-05f, 1.0313386155758053e-05f};
    for (int e = C.gw * 64 + C.lane; e < T_ * 8; e += C.NGW * 64) {
        const int tok = e >> 3, i = e & 7;
        float f = invf[0];
#pragma unroll
        for (int q = 1; q < 8; ++q) f = (i == q) ? invf[q] : f;
        const float ang = (float)pos[tok] * f;
        const double rev = (double)ang * 0.15915494309189535; const float fr = (float)(rev - floor(rev));
        tab[(size_t)tok * 16 + i] = __builtin_amdgcn_cosf(fr); tab[(size_t)tok * 16 + 8 + i] = __builtin_amdgcn_sinf(fr);
    }
}
__device__ __forceinline__ void prenorm_rows(const Ctx& C, const float* x, const float* g, bf16_t* h) {
    for (int m = C.gw; m < T_; m += C.NGW) {
        const f32x4* xr = (const f32x4*)(x + (size_t)m * DM) + C.lane;
        f32x4 v[4]; float s = 0.f;
#pragma unroll
        for (int j = 0; j < 4; ++j) { v[j] = xr[64 * j]; s += (v[j].x * v[j].x + v[j].y * v[j].y) + (v[j].z * v[j].z + v[j].w * v[j].w); }
        const float rstd = rsqrtf(wave_sum(s) * (1.f / DM) + EPS);
        u32x2* o = (u32x2*)(h + (size_t)m * DM) + C.lane;
#pragma unroll
        for (int j = 0; j < 4; ++j) { const f32x4 gg = ((const f32x4*)g)[C.lane + 64 * j]; u32x2 w; w.x = cvt_pk_bf16(v[j].x * rstd * gg.x, v[j].y * rstd * gg.y); w.y = cvt_pk_bf16(v[j].z * rstd * gg.z, v[j].w * rstd * gg.w); o[64 * j] = w; }
    }
}
__device__ __forceinline__ void norm_phase(const Ctx& C, int w0, int nw, const float* xin, float* xout, const bf16_t* y, bf16_t* h, const float* gpost, const float* gpre, float coef) {
    for (int m0 = w0; m0 < T_; m0 += 2 * nw) {
        f32x4 xv[2][4]; u32x2 yw[2][4];
#pragma unroll
        for (int r = 0; r < 2; ++r) { const int m = (m0 + r * nw < T_) ? m0 + r * nw : m0; const f32x4* xr = (const f32x4*)(xin + (size_t)m * DM) + C.lane; const u32x2* yr = (const u32x2*)(y + (size_t)m * DM) + C.lane;
#pragma unroll
            for (int j = 0; j < 4; ++j) { xv[r][j] = xr[64 * j]; yw[r][j] = yr[64 * j]; } }
#pragma unroll
        for (int r = 0; r < 2; ++r) {
            const int m = m0 + r * nw; if (m >= T_) break;
            f32x4 yv[4]; float s = 0.f;
#pragma unroll
            for (int j = 0; j < 4; ++j) { const u32x2 w = yw[r][j]; yv[j] = (f32x4){bf_lo(w.x), bf_hi(w.x), bf_lo(w.y), bf_hi(w.y)};
                s += (yv[j].x * yv[j].x + yv[j].y * yv[j].y) + (yv[j].z * yv[j].z + yv[j].w * yv[j].w); }
            const float rs = rsqrtf(wave_sum(s) * (1.f / DM) + EPS) * coef; float s2 = 0.f;
            f32x4* xo = (f32x4*)(xout + (size_t)m * DM) + C.lane;
#pragma unroll
            for (int j = 0; j < 4; ++j) { const f32x4 gg = ((const f32x4*)gpost)[C.lane + 64 * j]; xv[r][j] = xv[r][j] + yv[j] * gg * rs; xo[64 * j] = xv[r][j];
                s2 += (xv[r][j].x * xv[r][j].x + xv[r][j].y * xv[r][j].y) + (xv[r][j].z * xv[r][j].z + xv[r][j].w * xv[r][j].w); }
            if (gpre) {
                const float r2 = rsqrtf(wave_sum(s2) * (1.f / DM) + EPS);
                u32x2* o = (u32x2*)(h + (size_t)m * DM) + C.lane;
#pragma unroll
                for (int j = 0; j < 4; ++j) { const f32x4 gg = ((const f32x4*)gpre)[C.lane + 64 * j]; u32x2 w; w.x = cvt_pk_bf16(xv[r][j].x * r2 * gg.x, xv[r][j].y * r2 * gg.y); w.y = cvt_pk_bf16(xv[r][j].z * r2 * gg.z, xv[r][j].w * r2 * gg.w); o[64 * j] = w; }
            }
        }
    }
}
__device__ __forceinline__ void cb_reduce(const Ctx& C, int l) {
    const int e = C.gw * 64 + C.lane;
    if (e < 512) { const int kv = e >> 8, n = e & 255; const float* pp = (const float*)(C.ws + WS_CBP) + (size_t)l * 64 * 256 + (size_t)kv * 32 * 256 + n;
        float s = (kv ? INF(18, l, 256) : INF(15, l, 256))[n];
        for (int ch = 0; ch < 32; ++ch) s += pp[ch * 256];
        ((float*)(C.ws + WS_CB))[l * 512 + e] = s; }
}
__device__ __forceinline__ void memkv_ops(const Ctx& C, int w0, int nw) {
    const bf16_t* src = (const bf16_t*)(C.ws + WS_MKV); bf16_t* ko = (bf16_t*)(C.ws + WS_MEMK); bf16_t* vo = (bf16_t*)(C.ws + WS_MEMV);
    for (int e = w0 * 64 + C.lane; e < 512 * 1024; e += nw * 64) {
        const int mr = e >> 10, col = e & 1023, kv = col >> 9, hm = (col >> 7) & 3, d = col & 127, b = mr >> 8, m = mr & 255;
        const bf16_t v = src[e];
        if (kv == 0) ko[((size_t)((((b * 4 + hm) * 8 + (m >> 5)) * 8 + (d >> 4)) * 64 + pi32(m & 31) + 32 * ((d >> 3) & 1))) * 8 + (d & 7)] = v;
        else vo[((size_t)((((b * 4 + hm) * 16 + (m >> 4)) * 4 + (d >> 5)) * 64 + (d & 31) + 32 * ((m >> 3) & 1))) * 8 + (m & 7)] = v;
    }
}

__device__ __forceinline__ void prep_items(const Ctx& C, int l, int w0, int nw) {
    const bf16_t* P = (const bf16_t*)(C.ws + WS_R1); bf16_t* Y = (bf16_t*)(C.ws + WS_Y);
    const int lane = C.lane;
    {
        const float* cw = INF(11, l, 3 * 512);
        float w[3][8];
#pragma unroll
        for (int k = 0; k < 3; ++k)
#pragma unroll
            for (int e = 0; e < 8; ++e) w[k][e] = cw[k * 512 + lane * 8 + e];
        for (int it = w0; it < T_ / 8; it += nw) {
            const int tok0 = it * 8, s0 = tok0 & (S_ - 1);
            float c1[8], c2[8];
#pragma unroll
            for (int e = 0; e < 8; ++e) { c1[e] = 0.f; c2[e] = 0.f; }
            if (s0 > 0) {
#pragma unroll
                for (int back = 2; back >= 1; --back) {
                    const bf16_t* row = P + (size_t)(tok0 - back) * PP + lane * 8;
                    const u32x4 u = *(const u32x4*)row, cc = *(const u32x4*)(row + 1024);
                    float t[8] = {bf_lo(u.x) * bf_lo(cc.x), bf_hi(u.x) * bf_hi(cc.x), bf_lo(u.y) * bf_lo(cc.y), bf_hi(u.y) * bf_hi(cc.y), bf_lo(u.z) * bf_lo(cc.z), bf_hi(u.z) * bf_hi(cc.z), bf_lo(u.w) * bf_lo(cc.w), bf_hi(u.w) * bf_hi(cc.w)};
#pragma unroll
                    for (int e = 0; e < 8; ++e) { if (back == 2) c2[e] = t[e]; else c1[e] = t[e]; }
                }
            }
#pragma unroll
            for (int tt = 0; tt < 8; ++tt) {
                const bf16_t* row = P + (size_t)(tok0 + tt) * PP + lane * 8;
                const u32x4 u = *(const u32x4*)row, bb = *(const u32x4*)(row + 512), cc = *(const u32x4*)(row + 1024);
                const float c0[8] = {bf_lo(u.x) * bf_lo(cc.x), bf_hi(u.x) * bf_hi(cc.x), bf_lo(u.y) * bf_lo(cc.y), bf_hi(u.y) * bf_hi(cc.y), bf_lo(u.z) * bf_lo(cc.z), bf_hi(u.z) * bf_hi(cc.z), bf_lo(u.w) * bf_lo(cc.w), bf_hi(u.w) * bf_hi(cc.w)};
                const float bv[8] = {bf_lo(bb.x), bf_hi(bb.x), bf_lo(bb.y), bf_hi(bb.y), bf_lo(bb.z), bf_hi(bb.z), bf_lo(bb.w), bf_hi(bb.w)};
                float o[8];
#pragma unroll
                for (int e = 0; e < 8; ++e) { o[e] = bv[e] * (w[0][e] * c2[e] + w[1][e] * c1[e] + w[2][e] * c0[e]); c2[e] = c1[e]; c1[e] = c0[e]; }
                u32x4 ov; ov.x = cvt_pk_bf16(o[0], o[1]); ov.y = cvt_pk_bf16(o[2], o[3]); ov.z = cvt_pk_bf16(o[4], o[5]); ov.w = cvt_pk_bf16(o[6], o[7]);
                *(u32x4*)(Y + (size_t)(tok0 + tt) * YP + lane * 8) = ov;
            }
        }
    }
    {
        const float* rope = (const float*)(C.ws + WS_ROPE);
        LAS bf16_t* vt = (LAS bf16_t*)(C.lds + C.wave * 4608);
        const int hi = lane >> 5, dl = lane & 31;
        for (int it = w0; it < 4 * 512; it += nw) {
            const int bg = it >> 9, tile = it & 511, b = bg >> 1, g = bg & 1;
            const size_t tokb = (size_t)b * S_ + 32 * tile;
#pragma unroll
            for (int which = 0; which < 2; ++which) {
                const int kc = PC_KV + (2 + 2 * which) * 128 + g * 64, vc = kc + 128;
                bf16_t* kop = (bf16_t*)(C.ws + (which ? WS_KWIN : WS_KSLC)); bf16_t* vop = (bf16_t*)(C.ws + (which ? WS_VWIN : WS_VSLC));
#pragma unroll
                for (int q = 0; q < 4; ++q) {
                    const int r = (lane >> 3) + 8 * q, c = lane & 7;
                    const bf16_t* row = P + (tokb + r) * PP;
                    u32x4 kv = *(const u32x4*)(row + kc + 8 * c);
                    if (c < 2) {
                        const u32x4 pv = *(const u32x4*)(row + kc + 8 * (c ^ 1));
                        const float* rt = rope + (tokb + r) * 16;
                        const f32x4 ca = *(const f32x4*)rt, cb2 = *(const f32x4*)(rt + 4), sa = *(const f32x4*)(rt + 8), sb = *(const f32x4*)(rt + 12);
                        const float cs[8] = {ca.x, ca.y, ca.z, ca.w, cb2.x, cb2.y, cb2.z, cb2.w}, sn[8] = {sa.x, sa.y, sa.z, sa.w, sb.x, sb.y, sb.z, sb.w};
                        const float mv[8] = {bf_lo(kv.x), bf_hi(kv.x), bf_lo(kv.y), bf_hi(kv.y), bf_lo(kv.z), bf_hi(kv.z), bf_lo(kv.w), bf_hi(kv.w)};
                        const float pp[8] = {bf_lo(pv.x), bf_hi(pv.x), bf_lo(pv.y), bf_hi(pv.y), bf_lo(pv.z), bf_hi(pv.z), bf_lo(pv.w), bf_hi(pv.w)};
                        const float sg = (c == 0) ? -1.f : 1.f; float o[8];
#pragma unroll
                        for (int e = 0; e < 8; ++e) o[e] = mv[e] * cs[e] + sg * pp[e] * sn[e];
                        kv.x = cvt_pk_bf16(o[0], o[1]); kv.y = cvt_pk_bf16(o[2], o[3]); kv.z = cvt_pk_bf16(o[4], o[5]); kv.w = cvt_pk_bf16(o[6], o[7]);
                    }
                    if (which == 0)
                        *(u32x4*)(kop + ((size_t)(((bg * 512 + tile) * 2 + ((r >> 2) & 1)) * 2 + (c >> 2)) * 64 + ((r >> 3) * 4 + (r & 3)) + 16 * (c & 3)) * 8) = kv;
                    else
                        *(u32x4*)(kop + ((size_t)((bg * 512 + tile) * 4 + (c >> 1)) * 64 + pi32(r) + 32 * (c & 1)) * 8) = kv;
                    const u32x4 vv = *(const u32x4*)(row + vc + 8 * c);
                    *(LAS u32x4*)(vt + r * 72 + 8 * c) = vv;
                }
                LDS_WAIT();
#pragma unroll
                for (int o4 = 0; o4 < 4; ++o4) {
                    if (which == 0) {
                        const LAS bf16_t* sp = vt + (8 * (lane >> 4)) * 72 + 16 * o4 + (lane & 15);
                        u32x4 o; o.x = (unsigned)sp[0] | ((unsigned)sp[72] << 16); o.y = (unsigned)sp[144] | ((unsigned)sp[216] << 16); o.z = (unsigned)sp[288] | ((unsigned)sp[360] << 16); o.w = (unsigned)sp[432] | ((unsigned)sp[504] << 16);
                        *(u32x4*)(vop + ((size_t)((bg * 512 + tile) * 4 + o4) * 64 + lane) * 8) = o;
                        continue;
                    }
                    const int ks = o4 >> 1, dt = o4 & 1;
                    const LAS bf16_t* sp = vt + (16 * ks + 8 * hi) * 72 + 32 * dt + dl;
                    u32x4 o; o.x = (unsigned)sp[0] | ((unsigned)sp[72] << 16); o.y = (unsigned)sp[144] | ((unsigned)sp[216] << 16); o.z = (unsigned)sp[288] | ((unsigned)sp[360] << 16); o.w = (unsigned)sp[432] | ((unsigned)sp[504] << 16);
                    *(u32x4*)(vop + ((size_t)((bg * 1024 + 2 * tile + ks) * 2 + dt) * 64 + lane) * 8) = o;
                }
                LDS_WAIT();
            }
        }
    }
}

__device__ __forceinline__ void cmp_stage2(const Ctx& C, int l) {
    const int bxx = C.gw / NWAVES, kv = bxx & 1, wi = bxx >> 1, nwg2 = (C.G + 1 - kv) >> 1;
    const float* w2 = kv ? INF(19, l, 256 * 64) : INF(16, l, 256 * 64);
    LAS float* ws2 = (LAS float*)C.lds;
    for (int e = C.tid; e < 256 * 64 / 4; e += NWAVES * 64) ((LAS f32x4*)ws2)[e] = ((const f32x4*)w2)[e];
    __syncthreads();
    const bf16_t* hid = (const bf16_t*)(C.ws + WS_CMPH) + (size_t)kv * 4096 * 256;
    bf16_t* ko = (bf16_t*)(C.ws + WS_KCMP); bf16_t* vo = (bf16_t*)(C.ws + WS_VCMP);
    const int d = C.lane;
    for (int row = wi * NWAVES + C.wave; row < 4096; row += nwg2 * NWAVES) {
        asm volatile("" ::: "memory");
        const u32x2 hv = *((const u32x2*)(hid + (size_t)row * 256) + C.lane);
        const float h0 = bf_lo(hv.x), h1 = bf_hi(hv.x), h2 = bf_lo(hv.y), h3 = bf_hi(hv.y);
        float acc = 0.f;
#pragma unroll 4
        for (int k = 0; k < 64; ++k) {
            const float a0 = __int_as_float(__builtin_amdgcn_readlane(__float_as_int(h0), k)), a1 = __int_as_float(__builtin_amdgcn_readlane(__float_as_int(h1), k));
            const float a2 = __int_as_float(__builtin_amdgcn_readlane(__float_as_int(h2), k)), a3 = __int_as_float(__builtin_amdgcn_readlane(__float_as_int(h3), k));
            acc += a0 * ws2[(4 * k + 0) * 64 + d]; acc += a1 * ws2[(4 * k + 1) * 64 + d]; acc += a2 * ws2[(4 * k + 2) * 64 + d]; acc += a3 * ws2[(4 * k + 3) * 64 + d];
        }
        const int bg = row >> 10, n = row & 1023;
        if (n == 1023) acc = 0.f;
        const bf16_t o = (bf16_t)(cvt_pk_bf16(acc, 0.f) & 0xffffu);
        if (kv == 0) ko[((size_t)((bg * 32 + (n >> 5)) * 4 + (d >> 4)) * 64 + pi32(n & 31) + 32 * ((d >> 3) & 1)) * 8 + (d & 7)] = o;
        else vo[((size_t)((bg * 64 + (n >> 4)) * 2 + (d >> 5)) * 64 + (d & 31) + 32 * ((n >> 3) & 1)) * 8 + (n & 7)] = o;
    }
    __syncthreads();
}

__device__ __forceinline__ float xhalf_max(float v) { const auto r = __builtin_amdgcn_permlane32_swap(__float_as_uint(v), __float_as_uint(v), false, false); return fmaxf(__uint_as_float(r[0]), __uint_as_float(r[1])); }
__device__ __forceinline__ float xhalf_sum(float v) { const auto r = __builtin_amdgcn_permlane32_swap(__float_as_uint(v), __float_as_uint(v), false, false); return __uint_as_float(r[0]) + __uint_as_float(r[1]); }
__device__ __forceinline__ f32x16 mfma32(bf16x8 a, bf16x8 b, f32x16 c) { return __builtin_amdgcn_mfma_f32_32x32x16_bf16(a, b, c, 0, 0, 0); }
__device__ __forceinline__ float dpp_xor1(float v) { return __int_as_float(__builtin_amdgcn_update_dpp(0, __float_as_int(v), 0xB1, 0xF, 0xF, true)); }
__device__ __forceinline__ float dpp_xor2(float v) { return __int_as_float(__builtin_amdgcn_update_dpp(0, __float_as_int(v), 0x4E, 0xF, 0xF, true)); }
__device__ __forceinline__ bf16x8 pack_p(const float* p) { u32x4 w; w.x = cvt_pk_bf16(p[0], p[1]); w.y = cvt_pk_bf16(p[2], p[3]); w.z = cvt_pk_bf16(p[4], p[5]); w.w = cvt_pk_bf16(p[6], p[7]); return __builtin_bit_cast(bf16x8, w); }
__device__ __forceinline__ bf16x8 scale_q(u32x4 v, float s) { u32x4 w; w.x = cvt_pk_bf16(bf_lo(v.x) * s, bf_hi(v.x) * s); w.y = cvt_pk_bf16(bf_lo(v.y) * s, bf_hi(v.y) * s); w.z = cvt_pk_bf16(bf_lo(v.z) * s, bf_hi(v.z) * s); w.w = cvt_pk_bf16(bf_lo(v.w) * s, bf_hi(v.w) * s); return __builtin_bit_cast(bf16x8, w); }
#define KREL(i, hi) (8 * (hi) + (i) + (((i) >= 8) ? 8 : 0))

__device__ __forceinline__ void flash_load(const bf16x8* kp, const bf16x8* vp, bf16x8 (&kf)[4], bf16x8 (&vf)[4]) {
#pragma unroll
    for (int s = 0; s < 4; ++s) kf[s] = kp[s * 64];
#pragma unroll
    for (int s = 0; s < 4; ++s) vf[s] = vp[s * 64];
    __builtin_amdgcn_sched_barrier(0);
}
__device__ __forceinline__ void flash_compute(bool domask, const bf16x8 (&kf)[4], const bf16x8 (&vf)[4], const bf16x8 (&q)[4], int x0, unsigned span, float& m, float& l, f32x16 (&O)[2]) {
    f32x16 sc;
#pragma unroll
    for (int i = 0; i < 16; ++i) sc[i] = 0.f;
#pragma unroll
    for (int s = 0; s < 4; ++s) sc = mfma32(kf[s], q[s], sc);
    if (domask) {
#pragma unroll
        for (int i = 0; i < 16; ++i) sc[i] = ((unsigned)(x0 + i + (i >= 8 ? 8 : 0)) <= span) ? sc[i] : -1e30f;
    }
    const float a0 = fmaxf(fmaxf(sc[0], sc[1]), sc[2]), a1 = fmaxf(fmaxf(sc[3], sc[4]), sc[5]), a2 = fmaxf(fmaxf(sc[6], sc[7]), sc[8]), a3 = fmaxf(fmaxf(sc[9], sc[10]), sc[11]), a4 = fmaxf(fmaxf(sc[12], sc[13]), sc[14]);
    float mx = fmaxf(fmaxf(fmaxf(a0, a1), fmaxf(a2, a3)), fmaxf(a4, sc[15]));
    mx = xhalf_max(mx);
    const float mn = fmaxf(m, mx);
    if (__ballot(mn > m) != 0ull) {
        const float alpha = ex2(m - mn); l *= alpha; O[0] = O[0] * alpha; O[1] = O[1] * alpha;
    }
    m = mn;
    const float msub = (mn < -1e29f) ? 0.f : mn;
    const f32x16 d = sc - msub;
    float p[16], ps = 0.f;
#pragma unroll
    for (int i = 0; i < 16; ++i) { p[i] = ex2(d[i]); ps += p[i]; }
    l += ps;
    const bf16x8 pb0 = pack_p(p), pb1 = pack_p(p + 8);
    O[0] = mfma32(vf[0], pb0, O[0]); O[1] = mfma32(vf[1], pb0, O[1]);
    O[0] = mfma32(vf[2], pb1, O[0]); O[1] = mfma32(vf[3], pb1, O[1]);
}
template <int MODE> __device__ __forceinline__ void flash_desc(int s, const LAS unsigned* list, int base, int t, int t0, int qi, int hi, int& tile, int& x0, unsigned& span, int& vm) {
    if constexpr (MODE == 0) {
        const unsigned e = (unsigned)__builtin_amdgcn_readfirstlane((int)list[s >> 1]);
        tile = 2 * (int)(e & 0xffffu) + (s & 1);
        const bool my = ((e >> 16) >> qi) & 1u; const int up = my ? (t - 32 * tile) : -1;
        x0 = up < 0 ? 64 : 8 * hi; span = up < 0 ? 0u : (unsigned)up;
        vm = (32 * tile + 31 <= t0) ? (((e >> 16) == 0xFFu) ? 0 : 1) : 2;
    } else {
        tile = base + s; x0 = 8 * hi - (t - 511 - 32 * tile); span = 511u;
        vm = (32 * tile + 31 <= t0 && 32 * tile >= t0 + 7 - 511) ? 0 : 2;
    }
}
template <int MODE> __device__ __forceinline__ void flash_run(const bf16x8* kb, const bf16x8* vb, const bf16x8 (&q)[4], int nsteps, const LAS unsigned* list, int base, int t, int t0, int qi, int hi, float& m, float& l, f32x16 (&O)[2]) {
    if (nsteps <= 0) return;
    bf16x8 kA[4], vA[4], kB[4], vB[4], kC[4], vC[4]; int x0A, x0B, x0C, vmA, vmB, vmC; unsigned spA, spB, spC;
#define FR_LOAD(S, KF, VF, X0, SP, VM) do { int tile_; const int sn_ = ((S) < nsteps) ? (S) : nsteps - 1; flash_desc<MODE>(sn_, list, base, t, t0, qi, hi, tile_, X0, SP, VM); \
        flash_load(kb + (size_t)tile_ * 256, vb + (size_t)tile_ * 256, KF, VF); } while (0)
    FR_LOAD(0, kA, vA, x0A, spA, vmA); FR_LOAD(1, kB, vB, x0B, spB, vmB);
#pragma unroll 1
    for (int s = 0; s < nsteps; s += 3) {
        FR_LOAD(s + 2, kC, vC, x0C, spC, vmC); flash_compute(vmA != 0, kA, vA, q, x0A, spA, m, l, O); if (s + 1 >= nsteps) break;
        FR_LOAD(s + 3, kA, vA, x0A, spA, vmA); flash_compute(vmB != 0, kB, vB, q, x0B, spB, m, l, O); if (s + 2 >= nsteps) break;
        FR_LOAD(s + 4, kB, vB, x0B, spB, vmB); flash_compute(vmC != 0, kC, vC, q, x0C, spC, m, l, O);
    }
#undef FR_LOAD
}

typedef float f32x4v __attribute__((ext_vector_type(4)));
__device__ __forceinline__ f32x4v mfma16(bf16x8 a, bf16x8 b, f32x4v c) { return __builtin_amdgcn_mfma_f32_16x16x32_bf16(a, b, c, 0, 0, 0); }
__device__ __forceinline__ float xq_max(float v) { const auto r = __builtin_amdgcn_permlane16_swap(__float_as_uint(v), __float_as_uint(v), false, false); return xhalf_max(fmaxf(__uint_as_float(r[0]), __uint_as_float(r[1]))); }
__device__ __forceinline__ float xq_sum(float v) { const auto r = __builtin_amdgcn_permlane16_swap(__float_as_uint(v), __float_as_uint(v), false, false); return xhalf_sum(__uint_as_float(r[0]) + __uint_as_float(r[1])); }
__device__ __forceinline__ void flash16_load(const bf16x8* kp, const bf16x8* vp, bf16x8 (&kf)[4], bf16x8 (&vf)[4]) {
#pragma unroll
    for (int s = 0; s < 4; ++s) kf[s] = kp[s * 64];
#pragma unroll
    for (int s = 0; s < 4; ++s) vf[s] = vp[s * 64];
    __builtin_amdgcn_sched_barrier(0);
}
__device__ __forceinline__ void flash16_compute(bool domask, const bf16x8 (&kf)[4], const bf16x8 (&vf)[4], const bf16x8 (&q)[2], int x0, unsigned span, float& m, float& l, f32x4v (&O)[4]) {
    f32x4v s0 = {0.f, 0.f, 0.f, 0.f}, s1 = {0.f, 0.f, 0.f, 0.f};
    s0 = mfma16(kf[0], q[0], s0); s1 = mfma16(kf[2], q[0], s1);
    s0 = mfma16(kf[1], q[1], s0); s1 = mfma16(kf[3], q[1], s1);
    float sc[8] = {s0[0], s0[1], s0[2], s0[3], s1[0], s1[1], s1[2], s1[3]};
    if (domask) {
#pragma unroll
        for (int j = 0; j < 8; ++j) sc[j] = ((unsigned)(x0 + j) <= span) ? sc[j] : -1e30f;
    }
    float mx = fmaxf(fmaxf(fmaxf(sc[0], sc[1]), fmaxf(sc[2], sc[3])), fmaxf(fmaxf(sc[4], sc[5]), fmaxf(sc[6], sc[7])));
    mx = xq_max(mx);
    const float mn = fmaxf(m, mx);
    if (__ballot(mn > m) != 0ull) {
        const float alpha = ex2(m - mn); l *= alpha;
#pragma unroll
        for (int dt = 0; dt < 4; ++dt) O[dt] = O[dt] * alpha;
    }
    m = mn;
    const float msub = (mn < -1e29f) ? 0.f : mn;
    float p[8], ps = 0.f;
#pragma unroll
    for (int j = 0; j < 8; ++j) { p[j] = ex2(sc[j] - msub); ps += p[j]; }
    l += ps;
    const bf16x8 pb = pack_p(p);
#pragma unroll
    for (int dt = 0; dt < 4; ++dt) O[dt] = mfma16(vf[dt], pb, O[dt]);
}
__device__ __forceinline__ unsigned flash16_entry(int s, const LAS unsigned* list) {
    const unsigned e = (unsigned)__builtin_amdgcn_readfirstlane((int)list[s >> 1]);
    return (e & 0xffff0000u) | (2u * (e & 0xffffu) + (unsigned)(s & 1));
}
__device__ __forceinline__ void flash16_run(const bf16x8* kb, const bf16x8* vb, const bf16x8 (&qa)[2], const bf16x8 (&qb)[2], int nsteps, const LAS unsigned* list, int tq, int t0, int qi4, int fq,
                                            float& ma, float& la, f32x4v (&Oa)[4], float& mb, float& lb, f32x4v (&Ob)[4]) {
    if (nsteps <= 0) return;
    bf16x8 kA[4], vA[4], kB[4], vB[4], kC[4], vC[4]; unsigned eA, eB, eC;
#define F16_LOAD(S, KF, VF, E) do { const int sn_ = ((S) < nsteps) ? (S) : nsteps - 1; E = flash16_entry(sn_, list); const size_t go_ = (size_t)(E & 0xffffu) * 256; \
        flash16_load(kb + go_, vb + go_, KF, VF); } while (0)
#define F16_COMP(KF, VF, E) do { const int grp_ = (int)(E & 0xffffu); const unsigned na_ = (E >> 16) & 0xFu, nb_ = E >> 20; const bool past_ = 32 * grp_ + 31 <= t0; \
        if (na_) { const int up_ = ((na_ >> qi4) & 1u) ? (tq - 32 * grp_) : -1; flash16_compute(!(past_ && na_ == 0xFu), KF, VF, qa, up_ < 0 ? 64 : 8 * fq, up_ < 0 ? 0u : (unsigned)up_, ma, la, Oa); } \
        if (nb_) { const int up_ = ((nb_ >> qi4) & 1u) ? (tq + 4 - 32 * grp_) : -1; flash16_compute(!(past_ && nb_ == 0xFu), KF, VF, qb, up_ < 0 ? 64 : 8 * fq, up_ < 0 ? 0u : (unsigned)up_, mb, lb, Ob); } } while (0)
    F16_LOAD(0, kA, vA, eA); F16_LOAD(1, kB, vB, eB);
#pragma unroll 1
    for (int s = 0; s < nsteps; s += 3) {
        F16_LOAD(s + 2, kC, vC, eC); F16_COMP(kA, vA, eA); if (s + 1 >= nsteps) break;
        F16_LOAD(s + 3, kA, vA, eA); F16_COMP(kB, vB, eB); if (s + 2 >= nsteps) break;
        F16_LOAD(s + 4, kB, vB, eB); F16_COMP(kC, vC, eC);
    }
#undef F16_LOAD
#undef F16_COMP
}

__device__ __forceinline__ unsigned wave_max_u32(unsigned v) {
#pragma unroll
    for (int o = 1; o < 16; o <<= 1) { const unsigned t = (unsigned)__shfl_xor((int)v, o); v = v > t ? v : t; }
    { const auto r = __builtin_amdgcn_permlane16_swap(v, v, false, false); v = r[0] > r[1] ? r[0] : r[1]; }
    { const auto r = __builtin_amdgcn_permlane32_swap(v, v, false, false); v = r[0] > r[1] ? r[0] : r[1]; }
    return v;
}

__device__ __forceinline__ void nsa_tile(const Ctx& C, int b, int g, int t0) {
    const bf16_t* P = (const bf16_t*)(C.ws + WS_R1); bf16_t* Y = (bf16_t*)(C.ws + WS_Y);
    int lane_ = C.lane; asm volatile("" : "+v"(lane_));
    const int lane = lane_, r = lane & 31, hi = lane >> 5, qi = r >> 2, h = r & 3, head = g * 4 + h, bg = b * 2 + g;
    const int t = t0 + qi; const size_t tok = (size_t)b * S_ + t;
    LAS float* imp = (LAS float*)(C.lds + C.wave * 16640);
    LAS float* ost = (LAS float*)(C.lds + C.wave * 16640 + 8448) + lane;
    const float QS = 0.18033688011112042f;
    bf16x8 qf[4];
    {
        const bf16_t* qp = P + tok * PP + PC_Q + head * 64;
#pragma unroll
        for (int s = 0; s < 4; ++s) qf[s] = scale_q(*(const u32x4*)(qp + 16 * s + 8 * hi), QS);
    }
    const bf16_t* gp = P + tok * PP + PC_NG + head * 3;
    const float gc = sigm(bf1(gp[0])), gs = sigm(bf1(gp[1])), gw = sigm(bf1(gp[2]));

    const int cur = t0 >> 6;
    {
        const int nvq = (t >= 31) ? ((t - 31) >> 4) + 1 : 0;
        const int tl = t0 + 7, nvmax = (tl >= 31) ? ((tl - 31) >> 4) + 1 : 0, ntile = (nvmax + 31) >> 5;
        const bf16x8* kb = (const bf16x8*)(C.ws + WS_KCMP) + (size_t)bg * 32 * 4 * 64 + lane;
        const bf16x8* vb = (const bf16x8*)(C.ws + WS_VCMP) + (size_t)bg * 64 * 2 * 64 + lane;
        float m1 = -1e30f, l1 = 0.f;
#define CMP_P1(KF, KT) do { \
            f32x16 sc; _Pragma("unroll") for (int i = 0; i < 16; ++i) sc[i] = 0.f; \
            _Pragma("unroll") for (int s = 0; s < 4; ++s) sc = mfma32(KF[s], qf[s], sc); \
            const int up = nvq - 1 - 32 * (KT); const int x0 = up < 0 ? 64 : 8 * hi; const unsigned span = up < 0 ? 0u : (unsigned)up; \
            float mx = -1e30f; bool ok[16]; \
            _Pragma("unroll") for (int i = 0; i < 16; ++i) { ok[i] = (unsigned)(x0 + i + (i >= 8 ? 8 : 0)) <= span; sc[i] = ok[i] ? sc[i] : -1e30f; mx = fmaxf(mx, sc[i]); } \
            mx = xhalf_max(mx); \
            const float mn = fmaxf(m1, mx); float ps = 0.f; \
            _Pragma("unroll") for (int i = 0; i < 16; ++i) ps += ok[i] ? ex2(sc[i] - mn) : 0.f; \
            l1 = l1 * ex2(m1 - mn) + ps; m1 = mn; } while (0)
        if (ntile > 0) {
            bf16x8 kA[4], kB[4];
#pragma unroll
            for (int s = 0; s < 4; ++s) kA[s] = kb[s * 64];
#pragma unroll 1
            for (int kt = 0; kt < ntile; kt += 2) {
                { const int kn = (kt + 1 < ntile) ? kt + 1 : ntile - 1;
#pragma unroll
                  for (int s = 0; s < 4; ++s) kB[s] = kb[kn * 256 + s * 64]; }
                __builtin_amdgcn_sched_barrier(0);
                CMP_P1(kA, kt);
                if (kt + 1 >= ntile) break;
                { const int kn = (kt + 2 < ntile) ? kt + 2 : ntile - 1;
#pragma unroll
                  for (int s = 0; s < 4; ++s) kA[s] = kb[kn * 256 + s * 64]; }
                __builtin_amdgcn_sched_barrier(0);
                CMP_P1(kB, kt + 1);
            }
        }
#undef CMP_P1
        l1 = xhalf_sum(l1);
        const float inv = 1.f / fmaxf(l1, 1e-30f);
        for (int e = lane; e < 8 * 264; e += 64) imp[e] = 0.f;
        LDS_WAIT();
        f32x16 O[2];
#pragma unroll
        for (int i = 0; i < 16; ++i) { O[0][i] = 0.f; O[1][i] = 0.f; }
#define CMP_P2(KF, VF, KT) do { \
            f32x16 sc; _Pragma("unroll") for (int i = 0; i < 16; ++i) sc[i] = 0.f; \
            _Pragma("unroll") for (int s = 0; s < 4; ++s) sc = mfma32(KF[s], qf[s], sc); \
            const int up = nvq - 1 - 32 * (KT); const int x0 = up < 0 ? 64 : 8 * hi; const unsigned span = up < 0 ? 0u : (unsigned)up; \
            float p[16]; \
            _Pragma("unroll") for (int i = 0; i < 16; ++i) { const bool ok = (unsigned)(x0 + i + (i >= 8 ? 8 : 0)) <= span; p[i] = ok ? ex2(sc[i] - m1) * inv : 0.f; } \
            _Pragma("unroll") for (int rr = 0; rr < 2; ++rr) { \
                const float* q8 = p + 8 * rr; \
                float a = q8[0] + q8[1] + q8[2] + 0.5f * q8[3], bq = 0.5f * q8[3] + q8[4] + q8[5] + q8[6] + 0.5f * q8[7], cq = 0.5f * q8[7]; \
                a += dpp_xor1(a); a += dpp_xor2(a); bq += dpp_xor1(bq); bq += dpp_xor2(bq); cq += dpp_xor1(cq); cq += dpp_xor2(cq); \
                _Pragma("unroll") for (int hh = 0; hh < 2; ++hh)     \
                if (h == 0 && hi == hh) { LAS float* ip = imp + qi * 264 + 8 * (KT) + 2 * hi + 4 * rr; \
                    __hip_atomic_fetch_add(ip, a, __ATOMIC_RELAXED, __HIP_MEMORY_SCOPE_WORKGROUP); __hip_atomic_fetch_add(ip + 1, bq, __ATOMIC_RELAXED, __HIP_MEMORY_SCOPE_WORKGROUP); \
                    __hip_atomic_fetch_add(ip + 2, cq, __ATOMIC_RELAXED, __HIP_MEMORY_SCOPE_WORKGROUP); } \
            } \
            const bf16x8 pb0 = pack_p(p), pb1 = pack_p(p + 8); \
            O[0] = mfma32(VF[0], pb0, O[0]); O[1] = mfma32(VF[1], pb0, O[1]); \
            O[0] = mfma32(VF[2], pb1, O[0]); O[1] = mfma32(VF[3], pb1, O[1]); } while (0)
        if (ntile > 0) {
            bf16x8 kA[4], kB[4], vA[4];
#pragma unroll
            for (int s = 0; s < 4; ++s) kA[s] = kb[s * 64];
#pragma unroll 1
            for (int kt = 0; kt < ntile; kt += 2) {
                { const int kn = (kt + 1 < ntile) ? kt + 1 : ntile - 1;
#pragma unroll
                  for (int s = 0; s < 4; ++s) kB[s] = kb[kn * 256 + s * 64];
#pragma unroll
                  for (int s = 0; s < 4; ++s) vA[s] = vb[kt * 256 + s * 64]; }
                __builtin_amdgcn_sched_barrier(0);
                CMP_P2(kA, vA, kt);
                if (kt + 1 >= ntile) break;
                { const int kn = (kt + 2 < ntile) ? kt + 2 : ntile - 1;
#pragma unroll
                  for (int s = 0; s < 4; ++s) kA[s] = kb[kn * 256 + s * 64];
#pragma unroll
                  for (int s = 0; s < 4; ++s) vA[s] = vb[(kt + 1) * 256 + s * 64]; }
                __builtin_amdgcn_sched_barrier(0);
                CMP_P2(kB, vA, kt + 1);
            }
        }
#undef CMP_P2
#pragma unroll
        for (int i = 0; i < 16; ++i) { ost[i * 64] = gc * O[0][i]; ost[(16 + i) * 64] = gc * O[1][i]; }
        LDS_WAIT();
    }

    unsigned bmv[4];
    if (cur <= 15) {
#pragma unroll
        for (int c = 0; c < 4; ++c) bmv[c] = (lane + 64 * c <= cur) ? 0xFFu : 0u;
    } else {
        unsigned key[8][4];
#pragma unroll
        for (int q2 = 0; q2 < 8; ++q2)
#pragma unroll
            for (int c = 0; c < 4; ++c) { const int j = lane + 64 * c; const bool cand = (j >= 1) && (j < cur - 1); const float v = imp[q2 * 264 + j];
                key[q2][c] = cand ? ((__float_as_uint(v) & 0xFFFFFF00u) | (unsigned)(255 - j)) : 0u; }
#pragma unroll
        for (int c = 0; c < 4; ++c) bmv[c] = 0u;
#pragma unroll 1
        for (int round = 0; round < 13; ++round) {
#pragma unroll
            for (int q2 = 0; q2 < 8; ++q2) {
                unsigned mx = key[q2][0]; mx = mx > key[q2][1] ? mx : key[q2][1]; mx = mx > key[q2][2] ? mx : key[q2][2]; mx = mx > key[q2][3] ? mx : key[q2][3];
                const unsigned w = wave_max_u32(mx);
#pragma unroll
                for (int c = 0; c < 4; ++c) { const bool win = (key[q2][c] == w) && (w != 0u); key[q2][c] = win ? 0u : key[q2][c]; bmv[c] |= win ? (1u << q2) : 0u; }
            }
        }
#pragma unroll
        for (int c = 0; c < 4; ++c) { const int j = lane + 64 * c; if (j == 0 || j == cur || j == cur - 1) bmv[c] = 0xFFu; }
    }

    {
        LAS unsigned* list = (LAS unsigned*)imp;
        LAS float* ostb = (LAS float*)(C.lds + C.wave * 16640 + 8448);
        const int q16 = lane & 15, fq = lane >> 4, qi4 = q16 >> 2, head4 = g * 4 + (q16 & 3);
        const bf16x8* kb = (const bf16x8*)(C.ws + WS_KSLC) + (size_t)bg * 512 * 256 + lane;
        const bf16x8* vb = (const bf16x8*)(C.ws + WS_VSLC) + (size_t)bg * 512 * 256 + lane;
        int nblk = 0;
#pragma unroll
        for (int c = 0; c < 4; ++c) {
            const unsigned long long mk = __ballot(bmv[c] != 0u);
            const int pos = nblk + (int)__builtin_amdgcn_mbcnt_hi((unsigned)(mk >> 32), __builtin_amdgcn_mbcnt_lo((unsigned)mk, 0u));
            if (bmv[c] != 0u) list[pos] = (unsigned)(lane + 64 * c) | (bmv[c] << 16);
            nblk += __builtin_popcountll(mk);
        }
        LDS_WAIT();
        const int tq = t0 + qi4;
        bf16x8 q16f[2][2]; float gs4[2];
#pragma unroll
        for (int sub = 0; sub < 2; ++sub) {
            const size_t tok4 = (size_t)b * S_ + tq + 4 * sub;
            const bf16_t* qp = P + tok4 * PP + PC_Q + head4 * 64;
            q16f[sub][1] = scale_q(*(const u32x4*)(qp + 32 + 8 * fq), QS);
            const u32x4 mv4 = *(const u32x4*)(qp + 8 * fq), pv4 = *(const u32x4*)(qp + 8 * ((fq ^ 1) & 1));
            const float* rt = (const float*)(C.ws + WS_ROPE) + tok4 * 16;
            const f32x4 ca = *(const f32x4*)rt, cb2 = *(const f32x4*)(rt + 4), sa = *(const f32x4*)(rt + 8), sb = *(const f32x4*)(rt + 12);
            const float cs[8] = {ca.x, ca.y, ca.z, ca.w, cb2.x, cb2.y, cb2.z, cb2.w}, sn[8] = {sa.x, sa.y, sa.z, sa.w, sb.x, sb.y, sb.z, sb.w};
            const float mv[8] = {bf_lo(mv4.x), bf_hi(mv4.x), bf_lo(mv4.y), bf_hi(mv4.y), bf_lo(mv4.z), bf_hi(mv4.z), bf_lo(mv4.w), bf_hi(mv4.w)};
            const float pp[8] = {bf_lo(pv4.x), bf_hi(pv4.x), bf_lo(pv4.y), bf_hi(pv4.y), bf_lo(pv4.z), bf_hi(pv4.z), bf_lo(pv4.w), bf_hi(pv4.w)};
            const bool roped = fq < 2; const float sg = (fq == 0) ? -1.f : 1.f; float o[8];
#pragma unroll
            for (int e = 0; e < 8; ++e) o[e] = (roped ? (mv[e] * cs[e] + sg * pp[e] * sn[e]) : mv[e]) * QS;
            q16f[sub][0] = pack_p(o);
            gs4[sub] = sigm(bf1(P[tok4 * PP + PC_NG + head4 * 3 + 1]));
        }
        float ma = -1e30f, la = 0.f, mb = -1e30f, lb = 0.f; f32x4v Oa[4], Ob[4];
#pragma unroll
        for (int dt = 0; dt < 4; ++dt) { Oa[dt] = (f32x4v){0.f, 0.f, 0.f, 0.f}; Ob[dt] = (f32x4v){0.f, 0.f, 0.f, 0.f}; }
        flash16_run(kb, vb, q16f[0], q16f[1], 2 * nblk, list, tq, t0, qi4, fq, ma, la, Oa, mb, lb, Ob);
        la = xq_sum(la); lb = xq_sum(lb);
        const float sca = gs4[0] / fmaxf(la, 1e-30f), scb = gs4[1] / fmaxf(lb, 1e-30f);
#pragma unroll
        for (int dt = 0; dt < 4; ++dt)
#pragma unroll
            for (int i = 0; i < 4; ++i) { LAS float* op = ostb + ((dt >> 1) * 16 + 4 * (2 * (dt & 1) + (fq >> 1)) + i) * 64 + q16 + 32 * (fq & 1); op[0] += sca * Oa[dt][i]; op[16] += scb * Ob[dt][i]; }
        LDS_WAIT();
    }
    {
        bf16x8 qr[4];
        {
            const bf16_t* qp = P + tok * PP + PC_Q + head * 64;
#pragma unroll
            for (int s = 1; s < 4; ++s) qr[s] = scale_q(*(const u32x4*)(qp + 16 * s + 8 * hi), QS);
            const u32x4 mv4 = *(const u32x4*)(qp + 8 * hi), pv4 = *(const u32x4*)(qp + 8 * (hi ^ 1));
            const float* rt = (const float*)(C.ws + WS_ROPE) + tok * 16;
            const f32x4 ca = *(const f32x4*)rt, cb2 = *(const f32x4*)(rt + 4), sa = *(const f32x4*)(rt + 8), sb = *(const f32x4*)(rt + 12);
            const float cs[8] = {ca.x, ca.y, ca.z, ca.w, cb2.x, cb2.y, cb2.z, cb2.w}, sn[8] = {sa.x, sa.y, sa.z, sa.w, sb.x, sb.y, sb.z, sb.w};
            const float mv[8] = {bf_lo(mv4.x), bf_hi(mv4.x), bf_lo(mv4.y), bf_hi(mv4.y), bf_lo(mv4.z), bf_hi(mv4.z), bf_lo(mv4.w), bf_hi(mv4.w)};
            const float pp[8] = {bf_lo(pv4.x), bf_hi(pv4.x), bf_lo(pv4.y), bf_hi(pv4.y), bf_lo(pv4.z), bf_hi(pv4.z), bf_lo(pv4.w), bf_hi(pv4.w)};
            const float sg = hi ? 1.f : -1.f; float o[8];
#pragma unroll
            for (int e = 0; e < 8; ++e) o[e] = (mv[e] * cs[e] + sg * pp[e] * sn[e]) * QS;
            qr[0] = pack_p(o);
        }
        const bf16x8* kb = (const bf16x8*)(C.ws + WS_KWIN) + (size_t)bg * 512 * 4 * 64 + lane;
        const bf16x8* vb = (const bf16x8*)(C.ws + WS_VWIN) + (size_t)bg * 1024 * 2 * 64 + lane;
        float m = -1e30f, l = 0.f; f32x16 O[2];
#pragma unroll
        for (int i = 0; i < 16; ++i) { O[0][i] = 0.f; O[1][i] = 0.f; }
        const int tlo = (t0 - 511 > 0 ? t0 - 511 : 0) >> 5, thi = (t0 + 7) >> 5;
        flash_run<1>(kb, vb, qr, thi - tlo + 1, (const LAS unsigned*)imp, tlo, t, t0, qi, hi, m, l, O);
        l = xhalf_sum(l);
        const float sc = gw / fmaxf(l, 1e-30f);
        bf16_t* yp = Y + tok * YP + 512 + head * 64 + 4 * hi;
#pragma unroll
        for (int dt = 0; dt < 2; ++dt)
#pragma unroll
            for (int ig = 0; ig < 4; ++ig) { float o4[4];
#pragma unroll
                for (int e = 0; e < 4; ++e) o4[e] = ost[(dt * 16 + 4 * ig + e) * 64] + sc * O[dt][4 * ig + e];
                u32x2 w; w.x = cvt_pk_bf16(o4[0], o4[1]); w.y = cvt_pk_bf16(o4[2], o4[3]); *(u32x2*)(yp + 32 * dt + 8 * ig) = w; }
        LDS_WAIT();
    }
}

__device__ __forceinline__ void mem_tile(const Ctx& C, int b, int hm, int t0) {
    const bf16_t* P = (const bf16_t*)(C.ws + WS_R1); bf16_t* Y = (bf16_t*)(C.ws + WS_Y);
    int lane_ = C.lane; asm volatile("" : "+v"(lane_));
    const int lane = lane_, r = lane & 31, hi = lane >> 5;
    const size_t tok = (size_t)b * S_ + t0 + r;
    const float QS = 0.12751743082459868f;
    bf16x8 q[8];
    const bf16_t* qp = P + tok * PP + PC_QM + hm * 128;
#pragma unroll
    for (int s = 0; s < 8; ++s) q[s] = scale_q(*(const u32x4*)(qp + 16 * s + 8 * hi), QS);
    const bf16x8* kb = (const bf16x8*)(C.ws + WS_MEMK) + (size_t)(b * 4 + hm) * 8 * 8 * 64 + lane;
    const bf16x8* vb = (const bf16x8*)(C.ws + WS_MEMV) + (size_t)(b * 4 + hm) * 16 * 4 * 64 + lane;
    float m = -1e30f, l = 0.f; f32x16 O[4];
#pragma unroll
    for (int i = 0; i < 16; ++i) { O[0][i] = 0.f; O[1][i] = 0.f; O[2][i] = 0.f; O[3][i] = 0.f; }
#define MEM_STEP(KF, VF) do { \
        f32x16 sc; _Pragma("unroll") for (int i = 0; i < 16; ++i) sc[i] = 0.f; \
        _Pragma("unroll") for (int s = 0; s < 8; ++s) sc = mfma32(KF[s], q[s], sc); \
        float mx = -1e30f; _Pragma("unroll") for (int i = 0; i < 16; ++i) mx = fmaxf(mx, sc[i]); \
        mx = xhalf_max(mx); \
        const float mn = fmaxf(m, mx), alpha = ex2(m - mn); m = mn; \
        float p[16], ps = 0.f; _Pragma("unroll") for (int i = 0; i < 16; ++i) { p[i] = ex2(sc[i] - mn); ps += p[i]; } \
        l = l * alpha + ps; \
        _Pragma("unroll") for (int i = 0; i < 16; ++i) { O[0][i] *= alpha; O[1][i] *= alpha; O[2][i] *= alpha; O[3][i] *= alpha; } \
        const bf16x8 pb0 = pack_p(p), pb1 = pack_p(p + 8); \
        _Pragma("unroll") for (int dt = 0; dt < 4; ++dt) { O[dt] = mfma32(VF[dt], pb0, O[dt]); O[dt] = mfma32(VF[4 + dt], pb1, O[dt]); } } while (0)
    {
        bf16x8 kA[8], vv[8];
#pragma unroll 1
        for (int kt = 0; kt < 8; ++kt) {
#pragma unroll
            for (int s = 0; s < 8; ++s) kA[s] = kb[kt * 512 + s * 64];
#pragma unroll
            for (int s = 0; s < 8; ++s) vv[s] = vb[kt * 512 + s * 64];
            __builtin_amdgcn_sched_barrier(0);
            MEM_STEP(kA, vv);
        }
    }
#undef MEM_STEP
    l = xhalf_sum(l);
    const float inv = 1.f / l;
    bf16_t* yp = Y + tok * YP + 1024 + hm * 128 + 4 * hi;
#pragma unroll
    for (int dt = 0; dt < 4; ++dt)
#pragma unroll
        for (int ig = 0; ig < 4; ++ig) { u32x2 w; w.x = cvt_pk_bf16(O[dt][4 * ig] * inv, O[dt][4 * ig + 1] * inv); w.y = cvt_pk_bf16(O[dt][4 * ig + 2] * inv, O[dt][4 * ig + 3] * inv); *(u32x2*)(yp + 32 * dt + 8 * ig) = w; }
}

__device__ __forceinline__ void attention_phase(const Ctx& C) {
    const int bxx = C.gw / NWAVES; const bool xmode = (C.G & 7) == 0;
    const int x = bxx & 7, rank = xmode ? (bxx >> 3) * NWAVES + C.wave : C.gw, nrank = xmode ? (C.G >> 3) * NWAVES : C.NGW, nitem = xmode ? 1536 : 12288;
    for (int i = rank; i < nitem; i += nrank) {
        int nsa_n, mem_e;
        if (xmode) { nsa_n = (i < 1024) ? (x >> 1) * 2048 + 2 * i + (x & 1) : -1; mem_e = x * 512 + (i - 1024); }
        else { if (i < 8192) { const int k = i >> 11, w = i & 2047; nsa_n = k * 2048 + ((k & 1) ? 2047 - w : w); } else nsa_n = -1; mem_e = i - 8192; }
        if (nsa_n >= 0) { const int k = nsa_n >> 11; nsa_tile(C, k >> 1, k & 1, (nsa_n & 2047) * 8); }
        else { const int bh = mem_e >> 9; mem_tile(C, bh >> 2, bh & 3, (mem_e & 511) * 32); }
    }
}

#define XB_TMO      128
#define XB_XCNT(j)  (256  + 64 * (j))
#define XB_XSUB(j)  (1280 + 64 * (j))
#define XB_XGEN(j)  (2304 + 64 * (j))
#define XB_TOP      3328
#define XB_TOPGEN   3392
#define XCD_BAR_WORDS 3456
#define XB_SPIN_CAP (1u << 18)
__device__ __forceinline__ unsigned xb_ld(unsigned* p)              { return __hip_atomic_load(p, __ATOMIC_RELAXED, __HIP_MEMORY_SCOPE_AGENT); }
__device__ __forceinline__ unsigned xb_add(unsigned* p, unsigned v) { return __hip_atomic_fetch_add(p, v, __ATOMIC_RELAXED, __HIP_MEMORY_SCOPE_AGENT); }
__device__ __forceinline__ unsigned xb_xcc_id() { return (unsigned)__builtin_amdgcn_s_getreg((3 << 11) | 20) & 0xFu; }
#define XB_SPIN(cond, bar) do { unsigned _sp = 0; while (cond) { __builtin_amdgcn_s_sleep(1); \
    if ((++_sp & 255u) == 0u) { if (xb_ld(&(bar)[XB_TMO])) break; if (_sp > XB_SPIN_CAP) { atomicAdd(&(bar)[XB_TMO], 1u); break; } } } } while (0)
__device__ __forceinline__ void xcd_barrier_complete(unsigned* bar, unsigned x, unsigned& nloc, unsigned& nx) {
    const unsigned G = gridDim.x * gridDim.y * gridDim.z;
    unsigned sum, cnt, mine, sp = 0u;
    for (;;) {
        sum = 0u; cnt = 0u; mine = 0u;
#pragma unroll
        for (unsigned j = 0; j < 16; ++j) { const unsigned c = xb_ld(&bar[XB_XCNT(j)]); sum += c; cnt += (c > 0u) ? 1u : 0u; mine = (j == x) ? c : mine; }
        if (sum == G) break;
        __builtin_amdgcn_s_sleep(1);
        if ((++sp & 255u) == 0u) { if (xb_ld(&bar[XB_TMO])) break; if (sp > XB_SPIN_CAP) { atomicAdd(&bar[XB_TMO], 1u); break; } }
    }
    nloc = mine > 0u ? mine : 1u; nx = cnt > 0u ? cnt : 1u;
}
__device__ __forceinline__ void xcd_barrier(unsigned* bar, volatile LAS unsigned* st, bool tid0) {
    asm volatile("s_waitcnt vmcnt(0)" ::: "memory");
    __syncthreads();
    if (tid0) {
        __builtin_amdgcn_s_waitcnt(0);
        const unsigned x = xb_xcc_id();
        unsigned nloc = st[0], nx = st[1];
        if (nloc == 0u) { xcd_barrier_complete(bar, x, nloc, nx); st[0] = nloc; st[1] = nx; }
        const unsigned old = xb_add(&bar[XB_XSUB(x)], 1u);
        const unsigned gen = old / nloc;
        if (old + 1u == (gen + 1u) * nloc) {
            __builtin_amdgcn_fence(__ATOMIC_RELEASE, "agent");
            asm volatile("s_waitcnt vmcnt(0)" ::: "memory");
            const unsigned og = xb_add(&bar[XB_TOP], 1u);
            const unsigned tg = og / nx;
            if (og + 1u == (tg + 1u) * nx) xb_add(&bar[XB_TOPGEN], 1u);
            else XB_SPIN(xb_ld(&bar[XB_TOPGEN]) == tg, bar);
            __builtin_amdgcn_fence(__ATOMIC_ACQUIRE, "agent");
            xb_add(&bar[XB_XGEN(x)], 1u);
            asm volatile("s_waitcnt vmcnt(0)" ::: "memory");
        } else {
            XB_SPIN(xb_ld(&bar[XB_XGEN(x)]) == gen, bar);
            __builtin_amdgcn_fence(__ATOMIC_ACQUIRE, "agent");
            asm volatile("s_waitcnt vmcnt(0)" ::: "memory");
        }
    }
    __syncthreads();
}

constexpr int LDS_BYTES = 147456, XB_LDS_OFF = 147456 - 64;
constexpr int NPHASE = 1 + 2 * 14;

__global__ void __launch_bounds__(NWAVES * 64, 2) fwd_kernel(Args args) {
    extern __shared__ __attribute__((aligned(16))) unsigned char lds_raw[];
    cg::grid_group grid = cg::this_grid();
    if (args.ph_lo == 0x7fffffff) grid.sync();
    const int wave0 = __builtin_amdgcn_readfirstlane((int)threadIdx.x >> 6);
    {
        volatile LAS unsigned* st = (volatile LAS unsigned*)(lds_raw + XB_LDS_OFF);
        if (threadIdx.x == 0) { st[0] = 0u; st[1] = 0u; (void)xb_add((unsigned*)(args.ws + WS_BAR) + XB_XCNT(xb_xcc_id()), 1u); }
        __syncthreads();
    }
#define PHASE_BEGIN { \
        unsigned char* ws0_ = args.ws; asm volatile("" : "+s"(ws0_)); gu8* ws = (gu8*)ws0_;     \
        int tid_; asm volatile("v_mbcnt_lo_u32_b32 %0, -1, 0\n\tv_mbcnt_hi_u32_b32 %0, -1, %0" : "=v"(tid_)); tid_ += wave0 * 64; \
        Ctx C; C.a = &args; C.ws = ws; C.lds = (LAS unsigned char*)lds_raw; C.tid = tid_; C.lane = tid_ & 63; C.wave = __builtin_amdgcn_readfirstlane(tid_ >> 6); \
        int bx = blockIdx.x; asm volatile("" : "+s"(bx)); C.G = gridDim.x; C.gw = bx * NWAVES + C.wave; C.NGW = C.G * NWAVES; \
        bf16_t* const H = (bf16_t*)(ws + WS_H); bf16_t* const R1 = (bf16_t*)(ws + WS_R1); bf16_t* const Y = (bf16_t*)(ws + WS_Y); (void)H; (void)R1; (void)Y; (void)bx;
#define PHASE_END   { int ln_; asm volatile("v_mbcnt_lo_u32_b32 %0, -1, 0\n\tv_mbcnt_hi_u32_b32 %0, -1, %0" : "=v"(ln_));   \
        xcd_barrier((unsigned*)(ws + WS_BAR), (volatile LAS unsigned*)(lds_raw + XB_LDS_OFF), (wave0 == 0) && (ln_ == 0)); } }
#define PHASE_END_CG grid.sync(); }

    PHASE_BEGIN
        convert_layer(C, 0);
        rope_table(C);
        prenorm_rows(C, (const float*)args.in[0], (const float*)args.in[3], H);
    PHASE_END

#pragma unroll 1
    for (int l = 0; l < 2; ++l) {
        PHASE_BEGIN
            { pg8::GemmDesc g{(const char*)H, (const char*)(ws + WS_W1IN), DM, DM, 128, 128, 16}; pg8::StdOrder S; S.init(T_, 2 * FF, C.G, bx, DM, DM);
              pg8::Epi<1> E{R1, FF, nullptr, nullptr}; pg8::gemm_phase(C.lds, C.tid, g, S, E); }
        PHASE_END
        PHASE_BEGIN
            { pg8::GemmDesc g{(const char*)R1, (const char*)(ws + WS_W1OUT), FF, FF, 128, 128, 44}; pg8::StdOrder S; S.init(T_, DM, C.G, bx, FF, FF);
              pg8::Epi<0> E{H, DM, nullptr, nullptr}; pg8::gemm_phase(C.lds, C.tid, g, S, E); }
        PHASE_END
        PHASE_BEGIN
            if (bx < 8) {
                { pg8::GemmDesc g{(const char*)(ws + WS_MEMN), (const char*)(ws + WS_WMKV), DM, DM, 128, 128, 16}; pg8::StdOrder S; S.init(512, DM, C.G, bx, DM, DM);
              pg8::Epi<0> E{(bf16_t*)(ws + WS_MKV), DM, nullptr, nullptr}; pg8::gemm_phase(C.lds, C.tid, g, S, E); }
            } else {
                norm_phase(C, C.gw - 8 * NWAVES, C.NGW - 8 * NWAVES, l == 0 ? (const float*)args.in[0] : args.out, args.out, H, H, INF(4, l, DM), INF(7, l, DM), 0.5f);
            }
            cb_reduce(C, l);
        PHASE_END
        PHASE_BEGIN
            { pg8::GemmDesc g{(const char*)H, (const char*)(ws + WS_WMIX), DM, DM, 128, 128, 16}; pg8::StdOrder S; S.init(T_, PP, C.G, bx, DM, DM);
              pg8::Epi<0> E{R1, PP, nullptr, nullptr}; pg8::gemm_phase(C.lds, C.tid, g, S, E); }
        PHASE_END
        PHASE_BEGIN
            if (bx < 32) {
                pg8::GemmDesc g{(const char*)R1, (const char*)(ws + WS_WC1), 16 * PP, 2048, PP * 2, 128, 32}; pg8::CmpOrder S{bx};
                pg8::Epi<4> E{(bf16_t*)(ws + WS_CMPH), 256, nullptr, (const float*)(ws + WS_CB) + l * 512}; pg8::gemm_phase(C.lds, C.tid, g, S, E);
            } else {
                prep_items(C, l, C.gw - 32 * NWAVES, C.NGW - 32 * NWAVES);
                memkv_ops(C, C.gw - 32 * NWAVES, C.NGW - 32 * NWAVES);
            }
        PHASE_END
        PHASE_BEGIN
            cmp_stage2(C, l);
        PHASE_END
        PHASE_BEGIN
            attention_phase(C);
        PHASE_END
        PHASE_BEGIN
            { pg8::GemmDesc g{(const char*)H, (const char*)(ws + WS_WG), DM, DM, 128, 128, 16}; pg8::StdOrder S; S.init(T_, GP, C.G, bx, DM, DM);
              pg8::Epi<2> E{R1, GP, nullptr, nullptr}; pg8::gemm_phase(C.lds, C.tid, g, S, E); }
        PHASE_END
        PHASE_BEGIN
            { pg8::GemmDesc g{(const char*)Y, (const char*)(ws + WS_WBR), YP, YP, 128, 128, 8}; pg8::MergeOrder S; S.init(T_, DM, C.G, bx, YP, YP);
              pg8::Epi<3> E{H, DM, R1, nullptr}; pg8::gemm_phase(C.lds, C.tid, g, S, E); }
        PHASE_END
        PHASE_BEGIN
            { pg8::GemmDesc g{(const char*)H, (const char*)(ws + WS_WOUT), DM, DM, 128, 128, 16}; pg8::StdOrder S; S.init(T_, DM, C.G, bx, DM, DM);
              pg8::Epi<0> E{R1, DM, nullptr, nullptr}; pg8::gemm_phase(C.lds, C.tid, g, S, E); }
        PHASE_END
        PHASE_BEGIN
            norm_phase(C, C.gw, C.NGW, args.out, args.out, R1, H, INF(8, l, DM), INF(25, l, DM), 1.0f);
        PHASE_END
        PHASE_BEGIN
            { pg8::GemmDesc g{(const char*)H, (const char*)(ws + WS_W2IN), DM, DM, 128, 128, 16}; pg8::StdOrder S; S.init(T_, 2 * FF, C.G, bx, DM, DM);
              pg8::Epi<1> E{R1, FF, nullptr, nullptr}; pg8::gemm_phase(C.lds, C.tid, g, S, E); }
        PHASE_END
        PHASE_BEGIN
            { pg8::GemmDesc g{(const char*)R1, (const char*)(ws + WS_W2OUT), FF, FF, 128, 128, 44}; pg8::StdOrder S; S.init(T_, DM, C.G, bx, FF, FF);
              pg8::Epi<0> E{H, DM, nullptr, nullptr}; pg8::gemm_phase(C.lds, C.tid, g, S, E); }
        PHASE_END
        PHASE_BEGIN
            norm_phase(C, C.gw, C.NGW, args.out, args.out, H, H, INF(26, l, DM), l == 0 ? INF(3, 1, DM) : nullptr, 0.5f);
            if (l == 0) convert_layer(C, 1);
        PHASE_END
    }
}

extern "C" void kernel_launch(void* const* d_in, const int* in_sizes, int n_in, void* d_out, int out_size, void* d_ws, size_t ws_size, hipStream_t stream) {
    static int grid = 0;
    if (grid == 0) {
        if (n_in != 29 || ws_size < WS_END) { fprintf(stderr, "kernel_launch: unexpected n_in %d / ws %zu\n", n_in, ws_size); grid = -1; return; }
        int dev = 0, cus = 0, per_cu = 0;
        hipGetDevice(&dev); hipDeviceGetAttribute(&cus, hipDeviceAttributeMultiprocessorCount, dev);
        hipFuncSetAttribute((const void*)fwd_kernel, hipFuncAttributeMaxDynamicSharedMemorySize, LDS_BYTES);
        hipOccupancyMaxActiveBlocksPerMultiprocessor(&per_cu, (const void*)fwd_kernel, NWAVES * 64, LDS_BYTES);
        if (per_cu < 1) per_cu = 1;
        grid = cus * per_cu;
        (void)hipGetLastError();
    }
    if (grid < 0) return;
    hipMemsetAsync((char*)d_ws + WS_BAR, 0, 16384, stream);
    Args a{};
    for (int i = 0; i < 29; ++i) a.in[i] = d_in[i];
    a.out = (float*)d_out; a.ws = (unsigned char*)d_ws; a.ph_lo = 0; a.ph_hi = NPHASE;
    void* kargs[] = {&a};
    hipError_t e = hipLaunchCooperativeKernel((const void*)fwd_kernel, dim3(grid), dim3(NWAVES * 64), kargs, LDS_BYTES, stream);
    if (e != hipSuccess) fprintf(stderr, "cooperative launch failed: %s (grid %d)\n", hipGetErrorString(e), grid);
}
```

```cpp
#include <hip/hip_runtime.h>
#include <hip/hip_cooperative_groups.h>
#include <cstdio>
#include <cstdint>
namespace cg = cooperative_groups;

#define LAS __attribute__((address_space(3)))
typedef unsigned short bf16_t;
typedef short bf16x8 __attribute__((ext_vector_type(8)));
typedef float f32x4 __attribute__((ext_vector_type(4)));
typedef float f32x16 __attribute__((ext_vector_type(16)));
typedef unsigned u32x4 __attribute__((ext_vector_type(4)));
typedef unsigned u32x2 __attribute__((ext_vector_type(2)));

constexpr int NBATCH = 2, S_ = 16384, T_ = NBATCH * S_, DM = 1024, FF = 2816, PP = 3584, GP = 3072, YP = 1536;
constexpr int NWAVES = 8;
constexpr float EPS = 1e-6f;
constexpr int PC_Q = 1536, PC_KV = 2048, PC_QM = 2816, PC_NG = 3328;

constexpr size_t MiB = 1u << 20;
constexpr size_t WS_W1IN = 0, WS_W1OUT = 11 * MiB, WS_WMIX = WS_W1OUT + 11 * MiB / 2, WS_WG = WS_WMIX + 7 * MiB, WS_WBR = WS_WG + 6 * MiB, WS_WOUT = WS_WBR + 3 * MiB,
                 WS_W2IN = WS_WOUT + 2 * MiB, WS_W2OUT = WS_W2IN + 11 * MiB, WS_WC1 = WS_W2OUT + 11 * MiB / 2  , WS_WMKV = WS_WC1 + 2 * MiB,
                 WS_MEMN = WS_WMKV + 2 * MiB, WS_MKV = WS_MEMN + 1 * MiB, WS_CB = WS_MKV + 1 * MiB  , WS_CBP = WS_CB + 8192  , WS_BAR = WS_CB + 8192 + 131072  ;
static_assert(WS_CB == 57 * MiB, "ws map");
constexpr size_t WS_ROPE = 58 * MiB, WS_MEMK = 60 * MiB, WS_MEMV = WS_MEMK + MiB / 2, WS_KCMP = 61 * MiB, WS_VCMP = WS_KCMP + MiB / 2, WS_CMPH = 62 * MiB,
                 WS_KSLC = 66 * MiB, WS_VSLC = 74 * MiB, WS_KWIN = 82 * MiB, WS_VWIN = 90 * MiB, WS_H = 98 * MiB, WS_Y = 162 * MiB, WS_R1 = 258 * MiB, WS_CMPP = 484 * MiB  , WS_END = 492 * MiB;

typedef float f32x2_t __attribute__((ext_vector_type(2)));
typedef __bf16 bf16x2_t __attribute__((ext_vector_type(2)));
__device__ __forceinline__ unsigned cvt_pk_bf16(float lo, float hi) { f32x2_t v = {lo, hi}; bf16x2_t b = __builtin_convertvector(v, bf16x2_t); return __builtin_bit_cast(unsigned, b); }
__device__ __forceinline__ float bf_lo(unsigned u) { return __uint_as_float(u << 16); }
__device__ __forceinline__ float bf_hi(unsigned u) { return __uint_as_float(u & 0xffff0000u); }
__device__ __forceinline__ float bf1(bf16_t u) { return __uint_as_float(((unsigned)u) << 16); }
__device__ __forceinline__ float ex2(float x) { return __builtin_amdgcn_exp2f(x); }
__device__ __forceinline__ float rcpf_(float x) { return __builtin_amdgcn_rcpf(x); }
__device__ __forceinline__ float sigm(float x) { return rcpf_(1.f + ex2(-1.44269504f * x)); }
__device__ __forceinline__ float gelu_tanh(float x) { const float u = 0.7978845608f * (x + 0.044715f * x * x * x); return x * rcpf_(1.f + ex2(-2.88539008f * u)); }
__device__ __forceinline__ float wave_sum(float v) {
#pragma unroll
    for (int o = 1; o < 64; o <<= 1) v += __shfl_xor(v, o);
    return v;
}
__device__ __forceinline__ int pi32(int r) { return (r & 0x13) | ((r & 4) << 1) | ((r & 8) >> 1); }
#define LDS_WAIT() asm volatile("s_waitcnt lgkmcnt(0)" ::: "memory")

namespace pg8 {
constexpr int BM = 256, BK = 64, HALF = 128, HTB = HALF * BK * 2, STAGE_BYTES = 8 * HTB, NXCD = 8, WGM = 8;
__device__ __forceinline__ int lds_byte(int r, int c) { const int st = (r >> 4) * 2 + (c >> 5), rr = r & 15, cc = c & 31, ob = rr * 64 + cc * 2; return st * 1024 + (ob ^ (((ob >> 9) & 1) << 5)); }
__device__ __forceinline__ void stage_rc(int b, int& R, int& C) { const int st = b / 1024, sb = b % 1024, swz = sb ^ (((sb >> 9) & 1) << 5); R = (st >> 1) * 16 + swz / 64; C = (st & 1) * 32 + (swz % 64) / 2; }
__device__ __forceinline__ int perm32(int rho) { const int n = rho >> 4, i = rho & 15; return 8 * (i >> 2) + 4 * n + (i & 3); }

struct Unit { int pm, pn, tag; long long aoff, boff; };
struct GemmDesc { const char* A; const char* Bt; int lda, ldb, kstepA, kstepB, nt; };

__device__ __forceinline__ void swz_tile(int L, int nM, int nN, int& pm, int& pn) {
    const int nwg = nM * nN; int wgid = L;
    { const int q = nwg / NXCD, r = nwg % NXCD, xcd = wgid % NXCD, off = wgid / NXCD; wgid = (xcd < r ? xcd * (q + 1) : r * (q + 1) + (xcd - r) * q) + off; }
    const int nig = WGM * nN, gid = wgid / nig, fm = gid * WGM, gsz = (nM - fm) < WGM ? (nM - fm) : WGM;
    pm = fm + ((wgid % nig) % gsz); pn = (wgid % nig) / gsz;
}
struct StdOrder {
    int nM, nN, G, c; long long tA, tB;
    __device__ void init(int M, int N, int G_, int c_, int lda, int ldb) { nM = M / BM; nN = N / BM; G = G_; c = c_; tA = 512LL * lda; tB = 512LL * ldb; }
    __device__ bool next(int i, Unit& u) const {
        const long long L = (long long)i * G + c; if (L >= (long long)nM * nN) return false;
        swz_tile((int)L, nM, nN, u.pm, u.pn); u.tag = 0; u.aoff = u.pm * tA; u.boff = u.pn * tB; return true;
    }
};
struct MergeOrder {
    int nM, nN, G, c; long long tA, tB;
    __device__ void init(int M, int N, int G_, int c_, int lda, int ldb) { nM = M / BM; nN = N / BM; G = G_; c = c_; tA = 512LL * lda; tB = 512LL * ldb; }
    __device__ bool next(int i, Unit& u) const {
        const int ti = i / 3, br = i - 3 * ti; const long long L = (long long)ti * G + c; if (L >= (long long)nM * nN) return false;
        swz_tile((int)L, nM, nN, u.pm, u.pn); u.tag = br; u.aoff = u.pm * tA + br * 1024; u.boff = u.pn * tB + br * 1024; return true;
    }
};
struct CmpOrder {
    int c;
    __device__ bool next(int i, Unit& u) const {
        if (i != 0 || c >= 64) return false;
        const int ks = c >> 5, kv = (c >> 4) & 1, bg = (c >> 2) & 3, tile = c & 3, b = bg >> 1, g = bg & 1;
        u.pm = c; u.pn = 0; u.tag = kv;
        u.aoff = 2LL * (((long long)b * S_ + 4096LL * tile + 16LL * ks) * PP + PC_KV + kv * 128 + g * 64);
        u.boff = (long long)kv * (256 * 2048 * 2) + (long long)ks * (1024 * 2); return true;
    }
};

__device__ __forceinline__ u32x4 pack8(f32x4 a, f32x4 b) { u32x4 w; w.x = cvt_pk_bf16(a[0], a[1]); w.y = cvt_pk_bf16(a[2], a[3]); w.z = cvt_pk_bf16(b[0], b[1]); w.w = cvt_pk_bf16(b[2], b[3]); return w; }
template <int MODE> struct Epi {
    bf16_t* O; int ldc; const bf16_t* G; const float* bias;
    __device__ __forceinline__ void operator()(const f32x4 (&acc)[2][2][4][2], const Unit& u, int wr, int wc, int fr, int fq) const {
        const int row0 = u.pm * BM + wr * 64 + fr;
        if constexpr (MODE == 1) {
            const int col0 = u.pn * 128 + wc * 32 + 8 * fq;
#pragma unroll
            for (int ai = 0; ai < 2; ++ai)
#pragma unroll
                for (int m = 0; m < 4; ++m) {
                    bf16_t* rowp = O + (size_t)(row0 + ai * HALF + m * 16) * ldc + col0;
                    f32x4 v0, v1;
#pragma unroll
                    for (int e = 0; e < 4; ++e) { const float a0 = acc[ai][0][m][0][e], a1 = acc[ai][0][m][1][e]; v0[e] = a0 * sigm(a0) * acc[ai][1][m][0][e]; v1[e] = a1 * sigm(a1) * acc[ai][1][m][1][e]; }
                    *(u32x4*)rowp = pack8(v0, v1);
                    __builtin_amdgcn_sched_barrier(0);
                }
        } else {
            const int col0 = u.pn * BM + wc * 32 + 8 * fq;
#pragma unroll
            for (int ai = 0; ai < 2; ++ai)
#pragma unroll
                for (int m = 0; m < 4; ++m) {
                    const size_t row = (size_t)(row0 + ai * HALF + m * 16);
#pragma unroll
                    for (int bj = 0; bj < 2; ++bj) {
                        const int col = col0 + bj * HALF;
                        f32x4 v0 = acc[ai][bj][m][0], v1 = acc[ai][bj][m][1];
                        bf16_t* dst = O + row * ldc + col;
                        if constexpr (MODE == 2) {
#pragma unroll
                            for (int e = 0; e < 4; ++e) { v0[e] = sigm(v0[e]); v1[e] = sigm(v1[e]); }
                        }
                        if constexpr (MODE == 4) {
                            const f32x4 b0 = *(const f32x4*)(bias + u.tag * 256 + col), b1 = *(const f32x4*)(bias + u.tag * 256 + col + 4);
#pragma unroll
                            for (int e = 0; e < 4; ++e) { v0[e] = gelu_tanh(v0[e] + b0[e]); v1[e] = gelu_tanh(v1[e] + b1[e]); }
                        }
                        if constexpr (MODE == 3) {
                            const u32x4 gv = *(const u32x4*)(G + row * GP + u.tag * 1024 + col);
                            v0[0] *= bf_lo(gv.x); v0[1] *= bf_hi(gv.x); v0[2] *= bf_lo(gv.y); v0[3] *= bf_hi(gv.y);
                            v1[0] *= bf_lo(gv.z); v1[1] *= bf_hi(gv.z); v1[2] *= bf_lo(gv.w); v1[3] *= bf_hi(gv.w);
                            if (u.tag > 0) {
                                const u32x4 ov = *(const u32x4*)dst;
                                v0[0] += bf_lo(ov.x); v0[1] += bf_hi(ov.x); v0[2] += bf_lo(ov.y); v0[3] += bf_hi(ov.y);
                                v1[0] += bf_lo(ov.z); v1[1] += bf_hi(ov.z); v1[2] += bf_lo(ov.w); v1[3] += bf_hi(ov.w);
                            }
                        }
                        *(u32x4*)dst = pack8(v0, v1);
                    }
                }
        }
    }
};

template <class EpiT, class Sched>
__device__ __forceinline__ void gemm_phase(LAS unsigned char* lds, int tid_in, const GemmDesc g, const Sched& S, const EpiT& E) {
    int tid_ = tid_in; asm volatile("" : "+v"(tid_));
    const int tid = tid_, wid = __builtin_amdgcn_readfirstlane(tid >> 6), lane = tid & 63, wr = wid >> 2, wc = wid & 3, fr = lane & 15, fq = lane >> 4;
    const int nt = g.nt;
    unsigned voffA[2], voffB[2];
#pragma unroll
    for (int i = 0; i < 2; ++i) { int R, C; stage_rc(tid * 16 + i * 8192, R, C); const int Rb = (R & ~31) + perm32(R & 31);
        voffA[i] = (unsigned)(R * g.lda + C) * 2u; voffB[i] = (unsigned)(Rb * g.ldb + C) * 2u; }
    const size_t kA = (size_t)g.kstepA, kB = (size_t)g.kstepB;
    const size_t hA = (size_t)HALF * g.lda * 2, hB = (size_t)HALF * g.ldb * 2;
    const unsigned ldsw = (unsigned)wid * 1024u;
    const int aoff = lds_byte(wr * 64 + fr, fq * 8), boff = lds_byte(wc * 32 + fr, fq * 8);
#define PG8_SA(b, h) (((b) * 2 + (h)) * HTB)
#define PG8_SB(b, h) ((4 + (b) * 2 + (h)) * HTB)
#define PG8_STAGE(bufoff, gbase, voff) do { _Pragma("unroll") for (int _i = 0; _i < 2; ++_i) \
        __builtin_amdgcn_global_load_lds((const unsigned*)((const char*)(gbase) + (voff)[_i]), (LAS unsigned*)(lds + (bufoff) + ldsw + _i * 8192), 16, 0, 0); } while (0)
#define PG8_LDA(dst, b, h) do { _Pragma("unroll") for (int m = 0; m < 4; ++m) _Pragma("unroll") for (int k = 0; k < 2; ++k) dst[m][k] = *(const LAS bf16x8*)(lds + PG8_SA(b, h) + aoff + m * 2048 + k * 1024); } while (0)
#define PG8_LDB(dst, b, h) do { _Pragma("unroll") for (int n = 0; n < 2; ++n) _Pragma("unroll") for (int k = 0; k < 2; ++k) dst[n][k] = *(const LAS bf16x8*)(lds + PG8_SB(b, h) + boff + n * 2048 + k * 1024); } while (0)
#define PG8_MMA(ai, bj, At, Bt) do { __builtin_amdgcn_s_setprio(1); _Pragma("unroll") for (int m = 0; m < 4; ++m) _Pragma("unroll") for (int n = 0; n < 2; ++n) _Pragma("unroll") for (int k = 0; k < 2; ++k) \
        acc[ai][bj][m][n] = __builtin_amdgcn_mfma_f32_16x16x32_bf16(Bt[n][k], At[m][k], acc[ai][bj][m][n], 0, 0, 0); __builtin_amdgcn_s_setprio(0); } while (0)
#define PG8_WAIT_V(n) asm volatile("s_waitcnt vmcnt(" #n ")" ::: "memory")
#define PG8_WAIT_L(n) asm volatile("s_waitcnt lgkmcnt(" #n ")" ::: "memory")
#define PG8_BAR __builtin_amdgcn_s_barrier()
#define PG8_SCHED __builtin_amdgcn_sched_barrier(0)
    Unit cur, nxt; int ui = 0;
    if (!S.next(0, cur)) return;
    f32x4 acc[2][2][4][2];
#pragma unroll
    for (int a = 0; a < 2; ++a)
#pragma unroll
        for (int b = 0; b < 2; ++b)
#pragma unroll
            for (int m = 0; m < 4; ++m)
#pragma unroll
                for (int n = 0; n < 2; ++n) acc[a][b][m][n] = (f32x4){0.f, 0.f, 0.f, 0.f};
    bf16x8 At[4][2], B0[2][2], B1[2][2];
    const char* cA = g.A + cur.aoff; const char* cB = g.Bt + cur.boff;
    PG8_STAGE(PG8_SB(0, 0), cB, voffB); PG8_STAGE(PG8_SB(0, 1), cB + hB, voffB); PG8_STAGE(PG8_SA(0, 0), cA, voffA); PG8_STAGE(PG8_SA(0, 1), cA + hA, voffA);
    if (wr == 1) PG8_BAR;
    PG8_WAIT_V(2); PG8_BAR;
    PG8_STAGE(PG8_SB(1, 0), cB + kB, voffB); PG8_STAGE(PG8_SA(1, 0), cA + kA, voffA); PG8_STAGE(PG8_SB(1, 1), cB + hB + kB, voffB);
    PG8_WAIT_V(6); PG8_BAR;
    for (;;) {
        const bool has_next = S.next(ui + 1, nxt);
        const char* nA = has_next ? g.A + nxt.aoff : cA; const char* nB = has_next ? g.Bt + nxt.boff : cB;
        for (int t = 0; t < nt; t += 2) {
            const bool last = (t == nt - 2);
            const char* a1 = cA + (size_t)(t + 1) * kA;
            const char* a2 = last ? nA : cA + (size_t)(t + 2) * kA; const char* b2 = last ? nB : cB + (size_t)(t + 2) * kB;
            const char* a3 = a2 + kA; const char* b3 = b2 + kB;
            PG8_LDB(B0, 0, 0); PG8_LDB(B1, 0, 1); PG8_SCHED; PG8_LDA(At, 0, 0); PG8_STAGE(PG8_SA(1, 1), a1 + hA, voffA);
            PG8_WAIT_V(8); PG8_WAIT_L(0); PG8_BAR; PG8_MMA(0, 0, At, B0); PG8_MMA(0, 1, At, B1); PG8_BAR; PG8_SCHED;
            PG8_LDA(At, 0, 1); PG8_STAGE(PG8_SB(0, 0), b2, voffB); PG8_STAGE(PG8_SB(0, 1), b2 + hB, voffB); PG8_STAGE(PG8_SA(0, 0), a2, voffA);
            PG8_WAIT_V(8); PG8_WAIT_L(0); PG8_BAR; PG8_MMA(1, 0, At, B0); PG8_MMA(1, 1, At, B1); PG8_BAR; PG8_SCHED;
            PG8_LDB(B0, 1, 0); PG8_LDB(B1, 1, 1); PG8_SCHED; PG8_LDA(At, 1, 0); PG8_STAGE(PG8_SA(0, 1), a2 + hA, voffA);
            PG8_WAIT_V(8); PG8_WAIT_L(0); PG8_BAR; PG8_MMA(0, 0, At, B0); PG8_MMA(0, 1, At, B1); PG8_BAR; PG8_SCHED;
            PG8_LDA(At, 1, 1); PG8_STAGE(PG8_SB(1, 0), b3, voffB); PG8_STAGE(PG8_SB(1, 1), b3 + hB, voffB); PG8_STAGE(PG8_SA(1, 0), a3, voffA);
            PG8_WAIT_V(8); PG8_WAIT_L(0); PG8_BAR; PG8_MMA(1, 0, At, B0); PG8_MMA(1, 1, At, B1); PG8_BAR; PG8_SCHED;
        }
        if (wr == 0) PG8_BAR;
        E(acc, cur, wr, wc, fr, fq);
        if (!has_next) break;
#pragma unroll
        for (int a = 0; a < 2; ++a)
#pragma unroll
            for (int b = 0; b < 2; ++b)
#pragma unroll
                for (int m = 0; m < 4; ++m)
#pragma unroll
                    for (int n = 0; n < 2; ++n) acc[a][b][m][n] = (f32x4){0.f, 0.f, 0.f, 0.f};
        cur = nxt; cA = nA; cB = nB; ++ui;
        if (wr == 1) PG8_BAR;
    }
    PG8_WAIT_V(0);
    PG8_BAR;
#undef PG8_SA
#undef PG8_SB
#undef PG8_STAGE
#undef PG8_LDA
#undef PG8_LDB
#undef PG8_MMA
#undef PG8_WAIT_V
#undef PG8_WAIT_L
#undef PG8_BAR
#undef PG8_SCHED
}
}

struct Args { const void* in[29]; float* out; unsigned char* ws; int ph_lo, ph_hi; };
static_assert(sizeof(Args) == 29 * 8 + 8 + 8 + 8, "Args has no padding");

typedef __attribute__((address_space(1))) unsigned char gu8;
struct Ctx {
    const Args* a; gu8* ws; LAS unsigned char* lds; int tid, lane, wave, G, gw, NGW;
};
#define INF(k, l, n) ((const float*)C.a->in[k] + (size_t)(l) * (n))

__device__ __forceinline__ void tr_item(const float* W, int ldw, int src_col, int nvalid, int k0, bf16_t* WT, int ldt, int dst_row, int dst_k, LAS float* scr, int lane) {
#pragma unroll 8
    for (int i = 0; i < 32; ++i) { const int kk = 2 * i + (lane >> 5), c = lane & 31; scr[kk * 33 + c] = (c < nvalid) ? W[(size_t)(k0 + kk) * ldw + src_col + c] : 0.f; }
    LDS_WAIT();
    const int c = lane & 7;
#pragma unroll
    for (int j = 0; j < 4; ++j) { const int n = (lane >> 3) + 8 * j; const LAS float* s = scr + (8 * c) * 33 + n;
        u32x4 o; o.x = cvt_pk_bf16(s[0 * 33], s[1 * 33]); o.y = cvt_pk_bf16(s[2 * 33], s[3 * 33]); o.z = cvt_pk_bf16(s[4 * 33], s[5 * 33]); o.w = cvt_pk_bf16(s[6 * 33], s[7 * 33]);
        *(u32x4*)(WT + (size_t)(dst_row + n) * ldt + dst_k + k0 + 8 * c) = o; }
    LDS_WAIT();
}

__device__ __forceinline__ void convert_layer(const Ctx& C, int l) {
    LAS float* scr = (LAS float*)(C.lds + C.wave * 8448);
    gu8* ws = C.ws; const int lane = C.lane;
    constexpr int NITEMS = 2816 + 1408 + 1792 + 1536 + 768 + 512 + 2816 + 1408 + 256 + 256 + 512;
    for (int it = C.gw; it < NITEMS; it += C.NGW) {
        int r = it;
        if (r < 2816) { const int kb = r / 176, nb = r % 176, tile = nb >> 3, w = nb & 7, src = (w >> 2) * FF + tile * 128 + (w & 3) * 32;
            tr_item(INF(5, l, DM * 2 * FF), 2 * FF, src, 32, kb * 64, (bf16_t*)(ws + WS_W1IN), DM, nb * 32, 0, scr, lane); continue; } r -= 2816;
        if (r < 1408) { const int kb = r / 32, nb = r % 32;
            tr_item(INF(6, l, FF * DM), DM, nb * 32, 32, kb * 64, (bf16_t*)(ws + WS_W1OUT), FF, nb * 32, 0, scr, lane); continue; } r -= 1408;
        if (r < 1792) { const int kb = r / 112, nb = r % 112; int src = 0, nv = 0;
            if (nb < 88) { src = nb * 32; nv = 32; } else if (nb < 104) { src = 2840 + (nb - 88) * 32; nv = 32; } else if (nb == 104) { src = 2816; nv = 24; }
            tr_item(INF(10, l, DM * 6424), 6424, src, nv, kb * 64, (bf16_t*)(ws + WS_WMIX), DM, nb * 32, 0, scr, lane); continue; } r -= 1792;
        if (r < 1536) { const int kb = r / 96, nb = r % 96;
            tr_item(INF(10, l, DM * 6424), 6424, 3352 + nb * 32, 32, kb * 64, (bf16_t*)(ws + WS_WG), DM, nb * 32, 0, scr, lane); continue; } r -= 1536;
        if (r < 768) { const int br = r / 256, q = r % 256, kb = q / 32, nb = q % 32;
            const float* W = br == 0 ? INF(21, l, 512 * DM) : (br == 1 ? INF(22, l, 512 * DM) : INF(23, l, 512 * DM));
            tr_item(W, DM, nb * 32, 32, kb * 64, (bf16_t*)(ws + WS_WBR), YP, nb * 32, br * 512, scr, lane); continue; } r -= 768;
        if (r < 512) { const int kb = r / 32, nb = r % 32;
            tr_item(INF(24, l, DM * DM), DM, nb * 32, 32, kb * 64, (bf16_t*)(ws + WS_WOUT), DM, nb * 32, 0, scr, lane); continue; } r -= 512;
        if (r < 2816) { const int kb = r / 176, nb = r % 176, tile = nb >> 3, w = nb & 7, src = (w >> 2) * FF + tile * 128 + (w & 3) * 32;
            tr_item(INF(27, l, DM * 2 * FF), 2 * FF, src, 32, kb * 64, (bf16_t*)(ws + WS_W2IN), DM, nb * 32, 0, scr, lane); continue; } r -= 2816;
        if (r < 1408) { const int kb = r / 32, nb = r % 32;
            tr_item(INF(28, l, FF * DM), DM, nb * 32, 32, kb * 64, (bf16_t*)(ws + WS_W2OUT), FF, nb * 32, 0, scr, lane); continue; } r -= 1408;
        if (r < 256) { const int kb = r / 8, nb = r % 8;
            tr_item(INF(14, l, 2048 * 256), 256, nb * 32, 32, kb * 64, (bf16_t*)(ws + WS_WC1), 2048, nb * 32, 0, scr, lane); continue; } r -= 256;
        if (r < 256) { const int kb = r / 8, nb = r % 8;
            tr_item(INF(17, l, 2048 * 256), 256, nb * 32, 32, kb * 64, (bf16_t*)(ws + WS_WC1 + MiB), 2048, nb * 32, 0, scr, lane); continue; } r -= 256;
        { const int kb = r / 32, nb = r % 32;
            tr_item(INF(20, l, DM * DM), DM, nb * 32, 32, kb * 64, (bf16_t*)(ws + WS_WMKV), DM, nb * 32, 0, scr, lane); }
    }
    {
        const float* gm = INF(9, l, DM);
        for (int m = C.gw; m < 512; m += C.NGW) {
            const f32x4* xr = (const f32x4*)((const float*)C.a->in[1] + (size_t)m * DM) + lane;
            f32x4 v[4]; float s = 0.f;
#pragma unroll
            for (int j = 0; j < 4; ++j) { v[j] = xr[64 * j]; s += (v[j].x * v[j].x + v[j].y * v[j].y) + (v[j].z * v[j].z + v[j].w * v[j].w); }
            const float rstd = rsqrtf(wave_sum(s) * (1.f / DM) + EPS);
            u32x2* o = (u32x2*)((bf16_t*)(ws + WS_MEMN) + (size_t)m * DM) + lane;
#pragma unroll
            for (int j = 0; j < 4; ++j) { const f32x4 gg = ((const f32x4*)gm)[lane + 64 * j]; u32x2 w; w.x = cvt_pk_bf16(v[j].x * rstd * gg.x, v[j].y * rstd * gg.y); w.y = cvt_pk_bf16(v[j].z * rstd * gg.z, v[j].w * rstd * gg.w); o[64 * j] = w; }
        }
    }
    {
        float* cb = (float*)(ws + WS_CBP) + (size_t)l * 64 * 256;
        for (int it = C.gw; it < 64; it += C.NGW) {
            const int kv = it >> 5, ch = it & 31;
            const float* pos = kv ? INF(13, l, 2048) : INF(12, l, 2048);
            const float* w1 = kv ? INF(17, l, 2048 * 256) : INF(14, l, 2048 * 256);
            float p[4] = {0.f, 0.f, 0.f, 0.f};
            for (int k = ch * 64; k < ch * 64 + 64; ++k) { const float pv = pos[k];
#pragma unroll
                for (int q = 0; q < 4; ++q) p[q] += pv * w1[(size_t)k * 256 + lane + 64 * q]; }
#pragma unroll
            for (int q = 0; q < 4; ++q) cb[(size_t)it * 256 + lane + 64 * q] = p[q];
        }
    }
}

__device__ __forceinline__ void rope_table(const Ctx& C) {
    const int* pos = (const int*)C.a->in[2];
    float* tab = (float*)(C.ws + WS_ROPE);
    const float invf[8] = {1.0f, 0.1939227432012558f, 0.03760603070259094f, 0.007292664609849453f, 0.0014142135623842478f, 0.00027424818836152554f, 5.318296098266728e-05f, 1.0313386155758053e-05f};
    for (int e = C.gw * 64 + C.lane; e < T_ * 8; e += C.NGW * 64) {
        const int tok = e >> 3, i = e & 7;
        float f = invf[0];
#pragma unroll
        for (int q = 1; q < 8; ++q) f = (i == q) ? invf[q] : f;
        const float ang = (float)pos[tok] * f;
        const double rev = (double)ang * 0.15915494309189535; const float fr = (float)(rev - floor(rev));
        tab[(size_t)tok * 16 + i] = __builtin_amdgcn_cosf(fr); tab[(size_t)tok * 16 + 8 + i] = __builtin_amdgcn_sinf(fr);
    }
}
__device__ __forceinline__ void prenorm_rows(const Ctx& C, const float* x, const float* g, bf16_t* h) {
    for (int m = C.gw; m < T_; m += C.NGW) {
        const f32x4* xr = (const f32x4*)(x + (size_t)m * DM) + C.lane;
        f32x4 v[4]; float s = 0.f;
#pragma unroll
        for (int j = 0; j < 4; ++j) { v[j] = xr[64 * j]; s += (v[j].x * v[j].x + v[j].y * v[j].y) + (v[j].z * v[j].z + v[j].w * v[j].w); }
        const float rstd = rsqrtf(wave_sum(s) * (1.f / DM) + EPS);
        u32x2* o = (u32x2*)(h + (size_t)m * DM) + C.lane;
#pragma unroll
        for (int j = 0; j < 4; ++j) { const f32x4 gg = ((const f32x4*)g)[C.lane + 64 * j]; u32x2 w; w.x = cvt_pk_bf16(v[j].x * rstd * gg.x, v[j].y * rstd * gg.y); w.y = cvt_pk_bf16(v[j].z * rstd * gg.z, v[j].w * rstd * gg.w); o[64 * j] = w; }
    }
}
__device__ __forceinline__ void norm_phase(const Ctx& C, int w0, int nw, const float* xin, float* xout, const bf16_t* y, bf16_t* h, const float* gpost, const float* gpre, float coef) {
    for (int m0 = w0; m0 < T_; m0 += 2 * nw) {
        f32x4 xv[2][4]; u32x2 yw[2][4];
#pragma unroll
        for (int r = 0; r < 2; ++r) { const int m = (m0 + r * nw < T_) ? m0 + r * nw : m0; const f32x4* xr = (const f32x4*)(xin + (size_t)m * DM) + C.lane; const u32x2* yr = (const u32x2*)(y + (size_t)m * DM) + C.lane;
#pragma unroll
            for (int j = 0; j < 4; ++j) { xv[r][j] = xr[64 * j]; yw[r][j] = yr[64 * j]; } }
#pragma unroll
        for (int r = 0; r < 2; ++r) {
            const int m = m0 + r * nw; if (m >= T_) break;
            f32x4 yv[4]; float s = 0.f;
#pragma unroll
            for (int j = 0; j < 4; ++j) { const u32x2 w = yw[r][j]; yv[j] = (f32x4){bf_lo(w.x), bf_hi(w.x), bf_lo(w.y), bf_hi(w.y)};
                s += (yv[j].x * yv[j].x + yv[j].y * yv[j].y) + (yv[j].z * yv[j].z + yv[j].w * yv[j].w); }
            const float rs = rsqrtf(wave_sum(s) * (1.f / DM) + EPS) * coef; float s2 = 0.f;
            f32x4* xo = (f32x4*)(xout + (size_t)m * DM) + C.lane;
#pragma unroll
            for (int j = 0; j < 4; ++j) { const f32x4 gg = ((const f32x4*)gpost)[C.lane + 64 * j]; xv[r][j] = xv[r][j] + yv[j] * gg * rs; xo[64 * j] = xv[r][j];
                s2 += (xv[r][j].x * xv[r][j].x + xv[r][j].y * xv[r][j].y) + (xv[r][j].z * xv[r][j].z + xv[r][j].w * xv[r][j].w); }
            if (gpre) {
                const float r2 = rsqrtf(wave_sum(s2) * (1.f / DM) + EPS);
                u32x2* o = (u32x2*)(h + (size_t)m * DM) + C.lane;
#pragma unroll
                for (int j = 0; j < 4; ++j) { const f32x4 gg = ((const f32x4*)gpre)[C.lane + 64 * j]; u32x2 w; w.x = cvt_pk_bf16(xv[r][j].x * r2 * gg.x, xv[r][j].y * r2 * gg.y); w.y = cvt_pk_bf16(xv[r][j].z * r2 * gg.z, xv[r][j].w * r2 * gg.w); o[64 * j] = w; }
            }
        }
    }
}
__device__ __forceinline__ void cb_reduce(const Ctx& C, int l) {
    const int e = C.gw * 64 + C.lane;
    if (e < 512) { const int kv = e >> 8, n = e & 255; const float* pp = (const float*)(C.ws + WS_CBP) + (size_t)l * 64 * 256 + (size_t)kv * 32 * 256 + n;
        float s = (kv ? INF(18, l, 256) : INF(15, l, 256))[n];
        for (int ch = 0; ch < 32; ++ch) s += pp[ch * 256];
        ((float*)(C.ws + WS_CB))[l * 512 + e] = s; }
}
__device__ __forceinline__ void memkv_ops(const Ctx& C, int w0, int nw) {
    const bf16_t* src = (const bf16_t*)(C.ws + WS_MKV); bf16_t* ko = (bf16_t*)(C.ws + WS_MEMK); bf16_t* vo = (bf16_t*)(C.ws + WS_MEMV);
    for (int e = w0 * 64 + C.lane; e < 512 * 1024; e += nw * 64) {
        const int mr = e >> 10, col = e & 1023, kv = col >> 9, hm = (col >> 7) & 3, d = col & 127, b = mr >> 8, m = mr & 255;
        const bf16_t v = src[e];
        if (kv == 0) ko[((size_t)((((b * 4 + hm) * 8 + (m >> 5)) * 8 + (d >> 4)) * 64 + pi32(m & 31) + 32 * ((d >> 3) & 1))) * 8 + (d & 7)] = v;
        else vo[((size_t)((((b * 4 + hm) * 16 + (m >> 4)) * 4 + (d >> 5)) * 64 + (d & 31) + 32 * ((m >> 3) & 1))) * 8 + (m & 7)] = v;
    }
}

__device__ __forceinline__ void prep_items(const Ctx& C, int l, int w0, int nw) {
    const bf16_t* P = (const bf16_t*)(C.ws + WS_R1); bf16_t* Y = (bf16_t*)(C.ws + WS_Y);
    const int lane = C.lane;
    {
        const float* cw = INF(11, l, 3 * 512);
        float w[3][8];
#pragma unroll
        for (int k = 0; k < 3; ++k)
#pragma unroll
            for (int e = 0; e < 8; ++e) w[k][e] = cw[k * 512 + lane * 8 + e];
        for (int it = w0; it < T_ / 8; it += nw) {
            const int tok0 = it * 8, s0 = tok0 & (S_ - 1);
            float c1[8], c2[8];
#pragma unroll
            for (int e = 0; e < 8; ++e) { c1[e] = 0.f; c2[e] = 0.f; }
            if (s0 > 0) {
#pragma unroll
                for (int back = 2; back >= 1; --back) {
                    const bf16_t* row = P + (size_t)(tok0 - back) * PP + lane * 8;
                    const u32x4 u = *(const u32x4*)row, cc = *(const u32x4*)(row + 1024);
                    float t[8] = {bf_lo(u.x) * bf_lo(cc.x), bf_hi(u.x) * bf_hi(cc.x), bf_lo(u.y) * bf_lo(cc.y), bf_hi(u.y) * bf_hi(cc.y), bf_lo(u.z) * bf_lo(cc.z), bf_hi(u.z) * bf_hi(cc.z), bf_lo(u.w) * bf_lo(cc.w), bf_hi(u.w) * bf_hi(cc.w)};
#pragma unroll
                    for (int e = 0; e < 8; ++e) { if (back == 2) c2[e] = t[e]; else c1[e] = t[e]; }
                }
            }
#pragma unroll
            for (int tt = 0; tt < 8; ++tt) {
                const bf16_t* row = P + (size_t)(tok0 + tt) * PP + lane * 8;
                const u32x4 u = *(const u32x4*)row, bb = *(const u32x4*)(row + 512), cc = *(const u32x4*)(row + 1024);
                const float c0[8] = {bf_lo(u.x) * bf_lo(cc.x), bf_hi(u.x) * bf_hi(cc.x), bf_lo(u.y) * bf_lo(cc.y), bf_hi(u.y) * bf_hi(cc.y), bf_lo(u.z) * bf_lo(cc.z), bf_hi(u.z) * bf_hi(cc.z), bf_lo(u.w) * bf_lo(cc.w), bf_hi(u.w) * bf_hi(cc.w)};
                const float bv[8] = {bf_lo(bb.x), bf_hi(bb.x), bf_lo(bb.y), bf_hi(bb.y), bf_lo(bb.z), bf_hi(bb.z), bf_lo(bb.w), bf_hi(bb.w)};
                float o[8];
#pragma unroll
                for (int e = 0; e < 8; ++e) { o[e] = bv[e] * (w[0][e] * c2[e] + w[1][e] * c1[e] + w[2][e] * c0[e]); c2[e] = c1[e]; c1[e] = c0[e]; }
                u32x4 ov; ov.x = cvt_pk_bf16(o[0], o[1]); ov.y = cvt_pk_bf16(o[2], o[3]); ov.z = cvt_pk_bf16(o[4], o[5]); ov.w = cvt_pk_bf16(o[6], o[7]);
                *(u32x4*)(Y + (size_t)(tok0 + tt) * YP + lane * 8) = ov;
            }
        }
    }
    {
        const float* rope = (const float*)(C.ws + WS_ROPE);
        LAS bf16_t* vt = (LAS bf16_t*)(C.lds + C.wave * 4608);
        const int hi = lane >> 5, dl = lane & 31;
        for (int it = w0; it < 4 * 512; it += nw) {
            const int bg = it >> 9, tile = it & 511, b = bg >> 1, g = bg & 1;
            const size_t tokb = (size_t)b * S_ + 32 * tile;
#pragma unroll
            for (int which = 0; which < 2; ++which) {
                const int kc = PC_KV + (2 + 2 * which) * 128 + g * 64, vc = kc + 128;
                bf16_t* kop = (bf16_t*)(C.ws + (which ? WS_KWIN : WS_KSLC)); bf16_t* vop = (bf16_t*)(C.ws + (which ? WS_VWIN : WS_VSLC));
#pragma unroll
                for (int q = 0; q < 4; ++q) {
                    const int r = (lane >> 3) + 8 * q, c = lane & 7;
                    const bf16_t* row = P + (tokb + r) * PP;
                    u32x4 kv = *(const u32x4*)(row + kc + 8 * c);
                    if (c < 2) {
                        const u32x4 pv = *(const u32x4*)(row + kc + 8 * (c ^ 1));
                        const float* rt = rope + (tokb + r) * 16;
                        const f32x4 ca = *(const f32x4*)rt, cb2 = *(const f32x4*)(rt + 4), sa = *(const f32x4*)(rt + 8), sb = *(const f32x4*)(rt + 12);
                        const float cs[8] = {ca.x, ca.y, ca.z, ca.w, cb2.x, cb2.y, cb2.z, cb2.w}, sn[8] = {sa.x, sa.y, sa.z, sa.w, sb.x, sb.y, sb.z, sb.w};
                        const float mv[8] = {bf_lo(kv.x), bf_hi(kv.x), bf_lo(kv.y), bf_hi(kv.y), bf_lo(kv.z), bf_hi(kv.z), bf_lo(kv.w), bf_hi(kv.w)};
                        const float pp[8] = {bf_lo(pv.x), bf_hi(pv.x), bf_lo(pv.y), bf_hi(pv.y), bf_lo(pv.z), bf_hi(pv.z), bf_lo(pv.w), bf_hi(pv.w)};
                        const float sg = (c == 0) ? -1.f : 1.f; float o[8];
#pragma unroll
                        for (int e = 0; e < 8; ++e) o[e] = mv[e] * cs[e] + sg * pp[e] * sn[e];
                        kv.x = cvt_pk_bf16(o[0], o[1]); kv.y = cvt_pk_bf16(o[2], o[3]); kv.z = cvt_pk_bf16(o[4], o[5]); kv.w = cvt_pk_bf16(o[6], o[7]);
                    }
                    if (which == 0)
                        *(u32x4*)(kop + ((size_t)(((bg * 512 + tile) * 2 + ((r >> 2) & 1)) * 2 + (c >> 2)) * 64 + ((r >> 3) * 4 + (r & 3)) + 16 * (c & 3)) * 8) = kv;
                    else
                        *(u32x4*)(kop + ((size_t)((bg * 512 + tile) * 4 + (c >> 1)) * 64 + pi32(r) + 32 * (c & 1)) * 8) = kv;
                    const u32x4 vv = *(const u32x4*)(row + vc + 8 * c);
                    *(LAS u32x4*)(vt + r * 72 + 8 * c) = vv;
                }
                LDS_WAIT();
#pragma unroll
                for (int o4 = 0; o4 < 4; ++o4) {
                    if (which == 0) {
                        const LAS bf16_t* sp = vt + (8 * (lane >> 4)) * 72 + 16 * o4 + (lane & 15);
                        u32x4 o; o.x = (unsigned)sp[0] | ((unsigned)sp[72] << 16); o.y = (unsigned)sp[144] | ((unsigned)sp[216] << 16); o.z = (unsigned)sp[288] | ((unsigned)sp[360] << 16); o.w = (unsigned)sp[432] | ((unsigned)sp[504] << 16);
                        *(u32x4*)(vop + ((size_t)((bg * 512 + tile) * 4 + o4) * 64 + lane) * 8) = o;
                        continue;
                    }
                    const int ks = o4 >> 1, dt = o4 & 1;
                    const LAS bf16_t* sp = vt + (16 * ks + 8 * hi) * 72 + 32 * dt + dl;
                    u32x4 o; o.x = (unsigned)sp[0] | ((unsigned)sp[72] << 16); o.y = (unsigned)sp[144] | ((unsigned)sp[216] << 16); o.z = (unsigned)sp[288] | ((unsigned)sp[360] << 16); o.w = (unsigned)sp[432] | ((unsigned)sp[504] << 16);
                    *(u32x4*)(vop + ((size_t)((bg * 1024 + 2 * tile + ks) * 2 + dt) * 64 + lane) * 8) = o;
                }
                LDS_WAIT();
            }
        }
    }
}

__device__ __forceinline__ void cmp_stage2(const Ctx& C, int l) {
    const int bxx = C.gw / NWAVES, kv = bxx & 1, wi = bxx >> 1, nwg2 = (C.G + 1 - kv) >> 1;
    const float* w2 = kv ? INF(19, l, 256 * 64) : INF(16, l, 256 * 64);
    LAS float* ws2 = (LAS float*)C.lds;
    for (int e = C.tid; e < 256 * 64 / 4; e += NWAVES * 64) ((LAS f32x4*)ws2)[e] = ((const f32x4*)w2)[e];
    __syncthreads();
    const bf16_t* hid = (const bf16_t*)(C.ws + WS_CMPP) + (size_t)kv * 4096 * 256;
    const float* cbias = (const float*)(C.ws + WS_CB) + l * 512 + kv * 256;
    bf16_t* ko = (bf16_t*)(C.ws + WS_KCMP); bf16_t* vo = (bf16_t*)(C.ws + WS_VCMP);
    const int d = C.lane;
    for (int row = wi * NWAVES + C.wave; row < 4096; row += nwg2 * NWAVES) {
        asm volatile("" ::: "memory");
        const u32x2 hv = *((const u32x2*)(hid + (size_t)row * 256) + C.lane), hw = *((const u32x2*)(hid + (size_t)(row + 8192) * 256) + C.lane);
        const f32x4 cbv = *((const f32x4*)cbias + C.lane);
        const float h0 = gelu_tanh(bf_lo(hv.x) + bf_lo(hw.x) + cbv.x), h1 = gelu_tanh(bf_hi(hv.x) + bf_hi(hw.x) + cbv.y), h2 = gelu_tanh(bf_lo(hv.y) + bf_lo(hw.y) + cbv.z), h3 = gelu_tanh(bf_hi(hv.y) + bf_hi(hw.y) + cbv.w);
        float acc = 0.f;
#pragma unroll 4
        for (int k = 0; k < 64; ++k) {
            const float a0 = __int_as_float(__builtin_amdgcn_readlane(__float_as_int(h0), k)), a1 = __int_as_float(__builtin_amdgcn_readlane(__float_as_int(h1), k));
            const float a2 = __int_as_float(__builtin_amdgcn_readlane(__float_as_int(h2), k)), a3 = __int_as_float(__builtin_amdgcn_readlane(__float_as_int(h3), k));
            acc += a0 * ws2[(4 * k + 0) * 64 + d]; acc += a1 * ws2[(4 * k + 1) * 64 + d]; acc += a2 * ws2[(4 * k + 2) * 64 + d]; acc += a3 * ws2[(4 * k + 3) * 64 + d];
        }
        const int bg = row >> 10, n = row & 1023;
        if (n == 1023) acc = 0.f;
        const bf16_t o = (bf16_t)(cvt_pk_bf16(acc, 0.f) & 0xffffu);
        if (kv == 0) ko[((size_t)((bg * 32 + (n >> 5)) * 4 + (d >> 4)) * 64 + pi32(n & 31) + 32 * ((d >> 3) & 1)) * 8 + (d & 7)] = o;
        else vo[((size_t)((bg * 64 + (n >> 4)) * 2 + (d >> 5)) * 64 + (d & 31) + 32 * ((n >> 3) & 1)) * 8 + (n & 7)] = o;
    }
    __syncthreads();
}

__device__ __forceinline__ float xhalf_max(float v) { const auto r = __builtin_amdgcn_permlane32_swap(__float_as_uint(v), __float_as_uint(v), false, false); return fmaxf(__uint_as_float(r[0]), __uint_as_float(r[1])); }
__device__ __forceinline__ float xhalf_sum(float v) { const auto r = __builtin_amdgcn_permlane32_swap(__float_as_uint(v), __float_as_uint(v), false, false); return __uint_as_float(r[0]) + __uint_as_float(r[1]); }
__device__ __forceinline__ f32x16 mfma32(bf16x8 a, bf16x8 b, f32x16 c) { return __builtin_amdgcn_mfma_f32_32x32x16_bf16(a, b, c, 0, 0, 0); }
__device__ __forceinline__ float dpp_xor1(float v) { return __int_as_float(__builtin_amdgcn_update_dpp(0, __float_as_int(v), 0xB1, 0xF, 0xF, true)); }
__device__ __forceinline__ float dpp_xor2(float v) { return __int_as_float(__builtin_amdgcn_update_dpp(0, __float_as_int(v), 0x4E, 0xF, 0xF, true)); }
__device__ __forceinline__ bf16x8 pack_p(const float* p) { u32x4 w; w.x = cvt_pk_bf16(p[0], p[1]); w.y = cvt_pk_bf16(p[2], p[3]); w.z = cvt_pk_bf16(p[4], p[5]); w.w = cvt_pk_bf16(p[6], p[7]); return __builtin_bit_cast(bf16x8, w); }
__device__ __forceinline__ bf16x8 scale_q(u32x4 v, float s) { u32x4 w; w.x = cvt_pk_bf16(bf_lo(v.x) * s, bf_hi(v.x) * s); w.y = cvt_pk_bf16(bf_lo(v.y) * s, bf_hi(v.y) * s); w.z = cvt_pk_bf16(bf_lo(v.z) * s, bf_hi(v.z) * s); w.w = cvt_pk_bf16(bf_lo(v.w) * s, bf_hi(v.w) * s); return __builtin_bit_cast(bf16x8, w); }
#define KREL(i, hi) (8 * (hi) + (i) + (((i) >= 8) ? 8 : 0))

__device__ __forceinline__ void flash_load(const bf16x8* kp, const bf16x8* vp, bf16x8 (&kf)[4], bf16x8 (&vf)[4]) {
#pragma unroll
    for (int s = 0; s < 4; ++s) kf[s] = kp[s * 64];
#pragma unroll
    for (int s = 0; s < 4; ++s) vf[s] = vp[s * 64];
    __builtin_amdgcn_sched_barrier(0);
}
__device__ __forceinline__ void flash_compute(bool domask, const bf16x8 (&kf)[4], const bf16x8 (&vf)[4], const bf16x8 (&q)[4], int x0, unsigned span, float& m, float& l, f32x16 (&O)[2]) {
    f32x16 sc;
#pragma unroll
    for (int i = 0; i < 16; ++i) sc[i] = 0.f;
#pragma unroll
    for (int s = 0; s < 4; ++s) sc = mfma32(kf[s], q[s], sc);
    if (domask) {
#pragma unroll
        for (int i = 0; i < 16; ++i) sc[i] = ((unsigned)(x0 + i + (i >= 8 ? 8 : 0)) <= span) ? sc[i] : -1e30f;
    }
    const float a0 = fmaxf(fmaxf(sc[0], sc[1]), sc[2]), a1 = fmaxf(fmaxf(sc[3], sc[4]), sc[5]), a2 = fmaxf(fmaxf(sc[6], sc[7]), sc[8]), a3 = fmaxf(fmaxf(sc[9], sc[10]), sc[11]), a4 = fmaxf(fmaxf(sc[12], sc[13]), sc[14]);
    float mx = fmaxf(fmaxf(fmaxf(a0, a1), fmaxf(a2, a3)), fmaxf(a4, sc[15]));
    mx = xhalf_max(mx);
    const float mn = fmaxf(m, mx);
    if (__ballot(mn > m) != 0ull) {
        const float alpha = ex2(m - mn); l *= alpha; O[0] = O[0] * alpha; O[1] = O[1] * alpha;
    }
    m = mn;
    const float msub = (mn < -1e29f) ? 0.f : mn;
    const f32x16 d = sc - msub;
    float p[16], ps = 0.f;
#pragma unroll
    for (int i = 0; i < 16; ++i) { p[i] = ex2(d[i]); ps += p[i]; }
    l += ps;
    const bf16x8 pb0 = pack_p(p), pb1 = pack_p(p + 8);
    O[0] = mfma32(vf[0], pb0, O[0]); O[1] = mfma32(vf[1], pb0, O[1]);
    O[0] = mfma32(vf[2], pb1, O[0]); O[1] = mfma32(vf[3], pb1, O[1]);
}
template <int MODE> __device__ __forceinline__ void flash_desc(int s, const LAS unsigned* list, int base, int t, int t0, int qi, int hi, int& tile, int& x0, unsigned& span, int& vm) {
    if constexpr (MODE == 0) {
        const unsigned e = (unsigned)__builtin_amdgcn_readfirstlane((int)list[s >> 1]);
        tile = 2 * (int)(e & 0xffffu) + (s & 1);
        const bool my = ((e >> 16) >> qi) & 1u; const int up = my ? (t - 32 * tile) : -1;
        x0 = up < 0 ? 64 : 8 * hi; span = up < 0 ? 0u : (unsigned)up;
        vm = (32 * tile + 31 <= t0) ? (((e >> 16) == 0xFFu) ? 0 : 1) : 2;
    } else {
        tile = base + s; x0 = 8 * hi - (t - 511 - 32 * tile); span = 511u;
        vm = (32 * tile + 31 <= t0 && 32 * tile >= t0 + 7 - 511) ? 0 : 2;
    }
}
template <int MODE> __device__ __forceinline__ void flash_run(const bf16x8* kb, const bf16x8* vb, const bf16x8 (&q)[4], int nsteps, const LAS unsigned* list, int base, int t, int t0, int qi, int hi, float& m, float& l, f32x16 (&O)[2]) {
    if (nsteps <= 0) return;
    bf16x8 kA[4], vA[4], kB[4], vB[4], kC[4], vC[4]; int x0A, x0B, x0C, vmA, vmB, vmC; unsigned spA, spB, spC;
#define FR_LOAD(S, KF, VF, X0, SP, VM) do { int tile_; const int sn_ = ((S) < nsteps) ? (S) : nsteps - 1; flash_desc<MODE>(sn_, list, base, t, t0, qi, hi, tile_, X0, SP, VM); \
        flash_load(kb + (size_t)tile_ * 256, vb + (size_t)tile_ * 256, KF, VF); } while (0)
    FR_LOAD(0, kA, vA, x0A, spA, vmA); FR_LOAD(1, kB, vB, x0B, spB, vmB);
#pragma unroll 1
    for (int s = 0; s < nsteps; s += 3) {
        FR_LOAD(s + 2, kC, vC, x0C, spC, vmC); flash_compute(vmA != 0, kA, vA, q, x0A, spA, m, l, O); if (s + 1 >= nsteps) break;
        FR_LOAD(s + 3, kA, vA, x0A, spA, vmA); flash_compute(vmB != 0, kB, vB, q, x0B, spB, m, l, O); if (s + 2 >= nsteps) break;
        FR_LOAD(s + 4, kB, vB, x0B, spB, vmB); flash_compute(vmC != 0, kC, vC, q, x0C, spC, m, l, O);
    }
#undef FR_LOAD
}

typedef float f32x4v __attribute__((ext_vector_type(4)));
__device__ __forceinline__ f32x4v mfma16(bf16x8 a, bf16x8 b, f32x4v c) { return __builtin_amdgcn_mfma_f32_16x16x32_bf16(a, b, c, 0, 0, 0); }
__device__ __forceinline__ float xq_max(float v) { const auto r = __builtin_amdgcn_permlane16_swap(__float_as_uint(v), __float_as_uint(v), false, false); return xhalf_max(fmaxf(__uint_as_float(r[0]), __uint_as_float(r[1]))); }
__device__ __forceinline__ float xq_sum(float v) { const auto r = __builtin_amdgcn_permlane16_swap(__float_as_uint(v), __float_as_uint(v), false, false); return xhalf_sum(__uint_as_float(r[0]) + __uint_as_float(r[1])); }
__device__ __forceinline__ void flash16_load(const bf16x8* kp, const bf16x8* vp, bf16x8 (&kf)[4], bf16x8 (&vf)[4]) {
#pragma unroll
    for (int s = 0; s < 4; ++s) kf[s] = kp[s * 64];
#pragma unroll
    for (int s = 0; s < 4; ++s) vf[s] = vp[s * 64];
    __builtin_amdgcn_sched_barrier(0);
}
__device__ __forceinline__ void flash16_compute(bool domask, const bf16x8 (&kf)[4], const bf16x8 (&vf)[4], const bf16x8 (&q)[2], int x0, unsigned span, float& m, float& l, f32x4v (&O)[4]) {
    f32x4v s0 = {0.f, 0.f, 0.f, 0.f}, s1 = {0.f, 0.f, 0.f, 0.f};
    s0 = mfma16(kf[0], q[0], s0); s1 = mfma16(kf[2], q[0], s1);
    s0 = mfma16(kf[1], q[1], s0); s1 = mfma16(kf[3], q[1], s1);
    float sc[8] = {s0[0], s0[1], s0[2], s0[3], s1[0], s1[1], s1[2], s1[3]};
    if (domask) {
#pragma unroll
        for (int j = 0; j < 8; ++j) sc[j] = ((unsigned)(x0 + j) <= span) ? sc[j] : -1e30f;
    }
    float mx = fmaxf(fmaxf(fmaxf(sc[0], sc[1]), fmaxf(sc[2], sc[3])), fmaxf(fmaxf(sc[4], sc[5]), fmaxf(sc[6], sc[7])));
    mx = xq_max(mx);
    const float mn = fmaxf(m, mx);
    if (__ballot(mn > m) != 0ull) {
        const float alpha = ex2(m - mn); l *= alpha;
#pragma unroll
        for (int dt = 0; dt < 4; ++dt) O[dt] = O[dt] * alpha;
    }
    m = mn;
    const float msub = (mn < -1e29f) ? 0.f : mn;
    float p[8], ps = 0.f;
#pragma unroll
    for (int j = 0; j < 8; ++j) { p[j] = ex2(sc[j] - msub); ps += p[j]; }
    l += ps;
    const bf16x8 pb = pack_p(p);
#pragma unroll
    for (int dt = 0; dt < 4; ++dt) O[dt] = mfma16(vf[dt], pb, O[dt]);
}
__device__ __forceinline__ unsigned flash16_entry(int s, const LAS unsigned* list) {
    const unsigned e = (unsigned)__builtin_amdgcn_readfirstlane((int)list[s >> 1]);
    return (e & 0xffff0000u) | (2u * (e & 0xffffu) + (unsigned)(s & 1));
}
__device__ __forceinline__ void flash16_run(const bf16x8* kb, const bf16x8* vb, const bf16x8 (&qa)[2], const bf16x8 (&qb)[2], int nsteps, const LAS unsigned* list, int tq, int t0, int qi4, int fq,
                                            float& ma, float& la, f32x4v (&Oa)[4], float& mb, float& lb, f32x4v (&Ob)[4]) {
    if (nsteps <= 0) return;
    bf16x8 kA[4], vA[4], kB[4], vB[4], kC[4], vC[4]; unsigned eA, eB, eC;
#define F16_LOAD(S, KF, VF, E) do { const int sn_ = ((S) < nsteps) ? (S) : nsteps - 1; E = flash16_entry(sn_, list); const size_t go_ = (size_t)(E & 0xffffu) * 256; \
        flash16_load(kb + go_, vb + go_, KF, VF); } while (0)
#define F16_COMP(KF, VF, E) do { const int grp_ = (int)(E & 0xffffu); const unsigned na_ = (E >> 16) & 0xFu, nb_ = E >> 20; const bool past_ = 32 * grp_ + 31 <= t0; \
        if (na_) { const int up_ = ((na_ >> qi4) & 1u) ? (tq - 32 * grp_) : -1; flash16_compute(!(past_ && na_ == 0xFu), KF, VF, qa, up_ < 0 ? 64 : 8 * fq, up_ < 0 ? 0u : (unsigned)up_, ma, la, Oa); } \
        if (nb_) { const int up_ = ((nb_ >> qi4) & 1u) ? (tq + 4 - 32 * grp_) : -1; flash16_compute(!(past_ && nb_ == 0xFu), KF, VF, qb, up_ < 0 ? 64 : 8 * fq, up_ < 0 ? 0u : (unsigned)up_, mb, lb, Ob); } } while (0)
    F16_LOAD(0, kA, vA, eA); F16_LOAD(1, kB, vB, eB);
#pragma unroll 1
    for (int s = 0; s < nsteps; s += 3) {
        F16_LOAD(s + 2, kC, vC, eC); F16_COMP(kA, vA, eA); if (s + 1 >= nsteps) break;
        F16_LOAD(s + 3, kA, vA, eA); F16_COMP(kB, vB, eB); if (s + 2 >= nsteps) break;
        F16_LOAD(s + 4, kB, vB, eB); F16_COMP(kC, vC, eC);
    }
#undef F16_LOAD
#undef F16_COMP
}

__device__ __forceinline__ unsigned wave_max_u32(unsigned v) {
#pragma unroll
    for (int o = 1; o < 16; o <<= 1) { const unsigned t = (unsigned)__shfl_xor((int)v, o); v = v > t ? v : t; }
    { const auto r = __builtin_amdgcn_permlane16_swap(v, v, false, false); v = r[0] > r[1] ? r[0] : r[1]; }
    { const auto r = __builtin_amdgcn_permlane32_swap(v, v, false, false); v = r[0] > r[1] ? r[0] : r[1]; }
    return v;
}

__device__ __forceinline__ void nsa_tile(const Ctx& C, int b, int g, int t0) {
    const bf16_t* P = (const bf16_t*)(C.ws + WS_R1); bf16_t* Y = (bf16_t*)(C.ws + WS_Y);
    int lane_ = C.lane; asm volatile("" : "+v"(lane_));
    const int lane = lane_, r = lane & 31, hi = lane >> 5, qi = r >> 2, h = r & 3, head = g * 4 + h, bg = b * 2 + g;
    const int t = t0 + qi; const size_t tok = (size_t)b * S_ + t;
    LAS float* imp = (LAS float*)(C.lds + C.wave * 16640);
    LAS float* ost = (LAS float*)(C.lds + C.wave * 16640 + 8448) + lane;
    const float QS = 0.18033688011112042f;
    bf16x8 qf[4];
    {
        const bf16_t* qp = P + tok * PP + PC_Q + head * 64;
#pragma unroll
        for (int s = 0; s < 4; ++s) qf[s] = scale_q(*(const u32x4*)(qp + 16 * s + 8 * hi), QS);
    }
    const bf16_t* gp = P + tok * PP + PC_NG + head * 3;
    const float gc = sigm(bf1(gp[0])), gs = sigm(bf1(gp[1])), gw = sigm(bf1(gp[2]));

    const int cur = t0 >> 6;
    {
        const int nvq = (t >= 31) ? ((t - 31) >> 4) + 1 : 0;
        const int tl = t0 + 7, nvmax = (tl >= 31) ? ((tl - 31) >> 4) + 1 : 0, ntile = (nvmax + 31) >> 5;
        const bf16x8* kb = (const bf16x8*)(C.ws + WS_KCMP) + (size_t)bg * 32 * 4 * 64 + lane;
        const bf16x8* vb = (const bf16x8*)(C.ws + WS_VCMP) + (size_t)bg * 64 * 2 * 64 + lane;
        float m1 = -1e30f, l1 = 0.f;
#define CMP_P1(KF, KT) do { \
            f32x16 sc; _Pragma("unroll") for (int i = 0; i < 16; ++i) sc[i] = 0.f; \
            _Pragma("unroll") for (int s = 0; s < 4; ++s) sc = mfma32(KF[s], qf[s], sc); \
            const int up = nvq - 1 - 32 * (KT); const int x0 = up < 0 ? 64 : 8 * hi; const unsigned span = up < 0 ? 0u : (unsigned)up; \
            float mx = -1e30f; bool ok[16]; \
            _Pragma("unroll") for (int i = 0; i < 16; ++i) { ok[i] = (unsigned)(x0 + i + (i >= 8 ? 8 : 0)) <= span; sc[i] = ok[i] ? sc[i] : -1e30f; mx = fmaxf(mx, sc[i]); } \
            mx = xhalf_max(mx); \
            const float mn = fmaxf(m1, mx); float ps = 0.f; \
            _Pragma("unroll") for (int i = 0; i < 16; ++i) ps += ok[i] ? ex2(sc[i] - mn) : 0.f; \
            l1 = l1 * ex2(m1 - mn) + ps; m1 = mn; } while (0)
        if (ntile > 0) {
            bf16x8 kA[4], kB[4];
#pragma unroll
            for (int s = 0; s < 4; ++s) kA[s] = kb[s * 64];
#pragma unroll 1
            for (int kt = 0; kt < ntile; kt += 2) {
                { const int kn = (kt + 1 < ntile) ? kt + 1 : ntile - 1;
#pragma unroll
                  for (int s = 0; s < 4; ++s) kB[s] = kb[kn * 256 + s * 64]; }
                __builtin_amdgcn_sched_barrier(0);
                CMP_P1(kA, kt);
                if (kt + 1 >= ntile) break;
                { const int kn = (kt + 2 < ntile) ? kt + 2 : ntile - 1;
#pragma unroll
                  for (int s = 0; s < 4; ++s) kA[s] = kb[kn * 256 + s * 64]; }
                __builtin_amdgcn_sched_barrier(0);
                CMP_P1(kB, kt + 1);
            }
        }
#undef CMP_P1
        l1 = xhalf_sum(l1);
        const float inv = 1.f / fmaxf(l1, 1e-30f);
        for (int e = lane; e < 8 * 264; e += 64) imp[e] = 0.f;
        LDS_WAIT();
        f32x16 O[2];
#pragma unroll
        for (int i = 0; i < 16; ++i) { O[0][i] = 0.f; O[1][i] = 0.f; }
#define CMP_P2(KF, VF, KT) do { \
            f32x16 sc; _Pragma("unroll") for (int i = 0; i < 16; ++i) sc[i] = 0.f; \
            _Pragma("unroll") for (int s = 0; s < 4; ++s) sc = mfma32(KF[s], qf[s], sc); \
            const int up = nvq - 1 - 32 * (KT); const int x0 = up < 0 ? 64 : 8 * hi; const unsigned span = up < 0 ? 0u : (unsigned)up; \
            float p[16]; \
            _Pragma("unroll") for (int i = 0; i < 16; ++i) { const bool ok = (unsigned)(x0 + i + (i >= 8 ? 8 : 0)) <= span; p[i] = ok ? ex2(sc[i] - m1) * inv : 0.f; } \
            _Pragma("unroll") for (int rr = 0; rr < 2; ++rr) { \
                const float* q8 = p + 8 * rr; \
                float a = q8[0] + q8[1] + q8[2] + 0.5f * q8[3], bq = 0.5f * q8[3] + q8[4] + q8[5] + q8[6] + 0.5f * q8[7], cq = 0.5f * q8[7]; \
                a += dpp_xor1(a); a += dpp_xor2(a); bq += dpp_xor1(bq); bq += dpp_xor2(bq); cq += dpp_xor1(cq); cq += dpp_xor2(cq); \
                _Pragma("unroll") for (int hh = 0; hh < 2; ++hh)     \
                if (h == 0 && hi == hh) { LAS float* ip = imp + qi * 264 + 8 * (KT) + 2 * hi + 4 * rr; \
                    __hip_atomic_fetch_add(ip, a, __ATOMIC_RELAXED, __HIP_MEMORY_SCOPE_WORKGROUP); __hip_atomic_fetch_add(ip + 1, bq, __ATOMIC_RELAXED, __HIP_MEMORY_SCOPE_WORKGROUP); \
                    __hip_atomic_fetch_add(ip + 2, cq, __ATOMIC_RELAXED, __HIP_MEMORY_SCOPE_WORKGROUP); } \
            } \
            const bf16x8 pb0 = pack_p(p), pb1 = pack_p(p + 8); \
            O[0] = mfma32(VF[0], pb0, O[0]); O[1] = mfma32(VF[1], pb0, O[1]); \
            O[0] = mfma32(VF[2], pb1, O[0]); O[1] = mfma32(VF[3], pb1, O[1]); } while (0)
        if (ntile > 0) {
            bf16x8 kA[4], kB[4], vA[4];
#pragma unroll
            for (int s = 0; s < 4; ++s) kA[s] = kb[s * 64];
#pragma unroll 1
            for (int kt = 0; kt < ntile; kt += 2) {
                { const int kn = (kt + 1 < ntile) ? kt + 1 : ntile - 1;
#pragma unroll
                  for (int s = 0; s < 4; ++s) kB[s] = kb[kn * 256 + s * 64];
#pragma unroll
                  for (int s = 0; s < 4; ++s) vA[s] = vb[kt * 256 + s * 64]; }
                __builtin_amdgcn_sched_barrier(0);
                CMP_P2(kA, vA, kt);
                if (kt + 1 >= ntile) break;
                { const int kn = (kt + 2 < ntile) ? kt + 2 : ntile - 1;
#pragma unroll
                  for (int s = 0; s < 4; ++s) kA[s] = kb[kn * 256 + s * 64];
#pragma unroll
                  for (int s = 0; s < 4; ++s) vA[s] = vb[(kt + 1) * 256 + s * 64]; }
                __builtin_amdgcn_sched_barrier(0);
                CMP_P2(kB, vA, kt + 1);
            }
        }
#undef CMP_P2
#pragma unroll
        for (int i = 0; i < 16; ++i) { ost[i * 64] = gc * O[0][i]; ost[(16 + i) * 64] = gc * O[1][i]; }
        LDS_WAIT();
    }

    unsigned bmv[4];
    if (cur <= 15) {
#pragma unroll
        for (int c = 0; c < 4; ++c) bmv[c] = (lane + 64 * c <= cur) ? 0xFFu : 0u;
    } else {
        unsigned key[8][4];
#pragma unroll
        for (int q2 = 0; q2 < 8; ++q2)
#pragma unroll
            for (int c = 0; c < 4; ++c) { const int j = lane + 64 * c; const bool cand = (j >= 1) && (j < cur - 1); const float v = imp[q2 * 264 + j];
                key[q2][c] = cand ? ((__float_as_uint(v) & 0xFFFFFF00u) | (unsigned)(255 - j)) : 0u; }
#pragma unroll
        for (int c = 0; c < 4; ++c) bmv[c] = 0u;
#pragma unroll 1
        for (int round = 0; round < 13; ++round) {
#pragma unroll
            for (int q2 = 0; q2 < 8; ++q2) {
                unsigned mx = key[q2][0]; mx = mx > key[q2][1] ? mx : key[q2][1]; mx = mx > key[q2][2] ? mx : key[q2][2]; mx = mx > key[q2][3] ? mx : key[q2][3];
                const unsigned w = wave_max_u32(mx);
#pragma unroll
                for (int c = 0; c < 4; ++c) { const bool win = (key[q2][c] == w) && (w != 0u); key[q2][c] = win ? 0u : key[q2][c]; bmv[c] |= win ? (1u << q2) : 0u; }
            }
        }
#pragma unroll
        for (int c = 0; c < 4; ++c) { const int j = lane + 64 * c; if (j == 0 || j == cur || j == cur - 1) bmv[c] = 0xFFu; }
    }

    {
        LAS unsigned* list = (LAS unsigned*)imp;
        LAS float* ostb = (LAS float*)(C.lds + C.wave * 16640 + 8448);
        const int q16 = lane & 15, fq = lane >> 4, qi4 = q16 >> 2, head4 = g * 4 + (q16 & 3);
        const bf16x8* kb = (const bf16x8*)(C.ws + WS_KSLC) + (size_t)bg * 512 * 256 + lane;
        const bf16x8* vb = (const bf16x8*)(C.ws + WS_VSLC) + (size_t)bg * 512 * 256 + lane;
        int nblk = 0;
#pragma unroll
        for (int c = 0; c < 4; ++c) {
            const unsigned long long mk = __ballot(bmv[c] != 0u);
            const int pos = nblk + (int)__builtin_amdgcn_mbcnt_hi((unsigned)(mk >> 32), __builtin_amdgcn_mbcnt_lo((unsigned)mk, 0u));
            if (bmv[c] != 0u) list[pos] = (unsigned)(lane + 64 * c) | (bmv[c] << 16);
            nblk += __builtin_popcountll(mk);
        }
        LDS_WAIT();
        const int tq = t0 + qi4;
        bf16x8 q16f[2][2]; float gs4[2];
#pragma unroll
        for (int sub = 0; sub < 2; ++sub) {
            const size_t tok4 = (size_t)b * S_ + tq + 4 * sub;
            const bf16_t* qp = P + tok4 * PP + PC_Q + head4 * 64;
            q16f[sub][1] = scale_q(*(const u32x4*)(qp + 32 + 8 * fq), QS);
            const u32x4 mv4 = *(const u32x4*)(qp + 8 * fq), pv4 = *(const u32x4*)(qp + 8 * ((fq ^ 1) & 1));
            const float* rt = (const float*)(C.ws + WS_ROPE) + tok4 * 16;
            const f32x4 ca = *(const f32x4*)rt, cb2 = *(const f32x4*)(rt + 4), sa = *(const f32x4*)(rt + 8), sb = *(const f32x4*)(rt + 12);
            const float cs[8] = {ca.x, ca.y, ca.z, ca.w, cb2.x, cb2.y, cb2.z, cb2.w}, sn[8] = {sa.x, sa.y, sa.z, sa.w, sb.x, sb.y, sb.z, sb.w};
            const float mv[8] = {bf_lo(mv4.x), bf_hi(mv4.x), bf_lo(mv4.y), bf_hi(mv4.y), bf_lo(mv4.z), bf_hi(mv4.z), bf_lo(mv4.w), bf_hi(mv4.w)};
            const float pp[8] = {bf_lo(pv4.x), bf_hi(pv4.x), bf_lo(pv4.y), bf_hi(pv4.y), bf_lo(pv4.z), bf_hi(pv4.z), bf_lo(pv4.w), bf_hi(pv4.w)};
            const bool roped = fq < 2; const float sg = (fq == 0) ? -1.f : 1.f; float o[8];
#pragma unroll
            for (int e = 0; e < 8; ++e) o[e] = (roped ? (mv[e] * cs[e] + sg * pp[e] * sn[e]) : mv[e]) * QS;
            q16f[sub][0] = pack_p(o);
            gs4[sub] = sigm(bf1(P[tok4 * PP + PC_NG + head4 * 3 + 1]));
        }
        float ma = -1e30f, la = 0.f, mb = -1e30f, lb = 0.f; f32x4v Oa[4], Ob[4];
#pragma unroll
        for (int dt = 0; dt < 4; ++dt) { Oa[dt] = (f32x4v){0.f, 0.f, 0.f, 0.f}; Ob[dt] = (f32x4v){0.f, 0.f, 0.f, 0.f}; }
        flash16_run(kb, vb, q16f[0], q16f[1], 2 * nblk, list, tq, t0, qi4, fq, ma, la, Oa, mb, lb, Ob);
        la = xq_sum(la); lb = xq_sum(lb);
        const float sca = gs4[0] / fmaxf(la, 1e-30f), scb = gs4[1] / fmaxf(lb, 1e-30f);
#pragma unroll
        for (int dt = 0; dt < 4; ++dt)
#pragma unroll
            for (int i = 0; i < 4; ++i) { LAS float* op = ostb + ((dt >> 1) * 16 + 4 * (2 * (dt & 1) + (fq >> 1)) + i) * 64 + q16 + 32 * (fq & 1); op[0] += sca * Oa[dt][i]; op[16] += scb * Ob[dt][i]; }
        LDS_WAIT();
    }
    {
        bf16x8 qr[4];
        {
            const bf16_t* qp = P + tok * PP + PC_Q + head * 64;
#pragma unroll
            for (int s = 1; s < 4; ++s) qr[s] = scale_q(*(const u32x4*)(qp + 16 * s + 8 * hi), QS);
            const u32x4 mv4 = *(const u32x4*)(qp + 8 * hi), pv4 = *(const u32x4*)(qp + 8 * (hi ^ 1));
            const float* rt = (const float*)(C.ws + WS_ROPE) + tok * 16;
            const f32x4 ca = *(const f32x4*)rt, cb2 = *(const f32x4*)(rt + 4), sa = *(const f32x4*)(rt + 8), sb = *(const f32x4*)(rt + 12);
            const float cs[8] = {ca.x, ca.y, ca.z, ca.w, cb2.x, cb2.y, cb2.z, cb2.w}, sn[8] = {sa.x, sa.y, sa.z, sa.w, sb.x, sb.y, sb.z, sb.w};
            const float mv[8] = {bf_lo(mv4.x), bf_hi(mv4.x), bf_lo(mv4.y), bf_hi(mv4.y), bf_lo(mv4.z), bf_hi(mv4.z), bf_lo(mv4.w), bf_hi(mv4.w)};
            const float pp[8] = {bf_lo(pv4.x), bf_hi(pv4.x), bf_lo(pv4.y), bf_hi(pv4.y), bf_lo(pv4.z), bf_hi(pv4.z), bf_lo(pv4.w), bf_hi(pv4.w)};
            const float sg = hi ? 1.f : -1.f; float o[8];
#pragma unroll
            for (int e = 0; e < 8; ++e) o[e] = (mv[e] * cs[e] + sg * pp[e] * sn[e]) * QS;
            qr[0] = pack_p(o);
        }
        const bf16x8* kb = (const bf16x8*)(C.ws + WS_KWIN) + (size_t)bg * 512 * 4 * 64 + lane;
        const bf16x8* vb = (const bf16x8*)(C.ws + WS_VWIN) + (size_t)bg * 1024 * 2 * 64 + lane;
        float m = -1e30f, l = 0.f; f32x16 O[2];
#pragma unroll
        for (int i = 0; i < 16; ++i) { O[0][i] = 0.f; O[1][i] = 0.f; }
        const int tlo = (t0 - 511 > 0 ? t0 - 511 : 0) >> 5, thi = (t0 + 7) >> 5;
        flash_run<1>(kb, vb, qr, thi - tlo + 1, (const LAS unsigned*)imp, tlo, t, t0, qi, hi, m, l, O);
        l = xhalf_sum(l);
        const float sc = gw / fmaxf(l, 1e-30f);
        bf16_t* yp = Y + tok * YP + 512 + head * 64 + 4 * hi;
#pragma unroll
        for (int dt = 0; dt < 2; ++dt)
#pragma unroll
            for (int ig = 0; ig < 4; ++ig) { float o4[4];
#pragma unroll
                for (int e = 0; e < 4; ++e) o4[e] = ost[(dt * 16 + 4 * ig + e) * 64] + sc * O[dt][4 * ig + e];
                u32x2 w; w.x = cvt_pk_bf16(o4[0], o4[1]); w.y = cvt_pk_bf16(o4[2], o4[3]); *(u32x2*)(yp + 32 * dt + 8 * ig) = w; }
        LDS_WAIT();
    }
}

__device__ __forceinline__ void mem_tile(const Ctx& C, int b, int hm, int t0) {
    const bf16_t* P = (const bf16_t*)(C.ws + WS_R1); bf16_t* Y = (bf16_t*)(C.ws + WS_Y);
    int lane_ = C.lane; asm volatile("" : "+v"(lane_));
    const int lane = lane_, r = lane & 31, hi = lane >> 5;
    const size_t tok = (size_t)b * S_ + t0 + r;
    const float QS = 0.12751743082459868f;
    bf16x8 q[8];
    const bf16_t* qp = P + tok * PP + PC_QM + hm * 128;
#pragma unroll
    for (int s = 0; s < 8; ++s) q[s] = scale_q(*(const u32x4*)(qp + 16 * s + 8 * hi), QS);
    const bf16x8* kb = (const bf16x8*)(C.ws + WS_MEMK) + (size_t)(b * 4 + hm) * 8 * 8 * 64 + lane;
    const bf16x8* vb = (const bf16x8*)(C.ws + WS_MEMV) + (size_t)(b * 4 + hm) * 16 * 4 * 64 + lane;
    float m = -1e30f, l = 0.f; f32x16 O[4];
#pragma unroll
    for (int i = 0; i < 16; ++i) { O[0][i] = 0.f; O[1][i] = 0.f; O[2][i] = 0.f; O[3][i] = 0.f; }
#define MEM_STEP(KF, VF) do { \
        f32x16 sc; _Pragma("unroll") for (int i = 0; i < 16; ++i) sc[i] = 0.f; \
        _Pragma("unroll") for (int s = 0; s < 8; ++s) sc = mfma32(KF[s], q[s], sc); \
        float mx = -1e30f; _Pragma("unroll") for (int i = 0; i < 16; ++i) mx = fmaxf(mx, sc[i]); \
        mx = xhalf_max(mx); \
        const float mn = fmaxf(m, mx), alpha = ex2(m - mn); m = mn; \
        float p[16], ps = 0.f; _Pragma("unroll") for (int i = 0; i < 16; ++i) { p[i] = ex2(sc[i] - mn); ps += p[i]; } \
        l = l * alpha + ps; \
        _Pragma("unroll") for (int i = 0; i < 16; ++i) { O[0][i] *= alpha; O[1][i] *= alpha; O[2][i] *= alpha; O[3][i] *= alpha; } \
        const bf16x8 pb0 = pack_p(p), pb1 = pack_p(p + 8); \
        _Pragma("unroll") for (int dt = 0; dt < 4; ++dt) { O[dt] = mfma32(VF[dt], pb0, O[dt]); O[dt] = mfma32(VF[4 + dt], pb1, O[dt]); } } while (0)
    {
        bf16x8 kA[8], vv[8];
#pragma unroll 1
        for (int kt = 0; kt < 8; ++kt) {
#pragma unroll
            for (int s = 0; s < 8; ++s) kA[s] = kb[kt * 512 + s * 64];
#pragma unroll
            for (int s = 0; s < 8; ++s) vv[s] = vb[kt * 512 + s * 64];
            __builtin_amdgcn_sched_barrier(0);
            MEM_STEP(kA, vv);
        }
    }
#undef MEM_STEP
    l = xhalf_sum(l);
    const float inv = 1.f / l;
    bf16_t* yp = Y + tok * YP + 1024 + hm * 128 + 4 * hi;
#pragma unroll
    for (int dt = 0; dt < 4; ++dt)
#pragma unroll
        for (int ig = 0; ig < 4; ++ig) { u32x2 w; w.x = cvt_pk_bf16(O[dt][4 * ig] * inv, O[dt][4 * ig + 1] * inv); w.y = cvt_pk_bf16(O[dt][4 * ig + 2] * inv, O[dt][4 * ig + 3] * inv); *(u32x2*)(yp + 32 * dt + 8 * ig) = w; }
}

__device__ __forceinline__ void attention_phase(const Ctx& C) {
    const int bxx = C.gw / NWAVES; const bool xmode = (C.G & 7) == 0;
    const int x = bxx & 7, rank = xmode ? (bxx >> 3) * NWAVES + C.wave : C.gw, nrank = xmode ? (C.G >> 3) * NWAVES : C.NGW, nitem = xmode ? 1536 : 12288;
    for (int i = rank; i < nitem; i += nrank) {
        int nsa_n, mem_e;
        if (xmode) { nsa_n = (i < 1024) ? (x >> 1) * 2048 + 2 * i + (x & 1) : -1; mem_e = x * 512 + (i - 1024); }
        else { if (i < 8192) { const int k = i >> 11, w = i & 2047; nsa_n = k * 2048 + ((k & 1) ? 2047 - w : w); } else nsa_n = -1; mem_e = i - 8192; }
        if (nsa_n >= 0) { const int k = nsa_n >> 11; nsa_tile(C, k >> 1, k & 1, (nsa_n & 2047) * 8); }
        else { const int bh = mem_e >> 9; mem_tile(C, bh >> 2, bh & 3, (mem_e & 511) * 32); }
    }
}

#define XB_TMO      128
#define XB_XCNT(j)  (256  + 64 * (j))
#define XB_XSUB(j)  (1280 + 64 * (j))
#define XB_XGEN(j)  (2304 + 64 * (j))
#define XB_TOP      3328
#define XB_TOPGEN   3392
#define XCD_BAR_WORDS 3456
#define XB_SPIN_CAP (1u << 18)
__device__ __forceinline__ unsigned xb_ld(unsigned* p)              { return __hip_atomic_load(p, __ATOMIC_RELAXED, __HIP_MEMORY_SCOPE_AGENT); }
__device__ __forceinline__ unsigned xb_add(unsigned* p, unsigned v) { return __hip_atomic_fetch_add(p, v, __ATOMIC_RELAXED, __HIP_MEMORY_SCOPE_AGENT); }
__device__ __forceinline__ unsigned xb_xcc_id() { return (unsigned)__builtin_amdgcn_s_getreg((3 << 11) | 20) & 0xFu; }
#define XB_SPIN(cond, bar) do { unsigned _sp = 0; while (cond) { __builtin_amdgcn_s_sleep(1); \
    if ((++_sp & 255u) == 0u) { if (xb_ld(&(bar)[XB_TMO])) break; if (_sp > XB_SPIN_CAP) { atomicAdd(&(bar)[XB_TMO], 1u); break; } } } } while (0)
__device__ __forceinline__ void xcd_barrier_complete(unsigned* bar, unsigned x, unsigned& nloc, unsigned& nx) {
    const unsigned G = gridDim.x * gridDim.y * gridDim.z;
    unsigned sum, cnt, mine, sp = 0u;
    for (;;) {
        sum = 0u; cnt = 0u; mine = 0u;
#pragma unroll
        for (unsigned j = 0; j < 16; ++j) { const unsigned c = xb_ld(&bar[XB_XCNT(j)]); sum += c; cnt += (c > 0u) ? 1u : 0u; mine = (j == x) ? c : mine; }
        if (sum == G) break;
        __builtin_amdgcn_s_sleep(1);
        if ((++sp & 255u) == 0u) { if (xb_ld(&bar[XB_TMO])) break; if (sp > XB_SPIN_CAP) { atomicAdd(&bar[XB_TMO], 1u); break; } }
    }
    nloc = mine > 0u ? mine : 1u; nx = cnt > 0u ? cnt : 1u;
}
__device__ __forceinline__ void xcd_barrier(unsigned* bar, volatile LAS unsigned* st, bool tid0) {
    asm volatile("s_waitcnt vmcnt(0)" ::: "memory");
    __syncthreads();
    if (tid0) {
        __builtin_amdgcn_s_waitcnt(0);
        const unsigned x = xb_xcc_id();
        unsigned nloc = st[0], nx = st[1];
        if (nloc == 0u) { xcd_barrier_complete(bar, x, nloc, nx); st[0] = nloc; st[1] = nx; }
        const unsigned old = xb_add(&bar[XB_XSUB(x)], 1u);
        const unsigned gen = old / nloc;
        if (old + 1u == (gen + 1u) * nloc) {
            __builtin_amdgcn_fence(__ATOMIC_RELEASE, "agent");
            asm volatile("s_waitcnt vmcnt(0)" ::: "memory");
            const unsigned og = xb_add(&bar[XB_TOP], 1u);
            const unsigned tg = og / nx;
            if (og + 1u == (tg + 1u) * nx) xb_add(&bar[XB_TOPGEN], 1u);
            else XB_SPIN(xb_ld(&bar[XB_TOPGEN]) == tg, bar);
            __builtin_amdgcn_fence(__ATOMIC_ACQUIRE, "agent");
            xb_add(&bar[XB_XGEN(x)], 1u);
            asm volatile("s_waitcnt vmcnt(0)" ::: "memory");
        } else {
            XB_SPIN(xb_ld(&bar[XB_XGEN(x)]) == gen, bar);
            __builtin_amdgcn_fence(__ATOMIC_ACQUIRE, "agent");
            asm volatile("s_waitcnt vmcnt(0)" ::: "memory");
        }
    }
    __syncthreads();
}

constexpr int LDS_BYTES = 147456, XB_LDS_OFF = 147456 - 64;
constexpr int NPHASE = 1 + 2 * 14;

__global__ void __launch_bounds__(NWAVES * 64, 2) fwd_kernel(Args args) {
    extern __shared__ __attribute__((aligned(16))) unsigned char lds_raw[];
    cg::grid_group grid = cg::this_grid();
    if (args.ph_lo == 0x7fffffff) grid.sync();
    const int wave0 = __builtin_amdgcn_readfirstlane((int)threadIdx.x >> 6);
    {
        volatile LAS unsigned* st = (volatile LAS unsigned*)(lds_raw + XB_LDS_OFF);
        if (threadIdx.x == 0) { st[0] = 0u; st[1] = 0u; (void)xb_add((unsigned*)(args.ws + WS_BAR) + XB_XCNT(xb_xcc_id()), 1u); }
        __syncthreads();
    }
#define PHASE_BEGIN { \
        unsigned char* ws0_ = args.ws; asm volatile("" : "+s"(ws0_)); gu8* ws = (gu8*)ws0_;     \
        int tid_; asm volatile("v_mbcnt_lo_u32_b32 %0, -1, 0\n\tv_mbcnt_hi_u32_b32 %0, -1, %0" : "=v"(tid_)); tid_ += wave0 * 64; \
        Ctx C; C.a = &args; C.ws = ws; C.lds = (LAS unsigned char*)lds_raw; C.tid = tid_; C.lane = tid_ & 63; C.wave = __builtin_amdgcn_readfirstlane(tid_ >> 6); \
        int bx = blockIdx.x; asm volatile("" : "+s"(bx)); C.G = gridDim.x; C.gw = bx * NWAVES + C.wave; C.NGW = C.G * NWAVES; \
        bf16_t* const H = (bf16_t*)(ws + WS_H); bf16_t* const R1 = (bf16_t*)(ws + WS_R1); bf16_t* const Y = (bf16_t*)(ws + WS_Y); (void)H; (void)R1; (void)Y; (void)bx;
#define PHASE_END   { int ln_; asm volatile("v_mbcnt_lo_u32_b32 %0, -1, 0\n\tv_mbcnt_hi_u32_b32 %0, -1, %0" : "=v"(ln_));   \
        xcd_barrier((unsigned*)(ws + WS_BAR), (volatile LAS unsigned*)(lds_raw + XB_LDS_OFF), (wave0 == 0) && (ln_ == 0)); } }
#define PHASE_END_CG grid.sync(); }

    PHASE_BEGIN
        convert_layer(C, 0);
        rope_table(C);
        prenorm_rows(C, (const float*)args.in[0], (const float*)args.in[3], H);
    PHASE_END

#pragma unroll 1
    for (int l = 0; l < 2; ++l) {
        PHASE_BEGIN
            { pg8::GemmDesc g{(const char*)H, (const char*)(ws + WS_W1IN), DM, DM, 128, 128, 16}; pg8::StdOrder S; S.init(T_, 2 * FF, C.G, bx, DM, DM);
              pg8::Epi<1> E{R1, FF, nullptr, nullptr}; pg8::gemm_phase(C.lds, C.tid, g, S, E); }
        PHASE_END
        PHASE_BEGIN
            { pg8::GemmDesc g{(const char*)R1, (const char*)(ws + WS_W1OUT), FF, FF, 128, 128, 44}; pg8::StdOrder S; S.init(T_, DM, C.G, bx, FF, FF);
              pg8::Epi<0> E{H, DM, nullptr, nullptr}; pg8::gemm_phase(C.lds, C.tid, g, S, E); }
        PHASE_END
        PHASE_BEGIN
            if (bx < 8) {
                { pg8::GemmDesc g{(const char*)(ws + WS_MEMN), (const char*)(ws + WS_WMKV), DM, DM, 128, 128, 16}; pg8::StdOrder S; S.init(512, DM, C.G, bx, DM, DM);
              pg8::Epi<0> E{(bf16_t*)(ws + WS_MKV), DM, nullptr, nullptr}; pg8::gemm_phase(C.lds, C.tid, g, S, E); }
            } else {
                norm_phase(C, C.gw - 8 * NWAVES, C.NGW - 8 * NWAVES, l == 0 ? (const float*)args.in[0] : args.out, args.out, H, H, INF(4, l, DM), INF(7, l, DM), 0.5f);
            }
            cb_reduce(C, l);
        PHASE_END
        PHASE_BEGIN
            { pg8::GemmDesc g{(const char*)H, (const char*)(ws + WS_WMIX), DM, DM, 128, 128, 16}; pg8::StdOrder S; S.init(T_, PP, C.G, bx, DM, DM);
              pg8::Epi<0> E{R1, PP, nullptr, nullptr}; pg8::gemm_phase(C.lds, C.tid, g, S, E); }
        PHASE_END
        PHASE_BEGIN
            if (bx < 64) {
                pg8::GemmDesc g{(const char*)R1, (const char*)(ws + WS_WC1), 16 * PP, 2048, PP * 2, 128, 16}; pg8::CmpOrder S{bx};
                pg8::Epi<0> E{(bf16_t*)(ws + WS_CMPP), 256, nullptr, nullptr}; pg8::gemm_phase(C.lds, C.tid, g, S, E);
            } else {
                prep_items(C, l, C.gw - 64 * NWAVES, C.NGW - 64 * NWAVES);
                memkv_ops(C, C.gw - 64 * NWAVES, C.NGW - 64 * NWAVES);
            }
        PHASE_END
        PHASE_BEGIN
            cmp_stage2(C, l);
        PHASE_END
        PHASE_BEGIN
            attention_phase(C);
        PHASE_END
        PHASE_BEGIN
            { pg8::GemmDesc g{(const char*)H, (const char*)(ws + WS_WG), DM, DM, 128, 128, 16}; pg8::StdOrder S; S.init(T_, GP, C.G, bx, DM, DM);
              pg8::Epi<2> E{R1, GP, nullptr, nullptr}; pg8::gemm_phase(C.lds, C.tid, g, S, E); }
        PHASE_END
        PHASE_BEGIN
            { pg8::GemmDesc g{(const char*)Y, (const char*)(ws + WS_WBR), YP, YP, 128, 128, 8}; pg8::MergeOrder S; S.init(T_, DM, C.G, bx, YP, YP);
              pg8::Epi<3> E{H, DM, R1, nullptr}; pg8::gemm_phase(C.lds, C.tid, g, S, E); }
        PHASE_END
        PHASE_BEGIN
            { pg8::GemmDesc g{(const char*)H, (const char*)(ws + WS_WOUT), DM, DM, 128, 128, 16}; pg8::StdOrder S; S.init(T_, DM, C.G, bx, DM, DM);
              pg8::Epi<0> E{R1, DM, nullptr, nullptr}; pg8::gemm_phase(C.lds, C.tid, g, S, E); }
        PHASE_END
        PHASE_BEGIN
            norm_phase(C, C.gw, C.NGW, args.out, args.out, R1, H, INF(8, l, DM), INF(25, l, DM), 1.0f);
        PHASE_END
        PHASE_BEGIN
            { pg8::GemmDesc g{(const char*)H, (const char*)(ws + WS_W2IN), DM, DM, 128, 128, 16}; pg8::StdOrder S; S.init(T_, 2 * FF, C.G, bx, DM, DM);
              pg8::Epi<1> E{R1, FF, nullptr, nullptr}; pg8::gemm_phase(C.lds, C.tid, g, S, E); }
        PHASE_END
        PHASE_BEGIN
            { pg8::GemmDesc g{(const char*)R1, (const char*)(ws + WS_W2OUT), FF, FF, 128, 128, 44}; pg8::StdOrder S; S.init(T_, DM, C.G, bx, FF, FF);
              pg8::Epi<0> E{H, DM, nullptr, nullptr}; pg8::gemm_phase(C.lds, C.tid, g, S, E); }
        PHASE_END
        PHASE_BEGIN
            norm_phase(C, C.gw, C.NGW, args.out, args.out, H, H, INF(26, l, DM), l == 0 ? INF(3, 1, DM) : nullptr, 0.5f);
            if (l == 0) convert_layer(C, 1);
        PHASE_END
    }
}

extern "C" void kernel_launch(void* const* d_in, const int* in_sizes, int n_in, void* d_out, int out_size, void* d_ws, size_t ws_size, hipStream_t stream) {
    static int grid = 0;
    if (grid == 0) {
        if (n_in != 29 || ws_size < WS_END) { fprintf(stderr, "kernel_launch: unexpected n_in %d / ws %zu\n", n_in, ws_size); grid = -1; return; }
        int dev = 0, cus = 0, per_cu = 0;
        hipGetDevice(&dev); hipDeviceGetAttribute(&cus, hipDeviceAttributeMultiprocessorCount, dev);
        hipFuncSetAttribute((const void*)fwd_kernel, hipFuncAttributeMaxDynamicSharedMemorySize, LDS_BYTES);
        hipOccupancyMaxActiveBlocksPerMultiprocessor(&per_cu, (const void*)fwd_kernel, NWAVES * 64, LDS_BYTES);
        if (per_cu < 1) per_cu = 1;
        grid = cus * per_cu;
        (void)hipGetLastError();
    }
    if (grid < 0) return;
    hipMemsetAsync((char*)d_ws + WS_BAR, 0, 16384, stream);
    Args a{};
    for (int i = 0; i < 29; ++i) a.in[i] = d_in[i];
    a.out = (float*)d_out; a.ws = (unsigned char*)d_ws; a.ph_lo = 0; a.ph_hi = NPHASE;
    void* kargs[] = {&a};
    hipError_t e = hipLaunchCooperativeKernel((const void*)fwd_kernel, dim3(grid), dim3(NWAVES * 64), kargs, LDS_BYTES, stream);
    if (e != hipSuccess) fprintf(stderr, "cooperative launch failed: %s (grid %d)\n", hipGetErrorString(e), grid);
}
```

```cpp
#include <hip/hip_runtime.h>
#include <hip/hip_cooperative_groups.h>
#include <cstdio>
#include <cstdint>
namespace cg = cooperative_groups;

#define LAS __attribute__((address_space(3)))
typedef unsigned short bf16_t;
typedef short bf16x8 __attribute__((ext_vector_type(8)));
typedef float f32x4 __attribute__((ext_vector_type(4)));
typedef float f32x16 __attribute__((ext_vector_type(16)));
typedef unsigned u32x4 __attribute__((ext_vector_type(4)));
typedef unsigned u32x2 __attribute__((ext_vector_type(2)));

constexpr int NBATCH = 2, S_ = 16384, T_ = NBATCH * S_, DM = 1024, FF = 2816, PP = 3584, GP = 3072, YP = 1536;
constexpr int NWAVES = 8;
constexpr float EPS = 1e-6f;
constexpr int PC_Q = 1536, PC_KV = 2048, PC_QM = 2816, PC_NG = 3328;

constexpr size_t MiB = 1u << 20;
constexpr size_t WS_W1IN = 0, WS_W1OUT = 11 * MiB, WS_WMIX = WS_W1OUT + 11 * MiB / 2, WS_WG = WS_WMIX + 7 * MiB, WS_WBR = WS_WG + 6 * MiB, WS_WOUT = WS_WBR + 3 * MiB,
                 WS_W2IN = WS_WOUT + 2 * MiB, WS_W2OUT = WS_W2IN + 11 * MiB, WS_WC1 = WS_W2OUT + 11 * MiB / 2  , WS_WMKV = WS_WC1 + 2 * MiB,
                 WS_MEMN = WS_WMKV + 2 * MiB, WS_MKV = WS_MEMN + 1 * MiB, WS_CB = WS_MKV + 1 * MiB  , WS_CBP = WS_CB + 8192  , WS_BAR = WS_CB + 8192 + 131072  ;
static_assert(WS_CB == 57 * MiB, "ws map");
constexpr size_t WS_ROPE = 58 * MiB, WS_MEMK = 60 * MiB, WS_MEMV = WS_MEMK + MiB / 2, WS_KCMP = 61 * MiB, WS_VCMP = WS_KCMP + MiB / 2, WS_CMPH = 62 * MiB,
                 WS_KSLC = 66 * MiB, WS_VSLC = 74 * MiB, WS_KWIN = 82 * MiB, WS_VWIN = 90 * MiB, WS_H = 98 * MiB, WS_Y = 162 * MiB, WS_R1 = 258 * MiB, WS_CMPP = 484 * MiB  , WS_END = 492 * MiB;

typedef float f32x2_t __attribute__((ext_vector_type(2)));
typedef __bf16 bf16x2_t __attribute__((ext_vector_type(2)));
__device__ __forceinline__ unsigned cvt_pk_bf16(float lo, float hi) { f32x2_t v = {lo, hi}; bf16x2_t b = __builtin_convertvector(v, bf16x2_t); return __builtin_bit_cast(unsigned, b); }
__device__ __forceinline__ float bf_lo(unsigned u) { return __uint_as_float(u << 16); }
__device__ __forceinline__ float bf_hi(unsigned u) { return __uint_as_float(u & 0xffff0000u); }
__device__ __forceinline__ float bf1(bf16_t u) { return __uint_as_float(((unsigned)u) << 16); }
__device__ __forceinline__ float ex2(float x) { return __builtin_amdgcn_exp2f(x); }
__device__ __forceinline__ float rcpf_(float x) { return __builtin_amdgcn_rcpf(x); }
__device__ __forceinline__ float sigm(float x) { return rcpf_(1.f + ex2(-1.44269504f * x)); }
__device__ __forceinline__ float gelu_tanh(float x) { const float u = 0.7978845608f * (x + 0.044715f * x * x * x); return x * rcpf_(1.f + ex2(-2.88539008f * u)); }
__device__ __forceinline__ float wave_sum(float v) {
#pragma unroll
    for (int o = 1; o < 64; o <<= 1) v += __shfl_xor(v, o);
    return v;
}
__device__ __forceinline__ int pi32(int r) { return (r & 0x13) | ((r & 4) << 1) | ((r & 8) >> 1); }
#define LDS_WAIT() asm volatile("s_waitcnt lgkmcnt(0)" ::: "memory")

namespace pg8 {
constexpr int BM = 256, BK = 64, HALF = 128, HTB = HALF * BK * 2, STAGE_BYTES = 8 * HTB, NXCD = 8, WGM = 8;
__device__ __forceinline__ int lds_byte(int r, int c) { const int st = (r >> 4) * 2 + (c >> 5), rr = r & 15, cc = c & 31, ob = rr * 64 + cc * 2; return st * 1024 + (ob ^ (((ob >> 9) & 1) << 5)); }
__device__ __forceinline__ void stage_rc(int b, int& R, int& C) { const int st = b / 1024, sb = b % 1024, swz = sb ^ (((sb >> 9) & 1) << 5); R = (st >> 1) * 16 + swz / 64; C = (st & 1) * 32 + (swz % 64) / 2; }
__device__ __forceinline__ int perm32(int rho) { const int n = rho >> 4, i = rho & 15; return 8 * (i >> 2) + 4 * n + (i & 3); }

struct Unit { int pm, pn, tag; long long aoff, boff; };
struct GemmDesc { const char* A; const char* Bt; int lda, ldb, kstepA, kstepB, nt; };

__device__ __forceinline__ void swz_tile(int L, int nM, int nN, int& pm, int& pn) {
    const int nwg = nM * nN; int wgid = L;
    { const int q = nwg / NXCD, r = nwg % NXCD, xcd = wgid % NXCD, off = wgid / NXCD; wgid = (xcd < r ? xcd * (q + 1) : r * (q + 1) + (xcd - r) * q) + off; }
    const int nig = WGM * nN, gid = wgid / nig, fm = gid * WGM, gsz = (nM - fm) < WGM ? (nM - fm) : WGM;
    pm = fm + ((wgid % nig) % gsz); pn = (wgid % nig) / gsz;
}
struct StdOrder {
    int nM, nN, G, c; long long tA, tB;
    __device__ void init(int M, int N, int G_, int c_, int lda, int ldb) { nM = M / BM; nN = N / BM; G = G_; c = c_; tA = 512LL * lda; tB = 512LL * ldb; }
    __device__ bool next(int i, Unit& u) const {
        const long long L = (long long)i * G + c; if (L >= (long long)nM * nN) return false;
        swz_tile((int)L, nM, nN, u.pm, u.pn); u.tag = 0; u.aoff = u.pm * tA; u.boff = u.pn * tB; return true;
    }
};
struct MergeOrder {
    int nM, nN, G, c; long long tA, tB;
    __device__ void init(int M, int N, int G_, int c_, int lda, int ldb) { nM = M / BM; nN = N / BM; G = G_; c = c_; tA = 512LL * lda; tB = 512LL * ldb; }
    __device__ bool next(int i, Unit& u) const {
        const int ti = i / 3, br = i - 3 * ti; const long long L = (long long)ti * G + c; if (L >= (long long)nM * nN) return false;
        swz_tile((int)L, nM, nN, u.pm, u.pn); u.tag = br; u.aoff = u.pm * tA + br * 1024; u.boff = u.pn * tB + br * 1024; return true;
    }
};
struct CmpOrder {
    int c;
    __device__ bool next(int i, Unit& u) const {
        if (i != 0 || c >= 64) return false;
        const int ks = c >> 5, kv = (c >> 4) & 1, bg = (c >> 2) & 3, tile = c & 3, b = bg >> 1, g = bg & 1;
        u.pm = c; u.pn = 0; u.tag = kv;
        u.aoff = 2LL * (((long long)b * S_ + 4096LL * tile + 16LL * ks) * PP + PC_KV + kv * 128 + g * 64);
        u.boff = (long long)kv * (256 * 2048 * 2) + (long long)ks * (1024 * 2); return true;
    }
};

__device__ __forceinline__ u32x4 pack8(f32x4 a, f32x4 b) { u32x4 w; w.x = cvt_pk_bf16(a[0], a[1]); w.y = cvt_pk_bf16(a[2], a[3]); w.z = cvt_pk_bf16(b[0], b[1]); w.w = cvt_pk_bf16(b[2], b[3]); return w; }
template <int MODE> struct Epi {
    bf16_t* O; int ldc; const bf16_t* G; const float* bias;
    __device__ __forceinline__ void operator()(const f32x4 (&acc)[2][2][4][2], const Unit& u, int wr, int wc, int fr, int fq) const {
        const int row0 = u.pm * BM + wr * 64 + fr;
        if constexpr (MODE == 1) {
            const int col0 = u.pn * 128 + wc * 32 + 8 * fq;
#pragma unroll
            for (int ai = 0; ai < 2; ++ai)
#pragma unroll
                for (int m = 0; m < 4; ++m) {
                    bf16_t* rowp = O + (size_t)(row0 + ai * HALF + m * 16) * ldc + col0;
                    f32x4 v0, v1;
#pragma unroll
                    for (int e = 0; e < 4; ++e) { const float a0 = acc[ai][0][m][0][e], a1 = acc[ai][0][m][1][e]; v0[e] = a0 * sigm(a0) * acc[ai][1][m][0][e]; v1[e] = a1 * sigm(a1) * acc[ai][1][m][1][e]; }
                    *(u32x4*)rowp = pack8(v0, v1);
                    __builtin_amdgcn_sched_barrier(0);
                }
        } else {
            const int col0 = u.pn * BM + wc * 32 + 8 * fq;
#pragma unroll
            for (int ai = 0; ai < 2; ++ai)
#pragma unroll
                for (int m = 0; m < 4; ++m) {
                    const size_t row = (size_t)(row0 + ai * HALF + m * 16);
#pragma unroll
                    for (int bj = 0; bj < 2; ++bj) {
                        const int col = col0 + bj * HALF;
                        f32x4 v0 = acc[ai][bj][m][0], v1 = acc[ai][bj][m][1];
                        bf16_t* dst = O + row * ldc + col;
                        if constexpr (MODE == 2) {
#pragma unroll
                            for (int e = 0; e < 4; ++e) { v0[e] = sigm(v0[e]); v1[e] = sigm(v1[e]); }
                        }
                        if constexpr (MODE == 4) {
                            const f32x4 b0 = *(const f32x4*)(bias + u.tag * 256 + col), b1 = *(const f32x4*)(bias + u.tag * 256 + col + 4);
#pragma unroll
                            for (int e = 0; e < 4; ++e) { v0[e] = gelu_tanh(v0[e] + b0[e]); v1[e] = gelu_tanh(v1[e] + b1[e]); }
                        }
                        if constexpr (MODE == 3) {
                            const u32x4 gv = *(const u32x4*)(G + row * GP + u.tag * 1024 + col);
                            v0[0] *= bf_lo(gv.x); v0[1] *= bf_hi(gv.x); v0[2] *= bf_lo(gv.y); v0[3] *= bf_hi(gv.y);
                            v1[0] *= bf_lo(gv.z); v1[1] *= bf_hi(gv.z); v1[2] *= bf_lo(gv.w); v1[3] *= bf_hi(gv.w);
                            if (u.tag > 0) {
                                const u32x4 ov = *(const u32x4*)dst;
                                v0[0] += bf_lo(ov.x); v0[1] += bf_hi(ov.x); v0[2] += bf_lo(ov.y); v0[3] += bf_hi(ov.y);
                                v1[0] += bf_lo(ov.z); v1[1] += bf_hi(ov.z); v1[2] += bf_lo(ov.w); v1[3] += bf_hi(ov.w);
                            }
                        }
                        *(u32x4*)dst = pack8(v0, v1);
                    }
                }
        }
    }
};

template <class EpiT, class Sched>
__device__ __forceinline__ void gemm_phase(LAS unsigned char* lds, int tid_in, const GemmDesc g, const Sched& S, const EpiT& E) {
    int tid_ = tid_in; asm volatile("" : "+v"(tid_));
    const int tid = tid_, wid = __builtin_amdgcn_readfirstlane(tid >> 6), lane = tid & 63, wr = wid >> 2, wc = wid & 3, fr = lane & 15, fq = lane >> 4;
    const int nt = g.nt;
    unsigned voffA[2], voffB[2];
#pragma unroll
    for (int i = 0; i < 2; ++i) { int R, C; stage_rc(tid * 16 + i * 8192, R, C); const int Rb = (R & ~31) + perm32(R & 31);
        voffA[i] = (unsigned)(R * g.lda + C) * 2u; voffB[i] = (unsigned)(Rb * g.ldb + C) * 2u; }
    const size_t kA = (size_t)g.kstepA, kB = (size_t)g.kstepB;
    const size_t hA = (size_t)HALF * g.lda * 2, hB = (size_t)HALF * g.ldb * 2;
    const unsigned ldsw = (unsigned)wid * 1024u;
    const int aoff = lds_byte(wr * 64 + fr, fq * 8), boff = lds_byte(wc * 32 + fr, fq * 8);
#define PG8_SA(b, h) (((b) * 2 + (h)) * HTB)
#define PG8_SB(b, h) ((4 + (b) * 2 + (h)) * HTB)
#define PG8_STAGE(bufoff, gbase, voff) do { _Pragma("unroll") for (int _i = 0; _i < 2; ++_i) \
        __builtin_amdgcn_global_load_lds((const unsigned*)((const char*)(gbase) + (voff)[_i]), (LAS unsigned*)(lds + (bufoff) + ldsw + _i * 8192), 16, 0, 0); } while (0)
#define PG8_LDA(dst, b, h) do { _Pragma("unroll") for (int m = 0; m < 4; ++m) _Pragma("unroll") for (int k = 0; k < 2; ++k) dst[m][k] = *(const LAS bf16x8*)(lds + PG8_SA(b, h) + aoff + m * 2048 + k * 1024); } while (0)
#define PG8_LDB(dst, b, h) do { _Pragma("unroll") for (int n = 0; n < 2; ++n) _Pragma("unroll") for (int k = 0; k < 2; ++k) dst[n][k] = *(const LAS bf16x8*)(lds + PG8_SB(b, h) + boff + n * 2048 + k * 1024); } while (0)
#define PG8_MMA(ai, bj, At, Bt) do { __builtin_amdgcn_s_setprio(1); _Pragma("unroll") for (int m = 0; m < 4; ++m) _Pragma("unroll") for (int n = 0; n < 2; ++n) _Pragma("unroll") for (int k = 0; k < 2; ++k) \
        acc[ai][bj][m][n] = __builtin_amdgcn_mfma_f32_16x16x32_bf16(Bt[n][k], At[m][k], acc[ai][bj][m][n], 0, 0, 0); __builtin_amdgcn_s_setprio(0); } while (0)
#define PG8_WAIT_V(n) asm volatile("s_waitcnt vmcnt(" #n ")" ::: "memory")
#define PG8_WAIT_L(n) asm volatile("s_waitcnt lgkmcnt(" #n ")" ::: "memory")
#define PG8_BAR __builtin_amdgcn_s_barrier()
#define PG8_SCHED __builtin_amdgcn_sched_barrier(0)
    Unit cur, nxt; int ui = 0;
    if (!S.next(0, cur)) return;
    f32x4 acc[2][2][4][2];
#pragma unroll
    for (int a = 0; a < 2; ++a)
#pragma unroll
        for (int b = 0; b < 2; ++b)
#pragma unroll
            for (int m = 0; m < 4; ++m)
#pragma unroll
                for (int n = 0; n < 2; ++n) acc[a][b][m][n] = (f32x4){0.f, 0.f, 0.f, 0.f};
    bf16x8 At[4][2], B0[2][2], B1[2][2];
    const char* cA = g.A + cur.aoff; const char* cB = g.Bt + cur.boff;
    PG8_STAGE(PG8_SB(0, 0), cB, voffB); PG8_STAGE(PG8_SB(0, 1), cB + hB, voffB); PG8_STAGE(PG8_SA(0, 0), cA, voffA); PG8_STAGE(PG8_SA(0, 1), cA + hA, voffA);
    if (wr == 1) PG8_BAR;
    PG8_WAIT_V(2); PG8_BAR;
    PG8_STAGE(PG8_SB(1, 0), cB + kB, voffB); PG8_STAGE(PG8_SA(1, 0), cA + kA, voffA); PG8_STAGE(PG8_SB(1, 1), cB + hB + kB, voffB);
    PG8_WAIT_V(6); PG8_BAR;
    for (;;) {
        const bool has_next = S.next(ui + 1, nxt);
        const char* nA = has_next ? g.A + nxt.aoff : cA; const char* nB = has_next ? g.Bt + nxt.boff : cB;
        for (int t = 0; t < nt; t += 2) {
            const bool last = (t == nt - 2);
            const char* a1 = cA + (size_t)(t + 1) * kA;
            const char* a2 = last ? nA : cA + (size_t)(t + 2) * kA; const char* b2 = last ? nB : cB + (size_t)(t + 2) * kB;
            const char* a3 = a2 + kA; const char* b3 = b2 + kB;
            PG8_LDB(B0, 0, 0); PG8_LDB(B1, 0, 1); PG8_SCHED; PG8_LDA(At, 0, 0); PG8_STAGE(PG8_SA(1, 1), a1 + hA, voffA);
            PG8_WAIT_V(8); PG8_WAIT_L(0); PG8_BAR; PG8_MMA(0, 0, At, B0); PG8_MMA(0, 1, At, B1); PG8_BAR; PG8_SCHED;
            PG8_LDA(At, 0, 1); PG8_STAGE(PG8_SB(0, 0), b2, voffB); PG8_STAGE(PG8_SB(0, 1), b2 + hB, voffB); PG8_STAGE(PG8_SA(0, 0), a2, voffA);
            PG8_WAIT_V(8); PG8_WAIT_L(0); PG8_BAR; PG8_MMA(1, 0, At, B0); PG8_MMA(1, 1, At, B1); PG8_BAR; PG8_SCHED;
            PG8_LDB(B0, 1, 0); PG8_LDB(B1, 1, 1); PG8_SCHED; PG8_LDA(At, 1, 0); PG8_STAGE(PG8_SA(0, 1), a2 + hA, voffA);
            PG8_WAIT_V(8); PG8_WAIT_L(0); PG8_BAR; PG8_MMA(0, 0, At, B0); PG8_MMA(0, 1, At, B1); PG8_BAR; PG8_SCHED;
            PG8_LDA(At, 1, 1); PG8_STAGE(PG8_SB(1, 0), b3, voffB); PG8_STAGE(PG8_SB(1, 1), b3 + hB, voffB); PG8_STAGE(PG8_SA(1, 0), a3, voffA);
            PG8_WAIT_V(8); PG8_WAIT_L(0); PG8_BAR; PG8_MMA(1, 0, At, B0); PG8_MMA(1, 1, At, B1); PG8_BAR; PG8_SCHED;
        }
        if (wr == 0) PG8_BAR;
        E(acc, cur, wr, wc, fr, fq);
        if (!has_next) break;
#pragma unroll
        for (int a = 0; a < 2; ++a)
#pragma unroll
            for (int b = 0; b < 2; ++b)
#pragma unroll
                for (int m = 0; m < 4; ++m)
#pragma unroll
                    for (int n = 0; n < 2; ++n) acc[a][b][m][n] = (f32x4){0.f, 0.f, 0.f, 0.f};
        cur = nxt; cA = nA; cB = nB; ++ui;
        if (wr == 1) PG8_BAR;
    }
    PG8_WAIT_V(0);
    PG8_BAR;
#undef PG8_SA
#undef PG8_SB
#undef PG8_STAGE
#undef PG8_LDA
#undef PG8_LDB
#undef PG8_MMA
#undef PG8_WAIT_V
#undef PG8_WAIT_L
#undef PG8_BAR
#undef PG8_SCHED
}
}

struct Args { const void* in[29]; float* out; unsigned char* ws; int ph_lo, ph_hi; };
static_assert(sizeof(Args) == 29 * 8 + 8 + 8 + 8, "Args has no padding");

typedef __attribute__((address_space(1))) unsigned char gu8;
struct Ctx {
    const Args* a; gu8* ws; LAS unsigned char* lds; int tid, lane, wave, G, gw, NGW;
};
#define INF(k, l, n) ((const float*)C.a->in[k] + (size_t)(l) * (n))

__device__ __forceinline__ void tr_item(const float* W, int ldw, int src_col, int nvalid, int k0, bf16_t* WT, int ldt, int dst_row, int dst_k, LAS float* scr, int lane) {
#pragma unroll 8
    for (int i = 0; i < 32; ++i) { const int kk = 2 * i + (lane >> 5), c = lane & 31; scr[kk * 33 + c] = (c < nvalid) ? W[(size_t)(k0 + kk) * ldw + src_col + c] : 0.f; }
    LDS_WAIT();
    const int c = lane & 7;
#pragma unroll
    for (int j = 0; j < 4; ++j) { const int n = (lane >> 3) + 8 * j; const LAS float* s = scr + (8 * c) * 33 + n;
        u32x4 o; o.x = cvt_pk_bf16(s[0 * 33], s[1 * 33]); o.y = cvt_pk_bf16(s[2 * 33], s[3 * 33]); o.z = cvt_pk_bf16(s[4 * 33], s[5 * 33]); o.w = cvt_pk_bf16(s[6 * 33], s[7 * 33]);
        *(u32x4*)(WT + (size_t)(dst_row + n) * ldt + dst_k + k0 + 8 * c) = o; }
    LDS_WAIT();
}

__device__ __forceinline__ void convert_layer(const Ctx& C, int l) {
    LAS float* scr = (LAS float*)(C.lds + C.wave * 8448);
    gu8* ws = C.ws; const int lane = C.lane;
    constexpr int NITEMS = 2816 + 1408 + 1792 + 1536 + 768 + 512 + 2816 + 1408 + 256 + 256 + 512;
    for (int it = C.gw; it < NITEMS; it += C.NGW) {
        int r = it;
        if (r < 2816) { const int kb = r / 176, nb = r % 176, tile = nb >> 3, w = nb & 7, src = (w >> 2) * FF + tile * 128 + (w & 3) * 32;
            tr_item(INF(5, l, DM * 2 * FF), 2 * FF, src, 32, kb * 64, (bf16_t*)(ws + WS_W1IN), DM, nb * 32, 0, scr, lane); continue; } r -= 2816;
        if (r < 1408) { const int kb = r / 32, nb = r % 32;
            tr_item(INF(6, l, FF * DM), DM, nb * 32, 32, kb * 64, (bf16_t*)(ws + WS_W1OUT), FF, nb * 32, 0, scr, lane); continue; } r -= 1408;
        if (r < 1792) { const int kb = r / 112, nb = r % 112; int src = 0, nv = 0;
            if (nb < 88) { src = nb * 32; nv = 32; } else if (nb < 104) { src = 2840 + (nb - 88) * 32; nv = 32; } else if (nb == 104) { src = 2816; nv = 24; }
            tr_item(INF(10, l, DM * 6424), 6424, src, nv, kb * 64, (bf16_t*)(ws + WS_WMIX), DM, nb * 32, 0, scr, lane); continue; } r -= 1792;
        if (r < 1536) { const int kb = r / 96, nb = r % 96;
            tr_item(INF(10, l, DM * 6424), 6424, 3352 + nb * 32, 32, kb * 64, (bf16_t*)(ws + WS_WG), DM, nb * 32, 0, scr, lane); continue; } r -= 1536;
        if (r < 768) { const int br = r / 256, q = r % 256, kb = q / 32, nb = q % 32;
            const float* W = br == 0 ? INF(21, l, 512 * DM) : (br == 1 ? INF(22, l, 512 * DM) : INF(23, l, 512 * DM));
            tr_item(W, DM, nb * 32, 32, kb * 64, (bf16_t*)(ws + WS_WBR), YP, nb * 32, br * 512, scr, lane); continue; } r -= 768;
        if (r < 512) { const int kb = r / 32, nb = r % 32;
            tr_item(INF(24, l, DM * DM), DM, nb * 32, 32, kb * 64, (bf16_t*)(ws + WS_WOUT), DM, nb * 32, 0, scr, lane); continue; } r -= 512;
        if (r < 2816) { const int kb = r / 176, nb = r % 176, tile = nb >> 3, w = nb & 7, src = (w >> 2) * FF + tile * 128 + (w & 3) * 32;
            tr_item(INF(27, l, DM * 2 * FF), 2 * FF, src, 32, kb * 64, (bf16_t*)(ws + WS_W2IN), DM, nb * 32, 0, scr, lane); continue; } r -= 2816;
        if (r < 1408) { const int kb = r / 32, nb = r % 32;
            tr_item(INF(28, l, FF * DM), DM, nb * 32, 32, kb * 64, (bf16_t*)(ws + WS_W2OUT), FF, nb * 32, 0, scr, lane); continue; } r -= 1408;
        if (r < 256) { const int kb = r / 8, nb = r % 8;
            tr_item(INF(14, l, 2048 * 256), 256, nb * 32, 32, kb * 64, (bf16_t*)(ws + WS_WC1), 2048, nb * 32, 0, scr, lane); continue; } r -= 256;
        if (r < 256) { const int kb = r / 8, nb = r % 8;
            tr_item(INF(17, l, 2048 * 256), 256, nb * 32, 32, kb * 64, (bf16_t*)(ws + WS_WC1 + MiB), 2048, nb * 32, 0, scr, lane); continue; } r -= 256;
        { const int kb = r / 32, nb = r % 32;
            tr_item(INF(20, l, DM * DM), DM, nb * 32, 32, kb * 64, (bf16_t*)(ws + WS_WMKV), DM, nb * 32, 0, scr, lane); }
    }
    {
        const float* gm = INF(9, l, DM);
        for (int m = C.gw; m < 512; m += C.NGW) {
            const f32x4* xr = (const f32x4*)((const float*)C.a->in[1] + (size_t)m * DM) + lane;
            f32x4 v[4]; float s = 0.f;
#pragma unroll
            for (int j = 0; j < 4; ++j) { v[j] = xr[64 * j]; s += (v[j].x * v[j].x + v[j].y * v[j].y) + (v[j].z * v[j].z + v[j].w * v[j].w); }
            const float rstd = rsqrtf(wave_sum(s) * (1.f / DM) + EPS);
            u32x2* o = (u32x2*)((bf16_t*)(ws + WS_MEMN) + (size_t)m * DM) + lane;
#pragma unroll
            for (int j = 0; j < 4; ++j) { const f32x4 gg = ((const f32x4*)gm)[lane + 64 * j]; u32x2 w; w.x = cvt_pk_bf16(v[j].x * rstd * gg.x, v[j].y * rstd * gg.y); w.y = cvt_pk_bf16(v[j].z * rstd * gg.z, v[j].w * rstd * gg.w); o[64 * j] = w; }
        }
    }
    {
        float* cb = (float*)(ws + WS_CBP) + (size_t)l * 64 * 256;
        for (int it = C.gw; it < 64; it += C.NGW) {
            const int kv = it >> 5, ch = it & 31;
            const float* pos = kv ? INF(13, l, 2048) : INF(12, l, 2048);
            const float* w1 = kv ? INF(17, l, 2048 * 256) : INF(14, l, 2048 * 256);
            float p[4] = {0.f, 0.f, 0.f, 0.f};
            for (int k = ch * 64; k < ch * 64 + 64; ++k) { const float pv = pos[k];
#pragma unroll
                for (int q = 0; q < 4; ++q) p[q] += pv * w1[(size_t)k * 256 + lane + 64 * q]; }
#pragma unroll
            for (int q = 0; q < 4; ++q) cb[(size_t)it * 256 + lane + 64 * q] = p[q];
        }
    }
}

__device__ __forceinline__ void rope_table(const Ctx& C) {
    const int* pos = (const int*)C.a->in[2];
    float* tab = (float*)(C.ws + WS_ROPE);
    const float invf[8] = {1.0f, 0.1939227432012558f, 0.03760603070259094f, 0.007292664609849453f, 0.0014142135623842478f, 0.00027424818836152554f, 5.318296098266728e-05f, 1.0313386155758053e-05f};
    for (int e = C.gw * 64 + C.lane; e < T_ * 8; e += C.NGW * 64) {
        const int tok = e >> 3, i = e & 7;
        float f = invf[0];
#pragma unroll
        for (int q = 1; q < 8; ++q) f = (i == q) ? invf[q] : f;
        const float ang = (float)pos[tok] * f;
        const double rev = (double)ang * 0.15915494309189535; const float fr = (float)(rev - floor(rev));
        tab[(size_t)tok * 16 + i] = __builtin_amdgcn_cosf(fr); tab[(size_t)tok * 16 + 8 + i] = __builtin_amdgcn_sinf(fr);
    }
}
__device__ __forceinline__ void prenorm_rows(const Ctx& C, const float* x, const float* g, bf16_t* h) {
    for (int m = C.gw; m < T_; m += C.NGW) {
        const f32x4* xr = (const f32x4*)(x + (size_t)m * DM) + C.lane;
        f32x4 v[4]; float s = 0.f;
#pragma unroll
        for (int j = 0; j < 4; ++j) { v[j] = xr[64 * j]; s += (v[j].x * v[j].x + v[j].y * v[j].y) + (v[j].z * v[j].z + v[j].w * v[j].w); }
        const float rstd = rsqrtf(wave_sum(s) * (1.f / DM) + EPS);
        u32x2* o = (u32x2*)(h + (size_t)m * DM) + C.lane;
#pragma unroll
        for (int j = 0; j < 4; ++j) { const f32x4 gg = ((const f32x4*)g)[C.lane + 64 * j]; u32x2 w; w.x = cvt_pk_bf16(v[j].x * rstd * gg.x, v[j].y * rstd * gg.y); w.y = cvt_pk_bf16(v[j].z * rstd * gg.z, v[j].w * rstd * gg.w); o[64 * j] = w; }
    }
}
__device__ __forceinline__ void norm_phase(const Ctx& C, int w0, int nw, const float* xin, float* xout, const bf16_t* y, bf16_t* h, const float* gpost, const float* gpre, float coef) {
    for (int m0 = w0; m0 < T_; m0 += 2 * nw) {
        f32x4 xv[2][4]; u32x2 yw[2][4];
#pragma unroll
        for (int r = 0; r < 2; ++r) { const int m = (m0 + r * nw < T_) ? m0 + r * nw : m0; const f32x4* xr = (const f32x4*)(xin + (size_t)m * DM) + C.lane; const u32x2* yr = (const u32x2*)(y + (size_t)m * DM) + C.lane;
#pragma unroll
            for (int j = 0; j < 4; ++j) { xv[r][j] = xr[64 * j]; yw[r][j] = yr[64 * j]; } }
#pragma unroll
        for (int r = 0; r < 2; ++r) {
            const int m = m0 + r * nw; if (m >= T_) break;
            f32x4 yv[4]; float s = 0.f;
#pragma unroll
            for (int j = 0; j < 4; ++j) { const u32x2 w = yw[r][j]; yv[j] = (f32x4){bf_lo(w.x), bf_hi(w.x), bf_lo(w.y), bf_hi(w.y)};
                s += (yv[j].x * yv[j].x + yv[j].y * yv[j].y) + (yv[j].z * yv[j].z + yv[j].w * yv[j].w); }
            const float rs = rsqrtf(wave_sum(s) * (1.f / DM) + EPS) * coef; float s2 = 0.f;
            f32x4* xo = (f32x4*)(xout + (size_t)m * DM) + C.lane;
#pragma unroll
            for (int j = 0; j < 4; ++j) { const f32x4 gg = ((const f32x4*)gpost)[C.lane + 64 * j]; xv[r][j] = xv[r][j] + yv[j] * gg * rs; xo[64 * j] = xv[r][j];
                s2 += (xv[r][j].x * xv[r][j].x + xv[r][j].y * xv[r][j].y) + (xv[r][j].z * xv[r][j].z + xv[r][j].w * xv[r][j].w); }
            if (gpre) {
                const float r2 = rsqrtf(wave_sum(s2) * (1.f / DM) + EPS);
                u32x2* o = (u32x2*)(h + (size_t)m * DM) + C.lane;
#pragma unroll
                for (int j = 0; j < 4; ++j) { const f32x4 gg = ((const f32x4*)gpre)[C.lane + 64 * j]; u32x2 w; w.x = cvt_pk_bf16(xv[r][j].x * r2 * gg.x, xv[r][j].y * r2 * gg.y); w.y = cvt_pk_bf16(xv[r][j].z * r2 * gg.z, xv[r][j].w * r2 * gg.w); o[64 * j] = w; }
            }
        }
    }
}
__device__ __forceinline__ void cb_reduce(const Ctx& C, int l) {
    const int e = C.gw * 64 + C.lane;
    if (e < 512) { const int kv = e >> 8, n = e & 255; const float* pp = (const float*)(C.ws + WS_CBP) + (size_t)l * 64 * 256 + (size_t)kv * 32 * 256 + n;
        float s = (kv ? INF(18, l, 256) : INF(15, l, 256))[n];
        for (int ch = 0; ch < 32; ++ch) s += pp[ch * 256];
        ((float*)(C.ws + WS_CB))[l * 512 + e] = s; }
}
__device__ __forceinline__ void memkv_ops(const Ctx& C, int w0, int nw) {
    const bf16_t* src = (const bf16_t*)(C.ws + WS_MKV); bf16_t* ko = (bf16_t*)(C.ws + WS_MEMK); bf16_t* vo = (bf16_t*)(C.ws + WS_MEMV);
    for (int e = w0 * 64 + C.lane; e < 512 * 1024; e += nw * 64) {
        const int mr = e >> 10, col = e & 1023, kv = col >> 9, hm = (col >> 7) & 3, d = col & 127, b = mr >> 8, m = mr & 255;
        const bf16_t v = src[e];
        if (kv == 0) ko[((size_t)((((b * 4 + hm) * 8 + (m >> 5)) * 8 + (d >> 4)) * 64 + pi32(m & 31) + 32 * ((d >> 3) & 1))) * 8 + (d & 7)] = v;
        else vo[((size_t)((((b * 4 + hm) * 16 + (m >> 4)) * 4 + (d >> 5)) * 64 + (d & 31) + 32 * ((m >> 3) & 1))) * 8 + (m & 7)] = v;
    }
}

__device__ __forceinline__ void prep_items(const Ctx& C, int l, int w0, int nw) {
    const bf16_t* P = (const bf16_t*)(C.ws + WS_R1); bf16_t* Y = (bf16_t*)(C.ws + WS_Y);
    const int lane = C.lane;
    {
        const float* cw = INF(11, l, 3 * 512);
        float w[3][8];
#pragma unroll
        for (int k = 0; k < 3; ++k)
#pragma unroll
            for (int e = 0; e < 8; ++e) w[k][e] = cw[k * 512 + lane * 8 + e];
        for (int it = w0; it < T_ / 8; it += nw) {
            const int tok0 = it * 8, s0 = tok0 & (S_ - 1);
            float c1[8], c2[8];
#pragma unroll
            for (int e = 0; e < 8; ++e) { c1[e] = 0.f; c2[e] = 0.f; }
            if (s0 > 0) {
#pragma unroll
                for (int back = 2; back >= 1; --back) {
                    const bf16_t* row = P + (size_t)(tok0 - back) * PP + lane * 8;
                    const u32x4 u = *(const u32x4*)row, cc = *(const u32x4*)(row + 1024);
                    float t[8] = {bf_lo(u.x) * bf_lo(cc.x), bf_hi(u.x) * bf_hi(cc.x), bf_lo(u.y) * bf_lo(cc.y), bf_hi(u.y) * bf_hi(cc.y), bf_lo(u.z) * bf_lo(cc.z), bf_hi(u.z) * bf_hi(cc.z), bf_lo(u.w) * bf_lo(cc.w), bf_hi(u.w) * bf_hi(cc.w)};
#pragma unroll
                    for (int e = 0; e < 8; ++e) { if (back == 2) c2[e] = t[e]; else c1[e] = t[e]; }
                }
            }
#pragma unroll
            for (int tt = 0; tt < 8; ++tt) {
                const bf16_t* row = P + (size_t)(tok0 + tt) * PP + lane * 8;
                const u32x4 u = *(const u32x4*)row, bb = *(const u32x4*)(row + 512), cc = *(const u32x4*)(row + 1024);
                const float c0[8] = {bf_lo(u.x) * bf_lo(cc.x), bf_hi(u.x) * bf_hi(cc.x), bf_lo(u.y) * bf_lo(cc.y), bf_hi(u.y) * bf_hi(cc.y), bf_lo(u.z) * bf_lo(cc.z), bf_hi(u.z) * bf_hi(cc.z), bf_lo(u.w) * bf_lo(cc.w), bf_hi(u.w) * bf_hi(cc.w)};
                const float bv[8] = {bf_lo(bb.x), bf_hi(bb.x), bf_lo(bb.y), bf_hi(bb.y), bf_lo(bb.z), bf_hi(bb.z), bf_lo(bb.w), bf_hi(bb.w)};
                float o[8];
#pragma unroll
                for (int e = 0; e < 8; ++e) { o[e] = bv[e] * (w[0][e] * c2[e] + w[1][e] * c1[e] + w[2][e] * c0[e]); c2[e] = c1[e]; c1[e] = c0[e]; }
                u32x4 ov; ov.x = cvt_pk_bf16(o[0], o[1]); ov.y = cvt_pk_bf16(o[2], o[3]); ov.z = cvt_pk_bf16(o[4], o[5]); ov.w = cvt_pk_bf16(o[6], o[7]);
                *(u32x4*)(Y + (size_t)(tok0 + tt) * YP + lane * 8) = ov;
            }
        }
    }
    {
        const float* rope = (const float*)(C.ws + WS_ROPE);
        LAS bf16_t* vt = (LAS bf16_t*)(C.lds + C.wave * 4608);
        const int hi = lane >> 5, dl = lane & 31;
        for (int it = w0; it < 4 * 512; it += nw) {
            const int bg = it >> 9, tile = it & 511, b = bg >> 1, g = bg & 1;
            const size_t tokb = (size_t)b * S_ + 32 * tile;
#pragma unroll
            for (int which = 0; which < 2; ++which) {
                const int kc = PC_KV + (2 + 2 * which) * 128 + g * 64, vc = kc + 128;
                bf16_t* kop = (bf16_t*)(C.ws + (which ? WS_KWIN : WS_KSLC)); bf16_t* vop = (bf16_t*)(C.ws + (which ? WS_VWIN : WS_VSLC));
#pragma unroll
                for (int q = 0; q < 4; ++q) {
                    const int r = (lane >> 3) + 8 * q, c = lane & 7;
                    const bf16_t* row = P + (tokb + r) * PP;
                    u32x4 kv = *(const u32x4*)(row + kc + 8 * c);
                    if (c < 2) {
                        const u32x4 pv = *(const u32x4*)(row + kc + 8 * (c ^ 1));
                        const float* rt = rope + (tokb + r) * 16;
                        const f32x4 ca = *(const f32x4*)rt, cb2 = *(const f32x4*)(rt + 4), sa = *(const f32x4*)(rt + 8), sb = *(const f32x4*)(rt + 12);
                        const float cs[8] = {ca.x, ca.y, ca.z, ca.w, cb2.x, cb2.y, cb2.z, cb2.w}, sn[8] = {sa.x, sa.y, sa.z, sa.w, sb.x, sb.y, sb.z, sb.w};
                        const float mv[8] = {bf_lo(kv.x), bf_hi(kv.x), bf_lo(kv.y), bf_hi(kv.y), bf_lo(kv.z), bf_hi(kv.z), bf_lo(kv.w), bf_hi(kv.w)};
                        const float pp[8] = {bf_lo(pv.x), bf_hi(pv.x), bf_lo(pv.y), bf_hi(pv.y), bf_lo(pv.z), bf_hi(pv.z), bf_lo(pv.w), bf_hi(pv.w)};
                        const float sg = (c == 0) ? -1.f : 1.f; float o[8];
#pragma unroll
                        for (int e = 0; e < 8; ++e) o[e] = mv[e] * cs[e] + sg * pp[e] * sn[e];
                        kv.x = cvt_pk_bf16(o[0], o[1]); kv.y = cvt_pk_bf16(o[2], o[3]); kv.z = cvt_pk_bf16(o[4], o[5]); kv.w = cvt_pk_bf16(o[6], o[7]);
                    }
                    if (which == 0)
                        *(u32x4*)(kop + ((size_t)(((bg * 512 + tile) * 2 + ((r >> 2) & 1)) * 2 + (c >> 2)) * 64 + ((r >> 3) * 4 + (r & 3)) + 16 * (c & 3)) * 8) = kv;
                    else
                        *(u32x4*)(kop + ((size_t)((bg * 512 + tile) * 4 + (c >> 1)) * 64 + pi32(r) + 32 * (c & 1)) * 8) = kv;
                    const u32x4 vv = *(const u32x4*)(row + vc + 8 * c);
                    *(LAS u32x4*)(vt + r * 72 + 8 * c) = vv;
                }
                LDS_WAIT();
#pragma unroll
                for (int o4 = 0; o4 < 4; ++o4) {
                    if (which == 0) {
                        const LAS bf16_t* sp = vt + (8 * (lane >> 4)) * 72 + 16 * o4 + (lane & 15);
                        u32x4 o; o.x = (unsigned)sp[0] | ((unsigned)sp[72] << 16); o.y = (unsigned)sp[144] | ((unsigned)sp[216] << 16); o.z = (unsigned)sp[288] | ((unsigned)sp[360] << 16); o.w = (unsigned)sp[432] | ((unsigned)sp[504] << 16);
                        *(u32x4*)(vop + ((size_t)((bg * 512 + tile) * 4 + o4) * 64 + lane) * 8) = o;
                        continue;
                    }
                    const int ks = o4 >> 1, dt = o4 & 1;
                    const LAS bf16_t* sp = vt + (16 * ks + 8 * hi) * 72 + 32 * dt + dl;
                    u32x4 o; o.x = (unsigned)sp[0] | ((unsigned)sp[72] << 16); o.y = (unsigned)sp[144] | ((unsigned)sp[216] << 16); o.z = (unsigned)sp[288] | ((unsigned)sp[360] << 16); o.w = (unsigned)sp[432] | ((unsigned)sp[504] << 16);
                    *(u32x4*)(vop + ((size_t)((bg * 1024 + 2 * tile + ks) * 2 + dt) * 64 + lane) * 8) = o;
                }
                LDS_WAIT();
            }
        }
    }
}

__device__ __forceinline__ void cmp_stage2(const Ctx& C, int l) {
    const int bxx = C.gw / NWAVES, kv = bxx & 1, wi = bxx >> 1, nwg2 = (C.G + 1 - kv) >> 1;
    const float* w2 = kv ? INF(19, l, 256 * 64) : INF(16, l, 256 * 64);
    LAS float* ws2 = (LAS float*)C.lds;
    for (int e = C.tid; e < 256 * 64 / 4; e += NWAVES * 64) ((LAS f32x4*)ws2)[e] = ((const f32x4*)w2)[e];
    __syncthreads();
    const bf16_t* hid = (const bf16_t*)(C.ws + WS_CMPP) + (size_t)kv * 4096 * 256;
    const float* cbias = (const float*)(C.ws + WS_CB) + l * 512 + kv * 256;
    bf16_t* ko = (bf16_t*)(C.ws + WS_KCMP); bf16_t* vo = (bf16_t*)(C.ws + WS_VCMP);
    const int d = C.lane;
    for (int row = wi * NWAVES + C.wave; row < 4096; row += nwg2 * NWAVES) {
        asm volatile("" ::: "memory");
        const u32x2 hv = *((const u32x2*)(hid + (size_t)row * 256) + C.lane), hw = *((const u32x2*)(hid + (size_t)(row + 8192) * 256) + C.lane);
        const f32x4 cbv = *((const f32x4*)cbias + C.lane);
        const float h0 = gelu_tanh(bf_lo(hv.x) + bf_lo(hw.x) + cbv.x), h1 = gelu_tanh(bf_hi(hv.x) + bf_hi(hw.x) + cbv.y), h2 = gelu_tanh(bf_lo(hv.y) + bf_lo(hw.y) + cbv.z), h3 = gelu_tanh(bf_hi(hv.y) + bf_hi(hw.y) + cbv.w);
        float acc = 0.f;
#pragma unroll 4
        for (int k = 0; k < 64; ++k) {
            const float a0 = __int_as_float(__builtin_amdgcn_readlane(__float_as_int(h0), k)), a1 = __int_as_float(__builtin_amdgcn_readlane(__float_as_int(h1), k));
            const float a2 = __int_as_float(__builtin_amdgcn_readlane(__float_as_int(h2), k)), a3 = __int_as_float(__builtin_amdgcn_readlane(__float_as_int(h3), k));
            acc += a0 * ws2[(4 * k + 0) * 64 + d]; acc += a1 * ws2[(4 * k + 1) * 64 + d]; acc += a2 * ws2[(4 * k + 2) * 64 + d]; acc += a3 * ws2[(4 * k + 3) * 64 + d];
        }
        const int bg = row >> 10, n = row & 1023;
        if (n == 1023) acc = 0.f;
        const bf16_t o = (bf16_t)(cvt_pk_bf16(acc, 0.f) & 0xffffu);
        if (kv == 0) ko[((size_t)((bg * 32 + (n >> 5)) * 4 + (d >> 4)) * 64 + pi32(n & 31) + 32 * ((d >> 3) & 1)) * 8 + (d & 7)] = o;
        else vo[((size_t)((bg * 64 + (n >> 4)) * 2 + (d >> 5)) * 64 + (d & 31) + 32 * ((n >> 3) & 1)) * 8 + (n & 7)] = o;
    }
    __syncthreads();
}

__device__ __forceinline__ float xhalf_max(float v) { const auto r = __builtin_amdgcn_permlane32_swap(__float_as_uint(v), __float_as_uint(v), false, false); return fmaxf(__uint_as_float(r[0]), __uint_as_float(r[1])); }
__device__ __forceinline__ float xhalf_sum(float v) { const auto r = __builtin_amdgcn_permlane32_swap(__float_as_uint(v), __float_as_uint(v), false, false); return __uint_as_float(r[0]) + __uint_as_float(r[1]); }
__device__ __forceinline__ f32x16 mfma32(bf16x8 a, bf16x8 b, f32x16 c) { return __builtin_amdgcn_mfma_f32_32x32x16_bf16(a, b, c, 0, 0, 0); }
__device__ __forceinline__ float dpp_xor1(float v) { return __int_as_float(__builtin_amdgcn_update_dpp(0, __float_as_int(v), 0xB1, 0xF, 0xF, true)); }
__device__ __forceinline__ float dpp_xor2(float v) { return __int_as_float(__builtin_amdgcn_update_dpp(0, __float_as_int(v), 0x4E, 0xF, 0xF, true)); }
__device__ __forceinline__ bf16x8 pack_p(const float* p) { u32x4 w; w.x = cvt_pk_bf16(p[0], p[1]); w.y = cvt_pk_bf16(p[2], p[3]); w.z = cvt_pk_bf16(p[4], p[5]); w.w = cvt_pk_bf16(p[6], p[7]); return __builtin_bit_cast(bf16x8, w); }
__device__ __forceinline__ bf16x8 scale_q(u32x4 v, float s) { u32x4 w; w.x = cvt_pk_bf16(bf_lo(v.x) * s, bf_hi(v.x) * s); w.y = cvt_pk_bf16(bf_lo(v.y) * s, bf_hi(v.y) * s); w.z = cvt_pk_bf16(bf_lo(v.z) * s, bf_hi(v.z) * s); w.w = cvt_pk_bf16(bf_lo(v.w) * s, bf_hi(v.w) * s); return __builtin_bit_cast(bf16x8, w); }
#define KREL(i, hi) (8 * (hi) + (i) + (((i) >= 8) ? 8 : 0))

__device__ __forceinline__ void flash_load(const bf16x8* kp, const bf16x8* vp, bf16x8 (&kf)[4], bf16x8 (&vf)[4]) {
#pragma unroll
    for (int s = 0; s < 4; ++s) kf[s] = kp[s * 64];
#pragma unroll
    for (int s = 0; s < 4; ++s) vf[s] = vp[s * 64];
    __builtin_amdgcn_sched_barrier(0);
}
__device__ __forceinline__ void flash_compute(bool domask, const bf16x8 (&kf)[4], const bf16x8 (&vf)[4], const bf16x8 (&q)[4], int x0, unsigned span, float& m, float& l, f32x16 (&O)[2]) {
    f32x16 sc;
#pragma unroll
    for (int i = 0; i < 16; ++i) sc[i] = 0.f;
#pragma unroll
    for (int s = 0; s < 4; ++s) sc = mfma32(kf[s], q[s], sc);
    if (domask) {
#pragma unroll
        for (int i = 0; i < 16; ++i) sc[i] = ((unsigned)(x0 + i + (i >= 8 ? 8 : 0)) <= span) ? sc[i] : -1e30f;
    }
    const float a0 = fmaxf(fmaxf(sc[0], sc[1]), sc[2]), a1 = fmaxf(fmaxf(sc[3], sc[4]), sc[5]), a2 = fmaxf(fmaxf(sc[6], sc[7]), sc[8]), a3 = fmaxf(fmaxf(sc[9], sc[10]), sc[11]), a4 = fmaxf(fmaxf(sc[12], sc[13]), sc[14]);
    float mx = fmaxf(fmaxf(fmaxf(a0, a1), fmaxf(a2, a3)), fmaxf(a4, sc[15]));
    mx = xhalf_max(mx);
    const float mn = fmaxf(m, mx);
    if (__ballot(mn > m) != 0ull) {
        const float alpha = ex2(m - mn); l *= alpha; O[0] = O[0] * alpha; O[1] = O[1] * alpha;
    }
    m = mn;
    const float msub = (mn < -1e29f) ? 0.f : mn;
    const f32x16 d = sc - msub;
    float p[16], ps = 0.f;
#pragma unroll
    for (int i = 0; i < 16; ++i) { p[i] = ex2(d[i]); ps += p[i]; }
    l += ps;
    const bf16x8 pb0 = pack_p(p), pb1 = pack_p(p + 8);
    O[0] = mfma32(vf[0], pb0, O[0]); O[1] = mfma32(vf[1], pb0, O[1]);
    O[0] = mfma32(vf[2], pb1, O[0]); O[1] = mfma32(vf[3], pb1, O[1]);
}
template <int MODE> __device__ __forceinline__ void flash_desc(int s, const LAS unsigned* list, int base, int t, int t0, int qi, int hi, int& tile, int& x0, unsigned& span, int& vm) {
    if constexpr (MODE == 0) {
        const unsigned e = (unsigned)__builtin_amdgcn_readfirstlane((int)list[s >> 1]);
        tile = 2 * (int)(e & 0xffffu) + (s & 1);
        const bool my = ((e >> 16) >> qi) & 1u; const int up = my ? (t - 32 * tile) : -1;
        x0 = up < 0 ? 64 : 8 * hi; span = up < 0 ? 0u : (unsigned)up;
        vm = (32 * tile + 31 <= t0) ? (((e >> 16) == 0xFFu) ? 0 : 1) : 2;
    } else {
        tile = base + s; x0 = 8 * hi - (t - 511 - 32 * tile); span = 511u;
        vm = (32 * tile + 31 <= t0 && 32 * tile >= t0 + 7 - 511) ? 0 : 2;
    }
}
template <int MODE> __device__ __forceinline__ void flash_run(const bf16x8* kb, const bf16x8* vb, const bf16x8 (&q)[4], int nsteps, const LAS unsigned* list, int base, int t, int t0, int qi, int hi, float& m, float& l, f32x16 (&O)[2]) {
    if (nsteps <= 0) return;
    bf16x8 kA[4], vA[4], kB[4], vB[4], kC[4], vC[4]; int x0A, x0B, x0C, vmA, vmB, vmC; unsigned spA, spB, spC;
#define FR_LOAD(S, KF, VF, X0, SP, VM) do { int tile_; const int sn_ = ((S) < nsteps) ? (S) : nsteps - 1; flash_desc<MODE>(sn_, list, base, t, t0, qi, hi, tile_, X0, SP, VM); \
        flash_load(kb + (size_t)tile_ * 256, vb + (size_t)tile_ * 256, KF, VF); } while (0)
    FR_LOAD(0, kA, vA, x0A, spA, vmA); FR_LOAD(1, kB, vB, x0B, spB, vmB);
#pragma unroll 1
    for (int s = 0; s < nsteps; s += 3) {
        FR_LOAD(s + 2, kC, vC, x0C, spC, vmC); flash_compute(vmA != 0, kA, vA, q, x0A, spA, m, l, O); if (s + 1 >= nsteps) break;
        FR_LOAD(s + 3, kA, vA, x0A, spA, vmA); flash_compute(vmB != 0, kB, vB, q, x0B, spB, m, l, O); if (s + 2 >= nsteps) break;
        FR_LOAD(s + 4, kB, vB, x0B, spB, vmB); flash_compute(vmC != 0, kC, vC, q, x0C, spC, m, l, O);
    }
#undef FR_LOAD
}

typedef float f32x4v __attribute__((ext_vector_type(4)));
__device__ __forceinline__ f32x4v mfma16(bf16x8 a, bf16x8 b, f32x4v c) { return __builtin_amdgcn_mfma_f32_16x16x32_bf16(a, b, c, 0, 0, 0); }
__device__ __forceinline__ float xq_max(float v) { const auto r = __builtin_amdgcn_permlane16_swap(__float_as_uint(v), __float_as_uint(v), false, false); return xhalf_max(fmaxf(__uint_as_float(r[0]), __uint_as_float(r[1]))); }
__device__ __forceinline__ float xq_sum(float v) { const auto r = __builtin_amdgcn_permlane16_swap(__float_as_uint(v), __float_as_uint(v), false, false); return xhalf_sum(__uint_as_float(r[0]) + __uint_as_float(r[1])); }
__device__ __forceinline__ void flash16_load(const bf16x8* kp, const bf16x8* vp, bf16x8 (&kf)[4], bf16x8 (&vf)[4]) {
#pragma unroll
    for (int s = 0; s < 4; ++s) kf[s] = kp[s * 64];
#pragma unroll
    for (int s = 0; s < 4; ++s) vf[s] = vp[s * 64];
    __builtin_amdgcn_sched_barrier(0);
}
__device__ __forceinline__ void flash16_compute(bool domask, const bf16x8 (&kf)[4], const bf16x8 (&vf)[4], const bf16x8 (&q)[2], int x0, unsigned span, float& m, float& l, f32x4v (&O)[4]) {
    f32x4v s0 = {0.f, 0.f, 0.f, 0.f}, s1 = {0.f, 0.f, 0.f, 0.f};
    s0 = mfma16(kf[0], q[0], s0); s1 = mfma16(kf[2], q[0], s1);
    s0 = mfma16(kf[1], q[1], s0); s1 = mfma16(kf[3], q[1], s1);
    float sc[8] = {s0[0], s0[1], s0[2], s0[3], s1[0], s1[1], s1[2], s1[3]};
    if (domask) {
#pragma unroll
        for (int j = 0; j < 8; ++j) sc[j] = ((unsigned)(x0 + j) <= span) ? sc[j] : -1e30f;
    }
    float mx = fmaxf(fmaxf(fmaxf(sc[0], sc[1]), fmaxf(sc[2], sc[3])), fmaxf(fmaxf(sc[4], sc[5]), fmaxf(sc[6], sc[7])));
    mx = xq_max(mx);
    const float mn = fmaxf(m, mx);
    if (__ballot(mn > m) != 0ull) {
        const float alpha = ex2(m - mn); l *= alpha;
#pragma unroll
        for (int dt = 0; dt < 4; ++dt) O[dt] = O[dt] * alpha;
    }
    m = mn;
    const float msub = (mn < -1e29f) ? 0.f : mn;
    float p[8], ps = 0.f;
#pragma unroll
    for (int j = 0; j < 8; ++j) { p[j] = ex2(sc[j] - msub); ps += p[j]; }
    l += ps;
    const bf16x8 pb = pack_p(p);
#pragma unroll
    for (int dt = 0; dt < 4; ++dt) O[dt] = mfma16(vf[dt], pb, O[dt]);
}
__device__ __forceinline__ unsigned flash16_entry(int s, const LAS unsigned* list) {
    const unsigned e = (unsigned)__builtin_amdgcn_readfirstlane((int)list[s >> 1]);
    return (e & 0xffff0000u) | (2u * (e & 0xffffu) + (unsigned)(s & 1));
}
__device__ __forceinline__ void flash16_run(const bf16x8* kb, const bf16x8* vb, const bf16x8 (&qa)[2], const bf16x8 (&qb)[2], int nsteps, const LAS unsigned* list, int tq, int t0, int qi4, int fq,
                                            float& ma, float& la, f32x4v (&Oa)[4], float& mb, float& lb, f32x4v (&Ob)[4]) {
    if (nsteps <= 0) return;
    bf16x8 kA[4], vA[4], kB[4], vB[4], kC[4], vC[4]; unsigned eA, eB, eC;
#define F16_LOAD(S, KF, VF, E) do { const int sn_ = ((S) < nsteps) ? (S) : nsteps - 1; E = flash16_entry(sn_, list); const size_t go_ = (size_t)(E & 0xffffu) * 256; \
        flash16_load(kb + go_, vb + go_, KF, VF); } while (0)
#define F16_COMP(KF, VF, E) do { const int grp_ = (int)(E & 0xffffu); const unsigned na_ = (E >> 16) & 0xFu, nb_ = E >> 20; const bool past_ = 32 * grp_ + 31 <= t0; \
        if (na_) { const int up_ = ((na_ >> qi4) & 1u) ? (tq - 32 * grp_) : -1; flash16_compute(!(past_ && na_ == 0xFu), KF, VF, qa, up_ < 0 ? 64 : 8 * fq, up_ < 0 ? 0u : (unsigned)up_, ma, la, Oa); } \
        if (nb_) { const int up_ = ((nb_ >> qi4) & 1u) ? (tq + 4 - 32 * grp_) : -1; flash16_compute(!(past_ && nb_ == 0xFu), KF, VF, qb, up_ < 0 ? 64 : 8 * fq, up_ < 0 ? 0u : (unsigned)up_, mb, lb, Ob); } } while (0)
    F16_LOAD(0, kA, vA, eA); F16_LOAD(1, kB, vB, eB);
#pragma unroll 1
    for (int s = 0; s < nsteps; s += 3) {
        F16_LOAD(s + 2, kC, vC, eC); F16_COMP(kA, vA, eA); if (s + 1 >= nsteps) break;
        F16_LOAD(s + 3, kA, vA, eA); F16_COMP(kB, vB, eB); if (s + 2 >= nsteps) break;
        F16_LOAD(s + 4, kB, vB, eB); F16_COMP(kC, vC, eC);
    }
#undef F16_LOAD
#undef F16_COMP
}

__device__ __forceinline__ unsigned wave_max_u32(unsigned v) {
#pragma unroll
    for (int o = 1; o < 16; o <<= 1) { const unsigned t = (unsigned)__shfl_xor((int)v, o); v = v > t ? v : t; }
    { const auto r = __builtin_amdgcn_permlane16_swap(v, v, false, false); v = r[0] > r[1] ? r[0] : r[1]; }
    { const auto r = __builtin_amdgcn_permlane32_swap(v, v, false, false); v = r[0] > r[1] ? r[0] : r[1]; }
    return v;
}

__device__ __forceinline__ void nsa_tile(const Ctx& C, int b, int g, int t0) {
    const bf16_t* P = (const bf16_t*)(C.ws + WS_R1); bf16_t* Y = (bf16_t*)(C.ws + WS_Y);
    int lane_ = C.lane; asm volatile("" : "+v"(lane_));
    const int lane = lane_, r = lane & 31, hi = lane >> 5, qi = r >> 2, h = r & 3, head = g * 4 + h, bg = b * 2 + g;
    const int t = t0 + qi; const size_t tok = (size_t)b * S_ + t;
    LAS float* imp = (LAS float*)(C.lds + C.wave * 16640);
    LAS float* ost = (LAS float*)(C.lds + C.wave * 16640 + 8448) + lane;
    const float QS = 0.18033688011112042f;
    bf16x8 qf[4];
    {
        const bf16_t* qp = P + tok * PP + PC_Q + head * 64;
#pragma unroll
        for (int s = 0; s < 4; ++s) qf[s] = scale_q(*(const u32x4*)(qp + 16 * s + 8 * hi), QS);
    }
    const bf16_t* gp = P + tok * PP + PC_NG + head * 3;
    const float gc = sigm(bf1(gp[0])), gs = sigm(bf1(gp[1])), gw = sigm(bf1(gp[2]));

    const int cur = t0 >> 6;
    {
        const int nvq = (t >= 31) ? ((t - 31) >> 4) + 1 : 0;
        const int tl = t0 + 7, nvmax = (tl >= 31) ? ((tl - 31) >> 4) + 1 : 0, ntile = (nvmax + 31) >> 5;
        const bf16x8* kb = (const bf16x8*)(C.ws + WS_KCMP) + (size_t)bg * 32 * 4 * 64 + lane;
        const bf16x8* vb = (const bf16x8*)(C.ws + WS_VCMP) + (size_t)bg * 64 * 2 * 64 + lane;
        float m1 = -1e30f, l1 = 0.f;
#define CMP_P1(KF, KT) do { \
            f32x16 sc; _Pragma("unroll") for (int i = 0; i < 16; ++i) sc[i] = 0.f; \
            _Pragma("unroll") for (int s = 0; s < 4; ++s) sc = mfma32(KF[s], qf[s], sc); \
            const int up = nvq - 1 - 32 * (KT); const int x0 = up < 0 ? 64 : 8 * hi; const unsigned span = up < 0 ? 0u : (unsigned)up; \
            float mx = -1e30f; bool ok[16]; \
            _Pragma("unroll") for (int i = 0; i < 16; ++i) { ok[i] = (unsigned)(x0 + i + (i >= 8 ? 8 : 0)) <= span; sc[i] = ok[i] ? sc[i] : -1e30f; mx = fmaxf(mx, sc[i]); } \
            mx = xhalf_max(mx); \
            const float mn = fmaxf(m1, mx); float ps = 0.f; \
            _Pragma("unroll") for (int i = 0; i < 16; ++i) ps += ok[i] ? ex2(sc[i] - mn) : 0.f; \
            l1 = l1 * ex2(m1 - mn) + ps; m1 = mn; } while (0)
        if (ntile > 0) {
            bf16x8 kA[4], kB[4], kC[4], kD[4];
#define CMP_LDK(KF, KT) do { const int kn_ = ((KT) < ntile) ? (KT) : ntile - 1; _Pragma("unroll") for (int s = 0; s < 4; ++s) KF[s] = kb[kn_ * 256 + s * 64]; } while (0)
            CMP_LDK(kA, 0); CMP_LDK(kB, 1); CMP_LDK(kC, 2);
#pragma unroll 1
            for (int kt = 0; kt < ntile; kt += 4) {
                CMP_LDK(kD, kt + 3); __builtin_amdgcn_sched_barrier(0); CMP_P1(kA, kt);     if (kt + 1 >= ntile) break;
                CMP_LDK(kA, kt + 4); __builtin_amdgcn_sched_barrier(0); CMP_P1(kB, kt + 1); if (kt + 2 >= ntile) break;
                CMP_LDK(kB, kt + 5); __builtin_amdgcn_sched_barrier(0); CMP_P1(kC, kt + 2); if (kt + 3 >= ntile) break;
                CMP_LDK(kC, kt + 6); __builtin_amdgcn_sched_barrier(0); CMP_P1(kD, kt + 3);
            }
        }
#undef CMP_P1
        l1 = xhalf_sum(l1);
        const float inv = 1.f / fmaxf(l1, 1e-30f);
        for (int e = lane; e < 8 * 264; e += 64) imp[e] = 0.f;
        LDS_WAIT();
        f32x16 O[2];
#pragma unroll
        for (int i = 0; i < 16; ++i) { O[0][i] = 0.f; O[1][i] = 0.f; }
#define CMP_P2(KF, VF, KT) do { \
            f32x16 sc; _Pragma("unroll") for (int i = 0; i < 16; ++i) sc[i] = 0.f; \
            _Pragma("unroll") for (int s = 0; s < 4; ++s) sc = mfma32(KF[s], qf[s], sc); \
            const int up = nvq - 1 - 32 * (KT); const int x0 = up < 0 ? 64 : 8 * hi; const unsigned span = up < 0 ? 0u : (unsigned)up; \
            float p[16]; \
            _Pragma("unroll") for (int i = 0; i < 16; ++i) { const bool ok = (unsigned)(x0 + i + (i >= 8 ? 8 : 0)) <= span; p[i] = ok ? ex2(sc[i] - m1) * inv : 0.f; } \
            _Pragma("unroll") for (int rr = 0; rr < 2; ++rr) { \
                const float* q8 = p + 8 * rr; \
                float a = q8[0] + q8[1] + q8[2] + 0.5f * q8[3], bq = 0.5f * q8[3] + q8[4] + q8[5] + q8[6] + 0.5f * q8[7], cq = 0.5f * q8[7]; \
                a += dpp_xor1(a); a += dpp_xor2(a); bq += dpp_xor1(bq); bq += dpp_xor2(bq); cq += dpp_xor1(cq); cq += dpp_xor2(cq); \
                _Pragma("unroll") for (int hh = 0; hh < 2; ++hh)     \
                if (h == 0 && hi == hh) { LAS float* ip = imp + qi * 264 + 8 * (KT) + 2 * hi + 4 * rr; \
                    __hip_atomic_fetch_add(ip, a, __ATOMIC_RELAXED, __HIP_MEMORY_SCOPE_WORKGROUP); __hip_atomic_fetch_add(ip + 1, bq, __ATOMIC_RELAXED, __HIP_MEMORY_SCOPE_WORKGROUP); \
                    __hip_atomic_fetch_add(ip + 2, cq, __ATOMIC_RELAXED, __HIP_MEMORY_SCOPE_WORKGROUP); } \
            } \
            const bf16x8 pb0 = pack_p(p), pb1 = pack_p(p + 8); \
            O[0] = mfma32(VF[0], pb0, O[0]); O[1] = mfma32(VF[1], pb0, O[1]); \
            O[0] = mfma32(VF[2], pb1, O[0]); O[1] = mfma32(VF[3], pb1, O[1]); } while (0)
        if (ntile > 0) {
            bf16x8 kA[4], kB[4], kC[4], vA[4];
#define CMP_LDV(KT) do { _Pragma("unroll") for (int s = 0; s < 4; ++s) vA[s] = vb[(KT) * 256 + s * 64]; } while (0)
            CMP_LDK(kA, 0); CMP_LDK(kB, 1);
#pragma unroll 1
            for (int kt = 0; kt < ntile; kt += 3) {
                CMP_LDK(kC, kt + 2); CMP_LDV(kt);     __builtin_amdgcn_sched_barrier(0); CMP_P2(kA, vA, kt);     if (kt + 1 >= ntile) break;
                CMP_LDK(kA, kt + 3); CMP_LDV(kt + 1); __builtin_amdgcn_sched_barrier(0); CMP_P2(kB, vA, kt + 1); if (kt + 2 >= ntile) break;
                CMP_LDK(kB, kt + 4); CMP_LDV(kt + 2); __builtin_amdgcn_sched_barrier(0); CMP_P2(kC, vA, kt + 2);
            }
#undef CMP_LDV
#undef CMP_LDK
        }
#undef CMP_P2
#pragma unroll
        for (int i = 0; i < 16; ++i) { ost[i * 64] = gc * O[0][i]; ost[(16 + i) * 64] = gc * O[1][i]; }
        LDS_WAIT();
    }

    unsigned bmv[4];
    if (cur <= 15) {
#pragma unroll
        for (int c = 0; c < 4; ++c) bmv[c] = (lane + 64 * c <= cur) ? 0xFFu : 0u;
    } else {
        unsigned key[8][4];
#pragma unroll
        for (int q2 = 0; q2 < 8; ++q2)
#pragma unroll
            for (int c = 0; c < 4; ++c) { const int j = lane + 64 * c; const bool cand = (j >= 1) && (j < cur - 1); const float v = imp[q2 * 264 + j];
                key[q2][c] = cand ? ((__float_as_uint(v) & 0xFFFFFF00u) | (unsigned)(255 - j)) : 0u; }
#pragma unroll
        for (int c = 0; c < 4; ++c) bmv[c] = 0u;
#pragma unroll 1
        for (int round = 0; round < 13; ++round) {
#pragma unroll
            for (int q2 = 0; q2 < 8; ++q2) {
                unsigned mx = key[q2][0]; mx = mx > key[q2][1] ? mx : key[q2][1]; mx = mx > key[q2][2] ? mx : key[q2][2]; mx = mx > key[q2][3] ? mx : key[q2][3];
                const unsigned w = wave_max_u32(mx);
#pragma unroll
                for (int c = 0; c < 4; ++c) { const bool win = (key[q2][c] == w) && (w != 0u); key[q2][c] = win ? 0u : key[q2][c]; bmv[c] |= win ? (1u << q2) : 0u; }
            }
        }
#pragma unroll
        for (int c = 0; c < 4; ++c) { const int j = lane + 64 * c; if (j == 0 || j == cur || j == cur - 1) bmv[c] = 0xFFu; }
    }

    {
        LAS unsigned* list = (LAS unsigned*)imp;
        LAS float* ostb = (LAS float*)(C.lds + C.wave * 16640 + 8448);
        const int q16 = lane & 15, fq = lane >> 4, qi4 = q16 >> 2, head4 = g * 4 + (q16 & 3);
        const bf16x8* kb = (const bf16x8*)(C.ws + WS_KSLC) + (size_t)bg * 512 * 256 + lane;
        const bf16x8* vb = (const bf16x8*)(C.ws + WS_VSLC) + (size_t)bg * 512 * 256 + lane;
        int nblk = 0;
#pragma unroll
        for (int c = 0; c < 4; ++c) {
            const unsigned long long mk = __ballot(bmv[c] != 0u);
            const int pos = nblk + (int)__builtin_amdgcn_mbcnt_hi((unsigned)(mk >> 32), __builtin_amdgcn_mbcnt_lo((unsigned)mk, 0u));
            if (bmv[c] != 0u) list[pos] = (unsigned)(lane + 64 * c) | (bmv[c] << 16);
            nblk += __builtin_popcountll(mk);
        }
        LDS_WAIT();
        const int tq = t0 + qi4;
        bf16x8 q16f[2][2]; float gs4[2];
#pragma unroll
        for (int sub = 0; sub < 2; ++sub) {
            const size_t tok4 = (size_t)b * S_ + tq + 4 * sub;
            const bf16_t* qp = P + tok4 * PP + PC_Q + head4 * 64;
            q16f[sub][1] = scale_q(*(const u32x4*)(qp + 32 + 8 * fq), QS);
            const u32x4 mv4 = *(const u32x4*)(qp + 8 * fq), pv4 = *(const u32x4*)(qp + 8 * ((fq ^ 1) & 1));
            const float* rt = (const float*)(C.ws + WS_ROPE) + tok4 * 16;
            const f32x4 ca = *(const f32x4*)rt, cb2 = *(const f32x4*)(rt + 4), sa = *(const f32x4*)(rt + 8), sb = *(const f32x4*)(rt + 12);
            const float cs[8] = {ca.x, ca.y, ca.z, ca.w, cb2.x, cb2.y, cb2.z, cb2.w}, sn[8] = {sa.x, sa.y, sa.z, sa.w, sb.x, sb.y, sb.z, sb.w};
            const float mv[8] = {bf_lo(mv4.x), bf_hi(mv4.x), bf_lo(mv4.y), bf_hi(mv4.y), bf_lo(mv4.z), bf_hi(mv4.z), bf_lo(mv4.w), bf_hi(mv4.w)};
            const float pp[8] = {bf_lo(pv4.x), bf_hi(pv4.x), bf_lo(pv4.y), bf_hi(pv4.y), bf_lo(pv4.z), bf_hi(pv4.z), bf_lo(pv4.w), bf_hi(pv4.w)};
            const bool roped = fq < 2; const float sg = (fq == 0) ? -1.f : 1.f; float o[8];
#pragma unroll
            for (int e = 0; e < 8; ++e) o[e] = (roped ? (mv[e] * cs[e] + sg * pp[e] * sn[e]) : mv[e]) * QS;
            q16f[sub][0] = pack_p(o);
            gs4[sub] = sigm(bf1(P[tok4 * PP + PC_NG + head4 * 3 + 1]));
        }
        float ma = -1e30f, la = 0.f, mb = -1e30f, lb = 0.f; f32x4v Oa[4], Ob[4];
#pragma unroll
        for (int dt = 0; dt < 4; ++dt) { Oa[dt] = (f32x4v){0.f, 0.f, 0.f, 0.f}; Ob[dt] = (f32x4v){0.f, 0.f, 0.f, 0.f}; }
        flash16_run(kb, vb, q16f[0], q16f[1], 2 * nblk, list, tq, t0, qi4, fq, ma, la, Oa, mb, lb, Ob);
        la = xq_sum(la); lb = xq_sum(lb);
        const float sca = gs4[0] / fmaxf(la, 1e-30f), scb = gs4[1] / fmaxf(lb, 1e-30f);
#pragma unroll
        for (int dt = 0; dt < 4; ++dt)
#pragma unroll
            for (int i = 0; i < 4; ++i) { LAS float* op = ostb + ((dt >> 1) * 16 + 4 * (2 * (dt & 1) + (fq >> 1)) + i) * 64 + q16 + 32 * (fq & 1); op[0] += sca * Oa[dt][i]; op[16] += scb * Ob[dt][i]; }
        LDS_WAIT();
    }
    {
        bf16x8 qr[4];
        {
            const bf16_t* qp = P + tok * PP + PC_Q + head * 64;
#pragma unroll
            for (int s = 1; s < 4; ++s) qr[s] = scale_q(*(const u32x4*)(qp + 16 * s + 8 * hi), QS);
            const u32x4 mv4 = *(const u32x4*)(qp + 8 * hi), pv4 = *(const u32x4*)(qp + 8 * (hi ^ 1));
            const float* rt = (const float*)(C.ws + WS_ROPE) + tok * 16;
            const f32x4 ca = *(const f32x4*)rt, cb2 = *(const f32x4*)(rt + 4), sa = *(const f32x4*)(rt + 8), sb = *(const f32x4*)(rt + 12);
            const float cs[8] = {ca.x, ca.y, ca.z, ca.w, cb2.x, cb2.y, cb2.z, cb2.w}, sn[8] = {sa.x, sa.y, sa.z, sa.w, sb.x, sb.y, sb.z, sb.w};
            const float mv[8] = {bf_lo(mv4.x), bf_hi(mv4.x), bf_lo(mv4.y), bf_hi(mv4.y), bf_lo(mv4.z), bf_hi(mv4.z), bf_lo(mv4.w), bf_hi(mv4.w)};
            const float pp[8] = {bf_lo(pv4.x), bf_hi(pv4.x), bf_lo(pv4.y), bf_hi(pv4.y), bf_lo(pv4.z), bf_hi(pv4.z), bf_lo(pv4.w), bf_hi(pv4.w)};
            const float sg = hi ? 1.f : -1.f; float o[8];
#pragma unroll
            for (int e = 0; e < 8; ++e) o[e] = (mv[e] * cs[e] + sg * pp[e] * sn[e]) * QS;
            qr[0] = pack_p(o);
        }
        const bf16x8* kb = (const bf16x8*)(C.ws + WS_KWIN) + (size_t)bg * 512 * 4 * 64 + lane;
        const bf16x8* vb = (const bf16x8*)(C.ws + WS_VWIN) + (size_t)bg * 1024 * 2 * 64 + lane;
        float m = -1e30f, l = 0.f; f32x16 O[2];
#pragma unroll
        for (int i = 0; i < 16; ++i) { O[0][i] = 0.f; O[1][i] = 0.f; }
        const int tlo = (t0 - 511 > 0 ? t0 - 511 : 0) >> 5, thi = (t0 + 7) >> 5;
        flash_run<1>(kb, vb, qr, thi - tlo + 1, (const LAS unsigned*)imp, tlo, t, t0, qi, hi, m, l, O);
        l = xhalf_sum(l);
        const float sc = gw / fmaxf(l, 1e-30f);
        bf16_t* yp = Y + tok * YP + 512 + head * 64 + 4 * hi;
#pragma unroll
        for (int dt = 0; dt < 2; ++dt)
#pragma unroll
            for (int ig = 0; ig < 4; ++ig) { float o4[4];
#pragma unroll
                for (int e = 0; e < 4; ++e) o4[e] = ost[(dt * 16 + 4 * ig + e) * 64] + sc * O[dt][4 * ig + e];
                u32x2 w; w.x = cvt_pk_bf16(o4[0], o4[1]); w.y = cvt_pk_bf16(o4[2], o4[3]); *(u32x2*)(yp + 32 * dt + 8 * ig) = w; }
        LDS_WAIT();
    }
}

__device__ __forceinline__ void mem_tile(const Ctx& C, int b, int hm, int t0) {
    const bf16_t* P = (const bf16_t*)(C.ws + WS_R1); bf16_t* Y = (bf16_t*)(C.ws + WS_Y);
    int lane_ = C.lane; asm volatile("" : "+v"(lane_));
    const int lane = lane_, r = lane & 31, hi = lane >> 5;
    const size_t tok = (size_t)b * S_ + t0 + r;
    const float QS = 0.12751743082459868f;
    bf16x8 q[8];
    const bf16_t* qp = P + tok * PP + PC_QM + hm * 128;
#pragma unroll
    for (int s = 0; s < 8; ++s) q[s] = scale_q(*(const u32x4*)(qp + 16 * s + 8 * hi), QS);
    const bf16x8* kb = (const bf16x8*)(C.ws + WS_MEMK) + (size_t)(b * 4 + hm) * 8 * 8 * 64 + lane;
    const bf16x8* vb = (const bf16x8*)(C.ws + WS_MEMV) + (size_t)(b * 4 + hm) * 16 * 4 * 64 + lane;
    float m = -1e30f, l = 0.f; f32x16 O[4];
#pragma unroll
    for (int i = 0; i < 16; ++i) { O[0][i] = 0.f; O[1][i] = 0.f; O[2][i] = 0.f; O[3][i] = 0.f; }
#define MEM_STEP(KF, VF) do { \
        f32x16 sc; _Pragma("unroll") for (int i = 0; i < 16; ++i) sc[i] = 0.f; \
        _Pragma("unroll") for (int s = 0; s < 8; ++s) sc = mfma32(KF[s], q[s], sc); \
        float mx = -1e30f; _Pragma("unroll") for (int i = 0; i < 16; ++i) mx = fmaxf(mx, sc[i]); \
        mx = xhalf_max(mx); \
        const float mn = fmaxf(m, mx), alpha = ex2(m - mn); m = mn; \
        float p[16], ps = 0.f; _Pragma("unroll") for (int i = 0; i < 16; ++i) { p[i] = ex2(sc[i] - mn); ps += p[i]; } \
        l = l * alpha + ps; \
        _Pragma("unroll") for (int i = 0; i < 16; ++i) { O[0][i] *= alpha; O[1][i] *= alpha; O[2][i] *= alpha; O[3][i] *= alpha; } \
        const bf16x8 pb0 = pack_p(p), pb1 = pack_p(p + 8); \
        _Pragma("unroll") for (int dt = 0; dt < 4; ++dt) { O[dt] = mfma32(VF[dt], pb0, O[dt]); O[dt] = mfma32(VF[4 + dt], pb1, O[dt]); } } while (0)
    {
        bf16x8 kA[8], vv[8];
#pragma unroll 1
        for (int kt = 0; kt < 8; ++kt) {
#pragma unroll
            for (int s = 0; s < 8; ++s) kA[s] = kb[kt * 512 + s * 64];
#pragma unroll
            for (int s = 0; s < 8; ++s) vv[s] = vb[kt * 512 + s * 64];
            __builtin_amdgcn_sched_barrier(0);
            MEM_STEP(kA, vv);
        }
    }
#undef MEM_STEP
    l = xhalf_sum(l);
    const float inv = 1.f / l;
    bf16_t* yp = Y + tok * YP + 1024 + hm * 128 + 4 * hi;
#pragma unroll
    for (int dt = 0; dt < 4; ++dt)
#pragma unroll
        for (int ig = 0; ig < 4; ++ig) { u32x2 w; w.x = cvt_pk_bf16(O[dt][4 * ig] * inv, O[dt][4 * ig + 1] * inv); w.y = cvt_pk_bf16(O[dt][4 * ig + 2] * inv, O[dt][4 * ig + 3] * inv); *(u32x2*)(yp + 32 * dt + 8 * ig) = w; }
}

__device__ __forceinline__ void attention_phase(const Ctx& C) {
    const int bxx = C.gw / NWAVES; const bool xmode = (C.G & 7) == 0;
    const int x = bxx & 7, rank = xmode ? (bxx >> 3) * NWAVES + C.wave : C.gw, nrank = xmode ? (C.G >> 3) * NWAVES : C.NGW, nitem = xmode ? 1536 : 12288;
    for (int i = rank; i < nitem; i += nrank) {
        int nsa_n, mem_e;
        if (xmode) { nsa_n = (i < 1024) ? (x >> 1) * 2048 + 2 * i + (x & 1) : -1; mem_e = x * 512 + (i - 1024); }
        else { if (i < 8192) { const int k = i >> 11, w = i & 2047; nsa_n = k * 2048 + ((k & 1) ? 2047 - w : w); } else nsa_n = -1; mem_e = i - 8192; }
        if (nsa_n >= 0) { const int k = nsa_n >> 11; nsa_tile(C, k >> 1, k & 1, (nsa_n & 2047) * 8); }
        else { const int bh = mem_e >> 9; mem_tile(C, bh >> 2, bh & 3, (mem_e & 511) * 32); }
    }
}

#define XB_TMO      128
#define XB_XCNT(j)  (256  + 64 * (j))
#define XB_XSUB(j)  (1280 + 64 * (j))
#define XB_XGEN(j)  (2304 + 64 * (j))
#define XB_TOP      3328
#define XB_TOPGEN   3392
#define XCD_BAR_WORDS 3456
#define XB_SPIN_CAP (1u << 18)
__device__ __forceinline__ unsigned xb_ld(unsigned* p)              { return __hip_atomic_load(p, __ATOMIC_RELAXED, __HIP_MEMORY_SCOPE_AGENT); }
__device__ __forceinline__ unsigned xb_add(unsigned* p, unsigned v) { return __hip_atomic_fetch_add(p, v, __ATOMIC_RELAXED, __HIP_MEMORY_SCOPE_AGENT); }
__device__ __forceinline__ unsigned xb_xcc_id() { return (unsigned)__builtin_amdgcn_s_getreg((3 << 11) | 20) & 0xFu; }
#define XB_SPIN(cond, bar) do { unsigned _sp = 0; while (cond) { __builtin_amdgcn_s_sleep(1); \
    if ((++_sp & 255u) == 0u) { if (xb_ld(&(bar)[XB_TMO])) break; if (_sp > XB_SPIN_CAP) { atomicAdd(&(bar)[XB_TMO], 1u); break; } } } } while (0)
__device__ __forceinline__ void xcd_barrier_complete(unsigned* bar, unsigned x, unsigned& nloc, unsigned& nx) {
    const unsigned G = gridDim.x * gridDim.y * gridDim.z;
    unsigned sum, cnt, mine, sp = 0u;
    for (;;) {
        sum = 0u; cnt = 0u; mine = 0u;
#pragma unroll
        for (unsigned j = 0; j < 16; ++j) { const unsigned c = xb_ld(&bar[XB_XCNT(j)]); sum += c; cnt += (c > 0u) ? 1u : 0u; mine = (j == x) ? c : mine; }
        if (sum == G) break;
        __builtin_amdgcn_s_sleep(1);
        if ((++sp & 255u) == 0u) { if (xb_ld(&bar[XB_TMO])) break; if (sp > XB_SPIN_CAP) { atomicAdd(&bar[XB_TMO], 1u); break; } }
    }
    nloc = mine > 0u ? mine : 1u; nx = cnt > 0u ? cnt : 1u;
}
__device__ __forceinline__ void xcd_barrier(unsigned* bar, volatile LAS unsigned* st, bool tid0) {
    asm volatile("s_waitcnt vmcnt(0)" ::: "memory");
    __syncthreads();
    if (tid0) {
        __builtin_amdgcn_s_waitcnt(0);
        const unsigned x = xb_xcc_id();
        unsigned nloc = st[0], nx = st[1];
        if (nloc == 0u) { xcd_barrier_complete(bar, x, nloc, nx); st[0] = nloc; st[1] = nx; }
        const unsigned old = xb_add(&bar[XB_XSUB(x)], 1u);
        const unsigned gen = old / nloc;
        if (old + 1u == (gen + 1u) * nloc) {
            __builtin_amdgcn_fence(__ATOMIC_RELEASE, "agent");
            asm volatile("s_waitcnt vmcnt(0)" ::: "memory");
            const unsigned og = xb_add(&bar[XB_TOP], 1u);
            const unsigned tg = og / nx;
            if (og + 1u == (tg + 1u) * nx) xb_add(&bar[XB_TOPGEN], 1u);
            else XB_SPIN(xb_ld(&bar[XB_TOPGEN]) == tg, bar);
            __builtin_amdgcn_fence(__ATOMIC_ACQUIRE, "agent");
            xb_add(&bar[XB_XGEN(x)], 1u);
            asm volatile("s_waitcnt vmcnt(0)" ::: "memory");
        } else {
            XB_SPIN(xb_ld(&bar[XB_XGEN(x)]) == gen, bar);
            __builtin_amdgcn_fence(__ATOMIC_ACQUIRE, "agent");
            asm volatile("s_waitcnt vmcnt(0)" ::: "memory");
        }
    }
    __syncthreads();
}

constexpr int LDS_BYTES = 147456, XB_LDS_OFF = 147456 - 64;
constexpr int NPHASE = 1 + 2 * 14;

__global__ void __launch_bounds__(NWAVES * 64, 2) fwd_kernel(Args args) {
    extern __shared__ __attribute__((aligned(16))) unsigned char lds_raw[];
    cg::grid_group grid = cg::this_grid();
    if (args.ph_lo == 0x7fffffff) grid.sync();
    const int wave0 = __builtin_amdgcn_readfirstlane((int)threadIdx.x >> 6);
    {
        volatile LAS unsigned* st = (volatile LAS unsigned*)(lds_raw + XB_LDS_OFF);
        if (threadIdx.x == 0) { st[0] = 0u; st[1] = 0u; (void)xb_add((unsigned*)(args.ws + WS_BAR) + XB_XCNT(xb_xcc_id()), 1u); }
        __syncthreads();
    }
#define PHASE_BEGIN { \
        unsigned char* ws0_ = args.ws; asm volatile("" : "+s"(ws0_)); gu8* ws = (gu8*)ws0_;     \
        int tid_; asm volatile("v_mbcnt_lo_u32_b32 %0, -1, 0\n\tv_mbcnt_hi_u32_b32 %0, -1, %0" : "=v"(tid_)); tid_ += wave0 * 64; \
        Ctx C; C.a = &args; C.ws = ws; C.lds = (LAS unsigned char*)lds_raw; C.tid = tid_; C.lane = tid_ & 63; C.wave = __builtin_amdgcn_readfirstlane(tid_ >> 6); \
        int bx = blockIdx.x; asm volatile("" : "+s"(bx)); C.G = gridDim.x; C.gw = bx * NWAVES + C.wave; C.NGW = C.G * NWAVES; \
        bf16_t* const H = (bf16_t*)(ws + WS_H); bf16_t* const R1 = (bf16_t*)(ws + WS_R1); bf16_t* const Y = (bf16_t*)(ws + WS_Y); (void)H; (void)R1; (void)Y; (void)bx;
#define PHASE_END   { int ln_; asm volatile("v_mbcnt_lo_u32_b32 %0, -1, 0\n\tv_mbcnt_hi_u32_b32 %0, -1, %0" : "=v"(ln_));   \
        xcd_barrier((unsigned*)(ws + WS_BAR), (volatile LAS unsigned*)(lds_raw + XB_LDS_OFF), (wave0 == 0) && (ln_ == 0)); } }
#define PHASE_END_IF(c_) { if (c_) { int ln_; asm volatile("v_mbcnt_lo_u32_b32 %0, -1, 0\n\tv_mbcnt_hi_u32_b32 %0, -1, %0" : "=v"(ln_));   \
        xcd_barrier((unsigned*)(ws + WS_BAR), (volatile LAS unsigned*)(lds_raw + XB_LDS_OFF), (wave0 == 0) && (ln_ == 0)); } } }
#define PHASE_END_CG grid.sync(); }

    PHASE_BEGIN
        convert_layer(C, 0);
        rope_table(C);
        prenorm_rows(C, (const float*)args.in[0], (const float*)args.in[3], H);
    PHASE_END

#pragma unroll 1
    for (int l = 0; l < 2; ++l) {
        PHASE_BEGIN
            { pg8::GemmDesc g{(const char*)H, (const char*)(ws + WS_W1IN), DM, DM, 128, 128, 16}; pg8::StdOrder S; S.init(T_, 2 * FF, C.G, bx, DM, DM);
              pg8::Epi<1> E{R1, FF, nullptr, nullptr}; pg8::gemm_phase(C.lds, C.tid, g, S, E); }
        PHASE_END
        PHASE_BEGIN
            { pg8::GemmDesc g{(const char*)R1, (const char*)(ws + WS_W1OUT), FF, FF, 128, 128, 44}; pg8::StdOrder S; S.init(T_, DM, C.G, bx, FF, FF);
              pg8::Epi<0> E{H, DM, nullptr, nullptr}; pg8::gemm_phase(C.lds, C.tid, g, S, E); }
        PHASE_END
        PHASE_BEGIN
            if (bx < 8) {
                { pg8::GemmDesc g{(const char*)(ws + WS_MEMN), (const char*)(ws + WS_WMKV), DM, DM, 128, 128, 16}; pg8::StdOrder S; S.init(512, DM, C.G, bx, DM, DM);
              pg8::Epi<0> E{(bf16_t*)(ws + WS_MKV), DM, nullptr, nullptr}; pg8::gemm_phase(C.lds, C.tid, g, S, E); }
            } else {
                norm_phase(C, C.gw - 8 * NWAVES, C.NGW - 8 * NWAVES, l == 0 ? (const float*)args.in[0] : args.out, args.out, H, H, INF(4, l, DM), INF(7, l, DM), 0.5f);
            }
            cb_reduce(C, l);
        PHASE_END
        PHASE_BEGIN
            { pg8::GemmDesc g{(const char*)H, (const char*)(ws + WS_WMIX), DM, DM, 128, 128, 16}; pg8::StdOrder S; S.init(T_, PP, C.G, bx, DM, DM);
              pg8::Epi<0> E{R1, PP, nullptr, nullptr}; pg8::gemm_phase(C.lds, C.tid, g, S, E); }
        PHASE_END
        PHASE_BEGIN
            if (bx < 64) {
                pg8::GemmDesc g{(const char*)R1, (const char*)(ws + WS_WC1), 16 * PP, 2048, PP * 2, 128, 16}; pg8::CmpOrder S{bx};
                pg8::Epi<0> E{(bf16_t*)(ws + WS_CMPP), 256, nullptr, nullptr}; pg8::gemm_phase(C.lds, C.tid, g, S, E);
            } else {
                prep_items(C, l, C.gw - 64 * NWAVES, C.NGW - 64 * NWAVES);
                memkv_ops(C, C.gw - 64 * NWAVES, C.NGW - 64 * NWAVES);
            }
        PHASE_END
        PHASE_BEGIN
            cmp_stage2(C, l);
        PHASE_END
        PHASE_BEGIN
            attention_phase(C);
        PHASE_END
        PHASE_BEGIN
            { pg8::GemmDesc g{(const char*)H, (const char*)(ws + WS_WG), DM, DM, 128, 128, 16}; pg8::StdOrder S; S.init(T_, GP, C.G, bx, DM, DM);
              pg8::Epi<2> E{R1, GP, nullptr, nullptr}; pg8::gemm_phase(C.lds, C.tid, g, S, E); }
        PHASE_END
        PHASE_BEGIN
            { pg8::GemmDesc g{(const char*)Y, (const char*)(ws + WS_WBR), YP, YP, 128, 128, 8}; pg8::MergeOrder S; S.init(T_, DM, C.G, bx, YP, YP);
              pg8::Epi<3> E{H, DM, R1, nullptr}; pg8::gemm_phase(C.lds, C.tid, g, S, E); }
        PHASE_END
        PHASE_BEGIN
            { pg8::GemmDesc g{(const char*)H, (const char*)(ws + WS_WOUT), DM, DM, 128, 128, 16}; pg8::StdOrder S; S.init(T_, DM, C.G, bx, DM, DM);
              pg8::Epi<0> E{R1, DM, nullptr, nullptr}; pg8::gemm_phase(C.lds, C.tid, g, S, E); }
        PHASE_END
        PHASE_BEGIN
            norm_phase(C, C.gw, C.NGW, args.out, args.out, R1, H, INF(8, l, DM), INF(25, l, DM), 1.0f);
        PHASE_END
        PHASE_BEGIN
            { pg8::GemmDesc g{(const char*)H, (const char*)(ws + WS_W2IN), DM, DM, 128, 128, 16}; pg8::StdOrder S; S.init(T_, 2 * FF, C.G, bx, DM, DM);
              pg8::Epi<1> E{R1, FF, nullptr, nullptr}; pg8::gemm_phase(C.lds, C.tid, g, S, E); }
        PHASE_END
        PHASE_BEGIN
            { pg8::GemmDesc g{(const char*)R1, (const char*)(ws + WS_W2OUT), FF, FF, 128, 128, 44}; pg8::StdOrder S; S.init(T_, DM, C.G, bx, FF, FF);
              pg8::Epi<0> E{H, DM, nullptr, nullptr}; pg8::gemm_phase(C.lds, C.tid, g, S, E); }
        PHASE_END
        PHASE_BEGIN
            norm_phase(C, C.gw, C.NGW, args.out, args.out, H, H, INF(26, l, DM), l == 0 ? INF(3, 1, DM) : nullptr, 0.5f);
            if (l == 0) convert_layer(C, 1);
        PHASE_END_IF(l == 0)
    }
}

extern "C" void kernel_launch(void* const* d_in, const int* in_sizes, int n_in, void* d_out, int out_size, void* d_ws, size_t ws_size, hipStream_t stream) {
    static int grid = 0;
    if (grid == 0) {
        if (n_in != 29 || ws_size < WS_END) { fprintf(stderr, "kernel_launch: unexpected n_in %d / ws %zu\n", n_in, ws_size); grid = -1; return; }
        int dev = 0, cus = 0, per_cu = 0;
        hipGetDevice(&dev); hipDeviceGetAttribute(&cus, hipDeviceAttributeMultiprocessorCount, dev);
        hipFuncSetAttribute((const void*)fwd_kernel, hipFuncAttributeMaxDynamicSharedMemorySize, LDS_BYTES);
        hipOccupancyMaxActiveBlocksPerMultiprocessor(&per_cu, (const void*)fwd_kernel, NWAVES * 64, LDS_BYTES);
        if (per_cu < 1) per_cu = 1;
        grid = cus * per_cu;
        (void)hipGetLastError();
    }
    if (grid < 0) return;
    hipMemsetAsync((char*)d_ws + WS_BAR, 0, 16384, stream);
    Args a{};
    for (int i = 0; i < 29; ++i) a.in[i] = d_in[i];
    a.out = (float*)d_out; a.ws = (unsigned char*)d_ws; a.ph_lo = 0; a.ph_hi = NPHASE;
    void* kargs[] = {&a};
    hipError_t e = hipLaunchCooperativeKernel((const void*)fwd_kernel, dim3(grid), dim3(NWAVES * 64), kargs, LDS_BYTES, stream);
    if (e != hipSuccess) fprintf(stderr, "cooperative launch failed: %s (grid %d)\n", hipGetErrorString(e), grid);
}
```

```cpp
#include <hip/hip_runtime.h>
#include <hip/hip_cooperative_groups.h>
#include <cstdio>
#include <cstdint>
namespace cg = cooperative_groups;

#define LAS __attribute__((address_space(3)))
typedef unsigned short bf16_t;
typedef short bf16x8 __attribute__((ext_vector_type(8)));
typedef float f32x4 __attribute__((ext_vector_type(4)));
typedef float f32x16 __attribute__((ext_vector_type(16)));
typedef unsigned u32x4 __attribute__((ext_vector_type(4)));
typedef unsigned u32x2 __attribute__((ext_vector_type(2)));

constexpr int NBATCH = 2, S_ = 16384, T_ = NBATCH * S_, DM = 1024, FF = 2816, PP = 3584, GP = 3072, YP = 1536;
constexpr int NWAVES = 8;
constexpr float EPS = 1e-6f;
constexpr int PC_Q = 1536, PC_KV = 2048, PC_QM = 2816, PC_NG = 3328;

constexpr size_t MiB = 1u << 20;
constexpr size_t WS_W1IN = 0, WS_W1OUT = 11 * MiB, WS_WMIX = WS_W1OUT + 11 * MiB / 2, WS_WG = WS_WMIX + 7 * MiB, WS_WBR = WS_WG + 6 * MiB, WS_WOUT = WS_WBR + 3 * MiB,
                 WS_W2IN = WS_WOUT + 2 * MiB, WS_W2OUT = WS_W2IN + 11 * MiB, WS_WC1 = WS_W2OUT + 11 * MiB / 2  , WS_WMKV = WS_WC1 + 2 * MiB,
                 WS_MEMN = WS_WMKV + 2 * MiB, WS_MKV = WS_MEMN + 1 * MiB, WS_CB = WS_MKV + 1 * MiB  , WS_CBP = WS_CB + 8192  , WS_BAR = WS_CB + 8192 + 131072  ;
static_assert(WS_CB == 57 * MiB, "ws map");
constexpr size_t WS_ROPE = 58 * MiB, WS_MEMK = 60 * MiB, WS_MEMV = WS_MEMK + MiB / 2, WS_KCMP = 61 * MiB, WS_VCMP = WS_KCMP + MiB / 2, WS_CMPH = 62 * MiB,
                 WS_KSLC = 66 * MiB, WS_VSLC = 74 * MiB, WS_KWIN = 82 * MiB, WS_VWIN = 90 * MiB, WS_H = 98 * MiB, WS_Y = 162 * MiB, WS_R1 = 258 * MiB, WS_CMPP = 484 * MiB  , WS_END = 492 * MiB;

typedef float f32x2_t __attribute__((ext_vector_type(2)));
typedef __bf16 bf16x2_t __attribute__((ext_vector_type(2)));
__device__ __forceinline__ unsigned cvt_pk_bf16(float lo, float hi) { f32x2_t v = {lo, hi}; bf16x2_t b = __builtin_convertvector(v, bf16x2_t); return __builtin_bit_cast(unsigned, b); }
__device__ __forceinline__ float bf_lo(unsigned u) { return __uint_as_float(u << 16); }
__device__ __forceinline__ float bf_hi(unsigned u) { return __uint_as_float(u & 0xffff0000u); }
__device__ __forceinline__ float bf1(bf16_t u) { return __uint_as_float(((unsigned)u) << 16); }
__device__ __forceinline__ float ex2(float x) { return __builtin_amdgcn_exp2f(x); }
__device__ __forceinline__ float rcpf_(float x) { return __builtin_amdgcn_rcpf(x); }
__device__ __forceinline__ float sigm(float x) { return rcpf_(1.f + ex2(-1.44269504f * x)); }
__device__ __forceinline__ float gelu_tanh(float x) { const float u = 0.7978845608f * (x + 0.044715f * x * x * x); return x * rcpf_(1.f + ex2(-2.88539008f * u)); }
__device__ __forceinline__ float wave_sum(float v) {
#pragma unroll
    for (int o = 1; o < 64; o <<= 1) v += __shfl_xor(v, o);
    return v;
}
__device__ __forceinline__ int pi32(int r) { return (r & 0x13) | ((r & 4) << 1) | ((r & 8) >> 1); }
#define LDS_WAIT() asm volatile("s_waitcnt lgkmcnt(0)" ::: "memory")

namespace pg8 {
constexpr int BM = 256, BK = 64, HALF = 128, HTB = HALF * BK * 2, STAGE_BYTES = 8 * HTB, NXCD = 8, WGM = 8;
__device__ __forceinline__ int lds_byte(int r, int c) { const int st = (r >> 4) * 2 + (c >> 5), rr = r & 15, cc = c & 31, ob = rr * 64 + cc * 2; return st * 1024 + (ob ^ (((ob >> 9) & 1) << 5)); }
__device__ __forceinline__ void stage_rc(int b, int& R, int& C) { const int st = b / 1024, sb = b % 1024, swz = sb ^ (((sb >> 9) & 1) << 5); R = (st >> 1) * 16 + swz / 64; C = (st & 1) * 32 + (swz % 64) / 2; }
__device__ __forceinline__ int perm32(int rho) { const int n = rho >> 4, i = rho & 15; return 8 * (i >> 2) + 4 * n + (i & 3); }

struct Unit { int pm, pn, tag; long long aoff, boff; };
struct GemmDesc { const char* A; const char* Bt; int lda, ldb, kstepA, kstepB, nt; };

__device__ __forceinline__ void swz_tile(int L, int nM, int nN, int& pm, int& pn) {
    const int nwg = nM * nN; int wgid = L;
    { const int q = nwg / NXCD, r = nwg % NXCD, xcd = wgid % NXCD, off = wgid / NXCD; wgid = (xcd < r ? xcd * (q + 1) : r * (q + 1) + (xcd - r) * q) + off; }
    const int nig = WGM * nN, gid = wgid / nig, fm = gid * WGM, gsz = (nM - fm) < WGM ? (nM - fm) : WGM;
    pm = fm + ((wgid % nig) % gsz); pn = (wgid % nig) / gsz;
}
struct StdOrder {
    int nM, nN, G, c; long long tA, tB;
    __device__ void init(int M, int N, int G_, int c_, int lda, int ldb) { nM = M / BM; nN = N / BM; G = G_; c = c_; tA = 512LL * lda; tB = 512LL * ldb; }
    __device__ bool next(int i, Unit& u) const {
        const long long L = (long long)i * G + c; if (L >= (long long)nM * nN) return false;
        swz_tile((int)L, nM, nN, u.pm, u.pn); u.tag = 0; u.aoff = u.pm * tA; u.boff = u.pn * tB; return true;
    }
};
struct MergeOrder {
    int nM, nN, G, c; long long tA, tB;
    __device__ void init(int M, int N, int G_, int c_, int lda, int ldb) { nM = M / BM; nN = N / BM; G = G_; c = c_; tA = 512LL * lda; tB = 512LL * ldb; }
    __device__ bool next(int i, Unit& u) const {
        const int ti = i / 3, br = i - 3 * ti; const long long L = (long long)ti * G + c; if (L >= (long long)nM * nN) return false;
        swz_tile((int)L, nM, nN, u.pm, u.pn); u.tag = br; u.aoff = u.pm * tA + br * 1024; u.boff = u.pn * tB + br * 1024; return true;
    }
};
struct CmpOrder {
    int c;
    __device__ bool next(int i, Unit& u) const {
        if (i != 0 || c >= 64) return false;
        const int ks = c >> 5, kv = (c >> 4) & 1, bg = (c >> 2) & 3, tile = c & 3, b = bg >> 1, g = bg & 1;
        u.pm = c; u.pn = 0; u.tag = kv;
        u.aoff = 2LL * (((long long)b * S_ + 4096LL * tile + 16LL * ks) * PP + PC_KV + kv * 128 + g * 64);
        u.boff = (long long)kv * (256 * 2048 * 2) + (long long)ks * (1024 * 2); return true;
    }
};

__device__ __forceinline__ u32x4 pack8(f32x4 a, f32x4 b) { u32x4 w; w.x = cvt_pk_bf16(a[0], a[1]); w.y = cvt_pk_bf16(a[2], a[3]); w.z = cvt_pk_bf16(b[0], b[1]); w.w = cvt_pk_bf16(b[2], b[3]); return w; }
template <int MODE> struct Epi {
    bf16_t* O; int ldc; const bf16_t* G; const float* bias;
    __device__ __forceinline__ void operator()(const f32x4 (&acc)[2][2][4][2], const Unit& u, int wr, int wc, int fr, int fq) const {
        const int row0 = u.pm * BM + wr * 64 + fr;
        if constexpr (MODE == 1) {
            const int col0 = u.pn * 128 + wc * 32 + 8 * fq;
#pragma unroll
            for (int ai = 0; ai < 2; ++ai)
#pragma unroll
                for (int m = 0; m < 4; ++m) {
                    bf16_t* rowp = O + (size_t)(row0 + ai * HALF + m * 16) * ldc + col0;
                    f32x4 v0, v1;
#pragma unroll
                    for (int e = 0; e < 4; ++e) { const float a0 = acc[ai][0][m][0][e], a1 = acc[ai][0][m][1][e]; v0[e] = a0 * sigm(a0) * acc[ai][1][m][0][e]; v1[e] = a1 * sigm(a1) * acc[ai][1][m][1][e]; }
                    *(u32x4*)rowp = pack8(v0, v1);
                    __builtin_amdgcn_sched_barrier(0);
                }
        } else if constexpr (MODE == 3) {
            const int col0 = u.pn * BM + wc * 32 + 8 * fq;
#pragma unroll
            for (int ai = 0; ai < 2; ++ai) {
                u32x4 gv[4][2], ov[4][2];
#pragma unroll
                for (int m = 0; m < 4; ++m)
#pragma unroll
                    for (int bj = 0; bj < 2; ++bj) { const size_t row = (size_t)(row0 + ai * HALF + m * 16); const int col = col0 + bj * HALF;
                        gv[m][bj] = *(const u32x4*)(G + row * GP + u.tag * 1024 + col);
                        ov[m][bj] = (u.tag > 0) ? *(const u32x4*)(O + row * ldc + col) : (u32x4){0u, 0u, 0u, 0u}; }
                __builtin_amdgcn_sched_barrier(0);
#pragma unroll
                for (int m = 0; m < 4; ++m)
#pragma unroll
                    for (int bj = 0; bj < 2; ++bj) { const size_t row = (size_t)(row0 + ai * HALF + m * 16); const int col = col0 + bj * HALF;
                        f32x4 v0 = acc[ai][bj][m][0], v1 = acc[ai][bj][m][1]; const u32x4 g4 = gv[m][bj], o4 = ov[m][bj];
                        v0[0] = v0[0] * bf_lo(g4.x) + bf_lo(o4.x); v0[1] = v0[1] * bf_hi(g4.x) + bf_hi(o4.x); v0[2] = v0[2] * bf_lo(g4.y) + bf_lo(o4.y); v0[3] = v0[3] * bf_hi(g4.y) + bf_hi(o4.y);
                        v1[0] = v1[0] * bf_lo(g4.z) + bf_lo(o4.z); v1[1] = v1[1] * bf_hi(g4.z) + bf_hi(o4.z); v1[2] = v1[2] * bf_lo(g4.w) + bf_lo(o4.w); v1[3] = v1[3] * bf_hi(g4.w) + bf_hi(o4.w);
                        *(u32x4*)(O + row * ldc + col) = pack8(v0, v1); }
            }
        } else {
            const int col0 = u.pn * BM + wc * 32 + 8 * fq;
#pragma unroll
            for (int ai = 0; ai < 2; ++ai)
#pragma unroll
                for (int m = 0; m < 4; ++m) {
                    const size_t row = (size_t)(row0 + ai * HALF + m * 16);
#pragma unroll
                    for (int bj = 0; bj < 2; ++bj) {
                        const int col = col0 + bj * HALF;
                        f32x4 v0 = acc[ai][bj][m][0], v1 = acc[ai][bj][m][1];
                        bf16_t* dst = O + row * ldc + col;
                        if constexpr (MODE == 2) {
#pragma unroll
                            for (int e = 0; e < 4; ++e) { v0[e] = sigm(v0[e]); v1[e] = sigm(v1[e]); }
                        }
                        if constexpr (MODE == 4) {
                            const f32x4 b0 = *(const f32x4*)(bias + u.tag * 256 + col), b1 = *(const f32x4*)(bias + u.tag * 256 + col + 4);
#pragma unroll
                            for (int e = 0; e < 4; ++e) { v0[e] = gelu_tanh(v0[e] + b0[e]); v1[e] = gelu_tanh(v1[e] + b1[e]); }
                        }
                        if constexpr (MODE == 3) {
                            const u32x4 gv = *(const u32x4*)(G + row * GP + u.tag * 1024 + col);
                            v0[0] *= bf_lo(gv.x); v0[1] *= bf_hi(gv.x); v0[2] *= bf_lo(gv.y); v0[3] *= bf_hi(gv.y);
                            v1[0] *= bf_lo(gv.z); v1[1] *= bf_hi(gv.z); v1[2] *= bf_lo(gv.w); v1[3] *= bf_hi(gv.w);
                            if (u.tag > 0) {
                                const u32x4 ov = *(const u32x4*)dst;
                                v0[0] += bf_lo(ov.x); v0[1] += bf_hi(ov.x); v0[2] += bf_lo(ov.y); v0[3] += bf_hi(ov.y);
                                v1[0] += bf_lo(ov.z); v1[1] += bf_hi(ov.z); v1[2] += bf_lo(ov.w); v1[3] += bf_hi(ov.w);
                            }
                        }
                        *(u32x4*)dst = pack8(v0, v1);
                    }
                }
        }
    }
};

template <class EpiT, class Sched>
__device__ __forceinline__ void gemm_phase(LAS unsigned char* lds, int tid_in, const GemmDesc g, const Sched& S, const EpiT& E) {
    int tid_ = tid_in; asm volatile("" : "+v"(tid_));
    const int tid = tid_, wid = __builtin_amdgcn_readfirstlane(tid >> 6), lane = tid & 63, wr = wid >> 2, wc = wid & 3, fr = lane & 15, fq = lane >> 4;
    const int nt = g.nt;
    unsigned voffA[2], voffB[2];
#pragma unroll
    for (int i = 0; i < 2; ++i) { int R, C; stage_rc(tid * 16 + i * 8192, R, C); const int Rb = (R & ~31) + perm32(R & 31);
        voffA[i] = (unsigned)(R * g.lda + C) * 2u; voffB[i] = (unsigned)(Rb * g.ldb + C) * 2u; }
    const size_t kA = (size_t)g.kstepA, kB = (size_t)g.kstepB;
    const size_t hA = (size_t)HALF * g.lda * 2, hB = (size_t)HALF * g.ldb * 2;
    const unsigned ldsw = (unsigned)wid * 1024u;
    const int aoff = lds_byte(wr * 64 + fr, fq * 8), boff = lds_byte(wc * 32 + fr, fq * 8);
#define PG8_SA(b, h) (((b) * 2 + (h)) * HTB)
#define PG8_SB(b, h) ((4 + (b) * 2 + (h)) * HTB)
#define PG8_STAGE(bufoff, gbase, voff) do { _Pragma("unroll") for (int _i = 0; _i < 2; ++_i) \
        __builtin_amdgcn_global_load_lds((const unsigned*)((const char*)(gbase) + (voff)[_i]), (LAS unsigned*)(lds + (bufoff) + ldsw + _i * 8192), 16, 0, 0); } while (0)
#define PG8_LDA(dst, b, h) do { _Pragma("unroll") for (int m = 0; m < 4; ++m) _Pragma("unroll") for (int k = 0; k < 2; ++k) dst[m][k] = *(const LAS bf16x8*)(lds + PG8_SA(b, h) + aoff + m * 2048 + k * 1024); } while (0)
#define PG8_LDB(dst, b, h) do { _Pragma("unroll") for (int n = 0; n < 2; ++n) _Pragma("unroll") for (int k = 0; k < 2; ++k) dst[n][k] = *(const LAS bf16x8*)(lds + PG8_SB(b, h) + boff + n * 2048 + k * 1024); } while (0)
#define PG8_MMA(ai, bj, At, Bt) do { __builtin_amdgcn_s_setprio(1); _Pragma("unroll") for (int m = 0; m < 4; ++m) _Pragma("unroll") for (int n = 0; n < 2; ++n) _Pragma("unroll") for (int k = 0; k < 2; ++k) \
        acc[ai][bj][m][n] = __builtin_amdgcn_mfma_f32_16x16x32_bf16(Bt[n][k], At[m][k], acc[ai][bj][m][n], 0, 0, 0); __builtin_amdgcn_s_setprio(0); } while (0)
#define PG8_WAIT_V(n) asm volatile("s_waitcnt vmcnt(" #n ")" ::: "memory")
#define PG8_WAIT_L(n) asm volatile("s_waitcnt lgkmcnt(" #n ")" ::: "memory")
#define PG8_BAR __builtin_amdgcn_s_barrier()
#define PG8_SCHED __builtin_amdgcn_sched_barrier(0)
    Unit cur, nxt; int ui = 0;
    if (!S.next(0, cur)) return;
    f32x4 acc[2][2][4][2];
#pragma unroll
    for (int a = 0; a < 2; ++a)
#pragma unroll
        for (int b = 0; b < 2; ++b)
#pragma unroll
            for (int m = 0; m < 4; ++m)
#pragma unroll
                for (int n = 0; n < 2; ++n) acc[a][b][m][n] = (f32x4){0.f, 0.f, 0.f, 0.f};
    bf16x8 At[4][2], B0[2][2], B1[2][2];
    const char* cA = g.A + cur.aoff; const char* cB = g.Bt + cur.boff;
    PG8_STAGE(PG8_SB(0, 0), cB, voffB); PG8_STAGE(PG8_SB(0, 1), cB + hB, voffB); PG8_STAGE(PG8_SA(0, 0), cA, voffA); PG8_STAGE(PG8_SA(0, 1), cA + hA, voffA);
    if (wr == 1) PG8_BAR;
    PG8_WAIT_V(2); PG8_BAR;
    PG8_STAGE(PG8_SB(1, 0), cB + kB, voffB); PG8_STAGE(PG8_SA(1, 0), cA + kA, voffA); PG8_STAGE(PG8_SB(1, 1), cB + hB + kB, voffB);
    PG8_WAIT_V(6); PG8_BAR;
    for (;;) {
        const bool has_next = S.next(ui + 1, nxt);
        const char* nA = has_next ? g.A + nxt.aoff : cA; const char* nB = has_next ? g.Bt + nxt.boff : cB;
        for (int t = 0; t < nt; t += 2) {
            const bool last = (t == nt - 2);
            const char* a1 = cA + (size_t)(t + 1) * kA;
            const char* a2 = last ? nA : cA + (size_t)(t + 2) * kA; const char* b2 = last ? nB : cB + (size_t)(t + 2) * kB;
            const char* a3 = a2 + kA; const char* b3 = b2 + kB;
            PG8_LDB(B0, 0, 0); PG8_LDB(B1, 0, 1); PG8_SCHED; PG8_LDA(At, 0, 0); PG8_STAGE(PG8_SA(1, 1), a1 + hA, voffA);
            PG8_WAIT_V(8); PG8_WAIT_L(0); PG8_BAR; PG8_MMA(0, 0, At, B0); PG8_MMA(0, 1, At, B1); PG8_BAR; PG8_SCHED;
            PG8_LDA(At, 0, 1); PG8_STAGE(PG8_SB(0, 0), b2, voffB); PG8_STAGE(PG8_SB(0, 1), b2 + hB, voffB); PG8_STAGE(PG8_SA(0, 0), a2, voffA);
            PG8_WAIT_V(8); PG8_WAIT_L(0); PG8_BAR; PG8_MMA(1, 0, At, B0); PG8_MMA(1, 1, At, B1); PG8_BAR; PG8_SCHED;
            PG8_LDB(B0, 1, 0); PG8_LDB(B1, 1, 1); PG8_SCHED; PG8_LDA(At, 1, 0); PG8_STAGE(PG8_SA(0, 1), a2 + hA, voffA);
            PG8_WAIT_V(8); PG8_WAIT_L(0); PG8_BAR; PG8_MMA(0, 0, At, B0); PG8_MMA(0, 1, At, B1); PG8_BAR; PG8_SCHED;
            PG8_LDA(At, 1, 1); PG8_STAGE(PG8_SB(1, 0), b3, voffB); PG8_STAGE(PG8_SB(1, 1), b3 + hB, voffB); PG8_STAGE(PG8_SA(1, 0), a3, voffA);
            PG8_WAIT_V(8); PG8_WAIT_L(0); PG8_BAR; PG8_MMA(1, 0, At, B0); PG8_MMA(1, 1, At, B1); PG8_BAR; PG8_SCHED;
        }
        if (wr == 0) PG8_BAR;
        E(acc, cur, wr, wc, fr, fq);
        if (!has_next) break;
#pragma unroll
        for (int a = 0; a < 2; ++a)
#pragma unroll
            for (int b = 0; b < 2; ++b)
#pragma unroll
                for (int m = 0; m < 4; ++m)
#pragma unroll
                    for (int n = 0; n < 2; ++n) acc[a][b][m][n] = (f32x4){0.f, 0.f, 0.f, 0.f};
        cur = nxt; cA = nA; cB = nB; ++ui;
        if (wr == 1) PG8_BAR;
    }
    PG8_WAIT_V(0);
    PG8_BAR;
#undef PG8_SA
#undef PG8_SB
#undef PG8_STAGE
#undef PG8_LDA
#undef PG8_LDB
#undef PG8_MMA
#undef PG8_WAIT_V
#undef PG8_WAIT_L
#undef PG8_BAR
#undef PG8_SCHED
}
}

struct Args { const void* in[29]; float* out; unsigned char* ws; int ph_lo, ph_hi; };
static_assert(sizeof(Args) == 29 * 8 + 8 + 8 + 8, "Args has no padding");

typedef __attribute__((address_space(1))) unsigned char gu8;
struct Ctx {
    const Args* a; gu8* ws; LAS unsigned char* lds; int tid, lane, wave, G, gw, NGW;
};
#define INF(k, l, n) ((const float*)C.a->in[k] + (size_t)(l) * (n))

__device__ __forceinline__ void tr_item(const float* W, int ldw, int src_col, int nvalid, int k0, bf16_t* WT, int ldt, int dst_row, int dst_k, LAS float* scr, int lane) {
#pragma unroll 8
    for (int i = 0; i < 32; ++i) { const int kk = 2 * i + (lane >> 5), c = lane & 31; scr[kk * 33 + c] = (c < nvalid) ? W[(size_t)(k0 + kk) * ldw + src_col + c] : 0.f; }
    LDS_WAIT();
    const int c = lane & 7;
#pragma unroll
    for (int j = 0; j < 4; ++j) { const int n = (lane >> 3) + 8 * j; const LAS float* s = scr + (8 * c) * 33 + n;
        u32x4 o; o.x = cvt_pk_bf16(s[0 * 33], s[1 * 33]); o.y = cvt_pk_bf16(s[2 * 33], s[3 * 33]); o.z = cvt_pk_bf16(s[4 * 33], s[5 * 33]); o.w = cvt_pk_bf16(s[6 * 33], s[7 * 33]);
        *(u32x4*)(WT + (size_t)(dst_row + n) * ldt + dst_k + k0 + 8 * c) = o; }
    LDS_WAIT();
}

__device__ __forceinline__ void convert_layer(const Ctx& C, int l) {
    LAS float* scr = (LAS float*)(C.lds + C.wave * 8448);
    gu8* ws = C.ws; const int lane = C.lane;
    constexpr int NITEMS = 2816 + 1408 + 1792 + 1536 + 768 + 512 + 2816 + 1408 + 256 + 256 + 512;
    for (int it = C.gw; it < NITEMS; it += C.NGW) {
        int r = it;
        if (r < 2816) { const int kb = r / 176, nb = r % 176, tile = nb >> 3, w = nb & 7, src = (w >> 2) * FF + tile * 128 + (w & 3) * 32;
            tr_item(INF(5, l, DM * 2 * FF), 2 * FF, src, 32, kb * 64, (bf16_t*)(ws + WS_W1IN), DM, nb * 32, 0, scr, lane); continue; } r -= 2816;
        if (r < 1408) { const int kb = r / 32, nb = r % 32;
            tr_item(INF(6, l, FF * DM), DM, nb * 32, 32, kb * 64, (bf16_t*)(ws + WS_W1OUT), FF, nb * 32, 0, scr, lane); continue; } r -= 1408;
        if (r < 1792) { const int kb = r / 112, nb = r % 112; int src = 0, nv = 0;
            if (nb < 88) { src = nb * 32; nv = 32; } else if (nb < 104) { src = 2840 + (nb - 88) * 32; nv = 32; } else if (nb == 104) { src = 2816; nv = 24; }
            tr_item(INF(10, l, DM * 6424), 6424, src, nv, kb * 64, (bf16_t*)(ws + WS_WMIX), DM, nb * 32, 0, scr, lane); continue; } r -= 1792;
        if (r < 1536) { const int kb = r / 96, nb = r % 96;
            tr_item(INF(10, l, DM * 6424), 6424, 3352 + nb * 32, 32, kb * 64, (bf16_t*)(ws + WS_WG), DM, nb * 32, 0, scr, lane); continue; } r -= 1536;
        if (r < 768) { const int br = r / 256, q = r % 256, kb = q / 32, nb = q % 32;
            const float* W = br == 0 ? INF(21, l, 512 * DM) : (br == 1 ? INF(22, l, 512 * DM) : INF(23, l, 512 * DM));
            tr_item(W, DM, nb * 32, 32, kb * 64, (bf16_t*)(ws + WS_WBR), YP, nb * 32, br * 512, scr, lane); continue; } r -= 768;
        if (r < 512) { const int kb = r / 32, nb = r % 32;
            tr_item(INF(24, l, DM * DM), DM, nb * 32, 32, kb * 64, (bf16_t*)(ws + WS_WOUT), DM, nb * 32, 0, scr, lane); continue; } r -= 512;
        if (r < 2816) { const int kb = r / 176, nb = r % 176, tile = nb >> 3, w = nb & 7, src = (w >> 2) * FF + tile * 128 + (w & 3) * 32;
            tr_item(INF(27, l, DM * 2 * FF), 2 * FF, src, 32, kb * 64, (bf16_t*)(ws + WS_W2IN), DM, nb * 32, 0, scr, lane); continue; } r -= 2816;
        if (r < 1408) { const int kb = r / 32, nb = r % 32;
            tr_item(INF(28, l, FF * DM), DM, nb * 32, 32, kb * 64, (bf16_t*)(ws + WS_W2OUT), FF, nb * 32, 0, scr, lane); continue; } r -= 1408;
        if (r < 256) { const int kb = r / 8, nb = r % 8;
            tr_item(INF(14, l, 2048 * 256), 256, nb * 32, 32, kb * 64, (bf16_t*)(ws + WS_WC1), 2048, nb * 32, 0, scr, lane); continue; } r -= 256;
        if (r < 256) { const int kb = r / 8, nb = r % 8;
            tr_item(INF(17, l, 2048 * 256), 256, nb * 32, 32, kb * 64, (bf16_t*)(ws + WS_WC1 + MiB), 2048, nb * 32, 0, scr, lane); continue; } r -= 256;
        { const int kb = r / 32, nb = r % 32;
            tr_item(INF(20, l, DM * DM), DM, nb * 32, 32, kb * 64, (bf16_t*)(ws + WS_WMKV), DM, nb * 32, 0, scr, lane); }
    }
    {
        const float* gm = INF(9, l, DM);
        for (int m = C.gw; m < 512; m += C.NGW) {
            const f32x4* xr = (const f32x4*)((const float*)C.a->in[1] + (size_t)m * DM) + lane;
            f32x4 v[4]; float s = 0.f;
#pragma unroll
            for (int j = 0; j < 4; ++j) { v[j] = xr[64 * j]; s += (v[j].x * v[j].x + v[j].y * v[j].y) + (v[j].z * v[j].z + v[j].w * v[j].w); }
            const float rstd = rsqrtf(wave_sum(s) * (1.f / DM) + EPS);
            u32x2* o = (u32x2*)((bf16_t*)(ws + WS_MEMN) + (size_t)m * DM) + lane;
#pragma unroll
            for (int j = 0; j < 4; ++j) { const f32x4 gg = ((const f32x4*)gm)[lane + 64 * j]; u32x2 w; w.x = cvt_pk_bf16(v[j].x * rstd * gg.x, v[j].y * rstd * gg.y); w.y = cvt_pk_bf16(v[j].z * rstd * gg.z, v[j].w * rstd * gg.w); o[64 * j] = w; }
        }
    }
    {
        float* cb = (float*)(ws + WS_CBP) + (size_t)l * 64 * 256;
        for (int it = C.gw; it < 64; it += C.NGW) {
            const int kv = it >> 5, ch = it & 31;
            const float* pos = kv ? INF(13, l, 2048) : INF(12, l, 2048);
            const float* w1 = kv ? INF(17, l, 2048 * 256) : INF(14, l, 2048 * 256);
            float p[4] = {0.f, 0.f, 0.f, 0.f};
            for (int k = ch * 64; k < ch * 64 + 64; ++k) { const float pv = pos[k];
#pragma unroll
                for (int q = 0; q < 4; ++q) p[q] += pv * w1[(size_t)k * 256 + lane + 64 * q]; }
#pragma unroll
            for (int q = 0; q < 4; ++q) cb[(size_t)it * 256 + lane + 64 * q] = p[q];
        }
    }
}

__device__ __forceinline__ void rope_table(const Ctx& C) {
    const int* pos = (const int*)C.a->in[2];
    float* tab = (float*)(C.ws + WS_ROPE);
    const float invf[8] = {1.0f, 0.1939227432012558f, 0.03760603070259094f, 0.007292664609849453f, 0.0014142135623842478f, 0.00027424818836152554f, 5.318296098266728e-05f, 1.0313386155758053e-05f};
    for (int e = C.gw * 64 + C.lane; e < T_ * 8; e += C.NGW * 64) {
        const int tok = e >> 3, i = e & 7;
        float f = invf[0];
#pragma unroll
        for (int q = 1; q < 8; ++q) f = (i == q) ? invf[q] : f;
        const float ang = (float)pos[tok] * f;
        const double rev = (double)ang * 0.15915494309189535; const float fr = (float)(rev - floor(rev));
        tab[(size_t)tok * 16 + i] = __builtin_amdgcn_cosf(fr); tab[(size_t)tok * 16 + 8 + i] = __builtin_amdgcn_sinf(fr);
    }
}
__device__ __forceinline__ void prenorm_rows(const Ctx& C, const float* x, const float* g, bf16_t* h) {
    for (int m = C.gw; m < T_; m += C.NGW) {
        const f32x4* xr = (const f32x4*)(x + (size_t)m * DM) + C.lane;
        f32x4 v[4]; float s = 0.f;
#pragma unroll
        for (int j = 0; j < 4; ++j) { v[j] = xr[64 * j]; s += (v[j].x * v[j].x + v[j].y * v[j].y) + (v[j].z * v[j].z + v[j].w * v[j].w); }
        const float rstd = rsqrtf(wave_sum(s) * (1.f / DM) + EPS);
        u32x2* o = (u32x2*)(h + (size_t)m * DM) + C.lane;
#pragma unroll
        for (int j = 0; j < 4; ++j) { const f32x4 gg = ((const f32x4*)g)[C.lane + 64 * j]; u32x2 w; w.x = cvt_pk_bf16(v[j].x * rstd * gg.x, v[j].y * rstd * gg.y); w.y = cvt_pk_bf16(v[j].z * rstd * gg.z, v[j].w * rstd * gg.w); o[64 * j] = w; }
    }
}
__device__ __forceinline__ void norm_phase(const Ctx& C, int w0, int nw, const float* xin, float* xout, const bf16_t* y, bf16_t* h, const float* gpost, const float* gpre, float coef) {
    for (int m0 = w0; m0 < T_; m0 += 2 * nw) {
        f32x4 xv[2][4]; u32x2 yw[2][4];
#pragma unroll
        for (int r = 0; r < 2; ++r) { const int m = (m0 + r * nw < T_) ? m0 + r * nw : m0; const f32x4* xr = (const f32x4*)(xin + (size_t)m * DM) + C.lane; const u32x2* yr = (const u32x2*)(y + (size_t)m * DM) + C.lane;
#pragma unroll
            for (int j = 0; j < 4; ++j) { xv[r][j] = xr[64 * j]; yw[r][j] = yr[64 * j]; } }
#pragma unroll
        for (int r = 0; r < 2; ++r) {
            const int m = m0 + r * nw; if (m >= T_) break;
            f32x4 yv[4]; float s = 0.f;
#pragma unroll
            for (int j = 0; j < 4; ++j) { const u32x2 w = yw[r][j]; yv[j] = (f32x4){bf_lo(w.x), bf_hi(w.x), bf_lo(w.y), bf_hi(w.y)};
                s += (yv[j].x * yv[j].x + yv[j].y * yv[j].y) + (yv[j].z * yv[j].z + yv[j].w * yv[j].w); }
            const float rs = rsqrtf(wave_sum(s) * (1.f / DM) + EPS) * coef; float s2 = 0.f;
            f32x4* xo = (f32x4*)(xout + (size_t)m * DM) + C.lane;
#pragma unroll
            for (int j = 0; j < 4; ++j) { const f32x4 gg = ((const f32x4*)gpost)[C.lane + 64 * j]; xv[r][j] = xv[r][j] + yv[j] * gg * rs; xo[64 * j] = xv[r][j];
                s2 += (xv[r][j].x * xv[r][j].x + xv[r][j].y * xv[r][j].y) + (xv[r][j].z * xv[r][j].z + xv[r][j].w * xv[r][j].w); }
            if (gpre) {
                const float r2 = rsqrtf(wave_sum(s2) * (1.f / DM) + EPS);
                u32x2* o = (u32x2*)(h + (size_t)m * DM) + C.lane;
#pragma unroll
                for (int j = 0; j < 4; ++j) { const f32x4 gg = ((const f32x4*)gpre)[C.lane + 64 * j]; u32x2 w; w.x = cvt_pk_bf16(xv[r][j].x * r2 * gg.x, xv[r][j].y * r2 * gg.y); w.y = cvt_pk_bf16(xv[r][j].z * r2 * gg.z, xv[r][j].w * r2 * gg.w); o[64 * j] = w; }
            }
        }
    }
}
__device__ __forceinline__ void cb_reduce(const Ctx& C, int l) {
    const int e = C.gw * 64 + C.lane;
    if (e < 512) { const int kv = e >> 8, n = e & 255; const float* pp = (const float*)(C.ws + WS_CBP) + (size_t)l * 64 * 256 + (size_t)kv * 32 * 256 + n;
        float s = (kv ? INF(18, l, 256) : INF(15, l, 256))[n];
        for (int ch = 0; ch < 32; ++ch) s += pp[ch * 256];
        ((float*)(C.ws + WS_CB))[l * 512 + e] = s; }
}
__device__ __forceinline__ void memkv_ops(const Ctx& C, int w0, int nw) {
    const bf16_t* src = (const bf16_t*)(C.ws + WS_MKV); bf16_t* ko = (bf16_t*)(C.ws + WS_MEMK); bf16_t* vo = (bf16_t*)(C.ws + WS_MEMV);
    for (int e = w0 * 64 + C.lane; e < 512 * 1024; e += nw * 64) {
        const int mr = e >> 10, col = e & 1023, kv = col >> 9, hm = (col >> 7) & 3, d = col & 127, b = mr >> 8, m = mr & 255;
        const bf16_t v = src[e];
        if (kv == 0) ko[((size_t)((((b * 4 + hm) * 8 + (m >> 5)) * 8 + (d >> 4)) * 64 + pi32(m & 31) + 32 * ((d >> 3) & 1))) * 8 + (d & 7)] = v;
        else vo[((size_t)((((b * 4 + hm) * 16 + (m >> 4)) * 4 + (d >> 5)) * 64 + (d & 31) + 32 * ((m >> 3) & 1))) * 8 + (m & 7)] = v;
    }
}

__device__ __forceinline__ void prep_items(const Ctx& C, int l, int w0, int nw) {
    const bf16_t* P = (const bf16_t*)(C.ws + WS_R1); bf16_t* Y = (bf16_t*)(C.ws + WS_Y);
    const int lane = C.lane;
    {
        const float* cw = INF(11, l, 3 * 512);
        float w[3][8];
#pragma unroll
        for (int k = 0; k < 3; ++k)
#pragma unroll
            for (int e = 0; e < 8; ++e) w[k][e] = cw[k * 512 + lane * 8 + e];
        for (int it = w0; it < T_ / 8; it += nw) {
            const int tok0 = it * 8, s0 = tok0 & (S_ - 1);
            float c1[8], c2[8];
#pragma unroll
            for (int e = 0; e < 8; ++e) { c1[e] = 0.f; c2[e] = 0.f; }
            if (s0 > 0) {
#pragma unroll
                for (int back = 2; back >= 1; --back) {
                    const bf16_t* row = P + (size_t)(tok0 - back) * PP + lane * 8;
                    const u32x4 u = *(const u32x4*)row, cc = *(const u32x4*)(row + 1024);
                    float t[8] = {bf_lo(u.x) * bf_lo(cc.x), bf_hi(u.x) * bf_hi(cc.x), bf_lo(u.y) * bf_lo(cc.y), bf_hi(u.y) * bf_hi(cc.y), bf_lo(u.z) * bf_lo(cc.z), bf_hi(u.z) * bf_hi(cc.z), bf_lo(u.w) * bf_lo(cc.w), bf_hi(u.w) * bf_hi(cc.w)};
#pragma unroll
                    for (int e = 0; e < 8; ++e) { if (back == 2) c2[e] = t[e]; else c1[e] = t[e]; }
                }
            }
#pragma unroll
            for (int tt = 0; tt < 8; ++tt) {
                const bf16_t* row = P + (size_t)(tok0 + tt) * PP + lane * 8;
                const u32x4 u = *(const u32x4*)row, bb = *(const u32x4*)(row + 512), cc = *(const u32x4*)(row + 1024);
                const float c0[8] = {bf_lo(u.x) * bf_lo(cc.x), bf_hi(u.x) * bf_hi(cc.x), bf_lo(u.y) * bf_lo(cc.y), bf_hi(u.y) * bf_hi(cc.y), bf_lo(u.z) * bf_lo(cc.z), bf_hi(u.z) * bf_hi(cc.z), bf_lo(u.w) * bf_lo(cc.w), bf_hi(u.w) * bf_hi(cc.w)};
                const float bv[8] = {bf_lo(bb.x), bf_hi(bb.x), bf_lo(bb.y), bf_hi(bb.y), bf_lo(bb.z), bf_hi(bb.z), bf_lo(bb.w), bf_hi(bb.w)};
                float o[8];
#pragma unroll
                for (int e = 0; e < 8; ++e) { o[e] = bv[e] * (w[0][e] * c2[e] + w[1][e] * c1[e] + w[2][e] * c0[e]); c2[e] = c1[e]; c1[e] = c0[e]; }
                u32x4 ov; ov.x = cvt_pk_bf16(o[0], o[1]); ov.y = cvt_pk_bf16(o[2], o[3]); ov.z = cvt_pk_bf16(o[4], o[5]); ov.w = cvt_pk_bf16(o[6], o[7]);
                *(u32x4*)(Y + (size_t)(tok0 + tt) * YP + lane * 8) = ov;
            }
        }
    }
    {
        const float* rope = (const float*)(C.ws + WS_ROPE);
        LAS bf16_t* vt = (LAS bf16_t*)(C.lds + C.wave * 4608);
        const int hi = lane >> 5, dl = lane & 31;
        for (int it = w0; it < 4 * 512; it += nw) {
            const int bg = it >> 9, tile = it & 511, b = bg >> 1, g = bg & 1;
            const size_t tokb = (size_t)b * S_ + 32 * tile;
#pragma unroll
            for (int which = 0; which < 2; ++which) {
                const int kc = PC_KV + (2 + 2 * which) * 128 + g * 64, vc = kc + 128;
                bf16_t* kop = (bf16_t*)(C.ws + (which ? WS_KWIN : WS_KSLC)); bf16_t* vop = (bf16_t*)(C.ws + (which ? WS_VWIN : WS_VSLC));
#pragma unroll
                for (int q = 0; q < 4; ++q) {
                    const int r = (lane >> 3) + 8 * q, c = lane & 7;
                    const bf16_t* row = P + (tokb + r) * PP;
                    u32x4 kv = *(const u32x4*)(row + kc + 8 * c);
                    if (c < 2) {
                        const u32x4 pv = *(const u32x4*)(row + kc + 8 * (c ^ 1));
                        const float* rt = rope + (tokb + r) * 16;
                        const f32x4 ca = *(const f32x4*)rt, cb2 = *(const f32x4*)(rt + 4), sa = *(const f32x4*)(rt + 8), sb = *(const f32x4*)(rt + 12);
                        const float cs[8] = {ca.x, ca.y, ca.z, ca.w, cb2.x, cb2.y, cb2.z, cb2.w}, sn[8] = {sa.x, sa.y, sa.z, sa.w, sb.x, sb.y, sb.z, sb.w};
                        const float mv[8] = {bf_lo(kv.x), bf_hi(kv.x), bf_lo(kv.y), bf_hi(kv.y), bf_lo(kv.z), bf_hi(kv.z), bf_lo(kv.w), bf_hi(kv.w)};
                        const float pp[8] = {bf_lo(pv.x), bf_hi(pv.x), bf_lo(pv.y), bf_hi(pv.y), bf_lo(pv.z), bf_hi(pv.z), bf_lo(pv.w), bf_hi(pv.w)};
                        const float sg = (c == 0) ? -1.f : 1.f; float o[8];
#pragma unroll
                        for (int e = 0; e < 8; ++e) o[e] = mv[e] * cs[e] + sg * pp[e] * sn[e];
                        kv.x = cvt_pk_bf16(o[0], o[1]); kv.y = cvt_pk_bf16(o[2], o[3]); kv.z = cvt_pk_bf16(o[4], o[5]); kv.w = cvt_pk_bf16(o[6], o[7]);
                    }
                    if (which == 0)
                        *(u32x4*)(kop + ((size_t)(((bg * 512 + tile) * 2 + ((r >> 2) & 1)) * 2 + (c >> 2)) * 64 + ((r >> 3) * 4 + (r & 3)) + 16 * (c & 3)) * 8) = kv;
                    else
                        *(u32x4*)(kop + ((size_t)((bg * 512 + tile) * 4 + (c >> 1)) * 64 + pi32(r) + 32 * (c & 1)) * 8) = kv;
                    const u32x4 vv = *(const u32x4*)(row + vc + 8 * c);
                    *(LAS u32x4*)(vt + r * 72 + 8 * c) = vv;
                }
                LDS_WAIT();
#pragma unroll
                for (int o4 = 0; o4 < 4; ++o4) {
                    if (which == 0) {
                        const LAS bf16_t* sp = vt + (8 * (lane >> 4)) * 72 + 16 * o4 + (lane & 15);
                        u32x4 o; o.x = (unsigned)sp[0] | ((unsigned)sp[72] << 16); o.y = (unsigned)sp[144] | ((unsigned)sp[216] << 16); o.z = (unsigned)sp[288] | ((unsigned)sp[360] << 16); o.w = (unsigned)sp[432] | ((unsigned)sp[504] << 16);
                        *(u32x4*)(vop + ((size_t)((bg * 512 + tile) * 4 + o4) * 64 + lane) * 8) = o;
                        continue;
                    }
                    const int ks = o4 >> 1, dt = o4 & 1;
                    const LAS bf16_t* sp = vt + (16 * ks + 8 * hi) * 72 + 32 * dt + dl;
                    u32x4 o; o.x = (unsigned)sp[0] | ((unsigned)sp[72] << 16); o.y = (unsigned)sp[144] | ((unsigned)sp[216] << 16); o.z = (unsigned)sp[288] | ((unsigned)sp[360] << 16); o.w = (unsigned)sp[432] | ((unsigned)sp[504] << 16);
                    *(u32x4*)(vop + ((size_t)((bg * 1024 + 2 * tile + ks) * 2 + dt) * 64 + lane) * 8) = o;
                }
                LDS_WAIT();
            }
        }
    }
}

__device__ __forceinline__ void cmp_stage2(const Ctx& C, int l) {
    const int bxx = C.gw / NWAVES, kv = bxx & 1, wi = bxx >> 1, nwg2 = (C.G + 1 - kv) >> 1;
    const float* w2 = kv ? INF(19, l, 256 * 64) : INF(16, l, 256 * 64);
    LAS float* ws2 = (LAS float*)C.lds;
    for (int e = C.tid; e < 256 * 64 / 4; e += NWAVES * 64) ((LAS f32x4*)ws2)[e] = ((const f32x4*)w2)[e];
    __syncthreads();
    const bf16_t* hid = (const bf16_t*)(C.ws + WS_CMPP) + (size_t)kv * 4096 * 256;
    const float* cbias = (const float*)(C.ws + WS_CB) + l * 512 + kv * 256;
    bf16_t* ko = (bf16_t*)(C.ws + WS_KCMP); bf16_t* vo = (bf16_t*)(C.ws + WS_VCMP);
    const int d = C.lane;
    for (int row = wi * NWAVES + C.wave; row < 4096; row += nwg2 * NWAVES) {
        asm volatile("" ::: "memory");
        const u32x2 hv = *((const u32x2*)(hid + (size_t)row * 256) + C.lane), hw = *((const u32x2*)(hid + (size_t)(row + 8192) * 256) + C.lane);
        const f32x4 cbv = *((const f32x4*)cbias + C.lane);
        const float h0 = gelu_tanh(bf_lo(hv.x) + bf_lo(hw.x) + cbv.x), h1 = gelu_tanh(bf_hi(hv.x) + bf_hi(hw.x) + cbv.y), h2 = gelu_tanh(bf_lo(hv.y) + bf_lo(hw.y) + cbv.z), h3 = gelu_tanh(bf_hi(hv.y) + bf_hi(hw.y) + cbv.w);
        float acc = 0.f;
#pragma unroll 4
        for (int k = 0; k < 64; ++k) {
            const float a0 = __int_as_float(__builtin_amdgcn_readlane(__float_as_int(h0), k)), a1 = __int_as_float(__builtin_amdgcn_readlane(__float_as_int(h1), k));
            const float a2 = __int_as_float(__builtin_amdgcn_readlane(__float_as_int(h2), k)), a3 = __int_as_float(__builtin_amdgcn_readlane(__float_as_int(h3), k));
            acc += a0 * ws2[(4 * k + 0) * 64 + d]; acc += a1 * ws2[(4 * k + 1) * 64 + d]; acc += a2 * ws2[(4 * k + 2) * 64 + d]; acc += a3 * ws2[(4 * k + 3) * 64 + d];
        }
        const int bg = row >> 10, n = row & 1023;
        if (n == 1023) acc = 0.f;
        const bf16_t o = (bf16_t)(cvt_pk_bf16(acc, 0.f) & 0xffffu);
        if (kv == 0) ko[((size_t)((bg * 32 + (n >> 5)) * 4 + (d >> 4)) * 64 + pi32(n & 31) + 32 * ((d >> 3) & 1)) * 8 + (d & 7)] = o;
        else vo[((size_t)((bg * 64 + (n >> 4)) * 2 + (d >> 5)) * 64 + (d & 31) + 32 * ((n >> 3) & 1)) * 8 + (n & 7)] = o;
    }
    __syncthreads();
}

__device__ __forceinline__ float xhalf_max(float v) { const auto r = __builtin_amdgcn_permlane32_swap(__float_as_uint(v), __float_as_uint(v), false, false); return fmaxf(__uint_as_float(r[0]), __uint_as_float(r[1])); }
__device__ __forceinline__ float xhalf_sum(float v) { const auto r = __builtin_amdgcn_permlane32_swap(__float_as_uint(v), __float_as_uint(v), false, false); return __uint_as_float(r[0]) + __uint_as_float(r[1]); }
__device__ __forceinline__ f32x16 mfma32(bf16x8 a, bf16x8 b, f32x16 c) { return __builtin_amdgcn_mfma_f32_32x32x16_bf16(a, b, c, 0, 0, 0); }
__device__ __forceinline__ float dpp_xor1(float v) { return __int_as_float(__builtin_amdgcn_update_dpp(0, __float_as_int(v), 0xB1, 0xF, 0xF, true)); }
__device__ __forceinline__ float dpp_xor2(float v) { return __int_as_float(__builtin_amdgcn_update_dpp(0, __float_as_int(v), 0x4E, 0xF, 0xF, true)); }
__device__ __forceinline__ bf16x8 pack_p(const float* p) { u32x4 w; w.x = cvt_pk_bf16(p[0], p[1]); w.y = cvt_pk_bf16(p[2], p[3]); w.z = cvt_pk_bf16(p[4], p[5]); w.w = cvt_pk_bf16(p[6], p[7]); return __builtin_bit_cast(bf16x8, w); }
__device__ __forceinline__ bf16x8 scale_q(u32x4 v, float s) { u32x4 w; w.x = cvt_pk_bf16(bf_lo(v.x) * s, bf_hi(v.x) * s); w.y = cvt_pk_bf16(bf_lo(v.y) * s, bf_hi(v.y) * s); w.z = cvt_pk_bf16(bf_lo(v.z) * s, bf_hi(v.z) * s); w.w = cvt_pk_bf16(bf_lo(v.w) * s, bf_hi(v.w) * s); return __builtin_bit_cast(bf16x8, w); }
#define KREL(i, hi) (8 * (hi) + (i) + (((i) >= 8) ? 8 : 0))

__device__ __forceinline__ void flash_load(const bf16x8* kp, const bf16x8* vp, bf16x8 (&kf)[4], bf16x8 (&vf)[4]) {
#pragma unroll
    for (int s = 0; s < 4; ++s) kf[s] = kp[s * 64];
#pragma unroll
    for (int s = 0; s < 4; ++s) vf[s] = vp[s * 64];
    __builtin_amdgcn_sched_barrier(0);
}
__device__ __forceinline__ void flash_compute(bool domask, const bf16x8 (&kf)[4], const bf16x8 (&vf)[4], const bf16x8 (&q)[4], int x0, unsigned span, float& m, float& l, f32x16 (&O)[2]) {
    f32x16 sc;
#pragma unroll
    for (int i = 0; i < 16; ++i) sc[i] = 0.f;
#pragma unroll
    for (int s = 0; s < 4; ++s) sc = mfma32(kf[s], q[s], sc);
    if (domask) {
#pragma unroll
        for (int i = 0; i < 16; ++i) sc[i] = ((unsigned)(x0 + i + (i >= 8 ? 8 : 0)) <= span) ? sc[i] : -1e30f;
    }
    const float a0 = fmaxf(fmaxf(sc[0], sc[1]), sc[2]), a1 = fmaxf(fmaxf(sc[3], sc[4]), sc[5]), a2 = fmaxf(fmaxf(sc[6], sc[7]), sc[8]), a3 = fmaxf(fmaxf(sc[9], sc[10]), sc[11]), a4 = fmaxf(fmaxf(sc[12], sc[13]), sc[14]);
    float mx = fmaxf(fmaxf(fmaxf(a0, a1), fmaxf(a2, a3)), fmaxf(a4, sc[15]));
    mx = xhalf_max(mx);
    const float mn = fmaxf(m, mx);
    if (__ballot(mn > m) != 0ull) {
        const float alpha = ex2(m - mn); l *= alpha; O[0] = O[0] * alpha; O[1] = O[1] * alpha;
    }
    m = mn;
    const float msub = (mn < -1e29f) ? 0.f : mn;
    const f32x16 d = sc - msub;
    float p[16], ps = 0.f;
#pragma unroll
    for (int i = 0; i < 16; ++i) { p[i] = ex2(d[i]); ps += p[i]; }
    l += ps;
    const bf16x8 pb0 = pack_p(p), pb1 = pack_p(p + 8);
    O[0] = mfma32(vf[0], pb0, O[0]); O[1] = mfma32(vf[1], pb0, O[1]);
    O[0] = mfma32(vf[2], pb1, O[0]); O[1] = mfma32(vf[3], pb1, O[1]);
}
template <int MODE> __device__ __forceinline__ void flash_desc(int s, const LAS unsigned* list, int base, int t, int t0, int qi, int hi, int& tile, int& x0, unsigned& span, int& vm) {
    if constexpr (MODE == 0) {
        const unsigned e = (unsigned)__builtin_amdgcn_readfirstlane((int)list[s >> 1]);
        tile = 2 * (int)(e & 0xffffu) + (s & 1);
        const bool my = ((e >> 16) >> qi) & 1u; const int up = my ? (t - 32 * tile) : -1;
        x0 = up < 0 ? 64 : 8 * hi; span = up < 0 ? 0u : (unsigned)up;
        vm = (32 * tile + 31 <= t0) ? (((e >> 16) == 0xFFu) ? 0 : 1) : 2;
    } else {
        tile = base + s; x0 = 8 * hi - (t - 511 - 32 * tile); span = 511u;
        vm = (32 * tile + 31 <= t0 && 32 * tile >= t0 + 7 - 511) ? 0 : 2;
    }
}
template <int MODE> __device__ __forceinline__ void flash_run(const bf16x8* kb, const bf16x8* vb, const bf16x8 (&q)[4], int nsteps, const LAS unsigned* list, int base, int t, int t0, int qi, int hi, float& m, float& l, f32x16 (&O)[2]) {
    if (nsteps <= 0) return;
    bf16x8 kA[4], vA[4], kB[4], vB[4], kC[4], vC[4]; int x0A, x0B, x0C, vmA, vmB, vmC; unsigned spA, spB, spC;
#define FR_LOAD(S, KF, VF, X0, SP, VM) do { int tile_; const int sn_ = ((S) < nsteps) ? (S) : nsteps - 1; flash_desc<MODE>(sn_, list, base, t, t0, qi, hi, tile_, X0, SP, VM); \
        flash_load(kb + (size_t)tile_ * 256, vb + (size_t)tile_ * 256, KF, VF); } while (0)
    FR_LOAD(0, kA, vA, x0A, spA, vmA); FR_LOAD(1, kB, vB, x0B, spB, vmB);
#pragma unroll 1
    for (int s = 0; s < nsteps; s += 3) {
        FR_LOAD(s + 2, kC, vC, x0C, spC, vmC); flash_compute(vmA != 0, kA, vA, q, x0A, spA, m, l, O); if (s + 1 >= nsteps) break;
        FR_LOAD(s + 3, kA, vA, x0A, spA, vmA); flash_compute(vmB != 0, kB, vB, q, x0B, spB, m, l, O); if (s + 2 >= nsteps) break;
        FR_LOAD(s + 4, kB, vB, x0B, spB, vmB); flash_compute(vmC != 0, kC, vC, q, x0C, spC, m, l, O);
    }
#undef FR_LOAD
}

typedef float f32x4v __attribute__((ext_vector_type(4)));
__device__ __forceinline__ f32x4v mfma16(bf16x8 a, bf16x8 b, f32x4v c) { return __builtin_amdgcn_mfma_f32_16x16x32_bf16(a, b, c, 0, 0, 0); }
__device__ __forceinline__ float xq_max(float v) { const auto r = __builtin_amdgcn_permlane16_swap(__float_as_uint(v), __float_as_uint(v), false, false); return xhalf_max(fmaxf(__uint_as_float(r[0]), __uint_as_float(r[1]))); }
__device__ __forceinline__ float xq_sum(float v) { const auto r = __builtin_amdgcn_permlane16_swap(__float_as_uint(v), __float_as_uint(v), false, false); return xhalf_sum(__uint_as_float(r[0]) + __uint_as_float(r[1])); }
__device__ __forceinline__ void flash16_load(const bf16x8* kp, const bf16x8* vp, bf16x8 (&kf)[4], bf16x8 (&vf)[4]) {
#pragma unroll
    for (int s = 0; s < 4; ++s) kf[s] = kp[s * 64];
#pragma unroll
    for (int s = 0; s < 4; ++s) vf[s] = vp[s * 64];
    __builtin_amdgcn_sched_barrier(0);
}
__device__ __forceinline__ void flash16_compute(bool domask, const bf16x8 (&kf)[4], const bf16x8 (&vf)[4], const bf16x8 (&q)[2], int x0, unsigned span, float& m, float& l, f32x4v (&O)[4]) {
    f32x4v s0 = {0.f, 0.f, 0.f, 0.f}, s1 = {0.f, 0.f, 0.f, 0.f};
    s0 = mfma16(kf[0], q[0], s0); s1 = mfma16(kf[2], q[0], s1);
    s0 = mfma16(kf[1], q[1], s0); s1 = mfma16(kf[3], q[1], s1);
    float sc[8] = {s0[0], s0[1], s0[2], s0[3], s1[0], s1[1], s1[2], s1[3]};
    if (domask) {
#pragma unroll
        for (int j = 0; j < 8; ++j) sc[j] = ((unsigned)(x0 + j) <= span) ? sc[j] : -1e30f;
    }
    float mx = fmaxf(fmaxf(fmaxf(sc[0], sc[1]), fmaxf(sc[2], sc[3])), fmaxf(fmaxf(sc[4], sc[5]), fmaxf(sc[6], sc[7])));
    mx = xq_max(mx);
    const float mn = fmaxf(m, mx);
    if (__ballot(mn > m) != 0ull) {
        const float alpha = ex2(m - mn); l *= alpha;
#pragma unroll
        for (int dt = 0; dt < 4; ++dt) O[dt] = O[dt] * alpha;
    }
    m = mn;
    const float msub = (mn < -1e29f) ? 0.f : mn;
    float p[8], ps = 0.f;
#pragma unroll
    for (int j = 0; j < 8; ++j) { p[j] = ex2(sc[j] - msub); ps += p[j]; }
    l += ps;
    const bf16x8 pb = pack_p(p);
#pragma unroll
    for (int dt = 0; dt < 4; ++dt) O[dt] = mfma16(vf[dt], pb, O[dt]);
}
__device__ __forceinline__ unsigned flash16_entry(int s, const LAS unsigned* list) {
    const unsigned e = (unsigned)__builtin_amdgcn_readfirstlane((int)list[s >> 1]);
    return (e & 0xffff0000u) | (2u * (e & 0xffffu) + (unsigned)(s & 1));
}
__device__ __forceinline__ void flash16_run(const bf16x8* kb, const bf16x8* vb, const bf16x8 (&qa)[2], const bf16x8 (&qb)[2], int nsteps, const LAS unsigned* list, int tq, int t0, int qi4, int fq,
                                            float& ma, float& la, f32x4v (&Oa)[4], float& mb, float& lb, f32x4v (&Ob)[4]) {
    if (nsteps <= 0) return;
    bf16x8 kA[4], vA[4], kB[4], vB[4], kC[4], vC[4]; unsigned eA, eB, eC;
#define F16_LOAD(S, KF, VF, E) do { const int sn_ = ((S) < nsteps) ? (S) : nsteps - 1; E = flash16_entry(sn_, list); const size_t go_ = (size_t)(E & 0xffffu) * 256; \
        flash16_load(kb + go_, vb + go_, KF, VF); } while (0)
#define F16_COMP(KF, VF, E) do { const int grp_ = (int)(E & 0xffffu); const unsigned na_ = (E >> 16) & 0xFu, nb_ = E >> 20; const bool past_ = 32 * grp_ + 31 <= t0; \
        if (na_) { const int up_ = ((na_ >> qi4) & 1u) ? (tq - 32 * grp_) : -1; flash16_compute(!(past_ && na_ == 0xFu), KF, VF, qa, up_ < 0 ? 64 : 8 * fq, up_ < 0 ? 0u : (unsigned)up_, ma, la, Oa); } \
        if (nb_) { const int up_ = ((nb_ >> qi4) & 1u) ? (tq + 4 - 32 * grp_) : -1; flash16_compute(!(past_ && nb_ == 0xFu), KF, VF, qb, up_ < 0 ? 64 : 8 * fq, up_ < 0 ? 0u : (unsigned)up_, mb, lb, Ob); } } while (0)
    F16_LOAD(0, kA, vA, eA); F16_LOAD(1, kB, vB, eB);
#pragma unroll 1
    for (int s = 0; s < nsteps; s += 3) {
        F16_LOAD(s + 2, kC, vC, eC); F16_COMP(kA, vA, eA); if (s + 1 >= nsteps) break;
        F16_LOAD(s + 3, kA, vA, eA); F16_COMP(kB, vB, eB); if (s + 2 >= nsteps) break;
        F16_LOAD(s + 4, kB, vB, eB); F16_COMP(kC, vC, eC);
    }
#undef F16_LOAD
#undef F16_COMP
}

__device__ __forceinline__ unsigned wave_max_u32(unsigned v) {
#pragma unroll
    for (int o = 1; o < 16; o <<= 1) { const unsigned t = (unsigned)__shfl_xor((int)v, o); v = v > t ? v : t; }
    { const auto r = __builtin_amdgcn_permlane16_swap(v, v, false, false); v = r[0] > r[1] ? r[0] : r[1]; }
    { const auto r = __builtin_amdgcn_permlane32_swap(v, v, false, false); v = r[0] > r[1] ? r[0] : r[1]; }
    return v;
}

__device__ __forceinline__ void nsa_tile(const Ctx& C, int b, int g, int t0) {
    const bf16_t* P = (const bf16_t*)(C.ws + WS_R1); bf16_t* Y = (bf16_t*)(C.ws + WS_Y);
    int lane_ = C.lane; asm volatile("" : "+v"(lane_));
    const int lane = lane_, r = lane & 31, hi = lane >> 5, qi = r >> 2, h = r & 3, head = g * 4 + h, bg = b * 2 + g;
    const int t = t0 + qi; const size_t tok = (size_t)b * S_ + t;
    LAS float* imp = (LAS float*)(C.lds + C.wave * 16640);
    LAS float* ost = (LAS float*)(C.lds + C.wave * 16640 + 8448) + lane;
    const float QS = 0.18033688011112042f;
    bf16x8 qf[4];
    {
        const bf16_t* qp = P + tok * PP + PC_Q + head * 64;
#pragma unroll
        for (int s = 0; s < 4; ++s) qf[s] = scale_q(*(const u32x4*)(qp + 16 * s + 8 * hi), QS);
    }
    const bf16_t* gp = P + tok * PP + PC_NG + head * 3;
    const float gc = sigm(bf1(gp[0])), gs = sigm(bf1(gp[1])), gw = sigm(bf1(gp[2]));

    const int cur = t0 >> 6;
    {
        const int nvq = (t >= 31) ? ((t - 31) >> 4) + 1 : 0;
        const int tl = t0 + 7, nvmax = (tl >= 31) ? ((tl - 31) >> 4) + 1 : 0, ntile = (nvmax + 31) >> 5;
        const bf16x8* kb = (const bf16x8*)(C.ws + WS_KCMP) + (size_t)bg * 32 * 4 * 64 + lane;
        const bf16x8* vb = (const bf16x8*)(C.ws + WS_VCMP) + (size_t)bg * 64 * 2 * 64 + lane;
        float m1 = -1e30f, l1 = 0.f;
#define CMP_P1(KF, KT) do { \
            f32x16 sc; _Pragma("unroll") for (int i = 0; i < 16; ++i) sc[i] = 0.f; \
            _Pragma("unroll") for (int s = 0; s < 4; ++s) sc = mfma32(KF[s], qf[s], sc); \
            const int up = nvq - 1 - 32 * (KT); const int x0 = up < 0 ? 64 : 8 * hi; const unsigned span = up < 0 ? 0u : (unsigned)up; \
            float mx = -1e30f; bool ok[16]; \
            _Pragma("unroll") for (int i = 0; i < 16; ++i) { ok[i] = (unsigned)(x0 + i + (i >= 8 ? 8 : 0)) <= span; sc[i] = ok[i] ? sc[i] : -1e30f; mx = fmaxf(mx, sc[i]); } \
            mx = xhalf_max(mx); \
            const float mn = fmaxf(m1, mx); float ps = 0.f; \
            _Pragma("unroll") for (int i = 0; i < 16; ++i) ps += ok[i] ? ex2(sc[i] - mn) : 0.f; \
            l1 = l1 * ex2(m1 - mn) + ps; m1 = mn; } while (0)
        if (ntile > 0) {
            bf16x8 kA[4], kB[4], kC[4], kD[4];
#define CMP_LDK(KF, KT) do { const int kn_ = ((KT) < ntile) ? (KT) : ntile - 1; _Pragma("unroll") for (int s = 0; s < 4; ++s) KF[s] = kb[kn_ * 256 + s * 64]; } while (0)
            CMP_LDK(kA, 0); CMP_LDK(kB, 1); CMP_LDK(kC, 2);
#pragma unroll 1
            for (int kt = 0; kt < ntile; kt += 4) {
                CMP_LDK(kD, kt + 3); __builtin_amdgcn_sched_barrier(0); CMP_P1(kA, kt);     if (kt + 1 >= ntile) break;
                CMP_LDK(kA, kt + 4); __builtin_amdgcn_sched_barrier(0); CMP_P1(kB, kt + 1); if (kt + 2 >= ntile) break;
                CMP_LDK(kB, kt + 5); __builtin_amdgcn_sched_barrier(0); CMP_P1(kC, kt + 2); if (kt + 3 >= ntile) break;
                CMP_LDK(kC, kt + 6); __builtin_amdgcn_sched_barrier(0); CMP_P1(kD, kt + 3);
            }
        }
#undef CMP_P1
        l1 = xhalf_sum(l1);
        const float inv = 1.f / fmaxf(l1, 1e-30f);
        for (int e = lane; e < 8 * 264; e += 64) imp[e] = 0.f;
        LDS_WAIT();
        f32x16 O[2];
#pragma unroll
        for (int i = 0; i < 16; ++i) { O[0][i] = 0.f; O[1][i] = 0.f; }
#define CMP_P2(KF, VF, KT) do { \
            f32x16 sc; _Pragma("unroll") for (int i = 0; i < 16; ++i) sc[i] = 0.f; \
            _Pragma("unroll") for (int s = 0; s < 4; ++s) sc = mfma32(KF[s], qf[s], sc); \
            const int up = nvq - 1 - 32 * (KT); const int x0 = up < 0 ? 64 : 8 * hi; const unsigned span = up < 0 ? 0u : (unsigned)up; \
            float p[16]; \
            _Pragma("unroll") for (int i = 0; i < 16; ++i) { const bool ok = (unsigned)(x0 + i + (i >= 8 ? 8 : 0)) <= span; p[i] = ok ? ex2(sc[i] - m1) * inv : 0.f; } \
            _Pragma("unroll") for (int rr = 0; rr < 2; ++rr) { \
                const float* q8 = p + 8 * rr; \
                float a = q8[0] + q8[1] + q8[2] + 0.5f * q8[3], bq = 0.5f * q8[3] + q8[4] + q8[5] + q8[6] + 0.5f * q8[7], cq = 0.5f * q8[7]; \
                a += dpp_xor1(a); a += dpp_xor2(a); bq += dpp_xor1(bq); bq += dpp_xor2(bq); cq += dpp_xor1(cq); cq += dpp_xor2(cq); \
                _Pragma("unroll") for (int hh = 0; hh < 2; ++hh)     \
                if (h == 0 && hi == hh) { LAS float* ip = imp + qi * 264 + 8 * (KT) + 2 * hi + 4 * rr; \
                    __hip_atomic_fetch_add(ip, a, __ATOMIC_RELAXED, __HIP_MEMORY_SCOPE_WORKGROUP); __hip_atomic_fetch_add(ip + 1, bq, __ATOMIC_RELAXED, __HIP_MEMORY_SCOPE_WORKGROUP); \
                    __hip_atomic_fetch_add(ip + 2, cq, __ATOMIC_RELAXED, __HIP_MEMORY_SCOPE_WORKGROUP); } \
            } \
            const bf16x8 pb0 = pack_p(p), pb1 = pack_p(p + 8); \
            O[0] = mfma32(VF[0], pb0, O[0]); O[1] = mfma32(VF[1], pb0, O[1]); \
            O[0] = mfma32(VF[2], pb1, O[0]); O[1] = mfma32(VF[3], pb1, O[1]); } while (0)
        if (ntile > 0) {
            bf16x8 kA[4], kB[4], kC[4], vA[4];
#define CMP_LDV(KT) do { _Pragma("unroll") for (int s = 0; s < 4; ++s) vA[s] = vb[(KT) * 256 + s * 64]; } while (0)
            CMP_LDK(kA, 0); CMP_LDK(kB, 1);
#pragma unroll 1
            for (int kt = 0; kt < ntile; kt += 3) {
                CMP_LDK(kC, kt + 2); CMP_LDV(kt);     __builtin_amdgcn_sched_barrier(0); CMP_P2(kA, vA, kt);     if (kt + 1 >= ntile) break;
                CMP_LDK(kA, kt + 3); CMP_LDV(kt + 1); __builtin_amdgcn_sched_barrier(0); CMP_P2(kB, vA, kt + 1); if (kt + 2 >= ntile) break;
                CMP_LDK(kB, kt + 4); CMP_LDV(kt + 2); __builtin_amdgcn_sched_barrier(0); CMP_P2(kC, vA, kt + 2);
            }
#undef CMP_LDV
#undef CMP_LDK
        }
#undef CMP_P2
#pragma unroll
        for (int i = 0; i < 16; ++i) { ost[i * 64] = gc * O[0][i]; ost[(16 + i) * 64] = gc * O[1][i]; }
        LDS_WAIT();
    }

    unsigned bmv[4];
    if (cur <= 15) {
#pragma unroll
        for (int c = 0; c < 4; ++c) bmv[c] = (lane + 64 * c <= cur) ? 0xFFu : 0u;
    } else {
        unsigned key[8][4];
#pragma unroll
        for (int q2 = 0; q2 < 8; ++q2)
#pragma unroll
            for (int c = 0; c < 4; ++c) { const int j = lane + 64 * c; const bool cand = (j >= 1) && (j < cur - 1); const float v = imp[q2 * 264 + j];
                key[q2][c] = cand ? ((__float_as_uint(v) & 0xFFFFFF00u) | (unsigned)(255 - j)) : 0u; }
#pragma unroll
        for (int c = 0; c < 4; ++c) bmv[c] = 0u;
#pragma unroll 1
        for (int round = 0; round < 13; ++round) {
#pragma unroll
            for (int q2 = 0; q2 < 8; ++q2) {
                unsigned mx = key[q2][0]; mx = mx > key[q2][1] ? mx : key[q2][1]; mx = mx > key[q2][2] ? mx : key[q2][2]; mx = mx > key[q2][3] ? mx : key[q2][3];
                const unsigned w = wave_max_u32(mx);
#pragma unroll
                for (int c = 0; c < 4; ++c) { const bool win = (key[q2][c] == w) && (w != 0u); key[q2][c] = win ? 0u : key[q2][c]; bmv[c] |= win ? (1u << q2) : 0u; }
            }
        }
#pragma unroll
        for (int c = 0; c < 4; ++c) { const int j = lane + 64 * c; if (j == 0 || j == cur || j == cur - 1) bmv[c] = 0xFFu; }
    }

    {
        LAS unsigned* list = (LAS unsigned*)imp;
        LAS float* ostb = (LAS float*)(C.lds + C.wave * 16640 + 8448);
        const int q16 = lane & 15, fq = lane >> 4, qi4 = q16 >> 2, head4 = g * 4 + (q16 & 3);
        const bf16x8* kb = (const bf16x8*)(C.ws + WS_KSLC) + (size_t)bg * 512 * 256 + lane;
        const bf16x8* vb = (const bf16x8*)(C.ws + WS_VSLC) + (size_t)bg * 512 * 256 + lane;
        int nblk = 0;
#pragma unroll
        for (int c = 0; c < 4; ++c) {
            const unsigned long long mk = __ballot(bmv[c] != 0u);
            const int pos = nblk + (int)__builtin_amdgcn_mbcnt_hi((unsigned)(mk >> 32), __builtin_amdgcn_mbcnt_lo((unsigned)mk, 0u));
            if (bmv[c] != 0u) list[pos] = (unsigned)(lane + 64 * c) | (bmv[c] << 16);
            nblk += __builtin_popcountll(mk);
        }
        LDS_WAIT();
        const int tq = t0 + qi4;
        bf16x8 q16f[2][2]; float gs4[2];
#pragma unroll
        for (int sub = 0; sub < 2; ++sub) {
            const size_t tok4 = (size_t)b * S_ + tq + 4 * sub;
            const bf16_t* qp = P + tok4 * PP + PC_Q + head4 * 64;
            q16f[sub][1] = scale_q(*(const u32x4*)(qp + 32 + 8 * fq), QS);
            const u32x4 mv4 = *(const u32x4*)(qp + 8 * fq), pv4 = *(const u32x4*)(qp + 8 * ((fq ^ 1) & 1));
            const float* rt = (const float*)(C.ws + WS_ROPE) + tok4 * 16;
            const f32x4 ca = *(const f32x4*)rt, cb2 = *(const f32x4*)(rt + 4), sa = *(const f32x4*)(rt + 8), sb = *(const f32x4*)(rt + 12);
            const float cs[8] = {ca.x, ca.y, ca.z, ca.w, cb2.x, cb2.y, cb2.z, cb2.w}, sn[8] = {sa.x, sa.y, sa.z, sa.w, sb.x, sb.y, sb.z, sb.w};
            const float mv[8] = {bf_lo(mv4.x), bf_hi(mv4.x), bf_lo(mv4.y), bf_hi(mv4.y), bf_lo(mv4.z), bf_hi(mv4.z), bf_lo(mv4.w), bf_hi(mv4.w)};
            const float pp[8] = {bf_lo(pv4.x), bf_hi(pv4.x), bf_lo(pv4.y), bf_hi(pv4.y), bf_lo(pv4.z), bf_hi(pv4.z), bf_lo(pv4.w), bf_hi(pv4.w)};
            const bool roped = fq < 2; const float sg = (fq == 0) ? -1.f : 1.f; float o[8];
#pragma unroll
            for (int e = 0; e < 8; ++e) o[e] = (roped ? (mv[e] * cs[e] + sg * pp[e] * sn[e]) : mv[e]) * QS;
            q16f[sub][0] = pack_p(o);
            gs4[sub] = sigm(bf1(P[tok4 * PP + PC_NG + head4 * 3 + 1]));
        }
        float ma = -1e30f, la = 0.f, mb = -1e30f, lb = 0.f; f32x4v Oa[4], Ob[4];
#pragma unroll
        for (int dt = 0; dt < 4; ++dt) { Oa[dt] = (f32x4v){0.f, 0.f, 0.f, 0.f}; Ob[dt] = (f32x4v){0.f, 0.f, 0.f, 0.f}; }
        flash16_run(kb, vb, q16f[0], q16f[1], 2 * nblk, list, tq, t0, qi4, fq, ma, la, Oa, mb, lb, Ob);
        la = xq_sum(la); lb = xq_sum(lb);
        const float sca = gs4[0] / fmaxf(la, 1e-30f), scb = gs4[1] / fmaxf(lb, 1e-30f);
#pragma unroll
        for (int dt = 0; dt < 4; ++dt)
#pragma unroll
            for (int i = 0; i < 4; ++i) { LAS float* op = ostb + ((dt >> 1) * 16 + 4 * (2 * (dt & 1) + (fq >> 1)) + i) * 64 + q16 + 32 * (fq & 1); op[0] += sca * Oa[dt][i]; op[16] += scb * Ob[dt][i]; }
        LDS_WAIT();
    }
    {
        bf16x8 qr[4];
        {
            const bf16_t* qp = P + tok * PP + PC_Q + head * 64;
#pragma unroll
            for (int s = 1; s < 4; ++s) qr[s] = scale_q(*(const u32x4*)(qp + 16 * s + 8 * hi), QS);
            const u32x4 mv4 = *(const u32x4*)(qp + 8 * hi), pv4 = *(const u32x4*)(qp + 8 * (hi ^ 1));
            const float* rt = (const float*)(C.ws + WS_ROPE) + tok * 16;
            const f32x4 ca = *(const f32x4*)rt, cb2 = *(const f32x4*)(rt + 4), sa = *(const f32x4*)(rt + 8), sb = *(const f32x4*)(rt + 12);
            const float cs[8] = {ca.x, ca.y, ca.z, ca.w, cb2.x, cb2.y, cb2.z, cb2.w}, sn[8] = {sa.x, sa.y, sa.z, sa.w, sb.x, sb.y, sb.z, sb.w};
            const float mv[8] = {bf_lo(mv4.x), bf_hi(mv4.x), bf_lo(mv4.y), bf_hi(mv4.y), bf_lo(mv4.z), bf_hi(mv4.z), bf_lo(mv4.w), bf_hi(mv4.w)};
            const float pp[8] = {bf_lo(pv4.x), bf_hi(pv4.x), bf_lo(pv4.y), bf_hi(pv4.y), bf_lo(pv4.z), bf_hi(pv4.z), bf_lo(pv4.w), bf_hi(pv4.w)};
            const float sg = hi ? 1.f : -1.f; float o[8];
#pragma unroll
            for (int e = 0; e < 8; ++e) o[e] = (mv[e] * cs[e] + sg * pp[e] * sn[e]) * QS;
            qr[0] = pack_p(o);
        }
        const bf16x8* kb = (const bf16x8*)(C.ws + WS_KWIN) + (size_t)bg * 512 * 4 * 64 + lane;
        const bf16x8* vb = (const bf16x8*)(C.ws + WS_VWIN) + (size_t)bg * 1024 * 2 * 64 + lane;
        float m = -1e30f, l = 0.f; f32x16 O[2];
#pragma unroll
        for (int i = 0; i < 16; ++i) { O[0][i] = 0.f; O[1][i] = 0.f; }
        const int tlo = (t0 - 511 > 0 ? t0 - 511 : 0) >> 5, thi = (t0 + 7) >> 5;
        flash_run<1>(kb, vb, qr, thi - tlo + 1, (const LAS unsigned*)imp, tlo, t, t0, qi, hi, m, l, O);
        l = xhalf_sum(l);
        const float sc = gw / fmaxf(l, 1e-30f);
        bf16_t* yp = Y + tok * YP + 512 + head * 64 + 4 * hi;
#pragma unroll
        for (int dt = 0; dt < 2; ++dt)
#pragma unroll
            for (int ig = 0; ig < 4; ++ig) { float o4[4];
#pragma unroll
                for (int e = 0; e < 4; ++e) o4[e] = ost[(dt * 16 + 4 * ig + e) * 64] + sc * O[dt][4 * ig + e];
                u32x2 w; w.x = cvt_pk_bf16(o4[0], o4[1]); w.y = cvt_pk_bf16(o4[2], o4[3]); *(u32x2*)(yp + 32 * dt + 8 * ig) = w; }
        LDS_WAIT();
    }
}

__device__ __forceinline__ void mem_tile(const Ctx& C, int b, int hm, int t0) {
    const bf16_t* P = (const bf16_t*)(C.ws + WS_R1); bf16_t* Y = (bf16_t*)(C.ws + WS_Y);
    int lane_ = C.lane; asm volatile("" : "+v"(lane_));
    const int lane = lane_, r = lane & 31, hi = lane >> 5;
    const size_t tok = (size_t)b * S_ + t0 + r;
    const float QS = 0.12751743082459868f;
    bf16x8 q[8];
    const bf16_t* qp = P + tok * PP + PC_QM + hm * 128;
#pragma unroll
    for (int s = 0; s < 8; ++s) q[s] = scale_q(*(const u32x4*)(qp + 16 * s + 8 * hi), QS);
    const bf16x8* kb = (const bf16x8*)(C.ws + WS_MEMK) + (size_t)(b * 4 + hm) * 8 * 8 * 64 + lane;
    const bf16x8* vb = (const bf16x8*)(C.ws + WS_MEMV) + (size_t)(b * 4 + hm) * 16 * 4 * 64 + lane;
    float m = -1e30f, l = 0.f; f32x16 O[4];
#pragma unroll
    for (int i = 0; i < 16; ++i) { O[0][i] = 0.f; O[1][i] = 0.f; O[2][i] = 0.f; O[3][i] = 0.f; }
#define MEM_STEP(KF, VF) do { \
        f32x16 sc; _Pragma("unroll") for (int i = 0; i < 16; ++i) sc[i] = 0.f; \
        _Pragma("unroll") for (int s = 0; s < 8; ++s) sc = mfma32(KF[s], q[s], sc); \
        float mx = -1e30f; _Pragma("unroll") for (int i = 0; i < 16; ++i) mx = fmaxf(mx, sc[i]); \
        mx = xhalf_max(mx); \
        const float mn = fmaxf(m, mx), alpha = ex2(m - mn); m = mn; \
        float p[16], ps = 0.f; _Pragma("unroll") for (int i = 0; i < 16; ++i) { p[i] = ex2(sc[i] - mn); ps += p[i]; } \
        l = l * alpha + ps; \
        _Pragma("unroll") for (int i = 0; i < 16; ++i) { O[0][i] *= alpha; O[1][i] *= alpha; O[2][i] *= alpha; O[3][i] *= alpha; } \
        const bf16x8 pb0 = pack_p(p), pb1 = pack_p(p + 8); \
        _Pragma("unroll") for (int dt = 0; dt < 4; ++dt) { O[dt] = mfma32(VF[dt], pb0, O[dt]); O[dt] = mfma32(VF[4 + dt], pb1, O[dt]); } } while (0)
    {
        bf16x8 kA[8], vv[8];
#pragma unroll 1
        for (int kt = 0; kt < 8; ++kt) {
#pragma unroll
            for (int s = 0; s < 8; ++s) kA[s] = kb[kt * 512 + s * 64];
#pragma unroll
            for (int s = 0; s < 8; ++s) vv[s] = vb[kt * 512 + s * 64];
            __builtin_amdgcn_sched_barrier(0);
            MEM_STEP(kA, vv);
        }
    }
#undef MEM_STEP
    l = xhalf_sum(l);
    const float inv = 1.f / l;
    bf16_t* yp = Y + tok * YP + 1024 + hm * 128 + 4 * hi;
#pragma unroll
    for (int dt = 0; dt < 4; ++dt)
#pragma unroll
        for (int ig = 0; ig < 4; ++ig) { u32x2 w; w.x = cvt_pk_bf16(O[dt][4 * ig] * inv, O[dt][4 * ig + 1] * inv); w.y = cvt_pk_bf16(O[dt][4 * ig + 2] * inv, O[dt][4 * ig + 3] * inv); *(u32x2*)(yp + 32 * dt + 8 * ig) = w; }
}

__device__ __forceinline__ void attention_phase(const Ctx& C) {
    const int bxx = C.gw / NWAVES; const bool xmode = (C.G & 7) == 0;
    const int x = bxx & 7, rank = xmode ? (bxx >> 3) * NWAVES + C.wave : C.gw, nrank = xmode ? (C.G >> 3) * NWAVES : C.NGW, nitem = xmode ? 1536 : 12288;
    for (int i = rank; i < nitem; i += nrank) {
        int nsa_n, mem_e;
        if (xmode) { nsa_n = (i < 1024) ? (x >> 1) * 2048 + 2 * i + (x & 1) : -1; mem_e = x * 512 + (i - 1024); }
        else { if (i < 8192) { const int k = i >> 11, w = i & 2047; nsa_n = k * 2048 + ((k & 1) ? 2047 - w : w); } else nsa_n = -1; mem_e = i - 8192; }
        if (nsa_n >= 0) { const int k = nsa_n >> 11; nsa_tile(C, k >> 1, k & 1, (nsa_n & 2047) * 8); }
        else { const int bh = mem_e >> 9; mem_tile(C, bh >> 2, bh & 3, (mem_e & 511) * 32); }
    }
}

#define XB_TMO      128
#define XB_XCNT(j)  (256  + 64 * (j))
#define XB_XSUB(j)  (1280 + 64 * (j))
#define XB_XGEN(j)  (2304 + 64 * (j))
#define XB_TOP      3328
#define XB_TOPGEN   3392
#define XCD_BAR_WORDS 3456
#define XB_SPIN_CAP (1u << 18)
__device__ __forceinline__ unsigned xb_ld(unsigned* p)              { return __hip_atomic_load(p, __ATOMIC_RELAXED, __HIP_MEMORY_SCOPE_AGENT); }
__device__ __forceinline__ unsigned xb_add(unsigned* p, unsigned v) { return __hip_atomic_fetch_add(p, v, __ATOMIC_RELAXED, __HIP_MEMORY_SCOPE_AGENT); }
__device__ __forceinline__ unsigned xb_xcc_id() { return (unsigned)__builtin_amdgcn_s_getreg((3 << 11) | 20) & 0xFu; }
#define XB_SPIN(cond, bar) do { unsigned _sp = 0; while (cond) { __builtin_amdgcn_s_sleep(1); \
    if ((++_sp & 255u) == 0u) { if (xb_ld(&(bar)[XB_TMO])) break; if (_sp > XB_SPIN_CAP) { atomicAdd(&(bar)[XB_TMO], 1u); break; } } } } while (0)
__device__ __forceinline__ void xcd_barrier_complete(unsigned* bar, unsigned x, unsigned& nloc, unsigned& nx) {
    const unsigned G = gridDim.x * gridDim.y * gridDim.z;
    unsigned sum, cnt, mine, sp = 0u;
    for (;;) {
        sum = 0u; cnt = 0u; mine = 0u;
#pragma unroll
        for (unsigned j = 0; j < 16; ++j) { const unsigned c = xb_ld(&bar[XB_XCNT(j)]); sum += c; cnt += (c > 0u) ? 1u : 0u; mine = (j == x) ? c : mine; }
        if (sum == G) break;
        __builtin_amdgcn_s_sleep(1);
        if ((++sp & 255u) == 0u) { if (xb_ld(&bar[XB_TMO])) break; if (sp > XB_SPIN_CAP) { atomicAdd(&bar[XB_TMO], 1u); break; } }
    }
    nloc = mine > 0u ? mine : 1u; nx = cnt > 0u ? cnt : 1u;
}
__device__ __forceinline__ void xcd_barrier(unsigned* bar, volatile LAS unsigned* st, bool tid0) {
    asm volatile("s_waitcnt vmcnt(0)" ::: "memory");
    __syncthreads();
    if (tid0) {
        __builtin_amdgcn_s_waitcnt(0);
        const unsigned x = xb_xcc_id();
        unsigned nloc = st[0], nx = st[1];
        if (nloc == 0u) { xcd_barrier_complete(bar, x, nloc, nx); st[0] = nloc; st[1] = nx; }
        const unsigned old = xb_add(&bar[XB_XSUB(x)], 1u);
        const unsigned gen = old / nloc;
        if (old + 1u == (gen + 1u) * nloc) {
            __builtin_amdgcn_fence(__ATOMIC_RELEASE, "agent");
            asm volatile("s_waitcnt vmcnt(0)" ::: "memory");
            const unsigned og = xb_add(&bar[XB_TOP], 1u);
            const unsigned tg = og / nx;
            if (og + 1u == (tg + 1u) * nx) xb_add(&bar[XB_TOPGEN], 1u);
            else XB_SPIN(xb_ld(&bar[XB_TOPGEN]) == tg, bar);
            __builtin_amdgcn_fence(__ATOMIC_ACQUIRE, "agent");
            xb_add(&bar[XB_XGEN(x)], 1u);
            asm volatile("s_waitcnt vmcnt(0)" ::: "memory");
        } else {
            XB_SPIN(xb_ld(&bar[XB_XGEN(x)]) == gen, bar);
            __builtin_amdgcn_fence(__ATOMIC_ACQUIRE, "agent");
            asm volatile("s_waitcnt vmcnt(0)" ::: "memory");
        }
    }
    __syncthreads();
}

constexpr int LDS_BYTES = 147456, XB_LDS_OFF = 147456 - 64;
constexpr int NPHASE = 1 + 2 * 14;

__global__ void __launch_bounds__(NWAVES * 64, 2) fwd_kernel(Args args) {
    extern __shared__ __attribute__((aligned(16))) unsigned char lds_raw[];
    cg::grid_group grid = cg::this_grid();
    if (args.ph_lo == 0x7fffffff) grid.sync();
    const int wave0 = __builtin_amdgcn_readfirstlane((int)threadIdx.x >> 6);
    {
        volatile LAS unsigned* st = (volatile LAS unsigned*)(lds_raw + XB_LDS_OFF);
        if (threadIdx.x == 0) { st[0] = 0u; st[1] = 0u; (void)xb_add((unsigned*)(args.ws + WS_BAR) + XB_XCNT(xb_xcc_id()), 1u); }
        __syncthreads();
    }
#define PHASE_BEGIN { \
        unsigned char* ws0_ = args.ws; asm volatile("" : "+s"(ws0_)); gu8* ws = (gu8*)ws0_;     \
        int tid_; asm volatile("v_mbcnt_lo_u32_b32 %0, -1, 0\n\tv_mbcnt_hi_u32_b32 %0, -1, %0" : "=v"(tid_)); tid_ += wave0 * 64; \
        Ctx C; C.a = &args; C.ws = ws; C.lds = (LAS unsigned char*)lds_raw; C.tid = tid_; C.lane = tid_ & 63; C.wave = __builtin_amdgcn_readfirstlane(tid_ >> 6); \
        int bx = blockIdx.x; asm volatile("" : "+s"(bx)); C.G = gridDim.x; C.gw = bx * NWAVES + C.wave; C.NGW = C.G * NWAVES; \
        bf16_t* const H = (bf16_t*)(ws + WS_H); bf16_t* const R1 = (bf16_t*)(ws + WS_R1); bf16_t* const Y = (bf16_t*)(ws + WS_Y); (void)H; (void)R1; (void)Y; (void)bx;
#define PHASE_END   { int ln_; asm volatile("v_mbcnt_lo_u32_b32 %0, -1, 0\n\tv_mbcnt_hi_u32_b32 %0, -1, %0" : "=v"(ln_));   \
        xcd_barrier((unsigned*)(ws + WS_BAR), (volatile LAS unsigned*)(lds_raw + XB_LDS_OFF), (wave0 == 0) && (ln_ == 0)); } }
#define PHASE_END_IF(c_) { if (c_) { int ln_; asm volatile("v_mbcnt_lo_u32_b32 %0, -1, 0\n\tv_mbcnt_hi_u32_b32 %0, -1, %0" : "=v"(ln_));   \
        xcd_barrier((unsigned*)(ws + WS_BAR), (volatile LAS unsigned*)(lds_raw + XB_LDS_OFF), (wave0 == 0) && (ln_ == 0)); } } }
#define PHASE_END_CG grid.sync(); }

    PHASE_BEGIN
        convert_layer(C, 0);
        rope_table(C);
        prenorm_rows(C, (const float*)args.in[0], (const float*)args.in[3], H);
    PHASE_END

#pragma unroll 1
    for (int l = 0; l < 2; ++l) {
        PHASE_BEGIN
            { pg8::GemmDesc g{(const char*)H, (const char*)(ws + WS_W1IN), DM, DM, 128, 128, 16}; pg8::StdOrder S; S.init(T_, 2 * FF, C.G, bx, DM, DM);
              pg8::Epi<1> E{R1, FF, nullptr, nullptr}; pg8::gemm_phase(C.lds, C.tid, g, S, E); }
        PHASE_END
        PHASE_BEGIN
            { pg8::GemmDesc g{(const char*)R1, (const char*)(ws + WS_W1OUT), FF, FF, 128, 128, 44}; pg8::StdOrder S; S.init(T_, DM, C.G, bx, FF, FF);
              pg8::Epi<0> E{H, DM, nullptr, nullptr}; pg8::gemm_phase(C.lds, C.tid, g, S, E); }
        PHASE_END
        PHASE_BEGIN
            if (bx < 8) {
                { pg8::GemmDesc g{(const char*)(ws + WS_MEMN), (const char*)(ws + WS_WMKV), DM, DM, 128, 128, 16}; pg8::StdOrder S; S.init(512, DM, C.G, bx, DM, DM);
              pg8::Epi<0> E{(bf16_t*)(ws + WS_MKV), DM, nullptr, nullptr}; pg8::gemm_phase(C.lds, C.tid, g, S, E); }
            } else {
                norm_phase(C, C.gw - 8 * NWAVES, C.NGW - 8 * NWAVES, l == 0 ? (const float*)args.in[0] : args.out, args.out, H, H, INF(4, l, DM), INF(7, l, DM), 0.5f);
            }
            cb_reduce(C, l);
        PHASE_END
        PHASE_BEGIN
            { pg8::GemmDesc g{(const char*)H, (const char*)(ws + WS_WMIX), DM, DM, 128, 128, 16}; pg8::StdOrder S; S.init(T_, PP, C.G, bx, DM, DM);
              pg8::Epi<0> E{R1, PP, nullptr, nullptr}; pg8::gemm_phase(C.lds, C.tid, g, S, E); }
        PHASE_END
        PHASE_BEGIN
            if (bx < 64) {
                pg8::GemmDesc g{(const char*)R1, (const char*)(ws + WS_WC1), 16 * PP, 2048, PP * 2, 128, 16}; pg8::CmpOrder S{bx};
                pg8::Epi<0> E{(bf16_t*)(ws + WS_CMPP), 256, nullptr, nullptr}; pg8::gemm_phase(C.lds, C.tid, g, S, E);
            } else {
                prep_items(C, l, C.gw - 64 * NWAVES, C.NGW - 64 * NWAVES);
                memkv_ops(C, C.gw - 64 * NWAVES, C.NGW - 64 * NWAVES);
            }
        PHASE_END
        PHASE_BEGIN
            cmp_stage2(C, l);
        PHASE_END
        PHASE_BEGIN
            attention_phase(C);
        PHASE_END
        PHASE_BEGIN
            { pg8::GemmDesc g{(const char*)H, (const char*)(ws + WS_WG), DM, DM, 128, 128, 16}; pg8::StdOrder S; S.init(T_, GP, C.G, bx, DM, DM);
              pg8::Epi<2> E{R1, GP, nullptr, nullptr}; pg8::gemm_phase(C.lds, C.tid, g, S, E); }
        PHASE_END
        PHASE_BEGIN
            { pg8::GemmDesc g{(const char*)Y, (const char*)(ws + WS_WBR), YP, YP, 128, 128, 8}; pg8::MergeOrder S; S.init(T_, DM, C.G, bx, YP, YP);
              pg8::Epi<3> E{H, DM, R1, nullptr}; pg8::gemm_phase(C.lds, C.tid, g, S, E); }
        PHASE_END
        PHASE_BEGIN
            { pg8::GemmDesc g{(const char*)H, (const char*)(ws + WS_WOUT), DM, DM, 128, 128, 16}; pg8::StdOrder S; S.init(T_, DM, C.G, bx, DM, DM);
              pg8::Epi<0> E{R1, DM, nullptr, nullptr}; pg8::gemm_phase(C.lds, C.tid, g, S, E); }
        PHASE_END
        PHASE_BEGIN
            norm_phase(C, C.gw, C.NGW, args.out, args.out, R1, H, INF(8, l, DM), INF(25, l, DM), 1.0f);
        PHASE_END
        PHASE_BEGIN
            { pg8::GemmDesc g{(const char*)H, (const char*)(ws + WS_W2IN), DM, DM, 128, 128, 16}; pg8::StdOrder S; S.init(T_, 2 * FF, C.G, bx, DM, DM);
              pg8::Epi<1> E{R1, FF, nullptr, nullptr}; pg8::gemm_phase(C.lds, C.tid, g, S, E); }
        PHASE_END
        PHASE_BEGIN
            { pg8::GemmDesc g{(const char*)R1, (const char*)(ws + WS_W2OUT), FF, FF, 128, 128, 44}; pg8::StdOrder S; S.init(T_, DM, C.G, bx, FF, FF);
              pg8::Epi<0> E{H, DM, nullptr, nullptr}; pg8::gemm_phase(C.lds, C.tid, g, S, E); }
        PHASE_END
        PHASE_BEGIN
            norm_phase(C, C.gw, C.NGW, args.out, args.out, H, H, INF(26, l, DM), l == 0 ? INF(3, 1, DM) : nullptr, 0.5f);
            if (l == 0) convert_layer(C, 1);
        PHASE_END_IF(l == 0)
    }
}

extern "C" void kernel_launch(void* const* d_in, const int* in_sizes, int n_in, void* d_out, int out_size, void* d_ws, size_t ws_size, hipStream_t stream) {
    static int grid = 0;
    if (grid == 0) {
        if (n_in != 29 || ws_size < WS_END) { fprintf(stderr, "kernel_launch: unexpected n_in %d / ws %zu\n", n_in, ws_size); grid = -1; return; }
        int dev = 0, cus = 0, per_cu = 0;
        hipGetDevice(&dev); hipDeviceGetAttribute(&cus, hipDeviceAttributeMultiprocessorCount, dev);
        hipFuncSetAttribute((const void*)fwd_kernel, hipFuncAttributeMaxDynamicSharedMemorySize, LDS_BYTES);
        hipOccupancyMaxActiveBlocksPerMultiprocessor(&per_cu, (const void*)fwd_kernel, NWAVES * 64, LDS_BYTES);
        if (per_cu < 1) per_cu = 1;
        grid = cus * per_cu;
        (void)hipGetLastError();
    }
    if (grid < 0) return;
    hipMemsetAsync((char*)d_ws + WS_BAR, 0, 16384, stream);
    Args a{};
    for (int i = 0; i < 29; ++i) a.in[i] = d_in[i];
    a.out = (float*)d_out; a.ws = (unsigned char*)d_ws; a.ph_lo = 0; a.ph_hi = NPHASE;
    void* kargs[] = {&a};
    hipError_t e = hipLaunchCooperativeKernel((const void*)fwd_kernel, dim3(grid), dim3(NWAVES * 64), kargs, LDS_BYTES, stream);
    if (e != hipSuccess) fprintf(stderr, "cooperative launch failed: %s (grid %d)\n", hipGetErrorString(e), grid);
}
```

```cpp
#include <hip/hip_runtime.h>
#include <hip/hip_cooperative_groups.h>
#include <cstdio>
#include <cstdint>
namespace cg = cooperative_groups;

#define LAS __attribute__((address_space(3)))
typedef unsigned short bf16_t;
typedef short bf16x8 __attribute__((ext_vector_type(8)));
typedef float f32x4 __attribute__((ext_vector_type(4)));
typedef float f32x16 __attribute__((ext_vector_type(16)));
typedef unsigned u32x4 __attribute__((ext_vector_type(4)));
typedef unsigned u32x2 __attribute__((ext_vector_type(2)));

constexpr int NBATCH = 2, S_ = 16384, T_ = NBATCH * S_, DM = 1024, FF = 2816, PP = 3584, GP = 3072, YP = 1536;
constexpr int NWAVES = 8;
constexpr float EPS = 1e-6f;
constexpr int PC_Q = 1536, PC_KV = 2048, PC_QM = 2816, PC_NG = 3328;

constexpr size_t MiB = 1u << 20;
constexpr size_t WS_W1IN = 0, WS_W1OUT = 11 * MiB, WS_WMIX = WS_W1OUT + 11 * MiB / 2, WS_WG = WS_WMIX + 7 * MiB, WS_WBR = WS_WG + 6 * MiB, WS_WOUT = WS_WBR + 3 * MiB,
                 WS_W2IN = WS_WOUT + 2 * MiB, WS_W2OUT = WS_W2IN + 11 * MiB, WS_WC1 = WS_W2OUT + 11 * MiB / 2  , WS_WMKV = WS_WC1 + 2 * MiB,
                 WS_MEMN = WS_WMKV + 2 * MiB, WS_MKV = WS_MEMN + 1 * MiB, WS_CB = WS_MKV + 1 * MiB  , WS_CBP = WS_CB + 8192  , WS_BAR = WS_CB + 8192 + 131072  ;
static_assert(WS_CB == 57 * MiB, "ws map");
constexpr size_t WS_ROPE = 58 * MiB, WS_MEMK = 60 * MiB, WS_MEMV = WS_MEMK + MiB / 2, WS_KCMP = 61 * MiB, WS_VCMP = WS_KCMP + MiB / 2, WS_CMPH = 62 * MiB,
                 WS_KSLC = 66 * MiB, WS_VSLC = 74 * MiB, WS_KWIN = 82 * MiB, WS_VWIN = 90 * MiB, WS_H = 98 * MiB, WS_Y = 162 * MiB, WS_R1 = 258 * MiB, WS_CMPP = 484 * MiB  , WS_END = 492 * MiB;

typedef float f32x2_t __attribute__((ext_vector_type(2)));
typedef __bf16 bf16x2_t __attribute__((ext_vector_type(2)));
__device__ __forceinline__ unsigned cvt_pk_bf16(float lo, float hi) { f32x2_t v = {lo, hi}; bf16x2_t b = __builtin_convertvector(v, bf16x2_t); return __builtin_bit_cast(unsigned, b); }
__device__ __forceinline__ float bf_lo(unsigned u) { return __uint_as_float(u << 16); }
__device__ __forceinline__ float bf_hi(unsigned u) { return __uint_as_float(u & 0xffff0000u); }
__device__ __forceinline__ float bf1(bf16_t u) { return __uint_as_float(((unsigned)u) << 16); }
__device__ __forceinline__ float ex2(float x) { return __builtin_amdgcn_exp2f(x); }
__device__ __forceinline__ float rcpf_(float x) { return __builtin_amdgcn_rcpf(x); }
__device__ __forceinline__ float sigm(float x) { return rcpf_(1.f + ex2(-1.44269504f * x)); }
__device__ __forceinline__ float gelu_tanh(float x) { const float u = 0.7978845608f * (x + 0.044715f * x * x * x); return x * rcpf_(1.f + ex2(-2.88539008f * u)); }
#define DPP_F(v, ctrl) __int_as_float(__builtin_amdgcn_update_dpp(0, __float_as_int(v), ctrl, 0xF, 0xF, true))
__device__ __forceinline__ float wave_sum(float v) {
    v += DPP_F(v, 0xB1); v += DPP_F(v, 0x4E); v += DPP_F(v, 0x141); v += DPP_F(v, 0x140);
    { const auto r = __builtin_amdgcn_permlane16_swap(__float_as_uint(v), __float_as_uint(v), false, false); v = __uint_as_float(r[0]) + __uint_as_float(r[1]); }
    { const auto r = __builtin_amdgcn_permlane32_swap(__float_as_uint(v), __float_as_uint(v), false, false); v = __uint_as_float(r[0]) + __uint_as_float(r[1]); }
    return v;
}
__device__ __forceinline__ int pi32(int r) { return (r & 0x13) | ((r & 4) << 1) | ((r & 8) >> 1); }
#define LDS_WAIT() asm volatile("s_waitcnt lgkmcnt(0)" ::: "memory")

namespace pg8 {
constexpr int BM = 256, BK = 64, HALF = 128, HTB = HALF * BK * 2, STAGE_BYTES = 8 * HTB, NXCD = 8, WGM = 8;
__device__ __forceinline__ int lds_byte(int r, int c) { const int st = (r >> 4) * 2 + (c >> 5), rr = r & 15, cc = c & 31, ob = rr * 64 + cc * 2; return st * 1024 + (ob ^ (((ob >> 9) & 1) << 5)); }
__device__ __forceinline__ void stage_rc(int b, int& R, int& C) { const int st = b / 1024, sb = b % 1024, swz = sb ^ (((sb >> 9) & 1) << 5); R = (st >> 1) * 16 + swz / 64; C = (st & 1) * 32 + (swz % 64) / 2; }
__device__ __forceinline__ int perm32(int rho) { const int n = rho >> 4, i = rho & 15; return 8 * (i >> 2) + 4 * n + (i & 3); }

struct Unit { int pm, pn, tag; long long aoff, boff; };
struct GemmDesc { const char* A; const char* Bt; int lda, ldb, kstepA, kstepB, nt; };

__device__ __forceinline__ void swz_tile(int L, int nM, int nN, int& pm, int& pn) {
    const int nwg = nM * nN; int wgid = L;
    { const int q = nwg / NXCD, r = nwg % NXCD, xcd = wgid % NXCD, off = wgid / NXCD; wgid = (xcd < r ? xcd * (q + 1) : r * (q + 1) + (xcd - r) * q) + off; }
    const int nig = WGM * nN, gid = wgid / nig, fm = gid * WGM, gsz = (nM - fm) < WGM ? (nM - fm) : WGM;
    pm = fm + ((wgid % nig) % gsz); pn = (wgid % nig) / gsz;
}
struct StdOrder {
    int nM, nN, G, c; long long tA, tB;
    __device__ void init(int M, int N, int G_, int c_, int lda, int ldb) { nM = M / BM; nN = N / BM; G = G_; c = c_; tA = 512LL * lda; tB = 512LL * ldb; }
    __device__ bool next(int i, Unit& u) const {
        const long long L = (long long)i * G + c; if (L >= (long long)nM * nN) return false;
        swz_tile((int)L, nM, nN, u.pm, u.pn); u.tag = 0; u.aoff = u.pm * tA; u.boff = u.pn * tB; return true;
    }
};
struct MergeOrder {
    int nM, nN, G, c; long long tA, tB;
    __device__ void init(int M, int N, int G_, int c_, int lda, int ldb) { nM = M / BM; nN = N / BM; G = G_; c = c_; tA = 512LL * lda; tB = 512LL * ldb; }
    __device__ bool next(int i, Unit& u) const {
        const int ti = i / 3, br = i - 3 * ti; const long long L = (long long)ti * G + c; if (L >= (long long)nM * nN) return false;
        swz_tile((int)L, nM, nN, u.pm, u.pn); u.tag = br; u.aoff = u.pm * tA + br * 1024; u.boff = u.pn * tB + br * 1024; return true;
    }
};
struct CmpOrder {
    int c;
    __device__ bool next(int i, Unit& u) const {
        if (i != 0 || c >= 64) return false;
        const int ks = c >> 5, kv = (c >> 4) & 1, bg = (c >> 2) & 3, tile = c & 3, b = bg >> 1, g = bg & 1;
        u.pm = c; u.pn = 0; u.tag = kv;
        u.aoff = 2LL * (((long long)b * S_ + 4096LL * tile + 16LL * ks) * PP + PC_KV + kv * 128 + g * 64);
        u.boff = (long long)kv * (256 * 2048 * 2) + (long long)ks * (1024 * 2); return true;
    }
};

__device__ __forceinline__ u32x4 pack8(f32x4 a, f32x4 b) { u32x4 w; w.x = cvt_pk_bf16(a[0], a[1]); w.y = cvt_pk_bf16(a[2], a[3]); w.z = cvt_pk_bf16(b[0], b[1]); w.w = cvt_pk_bf16(b[2], b[3]); return w; }
template <int MODE> struct Epi {
    bf16_t* O; int ldc; const bf16_t* G; const float* bias;
    __device__ __forceinline__ void operator()(const f32x4 (&acc)[2][2][4][2], const Unit& u, int wr, int wc, int fr, int fq) const {
        const int row0 = u.pm * BM + wr * 64 + fr;
        if constexpr (MODE == 1) {
            const int col0 = u.pn * 128 + wc * 32 + 8 * fq;
#pragma unroll
            for (int ai = 0; ai < 2; ++ai)
#pragma unroll
                for (int m = 0; m < 4; ++m) {
                    bf16_t* rowp = O + (size_t)(row0 + ai * HALF + m * 16) * ldc + col0;
                    f32x4 v0, v1;
#pragma unroll
                    for (int e = 0; e < 4; ++e) { const float a0 = acc[ai][0][m][0][e], a1 = acc[ai][0][m][1][e]; v0[e] = a0 * sigm(a0) * acc[ai][1][m][0][e]; v1[e] = a1 * sigm(a1) * acc[ai][1][m][1][e]; }
                    *(u32x4*)rowp = pack8(v0, v1);
                    __builtin_amdgcn_sched_barrier(0);
                }
        } else if constexpr (MODE == 3) {
            const int col0 = u.pn * BM + wc * 32 + 8 * fq;
#pragma unroll
            for (int ai = 0; ai < 2; ++ai) {
                u32x4 gv[4][2], ov[4][2];
#pragma unroll
                for (int m = 0; m < 4; ++m)
#pragma unroll
                    for (int bj = 0; bj < 2; ++bj) { const size_t row = (size_t)(row0 + ai * HALF + m * 16); const int col = col0 + bj * HALF;
                        gv[m][bj] = *(const u32x4*)(G + row * GP + u.tag * 1024 + col);
                        ov[m][bj] = (u.tag > 0) ? *(const u32x4*)(O + row * ldc + col) : (u32x4){0u, 0u, 0u, 0u}; }
                __builtin_amdgcn_sched_barrier(0);
#pragma unroll
                for (int m = 0; m < 4; ++m)
#pragma unroll
                    for (int bj = 0; bj < 2; ++bj) { const size_t row = (size_t)(row0 + ai * HALF + m * 16); const int col = col0 + bj * HALF;
                        f32x4 v0 = acc[ai][bj][m][0], v1 = acc[ai][bj][m][1]; const u32x4 g4 = gv[m][bj], o4 = ov[m][bj];
                        v0[0] = v0[0] * bf_lo(g4.x) + bf_lo(o4.x); v0[1] = v0[1] * bf_hi(g4.x) + bf_hi(o4.x); v0[2] = v0[2] * bf_lo(g4.y) + bf_lo(o4.y); v0[3] = v0[3] * bf_hi(g4.y) + bf_hi(o4.y);
                        v1[0] = v1[0] * bf_lo(g4.z) + bf_lo(o4.z); v1[1] = v1[1] * bf_hi(g4.z) + bf_hi(o4.z); v1[2] = v1[2] * bf_lo(g4.w) + bf_lo(o4.w); v1[3] = v1[3] * bf_hi(g4.w) + bf_hi(o4.w);
                        *(u32x4*)(O + row * ldc + col) = pack8(v0, v1); }
            }
        } else {
            const int col0 = u.pn * BM + wc * 32 + 8 * fq;
#pragma unroll
            for (int ai = 0; ai < 2; ++ai)
#pragma unroll
                for (int m = 0; m < 4; ++m) {
                    const size_t row = (size_t)(row0 + ai * HALF + m * 16);
#pragma unroll
                    for (int bj = 0; bj < 2; ++bj) {
                        const int col = col0 + bj * HALF;
                        f32x4 v0 = acc[ai][bj][m][0], v1 = acc[ai][bj][m][1];
                        bf16_t* dst = O + row * ldc + col;
                        if constexpr (MODE == 2) {
#pragma unroll
                            for (int e = 0; e < 4; ++e) { v0[e] = sigm(v0[e]); v1[e] = sigm(v1[e]); }
                        }
                        if constexpr (MODE == 4) {
                            const f32x4 b0 = *(const f32x4*)(bias + u.tag * 256 + col), b1 = *(const f32x4*)(bias + u.tag * 256 + col + 4);
#pragma unroll
                            for (int e = 0; e < 4; ++e) { v0[e] = gelu_tanh(v0[e] + b0[e]); v1[e] = gelu_tanh(v1[e] + b1[e]); }
                        }
                        if constexpr (MODE == 3) {
                            const u32x4 gv = *(const u32x4*)(G + row * GP + u.tag * 1024 + col);
                            v0[0] *= bf_lo(gv.x); v0[1] *= bf_hi(gv.x); v0[2] *= bf_lo(gv.y); v0[3] *= bf_hi(gv.y);
                            v1[0] *= bf_lo(gv.z); v1[1] *= bf_hi(gv.z); v1[2] *= bf_lo(gv.w); v1[3] *= bf_hi(gv.w);
                            if (u.tag > 0) {
                                const u32x4 ov = *(const u32x4*)dst;
                                v0[0] += bf_lo(ov.x); v0[1] += bf_hi(ov.x); v0[2] += bf_lo(ov.y); v0[3] += bf_hi(ov.y);
                                v1[0] += bf_lo(ov.z); v1[1] += bf_hi(ov.z); v1[2] += bf_lo(ov.w); v1[3] += bf_hi(ov.w);
                            }
                        }
                        *(u32x4*)dst = pack8(v0, v1);
                    }
                }
        }
    }
};

template <class EpiT, class Sched>
__device__ __forceinline__ void gemm_phase(LAS unsigned char* lds, int tid_in, const GemmDesc g, const Sched& S, const EpiT& E) {
    int tid_ = tid_in; asm volatile("" : "+v"(tid_));
    const int tid = tid_, wid = __builtin_amdgcn_readfirstlane(tid >> 6), lane = tid & 63, wr = wid >> 2, wc = wid & 3, fr = lane & 15, fq = lane >> 4;
    const int nt = g.nt;
    unsigned voffA[2], voffB[2];
#pragma unroll
    for (int i = 0; i < 2; ++i) { int R, C; stage_rc(tid * 16 + i * 8192, R, C); const int Rb = (R & ~31) + perm32(R & 31);
        voffA[i] = (unsigned)(R * g.lda + C) * 2u; voffB[i] = (unsigned)(Rb * g.ldb + C) * 2u; }
    const size_t kA = (size_t)g.kstepA, kB = (size_t)g.kstepB;
    const size_t hA = (size_t)HALF * g.lda * 2, hB = (size_t)HALF * g.ldb * 2;
    const unsigned ldsw = (unsigned)wid * 1024u;
    const int aoff = lds_byte(wr * 64 + fr, fq * 8), boff = lds_byte(wc * 32 + fr, fq * 8);
#define PG8_SA(b, h) (((b) * 2 + (h)) * HTB)
#define PG8_SB(b, h) ((4 + (b) * 2 + (h)) * HTB)
#define PG8_STAGE(bufoff, gbase, voff) do { _Pragma("unroll") for (int _i = 0; _i < 2; ++_i) \
        __builtin_amdgcn_global_load_lds((const unsigned*)((const char*)(gbase) + (voff)[_i]), (LAS unsigned*)(lds + (bufoff) + ldsw + _i * 8192), 16, 0, 0); } while (0)
#define PG8_LDA(dst, b, h) do { _Pragma("unroll") for (int m = 0; m < 4; ++m) _Pragma("unroll") for (int k = 0; k < 2; ++k) dst[m][k] = *(const LAS bf16x8*)(lds + PG8_SA(b, h) + aoff + m * 2048 + k * 1024); } while (0)
#define PG8_LDB(dst, b, h) do { _Pragma("unroll") for (int n = 0; n < 2; ++n) _Pragma("unroll") for (int k = 0; k < 2; ++k) dst[n][k] = *(const LAS bf16x8*)(lds + PG8_SB(b, h) + boff + n * 2048 + k * 1024); } while (0)
#define PG8_MMA(ai, bj, At, Bt) do { __builtin_amdgcn_s_setprio(1); _Pragma("unroll") for (int m = 0; m < 4; ++m) _Pragma("unroll") for (int n = 0; n < 2; ++n) _Pragma("unroll") for (int k = 0; k < 2; ++k) \
        acc[ai][bj][m][n] = __builtin_amdgcn_mfma_f32_16x16x32_bf16(Bt[n][k], At[m][k], acc[ai][bj][m][n], 0, 0, 0); __builtin_amdgcn_s_setprio(0); } while (0)
#define PG8_WAIT_V(n) asm volatile("s_waitcnt vmcnt(" #n ")" ::: "memory")
#define PG8_WAIT_L(n) asm volatile("s_waitcnt lgkmcnt(" #n ")" ::: "memory")
#define PG8_BAR __builtin_amdgcn_s_barrier()
#define PG8_SCHED __builtin_amdgcn_sched_barrier(0)
    Unit cur, nxt; int ui = 0;
    if (!S.next(0, cur)) return;
    f32x4 acc[2][2][4][2];
#pragma unroll
    for (int a = 0; a < 2; ++a)
#pragma unroll
        for (int b = 0; b < 2; ++b)
#pragma unroll
            for (int m = 0; m < 4; ++m)
#pragma unroll
                for (int n = 0; n < 2; ++n) acc[a][b][m][n] = (f32x4){0.f, 0.f, 0.f, 0.f};
    bf16x8 At[4][2], B0[2][2], B1[2][2];
    const char* cA = g.A + cur.aoff; const char* cB = g.Bt + cur.boff;
    PG8_STAGE(PG8_SB(0, 0), cB, voffB); PG8_STAGE(PG8_SB(0, 1), cB + hB, voffB); PG8_STAGE(PG8_SA(0, 0), cA, voffA); PG8_STAGE(PG8_SA(0, 1), cA + hA, voffA);
    if (wr == 1) PG8_BAR;
    PG8_WAIT_V(2); PG8_BAR;
    PG8_STAGE(PG8_SB(1, 0), cB + kB, voffB); PG8_STAGE(PG8_SA(1, 0), cA + kA, voffA); PG8_STAGE(PG8_SB(1, 1), cB + hB + kB, voffB);
    PG8_WAIT_V(6); PG8_BAR;
    for (;;) {
        const bool has_next = S.next(ui + 1, nxt);
        const char* nA = has_next ? g.A + nxt.aoff : cA; const char* nB = has_next ? g.Bt + nxt.boff : cB;
        for (int t = 0; t < nt; t += 2) {
            const bool last = (t == nt - 2);
            const char* a1 = cA + (size_t)(t + 1) * kA;
            const char* a2 = last ? nA : cA + (size_t)(t + 2) * kA; const char* b2 = last ? nB : cB + (size_t)(t + 2) * kB;
            const char* a3 = a2 + kA; const char* b3 = b2 + kB;
            PG8_LDB(B0, 0, 0); PG8_LDB(B1, 0, 1); PG8_SCHED; PG8_LDA(At, 0, 0); PG8_STAGE(PG8_SA(1, 1), a1 + hA, voffA);
            PG8_WAIT_V(8); PG8_WAIT_L(0); PG8_BAR; PG8_MMA(0, 0, At, B0); PG8_MMA(0, 1, At, B1); PG8_BAR; PG8_SCHED;
            PG8_LDA(At, 0, 1); PG8_STAGE(PG8_SB(0, 0), b2, voffB); PG8_STAGE(PG8_SB(0, 1), b2 + hB, voffB); PG8_STAGE(PG8_SA(0, 0), a2, voffA);
            PG8_WAIT_V(8); PG8_WAIT_L(0); PG8_BAR; PG8_MMA(1, 0, At, B0); PG8_MMA(1, 1, At, B1); PG8_BAR; PG8_SCHED;
            PG8_LDB(B0, 1, 0); PG8_LDB(B1, 1, 1); PG8_SCHED; PG8_LDA(At, 1, 0); PG8_STAGE(PG8_SA(0, 1), a2 + hA, voffA);
            PG8_WAIT_V(8); PG8_WAIT_L(0); PG8_BAR; PG8_MMA(0, 0, At, B0); PG8_MMA(0, 1, At, B1); PG8_BAR; PG8_SCHED;
            PG8_LDA(At, 1, 1); PG8_STAGE(PG8_SB(1, 0), b3, voffB); PG8_STAGE(PG8_SB(1, 1), b3 + hB, voffB); PG8_STAGE(PG8_SA(1, 0), a3, voffA);
            PG8_WAIT_V(8); PG8_WAIT_L(0); PG8_BAR; PG8_MMA(1, 0, At, B0); PG8_MMA(1, 1, At, B1); PG8_BAR; PG8_SCHED;
        }
        if (wr == 0) PG8_BAR;
        E(acc, cur, wr, wc, fr, fq);
        if (!has_next) break;
#pragma unroll
        for (int a = 0; a < 2; ++a)
#pragma unroll
            for (int b = 0; b < 2; ++b)
#pragma unroll
                for (int m = 0; m < 4; ++m)
#pragma unroll
                    for (int n = 0; n < 2; ++n) acc[a][b][m][n] = (f32x4){0.f, 0.f, 0.f, 0.f};
        cur = nxt; cA = nA; cB = nB; ++ui;
        if (wr == 1) PG8_BAR;
    }
    PG8_WAIT_V(0);
    PG8_BAR;
#undef PG8_SA
#undef PG8_SB
#undef PG8_STAGE
#undef PG8_LDA
#undef PG8_LDB
#undef PG8_MMA
#undef PG8_WAIT_V
#undef PG8_WAIT_L
#undef PG8_BAR
#undef PG8_SCHED
}
}

struct Args { const void* in[29]; float* out; unsigned char* ws; int ph_lo, ph_hi; };
static_assert(sizeof(Args) == 29 * 8 + 8 + 8 + 8, "Args has no padding");

typedef __attribute__((address_space(1))) unsigned char gu8;
struct Ctx {
    const Args* a; gu8* ws; LAS unsigned char* lds; int tid, lane, wave, G, gw, NGW;
};
#define INF(k, l, n) ((const float*)C.a->in[k] + (size_t)(l) * (n))

__device__ __forceinline__ void tr_item(const float* W, int ldw, int src_col, int nvalid, int k0, bf16_t* WT, int ldt, int dst_row, int dst_k, LAS float* scr, int lane) {
#pragma unroll 8
    for (int i = 0; i < 32; ++i) { const int kk = 2 * i + (lane >> 5), c = lane & 31; scr[kk * 33 + c] = (c < nvalid) ? W[(size_t)(k0 + kk) * ldw + src_col + c] : 0.f; }
    LDS_WAIT();
    const int c = lane & 7;
#pragma unroll
    for (int j = 0; j < 4; ++j) { const int n = (lane >> 3) + 8 * j; const LAS float* s = scr + (8 * c) * 33 + n;
        u32x4 o; o.x = cvt_pk_bf16(s[0 * 33], s[1 * 33]); o.y = cvt_pk_bf16(s[2 * 33], s[3 * 33]); o.z = cvt_pk_bf16(s[4 * 33], s[5 * 33]); o.w = cvt_pk_bf16(s[6 * 33], s[7 * 33]);
        *(u32x4*)(WT + (size_t)(dst_row + n) * ldt + dst_k + k0 + 8 * c) = o; }
    LDS_WAIT();
}

__device__ __forceinline__ void convert_layer(const Ctx& C, int l) {
    LAS float* scr = (LAS float*)(C.lds + C.wave * 8448);
    gu8* ws = C.ws; const int lane = C.lane;
    constexpr int NITEMS = 2816 + 1408 + 1792 + 1536 + 768 + 512 + 2816 + 1408 + 256 + 256 + 512;
    for (int it = C.gw; it < NITEMS; it += C.NGW) {
        int r = it;
        if (r < 2816) { const int kb = r / 176, nb = r % 176, tile = nb >> 3, w = nb & 7, src = (w >> 2) * FF + tile * 128 + (w & 3) * 32;
            tr_item(INF(5, l, DM * 2 * FF), 2 * FF, src, 32, kb * 64, (bf16_t*)(ws + WS_W1IN), DM, nb * 32, 0, scr, lane); continue; } r -= 2816;
        if (r < 1408) { const int kb = r / 32, nb = r % 32;
            tr_item(INF(6, l, FF * DM), DM, nb * 32, 32, kb * 64, (bf16_t*)(ws + WS_W1OUT), FF, nb * 32, 0, scr, lane); continue; } r -= 1408;
        if (r < 1792) { const int kb = r / 112, nb = r % 112; int src = 0, nv = 0;
            if (nb < 88) { src = nb * 32; nv = 32; } else if (nb < 104) { src = 2840 + (nb - 88) * 32; nv = 32; } else if (nb == 104) { src = 2816; nv = 24; }
            tr_item(INF(10, l, DM * 6424), 6424, src, nv, kb * 64, (bf16_t*)(ws + WS_WMIX), DM, nb * 32, 0, scr, lane); continue; } r -= 1792;
        if (r < 1536) { const int kb = r / 96, nb = r % 96;
            tr_item(INF(10, l, DM * 6424), 6424, 3352 + nb * 32, 32, kb * 64, (bf16_t*)(ws + WS_WG), DM, nb * 32, 0, scr, lane); continue; } r -= 1536;
        if (r < 768) { const int br = r / 256, q = r % 256, kb = q / 32, nb = q % 32;
            const float* W = br == 0 ? INF(21, l, 512 * DM) : (br == 1 ? INF(22, l, 512 * DM) : INF(23, l, 512 * DM));
            tr_item(W, DM, nb * 32, 32, kb * 64, (bf16_t*)(ws + WS_WBR), YP, nb * 32, br * 512, scr, lane); continue; } r -= 768;
        if (r < 512) { const int kb = r / 32, nb = r % 32;
            tr_item(INF(24, l, DM * DM), DM, nb * 32, 32, kb * 64, (bf16_t*)(ws + WS_WOUT), DM, nb * 32, 0, scr, lane); continue; } r -= 512;
        if (r < 2816) { const int kb = r / 176, nb = r % 176, tile = nb >> 3, w = nb & 7, src = (w >> 2) * FF + tile * 128 + (w & 3) * 32;
            tr_item(INF(27, l, DM * 2 * FF), 2 * FF, src, 32, kb * 64, (bf16_t*)(ws + WS_W2IN), DM, nb * 32, 0, scr, lane); continue; } r -= 2816;
        if (r < 1408) { const int kb = r / 32, nb = r % 32;
            tr_item(INF(28, l, FF * DM), DM, nb * 32, 32, kb * 64, (bf16_t*)(ws + WS_W2OUT), FF, nb * 32, 0, scr, lane); continue; } r -= 1408;
        if (r < 256) { const int kb = r / 8, nb = r % 8;
            tr_item(INF(14, l, 2048 * 256), 256, nb * 32, 32, kb * 64, (bf16_t*)(ws + WS_WC1), 2048, nb * 32, 0, scr, lane); continue; } r -= 256;
        if (r < 256) { const int kb = r / 8, nb = r % 8;
            tr_item(INF(17, l, 2048 * 256), 256, nb * 32, 32, kb * 64, (bf16_t*)(ws + WS_WC1 + MiB), 2048, nb * 32, 0, scr, lane); continue; } r -= 256;
        { const int kb = r / 32, nb = r % 32;
            tr_item(INF(20, l, DM * DM), DM, nb * 32, 32, kb * 64, (bf16_t*)(ws + WS_WMKV), DM, nb * 32, 0, scr, lane); }
    }
    {
        const float* gm = INF(9, l, DM);
        for (int m = C.gw; m < 512; m += C.NGW) {
            const f32x4* xr = (const f32x4*)((const float*)C.a->in[1] + (size_t)m * DM) + lane;
            f32x4 v[4]; float s = 0.f;
#pragma unroll
            for (int j = 0; j < 4; ++j) { v[j] = xr[64 * j]; s += (v[j].x * v[j].x + v[j].y * v[j].y) + (v[j].z * v[j].z + v[j].w * v[j].w); }
            const float rstd = rsqrtf(wave_sum(s) * (1.f / DM) + EPS);
            u32x2* o = (u32x2*)((bf16_t*)(ws + WS_MEMN) + (size_t)m * DM) + lane;
#pragma unroll
            for (int j = 0; j < 4; ++j) { const f32x4 gg = ((const f32x4*)gm)[lane + 64 * j]; u32x2 w; w.x = cvt_pk_bf16(v[j].x * rstd * gg.x, v[j].y * rstd * gg.y); w.y = cvt_pk_bf16(v[j].z * rstd * gg.z, v[j].w * rstd * gg.w); o[64 * j] = w; }
        }
    }
    {
        float* cb = (float*)(ws + WS_CBP) + (size_t)l * 64 * 256;
        for (int it = C.gw; it < 64; it += C.NGW) {
            const int kv = it >> 5, ch = it & 31;
            const float* pos = kv ? INF(13, l, 2048) : INF(12, l, 2048);
            const float* w1 = kv ? INF(17, l, 2048 * 256) : INF(14, l, 2048 * 256);
            float p[4] = {0.f, 0.f, 0.f, 0.f};
            for (int k = ch * 64; k < ch * 64 + 64; ++k) { const float pv = pos[k];
#pragma unroll
                for (int q = 0; q < 4; ++q) p[q] += pv * w1[(size_t)k * 256 + lane + 64 * q]; }
#pragma unroll
            for (int q = 0; q < 4; ++q) cb[(size_t)it * 256 + lane + 64 * q] = p[q];
        }
    }
}

__device__ __forceinline__ void rope_table(const Ctx& C) {
    const int* pos = (const int*)C.a->in[2];
    float* tab = (float*)(C.ws + WS_ROPE);
    const float invf[8] = {1.0f, 0.1939227432012558f, 0.03760603070259094f, 0.007292664609849453f, 0.0014142135623842478f, 0.00027424818836152554f, 5.318296098266728e-05f, 1.0313386155758053e-05f};
    for (int e = C.gw * 64 + C.lane; e < T_ * 8; e += C.NGW * 64) {
        const int tok = e >> 3, i = e & 7;
        float f = invf[0];
#pragma unroll
        for (int q = 1; q < 8; ++q) f = (i == q) ? invf[q] : f;
        const float ang = (float)pos[tok] * f;
        const double rev = (double)ang * 0.15915494309189535; const float fr = (float)(rev - floor(rev));
        tab[(size_t)tok * 16 + i] = __builtin_amdgcn_cosf(fr); tab[(size_t)tok * 16 + 8 + i] = __builtin_amdgcn_sinf(fr);
    }
}
__device__ __forceinline__ void prenorm_rows(const Ctx& C, const float* x, const float* g, bf16_t* h) {
    for (int m = C.gw; m < T_; m += C.NGW) {
        const f32x4* xr = (const f32x4*)(x + (size_t)m * DM) + C.lane;
        f32x4 v[4]; float s = 0.f;
#pragma unroll
        for (int j = 0; j < 4; ++j) { v[j] = xr[64 * j]; s += (v[j].x * v[j].x + v[j].y * v[j].y) + (v[j].z * v[j].z + v[j].w * v[j].w); }
        const float rstd = rsqrtf(wave_sum(s) * (1.f / DM) + EPS);
        u32x2* o = (u32x2*)(h + (size_t)m * DM) + C.lane;
#pragma unroll
        for (int j = 0; j < 4; ++j) { const f32x4 gg = ((const f32x4*)g)[C.lane + 64 * j]; u32x2 w; w.x = cvt_pk_bf16(v[j].x * rstd * gg.x, v[j].y * rstd * gg.y); w.y = cvt_pk_bf16(v[j].z * rstd * gg.z, v[j].w * rstd * gg.w); o[64 * j] = w; }
    }
}
__device__ __forceinline__ void norm_phase(const Ctx& C, int w0, int nw, const float* xin, float* xout, const bf16_t* y, bf16_t* h, const float* gpost, const float* gpre, float coef) {
    for (int m0 = w0; m0 < T_; m0 += 2 * nw) {
        f32x4 xv[2][4]; u32x2 yw[2][4];
#pragma unroll
        for (int r = 0; r < 2; ++r) { const int m = (m0 + r * nw < T_) ? m0 + r * nw : m0; const f32x4* xr = (const f32x4*)(xin + (size_t)m * DM) + C.lane; const u32x2* yr = (const u32x2*)(y + (size_t)m * DM) + C.lane;
#pragma unroll
            for (int j = 0; j < 4; ++j) { xv[r][j] = xr[64 * j]; yw[r][j] = yr[64 * j]; } }
#pragma unroll
        for (int r = 0; r < 2; ++r) {
            const int m = m0 + r * nw; if (m >= T_) break;
            f32x4 yv[4]; float s = 0.f;
#pragma unroll
            for (int j = 0; j < 4; ++j) { const u32x2 w = yw[r][j]; yv[j] = (f32x4){bf_lo(w.x), bf_hi(w.x), bf_lo(w.y), bf_hi(w.y)};
                s += (yv[j].x * yv[j].x + yv[j].y * yv[j].y) + (yv[j].z * yv[j].z + yv[j].w * yv[j].w); }
            const float rs = rsqrtf(wave_sum(s) * (1.f / DM) + EPS) * coef; float s2 = 0.f;
            f32x4* xo = (f32x4*)(xout + (size_t)m * DM) + C.lane;
#pragma unroll
            for (int j = 0; j < 4; ++j) { const f32x4 gg = ((const f32x4*)gpost)[C.lane + 64 * j]; xv[r][j] = xv[r][j] + yv[j] * gg * rs; xo[64 * j] = xv[r][j];
                s2 += (xv[r][j].x * xv[r][j].x + xv[r][j].y * xv[r][j].y) + (xv[r][j].z * xv[r][j].z + xv[r][j].w * xv[r][j].w); }
            if (gpre) {
                const float r2 = rsqrtf(wave_sum(s2) * (1.f / DM) + EPS);
                u32x2* o = (u32x2*)(h + (size_t)m * DM) + C.lane;
#pragma unroll
                for (int j = 0; j < 4; ++j) { const f32x4 gg = ((const f32x4*)gpre)[C.lane + 64 * j]; u32x2 w; w.x = cvt_pk_bf16(xv[r][j].x * r2 * gg.x, xv[r][j].y * r2 * gg.y); w.y = cvt_pk_bf16(xv[r][j].z * r2 * gg.z, xv[r][j].w * r2 * gg.w); o[64 * j] = w; }
            }
        }
    }
}
__device__ __forceinline__ void cb_reduce(const Ctx& C, int l) {
    const int e = C.gw * 64 + C.lane;
    if (e < 512) { const int kv = e >> 8, n = e & 255; const float* pp = (const float*)(C.ws + WS_CBP) + (size_t)l * 64 * 256 + (size_t)kv * 32 * 256 + n;
        float s = (kv ? INF(18, l, 256) : INF(15, l, 256))[n];
        for (int ch = 0; ch < 32; ++ch) s += pp[ch * 256];
        ((float*)(C.ws + WS_CB))[l * 512 + e] = s; }
}
__device__ __forceinline__ void memkv_ops(const Ctx& C, int w0, int nw) {
    const bf16_t* src = (const bf16_t*)(C.ws + WS_MKV); bf16_t* ko = (bf16_t*)(C.ws + WS_MEMK); bf16_t* vo = (bf16_t*)(C.ws + WS_MEMV);
    for (int e = w0 * 64 + C.lane; e < 512 * 1024; e += nw * 64) {
        const int mr = e >> 10, col = e & 1023, kv = col >> 9, hm = (col >> 7) & 3, d = col & 127, b = mr >> 8, m = mr & 255;
        const bf16_t v = src[e];
        if (kv == 0) ko[((size_t)((((b * 4 + hm) * 8 + (m >> 5)) * 8 + (d >> 4)) * 64 + pi32(m & 31) + 32 * ((d >> 3) & 1))) * 8 + (d & 7)] = v;
        else vo[((size_t)((((b * 4 + hm) * 16 + (m >> 4)) * 4 + (d >> 5)) * 64 + (d & 31) + 32 * ((m >> 3) & 1))) * 8 + (m & 7)] = v;
    }
}

__device__ __forceinline__ void prep_items(const Ctx& C, int l, int w0, int nw) {
    const bf16_t* P = (const bf16_t*)(C.ws + WS_R1); bf16_t* Y = (bf16_t*)(C.ws + WS_Y);
    const int lane = C.lane;
    {
        const float* cw = INF(11, l, 3 * 512);
        float w[3][8];
#pragma unroll
        for (int k = 0; k < 3; ++k)
#pragma unroll
            for (int e = 0; e < 8; ++e) w[k][e] = cw[k * 512 + lane * 8 + e];
        for (int it = w0; it < T_ / 8; it += nw) {
            const int tok0 = it * 8, s0 = tok0 & (S_ - 1);
            float c1[8], c2[8];
#pragma unroll
            for (int e = 0; e < 8; ++e) { c1[e] = 0.f; c2[e] = 0.f; }
            if (s0 > 0) {
#pragma unroll
                for (int back = 2; back >= 1; --back) {
                    const bf16_t* row = P + (size_t)(tok0 - back) * PP + lane * 8;
                    const u32x4 u = *(const u32x4*)row, cc = *(const u32x4*)(row + 1024);
                    float t[8] = {bf_lo(u.x) * bf_lo(cc.x), bf_hi(u.x) * bf_hi(cc.x), bf_lo(u.y) * bf_lo(cc.y), bf_hi(u.y) * bf_hi(cc.y), bf_lo(u.z) * bf_lo(cc.z), bf_hi(u.z) * bf_hi(cc.z), bf_lo(u.w) * bf_lo(cc.w), bf_hi(u.w) * bf_hi(cc.w)};
#pragma unroll
                    for (int e = 0; e < 8; ++e) { if (back == 2) c2[e] = t[e]; else c1[e] = t[e]; }
                }
            }
#pragma unroll
            for (int tt = 0; tt < 8; ++tt) {
                const bf16_t* row = P + (size_t)(tok0 + tt) * PP + lane * 8;
                const u32x4 u = *(const u32x4*)row, bb = *(const u32x4*)(row + 512), cc = *(const u32x4*)(row + 1024);
                const float c0[8] = {bf_lo(u.x) * bf_lo(cc.x), bf_hi(u.x) * bf_hi(cc.x), bf_lo(u.y) * bf_lo(cc.y), bf_hi(u.y) * bf_hi(cc.y), bf_lo(u.z) * bf_lo(cc.z), bf_hi(u.z) * bf_hi(cc.z), bf_lo(u.w) * bf_lo(cc.w), bf_hi(u.w) * bf_hi(cc.w)};
                const float bv[8] = {bf_lo(bb.x), bf_hi(bb.x), bf_lo(bb.y), bf_hi(bb.y), bf_lo(bb.z), bf_hi(bb.z), bf_lo(bb.w), bf_hi(bb.w)};
                float o[8];
#pragma unroll
                for (int e = 0; e < 8; ++e) { o[e] = bv[e] * (w[0][e] * c2[e] + w[1][e] * c1[e] + w[2][e] * c0[e]); c2[e] = c1[e]; c1[e] = c0[e]; }
                u32x4 ov; ov.x = cvt_pk_bf16(o[0], o[1]); ov.y = cvt_pk_bf16(o[2], o[3]); ov.z = cvt_pk_bf16(o[4], o[5]); ov.w = cvt_pk_bf16(o[6], o[7]);
                *(u32x4*)(Y + (size_t)(tok0 + tt) * YP + lane * 8) = ov;
            }
        }
    }
    {
        const float* rope = (const float*)(C.ws + WS_ROPE);
        LAS bf16_t* vt = (LAS bf16_t*)(C.lds + C.wave * 4608);
        const int hi = lane >> 5, dl = lane & 31;
        for (int it = w0; it < 4 * 512; it += nw) {
            const int bg = it >> 9, tile = it & 511, b = bg >> 1, g = bg & 1;
            const size_t tokb = (size_t)b * S_ + 32 * tile;
#pragma unroll
            for (int which = 0; which < 2; ++which) {
                const int kc = PC_KV + (2 + 2 * which) * 128 + g * 64, vc = kc + 128;
                bf16_t* kop = (bf16_t*)(C.ws + (which ? WS_KWIN : WS_KSLC)); bf16_t* vop = (bf16_t*)(C.ws + (which ? WS_VWIN : WS_VSLC));
#pragma unroll
                for (int q = 0; q < 4; ++q) {
                    const int r = (lane >> 3) + 8 * q, c = lane & 7;
                    const bf16_t* row = P + (tokb + r) * PP;
                    u32x4 kv = *(const u32x4*)(row + kc + 8 * c);
                    if (c < 2) {
                        const u32x4 pv = *(const u32x4*)(row + kc + 8 * (c ^ 1));
                        const float* rt = rope + (tokb + r) * 16;
                        const f32x4 ca = *(const f32x4*)rt, cb2 = *(const f32x4*)(rt + 4), sa = *(const f32x4*)(rt + 8), sb = *(const f32x4*)(rt + 12);
                        const float cs[8] = {ca.x, ca.y, ca.z, ca.w, cb2.x, cb2.y, cb2.z, cb2.w}, sn[8] = {sa.x, sa.y, sa.z, sa.w, sb.x, sb.y, sb.z, sb.w};
                        const float mv[8] = {bf_lo(kv.x), bf_hi(kv.x), bf_lo(kv.y), bf_hi(kv.y), bf_lo(kv.z), bf_hi(kv.z), bf_lo(kv.w), bf_hi(kv.w)};
                        const float pp[8] = {bf_lo(pv.x), bf_hi(pv.x), bf_lo(pv.y), bf_hi(pv.y), bf_lo(pv.z), bf_hi(pv.z), bf_lo(pv.w), bf_hi(pv.w)};
                        const float sg = (c == 0) ? -1.f : 1.f; float o[8];
#pragma unroll
                        for (int e = 0; e < 8; ++e) o[e] = mv[e] * cs[e] + sg * pp[e] * sn[e];
                        kv.x = cvt_pk_bf16(o[0], o[1]); kv.y = cvt_pk_bf16(o[2], o[3]); kv.z = cvt_pk_bf16(o[4], o[5]); kv.w = cvt_pk_bf16(o[6], o[7]);
                    }
                    if (which == 0)
                        *(u32x4*)(kop + ((size_t)(((bg * 512 + tile) * 2 + ((r >> 2) & 1)) * 2 + (c >> 2)) * 64 + ((r >> 3) * 4 + (r & 3)) + 16 * (c & 3)) * 8) = kv;
                    else
                        *(u32x4*)(kop + ((size_t)((bg * 512 + tile) * 4 + (c >> 1)) * 64 + pi32(r) + 32 * (c & 1)) * 8) = kv;
                    const u32x4 vv = *(const u32x4*)(row + vc + 8 * c);
                    *(LAS u32x4*)(vt + r * 72 + 8 * c) = vv;
                }
                LDS_WAIT();
#pragma unroll
                for (int o4 = 0; o4 < 4; ++o4) {
                    if (which == 0) {
                        const LAS bf16_t* sp = vt + (8 * (lane >> 4)) * 72 + 16 * o4 + (lane & 15);
                        u32x4 o; o.x = (unsigned)sp[0] | ((unsigned)sp[72] << 16); o.y = (unsigned)sp[144] | ((unsigned)sp[216] << 16); o.z = (unsigned)sp[288] | ((unsigned)sp[360] << 16); o.w = (unsigned)sp[432] | ((unsigned)sp[504] << 16);
                        *(u32x4*)(vop + ((size_t)((bg * 512 + tile) * 4 + o4) * 64 + lane) * 8) = o;
                        continue;
                    }
                    const int ks = o4 >> 1, dt = o4 & 1;
                    const LAS bf16_t* sp = vt + (16 * ks + 8 * hi) * 72 + 32 * dt + dl;
                    u32x4 o; o.x = (unsigned)sp[0] | ((unsigned)sp[72] << 16); o.y = (unsigned)sp[144] | ((unsigned)sp[216] << 16); o.z = (unsigned)sp[288] | ((unsigned)sp[360] << 16); o.w = (unsigned)sp[432] | ((unsigned)sp[504] << 16);
                    *(u32x4*)(vop + ((size_t)((bg * 1024 + 2 * tile + ks) * 2 + dt) * 64 + lane) * 8) = o;
                }
                LDS_WAIT();
            }
        }
    }
}

__device__ __forceinline__ void cmp_stage2(const Ctx& C, int l) {
    const int bxx = C.gw / NWAVES, kv = bxx & 1, wi = bxx >> 1, nwg2 = (C.G + 1 - kv) >> 1;
    const float* w2 = kv ? INF(19, l, 256 * 64) : INF(16, l, 256 * 64);
    LAS float* ws2 = (LAS float*)C.lds;
    for (int e = C.tid; e < 256 * 64 / 4; e += NWAVES * 64) ((LAS f32x4*)ws2)[e] = ((const f32x4*)w2)[e];
    __syncthreads();
    const bf16_t* hid = (const bf16_t*)(C.ws + WS_CMPP) + (size_t)kv * 4096 * 256;
    const float* cbias = (const float*)(C.ws + WS_CB) + l * 512 + kv * 256;
    bf16_t* ko = (bf16_t*)(C.ws + WS_KCMP); bf16_t* vo = (bf16_t*)(C.ws + WS_VCMP);
    const int d = C.lane;
    for (int row = wi * NWAVES + C.wave; row < 4096; row += nwg2 * NWAVES) {
        asm volatile("" ::: "memory");
        const u32x2 hv = *((const u32x2*)(hid + (size_t)row * 256) + C.lane), hw = *((const u32x2*)(hid + (size_t)(row + 8192) * 256) + C.lane);
        const f32x4 cbv = *((const f32x4*)cbias + C.lane);
        const float h0 = gelu_tanh(bf_lo(hv.x) + bf_lo(hw.x) + cbv.x), h1 = gelu_tanh(bf_hi(hv.x) + bf_hi(hw.x) + cbv.y), h2 = gelu_tanh(bf_lo(hv.y) + bf_lo(hw.y) + cbv.z), h3 = gelu_tanh(bf_hi(hv.y) + bf_hi(hw.y) + cbv.w);
        float acc = 0.f;
#pragma unroll 4
        for (int k = 0; k < 64; ++k) {
            const float a0 = __int_as_float(__builtin_amdgcn_readlane(__float_as_int(h0), k)), a1 = __int_as_float(__builtin_amdgcn_readlane(__float_as_int(h1), k));
            const float a2 = __int_as_float(__builtin_amdgcn_readlane(__float_as_int(h2), k)), a3 = __int_as_float(__builtin_amdgcn_readlane(__float_as_int(h3), k));
            acc += a0 * ws2[(4 * k + 0) * 64 + d]; acc += a1 * ws2[(4 * k + 1) * 64 + d]; acc += a2 * ws2[(4 * k + 2) * 64 + d]; acc += a3 * ws2[(4 * k + 3) * 64 + d];
        }
        const int bg = row >> 10, n = row & 1023;
        if (n == 1023) acc = 0.f;
        const bf16_t o = (bf16_t)(cvt_pk_bf16(acc, 0.f) & 0xffffu);
        if (kv == 0) ko[((size_t)((bg * 32 + (n >> 5)) * 4 + (d >> 4)) * 64 + pi32(n & 31) + 32 * ((d >> 3) & 1)) * 8 + (d & 7)] = o;
        else vo[((size_t)((bg * 64 + (n >> 4)) * 2 + (d >> 5)) * 64 + (d & 31) + 32 * ((n >> 3) & 1)) * 8 + (n & 7)] = o;
    }
    __syncthreads();
}

__device__ __forceinline__ float xhalf_max(float v) { const auto r = __builtin_amdgcn_permlane32_swap(__float_as_uint(v), __float_as_uint(v), false, false); return fmaxf(__uint_as_float(r[0]), __uint_as_float(r[1])); }
__device__ __forceinline__ float xhalf_sum(float v) { const auto r = __builtin_amdgcn_permlane32_swap(__float_as_uint(v), __float_as_uint(v), false, false); return __uint_as_float(r[0]) + __uint_as_float(r[1]); }
__device__ __forceinline__ f32x16 mfma32(bf16x8 a, bf16x8 b, f32x16 c) { return __builtin_amdgcn_mfma_f32_32x32x16_bf16(a, b, c, 0, 0, 0); }
__device__ __forceinline__ float dpp_xor1(float v) { return __int_as_float(__builtin_amdgcn_update_dpp(0, __float_as_int(v), 0xB1, 0xF, 0xF, true)); }
__device__ __forceinline__ float dpp_xor2(float v) { return __int_as_float(__builtin_amdgcn_update_dpp(0, __float_as_int(v), 0x4E, 0xF, 0xF, true)); }
__device__ __forceinline__ bf16x8 pack_p(const float* p) { u32x4 w; w.x = cvt_pk_bf16(p[0], p[1]); w.y = cvt_pk_bf16(p[2], p[3]); w.z = cvt_pk_bf16(p[4], p[5]); w.w = cvt_pk_bf16(p[6], p[7]); return __builtin_bit_cast(bf16x8, w); }
__device__ __forceinline__ bf16x8 scale_q(u32x4 v, float s) { u32x4 w; w.x = cvt_pk_bf16(bf_lo(v.x) * s, bf_hi(v.x) * s); w.y = cvt_pk_bf16(bf_lo(v.y) * s, bf_hi(v.y) * s); w.z = cvt_pk_bf16(bf_lo(v.z) * s, bf_hi(v.z) * s); w.w = cvt_pk_bf16(bf_lo(v.w) * s, bf_hi(v.w) * s); return __builtin_bit_cast(bf16x8, w); }
constexpr float SM_THR = 8.0f;
#define KREL(i, hi) (8 * (hi) + (i) + (((i) >= 8) ? 8 : 0))

__device__ __forceinline__ void flash_load(const bf16x8* kp, const bf16x8* vp, bf16x8 (&kf)[4], bf16x8 (&vf)[4]) {
#pragma unroll
    for (int s = 0; s < 4; ++s) kf[s] = kp[s * 64];
#pragma unroll
    for (int s = 0; s < 4; ++s) vf[s] = vp[s * 64];
    __builtin_amdgcn_sched_barrier(0);
}
__device__ __forceinline__ void flash_compute(bool domask, const bf16x8 (&kf)[4], const bf16x8 (&vf)[4], const bf16x8 (&q)[4], int x0, unsigned span, float& m, float& l, f32x16 (&O)[2]) {
    f32x16 sc;
#pragma unroll
    for (int i = 0; i < 16; ++i) sc[i] = 0.f;
#pragma unroll
    for (int s = 0; s < 4; ++s) sc = mfma32(kf[s], q[s], sc);
    if (domask) {
#pragma unroll
        for (int i = 0; i < 16; ++i) sc[i] = ((unsigned)(x0 + i + (i >= 8 ? 8 : 0)) <= span) ? sc[i] : -1e30f;
    }
    const float a0 = fmaxf(fmaxf(sc[0], sc[1]), sc[2]), a1 = fmaxf(fmaxf(sc[3], sc[4]), sc[5]), a2 = fmaxf(fmaxf(sc[6], sc[7]), sc[8]), a3 = fmaxf(fmaxf(sc[9], sc[10]), sc[11]), a4 = fmaxf(fmaxf(sc[12], sc[13]), sc[14]);
    float mx = fmaxf(fmaxf(fmaxf(a0, a1), fmaxf(a2, a3)), fmaxf(a4, sc[15]));
    mx = xhalf_max(mx);
    const bool upd = mx > m + SM_THR;
    if (__ballot(upd) != 0ull) {
        const float mn = upd ? mx : m, alpha = ex2(m - mn); l *= alpha; O[0] = O[0] * alpha; O[1] = O[1] * alpha; m = mn;
    }
    const float msub = (m < -1e29f) ? 0.f : m;
    const f32x16 d = sc - msub;
    float p[16], ps = 0.f;
#pragma unroll
    for (int i = 0; i < 16; ++i) { p[i] = ex2(d[i]); ps += p[i]; }
    l += ps;
    const bf16x8 pb0 = pack_p(p), pb1 = pack_p(p + 8);
    O[0] = mfma32(vf[0], pb0, O[0]); O[1] = mfma32(vf[1], pb0, O[1]);
    O[0] = mfma32(vf[2], pb1, O[0]); O[1] = mfma32(vf[3], pb1, O[1]);
}
template <int MODE> __device__ __forceinline__ void flash_desc(int s, const LAS unsigned* list, int base, int t, int t0, int qi, int hi, int& tile, int& x0, unsigned& span, int& vm) {
    if constexpr (MODE == 0) {
        const unsigned e = (unsigned)__builtin_amdgcn_readfirstlane((int)list[s >> 1]);
        tile = 2 * (int)(e & 0xffffu) + (s & 1);
        const bool my = ((e >> 16) >> qi) & 1u; const int up = my ? (t - 32 * tile) : -1;
        x0 = up < 0 ? 64 : 8 * hi; span = up < 0 ? 0u : (unsigned)up;
        vm = (32 * tile + 31 <= t0) ? (((e >> 16) == 0xFFu) ? 0 : 1) : 2;
    } else {
        tile = base + s; x0 = 8 * hi - (t - 511 - 32 * tile); span = 511u;
        vm = (32 * tile + 31 <= t0 && 32 * tile >= t0 + 7 - 511) ? 0 : 2;
    }
}
template <int MODE> __device__ __forceinline__ void flash_run(const bf16x8* kb, const bf16x8* vb, const bf16x8 (&q)[4], int nsteps, const LAS unsigned* list, int base, int t, int t0, int qi, int hi, float& m, float& l, f32x16 (&O)[2]) {
    if (nsteps <= 0) return;
    bf16x8 kA[4], vA[4], kB[4], vB[4], kC[4], vC[4]; int x0A, x0B, x0C, vmA, vmB, vmC; unsigned spA, spB, spC;
#define FR_LOAD(S, KF, VF, X0, SP, VM) do { int tile_; const int sn_ = ((S) < nsteps) ? (S) : nsteps - 1; flash_desc<MODE>(sn_, list, base, t, t0, qi, hi, tile_, X0, SP, VM); \
        flash_load(kb + (size_t)tile_ * 256, vb + (size_t)tile_ * 256, KF, VF); } while (0)
    FR_LOAD(0, kA, vA, x0A, spA, vmA); FR_LOAD(1, kB, vB, x0B, spB, vmB);
#pragma unroll 1
    for (int s = 0; s < nsteps; s += 3) {
        FR_LOAD(s + 2, kC, vC, x0C, spC, vmC); flash_compute(vmA != 0, kA, vA, q, x0A, spA, m, l, O); if (s + 1 >= nsteps) break;
        FR_LOAD(s + 3, kA, vA, x0A, spA, vmA); flash_compute(vmB != 0, kB, vB, q, x0B, spB, m, l, O); if (s + 2 >= nsteps) break;
        FR_LOAD(s + 4, kB, vB, x0B, spB, vmB); flash_compute(vmC != 0, kC, vC, q, x0C, spC, m, l, O);
    }
#undef FR_LOAD
}

typedef float f32x4v __attribute__((ext_vector_type(4)));
__device__ __forceinline__ f32x4v mfma16(bf16x8 a, bf16x8 b, f32x4v c) { return __builtin_amdgcn_mfma_f32_16x16x32_bf16(a, b, c, 0, 0, 0); }
__device__ __forceinline__ float xq_max(float v) { const auto r = __builtin_amdgcn_permlane16_swap(__float_as_uint(v), __float_as_uint(v), false, false); return xhalf_max(fmaxf(__uint_as_float(r[0]), __uint_as_float(r[1]))); }
__device__ __forceinline__ float xq_sum(float v) { const auto r = __builtin_amdgcn_permlane16_swap(__float_as_uint(v), __float_as_uint(v), false, false); return xhalf_sum(__uint_as_float(r[0]) + __uint_as_float(r[1])); }
__device__ __forceinline__ void flash16_load(const bf16x8* kp, const bf16x8* vp, bf16x8 (&kf)[4], bf16x8 (&vf)[4]) {
#pragma unroll
    for (int s = 0; s < 4; ++s) kf[s] = kp[s * 64];
#pragma unroll
    for (int s = 0; s < 4; ++s) vf[s] = vp[s * 64];
    __builtin_amdgcn_sched_barrier(0);
}
__device__ __forceinline__ void flash16_compute(bool domask, const bf16x8 (&kf)[4], const bf16x8 (&vf)[4], const bf16x8 (&q)[2], int x0, unsigned span, float& m, float& l, f32x4v (&O)[4]) {
    f32x4v s0 = {0.f, 0.f, 0.f, 0.f}, s1 = {0.f, 0.f, 0.f, 0.f};
    s0 = mfma16(kf[0], q[0], s0); s1 = mfma16(kf[2], q[0], s1);
    s0 = mfma16(kf[1], q[1], s0); s1 = mfma16(kf[3], q[1], s1);
    float sc[8] = {s0[0], s0[1], s0[2], s0[3], s1[0], s1[1], s1[2], s1[3]};
    if (domask) {
#pragma unroll
        for (int j = 0; j < 8; ++j) sc[j] = ((unsigned)(x0 + j) <= span) ? sc[j] : -1e30f;
    }
    float mx = fmaxf(fmaxf(fmaxf(sc[0], sc[1]), fmaxf(sc[2], sc[3])), fmaxf(fmaxf(sc[4], sc[5]), fmaxf(sc[6], sc[7])));
    mx = xq_max(mx);
    const bool upd = mx > m + SM_THR;
    if (__ballot(upd) != 0ull) {
        const float mn = upd ? mx : m, alpha = ex2(m - mn); l *= alpha;
#pragma unroll
        for (int dt = 0; dt < 4; ++dt) O[dt] = O[dt] * alpha;
        m = mn;
    }
    const float msub = (m < -1e29f) ? 0.f : m;
    float p[8], ps = 0.f;
#pragma unroll
    for (int j = 0; j < 8; ++j) { p[j] = ex2(sc[j] - msub); ps += p[j]; }
    l += ps;
    const bf16x8 pb = pack_p(p);
#pragma unroll
    for (int dt = 0; dt < 4; ++dt) O[dt] = mfma16(vf[dt], pb, O[dt]);
}
__device__ __forceinline__ unsigned flash16_entry(int s, const LAS unsigned* list) {
    const unsigned e = (unsigned)__builtin_amdgcn_readfirstlane((int)list[s >> 1]);
    return (e & 0xffff0000u) | (2u * (e & 0xffffu) + (unsigned)(s & 1));
}
__device__ __forceinline__ void flash16_run(const bf16x8* kb, const bf16x8* vb, const bf16x8 (&qa)[2], const bf16x8 (&qb)[2], int nsteps, const LAS unsigned* list, int tq, int t0, int qi4, int fq,
                                            float& ma, float& la, f32x4v (&Oa)[4], float& mb, float& lb, f32x4v (&Ob)[4]) {
    if (nsteps <= 0) return;
    bf16x8 kA[4], vA[4], kB[4], vB[4], kC[4], vC[4]; unsigned eA, eB, eC;
#define F16_LOAD(S, KF, VF, E) do { const int sn_ = ((S) < nsteps) ? (S) : nsteps - 1; E = flash16_entry(sn_, list); const size_t go_ = (size_t)(E & 0xffffu) * 256; \
        flash16_load(kb + go_, vb + go_, KF, VF); } while (0)
#define F16_COMP(KF, VF, E) do { const int grp_ = (int)(E & 0xffffu); const unsigned na_ = (E >> 16) & 0xFu, nb_ = E >> 20; const bool past_ = 32 * grp_ + 31 <= t0; \
        if (na_) { const int up_ = ((na_ >> qi4) & 1u) ? (tq - 32 * grp_) : -1; flash16_compute(!(past_ && na_ == 0xFu), KF, VF, qa, up_ < 0 ? 64 : 8 * fq, up_ < 0 ? 0u : (unsigned)up_, ma, la, Oa); } \
        if (nb_) { const int up_ = ((nb_ >> qi4) & 1u) ? (tq + 4 - 32 * grp_) : -1; flash16_compute(!(past_ && nb_ == 0xFu), KF, VF, qb, up_ < 0 ? 64 : 8 * fq, up_ < 0 ? 0u : (unsigned)up_, mb, lb, Ob); } } while (0)
    F16_LOAD(0, kA, vA, eA); F16_LOAD(1, kB, vB, eB);
#pragma unroll 1
    for (int s = 0; s < nsteps; s += 3) {
        F16_LOAD(s + 2, kC, vC, eC); F16_COMP(kA, vA, eA); if (s + 1 >= nsteps) break;
        F16_LOAD(s + 3, kA, vA, eA); F16_COMP(kB, vB, eB); if (s + 2 >= nsteps) break;
        F16_LOAD(s + 4, kB, vB, eB); F16_COMP(kC, vC, eC);
    }
#undef F16_LOAD
#undef F16_COMP
}

__device__ __forceinline__ unsigned wave_max_u32(unsigned v) {
#define DPP_U(v, ctrl) ((unsigned)__builtin_amdgcn_update_dpp(0, (int)(v), ctrl, 0xF, 0xF, true))
    { unsigned t = DPP_U(v, 0xB1); v = v > t ? v : t; t = DPP_U(v, 0x4E); v = v > t ? v : t; t = DPP_U(v, 0x141); v = v > t ? v : t; t = DPP_U(v, 0x140); v = v > t ? v : t; }
#undef DPP_U
    { const auto r = __builtin_amdgcn_permlane16_swap(v, v, false, false); v = r[0] > r[1] ? r[0] : r[1]; }
    { const auto r = __builtin_amdgcn_permlane32_swap(v, v, false, false); v = r[0] > r[1] ? r[0] : r[1]; }
    return v;
}

__device__ __forceinline__ void nsa_tile(const Ctx& C, int b, int g, int t0) {
    const bf16_t* P = (const bf16_t*)(C.ws + WS_R1); bf16_t* Y = (bf16_t*)(C.ws + WS_Y);
    int lane_ = C.lane; asm volatile("" : "+v"(lane_));
    const int lane = lane_, r = lane & 31, hi = lane >> 5, qi = r >> 2, h = r & 3, head = g * 4 + h, bg = b * 2 + g;
    const int t = t0 + qi; const size_t tok = (size_t)b * S_ + t;
    LAS float* imp = (LAS float*)(C.lds + C.wave * 16640);
    LAS float* ost = (LAS float*)(C.lds + C.wave * 16640 + 8448) + lane;
    const float QS = 0.18033688011112042f;
    bf16x8 qf[4];
    {
        const bf16_t* qp = P + tok * PP + PC_Q + head * 64;
#pragma unroll
        for (int s = 0; s < 4; ++s) qf[s] = scale_q(*(const u32x4*)(qp + 16 * s + 8 * hi), QS);
    }
    const bf16_t* gp = P + tok * PP + PC_NG + head * 3;
    const float gc = sigm(bf1(gp[0])), gs = sigm(bf1(gp[1])), gw = sigm(bf1(gp[2]));

    const int cur = t0 >> 6;
    {
        const int nvq = (t >= 31) ? ((t - 31) >> 4) + 1 : 0;
        const int tl = t0 + 7, nvmax = (tl >= 31) ? ((tl - 31) >> 4) + 1 : 0, ntile = (nvmax + 31) >> 5;
        const bf16x8* kb = (const bf16x8*)(C.ws + WS_KCMP) + (size_t)bg * 32 * 4 * 64 + lane;
        const bf16x8* vb = (const bf16x8*)(C.ws + WS_VCMP) + (size_t)bg * 64 * 2 * 64 + lane;
        float m1 = -1e30f, l1 = 0.f;
#define CMP_P1(KF, KT) do { \
            f32x16 sc; _Pragma("unroll") for (int i = 0; i < 16; ++i) sc[i] = 0.f; \
            _Pragma("unroll") for (int s = 0; s < 4; ++s) sc = mfma32(KF[s], qf[s], sc); \
            const int up = nvq - 1 - 32 * (KT); const int x0 = up < 0 ? 64 : 8 * hi; const unsigned span = up < 0 ? 0u : (unsigned)up; \
            float mx = -1e30f; bool ok[16]; \
            _Pragma("unroll") for (int i = 0; i < 16; ++i) { ok[i] = (unsigned)(x0 + i + (i >= 8 ? 8 : 0)) <= span; sc[i] = ok[i] ? sc[i] : -1e30f; mx = fmaxf(mx, sc[i]); } \
            mx = xhalf_max(mx); \
            const float mn = fmaxf(m1, mx); float ps = 0.f; \
            _Pragma("unroll") for (int i = 0; i < 16; ++i) ps += ok[i] ? ex2(sc[i] - mn) : 0.f; \
            l1 = l1 * ex2(m1 - mn) + ps; m1 = mn; } while (0)
        if (ntile > 0) {
            bf16x8 kA[4], kB[4], kC[4], kD[4];
#define CMP_LDK(KF, KT) do { const int kn_ = ((KT) < ntile) ? (KT) : ntile - 1; _Pragma("unroll") for (int s = 0; s < 4; ++s) KF[s] = kb[kn_ * 256 + s * 64]; } while (0)
            CMP_LDK(kA, 0); CMP_LDK(kB, 1); CMP_LDK(kC, 2);
#pragma unroll 1
            for (int kt = 0; kt < ntile; kt += 4) {
                CMP_LDK(kD, kt + 3); __builtin_amdgcn_sched_barrier(0); CMP_P1(kA, kt);     if (kt + 1 >= ntile) break;
                CMP_LDK(kA, kt + 4); __builtin_amdgcn_sched_barrier(0); CMP_P1(kB, kt + 1); if (kt + 2 >= ntile) break;
                CMP_LDK(kB, kt + 5); __builtin_amdgcn_sched_barrier(0); CMP_P1(kC, kt + 2); if (kt + 3 >= ntile) break;
                CMP_LDK(kC, kt + 6); __builtin_amdgcn_sched_barrier(0); CMP_P1(kD, kt + 3);
            }
        }
#undef CMP_P1
        l1 = xhalf_sum(l1);
        const float inv = 1.f / fmaxf(l1, 1e-30f);
        for (int e = lane; e < 8 * 264; e += 64) imp[e] = 0.f;
        LDS_WAIT();
        f32x16 O[2];
#pragma unroll
        for (int i = 0; i < 16; ++i) { O[0][i] = 0.f; O[1][i] = 0.f; }
#define CMP_P2(KF, VF, KT) do { \
            f32x16 sc; _Pragma("unroll") for (int i = 0; i < 16; ++i) sc[i] = 0.f; \
            _Pragma("unroll") for (int s = 0; s < 4; ++s) sc = mfma32(KF[s], qf[s], sc); \
            const int up = nvq - 1 - 32 * (KT); const int x0 = up < 0 ? 64 : 8 * hi; const unsigned span = up < 0 ? 0u : (unsigned)up; \
            float p[16]; \
            _Pragma("unroll") for (int i = 0; i < 16; ++i) { const bool ok = (unsigned)(x0 + i + (i >= 8 ? 8 : 0)) <= span; p[i] = ok ? ex2(sc[i] - m1) * inv : 0.f; } \
            _Pragma("unroll") for (int rr = 0; rr < 2; ++rr) { \
                const float* q8 = p + 8 * rr; \
                float a = q8[0] + q8[1] + q8[2] + 0.5f * q8[3], bq = 0.5f * q8[3] + q8[4] + q8[5] + q8[6] + 0.5f * q8[7], cq = 0.5f * q8[7]; \
                a += dpp_xor1(a); a += dpp_xor2(a); bq += dpp_xor1(bq); bq += dpp_xor2(bq); cq += dpp_xor1(cq); cq += dpp_xor2(cq); \
                _Pragma("unroll") for (int hh = 0; hh < 2; ++hh)     \
                if (h == 0 && hi == hh) { LAS float* ip = imp + qi * 264 + 8 * (KT) + 2 * hi + 4 * rr; \
                    __hip_atomic_fetch_add(ip, a, __ATOMIC_RELAXED, __HIP_MEMORY_SCOPE_WORKGROUP); __hip_atomic_fetch_add(ip + 1, bq, __ATOMIC_RELAXED, __HIP_MEMORY_SCOPE_WORKGROUP); \
                    __hip_atomic_fetch_add(ip + 2, cq, __ATOMIC_RELAXED, __HIP_MEMORY_SCOPE_WORKGROUP); } \
            } \
            const bf16x8 pb0 = pack_p(p), pb1 = pack_p(p + 8); \
            O[0] = mfma32(VF[0], pb0, O[0]); O[1] = mfma32(VF[1], pb0, O[1]); \
            O[0] = mfma32(VF[2], pb1, O[0]); O[1] = mfma32(VF[3], pb1, O[1]); } while (0)
        if (ntile > 0) {
            bf16x8 kA[4], kB[4], kC[4], vA[4];
#define CMP_LDV(KT) do { _Pragma("unroll") for (int s = 0; s < 4; ++s) vA[s] = vb[(KT) * 256 + s * 64]; } while (0)
            CMP_LDK(kA, 0); CMP_LDK(kB, 1);
#pragma unroll 1
            for (int kt = 0; kt < ntile; kt += 3) {
                CMP_LDK(kC, kt + 2); CMP_LDV(kt);     __builtin_amdgcn_sched_barrier(0); CMP_P2(kA, vA, kt);     if (kt + 1 >= ntile) break;
                CMP_LDK(kA, kt + 3); CMP_LDV(kt + 1); __builtin_amdgcn_sched_barrier(0); CMP_P2(kB, vA, kt + 1); if (kt + 2 >= ntile) break;
                CMP_LDK(kB, kt + 4); CMP_LDV(kt + 2); __builtin_amdgcn_sched_barrier(0); CMP_P2(kC, vA, kt + 2);
            }
#undef CMP_LDV
#undef CMP_LDK
        }
#undef CMP_P2
#pragma unroll
        for (int i = 0; i < 16; ++i) { ost[i * 64] = gc * O[0][i]; ost[(16 + i) * 64] = gc * O[1][i]; }
        LDS_WAIT();
    }

    unsigned bmv[4];
    if (cur <= 15) {
#pragma unroll
        for (int c = 0; c < 4; ++c) bmv[c] = (lane + 64 * c <= cur) ? 0xFFu : 0u;
    } else {
        unsigned key[8][4];
#pragma unroll
        for (int q2 = 0; q2 < 8; ++q2)
#pragma unroll
            for (int c = 0; c < 4; ++c) { const int j = lane + 64 * c; const bool cand = (j >= 1) && (j < cur - 1); const float v = imp[q2 * 264 + j];
                key[q2][c] = cand ? ((__float_as_uint(v) & 0xFFFFFF00u) | (unsigned)(255 - j)) : 0u; }
#pragma unroll
        for (int c = 0; c < 4; ++c) bmv[c] = 0u;
#pragma unroll 1
        for (int round = 0; round < 13; ++round) {
#pragma unroll
            for (int q2 = 0; q2 < 8; ++q2) {
                unsigned mx = key[q2][0]; mx = mx > key[q2][1] ? mx : key[q2][1]; mx = mx > key[q2][2] ? mx : key[q2][2]; mx = mx > key[q2][3] ? mx : key[q2][3];
                const unsigned w = wave_max_u32(mx);
#pragma unroll
                for (int c = 0; c < 4; ++c) { const bool win = (key[q2][c] == w) && (w != 0u); key[q2][c] = win ? 0u : key[q2][c]; bmv[c] |= win ? (1u << q2) : 0u; }
            }
        }
#pragma unroll
        for (int c = 0; c < 4; ++c) { const int j = lane + 64 * c; if (j == 0 || j == cur || j == cur - 1) bmv[c] = 0xFFu; }
    }

    {
        LAS unsigned* list = (LAS unsigned*)imp;
        LAS float* ostb = (LAS float*)(C.lds + C.wave * 16640 + 8448);
        const int q16 = lane & 15, fq = lane >> 4, qi4 = q16 >> 2, head4 = g * 4 + (q16 & 3);
        const bf16x8* kb = (const bf16x8*)(C.ws + WS_KSLC) + (size_t)bg * 512 * 256 + lane;
        const bf16x8* vb = (const bf16x8*)(C.ws + WS_VSLC) + (size_t)bg * 512 * 256 + lane;
        int nblk = 0;
#pragma unroll
        for (int c = 0; c < 4; ++c) {
            const unsigned long long mk = __ballot(bmv[c] != 0u);
            const int pos = nblk + (int)__builtin_amdgcn_mbcnt_hi((unsigned)(mk >> 32), __builtin_amdgcn_mbcnt_lo((unsigned)mk, 0u));
            if (bmv[c] != 0u) list[pos] = (unsigned)(lane + 64 * c) | (bmv[c] << 16);
            nblk += __builtin_popcountll(mk);
        }
        LDS_WAIT();
        const int tq = t0 + qi4;
        bf16x8 q16f[2][2]; float gs4[2];
#pragma unroll
        for (int sub = 0; sub < 2; ++sub) {
            const size_t tok4 = (size_t)b * S_ + tq + 4 * sub;
            const bf16_t* qp = P + tok4 * PP + PC_Q + head4 * 64;
            q16f[sub][1] = scale_q(*(const u32x4*)(qp + 32 + 8 * fq), QS);
            const u32x4 mv4 = *(const u32x4*)(qp + 8 * fq), pv4 = *(const u32x4*)(qp + 8 * ((fq ^ 1) & 1));
            const float* rt = (const float*)(C.ws + WS_ROPE) + tok4 * 16;
            const f32x4 ca = *(const f32x4*)rt, cb2 = *(const f32x4*)(rt + 4), sa = *(const f32x4*)(rt + 8), sb = *(const f32x4*)(rt + 12);
            const float cs[8] = {ca.x, ca.y, ca.z, ca.w, cb2.x, cb2.y, cb2.z, cb2.w}, sn[8] = {sa.x, sa.y, sa.z, sa.w, sb.x, sb.y, sb.z, sb.w};
            const float mv[8] = {bf_lo(mv4.x), bf_hi(mv4.x), bf_lo(mv4.y), bf_hi(mv4.y), bf_lo(mv4.z), bf_hi(mv4.z), bf_lo(mv4.w), bf_hi(mv4.w)};
            const float pp[8] = {bf_lo(pv4.x), bf_hi(pv4.x), bf_lo(pv4.y), bf_hi(pv4.y), bf_lo(pv4.z), bf_hi(pv4.z), bf_lo(pv4.w), bf_hi(pv4.w)};
            const bool roped = fq < 2; const float sg = (fq == 0) ? -1.f : 1.f; float o[8];
#pragma unroll
            for (int e = 0; e < 8; ++e) o[e] = (roped ? (mv[e] * cs[e] + sg * pp[e] * sn[e]) : mv[e]) * QS;
            q16f[sub][0] = pack_p(o);
            gs4[sub] = sigm(bf1(P[tok4 * PP + PC_NG + head4 * 3 + 1]));
        }
        float ma = -1e30f, la = 0.f, mb = -1e30f, lb = 0.f; f32x4v Oa[4], Ob[4];
#pragma unroll
        for (int dt = 0; dt < 4; ++dt) { Oa[dt] = (f32x4v){0.f, 0.f, 0.f, 0.f}; Ob[dt] = (f32x4v){0.f, 0.f, 0.f, 0.f}; }
        flash16_run(kb, vb, q16f[0], q16f[1], 2 * nblk, list, tq, t0, qi4, fq, ma, la, Oa, mb, lb, Ob);
        la = xq_sum(la); lb = xq_sum(lb);
        const float sca = gs4[0] / fmaxf(la, 1e-30f), scb = gs4[1] / fmaxf(lb, 1e-30f);
#pragma unroll
        for (int dt = 0; dt < 4; ++dt)
#pragma unroll
            for (int i = 0; i < 4; ++i) { LAS float* op = ostb + ((dt >> 1) * 16 + 4 * (2 * (dt & 1) + (fq >> 1)) + i) * 64 + q16 + 32 * (fq & 1); op[0] += sca * Oa[dt][i]; op[16] += scb * Ob[dt][i]; }
        LDS_WAIT();
    }
    {
        bf16x8 qr[4];
        {
            const bf16_t* qp = P + tok * PP + PC_Q + head * 64;
#pragma unroll
            for (int s = 1; s < 4; ++s) qr[s] = scale_q(*(const u32x4*)(qp + 16 * s + 8 * hi), QS);
            const u32x4 mv4 = *(const u32x4*)(qp + 8 * hi), pv4 = *(const u32x4*)(qp + 8 * (hi ^ 1));
            const float* rt = (const float*)(C.ws + WS_ROPE) + tok * 16;
            const f32x4 ca = *(const f32x4*)rt, cb2 = *(const f32x4*)(rt + 4), sa = *(const f32x4*)(rt + 8), sb = *(const f32x4*)(rt + 12);
            const float cs[8] = {ca.x, ca.y, ca.z, ca.w, cb2.x, cb2.y, cb2.z, cb2.w}, sn[8] = {sa.x, sa.y, sa.z, sa.w, sb.x, sb.y, sb.z, sb.w};
            const float mv[8] = {bf_lo(mv4.x), bf_hi(mv4.x), bf_lo(mv4.y), bf_hi(mv4.y), bf_lo(mv4.z), bf_hi(mv4.z), bf_lo(mv4.w), bf_hi(mv4.w)};
            const float pp[8] = {bf_lo(pv4.x), bf_hi(pv4.x), bf_lo(pv4.y), bf_hi(pv4.y), bf_lo(pv4.z), bf_hi(pv4.z), bf_lo(pv4.w), bf_hi(pv4.w)};
            const float sg = hi ? 1.f : -1.f; float o[8];
#pragma unroll
            for (int e = 0; e < 8; ++e) o[e] = (mv[e] * cs[e] + sg * pp[e] * sn[e]) * QS;
            qr[0] = pack_p(o);
        }
        const bf16x8* kb = (const bf16x8*)(C.ws + WS_KWIN) + (size_t)bg * 512 * 4 * 64 + lane;
        const bf16x8* vb = (const bf16x8*)(C.ws + WS_VWIN) + (size_t)bg * 1024 * 2 * 64 + lane;
        float m = -1e30f, l = 0.f; f32x16 O[2];
#pragma unroll
        for (int i = 0; i < 16; ++i) { O[0][i] = 0.f; O[1][i] = 0.f; }
        const int tlo = (t0 - 511 > 0 ? t0 - 511 : 0) >> 5, thi = (t0 + 7) >> 5;
        flash_run<1>(kb, vb, qr, thi - tlo + 1, (const LAS unsigned*)imp, tlo, t, t0, qi, hi, m, l, O);
        l = xhalf_sum(l);
        const float sc = gw / fmaxf(l, 1e-30f);
        bf16_t* yp = Y + tok * YP + 512 + head * 64 + 4 * hi;
#pragma unroll
        for (int dt = 0; dt < 2; ++dt)
#pragma unroll
            for (int ig = 0; ig < 4; ++ig) { float o4[4];
#pragma unroll
                for (int e = 0; e < 4; ++e) o4[e] = ost[(dt * 16 + 4 * ig + e) * 64] + sc * O[dt][4 * ig + e];
                u32x2 w; w.x = cvt_pk_bf16(o4[0], o4[1]); w.y = cvt_pk_bf16(o4[2], o4[3]); *(u32x2*)(yp + 32 * dt + 8 * ig) = w; }
        LDS_WAIT();
    }
}

__device__ __forceinline__ void mem_tile(const Ctx& C, int b, int hm, int t0) {
    const bf16_t* P = (const bf16_t*)(C.ws + WS_R1); bf16_t* Y = (bf16_t*)(C.ws + WS_Y);
    int lane_ = C.lane; asm volatile("" : "+v"(lane_));
    const int lane = lane_, r = lane & 31, hi = lane >> 5;
    const size_t tok = (size_t)b * S_ + t0 + r;
    const float QS = 0.12751743082459868f;
    bf16x8 q[8];
    const bf16_t* qp = P + tok * PP + PC_QM + hm * 128;
#pragma unroll
    for (int s = 0; s < 8; ++s) q[s] = scale_q(*(const u32x4*)(qp + 16 * s + 8 * hi), QS);
    const bf16x8* kb = (const bf16x8*)(C.ws + WS_MEMK) + (size_t)(b * 4 + hm) * 8 * 8 * 64 + lane;
    const bf16x8* vb = (const bf16x8*)(C.ws + WS_MEMV) + (size_t)(b * 4 + hm) * 16 * 4 * 64 + lane;
    float m = -1e30f, l = 0.f; f32x16 O[4];
#pragma unroll
    for (int i = 0; i < 16; ++i) { O[0][i] = 0.f; O[1][i] = 0.f; O[2][i] = 0.f; O[3][i] = 0.f; }
#define MEM_STEP(KF, VF) do { \
        f32x16 sc; _Pragma("unroll") for (int i = 0; i < 16; ++i) sc[i] = 0.f; \
        _Pragma("unroll") for (int s = 0; s < 8; ++s) sc = mfma32(KF[s], q[s], sc); \
        float mx = -1e30f; _Pragma("unroll") for (int i = 0; i < 16; ++i) mx = fmaxf(mx, sc[i]); \
        mx = xhalf_max(mx); \
        const bool upd = mx > m + SM_THR; \
        if (__ballot(upd) != 0ull) { const float mn = upd ? mx : m, alpha = ex2(m - mn); l *= alpha; O[0] = O[0] * alpha; O[1] = O[1] * alpha; O[2] = O[2] * alpha; O[3] = O[3] * alpha; m = mn; } \
        float p[16], ps = 0.f; _Pragma("unroll") for (int i = 0; i < 16; ++i) { p[i] = ex2(sc[i] - m); ps += p[i]; } \
        l += ps; \
        const bf16x8 pb0 = pack_p(p), pb1 = pack_p(p + 8); \
        _Pragma("unroll") for (int dt = 0; dt < 4; ++dt) { O[dt] = mfma32(VF[dt], pb0, O[dt]); O[dt] = mfma32(VF[4 + dt], pb1, O[dt]); } } while (0)
    {
        bf16x8 kA[8], vv[8];
#pragma unroll 1
        for (int kt = 0; kt < 8; ++kt) {
#pragma unroll
            for (int s = 0; s < 8; ++s) kA[s] = kb[kt * 512 + s * 64];
#pragma unroll
            for (int s = 0; s < 8; ++s) vv[s] = vb[kt * 512 + s * 64];
            __builtin_amdgcn_sched_barrier(0);
            MEM_STEP(kA, vv);
        }
    }
#undef MEM_STEP
    l = xhalf_sum(l);
    const float inv = 1.f / l;
    bf16_t* yp = Y + tok * YP + 1024 + hm * 128 + 4 * hi;
#pragma unroll
    for (int dt = 0; dt < 4; ++dt)
#pragma unroll
        for (int ig = 0; ig < 4; ++ig) { u32x2 w; w.x = cvt_pk_bf16(O[dt][4 * ig] * inv, O[dt][4 * ig + 1] * inv); w.y = cvt_pk_bf16(O[dt][4 * ig + 2] * inv, O[dt][4 * ig + 3] * inv); *(u32x2*)(yp + 32 * dt + 8 * ig) = w; }
}

__device__ __forceinline__ void attention_phase(const Ctx& C) {
    const int bxx = C.gw / NWAVES; const bool xmode = (C.G & 7) == 0;
    const int x = bxx & 7, rank = xmode ? (bxx >> 3) * NWAVES + C.wave : C.gw, nrank = xmode ? (C.G >> 3) * NWAVES : C.NGW, nitem = xmode ? 1536 : 12288;
    for (int i = rank; i < nitem; i += nrank) {
        int nsa_n, mem_e;
        if (xmode) { nsa_n = (i < 1024) ? (x >> 1) * 2048 + 2 * i + (x & 1) : -1; mem_e = x * 512 + (i - 1024); }
        else { if (i < 8192) { const int k = i >> 11, w = i & 2047; nsa_n = k * 2048 + ((k & 1) ? 2047 - w : w); } else nsa_n = -1; mem_e = i - 8192; }
        if (nsa_n >= 0) { const int k = nsa_n >> 11; nsa_tile(C, k >> 1, k & 1, (nsa_n & 2047) * 8); }
        else { const int bh = mem_e >> 9; mem_tile(C, bh >> 2, bh & 3, (mem_e & 511) * 32); }
    }
}

#define XB_TMO      128
#define XB_XCNT(j)  (256  + 64 * (j))
#define XB_XSUB(j)  (1280 + 64 * (j))
#define XB_XGEN(j)  (2304 + 64 * (j))
#define XB_TOP      3328
#define XB_TOPGEN   3392
#define XCD_BAR_WORDS 3456
#define XB_SPIN_CAP (1u << 18)
__device__ __forceinline__ unsigned xb_ld(unsigned* p)              { return __hip_atomic_load(p, __ATOMIC_RELAXED, __HIP_MEMORY_SCOPE_AGENT); }
__device__ __forceinline__ unsigned xb_add(unsigned* p, unsigned v) { return __hip_atomic_fetch_add(p, v, __ATOMIC_RELAXED, __HIP_MEMORY_SCOPE_AGENT); }
__device__ __forceinline__ unsigned xb_xcc_id() { return (unsigned)__builtin_amdgcn_s_getreg((3 << 11) | 20) & 0xFu; }
#define XB_SPIN(cond, bar) do { unsigned _sp = 0; while (cond) { __builtin_amdgcn_s_sleep(1); \
    if ((++_sp & 255u) == 0u) { if (xb_ld(&(bar)[XB_TMO])) break; if (_sp > XB_SPIN_CAP) { atomicAdd(&(bar)[XB_TMO], 1u); break; } } } } while (0)
__device__ __forceinline__ void xcd_barrier_complete(unsigned* bar, unsigned x, unsigned& nloc, unsigned& nx) {
    const unsigned G = gridDim.x * gridDim.y * gridDim.z;
    unsigned sum, cnt, mine, sp = 0u;
    for (;;) {
        sum = 0u; cnt = 0u; mine = 0u;
#pragma unroll
        for (unsigned j = 0; j < 16; ++j) { const unsigned c = xb_ld(&bar[XB_XCNT(j)]); sum += c; cnt += (c > 0u) ? 1u : 0u; mine = (j == x) ? c : mine; }
        if (sum == G) break;
        __builtin_amdgcn_s_sleep(1);
        if ((++sp & 255u) == 0u) { if (xb_ld(&bar[XB_TMO])) break; if (sp > XB_SPIN_CAP) { atomicAdd(&bar[XB_TMO], 1u); break; } }
    }
    nloc = mine > 0u ? mine : 1u; nx = cnt > 0u ? cnt : 1u;
}
__device__ __forceinline__ void xcd_barrier(unsigned* bar, volatile LAS unsigned* st, bool tid0) {
    asm volatile("s_waitcnt vmcnt(0)" ::: "memory");
    __syncthreads();
    if (tid0) {
        __builtin_amdgcn_s_waitcnt(0);
        const unsigned x = xb_xcc_id();
        unsigned nloc = st[0], nx = st[1];
        if (nloc == 0u) { xcd_barrier_complete(bar, x, nloc, nx); st[0] = nloc; st[1] = nx; }
        const unsigned old = xb_add(&bar[XB_XSUB(x)], 1u);
        const unsigned gen = old / nloc;
        if (old + 1u == (gen + 1u) * nloc) {
            __builtin_amdgcn_fence(__ATOMIC_RELEASE, "agent");
            asm volatile("s_waitcnt vmcnt(0)" ::: "memory");
            const unsigned og = xb_add(&bar[XB_TOP], 1u);
            const unsigned tg = og / nx;
            if (og + 1u == (tg + 1u) * nx) xb_add(&bar[XB_TOPGEN], 1u);
            else XB_SPIN(xb_ld(&bar[XB_TOPGEN]) == tg, bar);
            __builtin_amdgcn_fence(__ATOMIC_ACQUIRE, "agent");
            xb_add(&bar[XB_XGEN(x)], 1u);
            asm volatile("s_waitcnt vmcnt(0)" ::: "memory");
        } else {
            XB_SPIN(xb_ld(&bar[XB_XGEN(x)]) == gen, bar);
            __builtin_amdgcn_fence(__ATOMIC_ACQUIRE, "agent");
            asm volatile("s_waitcnt vmcnt(0)" ::: "memory");
        }
    }
    __syncthreads();
}

constexpr int LDS_BYTES = 147456, XB_LDS_OFF = 147456 - 64;
constexpr int NPHASE = 1 + 2 * 14;

__global__ void __launch_bounds__(NWAVES * 64, 2) fwd_kernel(Args args) {
    extern __shared__ __attribute__((aligned(16))) unsigned char lds_raw[];
    cg::grid_group grid = cg::this_grid();
    if (args.ph_lo == 0x7fffffff) grid.sync();
    const int wave0 = __builtin_amdgcn_readfirstlane((int)threadIdx.x >> 6);
    {
        volatile LAS unsigned* st = (volatile LAS unsigned*)(lds_raw + XB_LDS_OFF);
        if (threadIdx.x == 0) { st[0] = 0u; st[1] = 0u; (void)xb_add((unsigned*)(args.ws + WS_BAR) + XB_XCNT(xb_xcc_id()), 1u); }
        __syncthreads();
    }
#define PHASE_BEGIN { \
        unsigned char* ws0_ = args.ws; asm volatile("" : "+s"(ws0_)); gu8* ws = (gu8*)ws0_;     \
        int tid_; asm volatile("v_mbcnt_lo_u32_b32 %0, -1, 0\n\tv_mbcnt_hi_u32_b32 %0, -1, %0" : "=v"(tid_)); tid_ += wave0 * 64; \
        Ctx C; C.a = &args; C.ws = ws; C.lds = (LAS unsigned char*)lds_raw; C.tid = tid_; C.lane = tid_ & 63; C.wave = __builtin_amdgcn_readfirstlane(tid_ >> 6); \
        int bx = blockIdx.x; asm volatile("" : "+s"(bx)); C.G = gridDim.x; C.gw = bx * NWAVES + C.wave; C.NGW = C.G * NWAVES; \
        bf16_t* const H = (bf16_t*)(ws + WS_H); bf16_t* const R1 = (bf16_t*)(ws + WS_R1); bf16_t* const Y = (bf16_t*)(ws + WS_Y); (void)H; (void)R1; (void)Y; (void)bx;
#define PHASE_END   { int ln_; asm volatile("v_mbcnt_lo_u32_b32 %0, -1, 0\n\tv_mbcnt_hi_u32_b32 %0, -1, %0" : "=v"(ln_));   \
        xcd_barrier((unsigned*)(ws + WS_BAR), (volatile LAS unsigned*)(lds_raw + XB_LDS_OFF), (wave0 == 0) && (ln_ == 0)); } }
#define PHASE_END_IF(c_) { if (c_) { int ln_; asm volatile("v_mbcnt_lo_u32_b32 %0, -1, 0\n\tv_mbcnt_hi_u32_b32 %0, -1, %0" : "=v"(ln_));   \
        xcd_barrier((unsigned*)(ws + WS_BAR), (volatile LAS unsigned*)(lds_raw + XB_LDS_OFF), (wave0 == 0) && (ln_ == 0)); } } }
#define PHASE_END_CG grid.sync(); }

    PHASE_BEGIN
        convert_layer(C, 0);
        rope_table(C);
        prenorm_rows(C, (const float*)args.in[0], (const float*)args.in[3], H);
    PHASE_END

#pragma unroll 1
    for (int l = 0; l < 2; ++l) {
        PHASE_BEGIN
            { pg8::GemmDesc g{(const char*)H, (const char*)(ws + WS_W1IN), DM, DM, 128, 128, 16}; pg8::StdOrder S; S.init(T_, 2 * FF, C.G, bx, DM, DM);
              pg8::Epi<1> E{R1, FF, nullptr, nullptr}; pg8::gemm_phase(C.lds, C.tid, g, S, E); }
        PHASE_END
        PHASE_BEGIN
            { pg8::GemmDesc g{(const char*)R1, (const char*)(ws + WS_W1OUT), FF, FF, 128, 128, 44}; pg8::StdOrder S; S.init(T_, DM, C.G, bx, FF, FF);
              pg8::Epi<0> E{H, DM, nullptr, nullptr}; pg8::gemm_phase(C.lds, C.tid, g, S, E); }
        PHASE_END
        PHASE_BEGIN
            if (bx < 8) {
                { pg8::GemmDesc g{(const char*)(ws + WS_MEMN), (const char*)(ws + WS_WMKV), DM, DM, 128, 128, 16}; pg8::StdOrder S; S.init(512, DM, C.G, bx, DM, DM);
              pg8::Epi<0> E{(bf16_t*)(ws + WS_MKV), DM, nullptr, nullptr}; pg8::gemm_phase(C.lds, C.tid, g, S, E); }
            } else {
                norm_phase(C, C.gw - 8 * NWAVES, C.NGW - 8 * NWAVES, l == 0 ? (const float*)args.in[0] : args.out, args.out, H, H, INF(4, l, DM), INF(7, l, DM), 0.5f);
            }
            cb_reduce(C, l);
        PHASE_END
        PHASE_BEGIN
            { pg8::GemmDesc g{(const char*)H, (const char*)(ws + WS_WMIX), DM, DM, 128, 128, 16}; pg8::StdOrder S; S.init(T_, PP, C.G, bx, DM, DM);
              pg8::Epi<0> E{R1, PP, nullptr, nullptr}; pg8::gemm_phase(C.lds, C.tid, g, S, E); }
        PHASE_END
        PHASE_BEGIN
            if (bx < 64) {
                pg8::GemmDesc g{(const char*)R1, (const char*)(ws + WS_WC1), 16 * PP, 2048, PP * 2, 128, 16}; pg8::CmpOrder S{bx};
                pg8::Epi<0> E{(bf16_t*)(ws + WS_CMPP), 256, nullptr, nullptr}; pg8::gemm_phase(C.lds, C.tid, g, S, E);
            } else {
                prep_items(C, l, C.gw - 64 * NWAVES, C.NGW - 64 * NWAVES);
                memkv_ops(C, C.gw - 64 * NWAVES, C.NGW - 64 * NWAVES);
            }
        PHASE_END
        PHASE_BEGIN
            cmp_stage2(C, l);
        PHASE_END
        PHASE_BEGIN
            attention_phase(C);
        PHASE_END
        PHASE_BEGIN
            { pg8::GemmDesc g{(const char*)H, (const char*)(ws + WS_WG), DM, DM, 128, 128, 16}; pg8::StdOrder S; S.init(T_, GP, C.G, bx, DM, DM);
              pg8::Epi<2> E{R1, GP, nullptr, nullptr}; pg8::gemm_phase(C.lds, C.tid, g, S, E); }
        PHASE_END
        PHASE_BEGIN
            { pg8::GemmDesc g{(const char*)Y, (const char*)(ws + WS_WBR), YP, YP, 128, 128, 8}; pg8::MergeOrder S; S.init(T_, DM, C.G, bx, YP, YP);
              pg8::Epi<3> E{H, DM, R1, nullptr}; pg8::gemm_phase(C.lds, C.tid, g, S, E); }
        PHASE_END
        PHASE_BEGIN
            { pg8::GemmDesc g{(const char*)H, (const char*)(ws + WS_WOUT), DM, DM, 128, 128, 16}; pg8::StdOrder S; S.init(T_, DM, C.G, bx, DM, DM);
              pg8::Epi<0> E{R1, DM, nullptr, nullptr}; pg8::gemm_phase(C.lds, C.tid, g, S, E); }
        PHASE_END
        PHASE_BEGIN
            norm_phase(C, C.gw, C.NGW, args.out, args.out, R1, H, INF(8, l, DM), INF(25, l, DM), 1.0f);
        PHASE_END
        PHASE_BEGIN
            { pg8::GemmDesc g{(const char*)H, (const char*)(ws + WS_W2IN), DM, DM, 128, 128, 16}; pg8::StdOrder S; S.init(T_, 2 * FF, C.G, bx, DM, DM);
              pg8::Epi<1> E{R1, FF, nullptr, nullptr}; pg8::gemm_phase(C.lds, C.tid, g, S, E); }
        PHASE_END
        PHASE_BEGIN
            { pg8::GemmDesc g{(const char*)R1, (const char*)(ws + WS_W2OUT), FF, FF, 128, 128, 44}; pg8::StdOrder S; S.init(T_, DM, C.G, bx, FF, FF);
              pg8::Epi<0> E{H, DM, nullptr, nullptr}; pg8::gemm_phase(C.lds, C.tid, g, S, E); }
        PHASE_END
        PHASE_BEGIN
            norm_phase(C, C.gw, C.NGW, args.out, args.out, H, H, INF(26, l, DM), l == 0 ? INF(3, 1, DM) : nullptr, 0.5f);
            if (l == 0) convert_layer(C, 1);
        PHASE_END_IF(l == 0)
    }
}

extern "C" void kernel_launch(void* const* d_in, const int* in_sizes, int n_in, void* d_out, int out_size, void* d_ws, size_t ws_size, hipStream_t stream) {
    static int grid = 0;
    if (grid == 0) {
        if (n_in != 29 || ws_size < WS_END) { fprintf(stderr, "kernel_launch: unexpected n_in %d / ws %zu\n", n_in, ws_size); grid = -1; return; }
        int dev = 0, cus = 0, per_cu = 0;
        hipGetDevice(&dev); hipDeviceGetAttribute(&cus, hipDeviceAttributeMultiprocessorCount, dev);
        hipFuncSetAttribute((const void*)fwd_kernel, hipFuncAttributeMaxDynamicSharedMemorySize, LDS_BYTES);
        hipOccupancyMaxActiveBlocksPerMultiprocessor(&per_cu, (const void*)fwd_kernel, NWAVES * 64, LDS_BYTES);
        if (per_cu < 1) per_cu = 1;
        grid = cus * per_cu;
        (void)hipGetLastError();
    }
    if (grid < 0) return;
    hipMemsetAsync((char*)d_ws + WS_BAR, 0, 16384, stream);
    Args a{};
    for (int i = 0; i < 29; ++i) a.in[i] = d_in[i];
    a.out = (float*)d_out; a.ws = (unsigned char*)d_ws; a.ph_lo = 0; a.ph_hi = NPHASE;
    void* kargs[] = {&a};
    hipError_t e = hipLaunchCooperativeKernel((const void*)fwd_kernel, dim3(grid), dim3(NWAVES * 64), kargs, LDS_BYTES, stream);
    if (e != hipSuccess) fprintf(stderr, "cooperative launch failed: %s (grid %d)\n", hipGetErrorString(e), grid);
}
```

```cpp
#include <hip/hip_runtime.h>
#include <hip/hip_cooperative_groups.h>
#include <cstdio>
#include <cstdint>
namespace cg = cooperative_groups;

#define LAS __attribute__((address_space(3)))
typedef unsigned short bf16_t;
typedef short bf16x8 __attribute__((ext_vector_type(8)));
typedef float f32x4 __attribute__((ext_vector_type(4)));
typedef float f32x16 __attribute__((ext_vector_type(16)));
typedef unsigned u32x4 __attribute__((ext_vector_type(4)));
typedef unsigned u32x2 __attribute__((ext_vector_type(2)));

constexpr int NBATCH = 2, S_ = 16384, T_ = NBATCH * S_, DM = 1024, FF = 2816, PP = 3584, GP = 3072, YP = 1536;
constexpr int NWAVES = 8;
constexpr float EPS = 1e-6f;
constexpr int PC_Q = 1536, PC_KV = 2048, PC_QM = 2816, PC_NG = 3328;

constexpr size_t MiB = 1u << 20;
constexpr size_t WS_W1IN = 0, WS_W1OUT = 11 * MiB, WS_WMIX = WS_W1OUT + 11 * MiB / 2, WS_WG = WS_WMIX + 7 * MiB, WS_WBR = WS_WG + 6 * MiB, WS_WOUT = WS_WBR + 3 * MiB,
                 WS_W2IN = WS_WOUT + 2 * MiB, WS_W2OUT = WS_W2IN + 11 * MiB, WS_WC1 = WS_W2OUT + 11 * MiB / 2  , WS_WMKV = WS_WC1 + 2 * MiB,
                 WS_MEMN = WS_WMKV + 2 * MiB, WS_MKV = WS_MEMN + 1 * MiB, WS_CB = WS_MKV + 1 * MiB  , WS_CBP = WS_CB + 8192  , WS_BAR = WS_CB + 8192 + 131072  ;
static_assert(WS_CB == 57 * MiB, "ws map");
constexpr size_t WS_ROPE = 58 * MiB, WS_MEMK = 60 * MiB, WS_MEMV = WS_MEMK + MiB / 2, WS_KCMP = 61 * MiB, WS_VCMP = WS_KCMP + MiB / 2, WS_CMPH = 62 * MiB,
                 WS_KSLC = 66 * MiB, WS_VSLC = 74 * MiB, WS_KWIN = 82 * MiB, WS_VWIN = 90 * MiB, WS_H = 98 * MiB, WS_Y = 162 * MiB, WS_R1 = 258 * MiB, WS_CMPP = 484 * MiB  , WS_END = 492 * MiB;

typedef float f32x2_t __attribute__((ext_vector_type(2)));
typedef __bf16 bf16x2_t __attribute__((ext_vector_type(2)));
__device__ __forceinline__ unsigned cvt_pk_bf16(float lo, float hi) { f32x2_t v = {lo, hi}; bf16x2_t b = __builtin_convertvector(v, bf16x2_t); return __builtin_bit_cast(unsigned, b); }
__device__ __forceinline__ float bf_lo(unsigned u) { return __uint_as_float(u << 16); }
__device__ __forceinline__ float bf_hi(unsigned u) { return __uint_as_float(u & 0xffff0000u); }
__device__ __forceinline__ float bf1(bf16_t u) { return __uint_as_float(((unsigned)u) << 16); }
__device__ __forceinline__ float ex2(float x) { return __builtin_amdgcn_exp2f(x); }
__device__ __forceinline__ float rcpf_(float x) { return __builtin_amdgcn_rcpf(x); }
__device__ __forceinline__ float sigm(float x) { return rcpf_(1.f + ex2(-1.44269504f * x)); }
__device__ __forceinline__ float gelu_tanh(float x) { const float u = 0.7978845608f * (x + 0.044715f * x * x * x); return x * rcpf_(1.f + ex2(-2.88539008f * u)); }
#define DPP_F(v, ctrl) __int_as_float(__builtin_amdgcn_update_dpp(0, __float_as_int(v), ctrl, 0xF, 0xF, true))
__device__ __forceinline__ float wave_sum(float v) {
    v += DPP_F(v, 0xB1); v += DPP_F(v, 0x4E); v += DPP_F(v, 0x141); v += DPP_F(v, 0x140);
    { const auto r = __builtin_amdgcn_permlane16_swap(__float_as_uint(v), __float_as_uint(v), false, false); v = __uint_as_float(r[0]) + __uint_as_float(r[1]); }
    { const auto r = __builtin_amdgcn_permlane32_swap(__float_as_uint(v), __float_as_uint(v), false, false); v = __uint_as_float(r[0]) + __uint_as_float(r[1]); }
    return v;
}
__device__ __forceinline__ int pi32(int r) { return (r & 0x13) | ((r & 4) << 1) | ((r & 8) >> 1); }
#define LDS_WAIT() asm volatile("s_waitcnt lgkmcnt(0)" ::: "memory")

namespace pg8 {
constexpr int BM = 256, BK = 64, HALF = 128, HTB = HALF * BK * 2, STAGE_BYTES = 8 * HTB, NXCD = 8, WGM = 8;
__device__ __forceinline__ int lds_byte(int r, int c) { const int st = (r >> 4) * 2 + (c >> 5), rr = r & 15, cc = c & 31, ob = rr * 64 + cc * 2; return st * 1024 + (ob ^ (((ob >> 9) & 1) << 5)); }
__device__ __forceinline__ void stage_rc(int b, int& R, int& C) { const int st = b / 1024, sb = b % 1024, swz = sb ^ (((sb >> 9) & 1) << 5); R = (st >> 1) * 16 + swz / 64; C = (st & 1) * 32 + (swz % 64) / 2; }
__device__ __forceinline__ int perm32(int rho) { const int n = rho >> 4, i = rho & 15; return 8 * (i >> 2) + 4 * n + (i & 3); }

struct Unit { int pm, pn, tag; long long aoff, boff; };
struct GemmDesc { const char* A; const char* Bt; int lda, ldb, kstepA, kstepB, nt; };

__device__ __forceinline__ void swz_tile(int L, int nM, int nN, int& pm, int& pn) {
    const int nwg = nM * nN; int wgid = L;
    { const int q = nwg / NXCD, r = nwg % NXCD, xcd = wgid % NXCD, off = wgid / NXCD; wgid = (xcd < r ? xcd * (q + 1) : r * (q + 1) + (xcd - r) * q) + off; }
    const int nig = WGM * nN, gid = wgid / nig, fm = gid * WGM, gsz = (nM - fm) < WGM ? (nM - fm) : WGM;
    pm = fm + ((wgid % nig) % gsz); pn = (wgid % nig) / gsz;
}
struct StdOrder {
    int nM, nN, G, c; long long tA, tB;
    __device__ void init(int M, int N, int G_, int c_, int lda, int ldb) { nM = M / BM; nN = N / BM; G = G_; c = c_; tA = 512LL * lda; tB = 512LL * ldb; }
    __device__ bool next(int i, Unit& u) const {
        const long long L = (long long)i * G + c; if (L >= (long long)nM * nN) return false;
        swz_tile((int)L, nM, nN, u.pm, u.pn); u.tag = 0; u.aoff = u.pm * tA; u.boff = u.pn * tB; return true;
    }
};
struct MergeOrder {
    int nM, nN, G, c; long long tA, tB;
    __device__ void init(int M, int N, int G_, int c_, int lda, int ldb) { nM = M / BM; nN = N / BM; G = G_; c = c_; tA = 512LL * lda; tB = 512LL * ldb; }
    __device__ bool next(int i, Unit& u) const {
        const int ti = i / 3, br = i - 3 * ti; const long long L = (long long)ti * G + c; if (L >= (long long)nM * nN) return false;
        swz_tile((int)L, nM, nN, u.pm, u.pn); u.tag = br; u.aoff = u.pm * tA + br * 1024; u.boff = u.pn * tB + br * 1024; return true;
    }
};
struct CmpOrder {
    int c;
    __device__ bool next(int i, Unit& u) const {
        if (i != 0 || c >= 64) return false;
        const int ks = c >> 5, kv = (c >> 4) & 1, bg = (c >> 2) & 3, tile = c & 3, b = bg >> 1, g = bg & 1;
        u.pm = c; u.pn = 0; u.tag = kv;
        u.aoff = 2LL * (((long long)b * S_ + 4096LL * tile + 16LL * ks) * PP + PC_KV + kv * 128 + g * 64);
        u.boff = (long long)kv * (256 * 2048 * 2) + (long long)ks * (1024 * 2); return true;
    }
};

__device__ __forceinline__ u32x4 pack8(f32x4 a, f32x4 b) { u32x4 w; w.x = cvt_pk_bf16(a[0], a[1]); w.y = cvt_pk_bf16(a[2], a[3]); w.z = cvt_pk_bf16(b[0], b[1]); w.w = cvt_pk_bf16(b[2], b[3]); return w; }
template <int MODE> struct Epi {
    bf16_t* O; int ldc; const bf16_t* G; const float* bias;
    __device__ __forceinline__ void operator()(const f32x4 (&acc)[2][2][4][2], const Unit& u, int wr, int wc, int fr, int fq) const {
        const int row0 = u.pm * BM + wr * 64 + fr;
        if constexpr (MODE == 1) {
            const int col0 = u.pn * 128 + wc * 32 + 8 * fq;
#pragma unroll
            for (int ai = 0; ai < 2; ++ai)
#pragma unroll
                for (int m = 0; m < 4; ++m) {
                    bf16_t* rowp = O + (size_t)(row0 + ai * HALF + m * 16) * ldc + col0;
                    f32x4 v0, v1;
#pragma unroll
                    for (int e = 0; e < 4; ++e) { const float a0 = acc[ai][0][m][0][e], a1 = acc[ai][0][m][1][e]; v0[e] = a0 * sigm(a0) * acc[ai][1][m][0][e]; v1[e] = a1 * sigm(a1) * acc[ai][1][m][1][e]; }
                    *(u32x4*)rowp = pack8(v0, v1);
                    __builtin_amdgcn_sched_barrier(0);
                }
        } else if constexpr (MODE == 3) {
            const int col0 = u.pn * BM + wc * 32 + 8 * fq;
#pragma unroll
            for (int ai = 0; ai < 2; ++ai) {
                u32x4 gv[4][2], ov[4][2];
#pragma unroll
                for (int m = 0; m < 4; ++m)
#pragma unroll
                    for (int bj = 0; bj < 2; ++bj) { const size_t row = (size_t)(row0 + ai * HALF + m * 16); const int col = col0 + bj * HALF;
                        gv[m][bj] = *(const u32x4*)(G + row * GP + u.tag * 1024 + col);
                        ov[m][bj] = (u.tag > 0) ? *(const u32x4*)(O + row * ldc + col) : (u32x4){0u, 0u, 0u, 0u}; }
                __builtin_amdgcn_sched_barrier(0);
#pragma unroll
                for (int m = 0; m < 4; ++m)
#pragma unroll
                    for (int bj = 0; bj < 2; ++bj) { const size_t row = (size_t)(row0 + ai * HALF + m * 16); const int col = col0 + bj * HALF;
                        f32x4 v0 = acc[ai][bj][m][0], v1 = acc[ai][bj][m][1]; const u32x4 g4 = gv[m][bj], o4 = ov[m][bj];
                        v0[0] = v0[0] * bf_lo(g4.x) + bf_lo(o4.x); v0[1] = v0[1] * bf_hi(g4.x) + bf_hi(o4.x); v0[2] = v0[2] * bf_lo(g4.y) + bf_lo(o4.y); v0[3] = v0[3] * bf_hi(g4.y) + bf_hi(o4.y);
                        v1[0] = v1[0] * bf_lo(g4.z) + bf_lo(o4.z); v1[1] = v1[1] * bf_hi(g4.z) + bf_hi(o4.z); v1[2] = v1[2] * bf_lo(g4.w) + bf_lo(o4.w); v1[3] = v1[3] * bf_hi(g4.w) + bf_hi(o4.w);
                        *(u32x4*)(O + row * ldc + col) = pack8(v0, v1); }
            }
        } else {
            const int col0 = u.pn * BM + wc * 32 + 8 * fq;
#pragma unroll
            for (int ai = 0; ai < 2; ++ai)
#pragma unroll
                for (int m = 0; m < 4; ++m) {
                    const size_t row = (size_t)(row0 + ai * HALF + m * 16);
#pragma unroll
                    for (int bj = 0; bj < 2; ++bj) {
                        const int col = col0 + bj * HALF;
                        f32x4 v0 = acc[ai][bj][m][0], v1 = acc[ai][bj][m][1];
                        bf16_t* dst = O + row * ldc + col;
                        if constexpr (MODE == 2) {
#pragma unroll
                            for (int e = 0; e < 4; ++e) { v0[e] = sigm(v0[e]); v1[e] = sigm(v1[e]); }
                        }
                        if constexpr (MODE == 4) {
                            const f32x4 b0 = *(const f32x4*)(bias + u.tag * 256 + col), b1 = *(const f32x4*)(bias + u.tag * 256 + col + 4);
#pragma unroll
                            for (int e = 0; e < 4; ++e) { v0[e] = gelu_tanh(v0[e] + b0[e]); v1[e] = gelu_tanh(v1[e] + b1[e]); }
                        }
                        if constexpr (MODE == 3) {
                            const u32x4 gv = *(const u32x4*)(G + row * GP + u.tag * 1024 + col);
                            v0[0] *= bf_lo(gv.x); v0[1] *= bf_hi(gv.x); v0[2] *= bf_lo(gv.y); v0[3] *= bf_hi(gv.y);
                            v1[0] *= bf_lo(gv.z); v1[1] *= bf_hi(gv.z); v1[2] *= bf_lo(gv.w); v1[3] *= bf_hi(gv.w);
                            if (u.tag > 0) {
                                const u32x4 ov = *(const u32x4*)dst;
                                v0[0] += bf_lo(ov.x); v0[1] += bf_hi(ov.x); v0[2] += bf_lo(ov.y); v0[3] += bf_hi(ov.y);
                                v1[0] += bf_lo(ov.z); v1[1] += bf_hi(ov.z); v1[2] += bf_lo(ov.w); v1[3] += bf_hi(ov.w);
                            }
                        }
                        *(u32x4*)dst = pack8(v0, v1);
                    }
                }
        }
    }
};

template <class EpiT, class Sched>
__device__ __forceinline__ void gemm_phase(LAS unsigned char* lds, int tid_in, const GemmDesc g, const Sched& S, const EpiT& E) {
    int tid_ = tid_in; asm volatile("" : "+v"(tid_));
    const int tid = tid_, wid = __builtin_amdgcn_readfirstlane(tid >> 6), lane = tid & 63, wr = wid >> 2, wc = wid & 3, fr = lane & 15, fq = lane >> 4;
    const int nt = g.nt;
    unsigned voffA[2], voffB[2];
#pragma unroll
    for (int i = 0; i < 2; ++i) { int R, C; stage_rc(tid * 16 + i * 8192, R, C); const int Rb = (R & ~31) + perm32(R & 31);
        voffA[i] = (unsigned)(R * g.lda + C) * 2u; voffB[i] = (unsigned)(Rb * g.ldb + C) * 2u; }
    const size_t kA = (size_t)g.kstepA, kB = (size_t)g.kstepB;
    const size_t hA = (size_t)HALF * g.lda * 2, hB = (size_t)HALF * g.ldb * 2;
    const unsigned ldsw = (unsigned)wid * 1024u;
    const int aoff = lds_byte(wr * 64 + fr, fq * 8), boff = lds_byte(wc * 32 + fr, fq * 8);
#define PG8_SA(b, h) (((b) * 2 + (h)) * HTB)
#define PG8_SB(b, h) ((4 + (b) * 2 + (h)) * HTB)
#define PG8_STAGE(bufoff, gbase, voff) do { _Pragma("unroll") for (int _i = 0; _i < 2; ++_i) \
        __builtin_amdgcn_global_load_lds((const unsigned*)((const char*)(gbase) + (voff)[_i]), (LAS unsigned*)(lds + (bufoff) + ldsw + _i * 8192), 16, 0, 0); } while (0)
#define PG8_LDA(dst, b, h) do { _Pragma("unroll") for (int m = 0; m < 4; ++m) _Pragma("unroll") for (int k = 0; k < 2; ++k) dst[m][k] = *(const LAS bf16x8*)(lds + PG8_SA(b, h) + aoff + m * 2048 + k * 1024); } while (0)
#define PG8_LDB(dst, b, h) do { _Pragma("unroll") for (int n = 0; n < 2; ++n) _Pragma("unroll") for (int k = 0; k < 2; ++k) dst[n][k] = *(const LAS bf16x8*)(lds + PG8_SB(b, h) + boff + n * 2048 + k * 1024); } while (0)
#define PG8_MMA(ai, bj, At, Bt) do { __builtin_amdgcn_s_setprio(1); _Pragma("unroll") for (int m = 0; m < 4; ++m) _Pragma("unroll") for (int n = 0; n < 2; ++n) _Pragma("unroll") for (int k = 0; k < 2; ++k) \
        acc[ai][bj][m][n] = __builtin_amdgcn_mfma_f32_16x16x32_bf16(Bt[n][k], At[m][k], acc[ai][bj][m][n], 0, 0, 0); __builtin_amdgcn_s_setprio(0); } while (0)
#define PG8_WAIT_V(n) asm volatile("s_waitcnt vmcnt(" #n ")" ::: "memory")
#define PG8_WAIT_L(n) asm volatile("s_waitcnt lgkmcnt(" #n ")" ::: "memory")
#define PG8_BAR __builtin_amdgcn_s_barrier()
#define PG8_SCHED __builtin_amdgcn_sched_barrier(0)
    Unit cur, nxt; int ui = 0;
    if (!S.next(0, cur)) return;
    f32x4 acc[2][2][4][2];
#pragma unroll
    for (int a = 0; a < 2; ++a)
#pragma unroll
        for (int b = 0; b < 2; ++b)
#pragma unroll
            for (int m = 0; m < 4; ++m)
#pragma unroll
                for (int n = 0; n < 2; ++n) acc[a][b][m][n] = (f32x4){0.f, 0.f, 0.f, 0.f};
    bf16x8 At[4][2], B0[2][2], B1[2][2];
    const char* cA = g.A + cur.aoff; const char* cB = g.Bt + cur.boff;
    PG8_STAGE(PG8_SB(0, 0), cB, voffB); PG8_STAGE(PG8_SB(0, 1), cB + hB, voffB); PG8_STAGE(PG8_SA(0, 0), cA, voffA); PG8_STAGE(PG8_SA(0, 1), cA + hA, voffA);
    if (wr == 1) PG8_BAR;
    PG8_WAIT_V(2); PG8_BAR;
    PG8_STAGE(PG8_SB(1, 0), cB + kB, voffB); PG8_STAGE(PG8_SA(1, 0), cA + kA, voffA); PG8_STAGE(PG8_SB(1, 1), cB + hB + kB, voffB);
    PG8_WAIT_V(6); PG8_BAR;
    for (;;) {
        const bool has_next = S.next(ui + 1, nxt);
        const char* nA = has_next ? g.A + nxt.aoff : cA; const char* nB = has_next ? g.Bt + nxt.boff : cB;
        for (int t = 0; t < nt; t += 2) {
            const bool last = (t == nt - 2);
            const char* a1 = cA + (size_t)(t + 1) * kA;
            const char* a2 = last ? nA : cA + (size_t)(t + 2) * kA; const char* b2 = last ? nB : cB + (size_t)(t + 2) * kB;
            const char* a3 = a2 + kA; const char* b3 = b2 + kB;
            PG8_LDB(B0, 0, 0); PG8_LDB(B1, 0, 1); PG8_SCHED; PG8_LDA(At, 0, 0); PG8_STAGE(PG8_SA(1, 1), a1 + hA, voffA);
            PG8_WAIT_V(8); PG8_WAIT_L(0); PG8_BAR; PG8_MMA(0, 0, At, B0); PG8_MMA(0, 1, At, B1); PG8_BAR; PG8_SCHED;
            PG8_LDA(At, 0, 1); PG8_STAGE(PG8_SB(0, 0), b2, voffB); PG8_STAGE(PG8_SB(0, 1), b2 + hB, voffB); PG8_STAGE(PG8_SA(0, 0), a2, voffA);
            PG8_WAIT_V(8); PG8_WAIT_L(0); PG8_BAR; PG8_MMA(1, 0, At, B0); PG8_MMA(1, 1, At, B1); PG8_BAR; PG8_SCHED;
            PG8_LDB(B0, 1, 0); PG8_LDB(B1, 1, 1); PG8_SCHED; PG8_LDA(At, 1, 0); PG8_STAGE(PG8_SA(0, 1), a2 + hA, voffA);
            PG8_WAIT_V(8); PG8_WAIT_L(0); PG8_BAR; PG8_MMA(0, 0, At, B0); PG8_MMA(0, 1, At, B1); PG8_BAR; PG8_SCHED;
            PG8_LDA(At, 1, 1); PG8_STAGE(PG8_SB(1, 0), b3, voffB); PG8_STAGE(PG8_SB(1, 1), b3 + hB, voffB); PG8_STAGE(PG8_SA(1, 0), a3, voffA);
            PG8_WAIT_V(8); PG8_WAIT_L(0); PG8_BAR; PG8_MMA(1, 0, At, B0); PG8_MMA(1, 1, At, B1); PG8_BAR; PG8_SCHED;
        }
        if (wr == 0) PG8_BAR;
        E(acc, cur, wr, wc, fr, fq);
        if (!has_next) break;
#pragma unroll
        for (int a = 0; a < 2; ++a)
#pragma unroll
            for (int b = 0; b < 2; ++b)
#pragma unroll
                for (int m = 0; m < 4; ++m)
#pragma unroll
                    for (int n = 0; n < 2; ++n) acc[a][b][m][n] = (f32x4){0.f, 0.f, 0.f, 0.f};
        cur = nxt; cA = nA; cB = nB; ++ui;
        if (wr == 1) PG8_BAR;
    }
    PG8_WAIT_V(0);
    PG8_BAR;
#undef PG8_SA
#undef PG8_SB
#undef PG8_STAGE
#undef PG8_LDA
#undef PG8_LDB
#undef PG8_MMA
#undef PG8_WAIT_V
#undef PG8_WAIT_L
#undef PG8_BAR
#undef PG8_SCHED
}
}

struct Args { const void* in[29]; float* out; unsigned char* ws; int ph_lo, ph_hi; };
static_assert(sizeof(Args) == 29 * 8 + 8 + 8 + 8, "Args has no padding");

typedef __attribute__((address_space(1))) unsigned char gu8;
struct Ctx {
    const Args* a; gu8* ws; LAS unsigned char* lds; int tid, lane, wave, G, gw, NGW;
};
#define INF(k, l, n) ((const float*)C.a->in[k] + (size_t)(l) * (n))

__device__ __forceinline__ void tr_item(const float* W, int ldw, int src_col, int nvalid, int k0, bf16_t* WT, int ldt, int dst_row, int dst_k, LAS float* scr, int lane) {
#pragma unroll 8
    for (int i = 0; i < 32; ++i) { const int kk = 2 * i + (lane >> 5), c = lane & 31; scr[kk * 33 + c] = (c < nvalid) ? W[(size_t)(k0 + kk) * ldw + src_col + c] : 0.f; }
    LDS_WAIT();
    const int c = lane & 7;
#pragma unroll
    for (int j = 0; j < 4; ++j) { const int n = (lane >> 3) + 8 * j; const LAS float* s = scr + (8 * c) * 33 + n;
        u32x4 o; o.x = cvt_pk_bf16(s[0 * 33], s[1 * 33]); o.y = cvt_pk_bf16(s[2 * 33], s[3 * 33]); o.z = cvt_pk_bf16(s[4 * 33], s[5 * 33]); o.w = cvt_pk_bf16(s[6 * 33], s[7 * 33]);
        *(u32x4*)(WT + (size_t)(dst_row + n) * ldt + dst_k + k0 + 8 * c) = o; }
    LDS_WAIT();
}

__device__ __forceinline__ void convert_layer(const Ctx& C, int l) {
    LAS float* scr = (LAS float*)(C.lds + C.wave * 8448);
    gu8* ws = C.ws; const int lane = C.lane;
    constexpr int NITEMS = 2816 + 1408 + 1792 + 1536 + 768 + 512 + 2816 + 1408 + 256 + 256 + 512;
    for (int it = C.gw; it < NITEMS; it += C.NGW) {
        int r = it;
        if (r < 2816) { const int kb = r / 176, nb = r % 176, tile = nb >> 3, w = nb & 7, src = (w >> 2) * FF + tile * 128 + (w & 3) * 32;
            tr_item(INF(5, l, DM * 2 * FF), 2 * FF, src, 32, kb * 64, (bf16_t*)(ws + WS_W1IN), DM, nb * 32, 0, scr, lane); continue; } r -= 2816;
        if (r < 1408) { const int kb = r / 32, nb = r % 32;
            tr_item(INF(6, l, FF * DM), DM, nb * 32, 32, kb * 64, (bf16_t*)(ws + WS_W1OUT), FF, nb * 32, 0, scr, lane); continue; } r -= 1408;
        if (r < 1792) { const int kb = r / 112, nb = r % 112; int src = 0, nv = 0;
            if (nb < 88) { src = nb * 32; nv = 32; } else if (nb < 104) { src = 2840 + (nb - 88) * 32; nv = 32; } else if (nb == 104) { src = 2816; nv = 24; }
            tr_item(INF(10, l, DM * 6424), 6424, src, nv, kb * 64, (bf16_t*)(ws + WS_WMIX), DM, nb * 32, 0, scr, lane); continue; } r -= 1792;
        if (r < 1536) { const int kb = r / 96, nb = r % 96;
            tr_item(INF(10, l, DM * 6424), 6424, 3352 + nb * 32, 32, kb * 64, (bf16_t*)(ws + WS_WG), DM, nb * 32, 0, scr, lane); continue; } r -= 1536;
        if (r < 768) { const int br = r / 256, q = r % 256, kb = q / 32, nb = q % 32;
            const float* W = br == 0 ? INF(21, l, 512 * DM) : (br == 1 ? INF(22, l, 512 * DM) : INF(23, l, 512 * DM));
            tr_item(W, DM, nb * 32, 32, kb * 64, (bf16_t*)(ws + WS_WBR), YP, nb * 32, br * 512, scr, lane); continue; } r -= 768;
        if (r < 512) { const int kb = r / 32, nb = r % 32;
            tr_item(INF(24, l, DM * DM), DM, nb * 32, 32, kb * 64, (bf16_t*)(ws + WS_WOUT), DM, nb * 32, 0, scr, lane); continue; } r -= 512;
        if (r < 2816) { const int kb = r / 176, nb = r % 176, tile = nb >> 3, w = nb & 7, src = (w >> 2) * FF + tile * 128 + (w & 3) * 32;
            tr_item(INF(27, l, DM * 2 * FF), 2 * FF, src, 32, kb * 64, (bf16_t*)(ws + WS_W2IN), DM, nb * 32, 0, scr, lane); continue; } r -= 2816;
        if (r < 1408) { const int kb = r / 32, nb = r % 32;
            tr_item(INF(28, l, FF * DM), DM, nb * 32, 32, kb * 64, (bf16_t*)(ws + WS_W2OUT), FF, nb * 32, 0, scr, lane); continue; } r -= 1408;
        if (r < 256) { const int kb = r / 8, nb = r % 8;
            tr_item(INF(14, l, 2048 * 256), 256, nb * 32, 32, kb * 64, (bf16_t*)(ws + WS_WC1), 2048, nb * 32, 0, scr, lane); continue; } r -= 256;
        if (r < 256) { const int kb = r / 8, nb = r % 8;
            tr_item(INF(17, l, 2048 * 256), 256, nb * 32, 32, kb * 64, (bf16_t*)(ws + WS_WC1 + MiB), 2048, nb * 32, 0, scr, lane); continue; } r -= 256;
        { const int kb = r / 32, nb = r % 32;
            tr_item(INF(20, l, DM * DM), DM, nb * 32, 32, kb * 64, (bf16_t*)(ws + WS_WMKV), DM, nb * 32, 0, scr, lane); }
    }
    {
        const float* gm = INF(9, l, DM);
        for (int m = C.gw; m < 512; m += C.NGW) {
            const f32x4* xr = (const f32x4*)((const float*)C.a->in[1] + (size_t)m * DM) + lane;
            f32x4 v[4]; float s = 0.f;
#pragma unroll
            for (int j = 0; j < 4; ++j) { v[j] = xr[64 * j]; s += (v[j].x * v[j].x + v[j].y * v[j].y) + (v[j].z * v[j].z + v[j].w * v[j].w); }
            const float rstd = rsqrtf(wave_sum(s) * (1.f / DM) + EPS);
            u32x2* o = (u32x2*)((bf16_t*)(ws + WS_MEMN) + (size_t)m * DM) + lane;
#pragma unroll
            for (int j = 0; j < 4; ++j) { const f32x4 gg = ((const f32x4*)gm)[lane + 64 * j]; u32x2 w; w.x = cvt_pk_bf16(v[j].x * rstd * gg.x, v[j].y * rstd * gg.y); w.y = cvt_pk_bf16(v[j].z * rstd * gg.z, v[j].w * rstd * gg.w); o[64 * j] = w; }
        }
    }
    {
        float* cb = (float*)(ws + WS_CBP) + (size_t)l * 64 * 256;
        for (int it = C.gw; it < 64; it += C.NGW) {
            const int kv = it >> 5, ch = it & 31;
            const float* pos = kv ? INF(13, l, 2048) : INF(12, l, 2048);
            const float* w1 = kv ? INF(17, l, 2048 * 256) : INF(14, l, 2048 * 256);
            float p[4] = {0.f, 0.f, 0.f, 0.f};
            for (int k = ch * 64; k < ch * 64 + 64; ++k) { const float pv = pos[k];
#pragma unroll
                for (int q = 0; q < 4; ++q) p[q] += pv * w1[(size_t)k * 256 + lane + 64 * q]; }
#pragma unroll
            for (int q = 0; q < 4; ++q) cb[(size_t)it * 256 + lane + 64 * q] = p[q];
        }
    }
}

__device__ __forceinline__ void rope_table(const Ctx& C) {
    const int* pos = (const int*)C.a->in[2];
    float* tab = (float*)(C.ws + WS_ROPE);
    const float invf[8] = {1.0f, 0.1939227432012558f, 0.03760603070259094f, 0.007292664609849453f, 0.0014142135623842478f, 0.00027424818836152554f, 5.318296098266728e-05f, 1.0313386155758053e-05f};
    for (int e = C.gw * 64 + C.lane; e < T_ * 8; e += C.NGW * 64) {
        const int tok = e >> 3, i = e & 7;
        float f = invf[0];
#pragma unroll
        for (int q = 1; q < 8; ++q) f = (i == q) ? invf[q] : f;
        const float ang = (float)pos[tok] * f;
        const double rev = (double)ang * 0.15915494309189535; const float fr = (float)(rev - floor(rev));
        tab[(size_t)tok * 16 + i] = __builtin_amdgcn_cosf(fr); tab[(size_t)tok * 16 + 8 + i] = __builtin_amdgcn_sinf(fr);
    }
}
__device__ __forceinline__ void prenorm_rows(const Ctx& C, const float* x, const float* g, bf16_t* h) {
    for (int m = C.gw; m < T_; m += C.NGW) {
        const f32x4* xr = (const f32x4*)(x + (size_t)m * DM) + C.lane;
        f32x4 v[4]; float s = 0.f;
#pragma unroll
        for (int j = 0; j < 4; ++j) { v[j] = xr[64 * j]; s += (v[j].x * v[j].x + v[j].y * v[j].y) + (v[j].z * v[j].z + v[j].w * v[j].w); }
        const float rstd = rsqrtf(wave_sum(s) * (1.f / DM) + EPS);
        u32x2* o = (u32x2*)(h + (size_t)m * DM) + C.lane;
#pragma unroll
        for (int j = 0; j < 4; ++j) { const f32x4 gg = ((const f32x4*)g)[C.lane + 64 * j]; u32x2 w; w.x = cvt_pk_bf16(v[j].x * rstd * gg.x, v[j].y * rstd * gg.y); w.y = cvt_pk_bf16(v[j].z * rstd * gg.z, v[j].w * rstd * gg.w); o[64 * j] = w; }
    }
}
__device__ __forceinline__ void norm_phase(const Ctx& C, int w0, int nw, const float* xin, float* xout, const bf16_t* y, bf16_t* h, const float* gpost, const float* gpre, float coef) {
    for (int m0 = w0; m0 < T_; m0 += 2 * nw) {
        f32x4 xv[2][4]; u32x2 yw[2][4];
#pragma unroll
        for (int r = 0; r < 2; ++r) { const int m = (m0 + r * nw < T_) ? m0 + r * nw : m0; const f32x4* xr = (const f32x4*)(xin + (size_t)m * DM) + C.lane; const u32x2* yr = (const u32x2*)(y + (size_t)m * DM) + C.lane;
#pragma unroll
            for (int j = 0; j < 4; ++j) { xv[r][j] = xr[64 * j]; yw[r][j] = yr[64 * j]; } }
#pragma unroll
        for (int r = 0; r < 2; ++r) {
            const int m = m0 + r * nw; if (m >= T_) break;
            f32x4 yv[4]; float s = 0.f;
#pragma unroll
            for (int j = 0; j < 4; ++j) { const u32x2 w = yw[r][j]; yv[j] = (f32x4){bf_lo(w.x), bf_hi(w.x), bf_lo(w.y), bf_hi(w.y)};
                s += (yv[j].x * yv[j].x + yv[j].y * yv[j].y) + (yv[j].z * yv[j].z + yv[j].w * yv[j].w); }
            const float rs = rsqrtf(wave_sum(s) * (1.f / DM) + EPS) * coef; float s2 = 0.f;
            f32x4* xo = (f32x4*)(xout + (size_t)m * DM) + C.lane;
#pragma unroll
            for (int j = 0; j < 4; ++j) { const f32x4 gg = ((const f32x4*)gpost)[C.lane + 64 * j]; xv[r][j] = xv[r][j] + yv[j] * gg * rs; xo[64 * j] = xv[r][j];
                s2 += (xv[r][j].x * xv[r][j].x + xv[r][j].y * xv[r][j].y) + (xv[r][j].z * xv[r][j].z + xv[r][j].w * xv[r][j].w); }
            if (gpre) {
                const float r2 = rsqrtf(wave_sum(s2) * (1.f / DM) + EPS);
                u32x2* o = (u32x2*)(h + (size_t)m * DM) + C.lane;
#pragma unroll
                for (int j = 0; j < 4; ++j) { const f32x4 gg = ((const f32x4*)gpre)[C.lane + 64 * j]; u32x2 w; w.x = cvt_pk_bf16(xv[r][j].x * r2 * gg.x, xv[r][j].y * r2 * gg.y); w.y = cvt_pk_bf16(xv[r][j].z * r2 * gg.z, xv[r][j].w * r2 * gg.w); o[64 * j] = w; }
            }
        }
    }
}
__device__ __forceinline__ void cb_reduce(const Ctx& C, int l) {
    const int e = C.gw * 64 + C.lane;
    if (e < 512) { const int kv = e >> 8, n = e & 255; const float* pp = (const float*)(C.ws + WS_CBP) + (size_t)l * 64 * 256 + (size_t)kv * 32 * 256 + n;
        float s = (kv ? INF(18, l, 256) : INF(15, l, 256))[n];
        for (int ch = 0; ch < 32; ++ch) s += pp[ch * 256];
        ((float*)(C.ws + WS_CB))[l * 512 + e] = s; }
}
__device__ __forceinline__ void memkv_ops(const Ctx& C, int w0, int nw) {
    const bf16_t* src = (const bf16_t*)(C.ws + WS_MKV); bf16_t* ko = (bf16_t*)(C.ws + WS_MEMK); bf16_t* vo = (bf16_t*)(C.ws + WS_MEMV);
    for (int e = w0 * 64 + C.lane; e < 512 * 1024; e += nw * 64) {
        const int mr = e >> 10, col = e & 1023, kv = col >> 9, hm = (col >> 7) & 3, d = col & 127, b = mr >> 8, m = mr & 255;
        const bf16_t v = src[e];
        if (kv == 0) ko[((size_t)((((b * 4 + hm) * 8 + (m >> 5)) * 8 + (d >> 4)) * 64 + pi32(m & 31) + 32 * ((d >> 3) & 1))) * 8 + (d & 7)] = v;
        else vo[((size_t)((((b * 4 + hm) * 16 + (m >> 4)) * 4 + (d >> 5)) * 64 + (d & 31) + 32 * ((m >> 3) & 1))) * 8 + (m & 7)] = v;
    }
}

__device__ __forceinline__ void prep_items(const Ctx& C, int l, int w0, int nw) {
    const bf16_t* P = (const bf16_t*)(C.ws + WS_R1); bf16_t* Y = (bf16_t*)(C.ws + WS_Y);
    const int lane = C.lane;
    {
        const float* cw = INF(11, l, 3 * 512);
        float w[3][8];
#pragma unroll
        for (int k = 0; k < 3; ++k)
#pragma unroll
            for (int e = 0; e < 8; ++e) w[k][e] = cw[k * 512 + lane * 8 + e];
        for (int it = w0; it < T_ / 8; it += nw) {
            const int tok0 = it * 8, s0 = tok0 & (S_ - 1);
            float c1[8], c2[8];
#pragma unroll
            for (int e = 0; e < 8; ++e) { c1[e] = 0.f; c2[e] = 0.f; }
            if (s0 > 0) {
#pragma unroll
                for (int back = 2; back >= 1; --back) {
                    const bf16_t* row = P + (size_t)(tok0 - back) * PP + lane * 8;
                    const u32x4 u = *(const u32x4*)row, cc = *(const u32x4*)(row + 1024);
                    float t[8] = {bf_lo(u.x) * bf_lo(cc.x), bf_hi(u.x) * bf_hi(cc.x), bf_lo(u.y) * bf_lo(cc.y), bf_hi(u.y) * bf_hi(cc.y), bf_lo(u.z) * bf_lo(cc.z), bf_hi(u.z) * bf_hi(cc.z), bf_lo(u.w) * bf_lo(cc.w), bf_hi(u.w) * bf_hi(cc.w)};
#pragma unroll
                    for (int e = 0; e < 8; ++e) { if (back == 2) c2[e] = t[e]; else c1[e] = t[e]; }
                }
            }
#pragma unroll
            for (int tt = 0; tt < 8; ++tt) {
                const bf16_t* row = P + (size_t)(tok0 + tt) * PP + lane * 8;
                const u32x4 u = *(const u32x4*)row, bb = *(const u32x4*)(row + 512), cc = *(const u32x4*)(row + 1024);
                const float c0[8] = {bf_lo(u.x) * bf_lo(cc.x), bf_hi(u.x) * bf_hi(cc.x), bf_lo(u.y) * bf_lo(cc.y), bf_hi(u.y) * bf_hi(cc.y), bf_lo(u.z) * bf_lo(cc.z), bf_hi(u.z) * bf_hi(cc.z), bf_lo(u.w) * bf_lo(cc.w), bf_hi(u.w) * bf_hi(cc.w)};
                const float bv[8] = {bf_lo(bb.x), bf_hi(bb.x), bf_lo(bb.y), bf_hi(bb.y), bf_lo(bb.z), bf_hi(bb.z), bf_lo(bb.w), bf_hi(bb.w)};
                float o[8];
#pragma unroll
                for (int e = 0; e < 8; ++e) { o[e] = bv[e] * (w[0][e] * c2[e] + w[1][e] * c1[e] + w[2][e] * c0[e]); c2[e] = c1[e]; c1[e] = c0[e]; }
                u32x4 ov; ov.x = cvt_pk_bf16(o[0], o[1]); ov.y = cvt_pk_bf16(o[2], o[3]); ov.z = cvt_pk_bf16(o[4], o[5]); ov.w = cvt_pk_bf16(o[6], o[7]);
                *(u32x4*)(Y + (size_t)(tok0 + tt) * YP + lane * 8) = ov;
            }
        }
    }
    {
        const float* rope = (const float*)(C.ws + WS_ROPE);
        LAS bf16_t* vt = (LAS bf16_t*)(C.lds + C.wave * 4608);
        const int hi = lane >> 5, dl = lane & 31;
        for (int it = w0; it < 4 * 512; it += nw) {
            const int bg = it >> 9, tile = it & 511, b = bg >> 1, g = bg & 1;
            const size_t tokb = (size_t)b * S_ + 32 * tile;
#pragma unroll
            for (int which = 0; which < 2; ++which) {
                const int kc = PC_KV + (2 + 2 * which) * 128 + g * 64, vc = kc + 128;
                bf16_t* kop = (bf16_t*)(C.ws + (which ? WS_KWIN : WS_KSLC)); bf16_t* vop = (bf16_t*)(C.ws + (which ? WS_VWIN : WS_VSLC));
#pragma unroll
                for (int q = 0; q < 4; ++q) {
                    const int r = (lane >> 3) + 8 * q, c = lane & 7;
                    const bf16_t* row = P + (tokb + r) * PP;
                    u32x4 kv = *(const u32x4*)(row + kc + 8 * c);
                    if (c < 2) {
                        const u32x4 pv = *(const u32x4*)(row + kc + 8 * (c ^ 1));
                        const float* rt = rope + (tokb + r) * 16;
                        const f32x4 ca = *(const f32x4*)rt, cb2 = *(const f32x4*)(rt + 4), sa = *(const f32x4*)(rt + 8), sb = *(const f32x4*)(rt + 12);
                        const float cs[8] = {ca.x, ca.y, ca.z, ca.w, cb2.x, cb2.y, cb2.z, cb2.w}, sn[8] = {sa.x, sa.y, sa.z, sa.w, sb.x, sb.y, sb.z, sb.w};
                        const float mv[8] = {bf_lo(kv.x), bf_hi(kv.x), bf_lo(kv.y), bf_hi(kv.y), bf_lo(kv.z), bf_hi(kv.z), bf_lo(kv.w), bf_hi(kv.w)};
                        const float pp[8] = {bf_lo(pv.x), bf_hi(pv.x), bf_lo(pv.y), bf_hi(pv.y), bf_lo(pv.z), bf_hi(pv.z), bf_lo(pv.w), bf_hi(pv.w)};
                        const float sg = (c == 0) ? -1.f : 1.f; float o[8];
#pragma unroll
                        for (int e = 0; e < 8; ++e) o[e] = mv[e] * cs[e] + sg * pp[e] * sn[e];
                        kv.x = cvt_pk_bf16(o[0], o[1]); kv.y = cvt_pk_bf16(o[2], o[3]); kv.z = cvt_pk_bf16(o[4], o[5]); kv.w = cvt_pk_bf16(o[6], o[7]);
                    }
                    if (which == 0)
                        *(u32x4*)(kop + ((size_t)(((bg * 512 + tile) * 2 + ((r >> 2) & 1)) * 2 + (c >> 2)) * 64 + ((r >> 3) * 4 + (r & 3)) + 16 * (c & 3)) * 8) = kv;
                    else
                        *(u32x4*)(kop + ((size_t)((bg * 512 + tile) * 4 + (c >> 1)) * 64 + pi32(r) + 32 * (c & 1)) * 8) = kv;
                    const u32x4 vv = *(const u32x4*)(row + vc + 8 * c);
                    *(LAS u32x4*)(vt + r * 72 + 8 * c) = vv;
                }
                LDS_WAIT();
#pragma unroll
                for (int o4 = 0; o4 < 4; ++o4) {
                    if (which == 0) {
                        const LAS bf16_t* sp = vt + (8 * (lane >> 4)) * 72 + 16 * o4 + (lane & 15);
                        u32x4 o; o.x = (unsigned)sp[0] | ((unsigned)sp[72] << 16); o.y = (unsigned)sp[144] | ((unsigned)sp[216] << 16); o.z = (unsigned)sp[288] | ((unsigned)sp[360] << 16); o.w = (unsigned)sp[432] | ((unsigned)sp[504] << 16);
                        *(u32x4*)(vop + ((size_t)((bg * 512 + tile) * 4 + o4) * 64 + lane) * 8) = o;
                        continue;
                    }
                    const int ks = o4 >> 1, dt = o4 & 1;
                    const LAS bf16_t* sp = vt + (16 * ks + 8 * hi) * 72 + 32 * dt + dl;
                    u32x4 o; o.x = (unsigned)sp[0] | ((unsigned)sp[72] << 16); o.y = (unsigned)sp[144] | ((unsigned)sp[216] << 16); o.z = (unsigned)sp[288] | ((unsigned)sp[360] << 16); o.w = (unsigned)sp[432] | ((unsigned)sp[504] << 16);
                    *(u32x4*)(vop + ((size_t)((bg * 1024 + 2 * tile + ks) * 2 + dt) * 64 + lane) * 8) = o;
                }
                LDS_WAIT();
            }
        }
    }
}

__device__ __forceinline__ void cmp_stage2(const Ctx& C, int l) {
    const int bxx = C.gw / NWAVES, kv = bxx & 1, wi = bxx >> 1, nwg2 = (C.G + 1 - kv) >> 1;
    const float* w2 = kv ? INF(19, l, 256 * 64) : INF(16, l, 256 * 64);
    LAS float* ws2 = (LAS float*)C.lds;
    for (int e = C.tid; e < 256 * 64 / 4; e += NWAVES * 64) ((LAS f32x4*)ws2)[e] = ((const f32x4*)w2)[e];
    __syncthreads();
    const bf16_t* hid = (const bf16_t*)(C.ws + WS_CMPP) + (size_t)kv * 4096 * 256;
    const float* cbias = (const float*)(C.ws + WS_CB) + l * 512 + kv * 256;
    bf16_t* ko = (bf16_t*)(C.ws + WS_KCMP); bf16_t* vo = (bf16_t*)(C.ws + WS_VCMP);
    const int d = C.lane;
    for (int row = wi * NWAVES + C.wave; row < 4096; row += nwg2 * NWAVES) {
        asm volatile("" ::: "memory");
        const u32x2 hv = *((const u32x2*)(hid + (size_t)row * 256) + C.lane), hw = *((const u32x2*)(hid + (size_t)(row + 8192) * 256) + C.lane);
        const f32x4 cbv = *((const f32x4*)cbias + C.lane);
        const float h0 = gelu_tanh(bf_lo(hv.x) + bf_lo(hw.x) + cbv.x), h1 = gelu_tanh(bf_hi(hv.x) + bf_hi(hw.x) + cbv.y), h2 = gelu_tanh(bf_lo(hv.y) + bf_lo(hw.y) + cbv.z), h3 = gelu_tanh(bf_hi(hv.y) + bf_hi(hw.y) + cbv.w);
        float acc = 0.f;
#pragma unroll 4
        for (int k = 0; k < 64; ++k) {
            const float a0 = __int_as_float(__builtin_amdgcn_readlane(__float_as_int(h0), k)), a1 = __int_as_float(__builtin_amdgcn_readlane(__float_as_int(h1), k));
            const float a2 = __int_as_float(__builtin_amdgcn_readlane(__float_as_int(h2), k)), a3 = __int_as_float(__builtin_amdgcn_readlane(__float_as_int(h3), k));
            acc += a0 * ws2[(4 * k + 0) * 64 + d]; acc += a1 * ws2[(4 * k + 1) * 64 + d]; acc += a2 * ws2[(4 * k + 2) * 64 + d]; acc += a3 * ws2[(4 * k + 3) * 64 + d];
        }
        const int bg = row >> 10, n = row & 1023;
        if (n == 1023) acc = 0.f;
        const bf16_t o = (bf16_t)(cvt_pk_bf16(acc, 0.f) & 0xffffu);
        if (kv == 0) ko[((size_t)((bg * 32 + (n >> 5)) * 4 + (d >> 4)) * 64 + pi32(n & 31) + 32 * ((d >> 3) & 1)) * 8 + (d & 7)] = o;
        else vo[((size_t)((bg * 64 + (n >> 4)) * 2 + (d >> 5)) * 64 + (d & 31) + 32 * ((n >> 3) & 1)) * 8 + (n & 7)] = o;
    }
    __syncthreads();
}

__device__ __forceinline__ float xhalf_max(float v) { const auto r = __builtin_amdgcn_permlane32_swap(__float_as_uint(v), __float_as_uint(v), false, false); return fmaxf(__uint_as_float(r[0]), __uint_as_float(r[1])); }
__device__ __forceinline__ float xhalf_sum(float v) { const auto r = __builtin_amdgcn_permlane32_swap(__float_as_uint(v), __float_as_uint(v), false, false); return __uint_as_float(r[0]) + __uint_as_float(r[1]); }
__device__ __forceinline__ f32x16 mfma32(bf16x8 a, bf16x8 b, f32x16 c) { return __builtin_amdgcn_mfma_f32_32x32x16_bf16(a, b, c, 0, 0, 0); }
__device__ __forceinline__ float dpp_xor1(float v) { return __int_as_float(__builtin_amdgcn_update_dpp(0, __float_as_int(v), 0xB1, 0xF, 0xF, true)); }
__device__ __forceinline__ float dpp_xor2(float v) { return __int_as_float(__builtin_amdgcn_update_dpp(0, __float_as_int(v), 0x4E, 0xF, 0xF, true)); }
__device__ __forceinline__ bf16x8 pack_p(const float* p) { u32x4 w; w.x = cvt_pk_bf16(p[0], p[1]); w.y = cvt_pk_bf16(p[2], p[3]); w.z = cvt_pk_bf16(p[4], p[5]); w.w = cvt_pk_bf16(p[6], p[7]); return __builtin_bit_cast(bf16x8, w); }
__device__ __forceinline__ bf16x8 scale_q(u32x4 v, float s) { u32x4 w; w.x = cvt_pk_bf16(bf_lo(v.x) * s, bf_hi(v.x) * s); w.y = cvt_pk_bf16(bf_lo(v.y) * s, bf_hi(v.y) * s); w.z = cvt_pk_bf16(bf_lo(v.z) * s, bf_hi(v.z) * s); w.w = cvt_pk_bf16(bf_lo(v.w) * s, bf_hi(v.w) * s); return __builtin_bit_cast(bf16x8, w); }
constexpr float SM_THR = 8.0f;
#define KREL(i, hi) (8 * (hi) + (i) + (((i) >= 8) ? 8 : 0))

__device__ __forceinline__ void flash_load(const bf16x8* kp, const bf16x8* vp, bf16x8 (&kf)[4], bf16x8 (&vf)[4]) {
#pragma unroll
    for (int s = 0; s < 4; ++s) kf[s] = kp[s * 64];
#pragma unroll
    for (int s = 0; s < 4; ++s) vf[s] = vp[s * 64];
    __builtin_amdgcn_sched_barrier(0);
}
__device__ __forceinline__ void flash_compute(bool domask, const bf16x8 (&kf)[4], const bf16x8 (&vf)[4], const bf16x8 (&q)[4], int x0, unsigned span, float& m, float& l, f32x16 (&O)[2]) {
    f32x16 sc;
#pragma unroll
    for (int i = 0; i < 16; ++i) sc[i] = 0.f;
#pragma unroll
    for (int s = 0; s < 4; ++s) sc = mfma32(kf[s], q[s], sc);
    if (domask) {
#pragma unroll
        for (int i = 0; i < 16; ++i) sc[i] = ((unsigned)(x0 + i + (i >= 8 ? 8 : 0)) <= span) ? sc[i] : -1e30f;
    }
    const float a0 = fmaxf(fmaxf(sc[0], sc[1]), sc[2]), a1 = fmaxf(fmaxf(sc[3], sc[4]), sc[5]), a2 = fmaxf(fmaxf(sc[6], sc[7]), sc[8]), a3 = fmaxf(fmaxf(sc[9], sc[10]), sc[11]), a4 = fmaxf(fmaxf(sc[12], sc[13]), sc[14]);
    float mx = fmaxf(fmaxf(fmaxf(a0, a1), fmaxf(a2, a3)), fmaxf(a4, sc[15]));
    mx = xhalf_max(mx);
    const bool upd = mx > m + SM_THR;
    if (__ballot(upd) != 0ull) {
        const float mn = upd ? mx : m, alpha = ex2(m - mn); l *= alpha; O[0] = O[0] * alpha; O[1] = O[1] * alpha; m = mn;
    }
    const float msub = (m < -1e29f) ? 0.f : m;
    const f32x16 d = sc - msub;
    float p[16], ps = 0.f;
#pragma unroll
    for (int i = 0; i < 16; ++i) { p[i] = ex2(d[i]); ps += p[i]; }
    l += ps;
    const bf16x8 pb0 = pack_p(p), pb1 = pack_p(p + 8);
    O[0] = mfma32(vf[0], pb0, O[0]); O[1] = mfma32(vf[1], pb0, O[1]);
    O[0] = mfma32(vf[2], pb1, O[0]); O[1] = mfma32(vf[3], pb1, O[1]);
}
template <int MODE> __device__ __forceinline__ void flash_desc(int s, const LAS unsigned* list, int base, int t, int t0, int qi, int hi, int& tile, int& x0, unsigned& span, int& vm) {
    if constexpr (MODE == 0) {
        const unsigned e = (unsigned)__builtin_amdgcn_readfirstlane((int)list[s >> 1]);
        tile = 2 * (int)(e & 0xffffu) + (s & 1);
        const bool my = ((e >> 16) >> qi) & 1u; const int up = my ? (t - 32 * tile) : -1;
        x0 = up < 0 ? 64 : 8 * hi; span = up < 0 ? 0u : (unsigned)up;
        vm = (32 * tile + 31 <= t0) ? (((e >> 16) == 0xFFu) ? 0 : 1) : 2;
    } else {
        tile = base + s; x0 = 8 * hi - (t - 511 - 32 * tile); span = 511u;
        vm = (32 * tile + 31 <= t0 && 32 * tile >= t0 + 7 - 511) ? 0 : 2;
    }
}
template <int MODE> __device__ __forceinline__ void flash_run(const bf16x8* kb, const bf16x8* vb, const bf16x8 (&q)[4], int nsteps, const LAS unsigned* list, int base, int t, int t0, int qi, int hi, float& m, float& l, f32x16 (&O)[2]) {
    if (nsteps <= 0) return;
    bf16x8 kA[4], vA[4], kB[4], vB[4], kC[4], vC[4]; int x0A, x0B, x0C, vmA, vmB, vmC; unsigned spA, spB, spC;
#define FR_LOAD(S, KF, VF, X0, SP, VM) do { int tile_; const int sn_ = ((S) < nsteps) ? (S) : nsteps - 1; flash_desc<MODE>(sn_, list, base, t, t0, qi, hi, tile_, X0, SP, VM); \
        flash_load(kb + (size_t)tile_ * 256, vb + (size_t)tile_ * 256, KF, VF); } while (0)
    FR_LOAD(0, kA, vA, x0A, spA, vmA); FR_LOAD(1, kB, vB, x0B, spB, vmB);
#pragma unroll 1
    for (int s = 0; s < nsteps; s += 3) {
        FR_LOAD(s + 2, kC, vC, x0C, spC, vmC); flash_compute(vmA != 0, kA, vA, q, x0A, spA, m, l, O); if (s + 1 >= nsteps) break;
        FR_LOAD(s + 3, kA, vA, x0A, spA, vmA); flash_compute(vmB != 0, kB, vB, q, x0B, spB, m, l, O); if (s + 2 >= nsteps) break;
        FR_LOAD(s + 4, kB, vB, x0B, spB, vmB); flash_compute(vmC != 0, kC, vC, q, x0C, spC, m, l, O);
    }
#undef FR_LOAD
}

typedef float f32x4v __attribute__((ext_vector_type(4)));
__device__ __forceinline__ f32x4v mfma16(bf16x8 a, bf16x8 b, f32x4v c) { return __builtin_amdgcn_mfma_f32_16x16x32_bf16(a, b, c, 0, 0, 0); }
__device__ __forceinline__ float xq_max(float v) { const auto r = __builtin_amdgcn_permlane16_swap(__float_as_uint(v), __float_as_uint(v), false, false); return xhalf_max(fmaxf(__uint_as_float(r[0]), __uint_as_float(r[1]))); }
__device__ __forceinline__ float xq_sum(float v) { const auto r = __builtin_amdgcn_permlane16_swap(__float_as_uint(v), __float_as_uint(v), false, false); return xhalf_sum(__uint_as_float(r[0]) + __uint_as_float(r[1])); }
__device__ __forceinline__ void flash16_load(const bf16x8* kp, const bf16x8* vp, bf16x8 (&kf)[4], bf16x8 (&vf)[4]) {
#pragma unroll
    for (int s = 0; s < 4; ++s) kf[s] = kp[s * 64];
#pragma unroll
    for (int s = 0; s < 4; ++s) vf[s] = vp[s * 64];
    __builtin_amdgcn_sched_barrier(0);
}
__device__ __forceinline__ void flash16_compute(bool domask, const bf16x8 (&kf)[4], const bf16x8 (&vf)[4], const bf16x8 (&q)[2], int x0, unsigned span, float& m, float& l, f32x4v (&O)[4]) {
    f32x4v s0 = {0.f, 0.f, 0.f, 0.f}, s1 = {0.f, 0.f, 0.f, 0.f};
    s0 = mfma16(kf[0], q[0], s0); s1 = mfma16(kf[2], q[0], s1);
    s0 = mfma16(kf[1], q[1], s0); s1 = mfma16(kf[3], q[1], s1);
    float sc[8] = {s0[0], s0[1], s0[2], s0[3], s1[0], s1[1], s1[2], s1[3]};
    if (domask) {
#pragma unroll
        for (int j = 0; j < 8; ++j) sc[j] = ((unsigned)(x0 + j) <= span) ? sc[j] : -1e30f;
    }
    float mx = fmaxf(fmaxf(fmaxf(sc[0], sc[1]), fmaxf(sc[2], sc[3])), fmaxf(fmaxf(sc[4], sc[5]), fmaxf(sc[6], sc[7])));
    mx = xq_max(mx);
    const bool upd = mx > m + SM_THR;
    if (__ballot(upd) != 0ull) {
        const float mn = upd ? mx : m, alpha = ex2(m - mn); l *= alpha;
#pragma unroll
        for (int dt = 0; dt < 4; ++dt) O[dt] = O[dt] * alpha;
        m = mn;
    }
    const float msub = (m < -1e29f) ? 0.f : m;
    float p[8], ps = 0.f;
#pragma unroll
    for (int j = 0; j < 8; ++j) { p[j] = ex2(sc[j] - msub); ps += p[j]; }
    l += ps;
    const bf16x8 pb = pack_p(p);
#pragma unroll
    for (int dt = 0; dt < 4; ++dt) O[dt] = mfma16(vf[dt], pb, O[dt]);
}
__device__ __forceinline__ unsigned flash16_entry(int s, const LAS unsigned* list) {
    const unsigned e = (unsigned)__builtin_amdgcn_readfirstlane((int)list[s >> 1]);
    return (e & 0xffff0000u) | (2u * (e & 0xffffu) + (unsigned)(s & 1));
}
__device__ __forceinline__ void flash16_run(const bf16x8* kb, const bf16x8* vb, const bf16x8 (&qa)[2], const bf16x8 (&qb)[2], int nsteps, const LAS unsigned* list, int tq, int t0, int qi4, int fq,
                                            float& ma, float& la, f32x4v (&Oa)[4], float& mb, float& lb, f32x4v (&Ob)[4]) {
    if (nsteps <= 0) return;
    bf16x8 kA[4], vA[4], kB[4], vB[4], kC[4], vC[4]; unsigned eA, eB, eC;
#define F16_LOAD(S, KF, VF, E) do { const int sn_ = ((S) < nsteps) ? (S) : nsteps - 1; E = flash16_entry(sn_, list); const size_t go_ = (size_t)(E & 0xffffu) * 256; \
        flash16_load(kb + go_, vb + go_, KF, VF); } while (0)
#define F16_COMP(KF, VF, E) do { const int grp_ = (int)(E & 0xffffu); const unsigned na_ = (E >> 16) & 0xFu, nb_ = E >> 20; const bool past_ = 32 * grp_ + 31 <= t0; \
        if (na_) { const int up_ = ((na_ >> qi4) & 1u) ? (tq - 32 * grp_) : -1; flash16_compute(!(past_ && na_ == 0xFu), KF, VF, qa, up_ < 0 ? 64 : 8 * fq, up_ < 0 ? 0u : (unsigned)up_, ma, la, Oa); } \
        if (nb_) { const int up_ = ((nb_ >> qi4) & 1u) ? (tq + 4 - 32 * grp_) : -1; flash16_compute(!(past_ && nb_ == 0xFu), KF, VF, qb, up_ < 0 ? 64 : 8 * fq, up_ < 0 ? 0u : (unsigned)up_, mb, lb, Ob); } } while (0)
    F16_LOAD(0, kA, vA, eA); F16_LOAD(1, kB, vB, eB);
#pragma unroll 1
    for (int s = 0; s < nsteps; s += 3) {
        F16_LOAD(s + 2, kC, vC, eC); F16_COMP(kA, vA, eA); if (s + 1 >= nsteps) break;
        F16_LOAD(s + 3, kA, vA, eA); F16_COMP(kB, vB, eB); if (s + 2 >= nsteps) break;
        F16_LOAD(s + 4, kB, vB, eB); F16_COMP(kC, vC, eC);
    }
#undef F16_LOAD
#undef F16_COMP
}

__device__ __forceinline__ unsigned wave_max_u32(unsigned v) {
#define DPP_U(v, ctrl) ((unsigned)__builtin_amdgcn_update_dpp(0, (int)(v), ctrl, 0xF, 0xF, true))
    { unsigned t = DPP_U(v, 0xB1); v = v > t ? v : t; t = DPP_U(v, 0x4E); v = v > t ? v : t; t = DPP_U(v, 0x141); v = v > t ? v : t; t = DPP_U(v, 0x140); v = v > t ? v : t; }
#undef DPP_U
    { const auto r = __builtin_amdgcn_permlane16_swap(v, v, false, false); v = r[0] > r[1] ? r[0] : r[1]; }
    { const auto r = __builtin_amdgcn_permlane32_swap(v, v, false, false); v = r[0] > r[1] ? r[0] : r[1]; }
    return v;
}

__device__ __forceinline__ void nsa_tile(const Ctx& C, int b, int g, int t0) {
    const bf16_t* P = (const bf16_t*)(C.ws + WS_R1); bf16_t* Y = (bf16_t*)(C.ws + WS_Y);
    int lane_ = C.lane; asm volatile("" : "+v"(lane_));
    const int lane = lane_, r = lane & 31, hi = lane >> 5, qi = r >> 2, h = r & 3, head = g * 4 + h, bg = b * 2 + g;
    const int t = t0 + qi; const size_t tok = (size_t)b * S_ + t;
    LAS float* imp = (LAS float*)(C.lds + C.wave * 16640);
    LAS float* ost = (LAS float*)(C.lds + C.wave * 16640 + 8448) + lane;
    const float QS = 0.18033688011112042f;
    bf16x8 qf[4];
    {
        const bf16_t* qp = P + tok * PP + PC_Q + head * 64;
#pragma unroll
        for (int s = 0; s < 4; ++s) qf[s] = scale_q(*(const u32x4*)(qp + 16 * s + 8 * hi), QS);
    }
    const bf16_t* gp = P + tok * PP + PC_NG + head * 3;
    const float gc = sigm(bf1(gp[0])), gs = sigm(bf1(gp[1])), gw = sigm(bf1(gp[2]));

    const int cur = t0 >> 6;
    {
        const int nvq = (t >= 31) ? ((t - 31) >> 4) + 1 : 0;
        const int nvmin = (t0 >= 31) ? ((t0 - 31) >> 4) + 1 : 0;
        const int tl = t0 + 7, nvmax = (tl >= 31) ? ((tl - 31) >> 4) + 1 : 0, ntile = (nvmax + 31) >> 5;
        const bf16x8* kb = (const bf16x8*)(C.ws + WS_KCMP) + (size_t)bg * 32 * 4 * 64 + lane;
        const bf16x8* vb = (const bf16x8*)(C.ws + WS_VCMP) + (size_t)bg * 64 * 2 * 64 + lane;
        float m1 = -1e30f, l1 = 0.f;
#define CMP_P1(KF, KT) do { \
            f32x16 sc; _Pragma("unroll") for (int i = 0; i < 16; ++i) sc[i] = 0.f; \
            _Pragma("unroll") for (int s = 0; s < 4; ++s) sc = mfma32(KF[s], qf[s], sc); \
            if (nvmin - 1 - 32 * (KT) < 31) {     \
                asm volatile("" ::: "memory"); \
                const int up = nvq - 1 - 32 * (KT); const int x0 = up < 0 ? 64 : 8 * hi; const unsigned span = up < 0 ? 0u : (unsigned)up; \
                _Pragma("unroll") for (int i = 0; i < 16; ++i) sc[i] = ((unsigned)(x0 + i + (i >= 8 ? 8 : 0)) <= span) ? sc[i] : -1e30f; } \
            float mx = -1e30f; _Pragma("unroll") for (int i = 0; i < 16; ++i) mx = fmaxf(mx, sc[i]); \
            mx = xhalf_max(mx); \
            const float mn = fmaxf(m1, mx), msub = (mn < -1e29f) ? 0.f : mn; float ps = 0.f;     \
            _Pragma("unroll") for (int i = 0; i < 16; ++i) ps += ex2(sc[i] - msub); \
            l1 = l1 * ex2(m1 - mn) + ps; m1 = mn; } while (0)
        if (ntile > 0) {
            bf16x8 kA[4], kB[4], kC[4], kD[4];
#define CMP_LDK(KF, KT) do { const int kn_ = ((KT) < ntile) ? (KT) : ntile - 1; _Pragma("unroll") for (int s = 0; s < 4; ++s) KF[s] = kb[kn_ * 256 + s * 64]; } while (0)
            CMP_LDK(kA, 0); CMP_LDK(kB, 1); CMP_LDK(kC, 2);
#pragma unroll 1
            for (int kt = 0; kt < ntile; kt += 4) {
                CMP_LDK(kD, kt + 3); __builtin_amdgcn_sched_barrier(0); CMP_P1(kA, kt);     if (kt + 1 >= ntile) break;
                CMP_LDK(kA, kt + 4); __builtin_amdgcn_sched_barrier(0); CMP_P1(kB, kt + 1); if (kt + 2 >= ntile) break;
                CMP_LDK(kB, kt + 5); __builtin_amdgcn_sched_barrier(0); CMP_P1(kC, kt + 2); if (kt + 3 >= ntile) break;
                CMP_LDK(kC, kt + 6); __builtin_amdgcn_sched_barrier(0); CMP_P1(kD, kt + 3);
            }
        }
#undef CMP_P1
        l1 = xhalf_sum(l1);
        const float inv = 1.f / fmaxf(l1, 1e-30f), m1sub = (m1 < -1e29f) ? 0.f : m1;
        for (int e = lane; e < 8 * 264; e += 64) imp[e] = 0.f;
        LDS_WAIT();
        f32x16 O[2];
#pragma unroll
        for (int i = 0; i < 16; ++i) { O[0][i] = 0.f; O[1][i] = 0.f; }
#define CMP_P2(KF, VF, KT) do { \
            f32x16 sc; _Pragma("unroll") for (int i = 0; i < 16; ++i) sc[i] = 0.f; \
            _Pragma("unroll") for (int s = 0; s < 4; ++s) sc = mfma32(KF[s], qf[s], sc); \
            if (nvmin - 1 - 32 * (KT) < 31) { \
                asm volatile("" ::: "memory"); \
                const int up = nvq - 1 - 32 * (KT); const int x0 = up < 0 ? 64 : 8 * hi; const unsigned span = up < 0 ? 0u : (unsigned)up; \
                _Pragma("unroll") for (int i = 0; i < 16; ++i) sc[i] = ((unsigned)(x0 + i + (i >= 8 ? 8 : 0)) <= span) ? sc[i] : -1e30f; } \
            float p[16]; \
            _Pragma("unroll") for (int i = 0; i < 16; ++i) p[i] = ex2(sc[i] - m1sub) * inv; \
            _Pragma("unroll") for (int rr = 0; rr < 2; ++rr) { \
                const float* q8 = p + 8 * rr; \
                float a = q8[0] + q8[1] + q8[2] + 0.5f * q8[3], bq = 0.5f * q8[3] + q8[4] + q8[5] + q8[6] + 0.5f * q8[7], cq = 0.5f * q8[7]; \
                a += dpp_xor1(a); a += dpp_xor2(a); bq += dpp_xor1(bq); bq += dpp_xor2(bq); cq += dpp_xor1(cq); cq += dpp_xor2(cq); \
                _Pragma("unroll") for (int hh = 0; hh < 2; ++hh)     \
                if (h == 0 && hi == hh) { LAS float* ip = imp + qi * 264 + 8 * (KT) + 2 * hi + 4 * rr; \
                    __hip_atomic_fetch_add(ip, a, __ATOMIC_RELAXED, __HIP_MEMORY_SCOPE_WORKGROUP); __hip_atomic_fetch_add(ip + 1, bq, __ATOMIC_RELAXED, __HIP_MEMORY_SCOPE_WORKGROUP); \
                    __hip_atomic_fetch_add(ip + 2, cq, __ATOMIC_RELAXED, __HIP_MEMORY_SCOPE_WORKGROUP); } \
            } \
            const bf16x8 pb0 = pack_p(p), pb1 = pack_p(p + 8); \
            O[0] = mfma32(VF[0], pb0, O[0]); O[1] = mfma32(VF[1], pb0, O[1]); \
            O[0] = mfma32(VF[2], pb1, O[0]); O[1] = mfma32(VF[3], pb1, O[1]); } while (0)
        if (ntile > 0) {
            bf16x8 kA[4], kB[4], kC[4], vA[4];
#define CMP_LDV(KT) do { _Pragma("unroll") for (int s = 0; s < 4; ++s) vA[s] = vb[(KT) * 256 + s * 64]; } while (0)
            CMP_LDK(kA, 0); CMP_LDK(kB, 1);
#pragma unroll 1
            for (int kt = 0; kt < ntile; kt += 3) {
                CMP_LDK(kC, kt + 2); CMP_LDV(kt);     __builtin_amdgcn_sched_barrier(0); CMP_P2(kA, vA, kt);     if (kt + 1 >= ntile) break;
                CMP_LDK(kA, kt + 3); CMP_LDV(kt + 1); __builtin_amdgcn_sched_barrier(0); CMP_P2(kB, vA, kt + 1); if (kt + 2 >= ntile) break;
                CMP_LDK(kB, kt + 4); CMP_LDV(kt + 2); __builtin_amdgcn_sched_barrier(0); CMP_P2(kC, vA, kt + 2);
            }
#undef CMP_LDV
#undef CMP_LDK
        }
#undef CMP_P2
#pragma unroll
        for (int i = 0; i < 16; ++i) { ost[i * 64] = gc * O[0][i]; ost[(16 + i) * 64] = gc * O[1][i]; }
        LDS_WAIT();
    }

    unsigned bmv[4];
    if (cur <= 15) {
#pragma unroll
        for (int c = 0; c < 4; ++c) bmv[c] = (lane + 64 * c <= cur) ? 0xFFu : 0u;
    } else {
        unsigned key[8][4];
#pragma unroll
        for (int q2 = 0; q2 < 8; ++q2)
#pragma unroll
            for (int c = 0; c < 4; ++c) { const int j = lane + 64 * c; const bool cand = (j >= 1) && (j < cur - 1); const float v = imp[q2 * 264 + j];
                key[q2][c] = cand ? ((__float_as_uint(v) & 0xFFFFFF00u) | (unsigned)(255 - j)) : 0u; }
#pragma unroll
        for (int c = 0; c < 4; ++c) bmv[c] = 0u;
#pragma unroll 1
        for (int round = 0; round < 13; ++round) {
#pragma unroll
            for (int q2 = 0; q2 < 8; ++q2) {
                unsigned mx = key[q2][0]; mx = mx > key[q2][1] ? mx : key[q2][1]; mx = mx > key[q2][2] ? mx : key[q2][2]; mx = mx > key[q2][3] ? mx : key[q2][3];
                const unsigned w = wave_max_u32(mx);
#pragma unroll
                for (int c = 0; c < 4; ++c) { const bool win = (key[q2][c] == w) && (w != 0u); key[q2][c] = win ? 0u : key[q2][c]; bmv[c] |= win ? (1u << q2) : 0u; }
            }
        }
#pragma unroll
        for (int c = 0; c < 4; ++c) { const int j = lane + 64 * c; if (j == 0 || j == cur || j == cur - 1) bmv[c] = 0xFFu; }
    }

    {
        LAS unsigned* list = (LAS unsigned*)imp;
        LAS float* ostb = (LAS float*)(C.lds + C.wave * 16640 + 8448);
        const int q16 = lane & 15, fq = lane >> 4, qi4 = q16 >> 2, head4 = g * 4 + (q16 & 3);
        const bf16x8* kb = (const bf16x8*)(C.ws + WS_KSLC) + (size_t)bg * 512 * 256 + lane;
        const bf16x8* vb = (const bf16x8*)(C.ws + WS_VSLC) + (size_t)bg * 512 * 256 + lane;
        int nblk = 0;
#pragma unroll
        for (int c = 0; c < 4; ++c) {
            const unsigned long long mk = __ballot(bmv[c] != 0u);
            const int pos = nblk + (int)__builtin_amdgcn_mbcnt_hi((unsigned)(mk >> 32), __builtin_amdgcn_mbcnt_lo((unsigned)mk, 0u));
            if (bmv[c] != 0u) list[pos] = (unsigned)(lane + 64 * c) | (bmv[c] << 16);
            nblk += __builtin_popcountll(mk);
        }
        LDS_WAIT();
        const int tq = t0 + qi4;
        bf16x8 q16f[2][2]; float gs4[2];
#pragma unroll
        for (int sub = 0; sub < 2; ++sub) {
            const size_t tok4 = (size_t)b * S_ + tq + 4 * sub;
            const bf16_t* qp = P + tok4 * PP + PC_Q + head4 * 64;
            q16f[sub][1] = scale_q(*(const u32x4*)(qp + 32 + 8 * fq), QS);
            const u32x4 mv4 = *(const u32x4*)(qp + 8 * fq), pv4 = *(const u32x4*)(qp + 8 * ((fq ^ 1) & 1));
            const float* rt = (const float*)(C.ws + WS_ROPE) + tok4 * 16;
            const f32x4 ca = *(const f32x4*)rt, cb2 = *(const f32x4*)(rt + 4), sa = *(const f32x4*)(rt + 8), sb = *(const f32x4*)(rt + 12);
            const float cs[8] = {ca.x, ca.y, ca.z, ca.w, cb2.x, cb2.y, cb2.z, cb2.w}, sn[8] = {sa.x, sa.y, sa.z, sa.w, sb.x, sb.y, sb.z, sb.w};
            const float mv[8] = {bf_lo(mv4.x), bf_hi(mv4.x), bf_lo(mv4.y), bf_hi(mv4.y), bf_lo(mv4.z), bf_hi(mv4.z), bf_lo(mv4.w), bf_hi(mv4.w)};
            const float pp[8] = {bf_lo(pv4.x), bf_hi(pv4.x), bf_lo(pv4.y), bf_hi(pv4.y), bf_lo(pv4.z), bf_hi(pv4.z), bf_lo(pv4.w), bf_hi(pv4.w)};
            const bool roped = fq < 2; const float sg = (fq == 0) ? -1.f : 1.f; float o[8];
#pragma unroll
            for (int e = 0; e < 8; ++e) o[e] = (roped ? (mv[e] * cs[e] + sg * pp[e] * sn[e]) : mv[e]) * QS;
            q16f[sub][0] = pack_p(o);
            gs4[sub] = sigm(bf1(P[tok4 * PP + PC_NG + head4 * 3 + 1]));
        }
        float ma = -1e30f, la = 0.f, mb = -1e30f, lb = 0.f; f32x4v Oa[4], Ob[4];
#pragma unroll
        for (int dt = 0; dt < 4; ++dt) { Oa[dt] = (f32x4v){0.f, 0.f, 0.f, 0.f}; Ob[dt] = (f32x4v){0.f, 0.f, 0.f, 0.f}; }
        flash16_run(kb, vb, q16f[0], q16f[1], 2 * nblk, list, tq, t0, qi4, fq, ma, la, Oa, mb, lb, Ob);
        la = xq_sum(la); lb = xq_sum(lb);
        const float sca = gs4[0] / fmaxf(la, 1e-30f), scb = gs4[1] / fmaxf(lb, 1e-30f);
#pragma unroll
        for (int dt = 0; dt < 4; ++dt)
#pragma unroll
            for (int i = 0; i < 4; ++i) { LAS float* op = ostb + ((dt >> 1) * 16 + 4 * (2 * (dt & 1) + (fq >> 1)) + i) * 64 + q16 + 32 * (fq & 1); op[0] += sca * Oa[dt][i]; op[16] += scb * Ob[dt][i]; }
        LDS_WAIT();
    }
    {
        bf16x8 qr[4];
        {
            const bf16_t* qp = P + tok * PP + PC_Q + head * 64;
#pragma unroll
            for (int s = 1; s < 4; ++s) qr[s] = scale_q(*(const u32x4*)(qp + 16 * s + 8 * hi), QS);
            const u32x4 mv4 = *(const u32x4*)(qp + 8 * hi), pv4 = *(const u32x4*)(qp + 8 * (hi ^ 1));
            const float* rt = (const float*)(C.ws + WS_ROPE) + tok * 16;
            const f32x4 ca = *(const f32x4*)rt, cb2 = *(const f32x4*)(rt + 4), sa = *(const f32x4*)(rt + 8), sb = *(const f32x4*)(rt + 12);
            const float cs[8] = {ca.x, ca.y, ca.z, ca.w, cb2.x, cb2.y, cb2.z, cb2.w}, sn[8] = {sa.x, sa.y, sa.z, sa.w, sb.x, sb.y, sb.z, sb.w};
            const float mv[8] = {bf_lo(mv4.x), bf_hi(mv4.x), bf_lo(mv4.y), bf_hi(mv4.y), bf_lo(mv4.z), bf_hi(mv4.z), bf_lo(mv4.w), bf_hi(mv4.w)};
            const float pp[8] = {bf_lo(pv4.x), bf_hi(pv4.x), bf_lo(pv4.y), bf_hi(pv4.y), bf_lo(pv4.z), bf_hi(pv4.z), bf_lo(pv4.w), bf_hi(pv4.w)};
            const float sg = hi ? 1.f : -1.f; float o[8];
#pragma unroll
            for (int e = 0; e < 8; ++e) o[e] = (mv[e] * cs[e] + sg * pp[e] * sn[e]) * QS;
            qr[0] = pack_p(o);
        }
        const bf16x8* kb = (const bf16x8*)(C.ws + WS_KWIN) + (size_t)bg * 512 * 4 * 64 + lane;
        const bf16x8* vb = (const bf16x8*)(C.ws + WS_VWIN) + (size_t)bg * 1024 * 2 * 64 + lane;
        float m = -1e30f, l = 0.f; f32x16 O[2];
#pragma unroll
        for (int i = 0; i < 16; ++i) { O[0][i] = 0.f; O[1][i] = 0.f; }
        const int tlo = (t0 - 511 > 0 ? t0 - 511 : 0) >> 5, thi = (t0 + 7) >> 5;
        flash_run<1>(kb, vb, qr, thi - tlo + 1, (const LAS unsigned*)imp, tlo, t, t0, qi, hi, m, l, O);
        l = xhalf_sum(l);
        const float sc = gw / fmaxf(l, 1e-30f);
        bf16_t* yp = Y + tok * YP + 512 + head * 64 + 4 * hi;
#pragma unroll
        for (int dt = 0; dt < 2; ++dt)
#pragma unroll
            for (int ig = 0; ig < 4; ++ig) { float o4[4];
#pragma unroll
                for (int e = 0; e < 4; ++e) o4[e] = ost[(dt * 16 + 4 * ig + e) * 64] + sc * O[dt][4 * ig + e];
                u32x2 w; w.x = cvt_pk_bf16(o4[0], o4[1]); w.y = cvt_pk_bf16(o4[2], o4[3]); *(u32x2*)(yp + 32 * dt + 8 * ig) = w; }
        LDS_WAIT();
    }
}

__device__ __forceinline__ void mem_tile(const Ctx& C, int b, int hm, int t0) {
    const bf16_t* P = (const bf16_t*)(C.ws + WS_R1); bf16_t* Y = (bf16_t*)(C.ws + WS_Y);
    int lane_ = C.lane; asm volatile("" : "+v"(lane_));
    const int lane = lane_, r = lane & 31, hi = lane >> 5;
    const size_t tok = (size_t)b * S_ + t0 + r;
    const float QS = 0.12751743082459868f;
    bf16x8 q[8];
    const bf16_t* qp = P + tok * PP + PC_QM + hm * 128;
#pragma unroll
    for (int s = 0; s < 8; ++s) q[s] = scale_q(*(const u32x4*)(qp + 16 * s + 8 * hi), QS);
    const bf16x8* kb = (const bf16x8*)(C.ws + WS_MEMK) + (size_t)(b * 4 + hm) * 8 * 8 * 64 + lane;
    const bf16x8* vb = (const bf16x8*)(C.ws + WS_MEMV) + (size_t)(b * 4 + hm) * 16 * 4 * 64 + lane;
    float m = -1e30f, l = 0.f; f32x16 O[4];
#pragma unroll
    for (int i = 0; i < 16; ++i) { O[0][i] = 0.f; O[1][i] = 0.f; O[2][i] = 0.f; O[3][i] = 0.f; }
#define MEM_STEP(KF, VF) do { \
        f32x16 sc; _Pragma("unroll") for (int i = 0; i < 16; ++i) sc[i] = 0.f; \
        _Pragma("unroll") for (int s = 0; s < 8; ++s) sc = mfma32(KF[s], q[s], sc); \
        float mx = -1e30f; _Pragma("unroll") for (int i = 0; i < 16; ++i) mx = fmaxf(mx, sc[i]); \
        mx = xhalf_max(mx); \
        const bool upd = mx > m + SM_THR; \
        if (__ballot(upd) != 0ull) { const float mn = upd ? mx : m, alpha = ex2(m - mn); l *= alpha; O[0] = O[0] * alpha; O[1] = O[1] * alpha; O[2] = O[2] * alpha; O[3] = O[3] * alpha; m = mn; } \
        float p[16], ps = 0.f; _Pragma("unroll") for (int i = 0; i < 16; ++i) { p[i] = ex2(sc[i] - m); ps += p[i]; } \
        l += ps; \
        const bf16x8 pb0 = pack_p(p), pb1 = pack_p(p + 8); \
        _Pragma("unroll") for (int dt = 0; dt < 4; ++dt) { O[dt] = mfma32(VF[dt], pb0, O[dt]); O[dt] = mfma32(VF[4 + dt], pb1, O[dt]); } } while (0)
    {
        bf16x8 kA[8], vv[8];
#pragma unroll 1
        for (int kt = 0; kt < 8; ++kt) {
#pragma unroll
            for (int s = 0; s < 8; ++s) kA[s] = kb[kt * 512 + s * 64];
#pragma unroll
            for (int s = 0; s < 8; ++s) vv[s] = vb[kt * 512 + s * 64];
            __builtin_amdgcn_sched_barrier(0);
            MEM_STEP(kA, vv);
        }
    }
#undef MEM_STEP
    l = xhalf_sum(l);
    const float inv = 1.f / l;
    bf16_t* yp = Y + tok * YP + 1024 + hm * 128 + 4 * hi;
#pragma unroll
    for (int dt = 0; dt < 4; ++dt)
#pragma unroll
        for (int ig = 0; ig < 4; ++ig) { u32x2 w; w.x = cvt_pk_bf16(O[dt][4 * ig] * inv, O[dt][4 * ig + 1] * inv); w.y = cvt_pk_bf16(O[dt][4 * ig + 2] * inv, O[dt][4 * ig + 3] * inv); *(u32x2*)(yp + 32 * dt + 8 * ig) = w; }
}

__device__ __forceinline__ void attention_phase(const Ctx& C) {
    const int bxx = C.gw / NWAVES; const bool xmode = (C.G & 7) == 0;
    const int x = bxx & 7, rank = xmode ? (bxx >> 3) * NWAVES + C.wave : C.gw, nrank = xmode ? (C.G >> 3) * NWAVES : C.NGW, nitem = xmode ? 1536 : 12288;
    for (int i = rank; i < nitem; i += nrank) {
        int nsa_n, mem_e;
        if (xmode) { nsa_n = (i < 1024) ? (x >> 1) * 2048 + 2 * i + (x & 1) : -1; mem_e = x * 512 + (i - 1024); }
        else { if (i < 8192) { const int k = i >> 11, w = i & 2047; nsa_n = k * 2048 + ((k & 1) ? 2047 - w : w); } else nsa_n = -1; mem_e = i - 8192; }
        if (nsa_n >= 0) { const int k = nsa_n >> 11; nsa_tile(C, k >> 1, k & 1, (nsa_n & 2047) * 8); }
        else { const int bh = mem_e >> 9; mem_tile(C, bh >> 2, bh & 3, (mem_e & 511) * 32); }
    }
}

#define XB_TMO      128
#define XB_XCNT(j)  (256  + 64 * (j))
#define XB_XSUB(j)  (1280 + 64 * (j))
#define XB_XGEN(j)  (2304 + 64 * (j))
#define XB_TOP      3328
#define XB_TOPGEN   3392
#define XCD_BAR_WORDS 3456
#define XB_SPIN_CAP (1u << 18)
__device__ __forceinline__ unsigned xb_ld(unsigned* p)              { return __hip_atomic_load(p, __ATOMIC_RELAXED, __HIP_MEMORY_SCOPE_AGENT); }
__device__ __forceinline__ unsigned xb_add(unsigned* p, unsigned v) { return __hip_atomic_fetch_add(p, v, __ATOMIC_RELAXED, __HIP_MEMORY_SCOPE_AGENT); }
__device__ __forceinline__ unsigned xb_xcc_id() { return (unsigned)__builtin_amdgcn_s_getreg((3 << 11) | 20) & 0xFu; }
#define XB_SPIN(cond, bar) do { unsigned _sp = 0; while (cond) { __builtin_amdgcn_s_sleep(1); \
    if ((++_sp & 255u) == 0u) { if (xb_ld(&(bar)[XB_TMO])) break; if (_sp > XB_SPIN_CAP) { atomicAdd(&(bar)[XB_TMO], 1u); break; } } } } while (0)
__device__ __forceinline__ void xcd_barrier_complete(unsigned* bar, unsigned x, unsigned& nloc, unsigned& nx) {
    const unsigned G = gridDim.x * gridDim.y * gridDim.z;
    unsigned sum, cnt, mine, sp = 0u;
    for (;;) {
        sum = 0u; cnt = 0u; mine = 0u;
#pragma unroll
        for (unsigned j = 0; j < 16; ++j) { const unsigned c = xb_ld(&bar[XB_XCNT(j)]); sum += c; cnt += (c > 0u) ? 1u : 0u; mine = (j == x) ? c : mine; }
        if (sum == G) break;
        __builtin_amdgcn_s_sleep(1);
        if ((++sp & 255u) == 0u) { if (xb_ld(&bar[XB_TMO])) break; if (sp > XB_SPIN_CAP) { atomicAdd(&bar[XB_TMO], 1u); break; } }
    }
    nloc = mine > 0u ? mine : 1u; nx = cnt > 0u ? cnt : 1u;
}
__device__ __forceinline__ void xcd_barrier(unsigned* bar, volatile LAS unsigned* st, bool tid0) {
    asm volatile("s_waitcnt vmcnt(0)" ::: "memory");
    __syncthreads();
    if (tid0) {
        __builtin_amdgcn_s_waitcnt(0);
        const unsigned x = xb_xcc_id();
        unsigned nloc = st[0], nx = st[1];
        if (nloc == 0u) { xcd_barrier_complete(bar, x, nloc, nx); st[0] = nloc; st[1] = nx; }
        const unsigned old = xb_add(&bar[XB_XSUB(x)], 1u);
        const unsigned gen = old / nloc;
        if (old + 1u == (gen + 1u) * nloc) {
            __builtin_amdgcn_fence(__ATOMIC_RELEASE, "agent");
            asm volatile("s_waitcnt vmcnt(0)" ::: "memory");
            const unsigned og = xb_add(&bar[XB_TOP], 1u);
            const unsigned tg = og / nx;
            if (og + 1u == (tg + 1u) * nx) xb_add(&bar[XB_TOPGEN], 1u);
            else XB_SPIN(xb_ld(&bar[XB_TOPGEN]) == tg, bar);
            __builtin_amdgcn_fence(__ATOMIC_ACQUIRE, "agent");
            xb_add(&bar[XB_XGEN(x)], 1u);
            asm volatile("s_waitcnt vmcnt(0)" ::: "memory");
        } else {
            XB_SPIN(xb_ld(&bar[XB_XGEN(x)]) == gen, bar);
            __builtin_amdgcn_fence(__ATOMIC_ACQUIRE, "agent");
            asm volatile("s_waitcnt vmcnt(0)" ::: "memory");
        }
    }
    __syncthreads();
}

constexpr int LDS_BYTES = 147456, XB_LDS_OFF = 147456 - 64;
constexpr int NPHASE = 1 + 2 * 14;

__global__ void __launch_bounds__(NWAVES * 64, 2) fwd_kernel(Args args) {
    extern __shared__ __attribute__((aligned(16))) unsigned char lds_raw[];
    cg::grid_group grid = cg::this_grid();
    if (args.ph_lo == 0x7fffffff) grid.sync();
    const int wave0 = __builtin_amdgcn_readfirstlane((int)threadIdx.x >> 6);
    {
        volatile LAS unsigned* st = (volatile LAS unsigned*)(lds_raw + XB_LDS_OFF);
        if (threadIdx.x == 0) { st[0] = 0u; st[1] = 0u; (void)xb_add((unsigned*)(args.ws + WS_BAR) + XB_XCNT(xb_xcc_id()), 1u); }
        __syncthreads();
    }
#define PHASE_BEGIN { \
        unsigned char* ws0_ = args.ws; asm volatile("" : "+s"(ws0_)); gu8* ws = (gu8*)ws0_;     \
        int tid_; asm volatile("v_mbcnt_lo_u32_b32 %0, -1, 0\n\tv_mbcnt_hi_u32_b32 %0, -1, %0" : "=v"(tid_)); tid_ += wave0 * 64; \
        Ctx C; C.a = &args; C.ws = ws; C.lds = (LAS unsigned char*)lds_raw; C.tid = tid_; C.lane = tid_ & 63; C.wave = __builtin_amdgcn_readfirstlane(tid_ >> 6); \
        int bx = blockIdx.x; asm volatile("" : "+s"(bx)); C.G = gridDim.x; C.gw = bx * NWAVES + C.wave; C.NGW = C.G * NWAVES; \
        bf16_t* const H = (bf16_t*)(ws + WS_H); bf16_t* const R1 = (bf16_t*)(ws + WS_R1); bf16_t* const Y = (bf16_t*)(ws + WS_Y); (void)H; (void)R1; (void)Y; (void)bx;
#define PHASE_END   { int ln_; asm volatile("v_mbcnt_lo_u32_b32 %0, -1, 0\n\tv_mbcnt_hi_u32_b32 %0, -1, %0" : "=v"(ln_));   \
        xcd_barrier((unsigned*)(ws + WS_BAR), (volatile LAS unsigned*)(lds_raw + XB_LDS_OFF), (wave0 == 0) && (ln_ == 0)); } }
#define PHASE_END_IF(c_) { if (c_) { int ln_; asm volatile("v_mbcnt_lo_u32_b32 %0, -1, 0\n\tv_mbcnt_hi_u32_b32 %0, -1, %0" : "=v"(ln_));   \
        xcd_barrier((unsigned*)(ws + WS_BAR), (volatile LAS unsigned*)(lds_raw + XB_LDS_OFF), (wave0 == 0) && (ln_ == 0)); } } }
#define PHASE_END_CG grid.sync(); }

    PHASE_BEGIN
        convert_layer(C, 0);
        rope_table(C);
        prenorm_rows(C, (const float*)args.in[0], (const float*)args.in[3], H);
    PHASE_END

#pragma unroll 1
    for (int l = 0; l < 2; ++l) {
        PHASE_BEGIN
            { pg8::GemmDesc g{(const char*)H, (const char*)(ws + WS_W1IN), DM, DM, 128, 128, 16}; pg8::StdOrder S; S.init(T_, 2 * FF, C.G, bx, DM, DM);
              pg8::Epi<1> E{R1, FF, nullptr, nullptr}; pg8::gemm_phase(C.lds, C.tid, g, S, E); }
        PHASE_END
        PHASE_BEGIN
            { pg8::GemmDesc g{(const char*)R1, (const char*)(ws + WS_W1OUT), FF, FF, 128, 128, 44}; pg8::StdOrder S; S.init(T_, DM, C.G, bx, FF, FF);
              pg8::Epi<0> E{H, DM, nullptr, nullptr}; pg8::gemm_phase(C.lds, C.tid, g, S, E); }
        PHASE_END
        PHASE_BEGIN
            if (bx < 8) {
                { pg8::GemmDesc g{(const char*)(ws + WS_MEMN), (const char*)(ws + WS_WMKV), DM, DM, 128, 128, 16}; pg8::StdOrder S; S.init(512, DM, C.G, bx, DM, DM);
              pg8::Epi<0> E{(bf16_t*)(ws + WS_MKV), DM, nullptr, nullptr}; pg8::gemm_phase(C.lds, C.tid, g, S, E); }
            } else {
                norm_phase(C, C.gw - 8 * NWAVES, C.NGW - 8 * NWAVES, l == 0 ? (const float*)args.in[0] : args.out, args.out, H, H, INF(4, l, DM), INF(7, l, DM), 0.5f);
            }
            cb_reduce(C, l);
        PHASE_END
        PHASE_BEGIN
            { pg8::GemmDesc g{(const char*)H, (const char*)(ws + WS_WMIX), DM, DM, 128, 128, 16}; pg8::StdOrder S; S.init(T_, PP, C.G, bx, DM, DM);
              pg8::Epi<0> E{R1, PP, nullptr, nullptr}; pg8::gemm_phase(C.lds, C.tid, g, S, E); }
        PHASE_END
        PHASE_BEGIN
            if (bx < 64) {
                pg8::GemmDesc g{(const char*)R1, (const char*)(ws + WS_WC1), 16 * PP, 2048, PP * 2, 128, 16}; pg8::CmpOrder S{bx};
                pg8::Epi<0> E{(bf16_t*)(ws + WS_CMPP), 256, nullptr, nullptr}; pg8::gemm_phase(C.lds, C.tid, g, S, E);
            } else {
                prep_items(C, l, C.gw - 64 * NWAVES, C.NGW - 64 * NWAVES);
                memkv_ops(C, C.gw - 64 * NWAVES, C.NGW - 64 * NWAVES);
            }
        PHASE_END
        PHASE_BEGIN
            cmp_stage2(C, l);
        PHASE_END
        PHASE_BEGIN
            attention_phase(C);
        PHASE_END
        PHASE_BEGIN
            { pg8::GemmDesc g{(const char*)H, (const char*)(ws + WS_WG), DM, DM, 128, 128, 16}; pg8::StdOrder S; S.init(T_, GP, C.G, bx, DM, DM);
              pg8::Epi<2> E{R1, GP, nullptr, nullptr}; pg8::gemm_phase(C.lds, C.tid, g, S, E); }
        PHASE_END
        PHASE_BEGIN
            { pg8::GemmDesc g{(const char*)Y, (const char*)(ws + WS_WBR), YP, YP, 128, 128, 8}; pg8::MergeOrder S; S.init(T_, DM, C.G, bx, YP, YP);
              pg8::Epi<3> E{H, DM, R1, nullptr}; pg8::gemm_phase(C.lds, C.tid, g, S, E); }
        PHASE_END
        PHASE_BEGIN
            { pg8::GemmDesc g{(const char*)H, (const char*)(ws + WS_WOUT), DM, DM, 128, 128, 16}; pg8::StdOrder S; S.init(T_, DM, C.G, bx, DM, DM);
              pg8::Epi<0> E{R1, DM, nullptr, nullptr}; pg8::gemm_phase(C.lds, C.tid, g, S, E); }
        PHASE_END
        PHASE_BEGIN
            norm_phase(C, C.gw, C.NGW, args.out, args.out, R1, H, INF(8, l, DM), INF(25, l, DM), 1.0f);
        PHASE_END
        PHASE_BEGIN
            { pg8::GemmDesc g{(const char*)H, (const char*)(ws + WS_W2IN), DM, DM, 128, 128, 16}; pg8::StdOrder S; S.init(T_, 2 * FF, C.G, bx, DM, DM);
              pg8::Epi<1> E{R1, FF, nullptr, nullptr}; pg8::gemm_phase(C.lds, C.tid, g, S, E); }
        PHASE_END
        PHASE_BEGIN
            { pg8::GemmDesc g{(const char*)R1, (const char*)(ws + WS_W2OUT), FF, FF, 128, 128, 44}; pg8::StdOrder S; S.init(T_, DM, C.G, bx, FF, FF);
              pg8::Epi<0> E{H, DM, nullptr, nullptr}; pg8::gemm_phase(C.lds, C.tid, g, S, E); }
        PHASE_END
        PHASE_BEGIN
            norm_phase(C, C.gw, C.NGW, args.out, args.out, H, H, INF(26, l, DM), l == 0 ? INF(3, 1, DM) : nullptr, 0.5f);
            if (l == 0) convert_layer(C, 1);
        PHASE_END_IF(l == 0)
    }
}

extern "C" void kernel_launch(void* const* d_in, const int* in_sizes, int n_in, void* d_out, int out_size, void* d_ws, size_t ws_size, hipStream_t stream) {
    static int grid = 0;
    if (grid == 0) {
        if (n_in != 29 || ws_size < WS_END) { fprintf(stderr, "kernel_launch: unexpected n_in %d / ws %zu\n", n_in, ws_size); grid = -1; return; }
        int dev = 0, cus = 0, per_cu = 0;
        hipGetDevice(&dev); hipDeviceGetAttribute(&cus, hipDeviceAttributeMultiprocessorCount, dev);
        hipFuncSetAttribute((const void*)fwd_kernel, hipFuncAttributeMaxDynamicSharedMemorySize, LDS_BYTES);
        hipOccupancyMaxActiveBlocksPerMultiprocessor(&per_cu, (const void*)fwd_kernel, NWAVES * 64, LDS_BYTES);
        if (per_cu < 1) per_cu = 1;
        grid = cus * per_cu;
        (void)hipGetLastError();
    }
    if (grid < 0) return;
    hipMemsetAsync((char*)d_ws + WS_BAR, 0, 16384, stream);
    Args a{};
    for (int i = 0; i < 29; ++i) a.in[i] = d_in[i];
    a.out = (float*)d_out; a.ws = (unsigned char*)d_ws; a.ph_lo = 0; a.ph_hi = NPHASE;
    void* kargs[] = {&a};
    hipError_t e = hipLaunchCooperativeKernel((const void*)fwd_kernel, dim3(grid), dim3(NWAVES * 64), kargs, LDS_BYTES, stream);
    if (e != hipSuccess) fprintf(stderr, "cooperative launch failed: %s (grid %d)\n", hipGetErrorString(e), grid);
}
```

```cpp
#include <hip/hip_runtime.h>
#include <hip/hip_cooperative_groups.h>
#include <cstdio>
#include <cstdint>
namespace cg = cooperative_groups;

#define LAS __attribute__((address_space(3)))
typedef unsigned short bf16_t;
typedef short bf16x8 __attribute__((ext_vector_type(8)));
typedef float f32x4 __attribute__((ext_vector_type(4)));
typedef float f32x16 __attribute__((ext_vector_type(16)));
typedef unsigned u32x4 __attribute__((ext_vector_type(4)));
typedef unsigned u32x2 __attribute__((ext_vector_type(2)));

constexpr int NBATCH = 2, S_ = 16384, T_ = NBATCH * S_, DM = 1024, FF = 2816, PP = 3584, GP = 3072, YP = 1536;
constexpr int NWAVES = 8;
constexpr float EPS = 1e-6f;
constexpr int PC_Q = 1536, PC_KV = 2048, PC_QM = 2816, PC_NG = 3328;

constexpr size_t MiB = 1u << 20;
constexpr size_t WS_W1IN = 0, WS_W1OUT = 11 * MiB, WS_WMIX = WS_W1OUT + 11 * MiB / 2, WS_WG = WS_WMIX + 7 * MiB, WS_WBR = WS_WG + 6 * MiB, WS_WOUT = WS_WBR + 3 * MiB,
                 WS_W2IN = WS_WOUT + 2 * MiB, WS_W2OUT = WS_W2IN + 11 * MiB, WS_WC1 = WS_W2OUT + 11 * MiB / 2  , WS_WMKV = WS_WC1 + 2 * MiB,
                 WS_MEMN = WS_WMKV + 2 * MiB, WS_MKV = WS_MEMN + 1 * MiB, WS_CB = WS_MKV + 1 * MiB  , WS_CBP = WS_CB + 8192  , WS_BAR = WS_CB + 8192 + 131072  ;
static_assert(WS_CB == 57 * MiB, "ws map");
constexpr size_t WS_ROPE = 58 * MiB, WS_MEMK = 60 * MiB, WS_MEMV = WS_MEMK + MiB / 2, WS_KCMP = 61 * MiB, WS_VCMP = WS_KCMP + MiB / 2, WS_CMPH = 62 * MiB,
                 WS_KSLC = 66 * MiB, WS_VSLC = 74 * MiB, WS_KWIN = 82 * MiB, WS_VWIN = 90 * MiB, WS_H = 98 * MiB, WS_Y = 162 * MiB, WS_R1 = 258 * MiB, WS_CMPP = 484 * MiB  , WS_END = 492 * MiB;

typedef float f32x2_t __attribute__((ext_vector_type(2)));
typedef __bf16 bf16x2_t __attribute__((ext_vector_type(2)));
__device__ __forceinline__ unsigned cvt_pk_bf16(float lo, float hi) { f32x2_t v = {lo, hi}; bf16x2_t b = __builtin_convertvector(v, bf16x2_t); return __builtin_bit_cast(unsigned, b); }
__device__ __forceinline__ float bf_lo(unsigned u) { return __uint_as_float(u << 16); }
__device__ __forceinline__ float bf_hi(unsigned u) { return __uint_as_float(u & 0xffff0000u); }
__device__ __forceinline__ float bf1(bf16_t u) { return __uint_as_float(((unsigned)u) << 16); }
__device__ __forceinline__ float ex2(float x) { return __builtin_amdgcn_exp2f(x); }
__device__ __forceinline__ float rcpf_(float x) { return __builtin_amdgcn_rcpf(x); }
__device__ __forceinline__ float sigm(float x) { return rcpf_(1.f + ex2(-1.44269504f * x)); }
__device__ __forceinline__ float gelu_tanh(float x) { const float u = 0.7978845608f * (x + 0.044715f * x * x * x); return x * rcpf_(1.f + ex2(-2.88539008f * u)); }
#define DPP_F(v, ctrl) __int_as_float(__builtin_amdgcn_update_dpp(0, __float_as_int(v), ctrl, 0xF, 0xF, true))
__device__ __forceinline__ float wave_sum(float v) {
    v += DPP_F(v, 0xB1); v += DPP_F(v, 0x4E); v += DPP_F(v, 0x141); v += DPP_F(v, 0x140);
    { const auto r = __builtin_amdgcn_permlane16_swap(__float_as_uint(v), __float_as_uint(v), false, false); v = __uint_as_float(r[0]) + __uint_as_float(r[1]); }
    { const auto r = __builtin_amdgcn_permlane32_swap(__float_as_uint(v), __float_as_uint(v), false, false); v = __uint_as_float(r[0]) + __uint_as_float(r[1]); }
    return v;
}
__device__ __forceinline__ int pi32(int r) { return (r & 0x13) | ((r & 4) << 1) | ((r & 8) >> 1); }
#define LDS_WAIT() asm volatile("s_waitcnt lgkmcnt(0)" ::: "memory")

namespace pg8 {
constexpr int BM = 256, BK = 64, HALF = 128, HTB = HALF * BK * 2, STAGE_BYTES = 8 * HTB, NXCD = 8, WGM = 8;
__device__ __forceinline__ int lds_byte(int r, int c) { const int st = (r >> 4) * 2 + (c >> 5), rr = r & 15, cc = c & 31, ob = rr * 64 + cc * 2; return st * 1024 + (ob ^ (((ob >> 9) & 1) << 5)); }
__device__ __forceinline__ void stage_rc(int b, int& R, int& C) { const int st = b / 1024, sb = b % 1024, swz = sb ^ (((sb >> 9) & 1) << 5); R = (st >> 1) * 16 + swz / 64; C = (st & 1) * 32 + (swz % 64) / 2; }
__device__ __forceinline__ int perm32(int rho) { const int n = rho >> 4, i = rho & 15; return 8 * (i >> 2) + 4 * n + (i & 3); }

struct Unit { int pm, pn, tag; long long aoff, boff; };
struct GemmDesc { const char* A; const char* Bt; int lda, ldb, kstepA, kstepB, nt; };

__device__ __forceinline__ void swz_tile(int L, int nM, int nN, int& pm, int& pn) {
    const int nwg = nM * nN; int wgid = L;
    { const int q = nwg / NXCD, r = nwg % NXCD, xcd = wgid % NXCD, off = wgid / NXCD; wgid = (xcd < r ? xcd * (q + 1) : r * (q + 1) + (xcd - r) * q) + off; }
    const int nig = WGM * nN, gid = wgid / nig, fm = gid * WGM, gsz = (nM - fm) < WGM ? (nM - fm) : WGM;
    pm = fm + ((wgid % nig) % gsz); pn = (wgid % nig) / gsz;
}
struct StdOrder {
    int nM, nN, G, c; long long tA, tB;
    __device__ void init(int M, int N, int G_, int c_, int lda, int ldb) { nM = M / BM; nN = N / BM; G = G_; c = c_; tA = 512LL * lda; tB = 512LL * ldb; }
    __device__ bool next(int i, Unit& u) const {
        const long long L = (long long)i * G + c; if (L >= (long long)nM * nN) return false;
        swz_tile((int)L, nM, nN, u.pm, u.pn); u.tag = 0; u.aoff = u.pm * tA; u.boff = u.pn * tB; return true;
    }
};
struct MergeOrder {
    int nM, nN, G, c; long long tA, tB;
    __device__ void init(int M, int N, int G_, int c_, int lda, int ldb) { nM = M / BM; nN = N / BM; G = G_; c = c_; tA = 512LL * lda; tB = 512LL * ldb; }
    __device__ bool next(int i, Unit& u) const {
        const int ti = i / 3, br = i - 3 * ti; const long long L = (long long)ti * G + c; if (L >= (long long)nM * nN) return false;
        swz_tile((int)L, nM, nN, u.pm, u.pn); u.tag = br; u.aoff = u.pm * tA + br * 1024; u.boff = u.pn * tB + br * 1024; return true;
    }
};
struct CmpOrder {
    int c;
    __device__ bool next(int i, Unit& u) const {
        if (i != 0 || c >= 64) return false;
        const int ks = c >> 5, kv = (c >> 4) & 1, bg = (c >> 2) & 3, tile = c & 3, b = bg >> 1, g = bg & 1;
        u.pm = c; u.pn = 0; u.tag = kv;
        u.aoff = 2LL * (((long long)b * S_ + 4096LL * tile + 16LL * ks) * PP + PC_KV + kv * 128 + g * 64);
        u.boff = (long long)kv * (256 * 2048 * 2) + (long long)ks * (1024 * 2); return true;
    }
};

__device__ __forceinline__ u32x4 pack8(f32x4 a, f32x4 b) { u32x4 w; w.x = cvt_pk_bf16(a[0], a[1]); w.y = cvt_pk_bf16(a[2], a[3]); w.z = cvt_pk_bf16(b[0], b[1]); w.w = cvt_pk_bf16(b[2], b[3]); return w; }
template <int MODE> struct Epi {
    bf16_t* O; int ldc; const bf16_t* G; const float* bias;
    __device__ __forceinline__ void operator()(const f32x4 (&acc)[2][2][4][2], const Unit& u, int wr, int wc, int fr, int fq) const {
        const int row0 = u.pm * BM + wr * 64 + fr;
        if constexpr (MODE == 1) {
            const int col0 = u.pn * 128 + wc * 32 + 8 * fq;
#pragma unroll
            for (int ai = 0; ai < 2; ++ai)
#pragma unroll
                for (int m = 0; m < 4; ++m) {
                    bf16_t* rowp = O + (size_t)(row0 + ai * HALF + m * 16) * ldc + col0;
                    f32x4 v0, v1;
#pragma unroll
                    for (int e = 0; e < 4; ++e) { const float a0 = acc[ai][0][m][0][e], a1 = acc[ai][0][m][1][e]; v0[e] = a0 * sigm(a0) * acc[ai][1][m][0][e]; v1[e] = a1 * sigm(a1) * acc[ai][1][m][1][e]; }
                    *(u32x4*)rowp = pack8(v0, v1);
                    __builtin_amdgcn_sched_barrier(0);
                }
        } else if constexpr (MODE == 3) {
            const int col0 = u.pn * BM + wc * 32 + 8 * fq;
#pragma unroll
            for (int ai = 0; ai < 2; ++ai) {
                u32x4 gv[4][2], ov[4][2];
#pragma unroll
                for (int m = 0; m < 4; ++m)
#pragma unroll
                    for (int bj = 0; bj < 2; ++bj) { const size_t row = (size_t)(row0 + ai * HALF + m * 16); const int col = col0 + bj * HALF;
                        gv[m][bj] = *(const u32x4*)(G + row * GP + u.tag * 1024 + col);
                        ov[m][bj] = (u.tag > 0) ? *(const u32x4*)(O + row * ldc + col) : (u32x4){0u, 0u, 0u, 0u}; }
                __builtin_amdgcn_sched_barrier(0);
#pragma unroll
                for (int m = 0; m < 4; ++m)
#pragma unroll
                    for (int bj = 0; bj < 2; ++bj) { const size_t row = (size_t)(row0 + ai * HALF + m * 16); const int col = col0 + bj * HALF;
                        f32x4 v0 = acc[ai][bj][m][0], v1 = acc[ai][bj][m][1]; const u32x4 g4 = gv[m][bj], o4 = ov[m][bj];
                        v0[0] = v0[0] * bf_lo(g4.x) + bf_lo(o4.x); v0[1] = v0[1] * bf_hi(g4.x) + bf_hi(o4.x); v0[2] = v0[2] * bf_lo(g4.y) + bf_lo(o4.y); v0[3] = v0[3] * bf_hi(g4.y) + bf_hi(o4.y);
                        v1[0] = v1[0] * bf_lo(g4.z) + bf_lo(o4.z); v1[1] = v1[1] * bf_hi(g4.z) + bf_hi(o4.z); v1[2] = v1[2] * bf_lo(g4.w) + bf_lo(o4.w); v1[3] = v1[3] * bf_hi(g4.w) + bf_hi(o4.w);
                        *(u32x4*)(O + row * ldc + col) = pack8(v0, v1); }
            }
        } else {
            const int col0 = u.pn * BM + wc * 32 + 8 * fq;
#pragma unroll
            for (int ai = 0; ai < 2; ++ai)
#pragma unroll
                for (int m = 0; m < 4; ++m) {
                    const size_t row = (size_t)(row0 + ai * HALF + m * 16);
#pragma unroll
                    for (int bj = 0; bj < 2; ++bj) {
                        const int col = col0 + bj * HALF;
                        f32x4 v0 = acc[ai][bj][m][0], v1 = acc[ai][bj][m][1];
                        bf16_t* dst = O + row * ldc + col;
                        if constexpr (MODE == 2) {
#pragma unroll
                            for (int e = 0; e < 4; ++e) { v0[e] = sigm(v0[e]); v1[e] = sigm(v1[e]); }
                        }
                        if constexpr (MODE == 4) {
                            const f32x4 b0 = *(const f32x4*)(bias + u.tag * 256 + col), b1 = *(const f32x4*)(bias + u.tag * 256 + col + 4);
#pragma unroll
                            for (int e = 0; e < 4; ++e) { v0[e] = gelu_tanh(v0[e] + b0[e]); v1[e] = gelu_tanh(v1[e] + b1[e]); }
                        }
                        if constexpr (MODE == 3) {
                            const u32x4 gv = *(const u32x4*)(G + row * GP + u.tag * 1024 + col);
                            v0[0] *= bf_lo(gv.x); v0[1] *= bf_hi(gv.x); v0[2] *= bf_lo(gv.y); v0[3] *= bf_hi(gv.y);
                            v1[0] *= bf_lo(gv.z); v1[1] *= bf_hi(gv.z); v1[2] *= bf_lo(gv.w); v1[3] *= bf_hi(gv.w);
                            if (u.tag > 0) {
                                const u32x4 ov = *(const u32x4*)dst;
                                v0[0] += bf_lo(ov.x); v0[1] += bf_hi(ov.x); v0[2] += bf_lo(ov.y); v0[3] += bf_hi(ov.y);
                                v1[0] += bf_lo(ov.z); v1[1] += bf_hi(ov.z); v1[2] += bf_lo(ov.w); v1[3] += bf_hi(ov.w);
                            }
                        }
                        *(u32x4*)dst = pack8(v0, v1);
                    }
                }
        }
    }
};

template <class EpiT, class Sched>
__device__ __forceinline__ void gemm_phase(LAS unsigned char* lds, int tid_in, const GemmDesc g, const Sched& S, const EpiT& E) {
    int tid_ = tid_in; asm volatile("" : "+v"(tid_));
    const int tid = tid_, wid = __builtin_amdgcn_readfirstlane(tid >> 6), lane = tid & 63, wr = wid >> 2, wc = wid & 3, fr = lane & 15, fq = lane >> 4;
    const int nt = g.nt;
    unsigned voffA[2], voffB[2];
#pragma unroll
    for (int i = 0; i < 2; ++i) { int R, C; stage_rc(tid * 16 + i * 8192, R, C); const int Rb = (R & ~31) + perm32(R & 31);
        voffA[i] = (unsigned)(R * g.lda + C) * 2u; voffB[i] = (unsigned)(Rb * g.ldb + C) * 2u; }
    const size_t kA = (size_t)g.kstepA, kB = (size_t)g.kstepB;
    const size_t hA = (size_t)HALF * g.lda * 2, hB = (size_t)HALF * g.ldb * 2;
    const unsigned ldsw = (unsigned)wid * 1024u;
    const int aoff = lds_byte(wr * 64 + fr, fq * 8), boff = lds_byte(wc * 32 + fr, fq * 8);
#define PG8_SA(b, h) (((b) * 2 + (h)) * HTB)
#define PG8_SB(b, h) ((4 + (b) * 2 + (h)) * HTB)
#define PG8_STAGE(bufoff, gbase, voff) do { _Pragma("unroll") for (int _i = 0; _i < 2; ++_i) \
        __builtin_amdgcn_global_load_lds((const unsigned*)((const char*)(gbase) + (voff)[_i]), (LAS unsigned*)(lds + (bufoff) + ldsw + _i * 8192), 16, 0, 0); } while (0)
#define PG8_LDA(dst, b, h) do { _Pragma("unroll") for (int m = 0; m < 4; ++m) _Pragma("unroll") for (int k = 0; k < 2; ++k) dst[m][k] = *(const LAS bf16x8*)(lds + PG8_SA(b, h) + aoff + m * 2048 + k * 1024); } while (0)
#define PG8_LDB(dst, b, h) do { _Pragma("unroll") for (int n = 0; n < 2; ++n) _Pragma("unroll") for (int k = 0; k < 2; ++k) dst[n][k] = *(const LAS bf16x8*)(lds + PG8_SB(b, h) + boff + n * 2048 + k * 1024); } while (0)
#define PG8_MMA(ai, bj, At, Bt) do { __builtin_amdgcn_s_setprio(1); _Pragma("unroll") for (int m = 0; m < 4; ++m) _Pragma("unroll") for (int n = 0; n < 2; ++n) _Pragma("unroll") for (int k = 0; k < 2; ++k) \
        acc[ai][bj][m][n] = __builtin_amdgcn_mfma_f32_16x16x32_bf16(Bt[n][k], At[m][k], acc[ai][bj][m][n], 0, 0, 0); __builtin_amdgcn_s_setprio(0); } while (0)
#define PG8_WAIT_V(n) asm volatile("s_waitcnt vmcnt(" #n ")" ::: "memory")
#define PG8_WAIT_L(n) asm volatile("s_waitcnt lgkmcnt(" #n ")" ::: "memory")
#define PG8_BAR __builtin_amdgcn_s_barrier()
#define PG8_SCHED __builtin_amdgcn_sched_barrier(0)
    Unit cur, nxt; int ui = 0;
    if (!S.next(0, cur)) return;
    f32x4 acc[2][2][4][2];
#pragma unroll
    for (int a = 0; a < 2; ++a)
#pragma unroll
        for (int b = 0; b < 2; ++b)
#pragma unroll
            for (int m = 0; m < 4; ++m)
#pragma unroll
                for (int n = 0; n < 2; ++n) acc[a][b][m][n] = (f32x4){0.f, 0.f, 0.f, 0.f};
    bf16x8 At[4][2], B0[2][2], B1[2][2];
    const char* cA = g.A + cur.aoff; const char* cB = g.Bt + cur.boff;
    PG8_STAGE(PG8_SB(0, 0), cB, voffB); PG8_STAGE(PG8_SB(0, 1), cB + hB, voffB); PG8_STAGE(PG8_SA(0, 0), cA, voffA); PG8_STAGE(PG8_SA(0, 1), cA + hA, voffA);
    if (wr == 1) PG8_BAR;
    PG8_WAIT_V(2); PG8_BAR;
    PG8_STAGE(PG8_SB(1, 0), cB + kB, voffB); PG8_STAGE(PG8_SA(1, 0), cA + kA, voffA); PG8_STAGE(PG8_SB(1, 1), cB + hB + kB, voffB);
    PG8_WAIT_V(6); PG8_BAR;
    for (;;) {
        const bool has_next = S.next(ui + 1, nxt);
        const char* nA = has_next ? g.A + nxt.aoff : cA; const char* nB = has_next ? g.Bt + nxt.boff : cB;
        for (int t = 0; t < nt; t += 2) {
            const bool last = (t == nt - 2);
            const char* a1 = cA + (size_t)(t + 1) * kA;
            const char* a2 = last ? nA : cA + (size_t)(t + 2) * kA; const char* b2 = last ? nB : cB + (size_t)(t + 2) * kB;
            const char* a3 = a2 + kA; const char* b3 = b2 + kB;
            PG8_LDB(B0, 0, 0); PG8_LDB(B1, 0, 1); PG8_SCHED; PG8_LDA(At, 0, 0); PG8_STAGE(PG8_SA(1, 1), a1 + hA, voffA);
            PG8_WAIT_V(8); PG8_WAIT_L(0); PG8_BAR; PG8_MMA(0, 0, At, B0); PG8_MMA(0, 1, At, B1); PG8_BAR; PG8_SCHED;
            PG8_LDA(At, 0, 1); PG8_STAGE(PG8_SB(0, 0), b2, voffB); PG8_STAGE(PG8_SB(0, 1), b2 + hB, voffB); PG8_STAGE(PG8_SA(0, 0), a2, voffA);
            PG8_WAIT_V(8); PG8_WAIT_L(0); PG8_BAR; PG8_MMA(1, 0, At, B0); PG8_MMA(1, 1, At, B1); PG8_BAR; PG8_SCHED;
            PG8_LDB(B0, 1, 0); PG8_LDB(B1, 1, 1); PG8_SCHED; PG8_LDA(At, 1, 0); PG8_STAGE(PG8_SA(0, 1), a2 + hA, voffA);
            PG8_WAIT_V(8); PG8_WAIT_L(0); PG8_BAR; PG8_MMA(0, 0, At, B0); PG8_MMA(0, 1, At, B1); PG8_BAR; PG8_SCHED;
            PG8_LDA(At, 1, 1); PG8_STAGE(PG8_SB(1, 0), b3, voffB); PG8_STAGE(PG8_SB(1, 1), b3 + hB, voffB); PG8_STAGE(PG8_SA(1, 0), a3, voffA);
            PG8_WAIT_V(8); PG8_WAIT_L(0); PG8_BAR; PG8_MMA(1, 0, At, B0); PG8_MMA(1, 1, At, B1); PG8_BAR; PG8_SCHED;
        }
        if (wr == 0) PG8_BAR;
        E(acc, cur, wr, wc, fr, fq);
        if (!has_next) break;
#pragma unroll
        for (int a = 0; a < 2; ++a)
#pragma unroll
            for (int b = 0; b < 2; ++b)
#pragma unroll
                for (int m = 0; m < 4; ++m)
#pragma unroll
                    for (int n = 0; n < 2; ++n) acc[a][b][m][n] = (f32x4){0.f, 0.f, 0.f, 0.f};
        cur = nxt; cA = nA; cB = nB; ++ui;
        if (wr == 1) PG8_BAR;
    }
    PG8_WAIT_V(0);
    PG8_BAR;
#undef PG8_SA
#undef PG8_SB
#undef PG8_STAGE
#undef PG8_LDA
#undef PG8_LDB
#undef PG8_MMA
#undef PG8_WAIT_V
#undef PG8_WAIT_L
#undef PG8_BAR
#undef PG8_SCHED
}
}

struct Args { const void* in[29]; float* out; unsigned char* ws; int ph_lo, ph_hi; };
static_assert(sizeof(Args) == 29 * 8 + 8 + 8 + 8, "Args has no padding");

typedef __attribute__((address_space(1))) unsigned char gu8;
struct Ctx {
    const Args* a; gu8* ws; LAS unsigned char* lds; int tid, lane, wave, G, gw, NGW;
};
#define INF(k, l, n) ((const float*)C.a->in[k] + (size_t)(l) * (n))

__device__ __forceinline__ void tr_item(const float* W, int ldw, int src_col, int nvalid, int k0, bf16_t* WT, int ldt, int dst_row, int dst_k, LAS float* scr, int lane) {
#pragma unroll 8
    for (int i = 0; i < 32; ++i) { const int kk = 2 * i + (lane >> 5), c = lane & 31; scr[kk * 33 + c] = (c < nvalid) ? W[(size_t)(k0 + kk) * ldw + src_col + c] : 0.f; }
    LDS_WAIT();
    const int c = lane & 7;
#pragma unroll
    for (int j = 0; j < 4; ++j) { const int n = (lane >> 3) + 8 * j; const LAS float* s = scr + (8 * c) * 33 + n;
        u32x4 o; o.x = cvt_pk_bf16(s[0 * 33], s[1 * 33]); o.y = cvt_pk_bf16(s[2 * 33], s[3 * 33]); o.z = cvt_pk_bf16(s[4 * 33], s[5 * 33]); o.w = cvt_pk_bf16(s[6 * 33], s[7 * 33]);
        *(u32x4*)(WT + (size_t)(dst_row + n) * ldt + dst_k + k0 + 8 * c) = o; }
    LDS_WAIT();
}

__device__ __forceinline__ void convert_layer(const Ctx& C, int l) {
    LAS float* scr = (LAS float*)(C.lds + C.wave * 8448);
    gu8* ws = C.ws; const int lane = C.lane;
    constexpr int NITEMS = 2816 + 1408 + 1792 + 1536 + 768 + 512 + 2816 + 1408 + 256 + 256 + 512;
    for (int it = C.gw; it < NITEMS; it += C.NGW) {
        int r = it;
        if (r < 2816) { const int kb = r / 176, nb = r % 176, tile = nb >> 3, w = nb & 7, src = (w >> 2) * FF + tile * 128 + (w & 3) * 32;
            tr_item(INF(5, l, DM * 2 * FF), 2 * FF, src, 32, kb * 64, (bf16_t*)(ws + WS_W1IN), DM, nb * 32, 0, scr, lane); continue; } r -= 2816;
        if (r < 1408) { const int kb = r / 32, nb = r % 32;
            tr_item(INF(6, l, FF * DM), DM, nb * 32, 32, kb * 64, (bf16_t*)(ws + WS_W1OUT), FF, nb * 32, 0, scr, lane); continue; } r -= 1408;
        if (r < 1792) { const int kb = r / 112, nb = r % 112; int src = 0, nv = 0;
            if (nb < 88) { src = nb * 32; nv = 32; } else if (nb < 104) { src = 2840 + (nb - 88) * 32; nv = 32; } else if (nb == 104) { src = 2816; nv = 24; }
            tr_item(INF(10, l, DM * 6424), 6424, src, nv, kb * 64, (bf16_t*)(ws + WS_WMIX), DM, nb * 32, 0, scr, lane); continue; } r -= 1792;
        if (r < 1536) { const int kb = r / 96, nb = r % 96;
            tr_item(INF(10, l, DM * 6424), 6424, 3352 + nb * 32, 32, kb * 64, (bf16_t*)(ws + WS_WG), DM, nb * 32, 0, scr, lane); continue; } r -= 1536;
        if (r < 768) { const int br = r / 256, q = r % 256, kb = q / 32, nb = q % 32;
            const float* W = br == 0 ? INF(21, l, 512 * DM) : (br == 1 ? INF(22, l, 512 * DM) : INF(23, l, 512 * DM));
            tr_item(W, DM, nb * 32, 32, kb * 64, (bf16_t*)(ws + WS_WBR), YP, nb * 32, br * 512, scr, lane); continue; } r -= 768;
        if (r < 512) { const int kb = r / 32, nb = r % 32;
            tr_item(INF(24, l, DM * DM), DM, nb * 32, 32, kb * 64, (bf16_t*)(ws + WS_WOUT), DM, nb * 32, 0, scr, lane); continue; } r -= 512;
        if (r < 2816) { const int kb = r / 176, nb = r % 176, tile = nb >> 3, w = nb & 7, src = (w >> 2) * FF + tile * 128 + (w & 3) * 32;
            tr_item(INF(27, l, DM * 2 * FF), 2 * FF, src, 32, kb * 64, (bf16_t*)(ws + WS_W2IN), DM, nb * 32, 0, scr, lane); continue; } r -= 2816;
        if (r < 1408) { const int kb = r / 32, nb = r % 32;
            tr_item(INF(28, l, FF * DM), DM, nb * 32, 32, kb * 64, (bf16_t*)(ws + WS_W2OUT), FF, nb * 32, 0, scr, lane); continue; } r -= 1408;
        if (r < 256) { const int kb = r / 8, nb = r % 8;
            tr_item(INF(14, l, 2048 * 256), 256, nb * 32, 32, kb * 64, (bf16_t*)(ws + WS_WC1), 2048, nb * 32, 0, scr, lane); continue; } r -= 256;
        if (r < 256) { const int kb = r / 8, nb = r % 8;
            tr_item(INF(17, l, 2048 * 256), 256, nb * 32, 32, kb * 64, (bf16_t*)(ws + WS_WC1 + MiB), 2048, nb * 32, 0, scr, lane); continue; } r -= 256;
        { const int kb = r / 32, nb = r % 32;
            tr_item(INF(20, l, DM * DM), DM, nb * 32, 32, kb * 64, (bf16_t*)(ws + WS_WMKV), DM, nb * 32, 0, scr, lane); }
    }
    {
        const float* gm = INF(9, l, DM);
        for (int m = C.gw; m < 512; m += C.NGW) {
            const f32x4* xr = (const f32x4*)((const float*)C.a->in[1] + (size_t)m * DM) + lane;
            f32x4 v[4]; float s = 0.f;
#pragma unroll
            for (int j = 0; j < 4; ++j) { v[j] = xr[64 * j]; s += (v[j].x * v[j].x + v[j].y * v[j].y) + (v[j].z * v[j].z + v[j].w * v[j].w); }
            const float rstd = rsqrtf(wave_sum(s) * (1.f / DM) + EPS);
            u32x2* o = (u32x2*)((bf16_t*)(ws + WS_MEMN) + (size_t)m * DM) + lane;
#pragma unroll
            for (int j = 0; j < 4; ++j) { const f32x4 gg = ((const f32x4*)gm)[lane + 64 * j]; u32x2 w; w.x = cvt_pk_bf16(v[j].x * rstd * gg.x, v[j].y * rstd * gg.y); w.y = cvt_pk_bf16(v[j].z * rstd * gg.z, v[j].w * rstd * gg.w); o[64 * j] = w; }
        }
    }
    {
        float* cb = (float*)(ws + WS_CBP) + (size_t)l * 64 * 256;
        for (int it = C.gw; it < 64; it += C.NGW) {
            const int kv = it >> 5, ch = it & 31;
            const float* pos = kv ? INF(13, l, 2048) : INF(12, l, 2048);
            const float* w1 = kv ? INF(17, l, 2048 * 256) : INF(14, l, 2048 * 256);
            float p[4] = {0.f, 0.f, 0.f, 0.f};
            for (int k = ch * 64; k < ch * 64 + 64; ++k) { const float pv = pos[k];
#pragma unroll
                for (int q = 0; q < 4; ++q) p[q] += pv * w1[(size_t)k * 256 + lane + 64 * q]; }
#pragma unroll
            for (int q = 0; q < 4; ++q) cb[(size_t)it * 256 + lane + 64 * q] = p[q];
        }
    }
}

__device__ __forceinline__ void rope_table(const Ctx& C) {
    const int* pos = (const int*)C.a->in[2];
    float* tab = (float*)(C.ws + WS_ROPE);
    const float invf[8] = {1.0f, 0.1939227432012558f, 0.03760603070259094f, 0.007292664609849453f, 0.0014142135623842478f, 0.00027424818836152554f, 5.318296098266728e-05f, 1.0313386155758053e-05f};
    for (int e = C.gw * 64 + C.lane; e < T_ * 8; e += C.NGW * 64) {
        const int tok = e >> 3, i = e & 7;
        float f = invf[0];
#pragma unroll
        for (int q = 1; q < 8; ++q) f = (i == q) ? invf[q] : f;
        const float ang = (float)pos[tok] * f;
        const double rev = (double)ang * 0.15915494309189535; const float fr = (float)(rev - floor(rev));
        tab[(size_t)tok * 16 + i] = __builtin_amdgcn_cosf(fr); tab[(size_t)tok * 16 + 8 + i] = __builtin_amdgcn_sinf(fr);
    }
}
__device__ __forceinline__ void prenorm_rows(const Ctx& C, const float* x, const float* g, bf16_t* h) {
    for (int m = C.gw; m < T_; m += C.NGW) {
        const f32x4* xr = (const f32x4*)(x + (size_t)m * DM) + C.lane;
        f32x4 v[4]; float s = 0.f;
#pragma unroll
        for (int j = 0; j < 4; ++j) { v[j] = xr[64 * j]; s += (v[j].x * v[j].x + v[j].y * v[j].y) + (v[j].z * v[j].z + v[j].w * v[j].w); }
        const float rstd = rsqrtf(wave_sum(s) * (1.f / DM) + EPS);
        u32x2* o = (u32x2*)(h + (size_t)m * DM) + C.lane;
#pragma unroll
        for (int j = 0; j < 4; ++j) { const f32x4 gg = ((const f32x4*)g)[C.lane + 64 * j]; u32x2 w; w.x = cvt_pk_bf16(v[j].x * rstd * gg.x, v[j].y * rstd * gg.y); w.y = cvt_pk_bf16(v[j].z * rstd * gg.z, v[j].w * rstd * gg.w); o[64 * j] = w; }
    }
}
__device__ __forceinline__ void norm_phase(const Ctx& C, int w0, int nw, const float* xin, float* xout, const bf16_t* y, bf16_t* h, const float* gpost, const float* gpre, float coef) {
    for (int m0 = w0; m0 < T_; m0 += 2 * nw) {
        f32x4 xv[2][4]; u32x2 yw[2][4];
#pragma unroll
        for (int r = 0; r < 2; ++r) { const int m = (m0 + r * nw < T_) ? m0 + r * nw : m0; const f32x4* xr = (const f32x4*)(xin + (size_t)m * DM) + C.lane; const u32x2* yr = (const u32x2*)(y + (size_t)m * DM) + C.lane;
#pragma unroll
            for (int j = 0; j < 4; ++j) { xv[r][j] = xr[64 * j]; yw[r][j] = yr[64 * j]; } }
#pragma unroll
        for (int r = 0; r < 2; ++r) {
            const int m = m0 + r * nw; if (m >= T_) break;
            f32x4 yv[4]; float s = 0.f;
#pragma unroll
            for (int j = 0; j < 4; ++j) { const u32x2 w = yw[r][j]; yv[j] = (f32x4){bf_lo(w.x), bf_hi(w.x), bf_lo(w.y), bf_hi(w.y)};
                s += (yv[j].x * yv[j].x + yv[j].y * yv[j].y) + (yv[j].z * yv[j].z + yv[j].w * yv[j].w); }
            const float rs = rsqrtf(wave_sum(s) * (1.f / DM) + EPS) * coef; float s2 = 0.f;
            f32x4* xo = (f32x4*)(xout + (size_t)m * DM) + C.lane;
#pragma unroll
            for (int j = 0; j < 4; ++j) { const f32x4 gg = ((const f32x4*)gpost)[C.lane + 64 * j]; xv[r][j] = xv[r][j] + yv[j] * gg * rs; xo[64 * j] = xv[r][j];
                s2 += (xv[r][j].x * xv[r][j].x + xv[r][j].y * xv[r][j].y) + (xv[r][j].z * xv[r][j].z + xv[r][j].w * xv[r][j].w); }
            if (gpre) {
                const float r2 = rsqrtf(wave_sum(s2) * (1.f / DM) + EPS);
                u32x2* o = (u32x2*)(h + (size_t)m * DM) + C.lane;
#pragma unroll
                for (int j = 0; j < 4; ++j) { const f32x4 gg = ((const f32x4*)gpre)[C.lane + 64 * j]; u32x2 w; w.x = cvt_pk_bf16(xv[r][j].x * r2 * gg.x, xv[r][j].y * r2 * gg.y); w.y = cvt_pk_bf16(xv[r][j].z * r2 * gg.z, xv[r][j].w * r2 * gg.w); o[64 * j] = w; }
            }
        }
    }
}
__device__ __forceinline__ void cb_reduce(const Ctx& C, int l) {
    const int e = C.gw * 64 + C.lane;
    if (e < 512) { const int kv = e >> 8, n = e & 255; const float* pp = (const float*)(C.ws + WS_CBP) + (size_t)l * 64 * 256 + (size_t)kv * 32 * 256 + n;
        float s = (kv ? INF(18, l, 256) : INF(15, l, 256))[n];
        for (int ch = 0; ch < 32; ++ch) s += pp[ch * 256];
        ((float*)(C.ws + WS_CB))[l * 512 + e] = s; }
}
__device__ __forceinline__ void memkv_ops(const Ctx& C, int w0, int nw) {
    const bf16_t* src = (const bf16_t*)(C.ws + WS_MKV); bf16_t* ko = (bf16_t*)(C.ws + WS_MEMK); bf16_t* vo = (bf16_t*)(C.ws + WS_MEMV);
    for (int e = w0 * 64 + C.lane; e < 512 * 1024; e += nw * 64) {
        const int mr = e >> 10, col = e & 1023, kv = col >> 9, hm = (col >> 7) & 3, d = col & 127, b = mr >> 8, m = mr & 255;
        const bf16_t v = src[e];
        if (kv == 0) ko[((size_t)((((b * 4 + hm) * 8 + (m >> 5)) * 8 + (d >> 4)) * 64 + pi32(m & 31) + 32 * ((d >> 3) & 1))) * 8 + (d & 7)] = v;
        else vo[((size_t)((((b * 4 + hm) * 16 + (m >> 4)) * 4 + (d >> 5)) * 64 + (d & 31) + 32 * ((m >> 3) & 1))) * 8 + (m & 7)] = v;
    }
}

__device__ __forceinline__ void prep_items(const Ctx& C, int l, int w0, int nw) {
    const bf16_t* P = (const bf16_t*)(C.ws + WS_R1); bf16_t* Y = (bf16_t*)(C.ws + WS_Y);
    const int lane = C.lane;
    {
        const float* cw = INF(11, l, 3 * 512);
        float w[3][8];
#pragma unroll
        for (int k = 0; k < 3; ++k)
#pragma unroll
            for (int e = 0; e < 8; ++e) w[k][e] = cw[k * 512 + lane * 8 + e];
        for (int it = w0; it < T_ / 8; it += nw) {
            const int tok0 = it * 8, s0 = tok0 & (S_ - 1);
            float c1[8], c2[8];
#pragma unroll
            for (int e = 0; e < 8; ++e) { c1[e] = 0.f; c2[e] = 0.f; }
            if (s0 > 0) {
#pragma unroll
                for (int back = 2; back >= 1; --back) {
                    const bf16_t* row = P + (size_t)(tok0 - back) * PP + lane * 8;
                    const u32x4 u = *(const u32x4*)row, cc = *(const u32x4*)(row + 1024);
                    float t[8] = {bf_lo(u.x) * bf_lo(cc.x), bf_hi(u.x) * bf_hi(cc.x), bf_lo(u.y) * bf_lo(cc.y), bf_hi(u.y) * bf_hi(cc.y), bf_lo(u.z) * bf_lo(cc.z), bf_hi(u.z) * bf_hi(cc.z), bf_lo(u.w) * bf_lo(cc.w), bf_hi(u.w) * bf_hi(cc.w)};
#pragma unroll
                    for (int e = 0; e < 8; ++e) { if (back == 2) c2[e] = t[e]; else c1[e] = t[e]; }
                }
            }
#pragma unroll
            for (int tt = 0; tt < 8; ++tt) {
                const bf16_t* row = P + (size_t)(tok0 + tt) * PP + lane * 8;
                const u32x4 u = *(const u32x4*)row, bb = *(const u32x4*)(row + 512), cc = *(const u32x4*)(row + 1024);
                const float c0[8] = {bf_lo(u.x) * bf_lo(cc.x), bf_hi(u.x) * bf_hi(cc.x), bf_lo(u.y) * bf_lo(cc.y), bf_hi(u.y) * bf_hi(cc.y), bf_lo(u.z) * bf_lo(cc.z), bf_hi(u.z) * bf_hi(cc.z), bf_lo(u.w) * bf_lo(cc.w), bf_hi(u.w) * bf_hi(cc.w)};
                const float bv[8] = {bf_lo(bb.x), bf_hi(bb.x), bf_lo(bb.y), bf_hi(bb.y), bf_lo(bb.z), bf_hi(bb.z), bf_lo(bb.w), bf_hi(bb.w)};
                float o[8];
#pragma unroll
                for (int e = 0; e < 8; ++e) { o[e] = bv[e] * (w[0][e] * c2[e] + w[1][e] * c1[e] + w[2][e] * c0[e]); c2[e] = c1[e]; c1[e] = c0[e]; }
                u32x4 ov; ov.x = cvt_pk_bf16(o[0], o[1]); ov.y = cvt_pk_bf16(o[2], o[3]); ov.z = cvt_pk_bf16(o[4], o[5]); ov.w = cvt_pk_bf16(o[6], o[7]);
                *(u32x4*)(Y + (size_t)(tok0 + tt) * YP + lane * 8) = ov;
            }
        }
    }
    {
        const float* rope = (const float*)(C.ws + WS_ROPE);
        LAS bf16_t* vt = (LAS bf16_t*)(C.lds + C.wave * 4608);
        const int hi = lane >> 5, dl = lane & 31;
        for (int it = w0; it < 4 * 512; it += nw) {
            const int bg = it >> 9, tile = it & 511, b = bg >> 1, g = bg & 1;
            const size_t tokb = (size_t)b * S_ + 32 * tile;
#pragma unroll
            for (int which = 0; which < 2; ++which) {
                const int kc = PC_KV + (2 + 2 * which) * 128 + g * 64, vc = kc + 128;
                bf16_t* kop = (bf16_t*)(C.ws + (which ? WS_KWIN : WS_KSLC)); bf16_t* vop = (bf16_t*)(C.ws + (which ? WS_VWIN : WS_VSLC));
#pragma unroll
                for (int q = 0; q < 4; ++q) {
                    const int r = (lane >> 3) + 8 * q, c = lane & 7;
                    const bf16_t* row = P + (tokb + r) * PP;
                    u32x4 kv = *(const u32x4*)(row + kc + 8 * c);
                    if (c < 2) {
                        const u32x4 pv = *(const u32x4*)(row + kc + 8 * (c ^ 1));
                        const float* rt = rope + (tokb + r) * 16;
                        const f32x4 ca = *(const f32x4*)rt, cb2 = *(const f32x4*)(rt + 4), sa = *(const f32x4*)(rt + 8), sb = *(const f32x4*)(rt + 12);
                        const float cs[8] = {ca.x, ca.y, ca.z, ca.w, cb2.x, cb2.y, cb2.z, cb2.w}, sn[8] = {sa.x, sa.y, sa.z, sa.w, sb.x, sb.y, sb.z, sb.w};
                        const float mv[8] = {bf_lo(kv.x), bf_hi(kv.x), bf_lo(kv.y), bf_hi(kv.y), bf_lo(kv.z), bf_hi(kv.z), bf_lo(kv.w), bf_hi(kv.w)};
                        const float pp[8] = {bf_lo(pv.x), bf_hi(pv.x), bf_lo(pv.y), bf_hi(pv.y), bf_lo(pv.z), bf_hi(pv.z), bf_lo(pv.w), bf_hi(pv.w)};
                        const float sg = (c == 0) ? -1.f : 1.f; float o[8];
#pragma unroll
                        for (int e = 0; e < 8; ++e) o[e] = mv[e] * cs[e] + sg * pp[e] * sn[e];
                        kv.x = cvt_pk_bf16(o[0], o[1]); kv.y = cvt_pk_bf16(o[2], o[3]); kv.z = cvt_pk_bf16(o[4], o[5]); kv.w = cvt_pk_bf16(o[6], o[7]);
                    }
                    if (which == 0)
                        *(u32x4*)(kop + ((size_t)(((bg * 512 + tile) * 2 + ((r >> 2) & 1)) * 2 + (c >> 2)) * 64 + ((r >> 3) * 4 + (r & 3)) + 16 * (c & 3)) * 8) = kv;
                    else
                        *(u32x4*)(kop + ((size_t)((bg * 512 + tile) * 4 + (c >> 1)) * 64 + pi32(r) + 32 * (c & 1)) * 8) = kv;
                    const u32x4 vv = *(const u32x4*)(row + vc + 8 * c);
                    *(LAS u32x4*)(vt + r * 72 + 8 * c) = vv;
                }
                LDS_WAIT();
#pragma unroll
                for (int o4 = 0; o4 < 4; ++o4) {
                    if (which == 0) {
                        const LAS bf16_t* sp = vt + (8 * (lane >> 4)) * 72 + 16 * o4 + (lane & 15);
                        u32x4 o; o.x = (unsigned)sp[0] | ((unsigned)sp[72] << 16); o.y = (unsigned)sp[144] | ((unsigned)sp[216] << 16); o.z = (unsigned)sp[288] | ((unsigned)sp[360] << 16); o.w = (unsigned)sp[432] | ((unsigned)sp[504] << 16);
                        *(u32x4*)(vop + ((size_t)((bg * 512 + tile) * 4 + o4) * 64 + lane) * 8) = o;
                        continue;
                    }
                    const int ks = o4 >> 1, dt = o4 & 1;
                    const LAS bf16_t* sp = vt + (16 * ks + 8 * hi) * 72 + 32 * dt + dl;
                    u32x4 o; o.x = (unsigned)sp[0] | ((unsigned)sp[72] << 16); o.y = (unsigned)sp[144] | ((unsigned)sp[216] << 16); o.z = (unsigned)sp[288] | ((unsigned)sp[360] << 16); o.w = (unsigned)sp[432] | ((unsigned)sp[504] << 16);
                    *(u32x4*)(vop + ((size_t)((bg * 1024 + 2 * tile + ks) * 2 + dt) * 64 + lane) * 8) = o;
                }
                LDS_WAIT();
            }
        }
    }
}

__device__ __forceinline__ void cmp_stage2(const Ctx& C, int l) {
    const int bxx = C.gw / NWAVES, kv = bxx & 1, wi = bxx >> 1, nwg2 = (C.G + 1 - kv) >> 1;
    const float* w2 = kv ? INF(19, l, 256 * 64) : INF(16, l, 256 * 64);
    LAS float* ws2 = (LAS float*)C.lds;
    for (int e = C.tid; e < 256 * 64 / 4; e += NWAVES * 64) ((LAS f32x4*)ws2)[e] = ((const f32x4*)w2)[e];
    __syncthreads();
    const bf16_t* hid = (const bf16_t*)(C.ws + WS_CMPP) + (size_t)kv * 4096 * 256;
    const float* cbias = (const float*)(C.ws + WS_CB) + l * 512 + kv * 256;
    bf16_t* ko = (bf16_t*)(C.ws + WS_KCMP); bf16_t* vo = (bf16_t*)(C.ws + WS_VCMP);
    const int d = C.lane;
    for (int row = wi * NWAVES + C.wave; row < 4096; row += nwg2 * NWAVES) {
        asm volatile("" ::: "memory");
        const u32x2 hv = *((const u32x2*)(hid + (size_t)row * 256) + C.lane), hw = *((const u32x2*)(hid + (size_t)(row + 8192) * 256) + C.lane);
        const f32x4 cbv = *((const f32x4*)cbias + C.lane);
        const float h0 = gelu_tanh(bf_lo(hv.x) + bf_lo(hw.x) + cbv.x), h1 = gelu_tanh(bf_hi(hv.x) + bf_hi(hw.x) + cbv.y), h2 = gelu_tanh(bf_lo(hv.y) + bf_lo(hw.y) + cbv.z), h3 = gelu_tanh(bf_hi(hv.y) + bf_hi(hw.y) + cbv.w);
        float acc = 0.f;
#pragma unroll 4
        for (int k = 0; k < 64; ++k) {
            const float a0 = __int_as_float(__builtin_amdgcn_readlane(__float_as_int(h0), k)), a1 = __int_as_float(__builtin_amdgcn_readlane(__float_as_int(h1), k));
            const float a2 = __int_as_float(__builtin_amdgcn_readlane(__float_as_int(h2), k)), a3 = __int_as_float(__builtin_amdgcn_readlane(__float_as_int(h3), k));
            acc += a0 * ws2[(4 * k + 0) * 64 + d]; acc += a1 * ws2[(4 * k + 1) * 64 + d]; acc += a2 * ws2[(4 * k + 2) * 64 + d]; acc += a3 * ws2[(4 * k + 3) * 64 + d];
        }
        const int bg = row >> 10, n = row & 1023;
        if (n == 1023) acc = 0.f;
        const bf16_t o = (bf16_t)(cvt_pk_bf16(acc, 0.f) & 0xffffu);
        if (kv == 0) ko[((size_t)((bg * 32 + (n >> 5)) * 4 + (d >> 4)) * 64 + pi32(n & 31) + 32 * ((d >> 3) & 1)) * 8 + (d & 7)] = o;
        else vo[((size_t)((bg * 64 + (n >> 4)) * 2 + (d >> 5)) * 64 + (d & 31) + 32 * ((n >> 3) & 1)) * 8 + (n & 7)] = o;
    }
    __syncthreads();
}

__device__ __forceinline__ float xhalf_max(float v) { const auto r = __builtin_amdgcn_permlane32_swap(__float_as_uint(v), __float_as_uint(v), false, false); return fmaxf(__uint_as_float(r[0]), __uint_as_float(r[1])); }
__device__ __forceinline__ float xhalf_sum(float v) { const auto r = __builtin_amdgcn_permlane32_swap(__float_as_uint(v), __float_as_uint(v), false, false); return __uint_as_float(r[0]) + __uint_as_float(r[1]); }
__device__ __forceinline__ f32x16 mfma32(bf16x8 a, bf16x8 b, f32x16 c) { return __builtin_amdgcn_mfma_f32_32x32x16_bf16(a, b, c, 0, 0, 0); }
__device__ __forceinline__ float dpp_xor1(float v) { return __int_as_float(__builtin_amdgcn_update_dpp(0, __float_as_int(v), 0xB1, 0xF, 0xF, true)); }
__device__ __forceinline__ float dpp_xor2(float v) { return __int_as_float(__builtin_amdgcn_update_dpp(0, __float_as_int(v), 0x4E, 0xF, 0xF, true)); }
__device__ __forceinline__ bf16x8 pack_p(const float* p) { u32x4 w; w.x = cvt_pk_bf16(p[0], p[1]); w.y = cvt_pk_bf16(p[2], p[3]); w.z = cvt_pk_bf16(p[4], p[5]); w.w = cvt_pk_bf16(p[6], p[7]); return __builtin_bit_cast(bf16x8, w); }
__device__ __forceinline__ bf16x8 scale_q(u32x4 v, float s) { u32x4 w; w.x = cvt_pk_bf16(bf_lo(v.x) * s, bf_hi(v.x) * s); w.y = cvt_pk_bf16(bf_lo(v.y) * s, bf_hi(v.y) * s); w.z = cvt_pk_bf16(bf_lo(v.z) * s, bf_hi(v.z) * s); w.w = cvt_pk_bf16(bf_lo(v.w) * s, bf_hi(v.w) * s); return __builtin_bit_cast(bf16x8, w); }
constexpr float SM_THR = 8.0f;
#define KREL(i, hi) (8 * (hi) + (i) + (((i) >= 8) ? 8 : 0))

__device__ __forceinline__ void flash_load(const bf16x8* kp, const bf16x8* vp, bf16x8 (&kf)[4], bf16x8 (&vf)[4]) {
#pragma unroll
    for (int s = 0; s < 4; ++s) kf[s] = kp[s * 64];
#pragma unroll
    for (int s = 0; s < 4; ++s) vf[s] = vp[s * 64];
    __builtin_amdgcn_sched_barrier(0);
}
__device__ __forceinline__ void flash_compute(bool domask, const bf16x8 (&kf)[4], const bf16x8 (&vf)[4], const bf16x8 (&q)[4], int x0, unsigned span, float& m, float& l, f32x16 (&O)[2]) {
    f32x16 sc;
#pragma unroll
    for (int i = 0; i < 16; ++i) sc[i] = 0.f;
    __builtin_amdgcn_s_setprio(1);
#pragma unroll
    for (int s = 0; s < 4; ++s) sc = mfma32(kf[s], q[s], sc);
    __builtin_amdgcn_s_setprio(0);
    if (domask) {
#pragma unroll
        for (int i = 0; i < 16; ++i) sc[i] = ((unsigned)(x0 + i + (i >= 8 ? 8 : 0)) <= span) ? sc[i] : -1e30f;
    }
    const float a0 = fmaxf(fmaxf(sc[0], sc[1]), sc[2]), a1 = fmaxf(fmaxf(sc[3], sc[4]), sc[5]), a2 = fmaxf(fmaxf(sc[6], sc[7]), sc[8]), a3 = fmaxf(fmaxf(sc[9], sc[10]), sc[11]), a4 = fmaxf(fmaxf(sc[12], sc[13]), sc[14]);
    float mx = fmaxf(fmaxf(fmaxf(a0, a1), fmaxf(a2, a3)), fmaxf(a4, sc[15]));
    mx = xhalf_max(mx);
    const bool upd = mx > m + SM_THR;
    if (__ballot(upd) != 0ull) {
        const float mn = upd ? mx : m, alpha = ex2(m - mn); l *= alpha; O[0] = O[0] * alpha; O[1] = O[1] * alpha; m = mn;
    }
    const float msub = (m < -1e29f) ? 0.f : m;
    const f32x16 d = sc - msub;
    float p[16], ps = 0.f;
#pragma unroll
    for (int i = 0; i < 16; ++i) { p[i] = ex2(d[i]); ps += p[i]; }
    l += ps;
    const bf16x8 pb0 = pack_p(p), pb1 = pack_p(p + 8);
    __builtin_amdgcn_s_setprio(1);
    O[0] = mfma32(vf[0], pb0, O[0]); O[1] = mfma32(vf[1], pb0, O[1]);
    O[0] = mfma32(vf[2], pb1, O[0]); O[1] = mfma32(vf[3], pb1, O[1]);
    __builtin_amdgcn_s_setprio(0);
}
template <int MODE> __device__ __forceinline__ void flash_desc(int s, const LAS unsigned* list, int base, int t, int t0, int qi, int hi, int& tile, int& x0, unsigned& span, int& vm) {
    if constexpr (MODE == 0) {
        const unsigned e = (unsigned)__builtin_amdgcn_readfirstlane((int)list[s >> 1]);
        tile = 2 * (int)(e & 0xffffu) + (s & 1);
        const bool my = ((e >> 16) >> qi) & 1u; const int up = my ? (t - 32 * tile) : -1;
        x0 = up < 0 ? 64 : 8 * hi; span = up < 0 ? 0u : (unsigned)up;
        vm = (32 * tile + 31 <= t0) ? (((e >> 16) == 0xFFu) ? 0 : 1) : 2;
    } else {
        tile = base + s; x0 = 8 * hi - (t - 511 - 32 * tile); span = 511u;
        vm = (32 * tile + 31 <= t0 && 32 * tile >= t0 + 7 - 511) ? 0 : 2;
    }
}
template <int MODE> __device__ __forceinline__ void flash_run(const bf16x8* kb, const bf16x8* vb, const bf16x8 (&q)[4], int nsteps, const LAS unsigned* list, int base, int t, int t0, int qi, int hi, float& m, float& l, f32x16 (&O)[2]) {
    if (nsteps <= 0) return;
    bf16x8 kA[4], vA[4], kB[4], vB[4], kC[4], vC[4]; int x0A, x0B, x0C, vmA, vmB, vmC; unsigned spA, spB, spC;
#define FR_LOAD(S, KF, VF, X0, SP, VM) do { int tile_; const int sn_ = ((S) < nsteps) ? (S) : nsteps - 1; flash_desc<MODE>(sn_, list, base, t, t0, qi, hi, tile_, X0, SP, VM); \
        flash_load(kb + (size_t)tile_ * 256, vb + (size_t)tile_ * 256, KF, VF); } while (0)
    FR_LOAD(0, kA, vA, x0A, spA, vmA); FR_LOAD(1, kB, vB, x0B, spB, vmB);
#pragma unroll 1
    for (int s = 0; s < nsteps; s += 3) {
        FR_LOAD(s + 2, kC, vC, x0C, spC, vmC); flash_compute(vmA != 0, kA, vA, q, x0A, spA, m, l, O); if (s + 1 >= nsteps) break;
        FR_LOAD(s + 3, kA, vA, x0A, spA, vmA); flash_compute(vmB != 0, kB, vB, q, x0B, spB, m, l, O); if (s + 2 >= nsteps) break;
        FR_LOAD(s + 4, kB, vB, x0B, spB, vmB); flash_compute(vmC != 0, kC, vC, q, x0C, spC, m, l, O);
    }
#undef FR_LOAD
}

typedef float f32x4v __attribute__((ext_vector_type(4)));
__device__ __forceinline__ f32x4v mfma16(bf16x8 a, bf16x8 b, f32x4v c) { return __builtin_amdgcn_mfma_f32_16x16x32_bf16(a, b, c, 0, 0, 0); }
__device__ __forceinline__ float xq_max(float v) { const auto r = __builtin_amdgcn_permlane16_swap(__float_as_uint(v), __float_as_uint(v), false, false); return xhalf_max(fmaxf(__uint_as_float(r[0]), __uint_as_float(r[1]))); }
__device__ __forceinline__ float xq_sum(float v) { const auto r = __builtin_amdgcn_permlane16_swap(__float_as_uint(v), __float_as_uint(v), false, false); return xhalf_sum(__uint_as_float(r[0]) + __uint_as_float(r[1])); }
__device__ __forceinline__ void flash16_load(const bf16x8* kp, const bf16x8* vp, bf16x8 (&kf)[4], bf16x8 (&vf)[4]) {
#pragma unroll
    for (int s = 0; s < 4; ++s) kf[s] = kp[s * 64];
#pragma unroll
    for (int s = 0; s < 4; ++s) vf[s] = vp[s * 64];
    __builtin_amdgcn_sched_barrier(0);
}
__device__ __forceinline__ void flash16_compute(bool domask, const bf16x8 (&kf)[4], const bf16x8 (&vf)[4], const bf16x8 (&q)[2], int x0, unsigned span, float& m, float& l, f32x4v (&O)[4]) {
    f32x4v s0 = {0.f, 0.f, 0.f, 0.f}, s1 = {0.f, 0.f, 0.f, 0.f};
    __builtin_amdgcn_s_setprio(1);
    s0 = mfma16(kf[0], q[0], s0); s1 = mfma16(kf[2], q[0], s1);
    s0 = mfma16(kf[1], q[1], s0); s1 = mfma16(kf[3], q[1], s1);
    __builtin_amdgcn_s_setprio(0);
    float sc[8] = {s0[0], s0[1], s0[2], s0[3], s1[0], s1[1], s1[2], s1[3]};
    if (domask) {
#pragma unroll
        for (int j = 0; j < 8; ++j) sc[j] = ((unsigned)(x0 + j) <= span) ? sc[j] : -1e30f;
    }
    float mx = fmaxf(fmaxf(fmaxf(sc[0], sc[1]), fmaxf(sc[2], sc[3])), fmaxf(fmaxf(sc[4], sc[5]), fmaxf(sc[6], sc[7])));
    mx = xq_max(mx);
    const bool upd = mx > m + SM_THR;
    if (__ballot(upd) != 0ull) {
        const float mn = upd ? mx : m, alpha = ex2(m - mn); l *= alpha;
#pragma unroll
        for (int dt = 0; dt < 4; ++dt) O[dt] = O[dt] * alpha;
        m = mn;
    }
    const float msub = (m < -1e29f) ? 0.f : m;
    float p[8], ps = 0.f;
#pragma unroll
    for (int j = 0; j < 8; ++j) { p[j] = ex2(sc[j] - msub); ps += p[j]; }
    l += ps;
    const bf16x8 pb = pack_p(p);
    __builtin_amdgcn_s_setprio(1);
#pragma unroll
    for (int dt = 0; dt < 4; ++dt) O[dt] = mfma16(vf[dt], pb, O[dt]);
    __builtin_amdgcn_s_setprio(0);
}
__device__ __forceinline__ unsigned flash16_entry(int s, const LAS unsigned* list) {
    const unsigned e = (unsigned)__builtin_amdgcn_readfirstlane((int)list[s >> 1]);
    return (e & 0xffff0000u) | (2u * (e & 0xffffu) + (unsigned)(s & 1));
}
__device__ __forceinline__ void flash16_run(const bf16x8* kb, const bf16x8* vb, const bf16x8 (&qa)[2], const bf16x8 (&qb)[2], int nsteps, const LAS unsigned* list, int tq, int t0, int qi4, int fq,
                                            float& ma, float& la, f32x4v (&Oa)[4], float& mb, float& lb, f32x4v (&Ob)[4]) {
    if (nsteps <= 0) return;
    bf16x8 kA[4], vA[4], kB[4], vB[4], kC[4], vC[4]; unsigned eA, eB, eC;
#define F16_LOAD(S, KF, VF, E) do { const int sn_ = ((S) < nsteps) ? (S) : nsteps - 1; E = flash16_entry(sn_, list); const size_t go_ = (size_t)(E & 0xffffu) * 256; \
        flash16_load(kb + go_, vb + go_, KF, VF); } while (0)
#define F16_COMP(KF, VF, E) do { const int grp_ = (int)(E & 0xffffu); const unsigned na_ = (E >> 16) & 0xFu, nb_ = E >> 20; const bool past_ = 32 * grp_ + 31 <= t0; \
        if (na_) { const int up_ = ((na_ >> qi4) & 1u) ? (tq - 32 * grp_) : -1; flash16_compute(!(past_ && na_ == 0xFu), KF, VF, qa, up_ < 0 ? 64 : 8 * fq, up_ < 0 ? 0u : (unsigned)up_, ma, la, Oa); } \
        if (nb_) { const int up_ = ((nb_ >> qi4) & 1u) ? (tq + 4 - 32 * grp_) : -1; flash16_compute(!(past_ && nb_ == 0xFu), KF, VF, qb, up_ < 0 ? 64 : 8 * fq, up_ < 0 ? 0u : (unsigned)up_, mb, lb, Ob); } } while (0)
    F16_LOAD(0, kA, vA, eA); F16_LOAD(1, kB, vB, eB);
#pragma unroll 1
    for (int s = 0; s < nsteps; s += 3) {
        F16_LOAD(s + 2, kC, vC, eC); F16_COMP(kA, vA, eA); if (s + 1 >= nsteps) break;
        F16_LOAD(s + 3, kA, vA, eA); F16_COMP(kB, vB, eB); if (s + 2 >= nsteps) break;
        F16_LOAD(s + 4, kB, vB, eB); F16_COMP(kC, vC, eC);
    }
#undef F16_LOAD
#undef F16_COMP
}

__device__ __forceinline__ unsigned wave_max_u32(unsigned v) {
#define DPP_U(v, ctrl) ((unsigned)__builtin_amdgcn_update_dpp(0, (int)(v), ctrl, 0xF, 0xF, true))
    { unsigned t = DPP_U(v, 0xB1); v = v > t ? v : t; t = DPP_U(v, 0x4E); v = v > t ? v : t; t = DPP_U(v, 0x141); v = v > t ? v : t; t = DPP_U(v, 0x140); v = v > t ? v : t; }
#undef DPP_U
    { const auto r = __builtin_amdgcn_permlane16_swap(v, v, false, false); v = r[0] > r[1] ? r[0] : r[1]; }
    { const auto r = __builtin_amdgcn_permlane32_swap(v, v, false, false); v = r[0] > r[1] ? r[0] : r[1]; }
    return v;
}

__device__ __forceinline__ void nsa_tile(const Ctx& C, int b, int g, int t0) {
    const bf16_t* P = (const bf16_t*)(C.ws + WS_R1); bf16_t* Y = (bf16_t*)(C.ws + WS_Y);
    int lane_ = C.lane; asm volatile("" : "+v"(lane_));
    const int lane = lane_, r = lane & 31, hi = lane >> 5, qi = r >> 2, h = r & 3, head = g * 4 + h, bg = b * 2 + g;
    const int t = t0 + qi; const size_t tok = (size_t)b * S_ + t;
    LAS float* imp = (LAS float*)(C.lds + C.wave * 16640);
    LAS float* ost = (LAS float*)(C.lds + C.wave * 16640 + 8448) + lane;
    const float QS = 0.18033688011112042f;
    bf16x8 qf[4];
    {
        const bf16_t* qp = P + tok * PP + PC_Q + head * 64;
#pragma unroll
        for (int s = 0; s < 4; ++s) qf[s] = scale_q(*(const u32x4*)(qp + 16 * s + 8 * hi), QS);
    }
    const bf16_t* gp = P + tok * PP + PC_NG + head * 3;
    const float gc = sigm(bf1(gp[0])), gs = sigm(bf1(gp[1])), gw = sigm(bf1(gp[2]));

    const int cur = t0 >> 6;
    {
        const int nvq = (t >= 31) ? ((t - 31) >> 4) + 1 : 0;
        const int nvmin = (t0 >= 31) ? ((t0 - 31) >> 4) + 1 : 0;
        const int tl = t0 + 7, nvmax = (tl >= 31) ? ((tl - 31) >> 4) + 1 : 0, ntile = (nvmax + 31) >> 5;
        const bf16x8* kb = (const bf16x8*)(C.ws + WS_KCMP) + (size_t)bg * 32 * 4 * 64 + lane;
        const bf16x8* vb = (const bf16x8*)(C.ws + WS_VCMP) + (size_t)bg * 64 * 2 * 64 + lane;
        float m1 = -1e30f, l1 = 0.f;
#define CMP_P1(KF, KT) do { \
            f32x16 sc; _Pragma("unroll") for (int i = 0; i < 16; ++i) sc[i] = 0.f; \
            _Pragma("unroll") for (int s = 0; s < 4; ++s) sc = mfma32(KF[s], qf[s], sc); \
            if (nvmin - 1 - 32 * (KT) < 31) {     \
                asm volatile("" ::: "memory"); \
                const int up = nvq - 1 - 32 * (KT); const int x0 = up < 0 ? 64 : 8 * hi; const unsigned span = up < 0 ? 0u : (unsigned)up; \
                _Pragma("unroll") for (int i = 0; i < 16; ++i) sc[i] = ((unsigned)(x0 + i + (i >= 8 ? 8 : 0)) <= span) ? sc[i] : -1e30f; } \
            float mx = -1e30f; _Pragma("unroll") for (int i = 0; i < 16; ++i) mx = fmaxf(mx, sc[i]); \
            mx = xhalf_max(mx); \
            const float mn = fmaxf(m1, mx), msub = (mn < -1e29f) ? 0.f : mn; float ps = 0.f;     \
            _Pragma("unroll") for (int i = 0; i < 16; ++i) ps += ex2(sc[i] - msub); \
            l1 = l1 * ex2(m1 - mn) + ps; m1 = mn; } while (0)
        if (ntile > 0) {
            bf16x8 kA[4], kB[4], kC[4], kD[4];
#define CMP_LDK(KF, KT) do { const int kn_ = ((KT) < ntile) ? (KT) : ntile - 1; _Pragma("unroll") for (int s = 0; s < 4; ++s) KF[s] = kb[kn_ * 256 + s * 64]; } while (0)
            CMP_LDK(kA, 0); CMP_LDK(kB, 1); CMP_LDK(kC, 2);
#pragma unroll 1
            for (int kt = 0; kt < ntile; kt += 4) {
                CMP_LDK(kD, kt + 3); __builtin_amdgcn_sched_barrier(0); CMP_P1(kA, kt);     if (kt + 1 >= ntile) break;
                CMP_LDK(kA, kt + 4); __builtin_amdgcn_sched_barrier(0); CMP_P1(kB, kt + 1); if (kt + 2 >= ntile) break;
                CMP_LDK(kB, kt + 5); __builtin_amdgcn_sched_barrier(0); CMP_P1(kC, kt + 2); if (kt + 3 >= ntile) break;
                CMP_LDK(kC, kt + 6); __builtin_amdgcn_sched_barrier(0); CMP_P1(kD, kt + 3);
            }
        }
#undef CMP_P1
        l1 = xhalf_sum(l1);
        const float inv = 1.f / fmaxf(l1, 1e-30f), m1sub = (m1 < -1e29f) ? 0.f : m1;
        for (int e = lane; e < 8 * 264; e += 64) imp[e] = 0.f;
        LDS_WAIT();
        f32x16 O[2];
#pragma unroll
        for (int i = 0; i < 16; ++i) { O[0][i] = 0.f; O[1][i] = 0.f; }
#define CMP_P2(KF, VF, KT) do { \
            f32x16 sc; _Pragma("unroll") for (int i = 0; i < 16; ++i) sc[i] = 0.f; \
            _Pragma("unroll") for (int s = 0; s < 4; ++s) sc = mfma32(KF[s], qf[s], sc); \
            if (nvmin - 1 - 32 * (KT) < 31) { \
                asm volatile("" ::: "memory"); \
                const int up = nvq - 1 - 32 * (KT); const int x0 = up < 0 ? 64 : 8 * hi; const unsigned span = up < 0 ? 0u : (unsigned)up; \
                _Pragma("unroll") for (int i = 0; i < 16; ++i) sc[i] = ((unsigned)(x0 + i + (i >= 8 ? 8 : 0)) <= span) ? sc[i] : -1e30f; } \
            float p[16]; \
            _Pragma("unroll") for (int i = 0; i < 16; ++i) p[i] = ex2(sc[i] - m1sub) * inv; \
            _Pragma("unroll") for (int rr = 0; rr < 2; ++rr) { \
                const float* q8 = p + 8 * rr; \
                float a = q8[0] + q8[1] + q8[2] + 0.5f * q8[3], bq = 0.5f * q8[3] + q8[4] + q8[5] + q8[6] + 0.5f * q8[7], cq = 0.5f * q8[7]; \
                a += dpp_xor1(a); a += dpp_xor2(a); bq += dpp_xor1(bq); bq += dpp_xor2(bq); cq += dpp_xor1(cq); cq += dpp_xor2(cq); \
                _Pragma("unroll") for (int hh = 0; hh < 2; ++hh)     \
                if (h == 0 && hi == hh) { LAS float* ip = imp + qi * 264 + 8 * (KT) + 2 * hi + 4 * rr; \
                    __hip_atomic_fetch_add(ip, a, __ATOMIC_RELAXED, __HIP_MEMORY_SCOPE_WORKGROUP); __hip_atomic_fetch_add(ip + 1, bq, __ATOMIC_RELAXED, __HIP_MEMORY_SCOPE_WORKGROUP); \
                    __hip_atomic_fetch_add(ip + 2, cq, __ATOMIC_RELAXED, __HIP_MEMORY_SCOPE_WORKGROUP); } \
            } \
            const bf16x8 pb0 = pack_p(p), pb1 = pack_p(p + 8); \
            O[0] = mfma32(VF[0], pb0, O[0]); O[1] = mfma32(VF[1], pb0, O[1]); \
            O[0] = mfma32(VF[2], pb1, O[0]); O[1] = mfma32(VF[3], pb1, O[1]); } while (0)
        if (ntile > 0) {
            bf16x8 kA[4], kB[4], kC[4], vA[4];
#define CMP_LDV(KT) do { _Pragma("unroll") for (int s = 0; s < 4; ++s) vA[s] = vb[(KT) * 256 + s * 64]; } while (0)
            CMP_LDK(kA, 0); CMP_LDK(kB, 1);
#pragma unroll 1
            for (int kt = 0; kt < ntile; kt += 3) {
                CMP_LDK(kC, kt + 2); CMP_LDV(kt);     __builtin_amdgcn_sched_barrier(0); CMP_P2(kA, vA, kt);     if (kt + 1 >= ntile) break;
                CMP_LDK(kA, kt + 3); CMP_LDV(kt + 1); __builtin_amdgcn_sched_barrier(0); CMP_P2(kB, vA, kt + 1); if (kt + 2 >= ntile) break;
                CMP_LDK(kB, kt + 4); CMP_LDV(kt + 2); __builtin_amdgcn_sched_barrier(0); CMP_P2(kC, vA, kt + 2);
            }
#undef CMP_LDV
#undef CMP_LDK
        }
#undef CMP_P2
#pragma unroll
        for (int i = 0; i < 16; ++i) { ost[i * 64] = gc * O[0][i]; ost[(16 + i) * 64] = gc * O[1][i]; }
        LDS_WAIT();
    }

    unsigned bmv[4];
    if (cur <= 15) {
#pragma unroll
        for (int c = 0; c < 4; ++c) bmv[c] = (lane + 64 * c <= cur) ? 0xFFu : 0u;
    } else {
        unsigned key[8][4];
#pragma unroll
        for (int q2 = 0; q2 < 8; ++q2)
#pragma unroll
            for (int c = 0; c < 4; ++c) { const int j = lane + 64 * c; const bool cand = (j >= 1) && (j < cur - 1); const float v = imp[q2 * 264 + j];
                key[q2][c] = cand ? ((__float_as_uint(v) & 0xFFFFFF00u) | (unsigned)(255 - j)) : 0u; }
#pragma unroll
        for (int c = 0; c < 4; ++c) bmv[c] = 0u;
#pragma unroll 1
        for (int round = 0; round < 13; ++round) {
#pragma unroll
            for (int q2 = 0; q2 < 8; ++q2) {
                unsigned mx = key[q2][0]; mx = mx > key[q2][1] ? mx : key[q2][1]; mx = mx > key[q2][2] ? mx : key[q2][2]; mx = mx > key[q2][3] ? mx : key[q2][3];
                const unsigned w = wave_max_u32(mx);
#pragma unroll
                for (int c = 0; c < 4; ++c) { const bool win = (key[q2][c] == w) && (w != 0u); key[q2][c] = win ? 0u : key[q2][c]; bmv[c] |= win ? (1u << q2) : 0u; }
            }
        }
#pragma unroll
        for (int c = 0; c < 4; ++c) { const int j = lane + 64 * c; if (j == 0 || j == cur || j == cur - 1) bmv[c] = 0xFFu; }
    }

    {
        LAS unsigned* list = (LAS unsigned*)imp;
        LAS float* ostb = (LAS float*)(C.lds + C.wave * 16640 + 8448);
        const int q16 = lane & 15, fq = lane >> 4, qi4 = q16 >> 2, head4 = g * 4 + (q16 & 3);
        const bf16x8* kb = (const bf16x8*)(C.ws + WS_KSLC) + (size_t)bg * 512 * 256 + lane;
        const bf16x8* vb = (const bf16x8*)(C.ws + WS_VSLC) + (size_t)bg * 512 * 256 + lane;
        int nblk = 0;
#pragma unroll
        for (int c = 0; c < 4; ++c) {
            const unsigned long long mk = __ballot(bmv[c] != 0u);
            const int pos = nblk + (int)__builtin_amdgcn_mbcnt_hi((unsigned)(mk >> 32), __builtin_amdgcn_mbcnt_lo((unsigned)mk, 0u));
            if (bmv[c] != 0u) list[pos] = (unsigned)(lane + 64 * c) | (bmv[c] << 16);
            nblk += __builtin_popcountll(mk);
        }
        LDS_WAIT();
        const int tq = t0 + qi4;
        bf16x8 q16f[2][2]; float gs4[2];
#pragma unroll
        for (int sub = 0; sub < 2; ++sub) {
            const size_t tok4 = (size_t)b * S_ + tq + 4 * sub;
            const bf16_t* qp = P + tok4 * PP + PC_Q + head4 * 64;
            q16f[sub][1] = scale_q(*(const u32x4*)(qp + 32 + 8 * fq), QS);
            const u32x4 mv4 = *(const u32x4*)(qp + 8 * fq), pv4 = *(const u32x4*)(qp + 8 * ((fq ^ 1) & 1));
            const float* rt = (const float*)(C.ws + WS_ROPE) + tok4 * 16;
            const f32x4 ca = *(const f32x4*)rt, cb2 = *(const f32x4*)(rt + 4), sa = *(const f32x4*)(rt + 8), sb = *(const f32x4*)(rt + 12);
            const float cs[8] = {ca.x, ca.y, ca.z, ca.w, cb2.x, cb2.y, cb2.z, cb2.w}, sn[8] = {sa.x, sa.y, sa.z, sa.w, sb.x, sb.y, sb.z, sb.w};
            const float mv[8] = {bf_lo(mv4.x), bf_hi(mv4.x), bf_lo(mv4.y), bf_hi(mv4.y), bf_lo(mv4.z), bf_hi(mv4.z), bf_lo(mv4.w), bf_hi(mv4.w)};
            const float pp[8] = {bf_lo(pv4.x), bf_hi(pv4.x), bf_lo(pv4.y), bf_hi(pv4.y), bf_lo(pv4.z), bf_hi(pv4.z), bf_lo(pv4.w), bf_hi(pv4.w)};
            const bool roped = fq < 2; const float sg = (fq == 0) ? -1.f : 1.f; float o[8];
#pragma unroll
            for (int e = 0; e < 8; ++e) o[e] = (roped ? (mv[e] * cs[e] + sg * pp[e] * sn[e]) : mv[e]) * QS;
            q16f[sub][0] = pack_p(o);
            gs4[sub] = sigm(bf1(P[tok4 * PP + PC_NG + head4 * 3 + 1]));
        }
        float ma = -1e30f, la = 0.f, mb = -1e30f, lb = 0.f; f32x4v Oa[4], Ob[4];
#pragma unroll
        for (int dt = 0; dt < 4; ++dt) { Oa[dt] = (f32x4v){0.f, 0.f, 0.f, 0.f}; Ob[dt] = (f32x4v){0.f, 0.f, 0.f, 0.f}; }
        flash16_run(kb, vb, q16f[0], q16f[1], 2 * nblk, list, tq, t0, qi4, fq, ma, la, Oa, mb, lb, Ob);
        la = xq_sum(la); lb = xq_sum(lb);
        const float sca = gs4[0] / fmaxf(la, 1e-30f), scb = gs4[1] / fmaxf(lb, 1e-30f);
#pragma unroll
        for (int dt = 0; dt < 4; ++dt)
#pragma unroll
            for (int i = 0; i < 4; ++i) { LAS float* op = ostb + ((dt >> 1) * 16 + 4 * (2 * (dt & 1) + (fq >> 1)) + i) * 64 + q16 + 32 * (fq & 1); op[0] += sca * Oa[dt][i]; op[16] += scb * Ob[dt][i]; }
        LDS_WAIT();
    }
    {
        bf16x8 qr[4];
        {
            const bf16_t* qp = P + tok * PP + PC_Q + head * 64;
#pragma unroll
            for (int s = 1; s < 4; ++s) qr[s] = scale_q(*(const u32x4*)(qp + 16 * s + 8 * hi), QS);
            const u32x4 mv4 = *(const u32x4*)(qp + 8 * hi), pv4 = *(const u32x4*)(qp + 8 * (hi ^ 1));
            const float* rt = (const float*)(C.ws + WS_ROPE) + tok * 16;
            const f32x4 ca = *(const f32x4*)rt, cb2 = *(const f32x4*)(rt + 4), sa = *(const f32x4*)(rt + 8), sb = *(const f32x4*)(rt + 12);
            const float cs[8] = {ca.x, ca.y, ca.z, ca.w, cb2.x, cb2.y, cb2.z, cb2.w}, sn[8] = {sa.x, sa.y, sa.z, sa.w, sb.x, sb.y, sb.z, sb.w};
            const float mv[8] = {bf_lo(mv4.x), bf_hi(mv4.x), bf_lo(mv4.y), bf_hi(mv4.y), bf_lo(mv4.z), bf_hi(mv4.z), bf_lo(mv4.w), bf_hi(mv4.w)};
            const float pp[8] = {bf_lo(pv4.x), bf_hi(pv4.x), bf_lo(pv4.y), bf_hi(pv4.y), bf_lo(pv4.z), bf_hi(pv4.z), bf_lo(pv4.w), bf_hi(pv4.w)};
            const float sg = hi ? 1.f : -1.f; float o[8];
#pragma unroll
            for (int e = 0; e < 8; ++e) o[e] = (mv[e] * cs[e] + sg * pp[e] * sn[e]) * QS;
            qr[0] = pack_p(o);
        }
        const bf16x8* kb = (const bf16x8*)(C.ws + WS_KWIN) + (size_t)bg * 512 * 4 * 64 + lane;
        const bf16x8* vb = (const bf16x8*)(C.ws + WS_VWIN) + (size_t)bg * 1024 * 2 * 64 + lane;
        float m = -1e30f, l = 0.f; f32x16 O[2];
#pragma unroll
        for (int i = 0; i < 16; ++i) { O[0][i] = 0.f; O[1][i] = 0.f; }
        const int tlo = (t0 - 511 > 0 ? t0 - 511 : 0) >> 5, thi = (t0 + 7) >> 5;
        flash_run<1>(kb, vb, qr, thi - tlo + 1, (const LAS unsigned*)imp, tlo, t, t0, qi, hi, m, l, O);
        l = xhalf_sum(l);
        const float sc = gw / fmaxf(l, 1e-30f);
        bf16_t* yp = Y + tok * YP + 512 + head * 64 + 4 * hi;
#pragma unroll
        for (int dt = 0; dt < 2; ++dt)
#pragma unroll
            for (int ig = 0; ig < 4; ++ig) { float o4[4];
#pragma unroll
                for (int e = 0; e < 4; ++e) o4[e] = ost[(dt * 16 + 4 * ig + e) * 64] + sc * O[dt][4 * ig + e];
                u32x2 w; w.x = cvt_pk_bf16(o4[0], o4[1]); w.y = cvt_pk_bf16(o4[2], o4[3]); *(u32x2*)(yp + 32 * dt + 8 * ig) = w; }
        LDS_WAIT();
    }
}

__device__ __forceinline__ void mem_tile(const Ctx& C, int b, int hm, int t0) {
    const bf16_t* P = (const bf16_t*)(C.ws + WS_R1); bf16_t* Y = (bf16_t*)(C.ws + WS_Y);
    int lane_ = C.lane; asm volatile("" : "+v"(lane_));
    const int lane = lane_, r = lane & 31, hi = lane >> 5;
    const size_t tok = (size_t)b * S_ + t0 + r;
    const float QS = 0.12751743082459868f;
    bf16x8 q[8];
    const bf16_t* qp = P + tok * PP + PC_QM + hm * 128;
#pragma unroll
    for (int s = 0; s < 8; ++s) q[s] = scale_q(*(const u32x4*)(qp + 16 * s + 8 * hi), QS);
    const bf16x8* kb = (const bf16x8*)(C.ws + WS_MEMK) + (size_t)(b * 4 + hm) * 8 * 8 * 64 + lane;
    const bf16x8* vb = (const bf16x8*)(C.ws + WS_MEMV) + (size_t)(b * 4 + hm) * 16 * 4 * 64 + lane;
    float m = -1e30f, l = 0.f; f32x16 O[4];
#pragma unroll
    for (int i = 0; i < 16; ++i) { O[0][i] = 0.f; O[1][i] = 0.f; O[2][i] = 0.f; O[3][i] = 0.f; }
#define MEM_STEP(KF, VF) do { \
        f32x16 sc; _Pragma("unroll") for (int i = 0; i < 16; ++i) sc[i] = 0.f; \
        _Pragma("unroll") for (int s = 0; s < 8; ++s) sc = mfma32(KF[s], q[s], sc); \
        float mx = -1e30f; _Pragma("unroll") for (int i = 0; i < 16; ++i) mx = fmaxf(mx, sc[i]); \
        mx = xhalf_max(mx); \
        const bool upd = mx > m + SM_THR; \
        if (__ballot(upd) != 0ull) { const float mn = upd ? mx : m, alpha = ex2(m - mn); l *= alpha; O[0] = O[0] * alpha; O[1] = O[1] * alpha; O[2] = O[2] * alpha; O[3] = O[3] * alpha; m = mn; } \
        float p[16], ps = 0.f; _Pragma("unroll") for (int i = 0; i < 16; ++i) { p[i] = ex2(sc[i] - m); ps += p[i]; } \
        l += ps; \
        const bf16x8 pb0 = pack_p(p), pb1 = pack_p(p + 8); \
        _Pragma("unroll") for (int dt = 0; dt < 4; ++dt) { O[dt] = mfma32(VF[dt], pb0, O[dt]); O[dt] = mfma32(VF[4 + dt], pb1, O[dt]); } } while (0)
    {
        bf16x8 kA[8], vv[8];
#pragma unroll 1
        for (int kt = 0; kt < 8; ++kt) {
#pragma unroll
            for (int s = 0; s < 8; ++s) kA[s] = kb[kt * 512 + s * 64];
#pragma unroll
            for (int s = 0; s < 8; ++s) vv[s] = vb[kt * 512 + s * 64];
            __builtin_amdgcn_sched_barrier(0);
            MEM_STEP(kA, vv);
        }
    }
#undef MEM_STEP
    l = xhalf_sum(l);
    const float inv = 1.f / l;
    bf16_t* yp = Y + tok * YP + 1024 + hm * 128 + 4 * hi;
#pragma unroll
    for (int dt = 0; dt < 4; ++dt)
#pragma unroll
        for (int ig = 0; ig < 4; ++ig) { u32x2 w; w.x = cvt_pk_bf16(O[dt][4 * ig] * inv, O[dt][4 * ig + 1] * inv); w.y = cvt_pk_bf16(O[dt][4 * ig + 2] * inv, O[dt][4 * ig + 3] * inv); *(u32x2*)(yp + 32 * dt + 8 * ig) = w; }
}

__device__ __forceinline__ void attention_phase(const Ctx& C) {
    const int bxx = C.gw / NWAVES; const bool xmode = (C.G & 7) == 0;
    const int x = bxx & 7, rank = xmode ? (bxx >> 3) * NWAVES + C.wave : C.gw, nrank = xmode ? (C.G >> 3) * NWAVES : C.NGW, nitem = xmode ? 1536 : 12288;
    for (int i = rank; i < nitem; i += nrank) {
        int nsa_n, mem_e;
        if (xmode) { nsa_n = (i < 1024) ? (x >> 1) * 2048 + 2 * i + (x & 1) : -1; mem_e = x * 512 + (i - 1024); }
        else { if (i < 8192) { const int k = i >> 11, w = i & 2047; nsa_n = k * 2048 + ((k & 1) ? 2047 - w : w); } else nsa_n = -1; mem_e = i - 8192; }
        if (nsa_n >= 0) { const int k = nsa_n >> 11; nsa_tile(C, k >> 1, k & 1, (nsa_n & 2047) * 8); }
        else { const int bh = mem_e >> 9; mem_tile(C, bh >> 2, bh & 3, (mem_e & 511) * 32); }
    }
}

#define XB_TMO      128
#define XB_XCNT(j)  (256  + 64 * (j))
#define XB_XSUB(j)  (1280 + 64 * (j))
#define XB_XGEN(j)  (2304 + 64 * (j))
#define XB_TOP      3328
#define XB_TOPGEN   3392
#define XCD_BAR_WORDS 3456
#define XB_SPIN_CAP (1u << 18)
__device__ __forceinline__ unsigned xb_ld(unsigned* p)              { return __hip_atomic_load(p, __ATOMIC_RELAXED, __HIP_MEMORY_SCOPE_AGENT); }
__device__ __forceinline__ unsigned xb_add(unsigned* p, unsigned v) { return __hip_atomic_fetch_add(p, v, __ATOMIC_RELAXED, __HIP_MEMORY_SCOPE_AGENT); }
__device__ __forceinline__ unsigned xb_xcc_id() { return (unsigned)__builtin_amdgcn_s_getreg((3 << 11) | 20) & 0xFu; }
#define XB_SPIN(cond, bar) do { unsigned _sp = 0; while (cond) { __builtin_amdgcn_s_sleep(1); \
    if ((++_sp & 255u) == 0u) { if (xb_ld(&(bar)[XB_TMO])) break; if (_sp > XB_SPIN_CAP) { atomicAdd(&(bar)[XB_TMO], 1u); break; } } } } while (0)
__device__ __forceinline__ void xcd_barrier_complete(unsigned* bar, unsigned x, unsigned& nloc, unsigned& nx) {
    const unsigned G = gridDim.x * gridDim.y * gridDim.z;
    unsigned sum, cnt, mine, sp = 0u;
    for (;;) {
        sum = 0u; cnt = 0u; mine = 0u;
#pragma unroll
        for (unsigned j = 0; j < 16; ++j) { const unsigned c = xb_ld(&bar[XB_XCNT(j)]); sum += c; cnt += (c > 0u) ? 1u : 0u; mine = (j == x) ? c : mine; }
        if (sum == G) break;
        __builtin_amdgcn_s_sleep(1);
        if ((++sp & 255u) == 0u) { if (xb_ld(&bar[XB_TMO])) break; if (sp > XB_SPIN_CAP) { atomicAdd(&bar[XB_TMO], 1u); break; } }
    }
    nloc = mine > 0u ? mine : 1u; nx = cnt > 0u ? cnt : 1u;
}
__device__ __forceinline__ void xcd_barrier(unsigned* bar, volatile LAS unsigned* st, bool tid0) {
    asm volatile("s_waitcnt vmcnt(0)" ::: "memory");
    __syncthreads();
    if (tid0) {
        __builtin_amdgcn_s_waitcnt(0);
        const unsigned x = xb_xcc_id();
        unsigned nloc = st[0], nx = st[1];
        if (nloc == 0u) { xcd_barrier_complete(bar, x, nloc, nx); st[0] = nloc; st[1] = nx; }
        const unsigned old = xb_add(&bar[XB_XSUB(x)], 1u);
        const unsigned gen = old / nloc;
        if (old + 1u == (gen + 1u) * nloc) {
            __builtin_amdgcn_fence(__ATOMIC_RELEASE, "agent");
            asm volatile("s_waitcnt vmcnt(0)" ::: "memory");
            const unsigned og = xb_add(&bar[XB_TOP], 1u);
            const unsigned tg = og / nx;
            if (og + 1u == (tg + 1u) * nx) xb_add(&bar[XB_TOPGEN], 1u);
            else XB_SPIN(xb_ld(&bar[XB_TOPGEN]) == tg, bar);
            __builtin_amdgcn_fence(__ATOMIC_ACQUIRE, "agent");
            xb_add(&bar[XB_XGEN(x)], 1u);
            asm volatile("s_waitcnt vmcnt(0)" ::: "memory");
        } else {
            XB_SPIN(xb_ld(&bar[XB_XGEN(x)]) == gen, bar);
            __builtin_amdgcn_fence(__ATOMIC_ACQUIRE, "agent");
            asm volatile("s_waitcnt vmcnt(0)" ::: "memory");
        }
    }
    __syncthreads();
}

constexpr int LDS_BYTES = 147456, XB_LDS_OFF = 147456 - 64;
constexpr int NPHASE = 1 + 2 * 14;

__global__ void __launch_bounds__(NWAVES * 64, 2) fwd_kernel(Args args) {
    extern __shared__ __attribute__((aligned(16))) unsigned char lds_raw[];
    cg::grid_group grid = cg::this_grid();
    if (args.ph_lo == 0x7fffffff) grid.sync();
    const int wave0 = __builtin_amdgcn_readfirstlane((int)threadIdx.x >> 6);
    {
        volatile LAS unsigned* st = (volatile LAS unsigned*)(lds_raw + XB_LDS_OFF);
        if (threadIdx.x == 0) { st[0] = 0u; st[1] = 0u; (void)xb_add((unsigned*)(args.ws + WS_BAR) + XB_XCNT(xb_xcc_id()), 1u); }
        __syncthreads();
    }
#define PHASE_BEGIN { \
        unsigned char* ws0_ = args.ws; asm volatile("" : "+s"(ws0_)); gu8* ws = (gu8*)ws0_;     \
        int tid_; asm volatile("v_mbcnt_lo_u32_b32 %0, -1, 0\n\tv_mbcnt_hi_u32_b32 %0, -1, %0" : "=v"(tid_)); tid_ += wave0 * 64; \
        Ctx C; C.a = &args; C.ws = ws; C.lds = (LAS unsigned char*)lds_raw; C.tid = tid_; C.lane = tid_ & 63; C.wave = __builtin_amdgcn_readfirstlane(tid_ >> 6); \
        int bx = blockIdx.x; asm volatile("" : "+s"(bx)); C.G = gridDim.x; C.gw = bx * NWAVES + C.wave; C.NGW = C.G * NWAVES; \
        bf16_t* const H = (bf16_t*)(ws + WS_H); bf16_t* const R1 = (bf16_t*)(ws + WS_R1); bf16_t* const Y = (bf16_t*)(ws + WS_Y); (void)H; (void)R1; (void)Y; (void)bx;
#define PHASE_END   { int ln_; asm volatile("v_mbcnt_lo_u32_b32 %0, -1, 0\n\tv_mbcnt_hi_u32_b32 %0, -1, %0" : "=v"(ln_));   \
        xcd_barrier((unsigned*)(ws + WS_BAR), (volatile LAS unsigned*)(lds_raw + XB_LDS_OFF), (wave0 == 0) && (ln_ == 0)); } }
#define PHASE_END_IF(c_) { if (c_) { int ln_; asm volatile("v_mbcnt_lo_u32_b32 %0, -1, 0\n\tv_mbcnt_hi_u32_b32 %0, -1, %0" : "=v"(ln_));   \
        xcd_barrier((unsigned*)(ws + WS_BAR), (volatile LAS unsigned*)(lds_raw + XB_LDS_OFF), (wave0 == 0) && (ln_ == 0)); } } }
#define PHASE_END_CG grid.sync(); }

    PHASE_BEGIN
        convert_layer(C, 0);
        rope_table(C);
        prenorm_rows(C, (const float*)args.in[0], (const float*)args.in[3], H);
    PHASE_END

#pragma unroll 1
    for (int l = 0; l < 2; ++l) {
        PHASE_BEGIN
            { pg8::GemmDesc g{(const char*)H, (const char*)(ws + WS_W1IN), DM, DM, 128, 128, 16}; pg8::StdOrder S; S.init(T_, 2 * FF, C.G, bx, DM, DM);
              pg8::Epi<1> E{R1, FF, nullptr, nullptr}; pg8::gemm_phase(C.lds, C.tid, g, S, E); }
        PHASE_END
        PHASE_BEGIN
            { pg8::GemmDesc g{(const char*)R1, (const char*)(ws + WS_W1OUT), FF, FF, 128, 128, 44}; pg8::StdOrder S; S.init(T_, DM, C.G, bx, FF, FF);
              pg8::Epi<0> E{H, DM, nullptr, nullptr}; pg8::gemm_phase(C.lds, C.tid, g, S, E); }
        PHASE_END
        PHASE_BEGIN
            if (bx < 8) {
                { pg8::GemmDesc g{(const char*)(ws + WS_MEMN), (const char*)(ws + WS_WMKV), DM, DM, 128, 128, 16}; pg8::StdOrder S; S.init(512, DM, C.G, bx, DM, DM);
              pg8::Epi<0> E{(bf16_t*)(ws + WS_MKV), DM, nullptr, nullptr}; pg8::gemm_phase(C.lds, C.tid, g, S, E); }
            } else {
                norm_phase(C, C.gw - 8 * NWAVES, C.NGW - 8 * NWAVES, l == 0 ? (const float*)args.in[0] : args.out, args.out, H, H, INF(4, l, DM), INF(7, l, DM), 0.5f);
            }
            cb_reduce(C, l);
        PHASE_END
        PHASE_BEGIN
            { pg8::GemmDesc g{(const char*)H, (const char*)(ws + WS_WMIX), DM, DM, 128, 128, 16}; pg8::StdOrder S; S.init(T_, PP, C.G, bx, DM, DM);
              pg8::Epi<0> E{R1, PP, nullptr, nullptr}; pg8::gemm_phase(C.lds, C.tid, g, S, E); }
        PHASE_END
        PHASE_BEGIN
            if (bx < 64) {
                pg8::GemmDesc g{(const char*)R1, (const char*)(ws + WS_WC1), 16 * PP, 2048, PP * 2, 128, 16}; pg8::CmpOrder S{bx};
                pg8::Epi<0> E{(bf16_t*)(ws + WS_CMPP), 256, nullptr, nullptr}; pg8::gemm_phase(C.lds, C.tid, g, S, E);
            } else {
                prep_items(C, l, C.gw - 64 * NWAVES, C.NGW - 64 * NWAVES);
                memkv_ops(C, C.gw - 64 * NWAVES, C.NGW - 64 * NWAVES);
            }
        PHASE_END
        PHASE_BEGIN
            cmp_stage2(C, l);
        PHASE_END
        PHASE_BEGIN
            attention_phase(C);
        PHASE_END
        PHASE_BEGIN
            { pg8::GemmDesc g{(const char*)H, (const char*)(ws + WS_WG), DM, DM, 128, 128, 16}; pg8::StdOrder S; S.init(T_, GP, C.G, bx, DM, DM);
              pg8::Epi<2> E{R1, GP, nullptr, nullptr}; pg8::gemm_phase(C.lds, C.tid, g, S, E); }
        PHASE_END
        PHASE_BEGIN
            { pg8::GemmDesc g{(const char*)Y, (const char*)(ws + WS_WBR), YP, YP, 128, 128, 8}; pg8::MergeOrder S; S.init(T_, DM, C.G, bx, YP, YP);
              pg8::Epi<3> E{H, DM, R1, nullptr}; pg8::gemm_phase(C.lds, C.tid, g, S, E); }
        PHASE_END
        PHASE_BEGIN
            { pg8::GemmDesc g{(const char*)H, (const char*)(ws + WS_WOUT), DM, DM, 128, 128, 16}; pg8::StdOrder S; S.init(T_, DM, C.G, bx, DM, DM);
              pg8::Epi<0> E{R1, DM, nullptr, nullptr}; pg8::gemm_phase(C.lds, C.tid, g, S, E); }
        PHASE_END
        PHASE_BEGIN
            norm_phase(C, C.gw, C.NGW, args.out, args.out, R1, H, INF(8, l, DM), INF(25, l, DM), 1.0f);
        PHASE_END
        PHASE_BEGIN
            { pg8::GemmDesc g{(const char*)H, (const char*)(ws + WS_W2IN), DM, DM, 128, 128, 16}; pg8::StdOrder S; S.init(T_, 2 * FF, C.G, bx, DM, DM);
              pg8::Epi<1> E{R1, FF, nullptr, nullptr}; pg8::gemm_phase(C.lds, C.tid, g, S, E); }
        PHASE_END
        PHASE_BEGIN
            { pg8::GemmDesc g{(const char*)R1, (const char*)(ws + WS_W2OUT), FF, FF, 128, 128, 44}; pg8::StdOrder S; S.init(T_, DM, C.G, bx, FF, FF);
              pg8::Epi<0> E{H, DM, nullptr, nullptr}; pg8::gemm_phase(C.lds, C.tid, g, S, E); }
        PHASE_END
        PHASE_BEGIN
            norm_phase(C, C.gw, C.NGW, args.out, args.out, H, H, INF(26, l, DM), l == 0 ? INF(3, 1, DM) : nullptr, 0.5f);
            if (l == 0) convert_layer(C, 1);
        PHASE_END_IF(l == 0)
    }
}

extern "C" void kernel_launch(void* const* d_in, const int* in_sizes, int n_in, void* d_out, int out_size, void* d_ws, size_t ws_size, hipStream_t stream) {
    static int grid = 0;
    if (grid == 0) {
        if (n_in != 29 || ws_size < WS_END) { fprintf(stderr, "kernel_launch: unexpected n_in %d / ws %zu\n", n_in, ws_size); grid = -1; return; }
        int dev = 0, cus = 0, per_cu = 0;
        hipGetDevice(&dev); hipDeviceGetAttribute(&cus, hipDeviceAttributeMultiprocessorCount, dev);
        hipFuncSetAttribute((const void*)fwd_kernel, hipFuncAttributeMaxDynamicSharedMemorySize, LDS_BYTES);
        hipOccupancyMaxActiveBlocksPerMultiprocessor(&per_cu, (const void*)fwd_kernel, NWAVES * 64, LDS_BYTES);
        if (per_cu < 1) per_cu = 1;
        grid = cus * per_cu;
        (void)hipGetLastError();
    }
    if (grid < 0) return;
    hipMemsetAsync((char*)d_ws + WS_BAR, 0, 16384, stream);
    Args a{};
    for (int i = 0; i < 29; ++i) a.in[i] = d_in[i];
    a.out = (float*)d_out; a.ws = (unsigned char*)d_ws; a.ph_lo = 0; a.ph_hi = NPHASE;
    void* kargs[] = {&a};
    hipError_t e = hipLaunchCooperativeKernel((const void*)fwd_kernel, dim3(grid), dim3(NWAVES * 64), kargs, LDS_BYTES, stream);
    if (e != hipSuccess) fprintf(stderr, "cooperative launch failed: %s (grid %d)\n", hipGetErrorString(e), grid);
}
```

```cpp
#include <hip/hip_runtime.h>
#include <hip/hip_cooperative_groups.h>
#include <cstdio>
#include <cstdint>
namespace cg = cooperative_groups;

#define LAS __attribute__((address_space(3)))
typedef unsigned short bf16_t;
typedef short bf16x8 __attribute__((ext_vector_type(8)));
typedef float f32x4 __attribute__((ext_vector_type(4)));
typedef float f32x16 __attribute__((ext_vector_type(16)));
typedef unsigned u32x4 __attribute__((ext_vector_type(4)));
typedef unsigned u32x2 __attribute__((ext_vector_type(2)));

constexpr int NBATCH = 2, S_ = 16384, T_ = NBATCH * S_, DM = 1024, FF = 2816, PP = 3584, GP = 3072, YP = 1536;
constexpr int NWAVES = 8;
constexpr float EPS = 1e-6f;
constexpr int PC_Q = 1536, PC_KV = 2048, PC_QM = 2816, PC_NG = 3328;

constexpr size_t MiB = 1u << 20;
constexpr size_t WS_W1IN = 0, WS_W1OUT = 11 * MiB, WS_WMIX = WS_W1OUT + 11 * MiB / 2, WS_WG = WS_WMIX + 7 * MiB, WS_WBR = WS_WG + 6 * MiB, WS_WOUT = WS_WBR + 3 * MiB,
                 WS_W2IN = WS_WOUT + 2 * MiB, WS_W2OUT = WS_W2IN + 11 * MiB, WS_WC1 = WS_W2OUT + 11 * MiB / 2  , WS_WMKV = WS_WC1 + 2 * MiB,
                 WS_MEMN = WS_WMKV + 2 * MiB, WS_MKV = WS_MEMN + 1 * MiB, WS_CB = WS_MKV + 1 * MiB  , WS_CBP = WS_CB + 8192  , WS_BAR = WS_CB + 8192 + 131072  ;
static_assert(WS_CB == 57 * MiB, "ws map");
constexpr size_t WS_ROPE = 58 * MiB, WS_MEMK = 60 * MiB, WS_MEMV = WS_MEMK + MiB / 2, WS_KCMP = 61 * MiB, WS_VCMP = WS_KCMP + MiB / 2, WS_CMPH = 62 * MiB,
                 WS_KSLC = 66 * MiB, WS_VSLC = 74 * MiB, WS_KWIN = 82 * MiB, WS_VWIN = 90 * MiB, WS_H = 98 * MiB, WS_Y = 162 * MiB, WS_R1 = 258 * MiB, WS_CMPP = 484 * MiB  , WS_END = 492 * MiB;

typedef float f32x2_t __attribute__((ext_vector_type(2)));
typedef __bf16 bf16x2_t __attribute__((ext_vector_type(2)));
__device__ __forceinline__ unsigned cvt_pk_bf16(float lo, float hi) { f32x2_t v = {lo, hi}; bf16x2_t b = __builtin_convertvector(v, bf16x2_t); return __builtin_bit_cast(unsigned, b); }
__device__ __forceinline__ float bf_lo(unsigned u) { return __uint_as_float(u << 16); }
__device__ __forceinline__ float bf_hi(unsigned u) { return __uint_as_float(u & 0xffff0000u); }
__device__ __forceinline__ float bf1(bf16_t u) { return __uint_as_float(((unsigned)u) << 16); }
__device__ __forceinline__ float ex2(float x) { return __builtin_amdgcn_exp2f(x); }
__device__ __forceinline__ float rcpf_(float x) { return __builtin_amdgcn_rcpf(x); }
__device__ __forceinline__ float sigm(float x) { return rcpf_(1.f + ex2(-1.44269504f * x)); }
__device__ __forceinline__ float gelu_tanh(float x) { const float u = 0.7978845608f * (x + 0.044715f * x * x * x); return x * rcpf_(1.f + ex2(-2.88539008f * u)); }
#define DPP_F(v, ctrl) __int_as_float(__builtin_amdgcn_update_dpp(0, __float_as_int(v), ctrl, 0xF, 0xF, true))
__device__ __forceinline__ float wave_sum(float v) {
    v += DPP_F(v, 0xB1); v += DPP_F(v, 0x4E); v += DPP_F(v, 0x141); v += DPP_F(v, 0x140);
    { const auto r = __builtin_amdgcn_permlane16_swap(__float_as_uint(v), __float_as_uint(v), false, false); v = __uint_as_float(r[0]) + __uint_as_float(r[1]); }
    { const auto r = __builtin_amdgcn_permlane32_swap(__float_as_uint(v), __float_as_uint(v), false, false); v = __uint_as_float(r[0]) + __uint_as_float(r[1]); }
    return v;
}
__device__ __forceinline__ int pi32(int r) { return (r & 0x13) | ((r & 4) << 1) | ((r & 8) >> 1); }
#define LDS_WAIT() asm volatile("s_waitcnt lgkmcnt(0)" ::: "memory")

namespace pg8 {
constexpr int BM = 256, BK = 64, HALF = 128, HTB = HALF * BK * 2, STAGE_BYTES = 8 * HTB, NXCD = 8, WGM = 8;
__device__ __forceinline__ int lds_byte(int r, int c) { const int st = (r >> 4) * 2 + (c >> 5), rr = r & 15, cc = c & 31, ob = rr * 64 + cc * 2; return st * 1024 + (ob ^ (((ob >> 9) & 1) << 5)); }
__device__ __forceinline__ void stage_rc(int b, int& R, int& C) { const int st = b / 1024, sb = b % 1024, swz = sb ^ (((sb >> 9) & 1) << 5); R = (st >> 1) * 16 + swz / 64; C = (st & 1) * 32 + (swz % 64) / 2; }
__device__ __forceinline__ int perm32(int rho) { const int n = rho >> 4, i = rho & 15; return 8 * (i >> 2) + 4 * n + (i & 3); }

struct Unit { int pm, pn, tag; long long aoff, boff; };
struct GemmDesc { const char* A; const char* Bt; int lda, ldb, kstepA, kstepB, nt; };

__device__ __forceinline__ void swz_tile(int L, int nM, int nN, int& pm, int& pn) {
    const int nwg = nM * nN; int wgid = L;
    { const int q = nwg / NXCD, r = nwg % NXCD, xcd = wgid % NXCD, off = wgid / NXCD; wgid = (xcd < r ? xcd * (q + 1) : r * (q + 1) + (xcd - r) * q) + off; }
    const int nig = WGM * nN, gid = wgid / nig, fm = gid * WGM, gsz = (nM - fm) < WGM ? (nM - fm) : WGM;
    pm = fm + ((wgid % nig) % gsz); pn = (wgid % nig) / gsz;
}
struct StdOrder {
    int nM, nN, G, c; long long tA, tB;
    __device__ void init(int M, int N, int G_, int c_, int lda, int ldb) { nM = M / BM; nN = N / BM; G = G_; c = c_; tA = 512LL * lda; tB = 512LL * ldb; }
    __device__ bool next(int i, Unit& u) const {
        const long long L = (long long)i * G + c; if (L >= (long long)nM * nN) return false;
        swz_tile((int)L, nM, nN, u.pm, u.pn); u.tag = 0; u.aoff = u.pm * tA; u.boff = u.pn * tB; return true;
    }
};
struct MergeOrder {
    int nM, nN, G, c; long long tA, tB;
    __device__ void init(int M, int N, int G_, int c_, int lda, int ldb) { nM = M / BM; nN = N / BM; G = G_; c = c_; tA = 512LL * lda; tB = 512LL * ldb; }
    __device__ bool next(int i, Unit& u) const {
        const int ti = i / 3, br = i - 3 * ti; const long long L = (long long)ti * G + c; if (L >= (long long)nM * nN) return false;
        swz_tile((int)L, nM, nN, u.pm, u.pn); u.tag = br; u.aoff = u.pm * tA + br * 1024; u.boff = u.pn * tB + br * 1024; return true;
    }
};
struct CmpOrder {
    int c;
    __device__ bool next(int i, Unit& u) const {
        if (i != 0 || c >= 64) return false;
        const int ks = c >> 5, kv = (c >> 4) & 1, bg = (c >> 2) & 3, tile = c & 3, b = bg >> 1, g = bg & 1;
        u.pm = c; u.pn = 0; u.tag = kv;
        u.aoff = 2LL * (((long long)b * S_ + 4096LL * tile + 16LL * ks) * PP + PC_KV + kv * 128 + g * 64);
        u.boff = (long long)kv * (256 * 2048 * 2) + (long long)ks * (1024 * 2); return true;
    }
};

__device__ __forceinline__ u32x4 pack8(f32x4 a, f32x4 b) { u32x4 w; w.x = cvt_pk_bf16(a[0], a[1]); w.y = cvt_pk_bf16(a[2], a[3]); w.z = cvt_pk_bf16(b[0], b[1]); w.w = cvt_pk_bf16(b[2], b[3]); return w; }
template <int MODE> struct Epi {
    bf16_t* O; int ldc; const bf16_t* G; const float* bias;
    __device__ __forceinline__ void operator()(const f32x4 (&acc)[2][2][4][2], const Unit& u, int wr, int wc, int fr, int fq) const {
        const int row0 = u.pm * BM + wr * 64 + fr;
        if constexpr (MODE == 1) {
            const int col0 = u.pn * 128 + wc * 32 + 8 * fq;
#pragma unroll
            for (int ai = 0; ai < 2; ++ai)
#pragma unroll
                for (int m = 0; m < 4; ++m) {
                    bf16_t* rowp = O + (size_t)(row0 + ai * HALF + m * 16) * ldc + col0;
                    f32x4 v0, v1;
#pragma unroll
                    for (int e = 0; e < 4; ++e) { const float a0 = acc[ai][0][m][0][e], a1 = acc[ai][0][m][1][e]; v0[e] = a0 * sigm(a0) * acc[ai][1][m][0][e]; v1[e] = a1 * sigm(a1) * acc[ai][1][m][1][e]; }
                    *(u32x4*)rowp = pack8(v0, v1);
                    __builtin_amdgcn_sched_barrier(0);
                }
        } else if constexpr (MODE == 3) {
            const int col0 = u.pn * BM + wc * 32 + 8 * fq;
#pragma unroll
            for (int ai = 0; ai < 2; ++ai) {
                u32x4 gv[4][2], ov[4][2];
#pragma unroll
                for (int m = 0; m < 4; ++m)
#pragma unroll
                    for (int bj = 0; bj < 2; ++bj) { const size_t row = (size_t)(row0 + ai * HALF + m * 16); const int col = col0 + bj * HALF;
                        gv[m][bj] = *(const u32x4*)(G + row * GP + u.tag * 1024 + col);
                        ov[m][bj] = (u.tag > 0) ? *(const u32x4*)(O + row * ldc + col) : (u32x4){0u, 0u, 0u, 0u}; }
                __builtin_amdgcn_sched_barrier(0);
#pragma unroll
                for (int m = 0; m < 4; ++m)
#pragma unroll
                    for (int bj = 0; bj < 2; ++bj) { const size_t row = (size_t)(row0 + ai * HALF + m * 16); const int col = col0 + bj * HALF;
                        f32x4 v0 = acc[ai][bj][m][0], v1 = acc[ai][bj][m][1]; const u32x4 g4 = gv[m][bj], o4 = ov[m][bj];
                        v0[0] = v0[0] * bf_lo(g4.x) + bf_lo(o4.x); v0[1] = v0[1] * bf_hi(g4.x) + bf_hi(o4.x); v0[2] = v0[2] * bf_lo(g4.y) + bf_lo(o4.y); v0[3] = v0[3] * bf_hi(g4.y) + bf_hi(o4.y);
                        v1[0] = v1[0] * bf_lo(g4.z) + bf_lo(o4.z); v1[1] = v1[1] * bf_hi(g4.z) + bf_hi(o4.z); v1[2] = v1[2] * bf_lo(g4.w) + bf_lo(o4.w); v1[3] = v1[3] * bf_hi(g4.w) + bf_hi(o4.w);
                        *(u32x4*)(O + row * ldc + col) = pack8(v0, v1); }
            }
        } else {
            const int col0 = u.pn * BM + wc * 32 + 8 * fq;
#pragma unroll
            for (int ai = 0; ai < 2; ++ai)
#pragma unroll
                for (int m = 0; m < 4; ++m) {
                    const size_t row = (size_t)(row0 + ai * HALF + m * 16);
#pragma unroll
                    for (int bj = 0; bj < 2; ++bj) {
                        const int col = col0 + bj * HALF;
                        f32x4 v0 = acc[ai][bj][m][0], v1 = acc[ai][bj][m][1];
                        bf16_t* dst = O + row * ldc + col;
                        if constexpr (MODE == 2) {
#pragma unroll
                            for (int e = 0; e < 4; ++e) { v0[e] = sigm(v0[e]); v1[e] = sigm(v1[e]); }
                        }
                        if constexpr (MODE == 4) {
                            const f32x4 b0 = *(const f32x4*)(bias + u.tag * 256 + col), b1 = *(const f32x4*)(bias + u.tag * 256 + col + 4);
#pragma unroll
                            for (int e = 0; e < 4; ++e) { v0[e] = gelu_tanh(v0[e] + b0[e]); v1[e] = gelu_tanh(v1[e] + b1[e]); }
                        }
                        if constexpr (MODE == 3) {
                            const u32x4 gv = *(const u32x4*)(G + row * GP + u.tag * 1024 + col);
                            v0[0] *= bf_lo(gv.x); v0[1] *= bf_hi(gv.x); v0[2] *= bf_lo(gv.y); v0[3] *= bf_hi(gv.y);
                            v1[0] *= bf_lo(gv.z); v1[1] *= bf_hi(gv.z); v1[2] *= bf_lo(gv.w); v1[3] *= bf_hi(gv.w);
                            if (u.tag > 0) {
                                const u32x4 ov = *(const u32x4*)dst;
                                v0[0] += bf_lo(ov.x); v0[1] += bf_hi(ov.x); v0[2] += bf_lo(ov.y); v0[3] += bf_hi(ov.y);
                                v1[0] += bf_lo(ov.z); v1[1] += bf_hi(ov.z); v1[2] += bf_lo(ov.w); v1[3] += bf_hi(ov.w);
                            }
                        }
                        *(u32x4*)dst = pack8(v0, v1);
                    }
                }
        }
    }
};

template <class EpiT, class Sched>
__device__ __forceinline__ void gemm_phase(LAS unsigned char* lds, int tid_in, const GemmDesc g, const Sched& S, const EpiT& E) {
    int tid_ = tid_in; asm volatile("" : "+v"(tid_));
    const int tid = tid_, wid = __builtin_amdgcn_readfirstlane(tid >> 6), lane = tid & 63, wr = wid >> 2, wc = wid & 3, fr = lane & 15, fq = lane >> 4;
    const int nt = g.nt;
    unsigned voffA[2], voffB[2];
#pragma unroll
    for (int i = 0; i < 2; ++i) { int R, C; stage_rc(tid * 16 + i * 8192, R, C); const int Rb = (R & ~31) + perm32(R & 31);
        voffA[i] = (unsigned)(R * g.lda + C) * 2u; voffB[i] = (unsigned)(Rb * g.ldb + C) * 2u; }
    const size_t kA = (size_t)g.kstepA, kB = (size_t)g.kstepB;
    const size_t hA = (size_t)HALF * g.lda * 2, hB = (size_t)HALF * g.ldb * 2;
    const unsigned ldsw = (unsigned)wid * 1024u;
    const int aoff = lds_byte(wr * 64 + fr, fq * 8), boff = lds_byte(wc * 32 + fr, fq * 8);
#define PG8_SA(b, h) (((b) * 2 + (h)) * HTB)
#define PG8_SB(b, h) ((4 + (b) * 2 + (h)) * HTB)
#define PG8_STAGE(bufoff, gbase, voff) do { _Pragma("unroll") for (int _i = 0; _i < 2; ++_i) \
        __builtin_amdgcn_global_load_lds((const unsigned*)((const char*)(gbase) + (voff)[_i]), (LAS unsigned*)(lds + (bufoff) + ldsw + _i * 8192), 16, 0, 0); } while (0)
#define PG8_LDA(dst, b, h) do { _Pragma("unroll") for (int m = 0; m < 4; ++m) _Pragma("unroll") for (int k = 0; k < 2; ++k) dst[m][k] = *(const LAS bf16x8*)(lds + PG8_SA(b, h) + aoff + m * 2048 + k * 1024); } while (0)
#define PG8_LDB(dst, b, h) do { _Pragma("unroll") for (int n = 0; n < 2; ++n) _Pragma("unroll") for (int k = 0; k < 2; ++k) dst[n][k] = *(const LAS bf16x8*)(lds + PG8_SB(b, h) + boff + n * 2048 + k * 1024); } while (0)
#define PG8_MMA(ai, bj, At, Bt) do { __builtin_amdgcn_s_setprio(1); _Pragma("unroll") for (int m = 0; m < 4; ++m) _Pragma("unroll") for (int n = 0; n < 2; ++n) _Pragma("unroll") for (int k = 0; k < 2; ++k) \
        acc[ai][bj][m][n] = __builtin_amdgcn_mfma_f32_16x16x32_bf16(Bt[n][k], At[m][k], acc[ai][bj][m][n], 0, 0, 0); __builtin_amdgcn_s_setprio(0); } while (0)
#define PG8_WAIT_V(n) asm volatile("s_waitcnt vmcnt(" #n ")" ::: "memory")
#define PG8_WAIT_L(n) asm volatile("s_waitcnt lgkmcnt(" #n ")" ::: "memory")
#define PG8_BAR __builtin_amdgcn_s_barrier()
#define PG8_SCHED __builtin_amdgcn_sched_barrier(0)
    Unit cur, nxt; int ui = 0;
    if (!S.next(0, cur)) return;
    f32x4 acc[2][2][4][2];
#pragma unroll
    for (int a = 0; a < 2; ++a)
#pragma unroll
        for (int b = 0; b < 2; ++b)
#pragma unroll
            for (int m = 0; m < 4; ++m)
#pragma unroll
                for (int n = 0; n < 2; ++n) acc[a][b][m][n] = (f32x4){0.f, 0.f, 0.f, 0.f};
    bf16x8 At[4][2], B0[2][2], B1[2][2];
    const char* cA = g.A + cur.aoff; const char* cB = g.Bt + cur.boff;
    PG8_STAGE(PG8_SB(0, 0), cB, voffB); PG8_STAGE(PG8_SB(0, 1), cB + hB, voffB); PG8_STAGE(PG8_SA(0, 0), cA, voffA); PG8_STAGE(PG8_SA(0, 1), cA + hA, voffA);
    if (wr == 1) PG8_BAR;
    PG8_WAIT_V(2); PG8_BAR;
    PG8_STAGE(PG8_SB(1, 0), cB + kB, voffB); PG8_STAGE(PG8_SA(1, 0), cA + kA, voffA); PG8_STAGE(PG8_SB(1, 1), cB + hB + kB, voffB);
    PG8_WAIT_V(6); PG8_BAR;
    for (;;) {
        const bool has_next = S.next(ui + 1, nxt);
        const char* nA = has_next ? g.A + nxt.aoff : cA; const char* nB = has_next ? g.Bt + nxt.boff : cB;
        for (int t = 0; t < nt; t += 2) {
            const bool last = (t == nt - 2);
            const char* a1 = cA + (size_t)(t + 1) * kA;
            const char* a2 = last ? nA : cA + (size_t)(t + 2) * kA; const char* b2 = last ? nB : cB + (size_t)(t + 2) * kB;
            const char* a3 = a2 + kA; const char* b3 = b2 + kB;
            PG8_LDB(B0, 0, 0); PG8_LDB(B1, 0, 1); PG8_SCHED; PG8_LDA(At, 0, 0); PG8_STAGE(PG8_SA(1, 1), a1 + hA, voffA);
            PG8_WAIT_V(8); PG8_WAIT_L(0); PG8_BAR; PG8_MMA(0, 0, At, B0); PG8_MMA(0, 1, At, B1); PG8_BAR; PG8_SCHED;
            PG8_LDA(At, 0, 1); PG8_STAGE(PG8_SB(0, 0), b2, voffB); PG8_STAGE(PG8_SB(0, 1), b2 + hB, voffB); PG8_STAGE(PG8_SA(0, 0), a2, voffA);
            PG8_WAIT_V(8); PG8_WAIT_L(0); PG8_BAR; PG8_MMA(1, 0, At, B0); PG8_MMA(1, 1, At, B1); PG8_BAR; PG8_SCHED;
            PG8_LDB(B0, 1, 0); PG8_LDB(B1, 1, 1); PG8_SCHED; PG8_LDA(At, 1, 0); PG8_STAGE(PG8_SA(0, 1), a2 + hA, voffA);
            PG8_WAIT_V(8); PG8_WAIT_L(0); PG8_BAR; PG8_MMA(0, 0, At, B0); PG8_MMA(0, 1, At, B1); PG8_BAR; PG8_SCHED;
            PG8_LDA(At, 1, 1); PG8_STAGE(PG8_SB(1, 0), b3, voffB); PG8_STAGE(PG8_SB(1, 1), b3 + hB, voffB); PG8_STAGE(PG8_SA(1, 0), a3, voffA);
            PG8_WAIT_V(8); PG8_WAIT_L(0); PG8_BAR; PG8_MMA(1, 0, At, B0); PG8_MMA(1, 1, At, B1); PG8_BAR; PG8_SCHED;
        }
        if (wr == 0) PG8_BAR;
        E(acc, cur, wr, wc, fr, fq);
        if (!has_next) break;
#pragma unroll
        for (int a = 0; a < 2; ++a)
#pragma unroll
            for (int b = 0; b < 2; ++b)
#pragma unroll
                for (int m = 0; m < 4; ++m)
#pragma unroll
                    for (int n = 0; n < 2; ++n) acc[a][b][m][n] = (f32x4){0.f, 0.f, 0.f, 0.f};
        cur = nxt; cA = nA; cB = nB; ++ui;
        if (wr == 1) PG8_BAR;
    }
    PG8_WAIT_V(0);
    PG8_BAR;
#undef PG8_SA
#undef PG8_SB
#undef PG8_STAGE
#undef PG8_LDA
#undef PG8_LDB
#undef PG8_MMA
#undef PG8_WAIT_V
#undef PG8_WAIT_L
#undef PG8_BAR
#undef PG8_SCHED
}
}

struct Args { const void* in[29]; float* out; unsigned char* ws; int ph_lo, ph_hi; };
static_assert(sizeof(Args) == 29 * 8 + 8 + 8 + 8, "Args has no padding");

typedef __attribute__((address_space(1))) unsigned char gu8;
struct Ctx {
    const Args* a; gu8* ws; LAS unsigned char* lds; int tid, lane, wave, G, gw, NGW;
};
#define INF(k, l, n) ((const float*)C.a->in[k] + (size_t)(l) * (n))

__device__ __forceinline__ void tr_item(const float* W, int ldw, int src_col, int nvalid, int k0, bf16_t* WT, int ldt, int dst_row, int dst_k, LAS float* scr, int lane) {
#pragma unroll 8
    for (int i = 0; i < 32; ++i) { const int kk = 2 * i + (lane >> 5), c = lane & 31; scr[kk * 33 + c] = (c < nvalid) ? W[(size_t)(k0 + kk) * ldw + src_col + c] : 0.f; }
    LDS_WAIT();
    const int c = lane & 7;
#pragma unroll
    for (int j = 0; j < 4; ++j) { const int n = (lane >> 3) + 8 * j; const LAS float* s = scr + (8 * c) * 33 + n;
        u32x4 o; o.x = cvt_pk_bf16(s[0 * 33], s[1 * 33]); o.y = cvt_pk_bf16(s[2 * 33], s[3 * 33]); o.z = cvt_pk_bf16(s[4 * 33], s[5 * 33]); o.w = cvt_pk_bf16(s[6 * 33], s[7 * 33]);
        *(u32x4*)(WT + (size_t)(dst_row + n) * ldt + dst_k + k0 + 8 * c) = o; }
    LDS_WAIT();
}

__device__ __forceinline__ void convert_layer(const Ctx& C, int l) {
    LAS float* scr = (LAS float*)(C.lds + C.wave * 8448);
    gu8* ws = C.ws; const int lane = C.lane;
    constexpr int NITEMS = 2816 + 1408 + 1792 + 1536 + 768 + 512 + 2816 + 1408 + 256 + 256 + 512;
    for (int it = C.gw; it < NITEMS; it += C.NGW) {
        int r = it;
        if (r < 2816) { const int kb = r / 176, nb = r % 176, tile = nb >> 3, w = nb & 7, src = (w >> 2) * FF + tile * 128 + (w & 3) * 32;
            tr_item(INF(5, l, DM * 2 * FF), 2 * FF, src, 32, kb * 64, (bf16_t*)(ws + WS_W1IN), DM, nb * 32, 0, scr, lane); continue; } r -= 2816;
        if (r < 1408) { const int kb = r / 32, nb = r % 32;
            tr_item(INF(6, l, FF * DM), DM, nb * 32, 32, kb * 64, (bf16_t*)(ws + WS_W1OUT), FF, nb * 32, 0, scr, lane); continue; } r -= 1408;
        if (r < 1792) { const int kb = r / 112, nb = r % 112; int src = 0, nv = 0;
            if (nb < 88) { src = nb * 32; nv = 32; } else if (nb < 104) { src = 2840 + (nb - 88) * 32; nv = 32; } else if (nb == 104) { src = 2816; nv = 24; }
            tr_item(INF(10, l, DM * 6424), 6424, src, nv, kb * 64, (bf16_t*)(ws + WS_WMIX), DM, nb * 32, 0, scr, lane); continue; } r -= 1792;
        if (r < 1536) { const int kb = r / 96, nb = r % 96;
            tr_item(INF(10, l, DM * 6424), 6424, 3352 + nb * 32, 32, kb * 64, (bf16_t*)(ws + WS_WG), DM, nb * 32, 0, scr, lane); continue; } r -= 1536;
        if (r < 768) { const int br = r / 256, q = r % 256, kb = q / 32, nb = q % 32;
            const float* W = br == 0 ? INF(21, l, 512 * DM) : (br == 1 ? INF(22, l, 512 * DM) : INF(23, l, 512 * DM));
            tr_item(W, DM, nb * 32, 32, kb * 64, (bf16_t*)(ws + WS_WBR), YP, nb * 32, br * 512, scr, lane); continue; } r -= 768;
        if (r < 512) { const int kb = r / 32, nb = r % 32;
            tr_item(INF(24, l, DM * DM), DM, nb * 32, 32, kb * 64, (bf16_t*)(ws + WS_WOUT), DM, nb * 32, 0, scr, lane); continue; } r -= 512;
        if (r < 2816) { const int kb = r / 176, nb = r % 176, tile = nb >> 3, w = nb & 7, src = (w >> 2) * FF + tile * 128 + (w & 3) * 32;
            tr_item(INF(27, l, DM * 2 * FF), 2 * FF, src, 32, kb * 64, (bf16_t*)(ws + WS_W2IN), DM, nb * 32, 0, scr, lane); continue; } r -= 2816;
        if (r < 1408) { const int kb = r / 32, nb = r % 32;
            tr_item(INF(28, l, FF * DM), DM, nb * 32, 32, kb * 64, (bf16_t*)(ws + WS_W2OUT), FF, nb * 32, 0, scr, lane); continue; } r -= 1408;
        if (r < 256) { const int kb = r / 8, nb = r % 8;
            tr_item(INF(14, l, 2048 * 256), 256, nb * 32, 32, kb * 64, (bf16_t*)(ws + WS_WC1), 2048, nb * 32, 0, scr, lane); continue; } r -= 256;
        if (r < 256) { const int kb = r / 8, nb = r % 8;
            tr_item(INF(17, l, 2048 * 256), 256, nb * 32, 32, kb * 64, (bf16_t*)(ws + WS_WC1 + MiB), 2048, nb * 32, 0, scr, lane); continue; } r -= 256;
        { const int kb = r / 32, nb = r % 32;
            tr_item(INF(20, l, DM * DM), DM, nb * 32, 32, kb * 64, (bf16_t*)(ws + WS_WMKV), DM, nb * 32, 0, scr, lane); }
    }
    {
        const float* gm = INF(9, l, DM);
        for (int m = C.gw; m < 512; m += C.NGW) {
            const f32x4* xr = (const f32x4*)((const float*)C.a->in[1] + (size_t)m * DM) + lane;
            f32x4 v[4]; float s = 0.f;
#pragma unroll
            for (int j = 0; j < 4; ++j) { v[j] = xr[64 * j]; s += (v[j].x * v[j].x + v[j].y * v[j].y) + (v[j].z * v[j].z + v[j].w * v[j].w); }
            const float rstd = rsqrtf(wave_sum(s) * (1.f / DM) + EPS);
            u32x2* o = (u32x2*)((bf16_t*)(ws + WS_MEMN) + (size_t)m * DM) + lane;
#pragma unroll
            for (int j = 0; j < 4; ++j) { const f32x4 gg = ((const f32x4*)gm)[lane + 64 * j]; u32x2 w; w.x = cvt_pk_bf16(v[j].x * rstd * gg.x, v[j].y * rstd * gg.y); w.y = cvt_pk_bf16(v[j].z * rstd * gg.z, v[j].w * rstd * gg.w); o[64 * j] = w; }
        }
    }
    {
        float* cb = (float*)(ws + WS_CBP) + (size_t)l * 64 * 256;
        for (int it = C.gw; it < 64; it += C.NGW) {
            const int kv = it >> 5, ch = it & 31;
            const float* pos = kv ? INF(13, l, 2048) : INF(12, l, 2048);
            const float* w1 = kv ? INF(17, l, 2048 * 256) : INF(14, l, 2048 * 256);
            float p[4] = {0.f, 0.f, 0.f, 0.f};
            for (int k = ch * 64; k < ch * 64 + 64; ++k) { const float pv = pos[k];
#pragma unroll
                for (int q = 0; q < 4; ++q) p[q] += pv * w1[(size_t)k * 256 + lane + 64 * q]; }
#pragma unroll
            for (int q = 0; q < 4; ++q) cb[(size_t)it * 256 + lane + 64 * q] = p[q];
        }
    }
}

__device__ __forceinline__ void rope_table(const Ctx& C) {
    const int* pos = (const int*)C.a->in[2];
    float* tab = (float*)(C.ws + WS_ROPE);
    const float invf[8] = {1.0f, 0.1939227432012558f, 0.03760603070259094f, 0.007292664609849453f, 0.0014142135623842478f, 0.00027424818836152554f, 5.318296098266728e-05f, 1.0313386155758053e-05f};
    for (int e = C.gw * 64 + C.lane; e < T_ * 8; e += C.NGW * 64) {
        const int tok = e >> 3, i = e & 7;
        float f = invf[0];
#pragma unroll
        for (int q = 1; q < 8; ++q) f = (i == q) ? invf[q] : f;
        const float ang = (float)pos[tok] * f;
        const double rev = (double)ang * 0.15915494309189535; const float fr = (float)(rev - floor(rev));
        tab[(size_t)tok * 16 + i] = __builtin_amdgcn_cosf(fr); tab[(size_t)tok * 16 + 8 + i] = __builtin_amdgcn_sinf(fr);
    }
}
__device__ __forceinline__ void prenorm_rows(const Ctx& C, const float* x, const float* g, bf16_t* h) {
    for (int m = C.gw; m < T_; m += C.NGW) {
        const f32x4* xr = (const f32x4*)(x + (size_t)m * DM) + C.lane;
        f32x4 v[4]; float s = 0.f;
#pragma unroll
        for (int j = 0; j < 4; ++j) { v[j] = xr[64 * j]; s += (v[j].x * v[j].x + v[j].y * v[j].y) + (v[j].z * v[j].z + v[j].w * v[j].w); }
        const float rstd = rsqrtf(wave_sum(s) * (1.f / DM) + EPS);
        u32x2* o = (u32x2*)(h + (size_t)m * DM) + C.lane;
#pragma unroll
        for (int j = 0; j < 4; ++j) { const f32x4 gg = ((const f32x4*)g)[C.lane + 64 * j]; u32x2 w; w.x = cvt_pk_bf16(v[j].x * rstd * gg.x, v[j].y * rstd * gg.y); w.y = cvt_pk_bf16(v[j].z * rstd * gg.z, v[j].w * rstd * gg.w); o[64 * j] = w; }
    }
}
__device__ __forceinline__ void norm_phase(const Ctx& C, int w0, int nw, const float* xin, float* xout, const bf16_t* y, bf16_t* h, const float* gpost, const float* gpre, float coef) {
    for (int m0 = w0; m0 < T_; m0 += 2 * nw) {
        f32x4 xv[2][4]; u32x2 yw[2][4];
#pragma unroll
        for (int r = 0; r < 2; ++r) { const int m = (m0 + r * nw < T_) ? m0 + r * nw : m0; const f32x4* xr = (const f32x4*)(xin + (size_t)m * DM) + C.lane; const u32x2* yr = (const u32x2*)(y + (size_t)m * DM) + C.lane;
#pragma unroll
            for (int j = 0; j < 4; ++j) { xv[r][j] = xr[64 * j]; yw[r][j] = yr[64 * j]; } }
#pragma unroll
        for (int r = 0; r < 2; ++r) {
            const int m = m0 + r * nw; if (m >= T_) break;
            f32x4 yv[4]; float s = 0.f;
#pragma unroll
            for (int j = 0; j < 4; ++j) { const u32x2 w = yw[r][j]; yv[j] = (f32x4){bf_lo(w.x), bf_hi(w.x), bf_lo(w.y), bf_hi(w.y)};
                s += (yv[j].x * yv[j].x + yv[j].y * yv[j].y) + (yv[j].z * yv[j].z + yv[j].w * yv[j].w); }
            const float rs = rsqrtf(wave_sum(s) * (1.f / DM) + EPS) * coef; float s2 = 0.f;
            f32x4* xo = (f32x4*)(xout + (size_t)m * DM) + C.lane;
#pragma unroll
            for (int j = 0; j < 4; ++j) { const f32x4 gg = ((const f32x4*)gpost)[C.lane + 64 * j]; xv[r][j] = xv[r][j] + yv[j] * gg * rs; xo[64 * j] = xv[r][j];
                s2 += (xv[r][j].x * xv[r][j].x + xv[r][j].y * xv[r][j].y) + (xv[r][j].z * xv[r][j].z + xv[r][j].w * xv[r][j].w); }
            if (gpre) {
                const float r2 = rsqrtf(wave_sum(s2) * (1.f / DM) + EPS);
                u32x2* o = (u32x2*)(h + (size_t)m * DM) + C.lane;
#pragma unroll
                for (int j = 0; j < 4; ++j) { const f32x4 gg = ((const f32x4*)gpre)[C.lane + 64 * j]; u32x2 w; w.x = cvt_pk_bf16(xv[r][j].x * r2 * gg.x, xv[r][j].y * r2 * gg.y); w.y = cvt_pk_bf16(xv[r][j].z * r2 * gg.z, xv[r][j].w * r2 * gg.w); o[64 * j] = w; }
            }
        }
    }
}
__device__ __forceinline__ void cb_reduce(const Ctx& C, int l) {
    const int e = C.gw * 64 + C.lane;
    if (e < 512) { const int kv = e >> 8, n = e & 255; const float* pp = (const float*)(C.ws + WS_CBP) + (size_t)l * 64 * 256 + (size_t)kv * 32 * 256 + n;
        float s = (kv ? INF(18, l, 256) : INF(15, l, 256))[n];
        for (int ch = 0; ch < 32; ++ch) s += pp[ch * 256];
        ((float*)(C.ws + WS_CB))[l * 512 + e] = s; }
}
__device__ __forceinline__ void memkv_ops(const Ctx& C, int w0, int nw) {
    const bf16_t* src = (const bf16_t*)(C.ws + WS_MKV); bf16_t* ko = (bf16_t*)(C.ws + WS_MEMK); bf16_t* vo = (bf16_t*)(C.ws + WS_MEMV);
    for (int e = w0 * 64 + C.lane; e < 512 * 1024; e += nw * 64) {
        const int mr = e >> 10, col = e & 1023, kv = col >> 9, hm = (col >> 7) & 3, d = col & 127, b = mr >> 8, m = mr & 255;
        const bf16_t v = src[e];
        if (kv == 0) ko[((size_t)((((b * 4 + hm) * 8 + (m >> 5)) * 8 + (d >> 4)) * 64 + pi32(m & 31) + 32 * ((d >> 3) & 1))) * 8 + (d & 7)] = v;
        else vo[((size_t)((((b * 4 + hm) * 16 + (m >> 4)) * 4 + (d >> 5)) * 64 + (d & 31) + 32 * ((m >> 3) & 1))) * 8 + (m & 7)] = v;
    }
}

__device__ __forceinline__ void prep_items(const Ctx& C, int l, int w0, int nw) {
    const bf16_t* P = (const bf16_t*)(C.ws + WS_R1); bf16_t* Y = (bf16_t*)(C.ws + WS_Y);
    const int lane = C.lane;
    {
        const float* cw = INF(11, l, 3 * 512);
        float w[3][8];
#pragma unroll
        for (int k = 0; k < 3; ++k)
#pragma unroll
            for (int e = 0; e < 8; ++e) w[k][e] = cw[k * 512 + lane * 8 + e];
        for (int it = w0; it < T_ / 8; it += nw) {
            const int tok0 = it * 8, s0 = tok0 & (S_ - 1);
            float c1[8], c2[8];
#pragma unroll
            for (int e = 0; e < 8; ++e) { c1[e] = 0.f; c2[e] = 0.f; }
            if (s0 > 0) {
#pragma unroll
                for (int back = 2; back >= 1; --back) {
                    const bf16_t* row = P + (size_t)(tok0 - back) * PP + lane * 8;
                    const u32x4 u = *(const u32x4*)row, cc = *(const u32x4*)(row + 1024);
                    float t[8] = {bf_lo(u.x) * bf_lo(cc.x), bf_hi(u.x) * bf_hi(cc.x), bf_lo(u.y) * bf_lo(cc.y), bf_hi(u.y) * bf_hi(cc.y), bf_lo(u.z) * bf_lo(cc.z), bf_hi(u.z) * bf_hi(cc.z), bf_lo(u.w) * bf_lo(cc.w), bf_hi(u.w) * bf_hi(cc.w)};
#pragma unroll
                    for (int e = 0; e < 8; ++e) { if (back == 2) c2[e] = t[e]; else c1[e] = t[e]; }
                }
            }
#pragma unroll
            for (int tt = 0; tt < 8; ++tt) {
                const bf16_t* row = P + (size_t)(tok0 + tt) * PP + lane * 8;
                const u32x4 u = *(const u32x4*)row, bb = *(const u32x4*)(row + 512), cc = *(const u32x4*)(row + 1024);
                const float c0[8] = {bf_lo(u.x) * bf_lo(cc.x), bf_hi(u.x) * bf_hi(cc.x), bf_lo(u.y) * bf_lo(cc.y), bf_hi(u.y) * bf_hi(cc.y), bf_lo(u.z) * bf_lo(cc.z), bf_hi(u.z) * bf_hi(cc.z), bf_lo(u.w) * bf_lo(cc.w), bf_hi(u.w) * bf_hi(cc.w)};
                const float bv[8] = {bf_lo(bb.x), bf_hi(bb.x), bf_lo(bb.y), bf_hi(bb.y), bf_lo(bb.z), bf_hi(bb.z), bf_lo(bb.w), bf_hi(bb.w)};
                float o[8];
#pragma unroll
                for (int e = 0; e < 8; ++e) { o[e] = bv[e] * (w[0][e] * c2[e] + w[1][e] * c1[e] + w[2][e] * c0[e]); c2[e] = c1[e]; c1[e] = c0[e]; }
                u32x4 ov; ov.x = cvt_pk_bf16(o[0], o[1]); ov.y = cvt_pk_bf16(o[2], o[3]); ov.z = cvt_pk_bf16(o[4], o[5]); ov.w = cvt_pk_bf16(o[6], o[7]);
                *(u32x4*)(Y + (size_t)(tok0 + tt) * YP + lane * 8) = ov;
            }
        }
    }
    {
        const float* rope = (const float*)(C.ws + WS_ROPE);
        LAS bf16_t* vt = (LAS bf16_t*)(C.lds + C.wave * 4608);
        const int hi = lane >> 5, dl = lane & 31;
        for (int it = w0; it < 4 * 512; it += nw) {
            const int bg = it >> 9, tile = it & 511, b = bg >> 1, g = bg & 1;
            const size_t tokb = (size_t)b * S_ + 32 * tile;
#pragma unroll
            for (int which = 0; which < 2; ++which) {
                const int kc = PC_KV + (2 + 2 * which) * 128 + g * 64, vc = kc + 128;
                bf16_t* kop = (bf16_t*)(C.ws + (which ? WS_KWIN : WS_KSLC)); bf16_t* vop = (bf16_t*)(C.ws + (which ? WS_VWIN : WS_VSLC));
#pragma unroll
                for (int q = 0; q < 4; ++q) {
                    const int r = (lane >> 3) + 8 * q, c = lane & 7;
                    const bf16_t* row = P + (tokb + r) * PP;
                    u32x4 kv = *(const u32x4*)(row + kc + 8 * c);
                    if (c < 2) {
                        const u32x4 pv = *(const u32x4*)(row + kc + 8 * (c ^ 1));
                        const float* rt = rope + (tokb + r) * 16;
                        const f32x4 ca = *(const f32x4*)rt, cb2 = *(const f32x4*)(rt + 4), sa = *(const f32x4*)(rt + 8), sb = *(const f32x4*)(rt + 12);
                        const float cs[8] = {ca.x, ca.y, ca.z, ca.w, cb2.x, cb2.y, cb2.z, cb2.w}, sn[8] = {sa.x, sa.y, sa.z, sa.w, sb.x, sb.y, sb.z, sb.w};
                        const float mv[8] = {bf_lo(kv.x), bf_hi(kv.x), bf_lo(kv.y), bf_hi(kv.y), bf_lo(kv.z), bf_hi(kv.z), bf_lo(kv.w), bf_hi(kv.w)};
                        const float pp[8] = {bf_lo(pv.x), bf_hi(pv.x), bf_lo(pv.y), bf_hi(pv.y), bf_lo(pv.z), bf_hi(pv.z), bf_lo(pv.w), bf_hi(pv.w)};
                        const float sg = (c == 0) ? -1.f : 1.f; float o[8];
#pragma unroll
                        for (int e = 0; e < 8; ++e) o[e] = mv[e] * cs[e] + sg * pp[e] * sn[e];
                        kv.x = cvt_pk_bf16(o[0], o[1]); kv.y = cvt_pk_bf16(o[2], o[3]); kv.z = cvt_pk_bf16(o[4], o[5]); kv.w = cvt_pk_bf16(o[6], o[7]);
                    }
                    if (which == 0)
                        *(u32x4*)(kop + ((size_t)(((bg * 512 + tile) * 2 + ((r >> 2) & 1)) * 2 + (c >> 2)) * 64 + ((r >> 3) * 4 + (r & 3)) + 16 * (c & 3)) * 8) = kv;
                    else
                        *(u32x4*)(kop + ((size_t)((bg * 512 + tile) * 4 + (c >> 1)) * 64 + pi32(r) + 32 * (c & 1)) * 8) = kv;
                    const u32x4 vv = *(const u32x4*)(row + vc + 8 * c);
                    *(LAS u32x4*)(vt + r * 72 + 8 * c) = vv;
                }
                LDS_WAIT();
#pragma unroll
                for (int o4 = 0; o4 < 4; ++o4) {
                    if (which == 0) {
                        const LAS bf16_t* sp = vt + (8 * (lane >> 4)) * 72 + 16 * o4 + (lane & 15);
                        u32x4 o; o.x = (unsigned)sp[0] | ((unsigned)sp[72] << 16); o.y = (unsigned)sp[144] | ((unsigned)sp[216] << 16); o.z = (unsigned)sp[288] | ((unsigned)sp[360] << 16); o.w = (unsigned)sp[432] | ((unsigned)sp[504] << 16);
                        *(u32x4*)(vop + ((size_t)((bg * 512 + tile) * 4 + o4) * 64 + lane) * 8) = o;
                        continue;
                    }
                    const int ks = o4 >> 1, dt = o4 & 1;
                    const LAS bf16_t* sp = vt + (16 * ks + 8 * hi) * 72 + 32 * dt + dl;
                    u32x4 o; o.x = (unsigned)sp[0] | ((unsigned)sp[72] << 16); o.y = (unsigned)sp[144] | ((unsigned)sp[216] << 16); o.z = (unsigned)sp[288] | ((unsigned)sp[360] << 16); o.w = (unsigned)sp[432] | ((unsigned)sp[504] << 16);
                    *(u32x4*)(vop + ((size_t)((bg * 1024 + 2 * tile + ks) * 2 + dt) * 64 + lane) * 8) = o;
                }
                LDS_WAIT();
            }
        }
    }
}

__device__ __forceinline__ void cmp_stage2(const Ctx& C, int l) {
    const int bxx = C.gw / NWAVES, kv = bxx & 1, wi = bxx >> 1, nwg2 = (C.G + 1 - kv) >> 1;
    const float* w2 = kv ? INF(19, l, 256 * 64) : INF(16, l, 256 * 64);
    LAS float* ws2 = (LAS float*)C.lds;
    for (int e = C.tid; e < 256 * 64 / 4; e += NWAVES * 64) ((LAS f32x4*)ws2)[e] = ((const f32x4*)w2)[e];
    __syncthreads();
    const bf16_t* hid = (const bf16_t*)(C.ws + WS_CMPP) + (size_t)kv * 4096 * 256;
    const float* cbias = (const float*)(C.ws + WS_CB) + l * 512 + kv * 256;
    bf16_t* ko = (bf16_t*)(C.ws + WS_KCMP); bf16_t* vo = (bf16_t*)(C.ws + WS_VCMP);
    const int d = C.lane;
    for (int row = wi * NWAVES + C.wave; row < 4096; row += nwg2 * NWAVES) {
        asm volatile("" ::: "memory");
        const u32x2 hv = *((const u32x2*)(hid + (size_t)row * 256) + C.lane), hw = *((const u32x2*)(hid + (size_t)(row + 8192) * 256) + C.lane);
        const f32x4 cbv = *((const f32x4*)cbias + C.lane);
        const float h0 = gelu_tanh(bf_lo(hv.x) + bf_lo(hw.x) + cbv.x), h1 = gelu_tanh(bf_hi(hv.x) + bf_hi(hw.x) + cbv.y), h2 = gelu_tanh(bf_lo(hv.y) + bf_lo(hw.y) + cbv.z), h3 = gelu_tanh(bf_hi(hv.y) + bf_hi(hw.y) + cbv.w);
        float acc = 0.f;
#pragma unroll 4
        for (int k = 0; k < 64; ++k) {
            const float a0 = __int_as_float(__builtin_amdgcn_readlane(__float_as_int(h0), k)), a1 = __int_as_float(__builtin_amdgcn_readlane(__float_as_int(h1), k));
            const float a2 = __int_as_float(__builtin_amdgcn_readlane(__float_as_int(h2), k)), a3 = __int_as_float(__builtin_amdgcn_readlane(__float_as_int(h3), k));
            acc += a0 * ws2[(4 * k + 0) * 64 + d]; acc += a1 * ws2[(4 * k + 1) * 64 + d]; acc += a2 * ws2[(4 * k + 2) * 64 + d]; acc += a3 * ws2[(4 * k + 3) * 64 + d];
        }
        const int bg = row >> 10, n = row & 1023;
        if (n == 1023) acc = 0.f;
        const bf16_t o = (bf16_t)(cvt_pk_bf16(acc, 0.f) & 0xffffu);
        if (kv == 0) ko[((size_t)((bg * 32 + (n >> 5)) * 4 + (d >> 4)) * 64 + pi32(n & 31) + 32 * ((d >> 3) & 1)) * 8 + (d & 7)] = o;
        else vo[((size_t)((bg * 64 + (n >> 4)) * 2 + (d >> 5)) * 64 + (d & 31) + 32 * ((n >> 3) & 1)) * 8 + (n & 7)] = o;
    }
    __syncthreads();
}

__device__ __forceinline__ float xhalf_max(float v) { const auto r = __builtin_amdgcn_permlane32_swap(__float_as_uint(v), __float_as_uint(v), false, false); return fmaxf(__uint_as_float(r[0]), __uint_as_float(r[1])); }
__device__ __forceinline__ float xhalf_sum(float v) { const auto r = __builtin_amdgcn_permlane32_swap(__float_as_uint(v), __float_as_uint(v), false, false); return __uint_as_float(r[0]) + __uint_as_float(r[1]); }
__device__ __forceinline__ f32x16 mfma32(bf16x8 a, bf16x8 b, f32x16 c) { return __builtin_amdgcn_mfma_f32_32x32x16_bf16(a, b, c, 0, 0, 0); }
__device__ __forceinline__ float dpp_xor1(float v) { return __int_as_float(__builtin_amdgcn_update_dpp(0, __float_as_int(v), 0xB1, 0xF, 0xF, true)); }
__device__ __forceinline__ float dpp_xor2(float v) { return __int_as_float(__builtin_amdgcn_update_dpp(0, __float_as_int(v), 0x4E, 0xF, 0xF, true)); }
__device__ __forceinline__ bf16x8 pack_p(const float* p) { u32x4 w; w.x = cvt_pk_bf16(p[0], p[1]); w.y = cvt_pk_bf16(p[2], p[3]); w.z = cvt_pk_bf16(p[4], p[5]); w.w = cvt_pk_bf16(p[6], p[7]); return __builtin_bit_cast(bf16x8, w); }
__device__ __forceinline__ bf16x8 scale_q(u32x4 v, float s) { u32x4 w; w.x = cvt_pk_bf16(bf_lo(v.x) * s, bf_hi(v.x) * s); w.y = cvt_pk_bf16(bf_lo(v.y) * s, bf_hi(v.y) * s); w.z = cvt_pk_bf16(bf_lo(v.z) * s, bf_hi(v.z) * s); w.w = cvt_pk_bf16(bf_lo(v.w) * s, bf_hi(v.w) * s); return __builtin_bit_cast(bf16x8, w); }
constexpr float SM_THR = 8.0f;
#define KREL(i, hi) (8 * (hi) + (i) + (((i) >= 8) ? 8 : 0))

__device__ __forceinline__ void flash_load(const bf16x8* kp, const bf16x8* vp, bf16x8 (&kf)[4], bf16x8 (&vf)[4]) {
#pragma unroll
    for (int s = 0; s < 4; ++s) kf[s] = kp[s * 64];
#pragma unroll
    for (int s = 0; s < 4; ++s) vf[s] = vp[s * 64];
    __builtin_amdgcn_sched_barrier(0);
}
__device__ __forceinline__ void flash_compute(bool domask, const bf16x8 (&kf)[4], const bf16x8 (&vf)[4], const bf16x8 (&q)[4], int x0, unsigned span, float& m, float& l, f32x16 (&O)[2]) {
    f32x16 sc;
#pragma unroll
    for (int i = 0; i < 16; ++i) sc[i] = 0.f;
    __builtin_amdgcn_s_setprio(1);
#pragma unroll
    for (int s = 0; s < 4; ++s) sc = mfma32(kf[s], q[s], sc);
    __builtin_amdgcn_s_setprio(0);
    if (domask) {
#pragma unroll
        for (int i = 0; i < 16; ++i) sc[i] = ((unsigned)(x0 + i + (i >= 8 ? 8 : 0)) <= span) ? sc[i] : -1e30f;
    }
    const float a0 = fmaxf(fmaxf(sc[0], sc[1]), sc[2]), a1 = fmaxf(fmaxf(sc[3], sc[4]), sc[5]), a2 = fmaxf(fmaxf(sc[6], sc[7]), sc[8]), a3 = fmaxf(fmaxf(sc[9], sc[10]), sc[11]), a4 = fmaxf(fmaxf(sc[12], sc[13]), sc[14]);
    float mx = fmaxf(fmaxf(fmaxf(a0, a1), fmaxf(a2, a3)), fmaxf(a4, sc[15]));
    mx = xhalf_max(mx);
    const bool upd = mx > m + SM_THR;
    if (__ballot(upd) != 0ull) {
        const float mn = upd ? mx : m, alpha = ex2(m - mn); l *= alpha; O[0] = O[0] * alpha; O[1] = O[1] * alpha; m = mn;
    }
    const float msub = (m < -1e29f) ? 0.f : m;
    const f32x16 d = sc - msub;
    float p[16], ps = 0.f;
#pragma unroll
    for (int i = 0; i < 16; ++i) { p[i] = ex2(d[i]); ps += p[i]; }
    l += ps;
    const bf16x8 pb0 = pack_p(p), pb1 = pack_p(p + 8);
    __builtin_amdgcn_s_setprio(1);
    O[0] = mfma32(vf[0], pb0, O[0]); O[1] = mfma32(vf[1], pb0, O[1]);
    O[0] = mfma32(vf[2], pb1, O[0]); O[1] = mfma32(vf[3], pb1, O[1]);
    __builtin_amdgcn_s_setprio(0);
}
template <int MODE> __device__ __forceinline__ void flash_desc(int s, const LAS unsigned* list, int base, int t, int t0, int qi, int hi, int& tile, int& x0, unsigned& span, int& vm) {
    if constexpr (MODE == 0) {
        const unsigned e = (unsigned)__builtin_amdgcn_readfirstlane((int)list[s >> 1]);
        tile = 2 * (int)(e & 0xffffu) + (s & 1);
        const bool my = ((e >> 16) >> qi) & 1u; const int up = my ? (t - 32 * tile) : -1;
        x0 = up < 0 ? 64 : 8 * hi; span = up < 0 ? 0u : (unsigned)up;
        vm = (32 * tile + 31 <= t0) ? (((e >> 16) == 0xFFu) ? 0 : 1) : 2;
    } else {
        tile = base + s; x0 = 8 * hi - (t - 511 - 32 * tile); span = 511u;
        vm = (32 * tile + 31 <= t0 && 32 * tile >= t0 + 7 - 511) ? 0 : 2;
    }
}
template <int MODE> __device__ __forceinline__ void flash_run(const bf16x8* kb, const bf16x8* vb, const bf16x8 (&q)[4], int nsteps, const LAS unsigned* list, int base, int t, int t0, int qi, int hi, float& m, float& l, f32x16 (&O)[2]) {
    if (nsteps <= 0) return;
    bf16x8 kA[4], vA[4], kB[4], vB[4], kC[4], vC[4]; int x0A, x0B, x0C, vmA, vmB, vmC; unsigned spA, spB, spC;
#define FR_LOAD(S, KF, VF, X0, SP, VM) do { int tile_; const int sn_ = ((S) < nsteps) ? (S) : nsteps - 1; flash_desc<MODE>(sn_, list, base, t, t0, qi, hi, tile_, X0, SP, VM); \
        flash_load(kb + (size_t)tile_ * 256, vb + (size_t)tile_ * 256, KF, VF); } while (0)
    FR_LOAD(0, kA, vA, x0A, spA, vmA); FR_LOAD(1, kB, vB, x0B, spB, vmB);
#pragma unroll 1
    for (int s = 0; s < nsteps; s += 3) {
        FR_LOAD(s + 2, kC, vC, x0C, spC, vmC); flash_compute(vmA != 0, kA, vA, q, x0A, spA, m, l, O); if (s + 1 >= nsteps) break;
        FR_LOAD(s + 3, kA, vA, x0A, spA, vmA); flash_compute(vmB != 0, kB, vB, q, x0B, spB, m, l, O); if (s + 2 >= nsteps) break;
        FR_LOAD(s + 4, kB, vB, x0B, spB, vmB); flash_compute(vmC != 0, kC, vC, q, x0C, spC, m, l, O);
    }
#undef FR_LOAD
}

typedef float f32x4v __attribute__((ext_vector_type(4)));
__device__ __forceinline__ f32x4v mfma16(bf16x8 a, bf16x8 b, f32x4v c) { return __builtin_amdgcn_mfma_f32_16x16x32_bf16(a, b, c, 0, 0, 0); }
__device__ __forceinline__ float xq_max(float v) { const auto r = __builtin_amdgcn_permlane16_swap(__float_as_uint(v), __float_as_uint(v), false, false); return xhalf_max(fmaxf(__uint_as_float(r[0]), __uint_as_float(r[1]))); }
__device__ __forceinline__ float xq_sum(float v) { const auto r = __builtin_amdgcn_permlane16_swap(__float_as_uint(v), __float_as_uint(v), false, false); return xhalf_sum(__uint_as_float(r[0]) + __uint_as_float(r[1])); }
__device__ __forceinline__ void flash16_load(const bf16x8* kp, const bf16x8* vp, bf16x8 (&kf)[4], bf16x8 (&vf)[4]) {
#pragma unroll
    for (int s = 0; s < 4; ++s) kf[s] = kp[s * 64];
#pragma unroll
    for (int s = 0; s < 4; ++s) vf[s] = vp[s * 64];
    __builtin_amdgcn_sched_barrier(0);
}
__device__ __forceinline__ void flash16_compute(bool domask, const bf16x8 (&kf)[4], const bf16x8 (&vf)[4], const bf16x8 (&q)[2], int x0, unsigned span, float& m, float& l, f32x4v (&O)[4]) {
    f32x4v s0 = {0.f, 0.f, 0.f, 0.f}, s1 = {0.f, 0.f, 0.f, 0.f};
    __builtin_amdgcn_s_setprio(1);
    s0 = mfma16(kf[0], q[0], s0); s1 = mfma16(kf[2], q[0], s1);
    s0 = mfma16(kf[1], q[1], s0); s1 = mfma16(kf[3], q[1], s1);
    __builtin_amdgcn_s_setprio(0);
    float sc[8] = {s0[0], s0[1], s0[2], s0[3], s1[0], s1[1], s1[2], s1[3]};
    if (domask) {
#pragma unroll
        for (int j = 0; j < 8; ++j) sc[j] = ((unsigned)(x0 + j) <= span) ? sc[j] : -1e30f;
    }
    float mx = fmaxf(fmaxf(fmaxf(sc[0], sc[1]), fmaxf(sc[2], sc[3])), fmaxf(fmaxf(sc[4], sc[5]), fmaxf(sc[6], sc[7])));
    mx = xq_max(mx);
    const bool upd = mx > m + SM_THR;
    if (__ballot(upd) != 0ull) {
        const float mn = upd ? mx : m, alpha = ex2(m - mn); l *= alpha;
#pragma unroll
        for (int dt = 0; dt < 4; ++dt) O[dt] = O[dt] * alpha;
        m = mn;
    }
    const float msub = (m < -1e29f) ? 0.f : m;
    float p[8], ps = 0.f;
#pragma unroll
    for (int j = 0; j < 8; ++j) { p[j] = ex2(sc[j] - msub); ps += p[j]; }
    l += ps;
    const bf16x8 pb = pack_p(p);
    __builtin_amdgcn_s_setprio(1);
#pragma unroll
    for (int dt = 0; dt < 4; ++dt) O[dt] = mfma16(vf[dt], pb, O[dt]);
    __builtin_amdgcn_s_setprio(0);
}
__device__ __forceinline__ unsigned flash16_entry(int s, const LAS unsigned* list) {
    const unsigned e = (unsigned)__builtin_amdgcn_readfirstlane((int)list[s >> 1]);
    return (e & 0xffff0000u) | (2u * (e & 0xffffu) + (unsigned)(s & 1));
}
__device__ __forceinline__ void flash16_run(const bf16x8* kb, const bf16x8* vb, const bf16x8 (&qa)[2], const bf16x8 (&qb)[2], int nsteps, const LAS unsigned* list, int tq, int t0, int qi4, int fq,
                                            float& ma, float& la, f32x4v (&Oa)[4], float& mb, float& lb, f32x4v (&Ob)[4]) {
    if (nsteps <= 0) return;
    bf16x8 kA[4], vA[4], kB[4], vB[4], kC[4], vC[4]; unsigned eA, eB, eC;
#define F16_LOAD(S, KF, VF, E) do { const int sn_ = ((S) < nsteps) ? (S) : nsteps - 1; E = flash16_entry(sn_, list); const size_t go_ = (size_t)(E & 0xffffu) * 256; \
        flash16_load(kb + go_, vb + go_, KF, VF); } while (0)
#define F16_COMP(KF, VF, E) do { const int grp_ = (int)(E & 0xffffu); const unsigned na_ = (E >> 16) & 0xFu, nb_ = E >> 20; const bool past_ = 32 * grp_ + 31 <= t0; \
        if (na_) { const int up_ = ((na_ >> qi4) & 1u) ? (tq - 32 * grp_) : -1; flash16_compute(!(past_ && na_ == 0xFu), KF, VF, qa, up_ < 0 ? 64 : 8 * fq, up_ < 0 ? 0u : (unsigned)up_, ma, la, Oa); } \
        if (nb_) { const int up_ = ((nb_ >> qi4) & 1u) ? (tq + 4 - 32 * grp_) : -1; flash16_compute(!(past_ && nb_ == 0xFu), KF, VF, qb, up_ < 0 ? 64 : 8 * fq, up_ < 0 ? 0u : (unsigned)up_, mb, lb, Ob); } } while (0)
    F16_LOAD(0, kA, vA, eA); F16_LOAD(1, kB, vB, eB);
#pragma unroll 1
    for (int s = 0; s < nsteps; s += 3) {
        F16_LOAD(s + 2, kC, vC, eC); F16_COMP(kA, vA, eA); if (s + 1 >= nsteps) break;
        F16_LOAD(s + 3, kA, vA, eA); F16_COMP(kB, vB, eB); if (s + 2 >= nsteps) break;
        F16_LOAD(s + 4, kB, vB, eB); F16_COMP(kC, vC, eC);
    }
#undef F16_LOAD
#undef F16_COMP
}

__device__ __forceinline__ unsigned wave_max_u32(unsigned v) {
#define DPP_U(v, ctrl) ((unsigned)__builtin_amdgcn_update_dpp(0, (int)(v), ctrl, 0xF, 0xF, true))
    { unsigned t = DPP_U(v, 0xB1); v = v > t ? v : t; t = DPP_U(v, 0x4E); v = v > t ? v : t; t = DPP_U(v, 0x141); v = v > t ? v : t; t = DPP_U(v, 0x140); v = v > t ? v : t; }
#undef DPP_U
    { const auto r = __builtin_amdgcn_permlane16_swap(v, v, false, false); v = r[0] > r[1] ? r[0] : r[1]; }
    { const auto r = __builtin_amdgcn_permlane32_swap(v, v, false, false); v = r[0] > r[1] ? r[0] : r[1]; }
    return v;
}

__device__ __forceinline__ void nsa_tile(const Ctx& C, int b, int g, int t0) {
    const bf16_t* P = (const bf16_t*)(C.ws + WS_R1); bf16_t* Y = (bf16_t*)(C.ws + WS_Y);
    int lane_ = C.lane; asm volatile("" : "+v"(lane_));
    const int lane = lane_, r = lane & 31, hi = lane >> 5, qi = r >> 2, h = r & 3, head = g * 4 + h, bg = b * 2 + g;
    const int t = t0 + qi; const size_t tok = (size_t)b * S_ + t;
    LAS float* imp = (LAS float*)(C.lds + C.wave * 16640);
    LAS float* ost = (LAS float*)(C.lds + C.wave * 16640 + 8448) + lane;
    const float QS = 0.18033688011112042f;
    bf16x8 qf[4];
    {
        const bf16_t* qp = P + tok * PP + PC_Q + head * 64;
#pragma unroll
        for (int s = 0; s < 4; ++s) qf[s] = scale_q(*(const u32x4*)(qp + 16 * s + 8 * hi), QS);
    }
    const bf16_t* gp = P + tok * PP + PC_NG + head * 3;
    const float gc = sigm(bf1(gp[0])), gs = sigm(bf1(gp[1])), gw = sigm(bf1(gp[2]));

    const int cur = t0 >> 6;
    {
        const int nvq = (t >= 31) ? ((t - 31) >> 4) + 1 : 0;
        const int nvmin = (t0 >= 31) ? ((t0 - 31) >> 4) + 1 : 0;
        const int tl = t0 + 7, nvmax = (tl >= 31) ? ((tl - 31) >> 4) + 1 : 0, ntile = (nvmax + 31) >> 5;
        const bf16x8* kb = (const bf16x8*)(C.ws + WS_KCMP) + (size_t)bg * 32 * 4 * 64 + lane;
        const bf16x8* vb = (const bf16x8*)(C.ws + WS_VCMP) + (size_t)bg * 64 * 2 * 64 + lane;
        float m1 = -1e30f, l1 = 0.f;
#define CMP_P1(KF, KT) do { \
            f32x16 sc; _Pragma("unroll") for (int i = 0; i < 16; ++i) sc[i] = 0.f; \
            _Pragma("unroll") for (int s = 0; s < 4; ++s) sc = mfma32(KF[s], qf[s], sc); \
            if (nvmin - 1 - 32 * (KT) < 31) {     \
                asm volatile("" ::: "memory"); \
                const int up = nvq - 1 - 32 * (KT); const int x0 = up < 0 ? 64 : 8 * hi; const unsigned span = up < 0 ? 0u : (unsigned)up; \
                _Pragma("unroll") for (int i = 0; i < 16; ++i) sc[i] = ((unsigned)(x0 + i + (i >= 8 ? 8 : 0)) <= span) ? sc[i] : -1e30f; } \
            float mx = -1e30f; _Pragma("unroll") for (int i = 0; i < 16; ++i) mx = fmaxf(mx, sc[i]); \
            mx = xhalf_max(mx); \
            const float mn = fmaxf(m1, mx), msub = (mn < -1e29f) ? 0.f : mn; float ps = 0.f;     \
            _Pragma("unroll") for (int i = 0; i < 16; ++i) ps += ex2(sc[i] - msub); \
            l1 = l1 * ex2(m1 - mn) + ps; m1 = mn; } while (0)
        if (ntile > 0) {
            bf16x8 kA[4], kB[4], kC[4], kD[4];
#define CMP_LDK(KF, KT) do { const int kn_ = ((KT) < ntile) ? (KT) : ntile - 1; _Pragma("unroll") for (int s = 0; s < 4; ++s) KF[s] = kb[kn_ * 256 + s * 64]; } while (0)
            CMP_LDK(kA, 0); CMP_LDK(kB, 1); CMP_LDK(kC, 2);
#pragma unroll 1
            for (int kt = 0; kt < ntile; kt += 4) {
                CMP_LDK(kD, kt + 3); __builtin_amdgcn_sched_barrier(0); CMP_P1(kA, kt);     if (kt + 1 >= ntile) break;
                CMP_LDK(kA, kt + 4); __builtin_amdgcn_sched_barrier(0); CMP_P1(kB, kt + 1); if (kt + 2 >= ntile) break;
                CMP_LDK(kB, kt + 5); __builtin_amdgcn_sched_barrier(0); CMP_P1(kC, kt + 2); if (kt + 3 >= ntile) break;
                CMP_LDK(kC, kt + 6); __builtin_amdgcn_sched_barrier(0); CMP_P1(kD, kt + 3);
            }
        }
#undef CMP_P1
        l1 = xhalf_sum(l1);
        const float inv = 1.f / fmaxf(l1, 1e-30f), m1sub = (m1 < -1e29f) ? 0.f : m1;
        for (int e = lane; e < 8 * 264; e += 64) imp[e] = 0.f;
        LDS_WAIT();
        f32x16 O[2];
#pragma unroll
        for (int i = 0; i < 16; ++i) { O[0][i] = 0.f; O[1][i] = 0.f; }
#define CMP_P2(KF, VF, KT) do { \
            f32x16 sc; _Pragma("unroll") for (int i = 0; i < 16; ++i) sc[i] = 0.f; \
            _Pragma("unroll") for (int s = 0; s < 4; ++s) sc = mfma32(KF[s], qf[s], sc); \
            if (nvmin - 1 - 32 * (KT) < 31) { \
                asm volatile("" ::: "memory"); \
                const int up = nvq - 1 - 32 * (KT); const int x0 = up < 0 ? 64 : 8 * hi; const unsigned span = up < 0 ? 0u : (unsigned)up; \
                _Pragma("unroll") for (int i = 0; i < 16; ++i) sc[i] = ((unsigned)(x0 + i + (i >= 8 ? 8 : 0)) <= span) ? sc[i] : -1e30f; } \
            float p[16]; \
            _Pragma("unroll") for (int i = 0; i < 16; ++i) p[i] = ex2(sc[i] - m1sub) * inv; \
            _Pragma("unroll") for (int rr = 0; rr < 2; ++rr) { \
                const float* q8 = p + 8 * rr; \
                float a = q8[0] + q8[1] + q8[2] + 0.5f * q8[3], bq = 0.5f * q8[3] + q8[4] + q8[5] + q8[6] + 0.5f * q8[7], cq = 0.5f * q8[7]; \
                a += dpp_xor1(a); a += dpp_xor2(a); bq += dpp_xor1(bq); bq += dpp_xor2(bq); cq += dpp_xor1(cq); cq += dpp_xor2(cq); \
                _Pragma("unroll") for (int hh = 0; hh < 2; ++hh)     \
                if (h == 0 && hi == hh) { LAS float* ip = imp + qi * 264 + 8 * (KT) + 2 * hi + 4 * rr; \
                    __hip_atomic_fetch_add(ip, a, __ATOMIC_RELAXED, __HIP_MEMORY_SCOPE_WORKGROUP); __hip_atomic_fetch_add(ip + 1, bq, __ATOMIC_RELAXED, __HIP_MEMORY_SCOPE_WORKGROUP); \
                    __hip_atomic_fetch_add(ip + 2, cq, __ATOMIC_RELAXED, __HIP_MEMORY_SCOPE_WORKGROUP); } \
            } \
            const bf16x8 pb0 = pack_p(p), pb1 = pack_p(p + 8); \
            O[0] = mfma32(VF[0], pb0, O[0]); O[1] = mfma32(VF[1], pb0, O[1]); \
            O[0] = mfma32(VF[2], pb1, O[0]); O[1] = mfma32(VF[3], pb1, O[1]); } while (0)
        if (ntile > 0) {
            bf16x8 kA[4], kB[4], kC[4], vA[4];
#define CMP_LDV(KT) do { _Pragma("unroll") for (int s = 0; s < 4; ++s) vA[s] = vb[(KT) * 256 + s * 64]; } while (0)
            CMP_LDK(kA, 0); CMP_LDK(kB, 1);
#pragma unroll 1
            for (int kt = 0; kt < ntile; kt += 3) {
                CMP_LDK(kC, kt + 2); CMP_LDV(kt);     __builtin_amdgcn_sched_barrier(0); CMP_P2(kA, vA, kt);     if (kt + 1 >= ntile) break;
                CMP_LDK(kA, kt + 3); CMP_LDV(kt + 1); __builtin_amdgcn_sched_barrier(0); CMP_P2(kB, vA, kt + 1); if (kt + 2 >= ntile) break;
                CMP_LDK(kB, kt + 4); CMP_LDV(kt + 2); __builtin_amdgcn_sched_barrier(0); CMP_P2(kC, vA, kt + 2);
            }
#undef CMP_LDV
#undef CMP_LDK
        }
#undef CMP_P2
#pragma unroll
        for (int i = 0; i < 16; ++i) { ost[i * 64] = gc * O[0][i]; ost[(16 + i) * 64] = gc * O[1][i]; }
        LDS_WAIT();
    }

    unsigned bmv[4];
    if (cur <= 15) {
#pragma unroll
        for (int c = 0; c < 4; ++c) bmv[c] = (lane + 64 * c <= cur) ? 0xFFu : 0u;
    } else {
        unsigned key[8][4];
#pragma unroll
        for (int q2 = 0; q2 < 8; ++q2)
#pragma unroll
            for (int c = 0; c < 4; ++c) { const int j = lane + 64 * c; const bool cand = (j >= 1) && (j < cur - 1); const float v = imp[q2 * 264 + j];
                key[q2][c] = cand ? ((__float_as_uint(v) & 0xFFFFFF00u) | (unsigned)(255 - j)) : 0u; }
#pragma unroll
        for (int c = 0; c < 4; ++c) bmv[c] = 0u;
#pragma unroll 1
        for (int round = 0; round < 13; ++round) {
#pragma unroll
            for (int q2 = 0; q2 < 8; ++q2) {
                unsigned mx = key[q2][0]; mx = mx > key[q2][1] ? mx : key[q2][1]; mx = mx > key[q2][2] ? mx : key[q2][2]; mx = mx > key[q2][3] ? mx : key[q2][3];
                const unsigned w = wave_max_u32(mx);
#pragma unroll
                for (int c = 0; c < 4; ++c) { const bool win = (key[q2][c] == w) && (w != 0u); key[q2][c] = win ? 0u : key[q2][c]; bmv[c] |= win ? (1u << q2) : 0u; }
            }
        }
#pragma unroll
        for (int c = 0; c < 4; ++c) { const int j = lane + 64 * c; if (j == 0 || j == cur || j == cur - 1) bmv[c] = 0xFFu; }
    }

    {
        LAS unsigned* list = (LAS unsigned*)imp;
        LAS float* ostb = (LAS float*)(C.lds + C.wave * 16640 + 8448);
        const int q16 = lane & 15, fq = lane >> 4, qi4 = q16 >> 2, head4 = g * 4 + (q16 & 3);
        const bf16x8* kb = (const bf16x8*)(C.ws + WS_KSLC) + (size_t)bg * 512 * 256 + lane;
        const bf16x8* vb = (const bf16x8*)(C.ws + WS_VSLC) + (size_t)bg * 512 * 256 + lane;
        int nblk = 0;
#pragma unroll
        for (int c = 0; c < 4; ++c) {
            const unsigned long long mk = __ballot(bmv[c] != 0u);
            const int pos = nblk + (int)__builtin_amdgcn_mbcnt_hi((unsigned)(mk >> 32), __builtin_amdgcn_mbcnt_lo((unsigned)mk, 0u));
            if (bmv[c] != 0u) list[pos] = (unsigned)(lane + 64 * c) | (bmv[c] << 16);
            nblk += __builtin_popcountll(mk);
        }
        LDS_WAIT();
        const int tq = t0 + qi4;
        bf16x8 q16f[2][2]; float gs4[2];
#pragma unroll
        for (int sub = 0; sub < 2; ++sub) {
            const size_t tok4 = (size_t)b * S_ + tq + 4 * sub;
            const bf16_t* qp = P + tok4 * PP + PC_Q + head4 * 64;
            q16f[sub][1] = scale_q(*(const u32x4*)(qp + 32 + 8 * fq), QS);
            const u32x4 mv4 = *(const u32x4*)(qp + 8 * fq), pv4 = *(const u32x4*)(qp + 8 * ((fq ^ 1) & 1));
            const float* rt = (const float*)(C.ws + WS_ROPE) + tok4 * 16;
            const f32x4 ca = *(const f32x4*)rt, cb2 = *(const f32x4*)(rt + 4), sa = *(const f32x4*)(rt + 8), sb = *(const f32x4*)(rt + 12);
            const float cs[8] = {ca.x, ca.y, ca.z, ca.w, cb2.x, cb2.y, cb2.z, cb2.w}, sn[8] = {sa.x, sa.y, sa.z, sa.w, sb.x, sb.y, sb.z, sb.w};
            const float mv[8] = {bf_lo(mv4.x), bf_hi(mv4.x), bf_lo(mv4.y), bf_hi(mv4.y), bf_lo(mv4.z), bf_hi(mv4.z), bf_lo(mv4.w), bf_hi(mv4.w)};
            const float pp[8] = {bf_lo(pv4.x), bf_hi(pv4.x), bf_lo(pv4.y), bf_hi(pv4.y), bf_lo(pv4.z), bf_hi(pv4.z), bf_lo(pv4.w), bf_hi(pv4.w)};
            const bool roped = fq < 2; const float sg = (fq == 0) ? -1.f : 1.f; float o[8];
#pragma unroll
            for (int e = 0; e < 8; ++e) o[e] = (roped ? (mv[e] * cs[e] + sg * pp[e] * sn[e]) : mv[e]) * QS;
            q16f[sub][0] = pack_p(o);
            gs4[sub] = sigm(bf1(P[tok4 * PP + PC_NG + head4 * 3 + 1]));
        }
        float ma = -1e30f, la = 0.f, mb = -1e30f, lb = 0.f; f32x4v Oa[4], Ob[4];
#pragma unroll
        for (int dt = 0; dt < 4; ++dt) { Oa[dt] = (f32x4v){0.f, 0.f, 0.f, 0.f}; Ob[dt] = (f32x4v){0.f, 0.f, 0.f, 0.f}; }
        flash16_run(kb, vb, q16f[0], q16f[1], 2 * nblk, list, tq, t0, qi4, fq, ma, la, Oa, mb, lb, Ob);
        la = xq_sum(la); lb = xq_sum(lb);
        const float sca = gs4[0] / fmaxf(la, 1e-30f), scb = gs4[1] / fmaxf(lb, 1e-30f);
#pragma unroll
        for (int dt = 0; dt < 4; ++dt)
#pragma unroll
            for (int i = 0; i < 4; ++i) { LAS float* op = ostb + ((dt >> 1) * 16 + 4 * (2 * (dt & 1) + (fq >> 1)) + i) * 64 + q16 + 32 * (fq & 1); op[0] += sca * Oa[dt][i]; op[16] += scb * Ob[dt][i]; }
        LDS_WAIT();
    }
    {
        bf16x8 qr[4];
        {
            const bf16_t* qp = P + tok * PP + PC_Q + head * 64;
#pragma unroll
            for (int s = 1; s < 4; ++s) qr[s] = scale_q(*(const u32x4*)(qp + 16 * s + 8 * hi), QS);
            const u32x4 mv4 = *(const u32x4*)(qp + 8 * hi), pv4 = *(const u32x4*)(qp + 8 * (hi ^ 1));
            const float* rt = (const float*)(C.ws + WS_ROPE) + tok * 16;
            const f32x4 ca = *(const f32x4*)rt, cb2 = *(const f32x4*)(rt + 4), sa = *(const f32x4*)(rt + 8), sb = *(const f32x4*)(rt + 12);
            const float cs[8] = {ca.x, ca.y, ca.z, ca.w, cb2.x, cb2.y, cb2.z, cb2.w}, sn[8] = {sa.x, sa.y, sa.z, sa.w, sb.x, sb.y, sb.z, sb.w};
            const float mv[8] = {bf_lo(mv4.x), bf_hi(mv4.x), bf_lo(mv4.y), bf_hi(mv4.y), bf_lo(mv4.z), bf_hi(mv4.z), bf_lo(mv4.w), bf_hi(mv4.w)};
            const float pp[8] = {bf_lo(pv4.x), bf_hi(pv4.x), bf_lo(pv4.y), bf_hi(pv4.y), bf_lo(pv4.z), bf_hi(pv4.z), bf_lo(pv4.w), bf_hi(pv4.w)};
            const float sg = hi ? 1.f : -1.f; float o[8];
#pragma unroll
            for (int e = 0; e < 8; ++e) o[e] = (mv[e] * cs[e] + sg * pp[e] * sn[e]) * QS;
            qr[0] = pack_p(o);
        }
        const bf16x8* kb = (const bf16x8*)(C.ws + WS_KWIN) + (size_t)bg * 512 * 4 * 64 + lane;
        const bf16x8* vb = (const bf16x8*)(C.ws + WS_VWIN) + (size_t)bg * 1024 * 2 * 64 + lane;
        float m = -1e30f, l = 0.f; f32x16 O[2];
#pragma unroll
        for (int i = 0; i < 16; ++i) { O[0][i] = 0.f; O[1][i] = 0.f; }
        const int tlo = (t0 - 511 > 0 ? t0 - 511 : 0) >> 5, thi = (t0 + 7) >> 5;
        flash_run<1>(kb, vb, qr, thi - tlo + 1, (const LAS unsigned*)imp, tlo, t, t0, qi, hi, m, l, O);
        l = xhalf_sum(l);
        const float sc = gw / fmaxf(l, 1e-30f);
        bf16_t* yp = Y + tok * YP + 512 + head * 64 + 4 * hi;
#pragma unroll
        for (int dt = 0; dt < 2; ++dt)
#pragma unroll
            for (int ig = 0; ig < 4; ++ig) { float o4[4];
#pragma unroll
                for (int e = 0; e < 4; ++e) o4[e] = ost[(dt * 16 + 4 * ig + e) * 64] + sc * O[dt][4 * ig + e];
                u32x2 w; w.x = cvt_pk_bf16(o4[0], o4[1]); w.y = cvt_pk_bf16(o4[2], o4[3]); *(u32x2*)(yp + 32 * dt + 8 * ig) = w; }
        LDS_WAIT();
    }
}

__device__ __forceinline__ void mem_tile(const Ctx& C, int b, int hm, int t0) {
    const bf16_t* P = (const bf16_t*)(C.ws + WS_R1); bf16_t* Y = (bf16_t*)(C.ws + WS_Y);
    int lane_ = C.lane; asm volatile("" : "+v"(lane_));
    const int lane = lane_, r = lane & 31, hi = lane >> 5;
    const size_t tok = (size_t)b * S_ + t0 + r;
    const float QS = 0.12751743082459868f;
    bf16x8 q[8];
    const bf16_t* qp = P + tok * PP + PC_QM + hm * 128;
#pragma unroll
    for (int s = 0; s < 8; ++s) q[s] = scale_q(*(const u32x4*)(qp + 16 * s + 8 * hi), QS);
    const bf16x8* kb = (const bf16x8*)(C.ws + WS_MEMK) + (size_t)(b * 4 + hm) * 8 * 8 * 64 + lane;
    const bf16x8* vb = (const bf16x8*)(C.ws + WS_MEMV) + (size_t)(b * 4 + hm) * 16 * 4 * 64 + lane;
    float m = -1e30f, l = 0.f; f32x16 O[4];
#pragma unroll
    for (int i = 0; i < 16; ++i) { O[0][i] = 0.f; O[1][i] = 0.f; O[2][i] = 0.f; O[3][i] = 0.f; }
#define MEM_STEP(KF, VF) do { \
        f32x16 sc; _Pragma("unroll") for (int i = 0; i < 16; ++i) sc[i] = 0.f; \
        _Pragma("unroll") for (int s = 0; s < 8; ++s) sc = mfma32(KF[s], q[s], sc); \
        float mx = -1e30f; _Pragma("unroll") for (int i = 0; i < 16; ++i) mx = fmaxf(mx, sc[i]); \
        mx = xhalf_max(mx); \
        const bool upd = mx > m + SM_THR; \
        if (__ballot(upd) != 0ull) { const float mn = upd ? mx : m, alpha = ex2(m - mn); l *= alpha; O[0] = O[0] * alpha; O[1] = O[1] * alpha; O[2] = O[2] * alpha; O[3] = O[3] * alpha; m = mn; } \
        float p[16], ps = 0.f; _Pragma("unroll") for (int i = 0; i < 16; ++i) { p[i] = ex2(sc[i] - m); ps += p[i]; } \
        l += ps; \
        const bf16x8 pb0 = pack_p(p), pb1 = pack_p(p + 8); \
        _Pragma("unroll") for (int dt = 0; dt < 4; ++dt) { O[dt] = mfma32(VF[dt], pb0, O[dt]); O[dt] = mfma32(VF[4 + dt], pb1, O[dt]); } } while (0)
    {
        bf16x8 kA[8], vv[8];
#pragma unroll 1
        for (int kt = 0; kt < 8; ++kt) {
#pragma unroll
            for (int s = 0; s < 8; ++s) kA[s] = kb[kt * 512 + s * 64];
#pragma unroll
            for (int s = 0; s < 8; ++s) vv[s] = vb[kt * 512 + s * 64];
            __builtin_amdgcn_sched_barrier(0);
            MEM_STEP(kA, vv);
        }
    }
#undef MEM_STEP
    l = xhalf_sum(l);
    const float inv = 1.f / l;
    bf16_t* yp = Y + tok * YP + 1024 + hm * 128 + 4 * hi;
#pragma unroll
    for (int dt = 0; dt < 4; ++dt)
#pragma unroll
        for (int ig = 0; ig < 4; ++ig) { u32x2 w; w.x = cvt_pk_bf16(O[dt][4 * ig] * inv, O[dt][4 * ig + 1] * inv); w.y = cvt_pk_bf16(O[dt][4 * ig + 2] * inv, O[dt][4 * ig + 3] * inv); *(u32x2*)(yp + 32 * dt + 8 * ig) = w; }
}

__device__ __forceinline__ void attention_phase(const Ctx& C) {
    const int bxx = C.gw / NWAVES; const bool xmode = (C.G & 7) == 0;
    const int x = bxx & 7, rank = xmode ? (bxx >> 3) * NWAVES + C.wave : C.gw, nrank = xmode ? (C.G >> 3) * NWAVES : C.NGW, nitem = xmode ? 1536 : 12288;
    const int nper = (nitem + nrank - 1) / nrank, nmem_it = xmode ? (512 + nrank - 1) / nrank : 0; const bool flip = xmode && (C.wave & 4) && (nitem % nrank == 0);
    for (int k0 = 0; k0 < nper; ++k0) {
        const int kk = flip ? (k0 + (nper - nmem_it)) % nper : k0; const int i = rank + kk * nrank; if (i >= nitem) continue;
        int nsa_n, mem_e;
        if (xmode) { nsa_n = (i < 1024) ? (x >> 1) * 2048 + 2 * i + (x & 1) : -1; mem_e = x * 512 + (i - 1024); }
        else { if (i < 8192) { const int k = i >> 11, w = i & 2047; nsa_n = k * 2048 + ((k & 1) ? 2047 - w : w); } else nsa_n = -1; mem_e = i - 8192; }
        if (nsa_n >= 0) { const int k = nsa_n >> 11; nsa_tile(C, k >> 1, k & 1, (nsa_n & 2047) * 8); }
        else { const int bh = mem_e >> 9; mem_tile(C, bh >> 2, bh & 3, (mem_e & 511) * 32); }
    }
}

#define XB_TMO      128
#define XB_XCNT(j)  (256  + 64 * (j))
#define XB_XSUB(j)  (1280 + 64 * (j))
#define XB_XGEN(j)  (2304 + 64 * (j))
#define XB_TOP      3328
#define XB_TOPGEN   3392
#define XCD_BAR_WORDS 3456
#define XB_SPIN_CAP (1u << 18)
__device__ __forceinline__ unsigned xb_ld(unsigned* p)              { return __hip_atomic_load(p, __ATOMIC_RELAXED, __HIP_MEMORY_SCOPE_AGENT); }
__device__ __forceinline__ unsigned xb_add(unsigned* p, unsigned v) { return __hip_atomic_fetch_add(p, v, __ATOMIC_RELAXED, __HIP_MEMORY_SCOPE_AGENT); }
__device__ __forceinline__ unsigned xb_xcc_id() { return (unsigned)__builtin_amdgcn_s_getreg((3 << 11) | 20) & 0xFu; }
#define XB_SPIN(cond, bar) do { unsigned _sp = 0; while (cond) { __builtin_amdgcn_s_sleep(1); \
    if ((++_sp & 255u) == 0u) { if (xb_ld(&(bar)[XB_TMO])) break; if (_sp > XB_SPIN_CAP) { atomicAdd(&(bar)[XB_TMO], 1u); break; } } } } while (0)
__device__ __forceinline__ void xcd_barrier_complete(unsigned* bar, unsigned x, unsigned& nloc, unsigned& nx) {
    const unsigned G = gridDim.x * gridDim.y * gridDim.z;
    unsigned sum, cnt, mine, sp = 0u;
    for (;;) {
        sum = 0u; cnt = 0u; mine = 0u;
#pragma unroll
        for (unsigned j = 0; j < 16; ++j) { const unsigned c = xb_ld(&bar[XB_XCNT(j)]); sum += c; cnt += (c > 0u) ? 1u : 0u; mine = (j == x) ? c : mine; }
        if (sum == G) break;
        __builtin_amdgcn_s_sleep(1);
        if ((++sp & 255u) == 0u) { if (xb_ld(&bar[XB_TMO])) break; if (sp > XB_SPIN_CAP) { atomicAdd(&bar[XB_TMO], 1u); break; } }
    }
    nloc = mine > 0u ? mine : 1u; nx = cnt > 0u ? cnt : 1u;
}
__device__ __forceinline__ void xcd_barrier(unsigned* bar, volatile LAS unsigned* st, bool tid0) {
    asm volatile("s_waitcnt vmcnt(0)" ::: "memory");
    __syncthreads();
    if (tid0) {
        __builtin_amdgcn_s_waitcnt(0);
        const unsigned x = xb_xcc_id();
        unsigned nloc = st[0], nx = st[1];
        if (nloc == 0u) { xcd_barrier_complete(bar, x, nloc, nx); st[0] = nloc; st[1] = nx; }
        const unsigned old = xb_add(&bar[XB_XSUB(x)], 1u);
        const unsigned gen = old / nloc;
        if (old + 1u == (gen + 1u) * nloc) {
            __builtin_amdgcn_fence(__ATOMIC_RELEASE, "agent");
            asm volatile("s_waitcnt vmcnt(0)" ::: "memory");
            const unsigned og = xb_add(&bar[XB_TOP], 1u);
            const unsigned tg = og / nx;
            if (og + 1u == (tg + 1u) * nx) xb_add(&bar[XB_TOPGEN], 1u);
            else XB_SPIN(xb_ld(&bar[XB_TOPGEN]) == tg, bar);
            __builtin_amdgcn_fence(__ATOMIC_ACQUIRE, "agent");
            xb_add(&bar[XB_XGEN(x)], 1u);
            asm volatile("s_waitcnt vmcnt(0)" ::: "memory");
        } else {
            XB_SPIN(xb_ld(&bar[XB_XGEN(x)]) == gen, bar);
            __builtin_amdgcn_fence(__ATOMIC_ACQUIRE, "agent");
            asm volatile("s_waitcnt vmcnt(0)" ::: "memory");
        }
    }
    __syncthreads();
}

constexpr int LDS_BYTES = 147456, XB_LDS_OFF = 147456 - 64;
constexpr int NPHASE = 1 + 2 * 14;

__global__ void __launch_bounds__(NWAVES * 64, 2) fwd_kernel(Args args) {
    extern __shared__ __attribute__((aligned(16))) unsigned char lds_raw[];
    cg::grid_group grid = cg::this_grid();
    if (args.ph_lo == 0x7fffffff) grid.sync();
    const int wave0 = __builtin_amdgcn_readfirstlane((int)threadIdx.x >> 6);
    {
        volatile LAS unsigned* st = (volatile LAS unsigned*)(lds_raw + XB_LDS_OFF);
        if (threadIdx.x == 0) { st[0] = 0u; st[1] = 0u; (void)xb_add((unsigned*)(args.ws + WS_BAR) + XB_XCNT(xb_xcc_id()), 1u); }
        __syncthreads();
    }
#define PHASE_BEGIN { \
        unsigned char* ws0_ = args.ws; asm volatile("" : "+s"(ws0_)); gu8* ws = (gu8*)ws0_;     \
        int tid_; asm volatile("v_mbcnt_lo_u32_b32 %0, -1, 0\n\tv_mbcnt_hi_u32_b32 %0, -1, %0" : "=v"(tid_)); tid_ += wave0 * 64; \
        Ctx C; C.a = &args; C.ws = ws; C.lds = (LAS unsigned char*)lds_raw; C.tid = tid_; C.lane = tid_ & 63; C.wave = __builtin_amdgcn_readfirstlane(tid_ >> 6); \
        int bx = blockIdx.x; asm volatile("" : "+s"(bx)); C.G = gridDim.x; C.gw = bx * NWAVES + C.wave; C.NGW = C.G * NWAVES; \
        bf16_t* const H = (bf16_t*)(ws + WS_H); bf16_t* const R1 = (bf16_t*)(ws + WS_R1); bf16_t* const Y = (bf16_t*)(ws + WS_Y); (void)H; (void)R1; (void)Y; (void)bx;
#define PHASE_END   { int ln_; asm volatile("v_mbcnt_lo_u32_b32 %0, -1, 0\n\tv_mbcnt_hi_u32_b32 %0, -1, %0" : "=v"(ln_));   \
        xcd_barrier((unsigned*)(ws + WS_BAR), (volatile LAS unsigned*)(lds_raw + XB_LDS_OFF), (wave0 == 0) && (ln_ == 0)); } }
#define PHASE_END_IF(c_) { if (c_) { int ln_; asm volatile("v_mbcnt_lo_u32_b32 %0, -1, 0\n\tv_mbcnt_hi_u32_b32 %0, -1, %0" : "=v"(ln_));   \
        xcd_barrier((unsigned*)(ws + WS_BAR), (volatile LAS unsigned*)(lds_raw + XB_LDS_OFF), (wave0 == 0) && (ln_ == 0)); } } }
#define PHASE_END_CG grid.sync(); }

    PHASE_BEGIN
        convert_layer(C, 0);
        rope_table(C);
        prenorm_rows(C, (const float*)args.in[0], (const float*)args.in[3], H);
    PHASE_END

#pragma unroll 1
    for (int l = 0; l < 2; ++l) {
        PHASE_BEGIN
            { pg8::GemmDesc g{(const char*)H, (const char*)(ws + WS_W1IN), DM, DM, 128, 128, 16}; pg8::StdOrder S; S.init(T_, 2 * FF, C.G, bx, DM, DM);
              pg8::Epi<1> E{R1, FF, nullptr, nullptr}; pg8::gemm_phase(C.lds, C.tid, g, S, E); }
        PHASE_END
        PHASE_BEGIN
            { pg8::GemmDesc g{(const char*)R1, (const char*)(ws + WS_W1OUT), FF, FF, 128, 128, 44}; pg8::StdOrder S; S.init(T_, DM, C.G, bx, FF, FF);
              pg8::Epi<0> E{H, DM, nullptr, nullptr}; pg8::gemm_phase(C.lds, C.tid, g, S, E); }
        PHASE_END
        PHASE_BEGIN
            if (bx < 8) {
                { pg8::GemmDesc g{(const char*)(ws + WS_MEMN), (const char*)(ws + WS_WMKV), DM, DM, 128, 128, 16}; pg8::StdOrder S; S.init(512, DM, C.G, bx, DM, DM);
              pg8::Epi<0> E{(bf16_t*)(ws + WS_MKV), DM, nullptr, nullptr}; pg8::gemm_phase(C.lds, C.tid, g, S, E); }
            } else {
                norm_phase(C, C.gw - 8 * NWAVES, C.NGW - 8 * NWAVES, l == 0 ? (const float*)args.in[0] : args.out, args.out, H, H, INF(4, l, DM), INF(7, l, DM), 0.5f);
            }
            cb_reduce(C, l);
        PHASE_END
        PHASE_BEGIN
            { pg8::GemmDesc g{(const char*)H, (const char*)(ws + WS_WMIX), DM, DM, 128, 128, 16}; pg8::StdOrder S; S.init(T_, PP, C.G, bx, DM, DM);
              pg8::Epi<0> E{R1, PP, nullptr, nullptr}; pg8::gemm_phase(C.lds, C.tid, g, S, E); }
        PHASE_END
        PHASE_BEGIN
            if (bx < 64) {
                pg8::GemmDesc g{(const char*)R1, (const char*)(ws + WS_WC1), 16 * PP, 2048, PP * 2, 128, 16}; pg8::CmpOrder S{bx};
                pg8::Epi<0> E{(bf16_t*)(ws + WS_CMPP), 256, nullptr, nullptr}; pg8::gemm_phase(C.lds, C.tid, g, S, E);
            } else {
                prep_items(C, l, C.gw - 64 * NWAVES, C.NGW - 64 * NWAVES);
                memkv_ops(C, C.gw - 64 * NWAVES, C.NGW - 64 * NWAVES);
            }
        PHASE_END
        PHASE_BEGIN
            cmp_stage2(C, l);
        PHASE_END
        PHASE_BEGIN
            attention_phase(C);
        PHASE_END
        PHASE_BEGIN
            { pg8::GemmDesc g{(const char*)H, (const char*)(ws + WS_WG), DM, DM, 128, 128, 16}; pg8::StdOrder S; S.init(T_, GP, C.G, bx, DM, DM);
              pg8::Epi<2> E{R1, GP, nullptr, nullptr}; pg8::gemm_phase(C.lds, C.tid, g, S, E); }
        PHASE_END
        PHASE_BEGIN
            { pg8::GemmDesc g{(const char*)Y, (const char*)(ws + WS_WBR), YP, YP, 128, 128, 8}; pg8::MergeOrder S; S.init(T_, DM, C.G, bx, YP, YP);
              pg8::Epi<3> E{H, DM, R1, nullptr}; pg8::gemm_phase(C.lds, C.tid, g, S, E); }
        PHASE_END
        PHASE_BEGIN
            { pg8::GemmDesc g{(const char*)H, (const char*)(ws + WS_WOUT), DM, DM, 128, 128, 16}; pg8::StdOrder S; S.init(T_, DM, C.G, bx, DM, DM);
              pg8::Epi<0> E{R1, DM, nullptr, nullptr}; pg8::gemm_phase(C.lds, C.tid, g, S, E); }
        PHASE_END
        PHASE_BEGIN
            norm_phase(C, C.gw, C.NGW, args.out, args.out, R1, H, INF(8, l, DM), INF(25, l, DM), 1.0f);
        PHASE_END
        PHASE_BEGIN
            { pg8::GemmDesc g{(const char*)H, (const char*)(ws + WS_W2IN), DM, DM, 128, 128, 16}; pg8::StdOrder S; S.init(T_, 2 * FF, C.G, bx, DM, DM);
              pg8::Epi<1> E{R1, FF, nullptr, nullptr}; pg8::gemm_phase(C.lds, C.tid, g, S, E); }
        PHASE_END
        PHASE_BEGIN
            { pg8::GemmDesc g{(const char*)R1, (const char*)(ws + WS_W2OUT), FF, FF, 128, 128, 44}; pg8::StdOrder S; S.init(T_, DM, C.G, bx, FF, FF);
              pg8::Epi<0> E{H, DM, nullptr, nullptr}; pg8::gemm_phase(C.lds, C.tid, g, S, E); }
        PHASE_END
        PHASE_BEGIN
            norm_phase(C, C.gw, C.NGW, args.out, args.out, H, H, INF(26, l, DM), l == 0 ? INF(3, 1, DM) : nullptr, 0.5f);
            if (l == 0) convert_layer(C, 1);
        PHASE_END_IF(l == 0)
    }
}

extern "C" void kernel_launch(void* const* d_in, const int* in_sizes, int n_in, void* d_out, int out_size, void* d_ws, size_t ws_size, hipStream_t stream) {
    static int grid = 0;
    if (grid == 0) {
        if (n_in != 29 || ws_size < WS_END) { fprintf(stderr, "kernel_launch: unexpected n_in %d / ws %zu\n", n_in, ws_size); grid = -1; return; }
        int dev = 0, cus = 0, per_cu = 0;
        hipGetDevice(&dev); hipDeviceGetAttribute(&cus, hipDeviceAttributeMultiprocessorCount, dev);
        hipFuncSetAttribute((const void*)fwd_kernel, hipFuncAttributeMaxDynamicSharedMemorySize, LDS_BYTES);
        hipOccupancyMaxActiveBlocksPerMultiprocessor(&per_cu, (const void*)fwd_kernel, NWAVES * 64, LDS_BYTES);
        if (per_cu < 1) per_cu = 1;
        grid = cus * per_cu;
        (void)hipGetLastError();
    }
    if (grid < 0) return;
    hipMemsetAsync((char*)d_ws + WS_BAR, 0, 16384, stream);
    Args a{};
    for (int i = 0; i < 29; ++i) a.in[i] = d_in[i];
    a.out = (float*)d_out; a.ws = (unsigned char*)d_ws; a.ph_lo = 0; a.ph_hi = NPHASE;
    void* kargs[] = {&a};
    hipError_t e = hipLaunchCooperativeKernel((const void*)fwd_kernel, dim3(grid), dim3(NWAVES * 64), kargs, LDS_BYTES, stream);
    if (e != hipSuccess) fprintf(stderr, "cooperative launch failed: %s (grid %d)\n", hipGetErrorString(e), grid);
}
```

```cpp
#include <hip/hip_runtime.h>
#include <hip/hip_cooperative_groups.h>
#include <cstdio>
#include <cstdint>
namespace cg = cooperative_groups;

#define LAS __attribute__((address_space(3)))
typedef unsigned short bf16_t;
typedef short bf16x8 __attribute__((ext_vector_type(8)));
typedef float f32x4 __attribute__((ext_vector_type(4)));
typedef float f32x16 __attribute__((ext_vector_type(16)));
typedef unsigned u32x4 __attribute__((ext_vector_type(4)));
typedef unsigned u32x2 __attribute__((ext_vector_type(2)));

constexpr int NBATCH = 2, S_ = 16384, T_ = NBATCH * S_, DM = 1024, FF = 2816, PP = 3584, GP = 3072, YP = 1536;
constexpr int NWAVES = 8;
constexpr float EPS = 1e-6f;
constexpr int PC_Q = 1536, PC_KV = 2048, PC_QM = 2816, PC_NG = 3328;

constexpr size_t MiB = 1u << 20;
constexpr size_t WS_W1IN = 0, WS_W1OUT = 11 * MiB, WS_WMIX = WS_W1OUT + 11 * MiB / 2, WS_WG = WS_WMIX + 7 * MiB, WS_WBR = WS_WG + 6 * MiB, WS_WOUT = WS_WBR + 3 * MiB,
                 WS_W2IN = WS_WOUT + 2 * MiB, WS_W2OUT = WS_W2IN + 11 * MiB, WS_WC1 = WS_W2OUT + 11 * MiB / 2  , WS_WMKV = WS_WC1 + 2 * MiB,
                 WS_MEMN = WS_WMKV + 2 * MiB, WS_MKV = WS_MEMN + 1 * MiB, WS_CB = WS_MKV + 1 * MiB  , WS_CBP = WS_CB + 8192  , WS_BAR = WS_CB + 8192 + 131072  ;
static_assert(WS_CB == 57 * MiB, "ws map");
constexpr size_t WS_ROPE = 58 * MiB, WS_MEMK = 60 * MiB, WS_MEMV = WS_MEMK + MiB / 2, WS_KCMP = 61 * MiB, WS_VCMP = WS_KCMP + MiB / 2, WS_CMPH = 62 * MiB,
                 WS_KSLC = 66 * MiB, WS_VSLC = 74 * MiB, WS_KWIN = 82 * MiB, WS_VWIN = 90 * MiB, WS_H = 98 * MiB, WS_Y = 162 * MiB, WS_R1 = 258 * MiB, WS_CMPP = 484 * MiB  , WS_END = 492 * MiB;

typedef float f32x2_t __attribute__((ext_vector_type(2)));
typedef __bf16 bf16x2_t __attribute__((ext_vector_type(2)));
__device__ __forceinline__ unsigned cvt_pk_bf16(float lo, float hi) { f32x2_t v = {lo, hi}; bf16x2_t b = __builtin_convertvector(v, bf16x2_t); return __builtin_bit_cast(unsigned, b); }
__device__ __forceinline__ float bf_lo(unsigned u) { return __uint_as_float(u << 16); }
__device__ __forceinline__ float bf_hi(unsigned u) { return __uint_as_float(u & 0xffff0000u); }
__device__ __forceinline__ float bf1(bf16_t u) { return __uint_as_float(((unsigned)u) << 16); }
__device__ __forceinline__ float ex2(float x) { return __builtin_amdgcn_exp2f(x); }
__device__ __forceinline__ float rcpf_(float x) { return __builtin_amdgcn_rcpf(x); }
__device__ __forceinline__ float sigm(float x) { return rcpf_(1.f + ex2(-1.44269504f * x)); }
__device__ __forceinline__ float gelu_tanh(float x) { const float u = 0.7978845608f * (x + 0.044715f * x * x * x); return x * rcpf_(1.f + ex2(-2.88539008f * u)); }
#define DPP_F(v, ctrl) __int_as_float(__builtin_amdgcn_update_dpp(0, __float_as_int(v), ctrl, 0xF, 0xF, true))
__device__ __forceinline__ float wave_sum(float v) {
    v += DPP_F(v, 0xB1); v += DPP_F(v, 0x4E); v += DPP_F(v, 0x141); v += DPP_F(v, 0x140);
    { const auto r = __builtin_amdgcn_permlane16_swap(__float_as_uint(v), __float_as_uint(v), false, false); v = __uint_as_float(r[0]) + __uint_as_float(r[1]); }
    { const auto r = __builtin_amdgcn_permlane32_swap(__float_as_uint(v), __float_as_uint(v), false, false); v = __uint_as_float(r[0]) + __uint_as_float(r[1]); }
    return v;
}
__device__ __forceinline__ int pi32(int r) { return (r & 0x13) | ((r & 4) << 1) | ((r & 8) >> 1); }
#define LDS_WAIT() asm volatile("s_waitcnt lgkmcnt(0)" ::: "memory")

namespace pg8 {
constexpr int BM = 256, BK = 64, HALF = 128, HTB = HALF * BK * 2, STAGE_BYTES = 8 * HTB, NXCD = 8, WGM = 8;
__device__ __forceinline__ int lds_byte(int r, int c) { const int st = (r >> 4) * 2 + (c >> 5), rr = r & 15, cc = c & 31, ob = rr * 64 + cc * 2; return st * 1024 + (ob ^ (((ob >> 9) & 1) << 5)); }
__device__ __forceinline__ void stage_rc(int b, int& R, int& C) { const int st = b / 1024, sb = b % 1024, swz = sb ^ (((sb >> 9) & 1) << 5); R = (st >> 1) * 16 + swz / 64; C = (st & 1) * 32 + (swz % 64) / 2; }
__device__ __forceinline__ int perm32(int rho) { const int n = rho >> 4, i = rho & 15; return 8 * (i >> 2) + 4 * n + (i & 3); }

struct Unit { int pm, pn, tag; long long aoff, boff; };
struct GemmDesc { const char* A; const char* Bt; int lda, ldb, kstepA, kstepB, nt; };

__device__ __forceinline__ void swz_tile(int L, int nM, int nN, int& pm, int& pn) {
    const int nwg = nM * nN; int wgid = L;
    { const int q = nwg / NXCD, r = nwg % NXCD, xcd = wgid % NXCD, off = wgid / NXCD; wgid = (xcd < r ? xcd * (q + 1) : r * (q + 1) + (xcd - r) * q) + off; }
    const int nig = WGM * nN, gid = wgid / nig, fm = gid * WGM, gsz = (nM - fm) < WGM ? (nM - fm) : WGM;
    pm = fm + ((wgid % nig) % gsz); pn = (wgid % nig) / gsz;
}
struct StdOrder {
    int nM, nN, G, c; long long tA, tB;
    __device__ void init(int M, int N, int G_, int c_, int lda, int ldb) { nM = M / BM; nN = N / BM; G = G_; c = c_; tA = 512LL * lda; tB = 512LL * ldb; }
    __device__ bool next(int i, Unit& u) const {
        const long long L = (long long)i * G + c; if (L >= (long long)nM * nN) return false;
        swz_tile((int)L, nM, nN, u.pm, u.pn); u.tag = 0; u.aoff = u.pm * tA; u.boff = u.pn * tB; return true;
    }
};
struct MergeOrder {
    int nM, nN, G, c; long long tA, tB;
    __device__ void init(int M, int N, int G_, int c_, int lda, int ldb) { nM = M / BM; nN = N / BM; G = G_; c = c_; tA = 512LL * lda; tB = 512LL * ldb; }
    __device__ bool next(int i, Unit& u) const {
        const int ti = i / 3, br = i - 3 * ti; const long long L = (long long)ti * G + c; if (L >= (long long)nM * nN) return false;
        swz_tile((int)L, nM, nN, u.pm, u.pn); u.tag = br; u.aoff = u.pm * tA + br * 1024; u.boff = u.pn * tB + br * 1024; return true;
    }
};
struct CmpOrder {
    int c;
    __device__ bool next(int i, Unit& u) const {
        if (i != 0 || c >= 64) return false;
        const int ks = c >> 5, kv = (c >> 4) & 1, bg = (c >> 2) & 3, tile = c & 3, b = bg >> 1, g = bg & 1;
        u.pm = c; u.pn = 0; u.tag = kv;
        u.aoff = 2LL * (((long long)b * S_ + 4096LL * tile + 16LL * ks) * PP + PC_KV + kv * 128 + g * 64);
        u.boff = (long long)kv * (256 * 2048 * 2) + (long long)ks * (1024 * 2); return true;
    }
};

__device__ __forceinline__ u32x4 pack8(f32x4 a, f32x4 b) { u32x4 w; w.x = cvt_pk_bf16(a[0], a[1]); w.y = cvt_pk_bf16(a[2], a[3]); w.z = cvt_pk_bf16(b[0], b[1]); w.w = cvt_pk_bf16(b[2], b[3]); return w; }
template <int MODE> struct Epi {
    bf16_t* O; int ldc; const bf16_t* G; const float* bias;
    __device__ __forceinline__ void operator()(const f32x4 (&acc)[2][2][4][2], const Unit& u, int wr, int wc, int fr, int fq) const {
        const int row0 = u.pm * BM + wr * 64 + fr;
        if constexpr (MODE == 1) {
            const int col0 = u.pn * 128 + wc * 32 + 8 * fq;
#pragma unroll
            for (int ai = 0; ai < 2; ++ai)
#pragma unroll
                for (int m = 0; m < 4; ++m) {
                    bf16_t* rowp = O + (size_t)(row0 + ai * HALF + m * 16) * ldc + col0;
                    f32x4 v0, v1;
#pragma unroll
                    for (int e = 0; e < 4; ++e) { const float a0 = acc[ai][0][m][0][e], a1 = acc[ai][0][m][1][e]; v0[e] = a0 * sigm(a0) * acc[ai][1][m][0][e]; v1[e] = a1 * sigm(a1) * acc[ai][1][m][1][e]; }
                    *(u32x4*)rowp = pack8(v0, v1);
                    __builtin_amdgcn_sched_barrier(0);
                }
        } else if constexpr (MODE == 3) {
            const int col0 = u.pn * BM + wc * 32 + 8 * fq;
#pragma unroll
            for (int ai = 0; ai < 2; ++ai) {
                u32x4 gv[4][2], ov[4][2];
#pragma unroll
                for (int m = 0; m < 4; ++m)
#pragma unroll
                    for (int bj = 0; bj < 2; ++bj) { const size_t row = (size_t)(row0 + ai * HALF + m * 16); const int col = col0 + bj * HALF;
                        gv[m][bj] = *(const u32x4*)(G + row * GP + u.tag * 1024 + col);
                        ov[m][bj] = (u.tag > 0) ? *(const u32x4*)(O + row * ldc + col) : (u32x4){0u, 0u, 0u, 0u}; }
                __builtin_amdgcn_sched_barrier(0);
#pragma unroll
                for (int m = 0; m < 4; ++m)
#pragma unroll
                    for (int bj = 0; bj < 2; ++bj) { const size_t row = (size_t)(row0 + ai * HALF + m * 16); const int col = col0 + bj * HALF;
                        f32x4 v0 = acc[ai][bj][m][0], v1 = acc[ai][bj][m][1]; const u32x4 g4 = gv[m][bj], o4 = ov[m][bj];
                        v0[0] = v0[0] * bf_lo(g4.x) + bf_lo(o4.x); v0[1] = v0[1] * bf_hi(g4.x) + bf_hi(o4.x); v0[2] = v0[2] * bf_lo(g4.y) + bf_lo(o4.y); v0[3] = v0[3] * bf_hi(g4.y) + bf_hi(o4.y);
                        v1[0] = v1[0] * bf_lo(g4.z) + bf_lo(o4.z); v1[1] = v1[1] * bf_hi(g4.z) + bf_hi(o4.z); v1[2] = v1[2] * bf_lo(g4.w) + bf_lo(o4.w); v1[3] = v1[3] * bf_hi(g4.w) + bf_hi(o4.w);
                        *(u32x4*)(O + row * ldc + col) = pack8(v0, v1); }
            }
        } else {
            const int col0 = u.pn * BM + wc * 32 + 8 * fq;
#pragma unroll
            for (int ai = 0; ai < 2; ++ai)
#pragma unroll
                for (int m = 0; m < 4; ++m) {
                    const size_t row = (size_t)(row0 + ai * HALF + m * 16);
#pragma unroll
                    for (int bj = 0; bj < 2; ++bj) {
                        const int col = col0 + bj * HALF;
                        f32x4 v0 = acc[ai][bj][m][0], v1 = acc[ai][bj][m][1];
                        bf16_t* dst = O + row * ldc + col;
                        if constexpr (MODE == 2) {
#pragma unroll
                            for (int e = 0; e < 4; ++e) { v0[e] = sigm(v0[e]); v1[e] = sigm(v1[e]); }
                        }
                        if constexpr (MODE == 4) {
                            const f32x4 b0 = *(const f32x4*)(bias + u.tag * 256 + col), b1 = *(const f32x4*)(bias + u.tag * 256 + col + 4);
#pragma unroll
                            for (int e = 0; e < 4; ++e) { v0[e] = gelu_tanh(v0[e] + b0[e]); v1[e] = gelu_tanh(v1[e] + b1[e]); }
                        }
                        if constexpr (MODE == 3) {
                            const u32x4 gv = *(const u32x4*)(G + row * GP + u.tag * 1024 + col);
                            v0[0] *= bf_lo(gv.x); v0[1] *= bf_hi(gv.x); v0[2] *= bf_lo(gv.y); v0[3] *= bf_hi(gv.y);
                            v1[0] *= bf_lo(gv.z); v1[1] *= bf_hi(gv.z); v1[2] *= bf_lo(gv.w); v1[3] *= bf_hi(gv.w);
                            if (u.tag > 0) {
                                const u32x4 ov = *(const u32x4*)dst;
                                v0[0] += bf_lo(ov.x); v0[1] += bf_hi(ov.x); v0[2] += bf_lo(ov.y); v0[3] += bf_hi(ov.y);
                                v1[0] += bf_lo(ov.z); v1[1] += bf_hi(ov.z); v1[2] += bf_lo(ov.w); v1[3] += bf_hi(ov.w);
                            }
                        }
                        *(u32x4*)dst = pack8(v0, v1);
                    }
                }
        }
    }
};

template <class EpiT, class Sched>
__device__ __forceinline__ void gemm_phase(LAS unsigned char* lds, int tid_in, const GemmDesc g, const Sched& S, const EpiT& E) {
    int tid_ = tid_in; asm volatile("" : "+v"(tid_));
    const int tid = tid_, wid = __builtin_amdgcn_readfirstlane(tid >> 6), lane = tid & 63, wr = wid >> 2, wc = wid & 3, fr = lane & 15, fq = lane >> 4;
    const int nt = g.nt;
    unsigned voffA[2], voffB[2];
#pragma unroll
    for (int i = 0; i < 2; ++i) { int R, C; stage_rc(tid * 16 + i * 8192, R, C); const int Rb = (R & ~31) + perm32(R & 31);
        voffA[i] = (unsigned)(R * g.lda + C) * 2u; voffB[i] = (unsigned)(Rb * g.ldb + C) * 2u; }
    const size_t kA = (size_t)g.kstepA, kB = (size_t)g.kstepB;
    const size_t hA = (size_t)HALF * g.lda * 2, hB = (size_t)HALF * g.ldb * 2;
    const unsigned ldsw = (unsigned)wid * 1024u;
    const int aoff = lds_byte(wr * 64 + fr, fq * 8), boff = lds_byte(wc * 32 + fr, fq * 8);
#define PG8_SA(b, h) (((b) * 2 + (h)) * HTB)
#define PG8_SB(b, h) ((4 + (b) * 2 + (h)) * HTB)
#define PG8_STAGE(bufoff, gbase, voff) do { _Pragma("unroll") for (int _i = 0; _i < 2; ++_i) \
        __builtin_amdgcn_global_load_lds((const unsigned*)((const char*)(gbase) + (voff)[_i]), (LAS unsigned*)(lds + (bufoff) + ldsw + _i * 8192), 16, 0, 0); } while (0)
#define PG8_LDA(dst, b, h) do { _Pragma("unroll") for (int m = 0; m < 4; ++m) _Pragma("unroll") for (int k = 0; k < 2; ++k) dst[m][k] = *(const LAS bf16x8*)(lds + PG8_SA(b, h) + aoff + m * 2048 + k * 1024); } while (0)
#define PG8_LDB(dst, b, h) do { _Pragma("unroll") for (int n = 0; n < 2; ++n) _Pragma("unroll") for (int k = 0; k < 2; ++k) dst[n][k] = *(const LAS bf16x8*)(lds + PG8_SB(b, h) + boff + n * 2048 + k * 1024); } while (0)
#define PG8_MMA(ai, bj, At, Bt) do { __builtin_amdgcn_s_setprio(1); _Pragma("unroll") for (int m = 0; m < 4; ++m) _Pragma("unroll") for (int n = 0; n < 2; ++n) _Pragma("unroll") for (int k = 0; k < 2; ++k) \
        acc[ai][bj][m][n] = __builtin_amdgcn_mfma_f32_16x16x32_bf16(Bt[n][k], At[m][k], acc[ai][bj][m][n], 0, 0, 0); __builtin_amdgcn_s_setprio(0); } while (0)
#define PG8_WAIT_V(n) asm volatile("s_waitcnt vmcnt(" #n ")" ::: "memory")
#define PG8_WAIT_L(n) asm volatile("s_waitcnt lgkmcnt(" #n ")" ::: "memory")
#define PG8_BAR __builtin_amdgcn_s_barrier()
#define PG8_SCHED __builtin_amdgcn_sched_barrier(0)
    Unit cur, nxt; int ui = 0;
    if (!S.next(0, cur)) return;
    f32x4 acc[2][2][4][2];
#pragma unroll
    for (int a = 0; a < 2; ++a)
#pragma unroll
        for (int b = 0; b < 2; ++b)
#pragma unroll
            for (int m = 0; m < 4; ++m)
#pragma unroll
                for (int n = 0; n < 2; ++n) acc[a][b][m][n] = (f32x4){0.f, 0.f, 0.f, 0.f};
    bf16x8 At[4][2], B0[2][2], B1[2][2];
    const char* cA = g.A + cur.aoff; const char* cB = g.Bt + cur.boff;
    PG8_STAGE(PG8_SB(0, 0), cB, voffB); PG8_STAGE(PG8_SB(0, 1), cB + hB, voffB); PG8_STAGE(PG8_SA(0, 0), cA, voffA); PG8_STAGE(PG8_SA(0, 1), cA + hA, voffA);
    if (wr == 1) PG8_BAR;
    PG8_WAIT_V(2); PG8_BAR;
    PG8_STAGE(PG8_SB(1, 0), cB + kB, voffB); PG8_STAGE(PG8_SA(1, 0), cA + kA, voffA); PG8_STAGE(PG8_SB(1, 1), cB + hB + kB, voffB);
    PG8_WAIT_V(6); PG8_BAR;
    for (;;) {
        const bool has_next = S.next(ui + 1, nxt);
        const char* nA = has_next ? g.A + nxt.aoff : cA; const char* nB = has_next ? g.Bt + nxt.boff : cB;
        for (int t = 0; t < nt; t += 2) {
            const bool last = (t == nt - 2);
            const char* a1 = cA + (size_t)(t + 1) * kA;
            const char* a2 = last ? nA : cA + (size_t)(t + 2) * kA; const char* b2 = last ? nB : cB + (size_t)(t + 2) * kB;
            const char* a3 = a2 + kA; const char* b3 = b2 + kB;
            PG8_LDB(B0, 0, 0); PG8_LDB(B1, 0, 1); PG8_SCHED; PG8_LDA(At, 0, 0); PG8_STAGE(PG8_SA(1, 1), a1 + hA, voffA);
            PG8_WAIT_V(8); PG8_WAIT_L(0); PG8_BAR; PG8_MMA(0, 0, At, B0); PG8_MMA(0, 1, At, B1); PG8_BAR; PG8_SCHED;
            PG8_LDA(At, 0, 1); PG8_STAGE(PG8_SB(0, 0), b2, voffB); PG8_STAGE(PG8_SB(0, 1), b2 + hB, voffB); PG8_STAGE(PG8_SA(0, 0), a2, voffA);
            PG8_WAIT_V(8); PG8_WAIT_L(0); PG8_BAR; PG8_MMA(1, 0, At, B0); PG8_MMA(1, 1, At, B1); PG8_BAR; PG8_SCHED;
            PG8_LDB(B0, 1, 0); PG8_LDB(B1, 1, 1); PG8_SCHED; PG8_LDA(At, 1, 0); PG8_STAGE(PG8_SA(0, 1), a2 + hA, voffA);
            PG8_WAIT_V(8); PG8_WAIT_L(0); PG8_BAR; PG8_MMA(0, 0, At, B0); PG8_MMA(0, 1, At, B1); PG8_BAR; PG8_SCHED;
            PG8_LDA(At, 1, 1); PG8_STAGE(PG8_SB(1, 0), b3, voffB); PG8_STAGE(PG8_SB(1, 1), b3 + hB, voffB); PG8_STAGE(PG8_SA(1, 0), a3, voffA);
            PG8_WAIT_V(8); PG8_WAIT_L(0); PG8_BAR; PG8_MMA(1, 0, At, B0); PG8_MMA(1, 1, At, B1); PG8_BAR; PG8_SCHED;
        }
        if (wr == 0) PG8_BAR;
        E(acc, cur, wr, wc, fr, fq);
        if (!has_next) break;
#pragma unroll
        for (int a = 0; a < 2; ++a)
#pragma unroll
            for (int b = 0; b < 2; ++b)
#pragma unroll
                for (int m = 0; m < 4; ++m)
#pragma unroll
                    for (int n = 0; n < 2; ++n) acc[a][b][m][n] = (f32x4){0.f, 0.f, 0.f, 0.f};
        cur = nxt; cA = nA; cB = nB; ++ui;
        if (wr == 1) PG8_BAR;
    }
    PG8_WAIT_V(0);
    PG8_BAR;
#undef PG8_SA
#undef PG8_SB
#undef PG8_STAGE
#undef PG8_LDA
#undef PG8_LDB
#undef PG8_MMA
#undef PG8_WAIT_V
#undef PG8_WAIT_L
#undef PG8_BAR
#undef PG8_SCHED
}
}

struct Args { const void* in[29]; float* out; unsigned char* ws; int ph_lo, ph_hi; };
static_assert(sizeof(Args) == 29 * 8 + 8 + 8 + 8, "Args has no padding");

typedef __attribute__((address_space(1))) unsigned char gu8;
struct Ctx {
    const Args* a; gu8* ws; LAS unsigned char* lds; int tid, lane, wave, G, gw, NGW;
};
#define INF(k, l, n) ((const float*)C.a->in[k] + (size_t)(l) * (n))

__device__ __forceinline__ void tr_item(const float* W, int ldw, int src_col, int nvalid, int k0, bf16_t* WT, int ldt, int dst_row, int dst_k, LAS float* scr, int lane) {
#pragma unroll 8
    for (int i = 0; i < 32; ++i) { const int kk = 2 * i + (lane >> 5), c = lane & 31; scr[kk * 33 + c] = (c < nvalid) ? W[(size_t)(k0 + kk) * ldw + src_col + c] : 0.f; }
    LDS_WAIT();
    const int c = lane & 7;
#pragma unroll
    for (int j = 0; j < 4; ++j) { const int n = (lane >> 3) + 8 * j; const LAS float* s = scr + (8 * c) * 33 + n;
        u32x4 o; o.x = cvt_pk_bf16(s[0 * 33], s[1 * 33]); o.y = cvt_pk_bf16(s[2 * 33], s[3 * 33]); o.z = cvt_pk_bf16(s[4 * 33], s[5 * 33]); o.w = cvt_pk_bf16(s[6 * 33], s[7 * 33]);
        *(u32x4*)(WT + (size_t)(dst_row + n) * ldt + dst_k + k0 + 8 * c) = o; }
    LDS_WAIT();
}

__device__ __forceinline__ void convert_layer(const Ctx& C, int l) {
    LAS float* scr = (LAS float*)(C.lds + C.wave * 8448);
    gu8* ws = C.ws; const int lane = C.lane;
    constexpr int NITEMS = 2816 + 1408 + 1792 + 1536 + 768 + 512 + 2816 + 1408 + 256 + 256 + 512;
    for (int it = C.gw; it < NITEMS; it += C.NGW) {
        int r = it;
        if (r < 2816) { const int kb = r / 176, nb = r % 176, tile = nb >> 3, w = nb & 7, src = (w >> 2) * FF + tile * 128 + (w & 3) * 32;
            tr_item(INF(5, l, DM * 2 * FF), 2 * FF, src, 32, kb * 64, (bf16_t*)(ws + WS_W1IN), DM, nb * 32, 0, scr, lane); continue; } r -= 2816;
        if (r < 1408) { const int kb = r / 32, nb = r % 32;
            tr_item(INF(6, l, FF * DM), DM, nb * 32, 32, kb * 64, (bf16_t*)(ws + WS_W1OUT), FF, nb * 32, 0, scr, lane); continue; } r -= 1408;
        if (r < 1792) { const int kb = r / 112, nb = r % 112; int src = 0, nv = 0;
            if (nb < 88) { src = nb * 32; nv = 32; } else if (nb < 104) { src = 2840 + (nb - 88) * 32; nv = 32; } else if (nb == 104) { src = 2816; nv = 24; }
            tr_item(INF(10, l, DM * 6424), 6424, src, nv, kb * 64, (bf16_t*)(ws + WS_WMIX), DM, nb * 32, 0, scr, lane); continue; } r -= 1792;
        if (r < 1536) { const int kb = r / 96, nb = r % 96;
            tr_item(INF(10, l, DM * 6424), 6424, 3352 + nb * 32, 32, kb * 64, (bf16_t*)(ws + WS_WG), DM, nb * 32, 0, scr, lane); continue; } r -= 1536;
        if (r < 768) { const int br = r / 256, q = r % 256, kb = q / 32, nb = q % 32;
            const float* W = br == 0 ? INF(21, l, 512 * DM) : (br == 1 ? INF(22, l, 512 * DM) : INF(23, l, 512 * DM));
            tr_item(W, DM, nb * 32, 32, kb * 64, (bf16_t*)(ws + WS_WBR), YP, nb * 32, br * 512, scr, lane); continue; } r -= 768;
        if (r < 512) { const int kb = r / 32, nb = r % 32;
            tr_item(INF(24, l, DM * DM), DM, nb * 32, 32, kb * 64, (bf16_t*)(ws + WS_WOUT), DM, nb * 32, 0, scr, lane); continue; } r -= 512;
        if (r < 2816) { const int kb = r / 176, nb = r % 176, tile = nb >> 3, w = nb & 7, src = (w >> 2) * FF + tile * 128 + (w & 3) * 32;
            tr_item(INF(27, l, DM * 2 * FF), 2 * FF, src, 32, kb * 64, (bf16_t*)(ws + WS_W2IN), DM, nb * 32, 0, scr, lane); continue; } r -= 2816;
        if (r < 1408) { const int kb = r / 32, nb = r % 32;
            tr_item(INF(28, l, FF * DM), DM, nb * 32, 32, kb * 64, (bf16_t*)(ws + WS_W2OUT), FF, nb * 32, 0, scr, lane); continue; } r -= 1408;
        if (r < 256) { const int kb = r / 8, nb = r % 8;
            tr_item(INF(14, l, 2048 * 256), 256, nb * 32, 32, kb * 64, (bf16_t*)(ws + WS_WC1), 2048, nb * 32, 0, scr, lane); continue; } r -= 256;
        if (r < 256) { const int kb = r / 8, nb = r % 8;
            tr_item(INF(17, l, 2048 * 256), 256, nb * 32, 32, kb * 64, (bf16_t*)(ws + WS_WC1 + MiB), 2048, nb * 32, 0, scr, lane); continue; } r -= 256;
        { const int kb = r / 32, nb = r % 32;
            tr_item(INF(20, l, DM * DM), DM, nb * 32, 32, kb * 64, (bf16_t*)(ws + WS_WMKV), DM, nb * 32, 0, scr, lane); }
    }
    {
        const float* gm = INF(9, l, DM);
        for (int m = C.gw; m < 512; m += C.NGW) {
            const f32x4* xr = (const f32x4*)((const float*)C.a->in[1] + (size_t)m * DM) + lane;
            f32x4 v[4]; float s = 0.f;
#pragma unroll
            for (int j = 0; j < 4; ++j) { v[j] = xr[64 * j]; s += (v[j].x * v[j].x + v[j].y * v[j].y) + (v[j].z * v[j].z + v[j].w * v[j].w); }
            const float rstd = rsqrtf(wave_sum(s) * (1.f / DM) + EPS);
            u32x2* o = (u32x2*)((bf16_t*)(ws + WS_MEMN) + (size_t)m * DM) + lane;
#pragma unroll
            for (int j = 0; j < 4; ++j) { const f32x4 gg = ((const f32x4*)gm)[lane + 64 * j]; u32x2 w; w.x = cvt_pk_bf16(v[j].x * rstd * gg.x, v[j].y * rstd * gg.y); w.y = cvt_pk_bf16(v[j].z * rstd * gg.z, v[j].w * rstd * gg.w); o[64 * j] = w; }
        }
    }
    {
        float* cb = (float*)(ws + WS_CBP) + (size_t)l * 64 * 256;
        for (int it = C.gw; it < 64; it += C.NGW) {
            const int kv = it >> 5, ch = it & 31;
            const float* pos = kv ? INF(13, l, 2048) : INF(12, l, 2048);
            const float* w1 = kv ? INF(17, l, 2048 * 256) : INF(14, l, 2048 * 256);
            float p[4] = {0.f, 0.f, 0.f, 0.f};
            for (int k = ch * 64; k < ch * 64 + 64; ++k) { const float pv = pos[k];
#pragma unroll
                for (int q = 0; q < 4; ++q) p[q] += pv * w1[(size_t)k * 256 + lane + 64 * q]; }
#pragma unroll
            for (int q = 0; q < 4; ++q) cb[(size_t)it * 256 + lane + 64 * q] = p[q];
        }
    }
}

__device__ __forceinline__ void rope_table(const Ctx& C) {
    const int* pos = (const int*)C.a->in[2];
    float* tab = (float*)(C.ws + WS_ROPE);
    const float invf[8] = {1.0f, 0.1939227432012558f, 0.03760603070259094f, 0.007292664609849453f, 0.0014142135623842478f, 0.00027424818836152554f, 5.318296098266728e-05f, 1.0313386155758053e-05f};
    for (int e = C.gw * 64 + C.lane; e < T_ * 8; e += C.NGW * 64) {
        const int tok = e >> 3, i = e & 7;
        float f = invf[0];
#pragma unroll
        for (int q = 1; q < 8; ++q) f = (i == q) ? invf[q] : f;
        const float ang = (float)pos[tok] * f;
        const double rev = (double)ang * 0.15915494309189535; const float fr = (float)(rev - floor(rev));
        tab[(size_t)tok * 16 + i] = __builtin_amdgcn_cosf(fr); tab[(size_t)tok * 16 + 8 + i] = __builtin_amdgcn_sinf(fr);
    }
}
__device__ __forceinline__ void prenorm_rows(const Ctx& C, const float* x, const float* g, bf16_t* h) {
    for (int m = C.gw; m < T_; m += C.NGW) {
        const f32x4* xr = (const f32x4*)(x + (size_t)m * DM) + C.lane;
        f32x4 v[4]; float s = 0.f;
#pragma unroll
        for (int j = 0; j < 4; ++j) { v[j] = xr[64 * j]; s += (v[j].x * v[j].x + v[j].y * v[j].y) + (v[j].z * v[j].z + v[j].w * v[j].w); }
        const float rstd = rsqrtf(wave_sum(s) * (1.f / DM) + EPS);
        u32x2* o = (u32x2*)(h + (size_t)m * DM) + C.lane;
#pragma unroll
        for (int j = 0; j < 4; ++j) { const f32x4 gg = ((const f32x4*)g)[C.lane + 64 * j]; u32x2 w; w.x = cvt_pk_bf16(v[j].x * rstd * gg.x, v[j].y * rstd * gg.y); w.y = cvt_pk_bf16(v[j].z * rstd * gg.z, v[j].w * rstd * gg.w); o[64 * j] = w; }
    }
}
__device__ __forceinline__ void norm_phase(const Ctx& C, int w0, int nw, const float* xin, float* xout, const bf16_t* y, bf16_t* h, const float* gpost, const float* gpre, float coef) {
    for (int m0 = w0; m0 < T_; m0 += 2 * nw) {
        f32x4 xv[2][4]; u32x2 yw[2][4];
#pragma unroll
        for (int r = 0; r < 2; ++r) { const int m = (m0 + r * nw < T_) ? m0 + r * nw : m0; const f32x4* xr = (const f32x4*)(xin + (size_t)m * DM) + C.lane; const u32x2* yr = (const u32x2*)(y + (size_t)m * DM) + C.lane;
#pragma unroll
            for (int j = 0; j < 4; ++j) { xv[r][j] = xr[64 * j]; yw[r][j] = yr[64 * j]; } }
#pragma unroll
        for (int r = 0; r < 2; ++r) {
            const int m = m0 + r * nw; if (m >= T_) break;
            f32x4 yv[4]; float s = 0.f;
#pragma unroll
            for (int j = 0; j < 4; ++j) { const u32x2 w = yw[r][j]; yv[j] = (f32x4){bf_lo(w.x), bf_hi(w.x), bf_lo(w.y), bf_hi(w.y)};
                s += (yv[j].x * yv[j].x + yv[j].y * yv[j].y) + (yv[j].z * yv[j].z + yv[j].w * yv[j].w); }
            const float rs = rsqrtf(wave_sum(s) * (1.f / DM) + EPS) * coef; float s2 = 0.f;
            f32x4* xo = (f32x4*)(xout + (size_t)m * DM) + C.lane;
#pragma unroll
            for (int j = 0; j < 4; ++j) { const f32x4 gg = ((const f32x4*)gpost)[C.lane + 64 * j]; xv[r][j] = xv[r][j] + yv[j] * gg * rs; xo[64 * j] = xv[r][j];
                s2 += (xv[r][j].x * xv[r][j].x + xv[r][j].y * xv[r][j].y) + (xv[r][j].z * xv[r][j].z + xv[r][j].w * xv[r][j].w); }
            if (gpre) {
                const float r2 = rsqrtf(wave_sum(s2) * (1.f / DM) + EPS);
                u32x2* o = (u32x2*)(h + (size_t)m * DM) + C.lane;
#pragma unroll
                for (int j = 0; j < 4; ++j) { const f32x4 gg = ((const f32x4*)gpre)[C.lane + 64 * j]; u32x2 w; w.x = cvt_pk_bf16(xv[r][j].x * r2 * gg.x, xv[r][j].y * r2 * gg.y); w.y = cvt_pk_bf16(xv[r][j].z * r2 * gg.z, xv[r][j].w * r2 * gg.w); o[64 * j] = w; }
            }
        }
    }
}
__device__ __forceinline__ void cb_reduce(const Ctx& C, int l) {
    const int e = C.gw * 64 + C.lane;
    if (e < 512) { const int kv = e >> 8, n = e & 255; const float* pp = (const float*)(C.ws + WS_CBP) + (size_t)l * 64 * 256 + (size_t)kv * 32 * 256 + n;
        float s = (kv ? INF(18, l, 256) : INF(15, l, 256))[n];
        for (int ch = 0; ch < 32; ++ch) s += pp[ch * 256];
        ((float*)(C.ws + WS_CB))[l * 512 + e] = s; }
}
__device__ __forceinline__ void memkv_ops(const Ctx& C, int w0, int nw) {
    const bf16_t* src = (const bf16_t*)(C.ws + WS_MKV); bf16_t* ko = (bf16_t*)(C.ws + WS_MEMK); bf16_t* vo = (bf16_t*)(C.ws + WS_MEMV);
    for (int e = w0 * 64 + C.lane; e < 512 * 1024; e += nw * 64) {
        const int mr = e >> 10, col = e & 1023, kv = col >> 9, hm = (col >> 7) & 3, d = col & 127, b = mr >> 8, m = mr & 255;
        const bf16_t v = src[e];
        if (kv == 0) ko[((size_t)((((b * 4 + hm) * 8 + (m >> 5)) * 8 + (d >> 4)) * 64 + pi32(m & 31) + 32 * ((d >> 3) & 1))) * 8 + (d & 7)] = v;
        else vo[((size_t)((((b * 4 + hm) * 16 + (m >> 4)) * 4 + (d >> 5)) * 64 + (d & 31) + 32 * ((m >> 3) & 1))) * 8 + (m & 7)] = v;
    }
}

__device__ __forceinline__ void prep_items(const Ctx& C, int l, int w0, int nw) {
    const bf16_t* P = (const bf16_t*)(C.ws + WS_R1); bf16_t* Y = (bf16_t*)(C.ws + WS_Y);
    const int lane = C.lane;
    {
        const float* cw = INF(11, l, 3 * 512);
        float w[3][8];
#pragma unroll
        for (int k = 0; k < 3; ++k)
#pragma unroll
            for (int e = 0; e < 8; ++e) w[k][e] = cw[k * 512 + lane * 8 + e];
        for (int it = w0; it < T_ / 8; it += nw) {
            const int tok0 = it * 8, s0 = tok0 & (S_ - 1);
            float c1[8], c2[8];
#pragma unroll
            for (int e = 0; e < 8; ++e) { c1[e] = 0.f; c2[e] = 0.f; }
            if (s0 > 0) {
#pragma unroll
                for (int back = 2; back >= 1; --back) {
                    const bf16_t* row = P + (size_t)(tok0 - back) * PP + lane * 8;
                    const u32x4 u = *(const u32x4*)row, cc = *(const u32x4*)(row + 1024);
                    float t[8] = {bf_lo(u.x) * bf_lo(cc.x), bf_hi(u.x) * bf_hi(cc.x), bf_lo(u.y) * bf_lo(cc.y), bf_hi(u.y) * bf_hi(cc.y), bf_lo(u.z) * bf_lo(cc.z), bf_hi(u.z) * bf_hi(cc.z), bf_lo(u.w) * bf_lo(cc.w), bf_hi(u.w) * bf_hi(cc.w)};
#pragma unroll
                    for (int e = 0; e < 8; ++e) { if (back == 2) c2[e] = t[e]; else c1[e] = t[e]; }
                }
            }
#pragma unroll
            for (int tt = 0; tt < 8; ++tt) {
                const bf16_t* row = P + (size_t)(tok0 + tt) * PP + lane * 8;
                const u32x4 u = *(const u32x4*)row, bb = *(const u32x4*)(row + 512), cc = *(const u32x4*)(row + 1024);
                const float c0[8] = {bf_lo(u.x) * bf_lo(cc.x), bf_hi(u.x) * bf_hi(cc.x), bf_lo(u.y) * bf_lo(cc.y), bf_hi(u.y) * bf_hi(cc.y), bf_lo(u.z) * bf_lo(cc.z), bf_hi(u.z) * bf_hi(cc.z), bf_lo(u.w) * bf_lo(cc.w), bf_hi(u.w) * bf_hi(cc.w)};
                const float bv[8] = {bf_lo(bb.x), bf_hi(bb.x), bf_lo(bb.y), bf_hi(bb.y), bf_lo(bb.z), bf_hi(bb.z), bf_lo(bb.w), bf_hi(bb.w)};
                float o[8];
#pragma unroll
                for (int e = 0; e < 8; ++e) { o[e] = bv[e] * (w[0][e] * c2[e] + w[1][e] * c1[e] + w[2][e] * c0[e]); c2[e] = c1[e]; c1[e] = c0[e]; }
                u32x4 ov; ov.x = cvt_pk_bf16(o[0], o[1]); ov.y = cvt_pk_bf16(o[2], o[3]); ov.z = cvt_pk_bf16(o[4], o[5]); ov.w = cvt_pk_bf16(o[6], o[7]);
                *(u32x4*)(Y + (size_t)(tok0 + tt) * YP + lane * 8) = ov;
            }
        }
    }
    {
        const float* rope = (const float*)(C.ws + WS_ROPE);
        LAS bf16_t* vt = (LAS bf16_t*)(C.lds + C.wave * 4608);
        const int hi = lane >> 5, dl = lane & 31;
        for (int it = w0; it < 4 * 512; it += nw) {
            const int bg = it >> 9, tile = it & 511, b = bg >> 1, g = bg & 1;
            const size_t tokb = (size_t)b * S_ + 32 * tile;
#pragma unroll
            for (int which = 0; which < 2; ++which) {
                const int kc = PC_KV + (2 + 2 * which) * 128 + g * 64, vc = kc + 128;
                bf16_t* kop = (bf16_t*)(C.ws + (which ? WS_KWIN : WS_KSLC)); bf16_t* vop = (bf16_t*)(C.ws + (which ? WS_VWIN : WS_VSLC));
#pragma unroll
                for (int q = 0; q < 4; ++q) {
                    const int r = (lane >> 3) + 8 * q, c = lane & 7;
                    const bf16_t* row = P + (tokb + r) * PP;
                    u32x4 kv = *(const u32x4*)(row + kc + 8 * c);
                    if (c < 2) {
                        const u32x4 pv = *(const u32x4*)(row + kc + 8 * (c ^ 1));
                        const float* rt = rope + (tokb + r) * 16;
                        const f32x4 ca = *(const f32x4*)rt, cb2 = *(const f32x4*)(rt + 4), sa = *(const f32x4*)(rt + 8), sb = *(const f32x4*)(rt + 12);
                        const float cs[8] = {ca.x, ca.y, ca.z, ca.w, cb2.x, cb2.y, cb2.z, cb2.w}, sn[8] = {sa.x, sa.y, sa.z, sa.w, sb.x, sb.y, sb.z, sb.w};
                        const float mv[8] = {bf_lo(kv.x), bf_hi(kv.x), bf_lo(kv.y), bf_hi(kv.y), bf_lo(kv.z), bf_hi(kv.z), bf_lo(kv.w), bf_hi(kv.w)};
                        const float pp[8] = {bf_lo(pv.x), bf_hi(pv.x), bf_lo(pv.y), bf_hi(pv.y), bf_lo(pv.z), bf_hi(pv.z), bf_lo(pv.w), bf_hi(pv.w)};
                        const float sg = (c == 0) ? -1.f : 1.f; float o[8];
#pragma unroll
                        for (int e = 0; e < 8; ++e) o[e] = mv[e] * cs[e] + sg * pp[e] * sn[e];
                        kv.x = cvt_pk_bf16(o[0], o[1]); kv.y = cvt_pk_bf16(o[2], o[3]); kv.z = cvt_pk_bf16(o[4], o[5]); kv.w = cvt_pk_bf16(o[6], o[7]);
                    }
                    if (which == 0)
                        *(u32x4*)(kop + ((size_t)(((bg * 512 + tile) * 2 + ((r >> 2) & 1)) * 2 + (c >> 2)) * 64 + ((r >> 3) * 4 + (r & 3)) + 16 * (c & 3)) * 8) = kv;
                    else
                        *(u32x4*)(kop + ((size_t)((bg * 512 + tile) * 4 + (c >> 1)) * 64 + pi32(r) + 32 * (c & 1)) * 8) = kv;
                    const u32x4 vv = *(const u32x4*)(row + vc + 8 * c);
                    *(LAS u32x4*)(vt + r * 72 + 8 * c) = vv;
                }
                LDS_WAIT();
#pragma unroll
                for (int o4 = 0; o4 < 4; ++o4) {
                    if (which == 0) {
                        const LAS bf16_t* sp = vt + (8 * (lane >> 4)) * 72 + 16 * o4 + (lane & 15);
                        u32x4 o; o.x = (unsigned)sp[0] | ((unsigned)sp[72] << 16); o.y = (unsigned)sp[144] | ((unsigned)sp[216] << 16); o.z = (unsigned)sp[288] | ((unsigned)sp[360] << 16); o.w = (unsigned)sp[432] | ((unsigned)sp[504] << 16);
                        *(u32x4*)(vop + ((size_t)((bg * 512 + tile) * 4 + o4) * 64 + lane) * 8) = o;
                        continue;
                    }
                    const int ks = o4 >> 1, dt = o4 & 1;
                    const LAS bf16_t* sp = vt + (16 * ks + 8 * hi) * 72 + 32 * dt + dl;
                    u32x4 o; o.x = (unsigned)sp[0] | ((unsigned)sp[72] << 16); o.y = (unsigned)sp[144] | ((unsigned)sp[216] << 16); o.z = (unsigned)sp[288] | ((unsigned)sp[360] << 16); o.w = (unsigned)sp[432] | ((unsigned)sp[504] << 16);
                    *(u32x4*)(vop + ((size_t)((bg * 1024 + 2 * tile + ks) * 2 + dt) * 64 + lane) * 8) = o;
                }
                LDS_WAIT();
            }
        }
    }
}

__device__ __forceinline__ void cmp_stage2(const Ctx& C, int l) {
    const int bxx = C.gw / NWAVES, kv = bxx & 1, wi = bxx >> 1, nwg2 = (C.G + 1 - kv) >> 1;
    const float* w2 = kv ? INF(19, l, 256 * 64) : INF(16, l, 256 * 64);
    LAS float* ws2 = (LAS float*)C.lds;
    for (int e = C.tid; e < 256 * 64 / 4; e += NWAVES * 64) ((LAS f32x4*)ws2)[e] = ((const f32x4*)w2)[e];
    __syncthreads();
    const bf16_t* hid = (const bf16_t*)(C.ws + WS_CMPP) + (size_t)kv * 4096 * 256;
    const float* cbias = (const float*)(C.ws + WS_CB) + l * 512 + kv * 256;
    bf16_t* ko = (bf16_t*)(C.ws + WS_KCMP); bf16_t* vo = (bf16_t*)(C.ws + WS_VCMP);
    const int d = C.lane;
    for (int row = wi * NWAVES + C.wave; row < 4096; row += nwg2 * NWAVES) {
        asm volatile("" ::: "memory");
        const u32x2 hv = *((const u32x2*)(hid + (size_t)row * 256) + C.lane), hw = *((const u32x2*)(hid + (size_t)(row + 8192) * 256) + C.lane);
        const f32x4 cbv = *((const f32x4*)cbias + C.lane);
        const float h0 = gelu_tanh(bf_lo(hv.x) + bf_lo(hw.x) + cbv.x), h1 = gelu_tanh(bf_hi(hv.x) + bf_hi(hw.x) + cbv.y), h2 = gelu_tanh(bf_lo(hv.y) + bf_lo(hw.y) + cbv.z), h3 = gelu_tanh(bf_hi(hv.y) + bf_hi(hw.y) + cbv.w);
        float acc = 0.f;
#pragma unroll 4
        for (int k = 0; k < 64; ++k) {
            const float a0 = __int_as_float(__builtin_amdgcn_readlane(__float_as_int(h0), k)), a1 = __int_as_float(__builtin_amdgcn_readlane(__float_as_int(h1), k));
            const float a2 = __int_as_float(__builtin_amdgcn_readlane(__float_as_int(h2), k)), a3 = __int_as_float(__builtin_amdgcn_readlane(__float_as_int(h3), k));
            acc += a0 * ws2[(4 * k + 0) * 64 + d]; acc += a1 * ws2[(4 * k + 1) * 64 + d]; acc += a2 * ws2[(4 * k + 2) * 64 + d]; acc += a3 * ws2[(4 * k + 3) * 64 + d];
        }
        const int bg = row >> 10, n = row & 1023;
        if (n == 1023) acc = 0.f;
        const bf16_t o = (bf16_t)(cvt_pk_bf16(acc, 0.f) & 0xffffu);
        if (kv == 0) ko[((size_t)((bg * 32 + (n >> 5)) * 4 + (d >> 4)) * 64 + pi32(n & 31) + 32 * ((d >> 3) & 1)) * 8 + (d & 7)] = o;
        else vo[((size_t)((bg * 64 + (n >> 4)) * 2 + (d >> 5)) * 64 + (d & 31) + 32 * ((n >> 3) & 1)) * 8 + (n & 7)] = o;
    }
    __syncthreads();
}

__device__ __forceinline__ float xhalf_max(float v) { const auto r = __builtin_amdgcn_permlane32_swap(__float_as_uint(v), __float_as_uint(v), false, false); return fmaxf(__uint_as_float(r[0]), __uint_as_float(r[1])); }
__device__ __forceinline__ float xhalf_sum(float v) { const auto r = __builtin_amdgcn_permlane32_swap(__float_as_uint(v), __float_as_uint(v), false, false); return __uint_as_float(r[0]) + __uint_as_float(r[1]); }
__device__ __forceinline__ f32x16 mfma32(bf16x8 a, bf16x8 b, f32x16 c) { return __builtin_amdgcn_mfma_f32_32x32x16_bf16(a, b, c, 0, 0, 0); }
__device__ __forceinline__ float dpp_xor1(float v) { return __int_as_float(__builtin_amdgcn_update_dpp(0, __float_as_int(v), 0xB1, 0xF, 0xF, true)); }
__device__ __forceinline__ float dpp_xor2(float v) { return __int_as_float(__builtin_amdgcn_update_dpp(0, __float_as_int(v), 0x4E, 0xF, 0xF, true)); }
__device__ __forceinline__ bf16x8 pack_p(const float* p) { u32x4 w; w.x = cvt_pk_bf16(p[0], p[1]); w.y = cvt_pk_bf16(p[2], p[3]); w.z = cvt_pk_bf16(p[4], p[5]); w.w = cvt_pk_bf16(p[6], p[7]); return __builtin_bit_cast(bf16x8, w); }
__device__ __forceinline__ bf16x8 scale_q(u32x4 v, float s) { u32x4 w; w.x = cvt_pk_bf16(bf_lo(v.x) * s, bf_hi(v.x) * s); w.y = cvt_pk_bf16(bf_lo(v.y) * s, bf_hi(v.y) * s); w.z = cvt_pk_bf16(bf_lo(v.z) * s, bf_hi(v.z) * s); w.w = cvt_pk_bf16(bf_lo(v.w) * s, bf_hi(v.w) * s); return __builtin_bit_cast(bf16x8, w); }
constexpr float SM_THR = 8.0f;
#define KREL(i, hi) (8 * (hi) + (i) + (((i) >= 8) ? 8 : 0))

__device__ __forceinline__ void flash_load(const bf16x8* kp, const bf16x8* vp, bf16x8 (&kf)[4], bf16x8 (&vf)[4]) {
#pragma unroll
    for (int s = 0; s < 4; ++s) kf[s] = kp[s * 64];
#pragma unroll
    for (int s = 0; s < 4; ++s) vf[s] = vp[s * 64];
    __builtin_amdgcn_sched_barrier(0);
}
__device__ __forceinline__ void flash_compute(bool domask, const bf16x8 (&kf)[4], const bf16x8 (&vf)[4], const bf16x8 (&q)[4], int x0, unsigned span, float& m, float& l, f32x16 (&O)[2]) {
    f32x16 sc;
#pragma unroll
    for (int i = 0; i < 16; ++i) sc[i] = 0.f;
    __builtin_amdgcn_s_setprio(1);
#pragma unroll
    for (int s = 0; s < 4; ++s) sc = mfma32(kf[s], q[s], sc);
    __builtin_amdgcn_s_setprio(0);
    if (domask) {
#pragma unroll
        for (int i = 0; i < 16; ++i) sc[i] = ((unsigned)(x0 + i + (i >= 8 ? 8 : 0)) <= span) ? sc[i] : -1e30f;
    }
    const float a0 = fmaxf(fmaxf(sc[0], sc[1]), sc[2]), a1 = fmaxf(fmaxf(sc[3], sc[4]), sc[5]), a2 = fmaxf(fmaxf(sc[6], sc[7]), sc[8]), a3 = fmaxf(fmaxf(sc[9], sc[10]), sc[11]), a4 = fmaxf(fmaxf(sc[12], sc[13]), sc[14]);
    float mx = fmaxf(fmaxf(fmaxf(a0, a1), fmaxf(a2, a3)), fmaxf(a4, sc[15]));
    mx = xhalf_max(mx);
    const bool upd = mx > m + SM_THR;
    if (__ballot(upd) != 0ull) {
        const float mn = upd ? mx : m, alpha = ex2(m - mn); l *= alpha; O[0] = O[0] * alpha; O[1] = O[1] * alpha; m = mn;
    }
    const float msub = (m < -1e29f) ? 0.f : m;
    const f32x16 d = sc - msub;
    float p[16], ps = 0.f;
#pragma unroll
    for (int i = 0; i < 16; ++i) { p[i] = ex2(d[i]); ps += p[i]; }
    l += ps;
    const bf16x8 pb0 = pack_p(p), pb1 = pack_p(p + 8);
    __builtin_amdgcn_s_setprio(1);
    O[0] = mfma32(vf[0], pb0, O[0]); O[1] = mfma32(vf[1], pb0, O[1]);
    O[0] = mfma32(vf[2], pb1, O[0]); O[1] = mfma32(vf[3], pb1, O[1]);
    __builtin_amdgcn_s_setprio(0);
}
template <int MODE> __device__ __forceinline__ void flash_desc(int s, const LAS unsigned* list, int base, int t, int t0, int qi, int hi, int& tile, int& x0, unsigned& span, int& vm) {
    if constexpr (MODE == 0) {
        const unsigned e = (unsigned)__builtin_amdgcn_readfirstlane((int)list[s >> 1]);
        tile = 2 * (int)(e & 0xffffu) + (s & 1);
        const bool my = ((e >> 16) >> qi) & 1u; const int up = my ? (t - 32 * tile) : -1;
        x0 = up < 0 ? 64 : 8 * hi; span = up < 0 ? 0u : (unsigned)up;
        vm = (32 * tile + 31 <= t0) ? (((e >> 16) == 0xFFu) ? 0 : 1) : 2;
    } else {
        tile = base + s; x0 = 8 * hi - (t - 511 - 32 * tile); span = 511u;
        vm = (32 * tile + 31 <= t0 && 32 * tile >= t0 + 7 - 511) ? 0 : 2;
    }
}
template <int MODE> __device__ __forceinline__ void flash_run(const bf16x8* kb, const bf16x8* vb, const bf16x8 (&q)[4], int nsteps, const LAS unsigned* list, int base, int t, int t0, int qi, int hi, float& m, float& l, f32x16 (&O)[2]) {
    if (nsteps <= 0) return;
    bf16x8 kA[4], vA[4], kB[4], vB[4], kC[4], vC[4]; int x0A, x0B, x0C, vmA, vmB, vmC; unsigned spA, spB, spC;
#define FR_LOAD(S, KF, VF, X0, SP, VM) do { int tile_; const int sn_ = ((S) < nsteps) ? (S) : nsteps - 1; flash_desc<MODE>(sn_, list, base, t, t0, qi, hi, tile_, X0, SP, VM); \
        flash_load(kb + (size_t)tile_ * 256, vb + (size_t)tile_ * 256, KF, VF); } while (0)
    FR_LOAD(0, kA, vA, x0A, spA, vmA); FR_LOAD(1, kB, vB, x0B, spB, vmB);
#pragma unroll 1
    for (int s = 0; s < nsteps; s += 3) {
        FR_LOAD(s + 2, kC, vC, x0C, spC, vmC); flash_compute(vmA != 0, kA, vA, q, x0A, spA, m, l, O); if (s + 1 >= nsteps) break;
        FR_LOAD(s + 3, kA, vA, x0A, spA, vmA); flash_compute(vmB != 0, kB, vB, q, x0B, spB, m, l, O); if (s + 2 >= nsteps) break;
        FR_LOAD(s + 4, kB, vB, x0B, spB, vmB); flash_compute(vmC != 0, kC, vC, q, x0C, spC, m, l, O);
    }
#undef FR_LOAD
}

typedef float f32x4v __attribute__((ext_vector_type(4)));
__device__ __forceinline__ f32x4v mfma16(bf16x8 a, bf16x8 b, f32x4v c) { return __builtin_amdgcn_mfma_f32_16x16x32_bf16(a, b, c, 0, 0, 0); }
__device__ __forceinline__ float xq_max(float v) { const auto r = __builtin_amdgcn_permlane16_swap(__float_as_uint(v), __float_as_uint(v), false, false); return xhalf_max(fmaxf(__uint_as_float(r[0]), __uint_as_float(r[1]))); }
__device__ __forceinline__ float xq_sum(float v) { const auto r = __builtin_amdgcn_permlane16_swap(__float_as_uint(v), __float_as_uint(v), false, false); return xhalf_sum(__uint_as_float(r[0]) + __uint_as_float(r[1])); }
__device__ __forceinline__ void flash16_load(const bf16x8* kp, const bf16x8* vp, bf16x8 (&kf)[4], bf16x8 (&vf)[4]) {
#pragma unroll
    for (int s = 0; s < 4; ++s) kf[s] = kp[s * 64];
#pragma unroll
    for (int s = 0; s < 4; ++s) vf[s] = vp[s * 64];
    __builtin_amdgcn_sched_barrier(0);
}
__device__ __forceinline__ void flash16_compute(bool domask, const bf16x8 (&kf)[4], const bf16x8 (&vf)[4], const bf16x8 (&q)[2], int x0, unsigned span, float& m, float& l, f32x4v (&O)[4]) {
    f32x4v s0 = {0.f, 0.f, 0.f, 0.f}, s1 = {0.f, 0.f, 0.f, 0.f};
    __builtin_amdgcn_s_setprio(1);
    s0 = mfma16(kf[0], q[0], s0); s1 = mfma16(kf[2], q[0], s1);
    s0 = mfma16(kf[1], q[1], s0); s1 = mfma16(kf[3], q[1], s1);
    __builtin_amdgcn_s_setprio(0);
    float sc[8] = {s0[0], s0[1], s0[2], s0[3], s1[0], s1[1], s1[2], s1[3]};
    if (domask) {
#pragma unroll
        for (int j = 0; j < 8; ++j) sc[j] = ((unsigned)(x0 + j) <= span) ? sc[j] : -1e30f;
    }
    float mx = fmaxf(fmaxf(fmaxf(sc[0], sc[1]), fmaxf(sc[2], sc[3])), fmaxf(fmaxf(sc[4], sc[5]), fmaxf(sc[6], sc[7])));
    mx = xq_max(mx);
    const bool upd = mx > m + SM_THR;
    if (__ballot(upd) != 0ull) {
        const float mn = upd ? mx : m, alpha = ex2(m - mn); l *= alpha;
#pragma unroll
        for (int dt = 0; dt < 4; ++dt) O[dt] = O[dt] * alpha;
        m = mn;
    }
    const float msub = (m < -1e29f) ? 0.f : m;
    float p[8], ps = 0.f;
#pragma unroll
    for (int j = 0; j < 8; ++j) { p[j] = ex2(sc[j] - msub); ps += p[j]; }
    l += ps;
    const bf16x8 pb = pack_p(p);
    __builtin_amdgcn_s_setprio(1);
#pragma unroll
    for (int dt = 0; dt < 4; ++dt) O[dt] = mfma16(vf[dt], pb, O[dt]);
    __builtin_amdgcn_s_setprio(0);
}
__device__ __forceinline__ unsigned flash16_entry(int s, const LAS unsigned* list) {
    const unsigned e = (unsigned)__builtin_amdgcn_readfirstlane((int)list[s >> 1]);
    return (e & 0xffff0000u) | (2u * (e & 0xffffu) + (unsigned)(s & 1));
}
__device__ __forceinline__ void flash16_run(const bf16x8* kb, const bf16x8* vb, const bf16x8 (&qa)[2], const bf16x8 (&qb)[2], int nsteps, const LAS unsigned* list, int tq, int t0, int qi4, int fq,
                                            float& ma, float& la, f32x4v (&Oa)[4], float& mb, float& lb, f32x4v (&Ob)[4]) {
    if (nsteps <= 0) return;
    bf16x8 kA[4], vA[4], kB[4], vB[4], kC[4], vC[4]; unsigned eA, eB, eC;
#define F16_LOAD(S, KF, VF, E) do { const int sn_ = ((S) < nsteps) ? (S) : nsteps - 1; E = flash16_entry(sn_, list); const size_t go_ = (size_t)(E & 0xffffu) * 256; \
        flash16_load(kb + go_, vb + go_, KF, VF); } while (0)
#define F16_COMP(KF, VF, E) do { const int grp_ = (int)(E & 0xffffu); const unsigned na_ = (E >> 16) & 0xFu, nb_ = E >> 20; const bool past_ = 32 * grp_ + 31 <= t0; \
        if (na_) { const int up_ = ((na_ >> qi4) & 1u) ? (tq - 32 * grp_) : -1; flash16_compute(!(past_ && na_ == 0xFu), KF, VF, qa, up_ < 0 ? 64 : 8 * fq, up_ < 0 ? 0u : (unsigned)up_, ma, la, Oa); } \
        if (nb_) { const int up_ = ((nb_ >> qi4) & 1u) ? (tq + 4 - 32 * grp_) : -1; flash16_compute(!(past_ && nb_ == 0xFu), KF, VF, qb, up_ < 0 ? 64 : 8 * fq, up_ < 0 ? 0u : (unsigned)up_, mb, lb, Ob); } } while (0)
    F16_LOAD(0, kA, vA, eA); F16_LOAD(1, kB, vB, eB);
#pragma unroll 1
    for (int s = 0; s < nsteps; s += 3) {
        F16_LOAD(s + 2, kC, vC, eC); F16_COMP(kA, vA, eA); if (s + 1 >= nsteps) break;
        F16_LOAD(s + 3, kA, vA, eA); F16_COMP(kB, vB, eB); if (s + 2 >= nsteps) break;
        F16_LOAD(s + 4, kB, vB, eB); F16_COMP(kC, vC, eC);
    }
#undef F16_LOAD
#undef F16_COMP
}

__device__ __forceinline__ unsigned wave_max_u32(unsigned v) {
#define DPP_U(v, ctrl) ((unsigned)__builtin_amdgcn_update_dpp(0, (int)(v), ctrl, 0xF, 0xF, true))
    { unsigned t = DPP_U(v, 0xB1); v = v > t ? v : t; t = DPP_U(v, 0x4E); v = v > t ? v : t; t = DPP_U(v, 0x141); v = v > t ? v : t; t = DPP_U(v, 0x140); v = v > t ? v : t; }
#undef DPP_U
    { const auto r = __builtin_amdgcn_permlane16_swap(v, v, false, false); v = r[0] > r[1] ? r[0] : r[1]; }
    { const auto r = __builtin_amdgcn_permlane32_swap(v, v, false, false); v = r[0] > r[1] ? r[0] : r[1]; }
    return v;
}

__device__ __forceinline__ void nsa_tile(const Ctx& C, int b, int g, int t0) {
    const bf16_t* P = (const bf16_t*)(C.ws + WS_R1); bf16_t* Y = (bf16_t*)(C.ws + WS_Y);
    int lane_ = C.lane; asm volatile("" : "+v"(lane_));
    const int lane = lane_, r = lane & 31, hi = lane >> 5, qi = r >> 2, h = r & 3, head = g * 4 + h, bg = b * 2 + g;
    const int t = t0 + qi; const size_t tok = (size_t)b * S_ + t;
    LAS float* imp = (LAS float*)(C.lds + C.wave * 16640);
    LAS float* ost = (LAS float*)(C.lds + C.wave * 16640 + 8448) + lane;
    const float QS = 0.18033688011112042f;
    bf16x8 qf[4];
    {
        const bf16_t* qp = P + tok * PP + PC_Q + head * 64;
#pragma unroll
        for (int s = 0; s < 4; ++s) qf[s] = scale_q(*(const u32x4*)(qp + 16 * s + 8 * hi), QS);
    }
    const bf16_t* gp = P + tok * PP + PC_NG + head * 3;
    const float gc = sigm(bf1(gp[0])), gs = sigm(bf1(gp[1])), gw = sigm(bf1(gp[2]));

    const int cur = t0 >> 6;
    {
        const int nvq = (t >= 31) ? ((t - 31) >> 4) + 1 : 0;
        const int nvmin = (t0 >= 31) ? ((t0 - 31) >> 4) + 1 : 0;
        const int tl = t0 + 7, nvmax = (tl >= 31) ? ((tl - 31) >> 4) + 1 : 0, ntile = (nvmax + 31) >> 5;
        const bf16x8* kb = (const bf16x8*)(C.ws + WS_KCMP) + (size_t)bg * 32 * 4 * 64 + lane;
        const bf16x8* vb = (const bf16x8*)(C.ws + WS_VCMP) + (size_t)bg * 64 * 2 * 64 + lane;
        float m1 = -1e30f, l1 = 0.f;
#define CMP_P1(KF, KT) do { \
            f32x16 sc; _Pragma("unroll") for (int i = 0; i < 16; ++i) sc[i] = 0.f; \
            _Pragma("unroll") for (int s = 0; s < 4; ++s) sc = mfma32(KF[s], qf[s], sc); \
            if (nvmin - 1 - 32 * (KT) < 31) {     \
                asm volatile("" ::: "memory"); \
                const int up = nvq - 1 - 32 * (KT); const int x0 = up < 0 ? 64 : 8 * hi; const unsigned span = up < 0 ? 0u : (unsigned)up; \
                _Pragma("unroll") for (int i = 0; i < 16; ++i) sc[i] = ((unsigned)(x0 + i + (i >= 8 ? 8 : 0)) <= span) ? sc[i] : -1e30f; } \
            float mx = -1e30f; _Pragma("unroll") for (int i = 0; i < 16; ++i) mx = fmaxf(mx, sc[i]); \
            mx = xhalf_max(mx); \
            const float mn = fmaxf(m1, mx), msub = (mn < -1e29f) ? 0.f : mn; float ps = 0.f;     \
            _Pragma("unroll") for (int i = 0; i < 16; ++i) ps += ex2(sc[i] - msub); \
            l1 = l1 * ex2(m1 - mn) + ps; m1 = mn; } while (0)
        if (ntile > 0) {
            bf16x8 kA[4], kB[4], kC[4], kD[4];
#define CMP_LDK(KF, KT) do { const int kn_ = ((KT) < ntile) ? (KT) : ntile - 1; _Pragma("unroll") for (int s = 0; s < 4; ++s) KF[s] = kb[kn_ * 256 + s * 64]; } while (0)
            CMP_LDK(kA, 0); CMP_LDK(kB, 1); CMP_LDK(kC, 2);
#pragma unroll 1
            for (int kt = 0; kt < ntile; kt += 4) {
                CMP_LDK(kD, kt + 3); __builtin_amdgcn_sched_barrier(0); CMP_P1(kA, kt);     if (kt + 1 >= ntile) break;
                CMP_LDK(kA, kt + 4); __builtin_amdgcn_sched_barrier(0); CMP_P1(kB, kt + 1); if (kt + 2 >= ntile) break;
                CMP_LDK(kB, kt + 5); __builtin_amdgcn_sched_barrier(0); CMP_P1(kC, kt + 2); if (kt + 3 >= ntile) break;
                CMP_LDK(kC, kt + 6); __builtin_amdgcn_sched_barrier(0); CMP_P1(kD, kt + 3);
            }
        }
#undef CMP_P1
        l1 = xhalf_sum(l1);
        const float inv = 1.f / fmaxf(l1, 1e-30f), m1sub = (m1 < -1e29f) ? 0.f : m1;
        for (int e = lane; e < 8 * 264; e += 64) imp[e] = 0.f;
        LDS_WAIT();
        f32x16 O[2];
#pragma unroll
        for (int i = 0; i < 16; ++i) { O[0][i] = 0.f; O[1][i] = 0.f; }
#define CMP_P2(KF, VF, KT) do { \
            f32x16 sc; _Pragma("unroll") for (int i = 0; i < 16; ++i) sc[i] = 0.f; \
            _Pragma("unroll") for (int s = 0; s < 4; ++s) sc = mfma32(KF[s], qf[s], sc); \
            if (nvmin - 1 - 32 * (KT) < 31) { \
                asm volatile("" ::: "memory"); \
                const int up = nvq - 1 - 32 * (KT); const int x0 = up < 0 ? 64 : 8 * hi; const unsigned span = up < 0 ? 0u : (unsigned)up; \
                _Pragma("unroll") for (int i = 0; i < 16; ++i) sc[i] = ((unsigned)(x0 + i + (i >= 8 ? 8 : 0)) <= span) ? sc[i] : -1e30f; } \
            float p[16]; \
            _Pragma("unroll") for (int i = 0; i < 16; ++i) p[i] = ex2(sc[i] - m1sub) * inv; \
            _Pragma("unroll") for (int rr = 0; rr < 2; ++rr) { \
                const float* q8 = p + 8 * rr; \
                float a = q8[0] + q8[1] + q8[2] + 0.5f * q8[3], bq = 0.5f * q8[3] + q8[4] + q8[5] + q8[6] + 0.5f * q8[7], cq = 0.5f * q8[7]; \
                a += dpp_xor1(a); a += dpp_xor2(a); bq += dpp_xor1(bq); bq += dpp_xor2(bq); cq += dpp_xor1(cq); cq += dpp_xor2(cq); \
                _Pragma("unroll") for (int hh = 0; hh < 2; ++hh)     \
                if (h == 0 && hi == hh) { LAS float* ip = imp + qi * 264 + 8 * (KT) + 2 * hi + 4 * rr; \
                    __hip_atomic_fetch_add(ip, a, __ATOMIC_RELAXED, __HIP_MEMORY_SCOPE_WORKGROUP); __hip_atomic_fetch_add(ip + 1, bq, __ATOMIC_RELAXED, __HIP_MEMORY_SCOPE_WORKGROUP); \
                    __hip_atomic_fetch_add(ip + 2, cq, __ATOMIC_RELAXED, __HIP_MEMORY_SCOPE_WORKGROUP); } \
            } \
            const bf16x8 pb0 = pack_p(p), pb1 = pack_p(p + 8); \
            O[0] = mfma32(VF[0], pb0, O[0]); O[1] = mfma32(VF[1], pb0, O[1]); \
            O[0] = mfma32(VF[2], pb1, O[0]); O[1] = mfma32(VF[3], pb1, O[1]); } while (0)
        if (ntile > 0) {
            bf16x8 kA[4], kB[4], kC[4], vA[4];
#define CMP_LDV(KT) do { _Pragma("unroll") for (int s = 0; s < 4; ++s) vA[s] = vb[(KT) * 256 + s * 64]; } while (0)
            CMP_LDK(kA, 0); CMP_LDK(kB, 1);
#pragma unroll 1
            for (int kt = 0; kt < ntile; kt += 3) {
                CMP_LDK(kC, kt + 2); CMP_LDV(kt);     __builtin_amdgcn_sched_barrier(0); CMP_P2(kA, vA, kt);     if (kt + 1 >= ntile) break;
                CMP_LDK(kA, kt + 3); CMP_LDV(kt + 1); __builtin_amdgcn_sched_barrier(0); CMP_P2(kB, vA, kt + 1); if (kt + 2 >= ntile) break;
                CMP_LDK(kB, kt + 4); CMP_LDV(kt + 2); __builtin_amdgcn_sched_barrier(0); CMP_P2(kC, vA, kt + 2);
            }
#undef CMP_LDV
#undef CMP_LDK
        }
#undef CMP_P2
#pragma unroll
        for (int i = 0; i < 16; ++i) { ost[i * 64] = gc * O[0][i]; ost[(16 + i) * 64] = gc * O[1][i]; }
        LDS_WAIT();
    }

    unsigned bmv[4];
    if (cur <= 15) {
#pragma unroll
        for (int c = 0; c < 4; ++c) bmv[c] = (lane + 64 * c <= cur) ? 0xFFu : 0u;
    } else {
        unsigned key[8][4];
#pragma unroll
        for (int q2 = 0; q2 < 8; ++q2)
#pragma unroll
            for (int c = 0; c < 4; ++c) { const int j = lane + 64 * c; const bool cand = (j >= 1) && (j < cur - 1); const float v = imp[q2 * 264 + j];
                key[q2][c] = cand ? ((__float_as_uint(v) & 0xFFFFFF00u) | (unsigned)(255 - j)) : 0u; }
#pragma unroll
        for (int c = 0; c < 4; ++c) bmv[c] = 0u;
#pragma unroll 1
        for (int round = 0; round < 13; ++round) {
#pragma unroll
            for (int q2 = 0; q2 < 8; ++q2) {
                unsigned mx = key[q2][0]; mx = mx > key[q2][1] ? mx : key[q2][1]; mx = mx > key[q2][2] ? mx : key[q2][2]; mx = mx > key[q2][3] ? mx : key[q2][3];
                const unsigned w = wave_max_u32(mx);
#pragma unroll
                for (int c = 0; c < 4; ++c) { const bool win = (key[q2][c] == w) && (w != 0u); key[q2][c] = win ? 0u : key[q2][c]; bmv[c] |= win ? (1u << q2) : 0u; }
            }
        }
#pragma unroll
        for (int c = 0; c < 4; ++c) { const int j = lane + 64 * c; if (j == 0 || j == cur || j == cur - 1) bmv[c] = 0xFFu; }
    }

    {
        LAS unsigned* list = (LAS unsigned*)imp;
        LAS float* ostb = (LAS float*)(C.lds + C.wave * 16640 + 8448);
        const int q16 = lane & 15, fq = lane >> 4, qi4 = q16 >> 2, head4 = g * 4 + (q16 & 3);
        const bf16x8* kb = (const bf16x8*)(C.ws + WS_KSLC) + (size_t)bg * 512 * 256 + lane;
        const bf16x8* vb = (const bf16x8*)(C.ws + WS_VSLC) + (size_t)bg * 512 * 256 + lane;
        int nblk = 0;
#pragma unroll
        for (int c = 0; c < 4; ++c) {
            const unsigned long long mk = __ballot(bmv[c] != 0u);
            const int pos = nblk + (int)__builtin_amdgcn_mbcnt_hi((unsigned)(mk >> 32), __builtin_amdgcn_mbcnt_lo((unsigned)mk, 0u));
            if (bmv[c] != 0u) list[pos] = (unsigned)(lane + 64 * c) | (bmv[c] << 16);
            nblk += __builtin_popcountll(mk);
        }
        LDS_WAIT();
        const int tq = t0 + qi4;
        bf16x8 q16f[2][2]; float gs4[2];
#pragma unroll
        for (int sub = 0; sub < 2; ++sub) {
            const size_t tok4 = (size_t)b * S_ + tq + 4 * sub;
            const bf16_t* qp = P + tok4 * PP + PC_Q + head4 * 64;
            q16f[sub][1] = scale_q(*(const u32x4*)(qp + 32 + 8 * fq), QS);
            const u32x4 mv4 = *(const u32x4*)(qp + 8 * fq), pv4 = *(const u32x4*)(qp + 8 * ((fq ^ 1) & 1));
            const float* rt = (const float*)(C.ws + WS_ROPE) + tok4 * 16;
            const f32x4 ca = *(const f32x4*)rt, cb2 = *(const f32x4*)(rt + 4), sa = *(const f32x4*)(rt + 8), sb = *(const f32x4*)(rt + 12);
            const float cs[8] = {ca.x, ca.y, ca.z, ca.w, cb2.x, cb2.y, cb2.z, cb2.w}, sn[8] = {sa.x, sa.y, sa.z, sa.w, sb.x, sb.y, sb.z, sb.w};
            const float mv[8] = {bf_lo(mv4.x), bf_hi(mv4.x), bf_lo(mv4.y), bf_hi(mv4.y), bf_lo(mv4.z), bf_hi(mv4.z), bf_lo(mv4.w), bf_hi(mv4.w)};
            const float pp[8] = {bf_lo(pv4.x), bf_hi(pv4.x), bf_lo(pv4.y), bf_hi(pv4.y), bf_lo(pv4.z), bf_hi(pv4.z), bf_lo(pv4.w), bf_hi(pv4.w)};
            const bool roped = fq < 2; const float sg = (fq == 0) ? -1.f : 1.f; float o[8];
#pragma unroll
            for (int e = 0; e < 8; ++e) o[e] = (roped ? (mv[e] * cs[e] + sg * pp[e] * sn[e]) : mv[e]) * QS;
            q16f[sub][0] = pack_p(o);
            gs4[sub] = sigm(bf1(P[tok4 * PP + PC_NG + head4 * 3 + 1]));
        }
        float ma = -1e30f, la = 0.f, mb = -1e30f, lb = 0.f; f32x4v Oa[4], Ob[4];
#pragma unroll
        for (int dt = 0; dt < 4; ++dt) { Oa[dt] = (f32x4v){0.f, 0.f, 0.f, 0.f}; Ob[dt] = (f32x4v){0.f, 0.f, 0.f, 0.f}; }
        flash16_run(kb, vb, q16f[0], q16f[1], 2 * nblk, list, tq, t0, qi4, fq, ma, la, Oa, mb, lb, Ob);
        la = xq_sum(la); lb = xq_sum(lb);
        const float sca = gs4[0] / fmaxf(la, 1e-30f), scb = gs4[1] / fmaxf(lb, 1e-30f);
#pragma unroll
        for (int dt = 0; dt < 4; ++dt)
#pragma unroll
            for (int i = 0; i < 4; ++i) { LAS float* op = ostb + ((dt >> 1) * 16 + 4 * (2 * (dt & 1) + (fq >> 1)) + i) * 64 + q16 + 32 * (fq & 1); op[0] += sca * Oa[dt][i]; op[16] += scb * Ob[dt][i]; }
        LDS_WAIT();
    }
    {
        bf16x8 qr[4];
        {
            const bf16_t* qp = P + tok * PP + PC_Q + head * 64;
#pragma unroll
            for (int s = 1; s < 4; ++s) qr[s] = scale_q(*(const u32x4*)(qp + 16 * s + 8 * hi), QS);
            const u32x4 mv4 = *(const u32x4*)(qp + 8 * hi), pv4 = *(const u32x4*)(qp + 8 * (hi ^ 1));
            const float* rt = (const float*)(C.ws + WS_ROPE) + tok * 16;
            const f32x4 ca = *(const f32x4*)rt, cb2 = *(const f32x4*)(rt + 4), sa = *(const f32x4*)(rt + 8), sb = *(const f32x4*)(rt + 12);
            const float cs[8] = {ca.x, ca.y, ca.z, ca.w, cb2.x, cb2.y, cb2.z, cb2.w}, sn[8] = {sa.x, sa.y, sa.z, sa.w, sb.x, sb.y, sb.z, sb.w};
            const float mv[8] = {bf_lo(mv4.x), bf_hi(mv4.x), bf_lo(mv4.y), bf_hi(mv4.y), bf_lo(mv4.z), bf_hi(mv4.z), bf_lo(mv4.w), bf_hi(mv4.w)};
            const float pp[8] = {bf_lo(pv4.x), bf_hi(pv4.x), bf_lo(pv4.y), bf_hi(pv4.y), bf_lo(pv4.z), bf_hi(pv4.z), bf_lo(pv4.w), bf_hi(pv4.w)};
            const float sg = hi ? 1.f : -1.f; float o[8];
#pragma unroll
            for (int e = 0; e < 8; ++e) o[e] = (mv[e] * cs[e] + sg * pp[e] * sn[e]) * QS;
            qr[0] = pack_p(o);
        }
        const bf16x8* kb = (const bf16x8*)(C.ws + WS_KWIN) + (size_t)bg * 512 * 4 * 64 + lane;
        const bf16x8* vb = (const bf16x8*)(C.ws + WS_VWIN) + (size_t)bg * 1024 * 2 * 64 + lane;
        float m = -1e30f, l = 0.f; f32x16 O[2];
#pragma unroll
        for (int i = 0; i < 16; ++i) { O[0][i] = 0.f; O[1][i] = 0.f; }
        const int tlo = (t0 - 511 > 0 ? t0 - 511 : 0) >> 5, thi = (t0 + 7) >> 5;
        flash_run<1>(kb, vb, qr, thi - tlo + 1, (const LAS unsigned*)imp, tlo, t, t0, qi, hi, m, l, O);
        l = xhalf_sum(l);
        const float sc = gw / fmaxf(l, 1e-30f);
        bf16_t* yp = Y + tok * YP + 512 + head * 64 + 4 * hi;
#pragma unroll
        for (int dt = 0; dt < 2; ++dt)
#pragma unroll
            for (int ig = 0; ig < 4; ++ig) { float o4[4];
#pragma unroll
                for (int e = 0; e < 4; ++e) o4[e] = ost[(dt * 16 + 4 * ig + e) * 64] + sc * O[dt][4 * ig + e];
                u32x2 w; w.x = cvt_pk_bf16(o4[0], o4[1]); w.y = cvt_pk_bf16(o4[2], o4[3]); *(u32x2*)(yp + 32 * dt + 8 * ig) = w; }
        LDS_WAIT();
    }
}

__device__ __forceinline__ void mem_tile(const Ctx& C, int b, int hm, int t0) {
    const bf16_t* P = (const bf16_t*)(C.ws + WS_R1); bf16_t* Y = (bf16_t*)(C.ws + WS_Y);
    int lane_ = C.lane; asm volatile("" : "+v"(lane_));
    const int lane = lane_, r = lane & 31, hi = lane >> 5;
    const size_t tok = (size_t)b * S_ + t0 + r;
    const float QS = 0.12751743082459868f;
    bf16x8 q[8];
    const bf16_t* qp = P + tok * PP + PC_QM + hm * 128;
#pragma unroll
    for (int s = 0; s < 8; ++s) q[s] = scale_q(*(const u32x4*)(qp + 16 * s + 8 * hi), QS);
    const bf16x8* kb = (const bf16x8*)(C.ws + WS_MEMK) + (size_t)(b * 4 + hm) * 8 * 8 * 64 + lane;
    const bf16x8* vb = (const bf16x8*)(C.ws + WS_MEMV) + (size_t)(b * 4 + hm) * 16 * 4 * 64 + lane;
    float m = -1e30f, l = 0.f; f32x16 O[4];
#pragma unroll
    for (int i = 0; i < 16; ++i) { O[0][i] = 0.f; O[1][i] = 0.f; O[2][i] = 0.f; O[3][i] = 0.f; }
#define MEM_STEP(KF, VF) do { \
        f32x16 sc; _Pragma("unroll") for (int i = 0; i < 16; ++i) sc[i] = 0.f; \
        _Pragma("unroll") for (int s = 0; s < 8; ++s) sc = mfma32(KF[s], q[s], sc); \
        float mx = -1e30f; _Pragma("unroll") for (int i = 0; i < 16; ++i) mx = fmaxf(mx, sc[i]); \
        mx = xhalf_max(mx); \
        const bool upd = mx > m + SM_THR; \
        if (__ballot(upd) != 0ull) { const float mn = upd ? mx : m, alpha = ex2(m - mn); l *= alpha; O[0] = O[0] * alpha; O[1] = O[1] * alpha; O[2] = O[2] * alpha; O[3] = O[3] * alpha; m = mn; } \
        float p[16], ps = 0.f; _Pragma("unroll") for (int i = 0; i < 16; ++i) { p[i] = ex2(sc[i] - m); ps += p[i]; } \
        l += ps; \
        const bf16x8 pb0 = pack_p(p), pb1 = pack_p(p + 8); \
        _Pragma("unroll") for (int dt = 0; dt < 4; ++dt) { O[dt] = mfma32(VF[dt], pb0, O[dt]); O[dt] = mfma32(VF[4 + dt], pb1, O[dt]); } } while (0)
    {
        bf16x8 kA[8], vv[8];
#pragma unroll 1
        for (int kt = 0; kt < 8; ++kt) {
#pragma unroll
            for (int s = 0; s < 8; ++s) kA[s] = kb[kt * 512 + s * 64];
#pragma unroll
            for (int s = 0; s < 8; ++s) vv[s] = vb[kt * 512 + s * 64];
            __builtin_amdgcn_sched_barrier(0);
            MEM_STEP(kA, vv);
        }
    }
#undef MEM_STEP
    l = xhalf_sum(l);
    const float inv = 1.f / l;
    bf16_t* yp = Y + tok * YP + 1024 + hm * 128 + 4 * hi;
#pragma unroll
    for (int dt = 0; dt < 4; ++dt)
#pragma unroll
        for (int ig = 0; ig < 4; ++ig) { u32x2 w; w.x = cvt_pk_bf16(O[dt][4 * ig] * inv, O[dt][4 * ig + 1] * inv); w.y = cvt_pk_bf16(O[dt][4 * ig + 2] * inv, O[dt][4 * ig + 3] * inv); *(u32x2*)(yp + 32 * dt + 8 * ig) = w; }
}

__device__ __forceinline__ void attention_phase(const Ctx& C) {
    const int bxx = C.gw / NWAVES; const bool xmode = (C.G & 7) == 0;
    const int x = bxx & 7, rank = xmode ? (bxx >> 3) * NWAVES + C.wave : C.gw, nrank = xmode ? (C.G >> 3) * NWAVES : C.NGW, nitem = xmode ? 1536 : 12288;
    const int nper = (nitem + nrank - 1) / nrank, nmem_it = xmode ? (512 + nrank - 1) / nrank : 0; const bool flip = xmode && (nitem % nrank == 0); const int rot = flip ? ((C.wave * 3) >> 3) * 2 : 0;
    for (int k0 = 0; k0 < nper; ++k0) {
        const int kk = flip ? (k0 + rot) % nper : k0; const int i = rank + kk * nrank; if (i >= nitem) continue;
        int nsa_n, mem_e;
        if (xmode) { nsa_n = (i < 1024) ? (x >> 1) * 2048 + 2 * i + (x & 1) : -1; mem_e = x * 512 + (i - 1024); }
        else { if (i < 8192) { const int k = i >> 11, w = i & 2047; nsa_n = k * 2048 + ((k & 1) ? 2047 - w : w); } else nsa_n = -1; mem_e = i - 8192; }
        if (nsa_n >= 0) { const int k = nsa_n >> 11; nsa_tile(C, k >> 1, k & 1, (nsa_n & 2047) * 8); }
        else { const int bh = mem_e >> 9; mem_tile(C, bh >> 2, bh & 3, (mem_e & 511) * 32); }
    }
}

#define XB_TMO      128
#define XB_XCNT(j)  (256  + 64 * (j))
#define XB_XSUB(j)  (1280 + 64 * (j))
#define XB_XGEN(j)  (2304 + 64 * (j))
#define XB_TOP      3328
#define XB_TOPGEN   3392
#define XCD_BAR_WORDS 3456
#define XB_SPIN_CAP (1u << 18)
__device__ __forceinline__ unsigned xb_ld(unsigned* p)              { return __hip_atomic_load(p, __ATOMIC_RELAXED, __HIP_MEMORY_SCOPE_AGENT); }
__device__ __forceinline__ unsigned xb_add(unsigned* p, unsigned v) { return __hip_atomic_fetch_add(p, v, __ATOMIC_RELAXED, __HIP_MEMORY_SCOPE_AGENT); }
__device__ __forceinline__ unsigned xb_xcc_id() { return (unsigned)__builtin_amdgcn_s_getreg((3 << 11) | 20) & 0xFu; }
#define XB_SPIN(cond, bar) do { unsigned _sp = 0; while (cond) { __builtin_amdgcn_s_sleep(1); \
    if ((++_sp & 255u) == 0u) { if (xb_ld(&(bar)[XB_TMO])) break; if (_sp > XB_SPIN_CAP) { atomicAdd(&(bar)[XB_TMO], 1u); break; } } } } while (0)
__device__ __forceinline__ void xcd_barrier_complete(unsigned* bar, unsigned x, unsigned& nloc, unsigned& nx) {
    const unsigned G = gridDim.x * gridDim.y * gridDim.z;
    unsigned sum, cnt, mine, sp = 0u;
    for (;;) {
        sum = 0u; cnt = 0u; mine = 0u;
#pragma unroll
        for (unsigned j = 0; j < 16; ++j) { const unsigned c = xb_ld(&bar[XB_XCNT(j)]); sum += c; cnt += (c > 0u) ? 1u : 0u; mine = (j == x) ? c : mine; }
        if (sum == G) break;
        __builtin_amdgcn_s_sleep(1);
        if ((++sp & 255u) == 0u) { if (xb_ld(&bar[XB_TMO])) break; if (sp > XB_SPIN_CAP) { atomicAdd(&bar[XB_TMO], 1u); break; } }
    }
    nloc = mine > 0u ? mine : 1u; nx = cnt > 0u ? cnt : 1u;
}
__device__ __forceinline__ void xcd_barrier(unsigned* bar, volatile LAS unsigned* st, bool tid0) {
    asm volatile("s_waitcnt vmcnt(0)" ::: "memory");
    __syncthreads();
    if (tid0) {
        __builtin_amdgcn_s_waitcnt(0);
        const unsigned x = xb_xcc_id();
        unsigned nloc = st[0], nx = st[1];
        if (nloc == 0u) { xcd_barrier_complete(bar, x, nloc, nx); st[0] = nloc; st[1] = nx; }
        const unsigned old = xb_add(&bar[XB_XSUB(x)], 1u);
        const unsigned gen = old / nloc;
        if (old + 1u == (gen + 1u) * nloc) {
            __builtin_amdgcn_fence(__ATOMIC_RELEASE, "agent");
            asm volatile("s_waitcnt vmcnt(0)" ::: "memory");
            const unsigned og = xb_add(&bar[XB_TOP], 1u);
            const unsigned tg = og / nx;
            if (og + 1u == (tg + 1u) * nx) xb_add(&bar[XB_TOPGEN], 1u);
            else XB_SPIN(xb_ld(&bar[XB_TOPGEN]) == tg, bar);
            __builtin_amdgcn_fence(__ATOMIC_ACQUIRE, "agent");
            xb_add(&bar[XB_XGEN(x)], 1u);
            asm volatile("s_waitcnt vmcnt(0)" ::: "memory");
        } else {
            XB_SPIN(xb_ld(&bar[XB_XGEN(x)]) == gen, bar);
            __builtin_amdgcn_fence(__ATOMIC_ACQUIRE, "agent");
            asm volatile("s_waitcnt vmcnt(0)" ::: "memory");
        }
    }
    __syncthreads();
}

constexpr int LDS_BYTES = 147456, XB_LDS_OFF = 147456 - 64;
constexpr int NPHASE = 1 + 2 * 14;

__global__ void __launch_bounds__(NWAVES * 64, 2) fwd_kernel(Args args) {
    extern __shared__ __attribute__((aligned(16))) unsigned char lds_raw[];
    cg::grid_group grid = cg::this_grid();
    if (args.ph_lo == 0x7fffffff) grid.sync();
    const int wave0 = __builtin_amdgcn_readfirstlane((int)threadIdx.x >> 6);
    {
        volatile LAS unsigned* st = (volatile LAS unsigned*)(lds_raw + XB_LDS_OFF);
        if (threadIdx.x == 0) { st[0] = 0u; st[1] = 0u; (void)xb_add((unsigned*)(args.ws + WS_BAR) + XB_XCNT(xb_xcc_id()), 1u); }
        __syncthreads();
    }
#define PHASE_BEGIN { \
        unsigned char* ws0_ = args.ws; asm volatile("" : "+s"(ws0_)); gu8* ws = (gu8*)ws0_;     \
        int tid_; asm volatile("v_mbcnt_lo_u32_b32 %0, -1, 0\n\tv_mbcnt_hi_u32_b32 %0, -1, %0" : "=v"(tid_)); tid_ += wave0 * 64; \
        Ctx C; C.a = &args; C.ws = ws; C.lds = (LAS unsigned char*)lds_raw; C.tid = tid_; C.lane = tid_ & 63; C.wave = __builtin_amdgcn_readfirstlane(tid_ >> 6); \
        int bx = blockIdx.x; asm volatile("" : "+s"(bx)); C.G = gridDim.x; C.gw = bx * NWAVES + C.wave; C.NGW = C.G * NWAVES; \
        bf16_t* const H = (bf16_t*)(ws + WS_H); bf16_t* const R1 = (bf16_t*)(ws + WS_R1); bf16_t* const Y = (bf16_t*)(ws + WS_Y); (void)H; (void)R1; (void)Y; (void)bx;
#define PHASE_END   { int ln_; asm volatile("v_mbcnt_lo_u32_b32 %0, -1, 0\n\tv_mbcnt_hi_u32_b32 %0, -1, %0" : "=v"(ln_));   \
        xcd_barrier((unsigned*)(ws + WS_BAR), (volatile LAS unsigned*)(lds_raw + XB_LDS_OFF), (wave0 == 0) && (ln_ == 0)); } }
#define PHASE_END_IF(c_) { if (c_) { int ln_; asm volatile("v_mbcnt_lo_u32_b32 %0, -1, 0\n\tv_mbcnt_hi_u32_b32 %0, -1, %0" : "=v"(ln_));   \
        xcd_barrier((unsigned*)(ws + WS_BAR), (volatile LAS unsigned*)(lds_raw + XB_LDS_OFF), (wave0 == 0) && (ln_ == 0)); } } }
#define PHASE_END_CG grid.sync(); }

    PHASE_BEGIN
        convert_layer(C, 0);
        rope_table(C);
        prenorm_rows(C, (const float*)args.in[0], (const float*)args.in[3], H);
    PHASE_END

#pragma unroll 1
    for (int l = 0; l < 2; ++l) {
        PHASE_BEGIN
            { pg8::GemmDesc g{(const char*)H, (const char*)(ws + WS_W1IN), DM, DM, 128, 128, 16}; pg8::StdOrder S; S.init(T_, 2 * FF, C.G, bx, DM, DM);
              pg8::Epi<1> E{R1, FF, nullptr, nullptr}; pg8::gemm_phase(C.lds, C.tid, g, S, E); }
        PHASE_END
        PHASE_BEGIN
            { pg8::GemmDesc g{(const char*)R1, (const char*)(ws + WS_W1OUT), FF, FF, 128, 128, 44}; pg8::StdOrder S; S.init(T_, DM, C.G, bx, FF, FF);
              pg8::Epi<0> E{H, DM, nullptr, nullptr}; pg8::gemm_phase(C.lds, C.tid, g, S, E); }
        PHASE_END
        PHASE_BEGIN
            if (bx < 8) {
                { pg8::GemmDesc g{(const char*)(ws + WS_MEMN), (const char*)(ws + WS_WMKV), DM, DM, 128, 128, 16}; pg8::StdOrder S; S.init(512, DM, C.G, bx, DM, DM);
              pg8::Epi<0> E{(bf16_t*)(ws + WS_MKV), DM, nullptr, nullptr}; pg8::gemm_phase(C.lds, C.tid, g, S, E); }
            } else {
                norm_phase(C, C.gw - 8 * NWAVES, C.NGW - 8 * NWAVES, l == 0 ? (const float*)args.in[0] : args.out, args.out, H, H, INF(4, l, DM), INF(7, l, DM), 0.5f);
            }
            cb_reduce(C, l);
        PHASE_END
        PHASE_BEGIN
            { pg8::GemmDesc g{(const char*)H, (const char*)(ws + WS_WMIX), DM, DM, 128, 128, 16}; pg8::StdOrder S; S.init(T_, PP, C.G, bx, DM, DM);
              pg8::Epi<0> E{R1, PP, nullptr, nullptr}; pg8::gemm_phase(C.lds, C.tid, g, S, E); }
        PHASE_END
        PHASE_BEGIN
            if (bx < 64) {
                pg8::GemmDesc g{(const char*)R1, (const char*)(ws + WS_WC1), 16 * PP, 2048, PP * 2, 128, 16}; pg8::CmpOrder S{bx};
                pg8::Epi<0> E{(bf16_t*)(ws + WS_CMPP), 256, nullptr, nullptr}; pg8::gemm_phase(C.lds, C.tid, g, S, E);
            } else {
                prep_items(C, l, C.gw - 64 * NWAVES, C.NGW - 64 * NWAVES);
                memkv_ops(C, C.gw - 64 * NWAVES, C.NGW - 64 * NWAVES);
            }
        PHASE_END
        PHASE_BEGIN
            cmp_stage2(C, l);
        PHASE_END
        PHASE_BEGIN
            attention_phase(C);
        PHASE_END
        PHASE_BEGIN
            { pg8::GemmDesc g{(const char*)H, (const char*)(ws + WS_WG), DM, DM, 128, 128, 16}; pg8::StdOrder S; S.init(T_, GP, C.G, bx, DM, DM);
              pg8::Epi<2> E{R1, GP, nullptr, nullptr}; pg8::gemm_phase(C.lds, C.tid, g, S, E); }
        PHASE_END
        PHASE_BEGIN
            { pg8::GemmDesc g{(const char*)Y, (const char*)(ws + WS_WBR), YP, YP, 128, 128, 8}; pg8::MergeOrder S; S.init(T_, DM, C.G, bx, YP, YP);
              pg8::Epi<3> E{H, DM, R1, nullptr}; pg8::gemm_phase(C.lds, C.tid, g, S, E); }
        PHASE_END
        PHASE_BEGIN
            { pg8::GemmDesc g{(const char*)H, (const char*)(ws + WS_WOUT), DM, DM, 128, 128, 16}; pg8::StdOrder S; S.init(T_, DM, C.G, bx, DM, DM);
              pg8::Epi<0> E{R1, DM, nullptr, nullptr}; pg8::gemm_phase(C.lds, C.tid, g, S, E); }
        PHASE_END
        PHASE_BEGIN
            norm_phase(C, C.gw, C.NGW, args.out, args.out, R1, H, INF(8, l, DM), INF(25, l, DM), 1.0f);
        PHASE_END
        PHASE_BEGIN
            { pg8::GemmDesc g{(const char*)H, (const char*)(ws + WS_W2IN), DM, DM, 128, 128, 16}; pg8::StdOrder S; S.init(T_, 2 * FF, C.G, bx, DM, DM);
              pg8::Epi<1> E{R1, FF, nullptr, nullptr}; pg8::gemm_phase(C.lds, C.tid, g, S, E); }
        PHASE_END
        PHASE_BEGIN
            { pg8::GemmDesc g{(const char*)R1, (const char*)(ws + WS_W2OUT), FF, FF, 128, 128, 44}; pg8::StdOrder S; S.init(T_, DM, C.G, bx, FF, FF);
              pg8::Epi<0> E{H, DM, nullptr, nullptr}; pg8::gemm_phase(C.lds, C.tid, g, S, E); }
        PHASE_END
        PHASE_BEGIN
            norm_phase(C, C.gw, C.NGW, args.out, args.out, H, H, INF(26, l, DM), l == 0 ? INF(3, 1, DM) : nullptr, 0.5f);
            if (l == 0) convert_layer(C, 1);
        PHASE_END_IF(l == 0)
    }
}

extern "C" void kernel_launch(void* const* d_in, const int* in_sizes, int n_in, void* d_out, int out_size, void* d_ws, size_t ws_size, hipStream_t stream) {
    static int grid = 0;
    if (grid == 0) {
        if (n_in != 29 || ws_size < WS_END) { fprintf(stderr, "kernel_launch: unexpected n_in %d / ws %zu\n", n_in, ws_size); grid = -1; return; }
        int dev = 0, cus = 0, per_cu = 0;
        hipGetDevice(&dev); hipDeviceGetAttribute(&cus, hipDeviceAttributeMultiprocessorCount, dev);
        hipFuncSetAttribute((const void*)fwd_kernel, hipFuncAttributeMaxDynamicSharedMemorySize, LDS_BYTES);
        hipOccupancyMaxActiveBlocksPerMultiprocessor(&per_cu, (const void*)fwd_kernel, NWAVES * 64, LDS_BYTES);
        if (per_cu < 1) per_cu = 1;
        grid = cus * per_cu;
        (void)hipGetLastError();
    }
    if (grid < 0) return;
    hipMemsetAsync((char*)d_ws + WS_BAR, 0, 16384, stream);
    Args a{};
    for (int i = 0; i < 29; ++i) a.in[i] = d_in[i];
    a.out = (float*)d_out; a.ws = (unsigned char*)d_ws; a.ph_lo = 0; a.ph_hi = NPHASE;
    void* kargs[] = {&a};
    hipError_t e = hipLaunchCooperativeKernel((const void*)fwd_kernel, dim3(grid), dim3(NWAVES * 64), kargs, LDS_BYTES, stream);
    if (e != hipSuccess) fprintf(stderr, "cooperative launch failed: %s (grid %d)\n", hipGetErrorString(e), grid);
}
```
